# Optimizing an MI355X kernel written in HIP

```python
import math
import jax, jax.numpy as jnp
from jax import lax
import numpy as np

D_MODEL = 1024
BATCH = 1
SEQ = 16384
DEPTH = 1
DEC_BATCH = 16
DEC_SEQ = 16
PAST_LEN = 2048

CHUNK = 64
Q_BLOCK = 128
HEAD_DIM = 64
N_DIFF_HEADS = 4
N_FOX_HEADS = 8
A_WIDTH = N_DIFF_HEADS * 2 * HEAD_DIM
B_WIDTH = N_FOX_HEADS * HEAD_DIM
D_FF = ((8 * D_MODEL // 3 + 255) // 256) * 256
NUM_BUCKETS = 32
MAX_DISTANCE = 128
ALPHA = (2 * DEPTH) ** 0.25
BETA = (8 * DEPTH) ** -0.25
FORGET_BIAS = 3.0
LN_EPS = 1e-5
NEG = -1e30
IN_COLS = 3 * A_WIDTH + 3 * B_WIDTH + N_FOX_HEADS + 2 * D_MODEL
SPLITS = [int(v) for v in np.cumsum([A_WIDTH] * 3 + [B_WIDTH] * 3 + [N_FOX_HEADS])]

kernel_name = 'diff_fox_hybrid_stream_step'


def layer_norm(x, g, b):
    x32 = x.astype(jnp.float32)
    mu = jnp.mean(x32, axis=-1, keepdims=True)
    var = jnp.mean(jnp.square(x32 - mu), axis=-1, keepdims=True)
    return ((x32 - mu) * lax.rsqrt(var + LN_EPS) * g + b).astype(x.dtype)


def modulation(c, w, b):
    m = jax.nn.silu(c) @ w + b
    return [t[:, None, :] for t in jnp.split(m, 6, axis=-1)]


def t5_bucket(rel):
    nb = NUM_BUCKETS // 2
    ret = jnp.where(rel > 0, nb, 0)
    n = jnp.abs(rel)
    max_exact = nb // 2
    nf = jnp.maximum(n, 1).astype(jnp.float32)
    large = max_exact + (jnp.log(nf / max_exact) / math.log(MAX_DISTANCE / max_exact)
                         * (nb - max_exact)).astype(jnp.int32)
    large = jnp.minimum(large, nb - 1)
    return ret + jnp.where(n < max_exact, n, large)


def mixer_inputs(h, w_in_l, b_forget_l):
    B, T, _ = h.shape
    z = h @ w_in_l
    qa, ka, va, qb, kb, vb, f_logit, gates = jnp.split(z, SPLITS, axis=-1)
    heads_a = lambda a: a.reshape(B, T, N_DIFF_HEADS, 2 * HEAD_DIM)
    heads_b = lambda a: a.reshape(B, T, N_FOX_HEADS, HEAD_DIM)
    logf = jax.nn.log_sigmoid((f_logit + b_forget_l).astype(jnp.float32))
    ga, gb = jnp.split(gates, 2, axis=-1)
    return (heads_a(qa), heads_a(ka), heads_a(va), heads_b(qb), heads_b(kb), heads_b(vb), logf, ga, gb)


def diff_attention(qa, ka, va, q_pos, k_pos, rel_bias, lam):
    mask = (k_pos[None, :] // CHUNK) <= (q_pos[:, None] // CHUNK)
    bias = jnp.transpose(rel_bias[t5_bucket(k_pos[None, :] - q_pos[:, None])], (2, 0, 1)).astype(jnp.float32)
    scale = HEAD_DIM ** -0.5

    def probs(q, k):
        s = jnp.einsum('bqhd,bkhd->bhqk', q, k).astype(jnp.float32) * scale + bias
        return jax.nn.softmax(jnp.where(mask, s, NEG), axis=-1)

    p = probs(qa[..., :HEAD_DIM], ka[..., :HEAD_DIM]) - lam * probs(qa[..., HEAD_DIM:], ka[..., HEAD_DIM:])
    return jnp.einsum('bhqk,bkhe->bqhe', p.astype(va.dtype), va)


def fox_attention(q, k, v, fq, fk, q_pos, k_pos):
    mask = k_pos[None, :] <= q_pos[:, None]
    decay = jnp.transpose(fq, (0, 2, 1))[..., :, None] - jnp.transpose(fk, (0, 2, 1))[..., None, :]
    s = jnp.einsum('bqhd,bkhd->bhqk', q, k).astype(jnp.float32) * (HEAD_DIM ** -0.5) + decay
    p = jax.nn.softmax(jnp.where(mask, s, NEG), axis=-1)
    return jnp.einsum('bhqk,bkhd->bqhd', p.astype(v.dtype), v)


def prompt_attention(qa, ka, va, qb, kb, vb, F, rel_bias, lam):
    B, S = qa.shape[:2]
    k_pos = jnp.arange(S, dtype=jnp.int32)

    def block(i):
        start = i * Q_BLOCK
        sl = lambda a: lax.dynamic_slice_in_dim(a, start, Q_BLOCK, axis=1)
        q_pos = start + jnp.arange(Q_BLOCK, dtype=jnp.int32)
        oa = diff_attention(sl(qa), ka, va, q_pos, k_pos, rel_bias, lam)
        ob = fox_attention(sl(qb), kb, vb, sl(F), F, q_pos, k_pos)
        return oa, ob

    oa, ob = lax.map(block, jnp.arange(S // Q_BLOCK, dtype=jnp.int32))
    unblock = lambda o: jnp.moveaxis(o, 0, 1).reshape(B, S, o.shape[3], o.shape[4])
    return unblock(oa), unblock(ob)


def mixer_output(oa, ob, ga, gb, subln_g_l, w_a, w_b, w_o_l, lam_init):
    B, T = oa.shape[:2]
    oa32 = oa.astype(jnp.float32)
    oa = (oa32 * lax.rsqrt(jnp.mean(jnp.square(oa32), axis=-1, keepdims=True) + LN_EPS)
          * subln_g_l * (1.0 - lam_init)).astype(ob.dtype)
    pa = oa.reshape(B, T, A_WIDTH) @ w_a
    pb = ob.reshape(B, T, B_WIDTH) @ w_b
    return (jax.nn.sigmoid(ga) * pa + jax.nn.sigmoid(gb) * pb) @ w_o_l


def post_mixer(x, y_mix, mod, ln1_g_l, ln1_b_l, ln2_g_l, ln2_b_l, w_ffn_in_l, w_ffn_out_l):
    _, _, gate1, shift2, scale2, gate2 = mod
    x1 = layer_norm(ALPHA * x + gate1 * y_mix, ln1_g_l, ln1_b_l)
    h2 = x1 * (1 + scale2) + shift2
    g, u = jnp.split(h2 @ w_ffn_in_l, 2, axis=-1)
    f = (jax.nn.silu(g) * u) @ w_ffn_out_l
    return layer_norm(ALPHA * x1 + gate2 * f, ln2_g_l, ln2_b_l)


def setup_inputs(seed: int = 0) -> dict:
    key = jax.random.key(seed)
    ks = jax.random.split(key, 32)
    nrm = lambda k, shape, s=1.0: jax.random.normal(k, shape, jnp.float32) * s
    col_scale = jnp.concatenate([
        jnp.ones((2 * A_WIDTH,), jnp.float32), jnp.full((A_WIDTH,), BETA, jnp.float32),
        jnp.ones((2 * B_WIDTH,), jnp.float32), jnp.full((B_WIDTH,), BETA, jnp.float32),
        jnp.ones((N_FOX_HEADS + 2 * D_MODEL,), jnp.float32)])
    return {
        'x_prompt': nrm(ks[0], (BATCH, SEQ, D_MODEL)),
        'x_sample': nrm(ks[1], (DEC_BATCH, DEC_SEQ, D_MODEL)),
        'cache_diff_k': nrm(ks[2], (DEPTH, DEC_BATCH, PAST_LEN, N_DIFF_HEADS, 2 * HEAD_DIM)),
        'cache_diff_v': nrm(ks[3], (DEPTH, DEC_BATCH, PAST_LEN, N_DIFF_HEADS, 2 * HEAD_DIM), BETA),
        'cache_fox_k': nrm(ks[4], (DEPTH, DEC_BATCH, PAST_LEN, N_FOX_HEADS, HEAD_DIM)),
        'cache_fox_v': nrm(ks[5], (DEPTH, DEC_BATCH, PAST_LEN, N_FOX_HEADS, HEAD_DIM), BETA),
        'cache_fox_logf': jax.nn.log_sigmoid(FORGET_BIAS + nrm(ks[6], (DEPTH, DEC_BATCH, PAST_LEN, N_FOX_HEADS))),
        'c_prompt': nrm(ks[7], (BATCH, D_MODEL)),
        'c_sample': nrm(ks[8], (DEC_BATCH, D_MODEL)),
        'w_ada': nrm(ks[9], (DEPTH, D_MODEL, 6 * D_MODEL), D_MODEL ** -0.5),
        'b_ada': nrm(ks[10], (DEPTH, 6 * D_MODEL), 0.02),
        'w_in': nrm(ks[11], (DEPTH, D_MODEL, IN_COLS), D_MODEL ** -0.5) * col_scale,
        'b_forget': FORGET_BIAS + nrm(ks[12], (DEPTH, N_FOX_HEADS), 0.1),
        'lambda_q1': nrm(ks[13], (DEPTH, HEAD_DIM), 0.1),
        'lambda_k1': nrm(ks[14], (DEPTH, HEAD_DIM), 0.1),
        'lambda_q2': nrm(ks[15], (DEPTH, HEAD_DIM), 0.1),
        'lambda_k2': nrm(ks[16], (DEPTH, HEAD_DIM), 0.1),
        'subln_g': 1.0 + nrm(ks[17], (DEPTH, 2 * HEAD_DIM), 0.02),
        'rel_bias': nrm(ks[18], (NUM_BUCKETS, N_DIFF_HEADS), 0.5),
        'w_branch_a': nrm(ks[19], (DEPTH, A_WIDTH, D_MODEL), A_WIDTH ** -0.5 * BETA),
        'w_branch_b': nrm(ks[20], (DEPTH, B_WIDTH, D_MODEL), B_WIDTH ** -0.5 * BETA),
        'w_o': nrm(ks[21], (DEPTH, D_MODEL, D_MODEL), D_MODEL ** -0.5 * BETA),
        'ln1_g': 1.0 + nrm(ks[22], (DEPTH, D_MODEL), 0.02),
        'ln1_b': nrm(ks[23], (DEPTH, D_MODEL), 0.02),
        'ln2_g': 1.0 + nrm(ks[24], (DEPTH, D_MODEL), 0.02),
        'ln2_b': nrm(ks[25], (DEPTH, D_MODEL), 0.02),
        'w_ffn_in': nrm(ks[26], (DEPTH, D_MODEL, 2 * D_FF), D_MODEL ** -0.5 * BETA),
        'w_ffn_out': nrm(ks[27], (DEPTH, D_FF, D_MODEL), D_FF ** -0.5 * BETA),
    }


def reference(x_prompt, x_sample, cache_diff_k, cache_diff_v, cache_fox_k, cache_fox_v, cache_fox_logf,
              c_prompt, c_sample, w_ada, b_ada, w_in, b_forget, lambda_q1, lambda_k1, lambda_q2, lambda_k2,
              subln_g, rel_bias, w_branch_a, w_branch_b, w_o, ln1_g, ln1_b, ln2_g, ln2_b, w_ffn_in, w_ffn_out):
    f32 = jnp.float32
    xp, xs = x_prompt, x_sample
    past = cache_diff_k.shape[2]
    dk_p, dv_p, fk_p, fv_p, fl_p = [], [], [], [], []
    dk_s, dv_s, fk_s, fv_s, fl_s = [], [], [], [], []
    for l in range(DEPTH):
        lam_init = 0.8 - 0.6 * math.exp(-0.3 * l)
        lam = (jnp.exp(jnp.sum(lambda_q1[l].astype(f32) * lambda_k1[l].astype(f32)))
               - jnp.exp(jnp.sum(lambda_q2[l].astype(f32) * lambda_k2[l].astype(f32))) + lam_init)
        ffn_w = (ln1_g[l], ln1_b[l], ln2_g[l], ln2_b[l], w_ffn_in[l], w_ffn_out[l])

        mod_p = modulation(c_prompt, w_ada[l], b_ada[l])
        hp = xp * (1 + mod_p[1]) + mod_p[0]
        qa, ka, va, qb, kb, vb, logf, ga, gb = mixer_inputs(hp, w_in[l], b_forget[l])
        F = jnp.cumsum(logf, axis=1)
        oa, ob = prompt_attention(qa, ka, va, qb, kb, vb, F, rel_bias, lam)
        y_mix = mixer_output(oa, ob, ga, gb, subln_g[l], w_branch_a[l], w_branch_b[l], w_o[l], lam_init)
        xp_next = post_mixer(xp, y_mix, mod_p, *ffn_w)
        dk_p.append(ka); dv_p.append(va); fk_p.append(kb); fv_p.append(vb); fl_p.append(logf.astype(xp.dtype))

        mod_s = modulation(c_sample, w_ada[l], b_ada[l])
        hs = xs * (1 + mod_s[1]) + mod_s[0]
        qa_s, ka_s, va_s, qb_s, kb_s, vb_s, logf_s, ga_s, gb_s = mixer_inputs(hs, w_in[l], b_forget[l])
        T = xs.shape[1]
        k_pos = jnp.arange(past + T, dtype=jnp.int32)
        q_pos = past + jnp.arange(T, dtype=jnp.int32)
        ka_all = jnp.concatenate([cache_diff_k[l], ka_s], axis=1)
        va_all = jnp.concatenate([cache_diff_v[l], va_s], axis=1)
        kb_all = jnp.concatenate([cache_fox_k[l], kb_s], axis=1)
        vb_all = jnp.concatenate([cache_fox_v[l], vb_s], axis=1)
        F_all = jnp.cumsum(jnp.concatenate([cache_fox_logf[l].astype(f32), logf_s], axis=1), axis=1)
        oa_s = diff_attention(qa_s, ka_all, va_all, q_pos, k_pos, rel_bias, lam)
        ob_s = fox_attention(qb_s, kb_all, vb_all, F_all[:, past:], F_all, q_pos, k_pos)
        y_mix_s = mixer_output(oa_s, ob_s, ga_s, gb_s, subln_g[l], w_branch_a[l], w_branch_b[l], w_o[l], lam_init)
        xs_next = post_mixer(xs, y_mix_s, mod_s, *ffn_w)
        dk_s.append(ka_s); dv_s.append(va_s); fk_s.append(kb_s); fv_s.append(vb_s); fl_s.append(logf_s.astype(xs.dtype))

        xp, xs = xp_next, xs_next

    st = lambda lst: jnp.stack(lst, axis=0)
    return (xp, xs, st(dk_p), st(dv_p), st(fk_p), st(fv_p), st(fl_p),
            st(dk_s), st(dv_s), st(fk_s), st(fv_s), st(fl_s))
```

```cpp
#include <hip/hip_runtime.h>
#include <hip/hip_cooperative_groups.h>
#include <cstdint>
#include <cstdio>
namespace cg = cooperative_groups;

#ifndef PROBE_DUP
#define PROBE_DUP -1
#endif
#ifndef PROBE_PV
#define PROBE_PV 0
#endif
#ifndef PROBE_MASK
#define PROBE_MASK 7
#endif
#ifndef MK_N_LAUNCHES
#define MK_N_LAUNCHES 1
#endif

#define LAS __attribute__((address_space(3)))
typedef unsigned short bf16_t;
typedef short bf16x8 __attribute__((ext_vector_type(8)));
typedef short s16x4 __attribute__((ext_vector_type(4)));
typedef float f32x4 __attribute__((ext_vector_type(4)));
typedef float f32x2 __attribute__((ext_vector_type(2)));
typedef float f32x16 __attribute__((ext_vector_type(16)));
typedef unsigned u32x4 __attribute__((ext_vector_type(4)));
typedef unsigned u32x2 __attribute__((ext_vector_type(2)));

constexpr int DM = 1024, SEQ = 16384, DEC_B = 16, DEC_T = 16, NSMP = DEC_B * DEC_T, MT = SEQ + NSMP, PAST = 2048, SKV = PAST + DEC_T;
constexpr int NZ = 5120, DFF = 2816, NFF2 = 2 * DFF, WIN_COLS = 5128;
constexpr float LOG2E = 1.4426950408889634f, C2 = 0.125f * LOG2E, ALPHA = 1.189207115002721f, LN_EPS = 1e-5f;
constexpr int NPH = 11;

constexpr size_t O_Y = 0, O_DKP = (size_t)MT * DM, O_DVP = O_DKP + (size_t)SEQ * 512, O_FKP = O_DVP + (size_t)SEQ * 512, O_FVP = O_FKP + (size_t)SEQ * 512,
                 O_FLP = O_FVP + (size_t)SEQ * 512, O_DKS = O_FLP + (size_t)SEQ * 8, O_DVS = O_DKS + (size_t)NSMP * 512, O_FKS = O_DVS + (size_t)NSMP * 512,
                 O_FVS = O_FKS + (size_t)NSMP * 512, O_FLS = O_FVS + (size_t)NSMP * 512, O_END = O_FLS + (size_t)NSMP * 8;

constexpr size_t MiB = 1u << 20;
constexpr size_t WS_CTL = 0, CTL_BYTES = 64 * 1024;
constexpr size_t WS_MOD = 1 * MiB;
constexpr size_t WS_FP = 2 * MiB;
constexpr size_t WS_FS = 3 * MiB;
constexpr size_t WS_WIN = 8 * MiB;
constexpr size_t WS_WAB = 18 * MiB;
constexpr size_t WS_WO2 = 20 * MiB;
constexpr size_t WS_WFI = 24 * MiB;
constexpr size_t WS_WFO = 35 * MiB;
constexpr size_t WS_XN = 48 * MiB;
constexpr size_t WS_QA = 84 * MiB, WS_KA = 101 * MiB, WS_VA = 118 * MiB, WS_QB = 135 * MiB, WS_KB = 152 * MiB, WS_VB = 169 * MiB;
constexpr size_t WS_ACT = 84 * MiB;
constexpr size_t WS_G = 188 * MiB;
constexpr size_t WS_AB = 254 * MiB;
constexpr size_t WS_OD1 = WS_XN, WS_OD2 = 288 * MiB;
constexpr size_t WS_PF = 304 * MiB, WS_PD = 309 * MiB;
constexpr size_t WS_TB = WS_AB;
constexpr size_t WS_X1B = WS_G;
constexpr size_t WS_SLAB = 288 * MiB;
constexpr size_t WS_ZSL = 320 * MiB;
constexpr size_t WS_END = 342 * MiB;

constexpr int LDS_BYTES = 147456;

struct Args { const float* in[28]; float* out; unsigned char* ws; int ph_lo, ph_hi; };

__device__ __forceinline__ int lane_id_opaque() { int l = (int)__builtin_amdgcn_mbcnt_hi(~0u, __builtin_amdgcn_mbcnt_lo(~0u, 0u)); asm volatile("" : "+v"(l)); return l; }
__device__ __forceinline__ unsigned f2bf(float f) { unsigned u = __builtin_bit_cast(unsigned, f); return (u + 0x7fffu + ((u >> 16) & 1u)) >> 16; }
__device__ __forceinline__ unsigned pk2(float lo, float hi) { return f2bf(lo) | (f2bf(hi) << 16); }
__device__ __forceinline__ float bf2f(unsigned short b) { return __builtin_bit_cast(float, (unsigned)b << 16); }
__device__ __forceinline__ float bflo(unsigned w) { return __builtin_bit_cast(float, w << 16); }
__device__ __forceinline__ float bfhi(unsigned w) { return __builtin_bit_cast(float, w & 0xffff0000u); }
__device__ __forceinline__ float wave_sum(float v) {
#pragma unroll
    for (int o = 1; o < 64; o <<= 1) v += __shfl_xor(v, o);
    return v;
}
__device__ __forceinline__ float sigmoidf_(float x) { return 1.0f / (1.0f + __expf(-x)); }
__device__ __forceinline__ float siluf_(float x) { return x / (1.0f + __expf(-x)); }

namespace pg8 {
constexpr int BM = 256, BK = 64, HALF = 128, HTB = HALF * BK * 2, STAGE_BYTES = 8 * HTB, NXCD = 8, WGM = 8;
__host__ __device__ __forceinline__ int lds_byte(int r, int c) { const int st = (r >> 4) * 2 + (c >> 5), rr = r & 15, cc = c & 31, ob = rr * 64 + cc * 2; return st * 1024 + (ob ^ (((ob >> 9) & 1) << 5)); }
__host__ __device__ __forceinline__ void stage_rc(int b, int& R, int& C) { const int st = b / 1024, sb = b % 1024, swz = sb ^ (((sb >> 9) & 1) << 5); R = (st >> 1) * 16 + swz / 64; C = (st & 1) * 32 + (swz % 64) / 2; }
__host__ __device__ __forceinline__ int perm32(int rho) { const int n = rho >> 4, i = rho & 15; return 8 * (i >> 2) + 4 * n + (i & 3); }

struct Unit { int pm, pn, ks; };
struct Gemm { const bf16_t* A; const bf16_t* Bt; int lda, ldb, K, a_split_pn, a_split_off, kpart; };

struct StaticOrder {
    int nM, nN, nwg, G, c, pm0;
    __device__ void init(int nM_, int nN_, int G_, int c_, int pm0_) { nM = nM_; nN = nN_; nwg = nM * nN; G = G_; c = c_; pm0 = pm0_; }
    __device__ bool next(int i, Unit& u) const {
        const long L = (long)i * G + c; if (L >= nwg) return false;
        int wgid = (int)L; { const int q = nwg / NXCD, r = nwg % NXCD, xcd = wgid % NXCD, off = wgid / NXCD; wgid = (xcd < r ? xcd * (q + 1) : r * (q + 1) + (xcd - r) * q) + off; }
        const int nig = WGM * nN, gid = wgid / nig, fm = gid * WGM, gsz = (nM - fm) < WGM ? (nM - fm) : WGM;
        u.pm = pm0 + fm + ((wgid % nig) % gsz); u.pn = (wgid % nig) / gsz; u.ks = 0; return true;
    }
};

struct SplitOrder {
    int nN, nun, G, c, pm;
    __device__ void init(int nN_, int KS_, int G_, int c_, int pm_) { nN = nN_; nun = nN_ * KS_; G = G_; c = c_; pm = pm_; }
    __device__ bool next(int i, Unit& u) const { const long L = (long)i * G + c; if (L >= nun) return false; u.pm = pm; u.pn = (int)L % nN; u.ks = (int)L / nN; return true; }
};

__device__ __forceinline__ unsigned cvt_pk_bf16(float lo, float hi) { unsigned r; asm volatile("v_cvt_pk_bf16_f32 %0, %1, %2" : "=v"(r) : "v"(lo), "v"(hi)); return r; }

template <class Epi, class Sched, bool ALIGN_EPI = true, bool SP2 = true>
__device__ __forceinline__ void gemm_phase(LAS unsigned char* lds, const Gemm g, const Sched& S, const Epi& E, int wid  ) {
    const int lane = lane_id_opaque(), tid = wid * 64 + lane, wr = wid >> 2, wc = wid & 3; int fr = lane & 15, fq = lane >> 4;
    const int K = g.K, nt = K / BK;
    unsigned voffA[2], voffB[2];
#pragma unroll
    for (int i = 0; i < 2; ++i) { int R, C; stage_rc(tid * 16 + i * 8192, R, C); const int Rb = Epi::PERM ? ((R & ~31) + perm32(R & 31)) : R;
        voffA[i] = (unsigned)(R * g.lda + C) * 2u; voffB[i] = (unsigned)(Rb * g.ldb + C) * 2u; }
    const size_t kstep = (size_t)(BK * 2);
    const size_t hstepA = (size_t)HALF * g.lda * 2, hstepB = (size_t)HALF * g.ldb * 2;
    const size_t tstepA = 2 * hstepA, tstepB = 2 * hstepB;
    const unsigned ldsw = (unsigned)wid * 1024u;
    const int aoff = lds_byte(wr * 64 + fr, fq * 8), boff = lds_byte(wc * 32 + fr, fq * 8);
#define PG8_SA(b, h) (((b) * 2 + (h)) * HTB)
#define PG8_SB(b, h) ((4 + (b) * 2 + (h)) * HTB)
#define PG8_STAGE(bufoff, gbase, voff) do { _Pragma("unroll") for (int _i = 0; _i < 2; ++_i) \
        __builtin_amdgcn_global_load_lds((const unsigned*)((const char*)(gbase) + (voff)[_i]), (LAS unsigned*)(lds + (bufoff) + ldsw + _i * 8192), 16, 0, 0); } while (0)
#define PG8_LDA(dst, b, h) do { _Pragma("unroll") for (int m = 0; m < 4; ++m) _Pragma("unroll") for (int k = 0; k < 2; ++k) dst[m][k] = *(const LAS bf16x8*)(lds + PG8_SA(b, h) + aoff + m * 2048 + k * 1024); } while (0)
#define PG8_LDB(dst, b, h) do { _Pragma("unroll") for (int n = 0; n < 2; ++n) _Pragma("unroll") for (int k = 0; k < 2; ++k) dst[n][k] = *(const LAS bf16x8*)(lds + PG8_SB(b, h) + boff + n * 2048 + k * 1024); } while (0)
#define PG8_MMA(ai, bj, At, Bt) do { __builtin_amdgcn_s_setprio(1); _Pragma("unroll") for (int m = 0; m < 4; ++m) _Pragma("unroll") for (int n = 0; n < 2; ++n) _Pragma("unroll") for (int k = 0; k < 2; ++k) \
        acc[ai][bj][m][n] = __builtin_amdgcn_mfma_f32_16x16x32_bf16(Bt[n][k], At[m][k], acc[ai][bj][m][n], 0, 0, 0); __builtin_amdgcn_s_setprio(0); } while (0)
#define PG8_WAIT_V(n) asm volatile("s_waitcnt vmcnt(" #n ")" ::: "memory")
#define PG8_WAIT_L(n) asm volatile("s_waitcnt lgkmcnt(" #n ")" ::: "memory")
#define PG8_BAR __builtin_amdgcn_s_barrier()
#define PG8_SCHED __builtin_amdgcn_sched_barrier(0)
#define PG8_ABASE(u) ((const char*)g.A + (size_t)(u).pm * tstepA + ((u).pn >= g.a_split_pn ? (size_t)g.a_split_off * 2 : (size_t)0) + (size_t)(u).ks * g.kpart * 2)
#define PG8_BBASE(u) ((const char*)g.Bt + (size_t)(u).pn * tstepB + (size_t)(u).ks * g.kpart * 2)
    Unit cur, nxt; int ui = 0;
    if (!S.next(0, cur)) return;
    f32x4 acc[2][2][4][2];
#pragma unroll
    for (int a = 0; a < 2; ++a)
#pragma unroll
        for (int b = 0; b < 2; ++b)
#pragma unroll
            for (int m = 0; m < 4; ++m)
#pragma unroll
                for (int n = 0; n < 2; ++n) acc[a][b][m][n] = (f32x4){0.f, 0.f, 0.f, 0.f};
    bf16x8 At[4][2], B0[2][2], B1[2][2];
    const char* cA = PG8_ABASE(cur); const char* cB = PG8_BBASE(cur);
    if constexpr (SP2) {
        PG8_STAGE(PG8_SB(0, 0), cB, voffB); PG8_STAGE(PG8_SB(0, 1), cB + hstepB, voffB); PG8_STAGE(PG8_SA(0, 0), cA, voffA); PG8_STAGE(PG8_SA(0, 1), cA + hstepA, voffA);
        if (wr == 1) PG8_BAR;
        PG8_WAIT_V(2); PG8_BAR;
        PG8_STAGE(PG8_SB(1, 0), cB + kstep, voffB); PG8_STAGE(PG8_SA(1, 0), cA + kstep, voffA); PG8_STAGE(PG8_SB(1, 1), cB + hstepB + kstep, voffB);
        PG8_WAIT_V(6); PG8_BAR;
    } else {
        PG8_STAGE(PG8_SB(0, 0), cB, voffB); PG8_STAGE(PG8_SA(0, 0), cA, voffA); PG8_STAGE(PG8_SB(0, 1), cB + hstepB, voffB); PG8_STAGE(PG8_SA(0, 1), cA + hstepA, voffA);
        if (wr == 1) PG8_BAR;
        PG8_WAIT_V(4); PG8_BAR;
        PG8_STAGE(PG8_SB(1, 0), cB + kstep, voffB); PG8_STAGE(PG8_SA(1, 0), cA + kstep, voffA); PG8_STAGE(PG8_SB(1, 1), cB + hstepB + kstep, voffB);
        PG8_WAIT_V(6); PG8_BAR;
    }
    for (;;) {
        const bool has_next = S.next(ui + 1, nxt);
        const char* nA = has_next ? PG8_ABASE(nxt) : cA; const char* nB = has_next ? PG8_BBASE(nxt) : cB;
        for (int t = 0; t < nt; t += 2) {
            const bool last = (t == nt - 2);
            const char* a1 = cA + (size_t)(t + 1) * kstep;
            const char* a2 = last ? nA : cA + (size_t)(t + 2) * kstep; const char* b2 = last ? nB : cB + (size_t)(t + 2) * kstep;
            const char* a3 = a2 + kstep; const char* b3 = b2 + kstep;
            if constexpr (SP2) {
            PG8_LDB(B0, 0, 0); PG8_LDB(B1, 0, 1); PG8_SCHED; PG8_LDA(At, 0, 0); PG8_STAGE(PG8_SA(1, 1), a1 + hstepA, voffA);
            PG8_WAIT_V(8); PG8_WAIT_L(0); PG8_BAR; PG8_MMA(0, 0, At, B0); PG8_MMA(0, 1, At, B1); PG8_BAR; PG8_SCHED;
            PG8_LDA(At, 0, 1); PG8_STAGE(PG8_SB(0, 0), b2, voffB); PG8_STAGE(PG8_SB(0, 1), b2 + hstepB, voffB); PG8_STAGE(PG8_SA(0, 0), a2, voffA);
            PG8_WAIT_V(8); PG8_WAIT_L(0); PG8_BAR; PG8_MMA(1, 0, At, B0); PG8_MMA(1, 1, At, B1); PG8_BAR; PG8_SCHED;
            PG8_LDB(B0, 1, 0); PG8_LDB(B1, 1, 1); PG8_SCHED; PG8_LDA(At, 1, 0); PG8_STAGE(PG8_SA(0, 1), a2 + hstepA, voffA);
            PG8_WAIT_V(8); PG8_WAIT_L(0); PG8_BAR; PG8_MMA(0, 0, At, B0); PG8_MMA(0, 1, At, B1); PG8_BAR; PG8_SCHED;
            PG8_LDA(At, 1, 1); PG8_STAGE(PG8_SB(1, 0), b3, voffB); PG8_STAGE(PG8_SB(1, 1), b3 + hstepB, voffB); PG8_STAGE(PG8_SA(1, 0), a3, voffA);
            PG8_WAIT_V(8); PG8_WAIT_L(0); PG8_BAR; PG8_MMA(1, 0, At, B0); PG8_MMA(1, 1, At, B1); PG8_BAR; PG8_SCHED;
            } else {
            PG8_LDB(B0, 0, 0); PG8_SCHED; PG8_LDA(At, 0, 0); PG8_STAGE(PG8_SA(1, 1), a1 + hstepA, voffA);
            PG8_WAIT_L(8); PG8_BAR; PG8_WAIT_L(0); PG8_MMA(0, 0, At, B0); PG8_BAR; PG8_SCHED;
            PG8_LDB(B1, 0, 1); PG8_STAGE(PG8_SB(0, 0), b2, voffB);
            PG8_BAR; PG8_WAIT_L(0); PG8_MMA(0, 1, At, B1); PG8_BAR;
            PG8_LDA(At, 0, 1); PG8_STAGE(PG8_SA(0, 0), a2, voffA);
            PG8_BAR; PG8_WAIT_L(0); PG8_MMA(1, 0, At, B0); PG8_BAR; PG8_SCHED;
            PG8_STAGE(PG8_SB(0, 1), b2 + hstepB, voffB);
            PG8_WAIT_V(6); PG8_BAR; PG8_MMA(1, 1, At, B1); PG8_BAR;
            PG8_LDB(B0, 1, 0); PG8_SCHED; PG8_LDA(At, 1, 0); PG8_STAGE(PG8_SA(0, 1), a2 + hstepA, voffA);
            PG8_WAIT_L(8); PG8_BAR; PG8_WAIT_L(0); PG8_MMA(0, 0, At, B0); PG8_BAR; PG8_SCHED;
            PG8_LDB(B1, 1, 1); PG8_STAGE(PG8_SB(1, 0), b3, voffB);
            PG8_BAR; PG8_WAIT_L(0); PG8_MMA(0, 1, At, B1); PG8_BAR;
            PG8_LDA(At, 1, 1); PG8_STAGE(PG8_SA(1, 0), a3, voffA);
            PG8_BAR; PG8_WAIT_L(0); PG8_MMA(1, 0, At, B0); PG8_BAR; PG8_SCHED;
            PG8_STAGE(PG8_SB(1, 1), b3 + hstepB, voffB);
            PG8_WAIT_V(6); PG8_BAR; PG8_MMA(1, 1, At, B1); PG8_BAR;
            }
        }
        if constexpr (ALIGN_EPI) { if (wr == 0) PG8_BAR; }
        { const int le_ = lane_id_opaque(); E(acc, cur, wr, wc, le_ & 15, le_ >> 4); }
        if (!has_next) break;
#pragma unroll
        for (int a = 0; a < 2; ++a)
#pragma unroll
            for (int b = 0; b < 2; ++b)
#pragma unroll
                for (int m = 0; m < 4; ++m)
#pragma unroll
                    for (int n = 0; n < 2; ++n) acc[a][b][m][n] = (f32x4){0.f, 0.f, 0.f, 0.f};
        cur = nxt; cA = nA; cB = nB; ++ui;
        if constexpr (ALIGN_EPI) { if (wr == 1) PG8_BAR; }
    }
    PG8_WAIT_V(0);
    if constexpr (!ALIGN_EPI) { if (wr == 0) PG8_BAR; }
    PG8_BAR;
#undef PG8_SA
#undef PG8_SB
#undef PG8_STAGE
#undef PG8_LDA
#undef PG8_LDB
#undef PG8_MMA
#undef PG8_WAIT_V
#undef PG8_WAIT_L
#undef PG8_BAR
#undef PG8_SCHED
#undef PG8_ABASE
#undef PG8_BBASE
}
}

struct EpiZ {
    static constexpr bool PERM = true;
    float* out; unsigned char* ws;
    __device__ __forceinline__ void operator()(const f32x4 (&acc)[2][2][4][2], const pg8::Unit& u, int wr, int wc, int fr, int fq) const {
        asm volatile("" : "+v"(fr), "+v"(fq));
        const int seg = u.pn >> 1;
        const bool smp = u.pm >= SEQ / 256;
        const int row0 = u.pm * 256 + wr * 64 + fr;
        const int cl0 = wc * 32 + 8 * fq;
        if (seg < 6) {
            bf16_t* B = (bf16_t*)(ws + WS_QA + (size_t)seg * (WS_KA - WS_QA));
            const bool isq = (seg == 0 || seg == 3);
            const float sc = isq ? C2 : 1.0f;
            const int kk = seg - 1 - (seg > 3 ? 1 : 0);
            float* ob = isq ? nullptr : (smp ? out + O_DKS + (size_t)kk * NSMP * 512 - (size_t)SEQ * 512 : out + O_DKP + (size_t)kk * SEQ * 512);
            const int cs = (u.pn & 1) * 256 + cl0;
            if (seg == 0 || seg == 1 || seg == 3 || seg == 4) {
                float mx0 = 0.f, mx1 = 0.f;
#pragma unroll
                for (int ai = 0; ai < 2; ++ai)
#pragma unroll
                    for (int m = 0; m < 4; ++m) {
#pragma unroll
                        for (int bj = 0; bj < 2; ++bj) { const f32x4 v0 = acc[ai][bj][m][0] * sc, v1 = acc[ai][bj][m][1] * sc;
                            float ss = (v0[0] * v0[0] + v0[1] * v0[1]) + (v0[2] * v0[2] + v0[3] * v0[3]) + (v1[0] * v1[0] + v1[1] * v1[1]) + (v1[2] * v1[2] + v1[3] * v1[3]);
                            ss += __shfl_xor(ss, 16); ss += __shfl_xor(ss, 32);
                            if (bj == 0) mx0 = fmaxf(mx0, ss); else mx1 = fmaxf(mx1, ss); } }
#pragma unroll
                for (int ofs = 1; ofs < 16; ofs <<= 1) { mx0 = fmaxf(mx0, __shfl_xor(mx0, ofs)); mx1 = fmaxf(mx1, __shfl_xor(mx1, ofs)); }
                if ((fr | fq) == 0) { unsigned* nw = (unsigned*)(ws + WS_CTL) + (seg < 3 ? 288 : 256) + ((seg == 4 || seg == 1) ? 16 : 0);
                    const int h0 = (u.pn & 1) * 4 + (wc >> 1), hf = wc & 1;
                    atomicMax(nw + (h0 * 2 + hf), __float_as_uint(mx0)); atomicMax(nw + ((h0 + 2) * 2 + hf), __float_as_uint(mx1)); }
            }
#pragma unroll
            for (int ai = 0; ai < 2; ++ai)
#pragma unroll
                for (int m = 0; m < 4; ++m) { const size_t r = (size_t)(row0 + ai * 128 + m * 16);
#pragma unroll
                    for (int bj = 0; bj < 2; ++bj) { const f32x4 v0 = acc[ai][bj][m][0], v1 = acc[ai][bj][m][1]; const int c = cs + bj * 128;
                        if (ob) { *(f32x4*)(ob + r * 512 + c) = v0; *(f32x4*)(ob + r * 512 + c + 4) = v1; }
                        u32x4 w; w.x = pg8::cvt_pk_bf16(v0[0] * sc, v0[1] * sc); w.y = pg8::cvt_pk_bf16(v0[2] * sc, v0[3] * sc); w.z = pg8::cvt_pk_bf16(v1[0] * sc, v1[1] * sc); w.w = pg8::cvt_pk_bf16(v1[2] * sc, v1[3] * sc);
                        *(u32x4*)(B + r * 512 + c) = w; } }
        } else {
            bf16_t* G = (bf16_t*)(ws + WS_G);
            const int cs = (u.pn - 12) * 256 + cl0;
#pragma unroll
            for (int ai = 0; ai < 2; ++ai)
#pragma unroll
                for (int m = 0; m < 4; ++m) { const size_t r = (size_t)(row0 + ai * 128 + m * 16);
#pragma unroll
                    for (int bj = 0; bj < 2; ++bj) { const f32x4 v0 = acc[ai][bj][m][0], v1 = acc[ai][bj][m][1]; const int c = cs + bj * 128;
                        u32x4 w; w.x = pg8::cvt_pk_bf16(sigmoidf_(v0[0]), sigmoidf_(v0[1])); w.y = pg8::cvt_pk_bf16(sigmoidf_(v0[2]), sigmoidf_(v0[3]));
                        w.z = pg8::cvt_pk_bf16(sigmoidf_(v1[0]), sigmoidf_(v1[1])); w.w = pg8::cvt_pk_bf16(sigmoidf_(v1[2]), sigmoidf_(v1[3]));
                        *(u32x4*)(G + r * 2048 + c) = w; } }
        }
    }
};
struct EpiGate {
    static constexpr bool PERM = true;
    bf16_t* G; bf16_t* GO;
    __device__ __forceinline__ void operator()(const f32x4 (&acc)[2][2][4][2], const pg8::Unit& u, int wr, int wc, int fr, int fq) const {
        asm volatile("" : "+v"(fr), "+v"(fq));
        const int row0 = u.pm * 256 + wr * 64 + fr, c0 = u.pn * 256 + wc * 32 + 8 * fq;
#pragma unroll
        for (int ai = 0; ai < 2; ++ai)
#pragma unroll
            for (int m = 0; m < 4; ++m) { const size_t ro = (size_t)(row0 + ai * 128 + m * 16) * 2048 + c0; const bf16_t* rp = G + ro; bf16_t* wp = GO + ro;
#pragma unroll
                for (int bj = 0; bj < 2; ++bj) { const f32x4 v0 = acc[ai][bj][m][0], v1 = acc[ai][bj][m][1]; const u32x4 gw = *(const u32x4*)(rp + bj * 128);
                    u32x4 w; w.x = pg8::cvt_pk_bf16(v0[0] * bflo(gw.x), v0[1] * bfhi(gw.x)); w.y = pg8::cvt_pk_bf16(v0[2] * bflo(gw.y), v0[3] * bfhi(gw.y));
                    w.z = pg8::cvt_pk_bf16(v1[0] * bflo(gw.z), v1[1] * bfhi(gw.z)); w.w = pg8::cvt_pk_bf16(v1[2] * bflo(gw.w), v1[3] * bfhi(gw.w));
                    *(u32x4*)(wp + bj * 128) = w; } }
    }
};
template <bool BASE_BF16> struct EpiRes {
    static constexpr bool PERM = true;
    const void* base; bf16_t* T; const float* gate;
    __device__ __forceinline__ void operator()(const f32x4 (&acc)[2][2][4][2], const pg8::Unit& u, int wr, int wc, int fr, int fq) const {
        asm volatile("" : "+v"(fr), "+v"(fq));
        const int row0 = u.pm * 256 + wr * 64 + fr, c0 = u.pn * 256 + wc * 32 + 8 * fq;
#pragma unroll
        for (int ai = 0; ai < 2; ++ai)
#pragma unroll
            for (int m = 0; m < 4; ++m) { const size_t ro = (size_t)(row0 + ai * 128 + m * 16) * DM;
#pragma unroll
                for (int bj = 0; bj < 2; ++bj) { const int c = c0 + bj * 128; f32x4 b0, b1;
                    if (BASE_BF16) { const u32x4 bw = *(const u32x4*)((const bf16_t*)base + ro + c); b0 = (f32x4){bflo(bw.x), bfhi(bw.x), bflo(bw.y), bfhi(bw.y)}; b1 = (f32x4){bflo(bw.z), bfhi(bw.z), bflo(bw.w), bfhi(bw.w)}; }
                    else { b0 = *(const f32x4*)((const float*)base + ro + c); b1 = *(const f32x4*)((const float*)base + ro + c + 4); }
                    const f32x4 g0 = *(const f32x4*)(gate + c), g1 = *(const f32x4*)(gate + c + 4);
                    const f32x4 v0 = b0 * ALPHA + g0 * acc[ai][bj][m][0], v1 = b1 * ALPHA + g1 * acc[ai][bj][m][1];
                    u32x4 w; w.x = pg8::cvt_pk_bf16(v0[0], v0[1]); w.y = pg8::cvt_pk_bf16(v0[2], v0[3]); w.z = pg8::cvt_pk_bf16(v1[0], v1[1]); w.w = pg8::cvt_pk_bf16(v1[2], v1[3]);
                    *(u32x4*)(T + ro + c) = w; } }
    }
};
struct EpiSlab {
    static constexpr bool PERM = true;
    float* slab; int ld;
    __device__ __forceinline__ void operator()(const f32x4 (&acc)[2][2][4][2], const pg8::Unit& u, int wr, int wc, int fr, int fq) const {
        asm volatile("" : "+v"(fr), "+v"(fq));
        const int row0 = wr * 64 + fr, c0 = u.pn * 256 + wc * 32 + 8 * fq; float* sb = slab + (size_t)u.ks * NSMP * ld;
#pragma unroll
        for (int ai = 0; ai < 2; ++ai)
#pragma unroll
            for (int m = 0; m < 4; ++m) { float* op = sb + (size_t)(row0 + ai * 128 + m * 16) * ld + c0;
#pragma unroll
                for (int bj = 0; bj < 2; ++bj) { *(f32x4*)(op + bj * 128) = acc[ai][bj][m][0]; *(f32x4*)(op + bj * 128 + 4) = acc[ai][bj][m][1]; } }
    }
};
struct EpiFfn {
    static constexpr bool PERM = true;
    bf16_t* ACT;
    __device__ __forceinline__ void operator()(const f32x4 (&acc)[2][2][4][2], const pg8::Unit& u, int wr, int wc, int fr, int fq) const {
        asm volatile("" : "+v"(fr), "+v"(fq));
        const int row0 = u.pm * 256 + wr * 64 + fr, c0 = u.pn * 128 + wc * 32 + 8 * fq;
#pragma unroll
        for (int ai = 0; ai < 2; ++ai)
#pragma unroll
            for (int m = 0; m < 4; ++m) { const f32x4 g0 = acc[ai][0][m][0], g1 = acc[ai][0][m][1], u0 = acc[ai][1][m][0], u1 = acc[ai][1][m][1];
                u32x4 w; w.x = pg8::cvt_pk_bf16(siluf_(g0[0]) * u0[0], siluf_(g0[1]) * u0[1]); w.y = pg8::cvt_pk_bf16(siluf_(g0[2]) * u0[2], siluf_(g0[3]) * u0[3]);
                w.z = pg8::cvt_pk_bf16(siluf_(g1[0]) * u1[0], siluf_(g1[1]) * u1[1]); w.w = pg8::cvt_pk_bf16(siluf_(g1[2]) * u1[2], siluf_(g1[3]) * u1[3]);
                *(u32x4*)(ACT + (size_t)(row0 + ai * 128 + m * 16) * DFF + c0) = w; }
    }
};

struct Frame {
    LAS unsigned char* lds; unsigned char* ldsg;
    int tid, lane, wave, G, bid;
    const float* const* in; float* out; unsigned char* ws;
};
enum { I_XP = 0, I_XS, I_CDK, I_CDV, I_CFK, I_CFV, I_CFL, I_CP, I_CS, I_WADA, I_BADA, I_WIN, I_BF, I_LQ1, I_LK1, I_LQ2, I_LK2, I_SUBG, I_RELB, I_WA, I_WB, I_WO, I_LN1G, I_LN1B, I_LN2G, I_LN2B, I_WFI, I_WFO };

__device__ __forceinline__ void tr_item(const float* W, int ldw, int src_n0, int k0, bf16_t* WT, int ldt, int dst_row0, int dst_k0, int dup_off, LAS float* scr, int lane) {
#pragma unroll 8
    for (int i = 0; i < 32; ++i) { const int kk = 2 * i + (lane >> 5); scr[kk * 33 + (lane & 31)] = W[(size_t)(k0 + kk) * ldw + src_n0 + (lane & 31)]; }
    asm volatile("s_waitcnt lgkmcnt(0)" ::: "memory");
    const int c = lane & 7;
#pragma unroll
    for (int j = 0; j < 4; ++j) { const int n = (lane >> 3) + 8 * j; const LAS float* s = scr + (8 * c) * 33 + n;
        u32x4 o; o.x = pk2(s[0 * 33], s[1 * 33]); o.y = pk2(s[2 * 33], s[3 * 33]); o.z = pk2(s[4 * 33], s[5 * 33]); o.w = pk2(s[6 * 33], s[7 * 33]);
        bf16_t* d = WT + (size_t)(dst_row0 + n) * ldt + dst_k0 + 8 * c;
        *(u32x4*)d = o; if (dup_off) *(u32x4*)(d + dup_off) = o; }
    asm volatile("s_waitcnt lgkmcnt(0)" ::: "memory");
}
__device__ __forceinline__ void p0_prologue(Frame& F) {
    if (F.bid < 96) {
        LAS float* sc = (LAS float*)F.lds;
        LAS float* part = sc + 17 * 1024;
        for (int i = F.tid; i < 17 * 1024; i += 512) { const int r = i >> 10, k = i & 1023; const float c = r == 0 ? F.in[I_CP][k] : F.in[I_CS][(r - 1) * 1024 + k]; sc[i] = siluf_(c); }
        __syncthreads();
        const int n = F.bid * 64 + F.lane; const float* wa = F.in[I_WADA] + n;
        float acc[17];
#pragma unroll
        for (int r = 0; r < 17; ++r) acc[r] = 0.f;
        for (int k = F.wave * 128; k < F.wave * 128 + 128; k += 4) {
            const float w0 = wa[(size_t)k * 6144], w1 = wa[(size_t)(k + 1) * 6144], w2 = wa[(size_t)(k + 2) * 6144], w3 = wa[(size_t)(k + 3) * 6144];
#pragma unroll
            for (int r = 0; r < 17; ++r) { const f32x4 s = *(const LAS f32x4*)(sc + r * 1024 + k); acc[r] += s[0] * w0 + s[1] * w1 + s[2] * w2 + s[3] * w3; }
        }
#pragma unroll
        for (int r = 0; r < 17; ++r) part[(F.wave * 17 + r) * 64 + F.lane] = acc[r];
        __syncthreads();
        float* mod = (float*)(F.ws + WS_MOD);
        for (int i = F.tid; i < 17 * 64; i += 512) { const int r = i >> 6, l = i & 63; float s = 0.f;
#pragma unroll
            for (int w = 0; w < 8; ++w) s += part[(w * 17 + r) * 64 + l];
            mod[r * 6144 + F.bid * 64 + l] = s + F.in[I_BADA][F.bid * 64 + l]; }
        asm volatile("s_waitcnt vmcnt(0)" ::: "memory");
        __syncthreads();
        if (F.tid == 0) { __builtin_amdgcn_fence(__ATOMIC_RELEASE, "agent"); asm volatile("s_waitcnt vmcnt(0)" ::: "memory");
            __hip_atomic_fetch_add((unsigned*)(F.ws + WS_CTL) + 320, 1u, __ATOMIC_RELAXED, __HIP_MEMORY_SCOPE_AGENT); }
    }
    LAS float* scr = (LAS float*)(F.lds + F.wave * 16384);
    const int gw = F.bid * 8 + F.wave, NGW = F.G * 8;
    constexpr int I_IN = 16 * (NZ / 32), I_A = 8 * 32, I_B = 8 * 32, I_O = 16 * 32, I_FI = 16 * (NFF2 / 32), I_FO = (DFF / 64) * 32;
    constexpr int NITEMS = I_IN + I_A + I_B + I_O + I_FI + I_FO;
    for (int it = gw; it < NITEMS; it += NGW) {
        int r = it;
        if (r < I_IN) { const int nb = NZ / 32, kb = r / nb, n0 = 32 * (r % nb); tr_item(F.in[I_WIN], WIN_COLS, n0 < 3072 ? n0 : n0 + 8, 64 * kb, (bf16_t*)(F.ws + WS_WIN), 1024, n0, 64 * kb, 0, scr, F.lane); continue; } r -= I_IN;
        if (r < I_A) { const int kb = r / 32, n0 = 32 * (r % 32); tr_item(F.in[I_WA], 1024, n0, 64 * kb, (bf16_t*)(F.ws + WS_WAB), 512, n0, 64 * kb, 0, scr, F.lane); continue; } r -= I_A;
        if (r < I_B) { const int kb = r / 32, n0 = 32 * (r % 32); tr_item(F.in[I_WB], 1024, n0, 64 * kb, (bf16_t*)(F.ws + WS_WAB), 512, 1024 + n0, 64 * kb, 0, scr, F.lane); continue; } r -= I_B;
        if (r < I_O) { const int kb = r / 32, n0 = 32 * (r % 32); tr_item(F.in[I_WO], 1024, n0, 64 * kb, (bf16_t*)(F.ws + WS_WO2), 2048, n0, 64 * kb, 1024, scr, F.lane); continue; } r -= I_O;
        if (r < I_FI) { const int nb = NFF2 / 32, kb = r / nb, n0 = 32 * (r % nb), t = n0 >> 8, j = n0 & 255; const int src = j < 128 ? 128 * t + j : DFF + 128 * t + (j - 128);
            tr_item(F.in[I_WFI], NFF2, src, 64 * kb, (bf16_t*)(F.ws + WS_WFI), 1024, n0, 64 * kb, 0, scr, F.lane); continue; } r -= I_FI;
        { const int kb = r / 32, n0 = 32 * (r % 32); tr_item(F.in[I_WFO], 1024, n0, 64 * kb, (bf16_t*)(F.ws + WS_WFO), DFF, n0, 64 * kb, 0, scr, F.lane); }
    }
}

__device__ __forceinline__ void p1_rows(Frame& F, bool wait_mod) {
    LAS float* wf = (LAS float*)F.lds;
    for (int i = F.tid; i < 1024 * 8; i += 512) wf[i] = F.in[I_WIN][(size_t)(i >> 3) * WIN_COLS + 3072 + (i & 7)];
    __syncthreads();
    const float* mod = (const float*)(F.ws + WS_MOD);
    bf16_t* XN = (bf16_t*)(F.ws + WS_XN);
    const int gw = F.bid * 8 + F.wave, NGW = F.G * 8;
    if (wait_mod) {
        if (F.tid == 0) { unsigned* w = (unsigned*)(F.ws + WS_CTL) + 320; unsigned sp = 0;
            while (__hip_atomic_load(w, __ATOMIC_RELAXED, __HIP_MEMORY_SCOPE_AGENT) < 96u && ++sp < (1u << 22)) __builtin_amdgcn_s_sleep(2);
            __builtin_amdgcn_fence(__ATOMIC_ACQUIRE, "agent"); asm volatile("s_waitcnt vmcnt(0)" ::: "memory"); }
        __syncthreads(); }
    for (int m = gw; m < MT; m += NGW) {
        const bool smp = m >= SEQ; const int rb = smp ? 1 + ((m - SEQ) >> 4) : 0;
        const float* xr = smp ? F.in[I_XS] + (size_t)(m - SEQ) * DM : F.in[I_XP] + (size_t)m * DM;
        const float* sh = mod + (size_t)rb * 6144, *scl = sh + 1024;
        float a8[8];
#pragma unroll
        for (int j = 0; j < 8; ++j) a8[j] = 0.f;
#pragma unroll
        for (int j = 0; j < 4; ++j) { const int k = 4 * F.lane + 256 * j;
            const f32x4 x = *(const f32x4*)(xr + k), s1 = *(const f32x4*)(scl + k), t1 = *(const f32x4*)(sh + k);
            const f32x4 h = x * (s1 + 1.0f) + t1;
            u32x2 w; w.x = pk2(h[0], h[1]); w.y = pk2(h[2], h[3]); *(u32x2*)(XN + (size_t)m * DM + k) = w;
#pragma unroll
            for (int e = 0; e < 4; ++e) { const f32x4 wa = *(const LAS f32x4*)(wf + (k + e) * 8), wb = *(const LAS f32x4*)(wf + (k + e) * 8 + 4);
                a8[0] += h[e] * wa[0]; a8[1] += h[e] * wa[1]; a8[2] += h[e] * wa[2]; a8[3] += h[e] * wa[3];
                a8[4] += h[e] * wb[0]; a8[5] += h[e] * wb[1]; a8[6] += h[e] * wb[2]; a8[7] += h[e] * wb[3]; } }
        float mine = 0.f;
#pragma unroll
        for (int j = 0; j < 8; ++j) { const float s = wave_sum(a8[j]); if (F.lane == j) mine = s; }
        if (F.lane < 8) { const float v = mine + F.in[I_BF][F.lane]; const float lf = fminf(v, 0.f) - log1pf(__expf(-fabsf(v)));
            float* o = smp ? F.out + O_FLS + (size_t)(m - SEQ) * 8 : F.out + O_FLP + (size_t)m * 8; o[F.lane] = lf; }
    }
}

__device__ __forceinline__ float block_excl_scan(Frame& F, float tot, LAS float* sm) {
    float inc = tot;
#pragma unroll
    for (int o = 1; o < 64; o <<= 1) { const float t = __shfl_up(inc, o); if (F.lane >= o) inc += t; }
    if (F.lane == 63) sm[F.wave] = inc;
    __syncthreads();
    float base = 0.f;
    for (int w = 0; w < F.wave; ++w) base += sm[w];
    __syncthreads();
    return base + inc - tot;
}
__device__ __forceinline__ void p2_cumsum(Frame& F) {
    LAS float* sm = (LAS float*)F.lds;
    if (F.bid < 8) {
        const int h = F.bid; const float* lf = F.out + O_FLP; float* Fp = (float*)(F.ws + WS_FP) + (size_t)h * SEQ;
        float v[32]; float run = 0.f;
#pragma unroll
        for (int i = 0; i < 32; ++i) { run += lf[(size_t)(32 * F.tid + i) * 8 + h]; v[i] = run; }
        const float off = block_excl_scan(F, run, sm);
#pragma unroll
        for (int i = 0; i < 32; i += 4) *(f32x4*)(Fp + 32 * F.tid + i) = (f32x4){(off + v[i]) * LOG2E, (off + v[i + 1]) * LOG2E, (off + v[i + 2]) * LOG2E, (off + v[i + 3]) * LOG2E};
    } else if (F.bid < 8 + 128) {
        const int b = (F.bid - 8) >> 3, h = (F.bid - 8) & 7;
        const float* cl = F.in[I_CFL] + (size_t)b * PAST * 8; float* Fs = (float*)(F.ws + WS_FS) + (size_t)(b * 8 + h) * SKV;
        float v[4]; float run = 0.f;
#pragma unroll
        for (int i = 0; i < 4; ++i) { run += cl[(size_t)(4 * F.tid + i) * 8 + h]; v[i] = run; }
        const float off = block_excl_scan(F, run, sm);
        *(f32x4*)(Fs + 4 * F.tid) = (f32x4){(off + v[0]) * LOG2E, (off + v[1]) * LOG2E, (off + v[2]) * LOG2E, (off + v[3]) * LOG2E};
        if (F.tid == 511) { float r2 = off + run; const float* ls = F.out + O_FLS + (size_t)b * DEC_T * 8;
            for (int t = 0; t < DEC_T; ++t) { r2 += ls[t * 8 + h]; Fs[PAST + t] = r2 * LOG2E; } }
    }
}

template <bool FINAL> __device__ __forceinline__ void ln_rows(Frame& F, const float* g, const float* b, int KS, int gate_off) {
    const float* mod = (const float*)(F.ws + WS_MOD);
    const bf16_t* T = (const bf16_t*)(F.ws + WS_TB); bf16_t* X1B = (bf16_t*)(F.ws + WS_X1B); bf16_t* XN = (bf16_t*)(F.ws + WS_XN);
    const int gw = F.bid * 8 + F.wave, NGW = F.G * 8;
    for (int m = gw; m < MT; m += NGW) {
        f32x4 v[4]; float s = 0.f;
        if (m < SEQ) {
#pragma unroll
            for (int j = 0; j < 2; ++j) { const u32x4 w = *(const u32x4*)(T + (size_t)m * DM + 8 * F.lane + 512 * j);
                v[2 * j] = (f32x4){bflo(w.x), bfhi(w.x), bflo(w.y), bfhi(w.y)}; v[2 * j + 1] = (f32x4){bflo(w.z), bfhi(w.z), bflo(w.w), bfhi(w.w)}; }
        } else {
            const float* sl = (const float*)(F.ws + WS_SLAB) + (size_t)(m - SEQ) * DM; const float* gp = mod + (size_t)(1 + ((m - SEQ) >> 4)) * 6144 + gate_off;
#pragma unroll
            for (int q = 0; q < 4; ++q) { const int k = 8 * F.lane + 512 * (q >> 1) + 4 * (q & 1); f32x4 a = (f32x4){0.f, 0.f, 0.f, 0.f};
                for (int ks = 0; ks < KS; ++ks) a += *(const f32x4*)(sl + (size_t)ks * NSMP * DM + k);
                f32x4 bs;
                if (FINAL) { const u32x2 w = *(const u32x2*)(X1B + (size_t)m * DM + k); bs = (f32x4){bflo(w.x), bfhi(w.x), bflo(w.y), bfhi(w.y)}; }
                else bs = *(const f32x4*)(F.in[I_XS] + (size_t)(m - SEQ) * DM + k);
                v[q] = bs * ALPHA + *(const f32x4*)(gp + k) * a; } }
#pragma unroll
        for (int q = 0; q < 4; ++q) s += (v[q][0] + v[q][1]) + (v[q][2] + v[q][3]);
        const float mean = wave_sum(s) * (1.f / DM); float s2 = 0.f;
#pragma unroll
        for (int q = 0; q < 4; ++q) { v[q] = v[q] - mean; s2 += (v[q][0] * v[q][0] + v[q][1] * v[q][1]) + (v[q][2] * v[q][2] + v[q][3] * v[q][3]); }
        const float rstd = 1.f / sqrtf(wave_sum(s2) * (1.f / DM) + LN_EPS);
        const int rb = m >= SEQ ? 1 + ((m - SEQ) >> 4) : 0;
#pragma unroll
        for (int q = 0; q < 4; ++q) { const int k = 8 * F.lane + 512 * (q >> 1) + 4 * (q & 1); const f32x4 gg = *(const f32x4*)(g + k), bb = *(const f32x4*)(b + k);
            const f32x4 y = v[q] * rstd * gg + bb;
            if (FINAL) *(f32x4*)(F.out + (size_t)m * DM + k) = y;
            else { u32x2 w; w.x = pk2(y[0], y[1]); w.y = pk2(y[2], y[3]); *(u32x2*)(X1B + (size_t)m * DM + k) = w;
                const f32x4 s2v = *(const f32x4*)(mod + (size_t)rb * 6144 + 4096 + k), t2v = *(const f32x4*)(mod + (size_t)rb * 6144 + 3072 + k);
                const f32x4 h = y * (s2v + 1.0f) + t2v; u32x2 w2; w2.x = pk2(h[0], h[1]); w2.y = pk2(h[2], h[3]); *(u32x2*)(XN + (size_t)m * DM + k) = w2; } }
    }
}

__device__ __forceinline__ int t5_bucket(int rel) {
    const int n = rel < 0 ? -rel : rel; int b;
    if (n < 8) b = n; else if (n < 12) b = 8; else if (n < 16) b = 9; else if (n < 23) b = 10; else if (n < 32) b = 11; else if (n < 46) b = 12; else if (n < 64) b = 13; else if (n < 91) b = 14; else b = 15;
    return b + (rel > 0 ? 16 : 0);
}
constexpr int AT_KB = 8192, AT_VB = 20480, AT_BUF = AT_KB + AT_VB;
constexpr int AT_WS = 2 * AT_BUF, AT_OST = AT_WS + 2048, AT_KEEP = 98304, AT_TAB = 131072, AT_MISC = AT_TAB + 4 * 192 * 4, AT_END = AT_MISC + 64;
__device__ __forceinline__ s16x4 vtr(const LAS char* p) { typedef short v4i16_t __attribute__((ext_vector_type(4))); return __builtin_bit_cast(s16x4, __builtin_amdgcn_ds_read_tr16_b64_v4i16((LAS v4i16_t*)p)); }

typedef __bf16 bf16x2_t_ __attribute__((ext_vector_type(2)));
__device__ __forceinline__ unsigned cvtpk_(float lo, float hi) { f32x2 v = {lo, hi}; bf16x2_t_ b = __builtin_convertvector(v, bf16x2_t_); return __builtin_bit_cast(unsigned, b); }
__device__ __forceinline__ void glds16_asm(const void* gsrc, unsigned lds_dst) { unsigned keep;
    asm volatile("s_mov_b32 %0, m0\n\ts_mov_b32 m0, %2\n\ts_nop 0\n\tglobal_load_lds_dwordx4 %1, off\n\ts_mov_b32 m0, %0" : "=&s"(keep) : "v"(gsrc), "s"(lds_dst) : "memory"); }
template <int OFF> __device__ __forceinline__ void glds16_asm_off(const void* gsrc, unsigned lds_dst) { unsigned keep;
    asm volatile("s_mov_b32 %0, m0\n\ts_mov_b32 m0, %2\n\ts_nop 0\n\tglobal_load_lds_dwordx4 %1, off offset:%3\n\ts_mov_b32 m0, %0" : "=&s"(keep) : "v"(gsrc), "s"(lds_dst), "i"(OFF) : "memory"); }
template <int OFF> __device__ __forceinline__ void glds16_s(const void* sbase, unsigned voff, unsigned lds_dst) { unsigned keep;
    asm volatile("s_mov_b32 %0, m0\n\ts_mov_b32 m0, %3\n\ts_nop 0\n\tglobal_load_lds_dwordx4 %1, %2 offset:%4\n\ts_mov_b32 m0, %0" : "=&s"(keep) : "v"(voff), "s"(sbase), "s"(lds_dst), "i"(OFF) : "memory"); }
__device__ __forceinline__ void glds4_s(const void* sbase, unsigned voff, unsigned lds_dst) { unsigned keep;
    asm volatile("s_mov_b32 %0, m0\n\ts_mov_b32 m0, %3\n\ts_nop 0\n\tglobal_load_lds_dword %1, %2\n\ts_mov_b32 m0, %0" : "=&s"(keep) : "v"(voff), "s"(sbase), "s"(lds_dst) : "memory"); }
__device__ __forceinline__ const void* uniform_ptr(const void* p) { const unsigned long long v = (unsigned long long)p;
    const unsigned lo = (unsigned)__builtin_amdgcn_readfirstlane((int)(unsigned)v), hi = (unsigned)__builtin_amdgcn_readfirstlane((int)(unsigned)(v >> 32)); return (const void*)(((unsigned long long)hi << 32) | lo); }
__device__ __forceinline__ void glds4_asm(const void* gsrc, unsigned lds_dst) { unsigned keep;
    asm volatile("s_mov_b32 %0, m0\n\ts_mov_b32 m0, %2\n\ts_nop 0\n\tglobal_load_lds_dword %1, off\n\ts_mov_b32 m0, %0" : "=&s"(keep) : "v"(gsrc), "s"(lds_dst) : "memory"); }
constexpr int R_V = 0, R_K = 49152, R_F = 73728, R_WS = 79872;
__device__ __forceinline__ float max3f_(float a, float b, float c) { float r; asm("v_max3_f32 %0, %1, %2, %3" : "=v"(r) : "v"(a), "v"(b), "v"(c)); return r; }
__device__ __forceinline__ float max2f_(float a, float b) { float r; asm("v_max_f32_e32 %0, %1, %2" : "=v"(r) : "v"(a), "v"(b)); return r; }
#define AP3_PIN(x) asm volatile("" : "+v"(x))
template <int MODE, int DV, int pv = 0, bool SREF = false>
__device__ __forceinline__ void attn_pass3(Frame& F, const bf16_t* Q, const bf16_t* K, const bf16_t* V, int q0, int NT, const float* Fh, int hb, f32x16 (&o)[DV / 32], int t0 = 0) {
    constexpr int NDB = DV / 32, VS = DV * 128, EPG = 8 / NDB;
    constexpr float THR = 8.0f;
    const int lane = F.lane, r32 = lane & 31, hi = lane >> 5, wid = F.wave;
    const LAS char* lds = (const LAS char*)F.lds;
    LAS float* wsf = (LAS float*)(F.lds + R_WS) + wid * 64;
    const LAS float* tab = (const LAS float*)(F.lds + AT_TAB) + hb * 192;
    const int qrow = q0 + wid * 32 + r32;
    const int tmaxw = (q0 >> 6) + (wid >> 1);
    const char* Ku = (const char*)uniform_ptr(K); const char* Vu = (const char*)uniform_ptr(V); const char* Fu = (const char*)uniform_ptr(MODE == 0 ? (const void*)Fh : (const void*)K);
    const unsigned kvo = (unsigned)(((8 * wid + (lane >> 3)) * 512 + (((lane & 7) ^ (lane >> 3)) << 3)) * 2);
    const unsigned vvo = (unsigned)(((16 * (wid & 3) + (lane >> 2)) * 512 + 32 * (wid >> 2) + 8 * (lane & 3)) * 2);
    const unsigned fvo = (unsigned)(lane * 4);
    const unsigned lds0 = (unsigned)(size_t)F.lds;
    const unsigned dk = (unsigned)__builtin_amdgcn_readfirstlane((int)(lds0 + R_K + wid * 1024)), dv = (unsigned)__builtin_amdgcn_readfirstlane((int)(lds0 + R_V + wid * 1024)),
                   df = (unsigned)__builtin_amdgcn_readfirstlane((int)(lds0 + R_F + wid * 256));
#define AP_ISSUE_K(t, SL) do { glds16_s<0>(Ku + (size_t)(t) * 65536, kvo, dk + (SL) * 8192); if (MODE == 0) glds4_s(Fu + (size_t)(t) * 256, fvo, df + (SL) * 2048); } while (0)
#define AP_ISSUE_V(t, SL) do { glds16_s<0>(Vu + (size_t)(t) * 65536, vvo, dv + (SL) * VS); if (DV == 128) glds16_s<0>(Vu + (size_t)(t) * 65536 + 128, vvo, dv + (SL) * VS + 8192); } while (0)
#define AP_BATCH(t, SL) do { if (pv != 1) { if ((t) + 2 < NT) AP_ISSUE_K((t) + 2, ((SL) + 2) % 3); if ((t) + 1 < NT) AP_ISSUE_V((t) + 1, ((SL) + 1) % 3); } } while (0)
    AP_ISSUE_K(t0, 0); AP_ISSUE_K(t0 + 1, 1); AP_ISSUE_V(t0, 0);
    bf16x8 qr[4];
#pragma unroll
    for (int d0 = 0; d0 < 4; ++d0) qr[d0] = *(const bf16x8*)(Q + (size_t)qrow * 512 + d0 * 16 + hi * 8);
    float fqp = MODE == 0 ? Fh[qrow] : 0.f;
#pragma unroll
    for (int d = 0; d < NDB; ++d) o[d] = f32x16{};
    float m_hat = 0.f, l_run = 0.f;
    f32x16 p0, p1, negm; u32x4 pwv[4];
#pragma unroll
    for (int r = 0; r < 16; ++r) negm[r] = 0.f;
#pragma unroll
    for (int i = 0; i < 4; ++i) pwv[i] = (u32x4){0u, 0u, 0u, 0u};
    const LAS char* kb4[4];
#pragma unroll
    for (int d0 = 0; d0 < 4; ++d0) kb4[d0] = lds + R_K + r32 * 128 + (((2 * d0 + hi) ^ (r32 & 7)) << 4);
    const LAS char* vb1 = lds + R_V + (4 * hi + ((lane & 15) >> 2)) * 64 + (((lane >> 4) & 1) * 16 + (lane & 3) * 4) * 2;
    const LAS char* fb1 = lds + R_F + wid * 256 + 16 * hi;
    asm volatile("s_waitcnt vmcnt(0)" ::: "memory");
    asm volatile("" : "+v"(qr[0]), "+v"(qr[1]), "+v"(qr[2]), "+v"(qr[3]), "+v"(fqp));
    asm volatile("s_waitcnt lgkmcnt(0)\n\ts_barrier" ::: "memory");
#define AP3_VFL(buf, ks, SLV) do { _Pragma("unroll") for (int d = 0; d < NDB; ++d) { buf[2 * d] = vtr(vb1 + (SLV) * VS + d * 4096 + (ks) * 1024); buf[2 * d + 1] = vtr(vb1 + (SLV) * VS + d * 4096 + (ks) * 1024 + 512); } } while (0)
#define AP3_VFL1(buf, d, ks, SLV) do { buf[2 * (d)] = vtr(vb1 + (SLV) * VS + (d) * 4096 + (ks) * 1024); buf[2 * (d) + 1] = vtr(vb1 + (SLV) * VS + (d) * 4096 + (ks) * 1024 + 512); } while (0)
#define AP3_FRAG(buf, d) ((bf16x8){buf[2 * (d)][0], buf[2 * (d)][1], buf[2 * (d)][2], buf[2 * (d)][3], buf[2 * (d) + 1][0], buf[2 * (d) + 1][1], buf[2 * (d) + 1][2], buf[2 * (d) + 1][3]})
#define AP3_GAP(ks, d, VCUR, VNXT, PC, BC, PP, BP, HASPREV, HASNEXT, SLV) do { \
        o[d] = __builtin_amdgcn_mfma_f32_32x32x16_bf16(__builtin_bit_cast(bf16x8, pwv[ks]), AP3_FRAG(VCUR, d), o[d], 0, 0, 0); \
        if (HASNEXT) AP3_VFL1(VNXT, d, (ks) + 1, SLV); \
        _Pragma("unroll") for (int e = 0; e < EPG; ++e) { PC[(BC) + EPG * (d) + e] = __builtin_amdgcn_exp2f(PC[(BC) + EPG * (d) + e]); } \
        if (HASPREV) { _Pragma("unroll") for (int e = 0; e < EPG; ++e) rs += PP[(BP) + EPG * (d) + e]; \
            _Pragma("unroll") for (int e = 0; e < EPG / 2; ++e) pwv[(ks) - 1][(EPG / 2) * (d) + e] = cvtpk_(PP[(BP) + EPG * (d) + 2 * e], PP[(BP) + EPG * (d) + 2 * e + 1]); AP3_PIN(rs); } \
        AP3_PIN(PC); \
        __builtin_amdgcn_sched_barrier(0); } while (0)
#define AP3_GROUP(ks, VCUR, VNXT, PC, BC, PP, BP, HASPREV, HASNEXT, SLV) do { _Pragma("unroll") for (int d = 0; d < NDB; ++d) AP3_GAP(ks, d, VCUR, VNXT, PC, BC, PP, BP, HASPREV, HASNEXT, SLV); } while (0)
#define AP3_OCT(PC, BC, KS) do { _Pragma("unroll") for (int e = 0; e < 8; ++e) { PC[(BC) + e] = __builtin_amdgcn_exp2f(PC[(BC) + e]); rs += PC[(BC) + e]; } \
        _Pragma("unroll") for (int e = 0; e < 4; ++e) pwv[KS][e] = cvtpk_(PC[(BC) + 2 * e], PC[(BC) + 2 * e + 1]); } while (0)
#define AP3_KRD(i, SL) (*(const LAS bf16x8*)(kb4[(i) >> 1] + (SL) * 8192 + ((i) & 1) * 4096))
#define AP3_MM(KF, d0, P) P = __builtin_amdgcn_mfma_f32_32x32x16_bf16(KF, qr[d0], P, 0, 0, 0)
#define AP3_QKF(SL) do { bf16x8 ka = AP3_KRD(0, SL), kb = AP3_KRD(1, SL), kc = AP3_KRD(2, SL); \
        if (MODE == 0) { \
            _Pragma("unroll") for (int g4 = 0; g4 < 4; ++g4) { const f32x4 fa = *(const LAS f32x4*)(fb1 + (SL) * 2048 + 32 * g4), fb = *(const LAS f32x4*)(fb1 + (SL) * 2048 + 128 + 32 * g4); \
                _Pragma("unroll") for (int e = 0; e < 4; ++e) { p0[4 * g4 + e] = fqp - fa[e]; p1[4 * g4 + e] = fqp - fb[e]; } } \
        } else { p0 = f32x16{}; p1 = f32x16{}; } \
        __builtin_amdgcn_sched_barrier(0); \
        AP3_MM(ka, 0, p0); ka = AP3_KRD(3, SL); __builtin_amdgcn_sched_barrier(0); \
        AP3_MM(kb, 0, p1); kb = AP3_KRD(4, SL); __builtin_amdgcn_sched_barrier(0); \
        AP3_MM(kc, 1, p0); kc = AP3_KRD(5, SL); __builtin_amdgcn_sched_barrier(0); \
        AP3_MM(ka, 1, p1); ka = AP3_KRD(6, SL); __builtin_amdgcn_sched_barrier(0); \
        AP3_MM(kb, 2, p0); kb = AP3_KRD(7, SL); __builtin_amdgcn_sched_barrier(0); \
        AP3_MM(kc, 2, p1); __builtin_amdgcn_sched_barrier(0); \
        AP3_MM(ka, 3, p0); __builtin_amdgcn_sched_barrier(0); \
        AP3_MM(kb, 3, p1); \
        asm volatile("" : "+v"(p0), "+v"(p1)); \
    } while (0)
#define AP3_QKS(SL) do { bf16x8 kf[8]; \
        _Pragma("unroll") for (int d0 = 0; d0 < 4; ++d0) { kf[2 * d0] = *(const LAS bf16x8*)(kb4[d0] + (SL) * 8192); kf[2 * d0 + 1] = *(const LAS bf16x8*)(kb4[d0] + (SL) * 8192 + 4096); } \
        if (MODE == 0) { const float sft = fqp - m_hat; \
            _Pragma("unroll") for (int g4 = 0; g4 < 4; ++g4) { const f32x4 fa = *(const LAS f32x4*)(fb1 + (SL) * 2048 + 32 * g4), fb = *(const LAS f32x4*)(fb1 + (SL) * 2048 + 128 + 32 * g4); \
                _Pragma("unroll") for (int e = 0; e < 4; ++e) { p0[4 * g4 + e] = sft - fa[e]; p1[4 * g4 + e] = sft - fb[e]; } } \
            _Pragma("unroll") for (int d0 = 0; d0 < 4; ++d0) { p0 = __builtin_amdgcn_mfma_f32_32x32x16_bf16(kf[2 * d0], qr[d0], p0, 0, 0, 0); p1 = __builtin_amdgcn_mfma_f32_32x32x16_bf16(kf[2 * d0 + 1], qr[d0], p1, 0, 0, 0); } \
        } else { \
            if constexpr (SREF) { p0 = __builtin_amdgcn_mfma_f32_32x32x16_bf16(kf[0], qr[0], f32x16{}, 0, 0, 0); p1 = __builtin_amdgcn_mfma_f32_32x32x16_bf16(kf[1], qr[0], f32x16{}, 0, 0, 0); } \
            else { p0 = __builtin_amdgcn_mfma_f32_32x32x16_bf16(kf[0], qr[0], negm, 0, 0, 0); p1 = __builtin_amdgcn_mfma_f32_32x32x16_bf16(kf[1], qr[0], negm, 0, 0, 0); } \
            _Pragma("unroll") for (int d0 = 1; d0 < 4; ++d0) { p0 = __builtin_amdgcn_mfma_f32_32x32x16_bf16(kf[2 * d0], qr[d0], p0, 0, 0, 0); p1 = __builtin_amdgcn_mfma_f32_32x32x16_bf16(kf[2 * d0 + 1], qr[d0], p1, 0, 0, 0); } } \
        if constexpr (SREF) asm volatile("" : "+v"(p0), "+v"(p1)); else asm volatile("s_nop 15\n\ts_nop 7" : "+v"(p0), "+v"(p1));     \
    } while (0)
#define AP3_QK(SL) do { if constexpr (SREF) AP3_QKF(SL); else AP3_QKS(SL); } while (0)
#define AP3_DECIDE(WITH_TAB) do { \
        if (MODE == 0) { \
            if (t * 64 + 63 > q0 + wid * 32) { const int ln_ = lane_id_opaque(), kv0 = t * 64 + 4 * (ln_ >> 5), qrow_ = q0 + wid * 32 + (ln_ & 31);     \
                _Pragma("unroll") for (int r = 0; r < 16; ++r) { const int kv = kv0 + (r & 3) + 8 * (r >> 2); if (kv > qrow_) p0[r] = -1e30f; if (kv + 32 > qrow_) p1[r] = -1e30f; } } \
        } else if (WITH_TAB) { \
            if (near) { const int ln_ = lane_id_opaque(), kv0 = t * 64 + 4 * (ln_ >> 5), qrow_ = q0 + wid * 32 + (ln_ & 31); const LAS float* tab_ = (const LAS float*)(F.lds + AT_TAB) + hb * 192; \
                _Pragma("unroll") for (int g4 = 0; g4 < 4; ++g4) { \
                    _Pragma("unroll") for (int e = 0; e < 4; ++e) { const int r = 4 * g4 + e; const int rel = kv0 + e + 8 * g4 - qrow_; int i0 = rel + 128, i1 = rel + 160; i0 = i0 < 0 ? 0 : i0; i1 = i1 < 0 ? 0 : i1; \
                        p0[r] += tab_[i0]; p1[r] += tab_[i1]; } \
                    __builtin_amdgcn_sched_barrier(0); } } } \
        if constexpr (!SREF) { \
        float ma = max3f_(p0[0], p0[1], p1[0]), mb = max3f_(p0[2], p0[3], p1[1]); ma = max3f_(ma, p1[2], p1[3]); \
        _Pragma("unroll") for (int r = 4; r < 16; r += 4) { ma = max3f_(ma, p0[r], p0[r + 1]); mb = max3f_(mb, p0[r + 2], p0[r + 3]); ma = max3f_(ma, p1[r], p1[r + 1]); mb = max3f_(mb, p1[r + 2], p1[r + 3]); } \
        float rm = max2f_(ma, mb); \
        { auto rr = __builtin_amdgcn_permlane32_swap(__float_as_uint(rm), __float_as_uint(rm), false, false); rm = max2f_(__uint_as_float(rr[0]), __uint_as_float(rr[1])); } \
        resc = (tz == t0) || __any(rm > THR); \
        if (resc) { const float dl = tz == t0 ? rm : fmaxf(rm, 0.f); m_hat += dl; \
            _Pragma("unroll") for (int r = 0; r < 16; ++r) { p0[r] -= dl; p1[r] -= dl; } \
            if (MODE == 1) { const float nm_ = -m_hat; _Pragma("unroll") for (int r = 0; r < 16; ++r) negm[r] = nm_; } \
            al = tz == t0 ? 1.0f : __builtin_amdgcn_exp2f(-dl); l_run *= al; } } } while (0)
#define AP3_STEP(tt, SL) do { const int t = (tt); if (t > NT) break; int tz = t; asm volatile("" : "+s"(tz)); \
        if (t < NT) AP_BATCH(t, SL); \
        const bool doPV = tz > t0 && t - 1 <= tmaxw, doQK = t < NT && t <= tmaxw; \
        bool resc = false; float al = 1.0f, rs = 0.f; \
        const bool near = MODE == 1 && (t * 64 + 63 + 91 > q0 + wid * 32); \
        if (doQK) AP3_QK(SL); else { p0 = f32x16{}; p1 = f32x16{}; }     \
        __builtin_amdgcn_sched_barrier(0); \
        if (doQK) AP3_DECIDE(true); \
        __builtin_amdgcn_sched_barrier(0); \
        if (doPV) { s16x4 vfa[2 * NDB]; AP3_VFL(vfa, 0, ((SL) + 2) % 3);     \
            AP3_GROUP(0, vfa, vfa, p0, 0, p0, 0, false, true, ((SL) + 2) % 3); \
            AP3_GROUP(1, vfa, vfa, p0, 8, p0, 0, true, true, ((SL) + 2) % 3); \
            AP3_GROUP(2, vfa, vfa, p1, 0, p0, 8, true, true, ((SL) + 2) % 3); \
            AP3_GROUP(3, vfa, vfa, p1, 8, p1, 0, true, false, ((SL) + 2) % 3); \
            _Pragma("unroll") for (int e = 0; e < 8; ++e) rs += p1[8 + e]; \
            _Pragma("unroll") for (int e = 0; e < 4; ++e) pwv[3][e] = cvtpk_(p1[8 + 2 * e], p1[8 + 2 * e + 1]); \
        } else if (doQK) { AP3_OCT(p0, 0, 0); AP3_OCT(p0, 8, 1); AP3_OCT(p1, 0, 2); AP3_OCT(p1, 8, 3); } \
        if (doQK) l_run += rs; \
          \
        if (resc && tz > t0) { \
            if (hi == 0) wsf[r32] = al; \
            asm volatile("s_waitcnt lgkmcnt(0)" ::: "memory"); \
            _Pragma("unroll") for (int g4 = 0; g4 < 4; ++g4) { const f32x4 a4 = *(const LAS f32x4*)(wsf + 8 * g4 + 4 * hi); \
                _Pragma("unroll") for (int d = 0; d < NDB; ++d) \
                    _Pragma("unroll") for (int e = 0; e < 4; ++e) o[d][4 * g4 + e] *= a4[e]; } } \
        if (t == NT) break; \
        if (pv == 6) { if (t + 2 < NT) asm volatile("s_waitcnt vmcnt(3) lgkmcnt(0)" ::: "memory"); else asm volatile("s_waitcnt vmcnt(0) lgkmcnt(0)" ::: "memory"); } \
        else { if (t + 2 < NT) asm volatile("s_waitcnt vmcnt(3) lgkmcnt(0)\n\ts_barrier" ::: "memory"); else asm volatile("s_waitcnt vmcnt(0) lgkmcnt(0)\n\ts_barrier" ::: "memory"); } \
    } while (0)
#define AP3_FSTEP(tt, SL) do { const int t = (tt); \
        AP_ISSUE_K(t + 2, ((SL) + 2) % 3); AP_ISSUE_V(t + 1, ((SL) + 1) % 3); \
        float rs = 0.f; \
        AP3_QKF(SL); \
        __builtin_amdgcn_sched_barrier(0); \
        { s16x4 vfa[2 * NDB]; AP3_VFL(vfa, 0, ((SL) + 2) % 3); \
          AP3_GROUP(0, vfa, vfa, p0, 0, p0, 0, false, true, ((SL) + 2) % 3); \
          AP3_GROUP(1, vfa, vfa, p0, 8, p0, 0, true, true, ((SL) + 2) % 3); \
          AP3_GROUP(2, vfa, vfa, p1, 0, p0, 8, true, true, ((SL) + 2) % 3); \
          AP3_GROUP(3, vfa, vfa, p1, 8, p1, 0, true, false, ((SL) + 2) % 3); \
          _Pragma("unroll") for (int e = 0; e < 8; ++e) rs += p1[8 + e]; \
          _Pragma("unroll") for (int e = 0; e < 4; ++e) pwv[3][e] = cvtpk_(p1[8 + 2 * e], p1[8 + 2 * e + 1]); } \
        l_run += rs; \
        asm volatile("s_waitcnt vmcnt(3) lgkmcnt(0)\n\ts_barrier" ::: "memory"); \
    } while (0)
    if (wid >= 4) __builtin_amdgcn_s_setprio(1);
    int t3 = t0;
    if constexpr (SREF && pv == 0) {
        AP3_STEP(t3, 0); AP3_STEP(t3 + 1, 1); AP3_STEP(t3 + 2, 2); t3 += 3;
        const int tfe = (q0 >> 6) - 3;
        for (; t3 + 2 <= tfe; t3 += 3) { AP3_FSTEP(t3, 0); AP3_FSTEP(t3 + 1, 1); AP3_FSTEP(t3 + 2, 2); }
    }
    for (; t3 <= NT; t3 += 3) { AP3_STEP(t3, 0); AP3_STEP(t3 + 1, 1); AP3_STEP(t3 + 2, 2); }
    if (wid >= 4) __builtin_amdgcn_s_setprio(0);
    asm volatile("s_waitcnt lgkmcnt(0)\n\ts_barrier" ::: "memory");
    l_run += __shfl_xor(l_run, 32);
    if (hi == 0) wsf[r32] = 1.0f / l_run;
    asm volatile("s_waitcnt lgkmcnt(0)" ::: "memory");
#pragma unroll
    for (int g4 = 0; g4 < 4; ++g4) { const f32x4 a4 = *(const LAS f32x4*)(wsf + 8 * g4 + 4 * hi);
#pragma unroll
        for (int d = 0; d < NDB; ++d)
#pragma unroll
            for (int e = 0; e < 4; ++e) o[d][4 * g4 + e] *= a4[e]; }
#undef AP_ISSUE_K
#undef AP_ISSUE_V
#undef AP_BATCH
#undef AP3_VFL
#undef AP3_VFL1
#undef AP3_FRAG
#undef AP3_GAP
#undef AP3_GROUP
#undef AP3_OCT
#undef AP3_STEP
#undef AP3_FSTEP
#undef AP3_QK
#undef AP3_QKF
#undef AP3_QKS
#undef AP3_KRD
#undef AP3_MM
#undef AP3_DECIDE
}

template <int NDB> __device__ __forceinline__ void store_o(const f32x16 (&o)[NDB], LAS unsigned char* stgb  , bf16_t* dst  , int ld, int lane) {
    const int r32 = lane & 31, hi = lane >> 5;
    constexpr int DVC = 32 * NDB;
    LAS bf16_t* stg = (LAS bf16_t*)stgb;
#pragma unroll
    for (int d = 0; d < NDB; ++d)
#pragma unroll
        for (int r = 0; r < 16; ++r) { const int row = (r & 3) + 8 * (r >> 2) + 4 * hi; stg[row * DVC + 32 * d + r32] = (bf16_t)f2bf(o[d][r]); }
    asm volatile("s_waitcnt lgkmcnt(0)" ::: "memory");
    constexpr int CPR = DVC / 8;
#pragma unroll
    for (int i = 0; i < (32 * CPR) / 64; ++i) { const int c = i * 64 + lane, row = c / CPR, ch = c % CPR;
        const u32x4 v = *(const LAS u32x4*)(stg + row * DVC + ch * 8); *(u32x4*)(dst + (size_t)row * ld + ch * 8) = v; }
    asm volatile("s_waitcnt lgkmcnt(0)" ::: "memory");
}

__device__ __forceinline__ float lambda_full(Frame& F) {
    float a = 0.f, b = 0.f;
    for (int i = 0; i < 64; ++i) { a += F.in[I_LQ1][i] * F.in[I_LK1][i]; b += F.in[I_LQ2][i] * F.in[I_LK2][i]; }
    return __expf(a) - __expf(b) + 0.2f;
}

template <int pv = 0> __device__ __forceinline__ void attn_prompt_fox(Frame& F, int h, int qb) {
    const bf16_t* Q = (const bf16_t*)(F.ws + WS_QB) + h * 64; const bf16_t* K = (const bf16_t*)(F.ws + WS_KB) + h * 64; const bf16_t* V = (const bf16_t*)(F.ws + WS_VB) + h * 64;
    f32x16 o[2];
    const float* Fh = (const float*)(F.ws + WS_FP) + (size_t)h * SEQ;
    int t0 = 0; bool fast;
    { const unsigned* nw = (const unsigned*)(F.ws + WS_CTL) + 256;
      const float qn2 = __uint_as_float(nw[h * 2]) + __uint_as_float(nw[h * 2 + 1]), kn2 = __uint_as_float(nw[16 + h * 2]) + __uint_as_float(nw[16 + h * 2 + 1]);
      const float B = sqrtf(qn2 * kn2) * 1.02f + 0.5f;
      const float thresh = -48.0f - 2.0f * B;
      fast = __builtin_amdgcn_readfirstlane(B <= 60.0f ? 1 : 0) != 0;
      volatile LAS int* cnt = (volatile LAS int*)(F.lds + AT_MISC + 32);
      __syncthreads();
      if (F.tid < 256) { const int t = F.tid; const bool sk = t < 4 * qb && (Fh[qb * 256] - Fh[64 * t + 63]) <= thresh;
          const int c = __popcll(__ballot(sk)); if (F.lane == 0) cnt[F.wave] = c; }
      __syncthreads();
      t0 = cnt[0] + cnt[1] + cnt[2] + cnt[3]; t0 -= t0 % 3; }
    if (fast) attn_pass3<0, 64, pv, true>(F, Q, K, V, qb * 256, 4 * qb + 4, Fh, 0, o, t0); else attn_pass3<0, 64, pv, false>(F, Q, K, V, qb * 256, 4 * qb + 4, Fh, 0, o, t0);
    if (pv != 0 && o[0][0] != 1234.5678f) { __syncthreads(); return; }
    bf16_t* AB = (bf16_t*)(F.ws + WS_AB);
    store_o<2>(o, F.lds + F.wave * 8192, AB + (size_t)(qb * 256 + F.wave * 32) * DM + 512 + h * 64, DM, F.lane);
    __syncthreads();
}
template <int pv = 0> __device__ __forceinline__ void attn_prompt_diff_half(Frame& F, int h, int half, int qb) {
    const bf16_t* Q = (const bf16_t*)(F.ws + WS_QA) + h * 128 + 64 * half; const bf16_t* K = (const bf16_t*)(F.ws + WS_KA) + h * 128 + 64 * half; const bf16_t* V = (const bf16_t*)(F.ws + WS_VA) + h * 128;
    f32x16 o[4];
    bool fast;
    { const unsigned* nw = (const unsigned*)(F.ws + WS_CTL) + 288; const int hh = h * 2 + half;
      const float qn2 = __uint_as_float(nw[hh * 2]) + __uint_as_float(nw[hh * 2 + 1]), kn2 = __uint_as_float(nw[16 + hh * 2]) + __uint_as_float(nw[16 + hh * 2 + 1]);
      float bm = 0.f; for (int b = 0; b < 32; ++b) bm = fmaxf(bm, fabsf(F.in[I_RELB][b * 4 + h] - F.in[I_RELB][15 * 4 + h]));
      const float B = sqrtf(qn2 * kn2) * 1.02f + 0.5f + bm * LOG2E;
      fast = __builtin_amdgcn_readfirstlane(B <= 60.0f ? 1 : 0) != 0; }
    if (fast) attn_pass3<1, 128, pv, true>(F, Q, K, V, qb * 256, 4 * qb + 4, nullptr, h, o); else attn_pass3<1, 128, pv, false>(F, Q, K, V, qb * 256, 4 * qb + 4, nullptr, h, o);
    if (pv != 0 && o[0][0] != 1234.5678f) { __syncthreads(); return; }
    bf16_t* OD = (bf16_t*)(F.ws + (half ? WS_OD2 : WS_OD1));
    store_o<4>(o, F.lds + F.wave * 8192, OD + (size_t)(qb * 256 + F.wave * 32) * 512 + h * 128, 512, F.lane);
    __syncthreads();
}
constexpr int PF_STR = 66, PD_STR = 130;
__device__ __forceinline__ void p_combine(Frame& F) {
    const float lam = lambda_full(F);
    const bf16_t* O1 = (const bf16_t*)(F.ws + WS_OD1); const bf16_t* O2 = (const bf16_t*)(F.ws + WS_OD2); bf16_t* AB = (bf16_t*)(F.ws + WS_AB);
    const int gw = F.bid * 8 + F.wave, NGW = F.G * 8;
    const int c0 = 8 * F.lane;
    float sg[8];
#pragma unroll
    for (int i = 0; i < 8; ++i) sg[i] = F.in[I_SUBG][(c0 & 127) + i] * 0.8f;
    for (int m = gw; m < SEQ; m += NGW) {
        const u32x4 a = *(const u32x4*)(O1 + (size_t)m * 512 + c0), b = *(const u32x4*)(O2 + (size_t)m * 512 + c0);
        float v[8];
        v[0] = bflo(a.x) - lam * bflo(b.x); v[1] = bfhi(a.x) - lam * bfhi(b.x); v[2] = bflo(a.y) - lam * bflo(b.y); v[3] = bfhi(a.y) - lam * bfhi(b.y);
        v[4] = bflo(a.z) - lam * bflo(b.z); v[5] = bfhi(a.z) - lam * bfhi(b.z); v[6] = bflo(a.w) - lam * bflo(b.w); v[7] = bfhi(a.w) - lam * bfhi(b.w);
        float ss = 0.f;
#pragma unroll
        for (int i = 0; i < 8; ++i) ss += v[i] * v[i];
#pragma unroll
        for (int ofs = 1; ofs < 16; ofs <<= 1) ss += __shfl_xor(ss, ofs);
        const float rn = 1.0f / sqrtf(ss * (1.0f / 128.0f) + LN_EPS);
        u32x4 w; w.x = pk2(v[0] * rn * sg[0], v[1] * rn * sg[1]); w.y = pk2(v[2] * rn * sg[2], v[3] * rn * sg[3]); w.z = pk2(v[4] * rn * sg[4], v[5] * rn * sg[5]); w.w = pk2(v[6] * rn * sg[6], v[7] * rn * sg[7]);
        *(u32x4*)(AB + (size_t)m * DM + c0) = w;
    }
    for (int it = gw; it < NSMP; it += NGW) {
        const int b = it >> 4, q = it & 15; const size_t row = (size_t)SEQ + it;
        {
            const int h = F.lane >> 3, cc = (F.lane & 7) * 8; const float* P = (const float*)(F.ws + WS_PF);
            float M = -1e30f;
            for (int s = 0; s < 8; ++s) M = fmaxf(M, P[((size_t)((b * 8 + s) * 8 + h) * 16 + q) * PF_STR + 64]);
            float acc[8], L = 0.f;
#pragma unroll
            for (int i = 0; i < 8; ++i) acc[i] = 0.f;
            for (int s = 0; s < 8; ++s) { const float* pr = P + ((size_t)((b * 8 + s) * 8 + h) * 16 + q) * PF_STR; const float wgt = __builtin_amdgcn_exp2f(pr[64] - M); L += wgt * pr[65];
#pragma unroll
                for (int i = 0; i < 8; ++i) acc[i] += wgt * pr[cc + i]; }
            const float inv = 1.0f / L;
            u32x4 w; w.x = pk2(acc[0] * inv, acc[1] * inv); w.y = pk2(acc[2] * inv, acc[3] * inv); w.z = pk2(acc[4] * inv, acc[5] * inv); w.w = pk2(acc[6] * inv, acc[7] * inv);
            *(u32x4*)(AB + row * DM + 512 + c0) = w; }
        {
            const int h = F.lane >> 4, cc = (F.lane & 15) * 8; const float* P = (const float*)(F.ws + WS_PD);
            float v[8];
#pragma unroll
            for (int i = 0; i < 8; ++i) v[i] = 0.f;
#pragma unroll
            for (int half = 0; half < 2; ++half) {
                float M = -1e30f;
                for (int s = 0; s < 8; ++s) M = fmaxf(M, P[((size_t)((b * 8 + s) * 8 + 2 * h + half) * 16 + q) * PD_STR + 128]);
                float acc[8], L = 0.f;
#pragma unroll
                for (int i = 0; i < 8; ++i) acc[i] = 0.f;
                for (int s = 0; s < 8; ++s) { const float* pr = P + ((size_t)((b * 8 + s) * 8 + 2 * h + half) * 16 + q) * PD_STR; const float wgt = __builtin_amdgcn_exp2f(pr[128] - M); L += wgt * pr[129];
#pragma unroll
                    for (int i = 0; i < 8; ++i) acc[i] += wgt * pr[cc + i]; }
                const float sc = (half ? -lam : 1.0f) / L;
#pragma unroll
                for (int i = 0; i < 8; ++i) v[i] += acc[i] * sc; }
            float ss = 0.f;
#pragma unroll
            for (int i = 0; i < 8; ++i) ss += v[i] * v[i];
#pragma unroll
            for (int ofs = 1; ofs < 16; ofs <<= 1) ss += __shfl_xor(ss, ofs);
            const float rn = 1.0f / sqrtf(ss * (1.0f / 128.0f) + LN_EPS);
            u32x4 w; w.x = pk2(v[0] * rn * sg[0], v[1] * rn * sg[1]); w.y = pk2(v[2] * rn * sg[2], v[3] * rn * sg[3]); w.z = pk2(v[4] * rn * sg[4], v[5] * rn * sg[5]); w.w = pk2(v[6] * rn * sg[6], v[7] * rn * sg[7]);
            *(u32x4*)(AB + row * DM + c0) = w; }
    }
}

constexpr int SM_K = 0, SM_V = 32768, SM_F = 81920, SM_WS = 83968;
template <int KIND  > __device__ __forceinline__ void sample_unit(Frame& F, int b, int s) {
    constexpr int DV = KIND == 0 ? 64 : 128, NDB = DV / 32, VSTR = KIND == 0 ? 192 : 320, VSUB = 16 * VSTR;
    const int lane = lane_id_opaque(), r32 = lane & 31, hi = lane >> 5, w = F.wave, tid = w * 64 + lane;
    const LAS char* lds = (const LAS char*)F.lds;
    LAS float* wsf = (LAS float*)(F.lds + SM_WS) + w * 64;
    const int hb = KIND == 0 ? w : (w >> 1);
    const LAS float* tab = (const LAS float*)(F.lds + AT_TAB) + hb * 192;
    const int q = r32 & 15, qpos = PAST + q;
    const size_t qrow = (size_t)SEQ + b * DEC_T + q;
    const bf16_t* Qp = (const bf16_t*)(F.ws + (KIND == 0 ? WS_QB : WS_QA)) + qrow * 512 + w * 64;
    bf16x8 qr[4];
#pragma unroll
    for (int d0 = 0; d0 < 4; ++d0) qr[d0] = *(const bf16x8*)(Qp + d0 * 16 + hi * 8);
    const float* Fs = (const float*)(F.ws + WS_FS) + (size_t)(b * 8 + w) * SKV;
    const float fq = KIND == 0 ? Fs[qpos] : 0.f;
    const float* Kc = F.in[KIND == 0 ? I_CFK : I_CDK] + (size_t)b * PAST * 512; const float* Vc = F.in[KIND == 0 ? I_CFV : I_CDV] + (size_t)b * PAST * 512;
    const float* Kn = F.out + (KIND == 0 ? O_FKS : O_DKS) + (size_t)b * DEC_T * 512; const float* Vn = F.out + (KIND == 0 ? O_FVS : O_DVS) + (size_t)b * DEC_T * 512;
    const int kr = tid >> 5, c16 = (tid & 31) * 16;
    const int ksub = c16 >> 6, kch = (c16 >> 3) & 7;
    const int kdst = SM_K + ksub * 4096 + kr * 128;
    const int vdst = KIND == 0 ? SM_V + ksub * VSUB + kr * VSTR + kch * 16 : SM_V + (c16 >> 7) * VSUB + kr * VSTR + ((c16 >> 3) & 15) * 16;
    f32x16 o[NDB];
#pragma unroll
    for (int d = 0; d < NDB; ++d) o[d] = f32x16{};
    float m_run = -1e30f, l_run = 0.f;
    f32x4 gkA[4], gvA[4], gkB[4], gvB[4]; float gfA = 0.f, gfB = 0.f;
    const int nt = s == 0 ? 17 : 16;
    auto gload = [&](f32x4 (&gk)[4], f32x4 (&gv)[4], float& gf, int t) {
        const float* ks; const float* vs;
        if (t < 128) { ks = Kc + (size_t)(16 * t + kr) * 512 + c16; vs = Vc + (size_t)(16 * t + kr) * 512 + c16; }
        else { ks = Kn + (size_t)kr * 512 + c16; vs = Vn + (size_t)kr * 512 + c16; }
#pragma unroll
        for (int j = 0; j < 4; ++j) { gk[j] = *(const f32x4*)(ks + 4 * j); gv[j] = *(const f32x4*)(vs + 4 * j); }
        if (KIND == 0 && tid < 128) gf = ((const float*)(F.ws + WS_FS))[(size_t)(b * 8 + (tid >> 4)) * SKV + 16 * t + (tid & 15)];
    };
    auto lwrite = [&](const f32x4 (&gk)[4], const f32x4 (&gv)[4], float gf) {
#pragma unroll
        for (int j = 0; j < 2; ++j) { u32x4 wk, wv;
            wk.x = pk2(gk[2 * j][0], gk[2 * j][1]); wk.y = pk2(gk[2 * j][2], gk[2 * j][3]); wk.z = pk2(gk[2 * j + 1][0], gk[2 * j + 1][1]); wk.w = pk2(gk[2 * j + 1][2], gk[2 * j + 1][3]);
            wv.x = pk2(gv[2 * j][0], gv[2 * j][1]); wv.y = pk2(gv[2 * j][2], gv[2 * j][3]); wv.z = pk2(gv[2 * j + 1][0], gv[2 * j + 1][1]); wv.w = pk2(gv[2 * j + 1][2], gv[2 * j + 1][3]);
            *(LAS u32x4*)(F.lds + kdst + (((kch + j) ^ (kr & 7)) << 4)) = wk;
            *(LAS u32x4*)(F.lds + vdst + j * 16) = wv; }
        if (KIND == 0 && tid < 128) ((LAS float*)(F.lds + SM_F))[tid] = gf;
    };
    gload(gkA, gvA, gfA, s); gload(gkB, gvB, gfB, s + 8);
    __syncthreads();
    { const int sub = tid >> 6, rr = 16 + ((tid >> 2) & 15), cq = (tid & 3) * 32;
      *(LAS u32x4*)(F.lds + SM_K + sub * 4096 + rr * 128 + cq) = (u32x4){0u, 0u, 0u, 0u}; *(LAS u32x4*)(F.lds + SM_K + sub * 4096 + rr * 128 + cq + 16) = (u32x4){0u, 0u, 0u, 0u}; }
    const int vb = SM_V + (KIND == 0 ? w : (w >> 1)) * VSUB + (4 * hi + ((lane & 15) >> 2)) * VSTR + (((lane >> 4) & 1) * 16 + (lane & 3) * 4) * 2;
    auto compute = [&](int t) {
        f32x16 p0 = f32x16{};
#pragma unroll
        for (int d0 = 0; d0 < 4; ++d0) { const bf16x8 kf = *(const LAS bf16x8*)(lds + SM_K + w * 4096 + r32 * 128 + (((2 * d0 + hi) ^ (r32 & 7)) << 4));
            p0 = __builtin_amdgcn_mfma_f32_32x32x16_bf16(kf, qr[d0], p0, 0, 0, 0); }
        const int kv0 = 16 * t + 4 * hi;
        float x[8];
        if (KIND == 0) {
#pragma unroll
            for (int g4 = 0; g4 < 2; ++g4) { const f32x4 fa = *(const LAS f32x4*)(lds + SM_F + (w * 16 + 4 * hi + 8 * g4) * 4);
#pragma unroll
                for (int e = 0; e < 4; ++e) x[4 * g4 + e] = p0[4 * g4 + e] + (fq - fa[e]); }
            if (t == 128) {
#pragma unroll
                for (int r = 0; r < 8; ++r) { const int kv = kv0 + (r & 3) + 8 * (r >> 2); if (kv > qpos) x[r] = -1e30f; } }
        } else {
            if (t < 120) {
#pragma unroll
                for (int r = 0; r < 8; ++r) x[r] = p0[r];
            } else {
#pragma unroll
                for (int r = 0; r < 8; ++r) { const int kv = kv0 + (r & 3) + 8 * (r >> 2); int i0 = kv - qpos + 128; i0 = i0 < 0 ? 0 : i0; x[r] = p0[r] + tab[i0]; } }
        }
        float rm = x[0];
#pragma unroll
        for (int r = 1; r < 8; ++r) rm = fmaxf(rm, x[r]);
        rm = fmaxf(rm, __shfl_xor(rm, 32));
        const float m_new = fmaxf(m_run, rm);
        if (__any(m_new > m_run)) { const float al = __builtin_amdgcn_exp2f(m_run - m_new); l_run *= al; m_run = m_new;
            if (hi == 0) wsf[r32] = al;
            asm volatile("s_waitcnt lgkmcnt(0)" ::: "memory");
#pragma unroll
            for (int g4 = 0; g4 < 2; ++g4) { const f32x4 a4 = *(const LAS f32x4*)(wsf + 8 * g4 + 4 * hi);
#pragma unroll
                for (int d = 0; d < NDB; ++d)
#pragma unroll
                    for (int e = 0; e < 4; ++e) o[d][4 * g4 + e] *= a4[e]; } }
        float rs = 0.f;
#pragma unroll
        for (int r = 0; r < 8; ++r) { x[r] = __builtin_amdgcn_exp2f(x[r] - m_run); rs += x[r]; }
        l_run += rs;
        u32x4 w0; w0.x = pg8::cvt_pk_bf16(x[0], x[1]); w0.y = pg8::cvt_pk_bf16(x[2], x[3]); w0.z = pg8::cvt_pk_bf16(x[4], x[5]); w0.w = pg8::cvt_pk_bf16(x[6], x[7]);
        const bf16x8 pa = __builtin_bit_cast(bf16x8, w0);
#pragma unroll
        for (int d = 0; d < NDB; ++d) { const LAS char* vp = lds + vb + d * 64;
            const s16x4 lo = vtr(vp), hi4 = vtr(vp + 8 * VSTR);
            const bf16x8 vf = (bf16x8){lo[0], lo[1], lo[2], lo[3], hi4[0], hi4[1], hi4[2], hi4[3]};
            o[d] = __builtin_amdgcn_mfma_f32_32x32x16_bf16(pa, vf, o[d], 0, 0, 0); }
    };
    for (int i = 0; i < nt; i += 2) {
        const int t = s + 8 * i;
        lwrite(gkA, gvA, gfA); __syncthreads();
        if (i + 2 < nt) gload(gkA, gvA, gfA, t + 16);
        compute(t);
        __syncthreads();
        if (i + 1 >= nt) break;
        lwrite(gkB, gvB, gfB); __syncthreads();
        if (i + 3 < nt) gload(gkB, gvB, gfB, t + 24);
        compute(t + 8);
        __syncthreads();
    }
    l_run += __shfl_xor(l_run, 32);
    float* P = (float*)(F.ws + (KIND == 0 ? WS_PF : WS_PD)) + ((size_t)((b * 8 + s) * 8 + w) * 16) * (DV + 2);
    { float* P0 = P + (size_t)(4 * hi) * (DV + 2) + r32; float* P1 = P0 + 8 * (DV + 2);
#pragma unroll
      for (int d = 0; d < NDB; ++d)
#pragma unroll
          for (int r = 0; r < 4; ++r) { P0[r * (DV + 2) + 32 * d] = o[d][r]; P1[r * (DV + 2) + 32 * d] = o[d][4 + r]; } }
    if (lane < 16) { P[(size_t)lane * (DV + 2) + DV] = m_run; P[(size_t)lane * (DV + 2) + DV + 1] = l_run; }
}

__device__ __forceinline__ void z_reduce(Frame& F) {
    const float* slab = (const float*)(F.ws + WS_ZSL);
    for (int r = F.bid; r < NSMP; r += F.G) {
        for (int ch = F.tid; ch < NZ / 8; ch += 512) {
            const int col = ch * 8; f32x4 a0 = {0.f, 0.f, 0.f, 0.f}, a1 = {0.f, 0.f, 0.f, 0.f};
#pragma unroll
            for (int sl = 0; sl < 4; ++sl) { const float* p = slab + ((size_t)sl * NSMP + r) * NZ + col; a0 += *(const f32x4*)p; a1 += *(const f32x4*)(p + 4); }
            const size_t row = (size_t)SEQ + r;
            if (col < 3072) {
                const int seg = col >> 9, cs = col & 511; const bool isq = (seg == 0 || seg == 3); const float sc = isq ? C2 : 1.0f;
                if (!isq) { const int kk = seg - 1 - (seg > 3 ? 1 : 0); float* ob = F.out + O_DKS + (size_t)kk * NSMP * 512 + (size_t)r * 512 + cs; *(f32x4*)ob = a0; *(f32x4*)(ob + 4) = a1; }
                u32x4 w; w.x = pg8::cvt_pk_bf16(a0[0] * sc, a0[1] * sc); w.y = pg8::cvt_pk_bf16(a0[2] * sc, a0[3] * sc); w.z = pg8::cvt_pk_bf16(a1[0] * sc, a1[1] * sc); w.w = pg8::cvt_pk_bf16(a1[2] * sc, a1[3] * sc);
                *(u32x4*)((bf16_t*)(F.ws + WS_QA + (size_t)seg * (WS_KA - WS_QA)) + row * 512 + cs) = w;
            } else {
                u32x4 w; w.x = pg8::cvt_pk_bf16(sigmoidf_(a0[0]), sigmoidf_(a0[1])); w.y = pg8::cvt_pk_bf16(sigmoidf_(a0[2]), sigmoidf_(a0[3]));
                w.z = pg8::cvt_pk_bf16(sigmoidf_(a1[0]), sigmoidf_(a1[1])); w.w = pg8::cvt_pk_bf16(sigmoidf_(a1[2]), sigmoidf_(a1[3]));
                *(u32x4*)((bf16_t*)(F.ws + WS_G) + row * 2048 + (col - 3072)) = w;
            }
        }
    }
    asm volatile("s_waitcnt vmcnt(0)" ::: "memory");
    __syncthreads();
    if (F.tid == 0) { __builtin_amdgcn_fence(__ATOMIC_RELEASE, "agent"); asm volatile("s_waitcnt vmcnt(0)" ::: "memory");
        __hip_atomic_fetch_add((unsigned*)(F.ws + WS_CTL) + 321, 1u, __ATOMIC_RELAXED, __HIP_MEMORY_SCOPE_AGENT); }
}
__device__ __forceinline__ void z_wait(Frame& F) {
    if (F.tid == 0) { unsigned* w = (unsigned*)(F.ws + WS_CTL) + 321; unsigned sp = 0;
        while (__hip_atomic_load(w, __ATOMIC_RELAXED, __HIP_MEMORY_SCOPE_AGENT) < (unsigned)F.G && ++sp < (1u << 22)) __builtin_amdgcn_s_sleep(2);
        __builtin_amdgcn_fence(__ATOMIC_ACQUIRE, "agent"); asm volatile("s_waitcnt vmcnt(0)" ::: "memory"); }
    __syncthreads();
}

template <int pv = 0> __device__ __forceinline__ void p3_attention(Frame& F, int mask) {
    z_reduce(F);
    LAS float* tab = (LAS float*)(F.lds + AT_TAB);
    for (int i = F.tid; i < 4 * 192; i += 512) { const int h = i / 192, rel = (i % 192) - 128; tab[i] = (F.in[I_RELB][t5_bucket(rel) * 4 + h] - F.in[I_RELB][15 * 4 + h]) * LOG2E; }
    const float lam = lambda_full(F);
    __syncthreads();
    const int x = F.bid & 7, p = (F.bid >> 3) & 31;
    const int spos = F.G == 256 ? (x + p) % 5 : 4;
    for (int j = 0; j < 5; ++j) {
        F.lane = lane_id_opaque(); F.tid = F.wave * 64 + F.lane;
        if (j == spos) {
            if (mask & 4) {
                z_wait(F);
                for (int u = F.bid; u < 256; u += F.G) {
                    F.lane = lane_id_opaque(); F.tid = F.wave * 64 + F.lane;
                    if ((u >> 3) & 1) sample_unit<1>(F, u >> 4, u & 7); else sample_unit<0>(F, u >> 4, u & 7);
                }
            }
        } else if (F.bid < 256) {
            const int i = j - (j > spos ? 1 : 0);
            const int qb = (i & 1) ? p : 63 - p;
            if (i < 2) { if (mask & 1) attn_prompt_diff_half<pv>(F, x >> 1, x & 1, qb); }
            else { if (mask & 2) attn_prompt_fox<pv>(F, x, qb); }
        }
    }
}

#define XB_TMO      128
#define XB_XCNT(j)  (256  + 64 * (j))
#define XB_XSUB(j)  (1280 + 64 * (j))
#define XB_XGEN(j)  (2304 + 64 * (j))
#define XB_TOP      3328
#define XB_TOPGEN   3392
#define XCD_BAR_WORDS 3456
#define XB_SPIN_CAP (1u << 20)
__device__ __forceinline__ unsigned xb_ld(unsigned* p)              { return __hip_atomic_load(p, __ATOMIC_RELAXED, __HIP_MEMORY_SCOPE_AGENT); }
__device__ __forceinline__ unsigned xb_add(unsigned* p, unsigned v) { return __hip_atomic_fetch_add(p, v, __ATOMIC_RELAXED, __HIP_MEMORY_SCOPE_AGENT); }
__device__ __forceinline__ unsigned xb_xcc_id() { return (unsigned)__builtin_amdgcn_s_getreg((3 << 11) | 20) & 0xFu; }
#define XB_SPIN(cond, bar) do { unsigned _sp = 0; while (cond) { __builtin_amdgcn_s_sleep(1); \
    if ((++_sp & 255u) == 0u) { if (xb_ld(&(bar)[XB_TMO])) break; if (_sp > XB_SPIN_CAP) { atomicAdd(&(bar)[XB_TMO], 1u); break; } } } } while (0)
struct XcdBarrier { unsigned* bar; unsigned x; volatile LAS unsigned* st; };
__device__ __forceinline__ XcdBarrier xcd_barrier_post(unsigned* bar, volatile LAS unsigned* st) {
    XcdBarrier b; b.bar = bar; b.x = xb_xcc_id(); b.st = st;
    if (threadIdx.x == 0) (void)xb_add(&bar[XB_XCNT(b.x)], 1u);
    return b;
}
__device__ __forceinline__ void xcd_barrier_complete(unsigned* bar, unsigned x, unsigned& nloc, unsigned& nx) {
    const unsigned G = gridDim.x * gridDim.y * gridDim.z;
    unsigned sum, cnt, mine, sp = 0u;
    for (;;) {
        sum = 0u; cnt = 0u; mine = 0u;
#pragma unroll
        for (unsigned j = 0; j < 16; ++j) { const unsigned c = xb_ld(&bar[XB_XCNT(j)]); sum += c; cnt += (c > 0u) ? 1u : 0u; mine = (j == x) ? c : mine; }
        if (sum == G) break;
        __builtin_amdgcn_s_sleep(1);
        if ((++sp & 255u) == 0u) { if (xb_ld(&bar[XB_TMO])) break; if (sp > XB_SPIN_CAP) { atomicAdd(&bar[XB_TMO], 1u); break; } }
    }
    nloc = mine > 0u ? mine : 1u; nx = cnt > 0u ? cnt : 1u;
}
__device__ __forceinline__ void xcd_barrier(const XcdBarrier& b) {
    asm volatile("s_waitcnt vmcnt(0)" ::: "memory");
    __syncthreads();
    if (threadIdx.x == 0) {
        unsigned* bar = b.bar;
        __builtin_amdgcn_s_waitcnt(0);
        unsigned nloc = b.st[0], nx = b.st[1];
        if (nloc == 0u) { xcd_barrier_complete(bar, b.x, nloc, nx); b.st[0] = nloc; b.st[1] = nx; }
        const unsigned old = xb_add(&bar[XB_XSUB(b.x)], 1u);
        const unsigned gen = old / nloc;
        if (old + 1u == (gen + 1u) * nloc) {
            __builtin_amdgcn_fence(__ATOMIC_RELEASE, "agent");
            asm volatile("s_waitcnt vmcnt(0)" ::: "memory");
            const unsigned og = xb_add(&bar[XB_TOP], 1u);
            const unsigned tg = og / nx;
            if (og + 1u == (tg + 1u) * nx) xb_add(&bar[XB_TOPGEN], 1u);
            else XB_SPIN(xb_ld(&bar[XB_TOPGEN]) == tg, bar);
            __builtin_amdgcn_fence(__ATOMIC_ACQUIRE, "agent");
            xb_add(&bar[XB_XGEN(b.x)], 1u);
            asm volatile("s_waitcnt vmcnt(0)" ::: "memory");
        } else {
            XB_SPIN(xb_ld(&bar[XB_XGEN(b.x)]) == gen, bar);
            __builtin_amdgcn_fence(__ATOMIC_ACQUIRE, "agent");
            asm volatile("s_waitcnt vmcnt(0)" ::: "memory");
        }
    }
    __syncthreads();
}

__global__ void __launch_bounds__(512, 2) mega_fwd(Args args) {
    extern __shared__ __attribute__((aligned(16))) unsigned char lds_raw[];
    Frame F;
    F.lds = (LAS unsigned char*)lds_raw; F.ldsg = lds_raw;
    F.tid = threadIdx.x; F.lane = F.tid & 63; F.wave = __builtin_amdgcn_readfirstlane(F.tid >> 6);
    F.G = gridDim.x; F.bid = blockIdx.x;
    F.in = args.in; F.out = args.out; F.ws = args.ws;
    const int lo = args.ph_lo, hi = args.ph_hi;
    cg::grid_group grid = cg::this_grid();
    const bool fused = (hi - lo) > 1;
    volatile LAS unsigned* bst = (volatile LAS unsigned*)(F.lds + AT_MISC + 16);
    if (F.tid == 0) { bst[0] = 0u; bst[1] = 0u; }
    __syncthreads();
    XcdBarrier xbar; xbar.bar = (unsigned*)(F.ws + WS_CTL) + 1024; xbar.x = 0; xbar.st = bst;
    if (fused) xbar = xcd_barrier_post((unsigned*)(F.ws + WS_CTL) + 1024, bst);
#define IN(k) (lo <= (k) && (k) < hi)
#define PB() do { F.lane = lane_id_opaque(); F.tid = F.wave * 64 + F.lane; } while (0)
#define SEAM(k) do { if (IN(k) && IN((k) + 1)) { xcd_barrier(xbar); } } while (0)
    const float* mod = (const float*)(F.ws + WS_MOD);
    if (IN(0)) { PB(); p0_prologue(F); }
    if (IN(0) && IN(1)) __syncthreads(); else SEAM(0);
    if (IN(1)) { PB(); p1_rows(F, IN(0)); } SEAM(1);
    if (IN(2)) { PB();
        p2_cumsum(F);
        __syncthreads();
        pg8::Gemm g{(const bf16_t*)(F.ws + WS_XN), (const bf16_t*)(F.ws + WS_WIN), 1024, 1024, 1024, 1 << 30, 0, 0};
        pg8::StaticOrder S; S.init(SEQ / 256, NZ / 256, F.G, F.bid, 0);
        EpiZ E{F.out, F.ws};
        pg8::gemm_phase<EpiZ, pg8::StaticOrder>(F.lds, g, S, E, F.wave);
        { pg8::Gemm g2{(const bf16_t*)(F.ws + WS_XN), (const bf16_t*)(F.ws + WS_WIN), 1024, 1024, 256, 1 << 30, 0, 256};
          pg8::SplitOrder S2; S2.init(NZ / 256, 4, F.G, F.G - 1 - F.bid, SEQ / 256); EpiSlab E2{(float*)(F.ws + WS_ZSL), NZ};
          pg8::gemm_phase<EpiSlab, pg8::SplitOrder>(F.lds, g2, S2, E2, F.wave); }
#if PROBE_DUP == 2
        pg8::gemm_phase<EpiZ, pg8::StaticOrder>(F.lds, g, S, E, F.wave);
#endif
    } SEAM(2);
    if (IN(3)) { PB(); p3_attention(F, 7);
#if PROBE_DUP == 3
        p3_attention<PROBE_PV>(F, PROBE_MASK);
#endif
    } SEAM(3);
    if (IN(10)) { PB(); p_combine(F);
#if PROBE_DUP == 10
        p_combine(F);
#endif
    } if (IN(10) && IN(4)) xcd_barrier(xbar);
    if (IN(4)) { PB();
        pg8::Gemm g{(const bf16_t*)(F.ws + WS_AB), (const bf16_t*)(F.ws + WS_WAB), 1024, 512, 512, 4, 512, 0};
        pg8::StaticOrder S; S.init(MT / 256, 8, F.G, F.bid, 0);
        EpiGate E{(bf16_t*)(F.ws + WS_G), (bf16_t*)(F.ws + WS_G)};
#if PROBE_DUP == 4
        { EpiGate E2{(bf16_t*)(F.ws + WS_G), (bf16_t*)(F.ws + WS_QA)}; pg8::gemm_phase<EpiGate, pg8::StaticOrder>(F.lds, g, S, E2, F.wave); }
#endif
        pg8::gemm_phase<EpiGate, pg8::StaticOrder>(F.lds, g, S, E, F.wave);
    } SEAM(4);
    if (IN(5)) { PB();
        { pg8::Gemm g2{(const bf16_t*)(F.ws + WS_G), (const bf16_t*)(F.ws + WS_WO2), 2048, 2048, 256, 1 << 30, 0, 256};
          pg8::SplitOrder S2; S2.init(4, 8, F.G, F.bid, SEQ / 256); EpiSlab E2{(float*)(F.ws + WS_SLAB), DM};
          pg8::gemm_phase<EpiSlab, pg8::SplitOrder>(F.lds, g2, S2, E2, F.wave); }
        pg8::Gemm g{(const bf16_t*)(F.ws + WS_G), (const bf16_t*)(F.ws + WS_WO2), 2048, 2048, 2048, 1 << 30, 0, 0};
        pg8::StaticOrder S; S.init(SEQ / 256, 4, F.G, F.bid, 0);
        EpiRes<false> E{(const void*)F.in[I_XP], (bf16_t*)(F.ws + WS_TB), mod + 2048};
        pg8::gemm_phase<EpiRes<false>, pg8::StaticOrder>(F.lds, g, S, E, F.wave);
    } SEAM(5);
    if (IN(6)) { PB(); ln_rows<false>(F, F.in[I_LN1G], F.in[I_LN1B], 8, 2048);
#if PROBE_DUP == 6
        ln_rows<false>(F, F.in[I_LN1G], F.in[I_LN1B], 8, 2048);
#endif
    } SEAM(6);
    if (IN(7)) { PB();
        pg8::Gemm g{(const bf16_t*)(F.ws + WS_XN), (const bf16_t*)(F.ws + WS_WFI), 1024, 1024, 1024, 1 << 30, 0, 0};
        pg8::StaticOrder S; S.init(MT / 256, NFF2 / 256, F.G, F.bid, 0);
        EpiFfn E{(bf16_t*)(F.ws + WS_ACT)};
        pg8::gemm_phase<EpiFfn, pg8::StaticOrder>(F.lds, g, S, E, F.wave);
#if PROBE_DUP == 7
        pg8::gemm_phase<EpiFfn, pg8::StaticOrder>(F.lds, g, S, E, F.wave);
#endif
    } SEAM(7);
    if (IN(8)) { PB();
        { pg8::Gemm g2{(const bf16_t*)(F.ws + WS_ACT), (const bf16_t*)(F.ws + WS_WFO), DFF, DFF, 256, 1 << 30, 0, 256};
          pg8::SplitOrder S2; S2.init(4, 11, F.G, F.bid, SEQ / 256); EpiSlab E2{(float*)(F.ws + WS_SLAB), DM};
          pg8::gemm_phase<EpiSlab, pg8::SplitOrder>(F.lds, g2, S2, E2, F.wave); }
        pg8::Gemm g{(const bf16_t*)(F.ws + WS_ACT), (const bf16_t*)(F.ws + WS_WFO), DFF, DFF, DFF, 1 << 30, 0, 0};
        pg8::StaticOrder S; S.init(SEQ / 256, 4, F.G, F.bid, 0);
        EpiRes<true> E{(const void*)(F.ws + WS_X1B), (bf16_t*)(F.ws + WS_TB), mod + 5120};
        pg8::gemm_phase<EpiRes<true>, pg8::StaticOrder>(F.lds, g, S, E, F.wave);
    } SEAM(8);
    if (IN(9)) { PB(); ln_rows<true>(F, F.in[I_LN2G], F.in[I_LN2B], 11, 5120);
#if PROBE_DUP == 9
        ln_rows<true>(F, F.in[I_LN2G], F.in[I_LN2B], 11, 5120);
#endif
    }
#undef IN
#undef SEAM
}

extern "C" void kernel_launch(void* const* d_in, const int* in_sizes, int n_in, void* d_out, int out_size, void* d_ws, size_t ws_size, hipStream_t stream) {
    static int grid = 0;
    if (grid == 0) {
        if (n_in != 28 || (size_t)out_size != O_END || ws_size < WS_END) { fprintf(stderr, "kernel_launch: unexpected shapes (n_in %d out %d ws %zu)\n", n_in, out_size, ws_size); grid = -1; return; }
        int dev = 0, cus = 0, per_cu = 0;
        hipGetDevice(&dev); hipDeviceGetAttribute(&cus, hipDeviceAttributeMultiprocessorCount, dev);
        hipFuncSetAttribute((const void*)mega_fwd, hipFuncAttributeMaxDynamicSharedMemorySize, LDS_BYTES);
        hipOccupancyMaxActiveBlocksPerMultiprocessor(&per_cu, (const void*)mega_fwd, 512, LDS_BYTES);
        if (per_cu < 1) { fprintf(stderr, "kernel_launch: occupancy query says %d blocks per CU\n", per_cu); per_cu = 1; }
        (void)hipGetLastError();
        grid = cus;
    }
    if (grid < 0) return;
    hipMemsetAsync((char*)d_ws + WS_CTL, 0, CTL_BYTES, stream);
    Args a{};
    for (int i = 0; i < 28; ++i) a.in[i] = (const float*)d_in[i];
    a.out = (float*)d_out; a.ws = (unsigned char*)d_ws;
#if MK_N_LAUNCHES == 1
    a.ph_lo = 0; a.ph_hi = NPH;
    void* kargs[] = {&a};
    hipError_t e = hipLaunchCooperativeKernel((const void*)mega_fwd, dim3(grid), dim3(512), kargs, LDS_BYTES, stream);
    if (e != hipSuccess) fprintf(stderr, "cooperative launch failed: %s\n", hipGetErrorString(e));
#else
    { const int seq[NPH] = {0, 1, 2, 3, 10, 4, 5, 6, 7, 8, 9}; for (int i = 0; i < NPH; ++i) { a.ph_lo = seq[i]; a.ph_hi = seq[i] + 1; hipLaunchKernelGGL(mega_fwd, dim3(grid), dim3(512), LDS_BYTES, stream, a); } }
#endif
}
```

```cpp
#include <hip/hip_runtime.h>
#include <hip/hip_cooperative_groups.h>
#include <cstdint>
#include <cstdio>
namespace cg = cooperative_groups;

#ifndef PROBE_DUP
#define PROBE_DUP -1
#endif
#ifndef PROBE_PV
#define PROBE_PV 0
#endif
#ifndef PROBE_MASK
#define PROBE_MASK 7
#endif
#ifndef MK_N_LAUNCHES
#define MK_N_LAUNCHES 1
#endif

#define LAS __attribute__((address_space(3)))
typedef unsigned short bf16_t;
typedef short bf16x8 __attribute__((ext_vector_type(8)));
typedef short s16x4 __attribute__((ext_vector_type(4)));
typedef float f32x4 __attribute__((ext_vector_type(4)));
typedef float f32x2 __attribute__((ext_vector_type(2)));
typedef float f32x16 __attribute__((ext_vector_type(16)));
typedef unsigned u32x4 __attribute__((ext_vector_type(4)));
typedef unsigned u32x2 __attribute__((ext_vector_type(2)));

constexpr int DM = 1024, SEQ = 16384, DEC_B = 16, DEC_T = 16, NSMP = DEC_B * DEC_T, MT = SEQ + NSMP, PAST = 2048, SKV = PAST + DEC_T;
constexpr int NZ = 5120, DFF = 2816, NFF2 = 2 * DFF, WIN_COLS = 5128;
constexpr float LOG2E = 1.4426950408889634f, C2 = 0.125f * LOG2E, ALPHA = 1.189207115002721f, LN_EPS = 1e-5f;
constexpr int NPH = 11;

constexpr size_t O_Y = 0, O_DKP = (size_t)MT * DM, O_DVP = O_DKP + (size_t)SEQ * 512, O_FKP = O_DVP + (size_t)SEQ * 512, O_FVP = O_FKP + (size_t)SEQ * 512,
                 O_FLP = O_FVP + (size_t)SEQ * 512, O_DKS = O_FLP + (size_t)SEQ * 8, O_DVS = O_DKS + (size_t)NSMP * 512, O_FKS = O_DVS + (size_t)NSMP * 512,
                 O_FVS = O_FKS + (size_t)NSMP * 512, O_FLS = O_FVS + (size_t)NSMP * 512, O_END = O_FLS + (size_t)NSMP * 8;

constexpr size_t MiB = 1u << 20;
constexpr size_t WS_CTL = 0, CTL_BYTES = 64 * 1024;
constexpr size_t WS_MOD = 1 * MiB;
constexpr size_t WS_FP = 2 * MiB;
constexpr size_t WS_FS = 3 * MiB;
constexpr size_t WS_WIN = 8 * MiB;
constexpr size_t WS_WAB = 18 * MiB;
constexpr size_t WS_WO2 = 20 * MiB;
constexpr size_t WS_WFI = 24 * MiB;
constexpr size_t WS_WFO = 35 * MiB;
constexpr size_t WS_XN = 48 * MiB;
constexpr size_t WS_QA = 84 * MiB, WS_KA = 101 * MiB, WS_VA = 118 * MiB, WS_QB = 135 * MiB, WS_KB = 152 * MiB, WS_VB = 169 * MiB;
constexpr size_t WS_ACT = 84 * MiB;
constexpr size_t WS_G = 188 * MiB;
constexpr size_t WS_AB = 254 * MiB;
constexpr size_t WS_OD1 = WS_XN, WS_OD2 = 288 * MiB;
constexpr size_t WS_PF = 304 * MiB, WS_PD = 309 * MiB;
constexpr size_t WS_TB = WS_AB;
constexpr size_t WS_X1B = WS_AB;
constexpr size_t WS_XB1 = 5 * MiB, WS_XB2 = 6 * MiB;
constexpr int CTL_LN1 = 8192, CTL_LN2 = 12288;
constexpr int LN_LDS = 135168;
constexpr size_t WS_SLAB = 288 * MiB;
constexpr size_t WS_END = 320 * MiB;

constexpr int LDS_BYTES = 147456;

struct Args { const float* in[28]; float* out; unsigned char* ws; int ph_lo, ph_hi; };

__device__ __forceinline__ int lane_id_opaque() { int l = (int)__builtin_amdgcn_mbcnt_hi(~0u, __builtin_amdgcn_mbcnt_lo(~0u, 0u)); asm volatile("" : "+v"(l)); return l; }
__device__ __forceinline__ unsigned f2bf(float f) { unsigned u = __builtin_bit_cast(unsigned, f); return (u + 0x7fffu + ((u >> 16) & 1u)) >> 16; }
__device__ __forceinline__ unsigned pk2(float lo, float hi) { return f2bf(lo) | (f2bf(hi) << 16); }
__device__ __forceinline__ float bf2f(unsigned short b) { return __builtin_bit_cast(float, (unsigned)b << 16); }
__device__ __forceinline__ float bflo(unsigned w) { return __builtin_bit_cast(float, w << 16); }
__device__ __forceinline__ float bfhi(unsigned w) { return __builtin_bit_cast(float, w & 0xffff0000u); }
__device__ __forceinline__ float wave_sum(float v) {
#pragma unroll
    for (int o = 1; o < 64; o <<= 1) v += __shfl_xor(v, o);
    return v;
}
__device__ __forceinline__ float sigmoidf_(float x) { return 1.0f / (1.0f + __expf(-x)); }
__device__ __forceinline__ float siluf_(float x) { return x / (1.0f + __expf(-x)); }

namespace pg8 {
constexpr int BM = 256, BK = 64, HALF = 128, HTB = HALF * BK * 2, STAGE_BYTES = 8 * HTB, NXCD = 8, WGM = 8;
__host__ __device__ __forceinline__ int lds_byte(int r, int c) { const int st = (r >> 4) * 2 + (c >> 5), rr = r & 15, cc = c & 31, ob = rr * 64 + cc * 2; return st * 1024 + (ob ^ (((ob >> 9) & 1) << 5)); }
__host__ __device__ __forceinline__ void stage_rc(int b, int& R, int& C) { const int st = b / 1024, sb = b % 1024, swz = sb ^ (((sb >> 9) & 1) << 5); R = (st >> 1) * 16 + swz / 64; C = (st & 1) * 32 + (swz % 64) / 2; }
__host__ __device__ __forceinline__ int perm32(int rho) { const int n = rho >> 4, i = rho & 15; return 8 * (i >> 2) + 4 * n + (i & 3); }

struct Unit { int pm, pn, ks; };
struct Gemm { const bf16_t* A; const bf16_t* Bt; int lda, ldb, K, a_split_pn, a_split_off, kpart; };

struct StaticOrder {
    int nM, nN, nwg, G, c, pm0;
    __device__ void init(int nM_, int nN_, int G_, int c_, int pm0_) { nM = nM_; nN = nN_; nwg = nM * nN; G = G_; c = c_; pm0 = pm0_; }
    __device__ bool next(int i, Unit& u) const {
        const long L = (long)i * G + c; if (L >= nwg) return false;
        int wgid = (int)L; { const int q = nwg / NXCD, r = nwg % NXCD, xcd = wgid % NXCD, off = wgid / NXCD; wgid = (xcd < r ? xcd * (q + 1) : r * (q + 1) + (xcd - r) * q) + off; }
        const int nig = WGM * nN, gid = wgid / nig, fm = gid * WGM, gsz = (nM - fm) < WGM ? (nM - fm) : WGM;
        u.pm = pm0 + fm + ((wgid % nig) % gsz); u.pn = (wgid % nig) / gsz; u.ks = 0; return true;
    }
};

struct SplitOrder {
    int nN, nun, G, c, pm;
    __device__ void init(int nN_, int KS_, int G_, int c_, int pm_) { nN = nN_; nun = nN_ * KS_; G = G_; c = c_; pm = pm_; }
    __device__ bool next(int i, Unit& u) const { const long L = (long)i * G + c; if (L >= nun) return false; u.pm = pm; u.pn = (int)L % nN; u.ks = (int)L / nN; return true; }
};

__device__ __forceinline__ unsigned cvt_pk_bf16(float lo, float hi) { unsigned r; asm volatile("v_cvt_pk_bf16_f32 %0, %1, %2" : "=v"(r) : "v"(lo), "v"(hi)); return r; }

template <class Epi, class Sched, bool ALIGN_EPI = true, bool SP2 = true>
__device__ __forceinline__ void gemm_phase(LAS unsigned char* lds, const Gemm g, const Sched& S, const Epi& E, int wid  ) {
    const int lane = lane_id_opaque(), tid = wid * 64 + lane, wr = wid >> 2, wc = wid & 3; int fr = lane & 15, fq = lane >> 4;
    const int K = g.K, nt = K / BK;
    unsigned voffA[2], voffB[2];
#pragma unroll
    for (int i = 0; i < 2; ++i) { int R, C; stage_rc(tid * 16 + i * 8192, R, C); const int Rb = Epi::PERM ? ((R & ~31) + perm32(R & 31)) : R;
        voffA[i] = (unsigned)(R * g.lda + C) * 2u; voffB[i] = (unsigned)(Rb * g.ldb + C) * 2u; }
    const size_t kstep = (size_t)(BK * 2);
    const size_t hstepA = (size_t)HALF * g.lda * 2, hstepB = (size_t)HALF * g.ldb * 2;
    const size_t tstepA = 2 * hstepA, tstepB = 2 * hstepB;
    const unsigned ldsw = (unsigned)wid * 1024u;
    const int aoff = lds_byte(wr * 64 + fr, fq * 8), boff = lds_byte(wc * 32 + fr, fq * 8);
#define PG8_SA(b, h) (((b) * 2 + (h)) * HTB)
#define PG8_SB(b, h) ((4 + (b) * 2 + (h)) * HTB)
#define PG8_STAGE(bufoff, gbase, voff) do { _Pragma("unroll") for (int _i = 0; _i < 2; ++_i) \
        __builtin_amdgcn_global_load_lds((const unsigned*)((const char*)(gbase) + (voff)[_i]), (LAS unsigned*)(lds + (bufoff) + ldsw + _i * 8192), 16, 0, 0); } while (0)
#define PG8_LDA(dst, b, h) do { _Pragma("unroll") for (int m = 0; m < 4; ++m) _Pragma("unroll") for (int k = 0; k < 2; ++k) dst[m][k] = *(const LAS bf16x8*)(lds + PG8_SA(b, h) + aoff + m * 2048 + k * 1024); } while (0)
#define PG8_LDB(dst, b, h) do { _Pragma("unroll") for (int n = 0; n < 2; ++n) _Pragma("unroll") for (int k = 0; k < 2; ++k) dst[n][k] = *(const LAS bf16x8*)(lds + PG8_SB(b, h) + boff + n * 2048 + k * 1024); } while (0)
#define PG8_MMA(ai, bj, At, Bt) do { __builtin_amdgcn_s_setprio(1); _Pragma("unroll") for (int m = 0; m < 4; ++m) _Pragma("unroll") for (int n = 0; n < 2; ++n) _Pragma("unroll") for (int k = 0; k < 2; ++k) \
        acc[ai][bj][m][n] = __builtin_amdgcn_mfma_f32_16x16x32_bf16(Bt[n][k], At[m][k], acc[ai][bj][m][n], 0, 0, 0); __builtin_amdgcn_s_setprio(0); } while (0)
#define PG8_WAIT_V(n) asm volatile("s_waitcnt vmcnt(" #n ")" ::: "memory")
#define PG8_WAIT_L(n) asm volatile("s_waitcnt lgkmcnt(" #n ")" ::: "memory")
#define PG8_BAR __builtin_amdgcn_s_barrier()
#define PG8_SCHED __builtin_amdgcn_sched_barrier(0)
#define PG8_ABASE(u) ((const char*)g.A + (size_t)(u).pm * tstepA + ((u).pn >= g.a_split_pn ? (size_t)g.a_split_off * 2 : (size_t)0) + (size_t)(u).ks * g.kpart * 2)
#define PG8_BBASE(u) ((const char*)g.Bt + (size_t)(u).pn * tstepB + (size_t)(u).ks * g.kpart * 2)
    Unit cur, nxt; int ui = 0;
    if (!S.next(0, cur)) return;
    f32x4 acc[2][2][4][2];
#pragma unroll
    for (int a = 0; a < 2; ++a)
#pragma unroll
        for (int b = 0; b < 2; ++b)
#pragma unroll
            for (int m = 0; m < 4; ++m)
#pragma unroll
                for (int n = 0; n < 2; ++n) acc[a][b][m][n] = (f32x4){0.f, 0.f, 0.f, 0.f};
    bf16x8 At[4][2], B0[2][2], B1[2][2];
    const char* cA = PG8_ABASE(cur); const char* cB = PG8_BBASE(cur);
    if constexpr (SP2) {
        PG8_STAGE(PG8_SB(0, 0), cB, voffB); PG8_STAGE(PG8_SB(0, 1), cB + hstepB, voffB); PG8_STAGE(PG8_SA(0, 0), cA, voffA); PG8_STAGE(PG8_SA(0, 1), cA + hstepA, voffA);
        if (wr == 1) PG8_BAR;
        PG8_WAIT_V(2); PG8_BAR;
        PG8_STAGE(PG8_SB(1, 0), cB + kstep, voffB); PG8_STAGE(PG8_SA(1, 0), cA + kstep, voffA); PG8_STAGE(PG8_SB(1, 1), cB + hstepB + kstep, voffB);
        PG8_WAIT_V(6); PG8_BAR;
    } else {
        PG8_STAGE(PG8_SB(0, 0), cB, voffB); PG8_STAGE(PG8_SA(0, 0), cA, voffA); PG8_STAGE(PG8_SB(0, 1), cB + hstepB, voffB); PG8_STAGE(PG8_SA(0, 1), cA + hstepA, voffA);
        if (wr == 1) PG8_BAR;
        PG8_WAIT_V(4); PG8_BAR;
        PG8_STAGE(PG8_SB(1, 0), cB + kstep, voffB); PG8_STAGE(PG8_SA(1, 0), cA + kstep, voffA); PG8_STAGE(PG8_SB(1, 1), cB + hstepB + kstep, voffB);
        PG8_WAIT_V(6); PG8_BAR;
    }
    for (;;) {
        const bool has_next = S.next(ui + 1, nxt);
        const char* nA = has_next ? PG8_ABASE(nxt) : cA; const char* nB = has_next ? PG8_BBASE(nxt) : cB;
        for (int t = 0; t < nt; t += 2) {
            const bool last = (t == nt - 2);
            const char* a1 = cA + (size_t)(t + 1) * kstep;
            const char* a2 = last ? nA : cA + (size_t)(t + 2) * kstep; const char* b2 = last ? nB : cB + (size_t)(t + 2) * kstep;
            const char* a3 = a2 + kstep; const char* b3 = b2 + kstep;
            if constexpr (SP2) {
            PG8_LDB(B0, 0, 0); PG8_LDB(B1, 0, 1); PG8_SCHED; PG8_LDA(At, 0, 0); PG8_STAGE(PG8_SA(1, 1), a1 + hstepA, voffA);
            PG8_WAIT_V(8); PG8_WAIT_L(0); PG8_BAR; PG8_MMA(0, 0, At, B0); PG8_MMA(0, 1, At, B1); PG8_BAR; PG8_SCHED;
            PG8_LDA(At, 0, 1); PG8_STAGE(PG8_SB(0, 0), b2, voffB); PG8_STAGE(PG8_SB(0, 1), b2 + hstepB, voffB); PG8_STAGE(PG8_SA(0, 0), a2, voffA);
            PG8_WAIT_V(8); PG8_WAIT_L(0); PG8_BAR; PG8_MMA(1, 0, At, B0); PG8_MMA(1, 1, At, B1); PG8_BAR; PG8_SCHED;
            PG8_LDB(B0, 1, 0); PG8_LDB(B1, 1, 1); PG8_SCHED; PG8_LDA(At, 1, 0); PG8_STAGE(PG8_SA(0, 1), a2 + hstepA, voffA);
            PG8_WAIT_V(8); PG8_WAIT_L(0); PG8_BAR; PG8_MMA(0, 0, At, B0); PG8_MMA(0, 1, At, B1); PG8_BAR; PG8_SCHED;
            PG8_LDA(At, 1, 1); PG8_STAGE(PG8_SB(1, 0), b3, voffB); PG8_STAGE(PG8_SB(1, 1), b3 + hstepB, voffB); PG8_STAGE(PG8_SA(1, 0), a3, voffA);
            PG8_WAIT_V(8); PG8_WAIT_L(0); PG8_BAR; PG8_MMA(1, 0, At, B0); PG8_MMA(1, 1, At, B1); PG8_BAR; PG8_SCHED;
            } else {
            PG8_LDB(B0, 0, 0); PG8_SCHED; PG8_LDA(At, 0, 0); PG8_STAGE(PG8_SA(1, 1), a1 + hstepA, voffA);
            PG8_WAIT_L(8); PG8_BAR; PG8_WAIT_L(0); PG8_MMA(0, 0, At, B0); PG8_BAR; PG8_SCHED;
            PG8_LDB(B1, 0, 1); PG8_STAGE(PG8_SB(0, 0), b2, voffB);
            PG8_BAR; PG8_WAIT_L(0); PG8_MMA(0, 1, At, B1); PG8_BAR;
            PG8_LDA(At, 0, 1); PG8_STAGE(PG8_SA(0, 0), a2, voffA);
            PG8_BAR; PG8_WAIT_L(0); PG8_MMA(1, 0, At, B0); PG8_BAR; PG8_SCHED;
            PG8_STAGE(PG8_SB(0, 1), b2 + hstepB, voffB);
            PG8_WAIT_V(6); PG8_BAR; PG8_MMA(1, 1, At, B1); PG8_BAR;
            PG8_LDB(B0, 1, 0); PG8_SCHED; PG8_LDA(At, 1, 0); PG8_STAGE(PG8_SA(0, 1), a2 + hstepA, voffA);
            PG8_WAIT_L(8); PG8_BAR; PG8_WAIT_L(0); PG8_MMA(0, 0, At, B0); PG8_BAR; PG8_SCHED;
            PG8_LDB(B1, 1, 1); PG8_STAGE(PG8_SB(1, 0), b3, voffB);
            PG8_BAR; PG8_WAIT_L(0); PG8_MMA(0, 1, At, B1); PG8_BAR;
            PG8_LDA(At, 1, 1); PG8_STAGE(PG8_SA(1, 0), a3, voffA);
            PG8_BAR; PG8_WAIT_L(0); PG8_MMA(1, 0, At, B0); PG8_BAR; PG8_SCHED;
            PG8_STAGE(PG8_SB(1, 1), b3 + hstepB, voffB);
            PG8_WAIT_V(6); PG8_BAR; PG8_MMA(1, 1, At, B1); PG8_BAR;
            }
        }
        if constexpr (ALIGN_EPI) { if (wr == 0) PG8_BAR; }
        { const int le_ = lane_id_opaque(); E(acc, cur, wr, wc, le_ & 15, le_ >> 4); }
        if (!has_next) break;
#pragma unroll
        for (int a = 0; a < 2; ++a)
#pragma unroll
            for (int b = 0; b < 2; ++b)
#pragma unroll
                for (int m = 0; m < 4; ++m)
#pragma unroll
                    for (int n = 0; n < 2; ++n) acc[a][b][m][n] = (f32x4){0.f, 0.f, 0.f, 0.f};
        cur = nxt; cA = nA; cB = nB; ++ui;
        if constexpr (ALIGN_EPI) { if (wr == 1) PG8_BAR; }
    }
    PG8_WAIT_V(0);
    if constexpr (!ALIGN_EPI) { if (wr == 0) PG8_BAR; }
    PG8_BAR;
#undef PG8_SA
#undef PG8_SB
#undef PG8_STAGE
#undef PG8_LDA
#undef PG8_LDB
#undef PG8_MMA
#undef PG8_WAIT_V
#undef PG8_WAIT_L
#undef PG8_BAR
#undef PG8_SCHED
#undef PG8_ABASE
#undef PG8_BBASE
}
}

struct EpiZ {
    static constexpr bool PERM = true;
    float* out; unsigned char* ws;
    __device__ __forceinline__ void operator()(const f32x4 (&acc)[2][2][4][2], const pg8::Unit& u, int wr, int wc, int fr, int fq) const {
        asm volatile("" : "+v"(fr), "+v"(fq));
        const int seg = u.pn >> 1;
        const bool smp = u.pm >= SEQ / 256;
        const int row0 = u.pm * 256 + wr * 64 + fr;
        const int cl0 = wc * 32 + 8 * fq;
        if (seg < 6) {
            bf16_t* B = (bf16_t*)(ws + WS_QA + (size_t)seg * (WS_KA - WS_QA));
            const bool isq = (seg == 0 || seg == 3);
            const float sc = isq ? C2 : 1.0f;
            const int kk = seg - 1 - (seg > 3 ? 1 : 0);
            float* ob = isq ? nullptr : (smp ? out + O_DKS + (size_t)kk * NSMP * 512 - (size_t)SEQ * 512 : out + O_DKP + (size_t)kk * SEQ * 512);
            const int cs = (u.pn & 1) * 256 + cl0;
            if (seg == 0 || seg == 1 || seg == 3 || seg == 4) {
                float mx0 = 0.f, mx1 = 0.f;
#pragma unroll
                for (int ai = 0; ai < 2; ++ai)
#pragma unroll
                    for (int m = 0; m < 4; ++m) {
#pragma unroll
                        for (int bj = 0; bj < 2; ++bj) { const f32x4 v0 = acc[ai][bj][m][0] * sc, v1 = acc[ai][bj][m][1] * sc;
                            float ss = (v0[0] * v0[0] + v0[1] * v0[1]) + (v0[2] * v0[2] + v0[3] * v0[3]) + (v1[0] * v1[0] + v1[1] * v1[1]) + (v1[2] * v1[2] + v1[3] * v1[3]);
                            ss += __shfl_xor(ss, 16); ss += __shfl_xor(ss, 32);
                            if (bj == 0) mx0 = fmaxf(mx0, ss); else mx1 = fmaxf(mx1, ss); } }
#pragma unroll
                for (int ofs = 1; ofs < 16; ofs <<= 1) { mx0 = fmaxf(mx0, __shfl_xor(mx0, ofs)); mx1 = fmaxf(mx1, __shfl_xor(mx1, ofs)); }
                if ((fr | fq) == 0) { unsigned* nw = (unsigned*)(ws + WS_CTL) + (seg < 3 ? 288 : 256) + ((seg == 4 || seg == 1) ? 16 : 0);
                    const int h0 = (u.pn & 1) * 4 + (wc >> 1), hf = wc & 1;
                    atomicMax(nw + (h0 * 2 + hf), __float_as_uint(mx0)); atomicMax(nw + ((h0 + 2) * 2 + hf), __float_as_uint(mx1)); }
            }
#pragma unroll
            for (int ai = 0; ai < 2; ++ai)
#pragma unroll
                for (int m = 0; m < 4; ++m) { const size_t r = (size_t)(row0 + ai * 128 + m * 16);
#pragma unroll
                    for (int bj = 0; bj < 2; ++bj) { const f32x4 v0 = acc[ai][bj][m][0], v1 = acc[ai][bj][m][1]; const int c = cs + bj * 128;
                        if (ob) { *(f32x4*)(ob + r * 512 + c) = v0; *(f32x4*)(ob + r * 512 + c + 4) = v1; }
                        u32x4 w; w.x = pg8::cvt_pk_bf16(v0[0] * sc, v0[1] * sc); w.y = pg8::cvt_pk_bf16(v0[2] * sc, v0[3] * sc); w.z = pg8::cvt_pk_bf16(v1[0] * sc, v1[1] * sc); w.w = pg8::cvt_pk_bf16(v1[2] * sc, v1[3] * sc);
                        *(u32x4*)(B + r * 512 + c) = w; } }
        } else {
            bf16_t* G = (bf16_t*)(ws + WS_G);
            const int cs = (u.pn - 12) * 256 + cl0;
#pragma unroll
            for (int ai = 0; ai < 2; ++ai)
#pragma unroll
                for (int m = 0; m < 4; ++m) { const size_t r = (size_t)(row0 + ai * 128 + m * 16);
#pragma unroll
                    for (int bj = 0; bj < 2; ++bj) { const f32x4 v0 = acc[ai][bj][m][0], v1 = acc[ai][bj][m][1]; const int c = cs + bj * 128;
                        u32x4 w; w.x = pg8::cvt_pk_bf16(sigmoidf_(v0[0]), sigmoidf_(v0[1])); w.y = pg8::cvt_pk_bf16(sigmoidf_(v0[2]), sigmoidf_(v0[3]));
                        w.z = pg8::cvt_pk_bf16(sigmoidf_(v1[0]), sigmoidf_(v1[1])); w.w = pg8::cvt_pk_bf16(sigmoidf_(v1[2]), sigmoidf_(v1[3]));
                        *(u32x4*)(G + r * 2048 + c) = w; } }
        }
    }
};
struct EpiGate {
    static constexpr bool PERM = true;
    bf16_t* G; bf16_t* GO;
    __device__ __forceinline__ void operator()(const f32x4 (&acc)[2][2][4][2], const pg8::Unit& u, int wr, int wc, int fr, int fq) const {
        asm volatile("" : "+v"(fr), "+v"(fq));
        const int row0 = u.pm * 256 + wr * 64 + fr, c0 = u.pn * 256 + wc * 32 + 8 * fq;
#pragma unroll
        for (int ai = 0; ai < 2; ++ai)
#pragma unroll
            for (int m = 0; m < 4; ++m) { const size_t ro = (size_t)(row0 + ai * 128 + m * 16) * 2048 + c0; const bf16_t* rp = G + ro; bf16_t* wp = GO + ro;
#pragma unroll
                for (int bj = 0; bj < 2; ++bj) { const f32x4 v0 = acc[ai][bj][m][0], v1 = acc[ai][bj][m][1]; const u32x4 gw = *(const u32x4*)(rp + bj * 128);
                    u32x4 w; w.x = pg8::cvt_pk_bf16(v0[0] * bflo(gw.x), v0[1] * bfhi(gw.x)); w.y = pg8::cvt_pk_bf16(v0[2] * bflo(gw.y), v0[3] * bfhi(gw.y));
                    w.z = pg8::cvt_pk_bf16(v1[0] * bflo(gw.z), v1[1] * bfhi(gw.z)); w.w = pg8::cvt_pk_bf16(v1[2] * bflo(gw.w), v1[3] * bfhi(gw.w));
                    *(u32x4*)(wp + bj * 128) = w; } }
    }
};
template <bool BASE_BF16> struct EpiRes {
    static constexpr bool PERM = true;
    const void* base; bf16_t* T; const float* gate;
    __device__ __forceinline__ void operator()(const f32x4 (&acc)[2][2][4][2], const pg8::Unit& u, int wr, int wc, int fr, int fq) const {
        asm volatile("" : "+v"(fr), "+v"(fq));
        const int row0 = u.pm * 256 + wr * 64 + fr, c0 = u.pn * 256 + wc * 32 + 8 * fq;
#pragma unroll
        for (int ai = 0; ai < 2; ++ai)
#pragma unroll
            for (int m = 0; m < 4; ++m) { const size_t ro = (size_t)(row0 + ai * 128 + m * 16) * DM;
#pragma unroll
                for (int bj = 0; bj < 2; ++bj) { const int c = c0 + bj * 128; f32x4 b0, b1;
                    if (BASE_BF16) { const u32x4 bw = *(const u32x4*)((const bf16_t*)base + ro + c); b0 = (f32x4){bflo(bw.x), bfhi(bw.x), bflo(bw.y), bfhi(bw.y)}; b1 = (f32x4){bflo(bw.z), bfhi(bw.z), bflo(bw.w), bfhi(bw.w)}; }
                    else { b0 = *(const f32x4*)((const float*)base + ro + c); b1 = *(const f32x4*)((const float*)base + ro + c + 4); }
                    const f32x4 g0 = *(const f32x4*)(gate + c), g1 = *(const f32x4*)(gate + c + 4);
                    const f32x4 v0 = b0 * ALPHA + g0 * acc[ai][bj][m][0], v1 = b1 * ALPHA + g1 * acc[ai][bj][m][1];
                    u32x4 w; w.x = pg8::cvt_pk_bf16(v0[0], v0[1]); w.y = pg8::cvt_pk_bf16(v0[2], v0[3]); w.z = pg8::cvt_pk_bf16(v1[0], v1[1]); w.w = pg8::cvt_pk_bf16(v1[2], v1[3]);
                    *(u32x4*)(T + ro + c) = w; } }
    }
};
struct PanelStats {
    unsigned* xbuf; unsigned* cnt; float eps;
    __device__ __forceinline__ void run(const f32x4 (&v)[2][2][4][2], const pg8::Unit& u, int wr, int wc, int fr, int fq, LAS unsigned char* lds, int wid, int lane) const {
        LAS f32x2* P = (LAS f32x2*)(lds + LN_LDS);
        LAS f32x2* S = (LAS f32x2*)(lds + LN_LDS + 8192);
#pragma unroll
        for (int ai = 0; ai < 2; ++ai)
#pragma unroll
            for (int m = 0; m < 4; ++m) {
                float s = 0.f;
#pragma unroll
                for (int bj = 0; bj < 2; ++bj)
#pragma unroll
                    for (int n = 0; n < 2; ++n) { const f32x4 x = v[ai][bj][m][n]; s += (x[0] + x[1]) + (x[2] + x[3]); }
                s += __shfl_xor(s, 16); s += __shfl_xor(s, 32);
                const float mw = s * (1.0f / 64.0f); float q = 0.f;
#pragma unroll
                for (int bj = 0; bj < 2; ++bj)
#pragma unroll
                    for (int n = 0; n < 2; ++n) { const f32x4 d = v[ai][bj][m][n] - mw; q += (d[0] * d[0] + d[1] * d[1]) + (d[2] * d[2] + d[3] * d[3]); }
                q += __shfl_xor(q, 16); q += __shfl_xor(q, 32);
                if (fq == 0) P[(ai * 128 + wr * 64 + m * 16 + fr) * 4 + wc] = (f32x2){mw, q};
                __builtin_amdgcn_sched_barrier(0);
            }
        asm volatile("s_waitcnt lgkmcnt(0)" ::: "memory"); __builtin_amdgcn_s_barrier(); asm volatile("" ::: "memory");
        const int row = wid * 32 + (lane & 31);
        if (lane < 32) {
            const f32x2 a = P[row * 4 + 0], b = P[row * 4 + 1], c = P[row * 4 + 2], d = P[row * 4 + 3];
            const float mt = (a.x + b.x + c.x + d.x) * 0.25f;
            const float da = a.x - mt, db = b.x - mt, dc = c.x - mt, dd = d.x - mt;
            const float m2 = (a.y + b.y) + (c.y + d.y) + 64.0f * ((da * da + db * db) + (dc * dc + dd * dd));
            unsigned long long* slot = (unsigned long long*)xbuf + ((size_t)(u.pm * 256 + row) * 4 + u.pn);
            __hip_atomic_store(slot, ((unsigned long long)__float_as_uint(m2) << 32) | __float_as_uint(mt), __ATOMIC_RELAXED, __HIP_MEMORY_SCOPE_AGENT);
        }
        asm volatile("s_waitcnt vmcnt(0)" ::: "memory");
        if (lane == 0) __hip_atomic_fetch_add(cnt + 64 * u.pm, 1u, __ATOMIC_RELAXED, __HIP_MEMORY_SCOPE_AGENT);
        if (wid == 0) {
            unsigned sp = 0;
            while ((unsigned)__builtin_amdgcn_readfirstlane(__hip_atomic_load(cnt + 64 * u.pm, __ATOMIC_RELAXED, __HIP_MEMORY_SCOPE_AGENT)) < 32u && ++sp < (1u << 21)) __builtin_amdgcn_s_sleep(2);
            __builtin_amdgcn_fence(__ATOMIC_ACQUIRE, "agent");
        }
        asm volatile("s_waitcnt vmcnt(0) lgkmcnt(0)" ::: "memory"); __builtin_amdgcn_s_barrier(); asm volatile("" ::: "memory");
        if (lane < 32) {
            const unsigned long long* slot = (const unsigned long long*)xbuf + (size_t)(u.pm * 256 + row) * 4; float mt[4], m2[4]; float ms = 0.f;
#pragma unroll
            for (int t = 0; t < 4; ++t) { const unsigned long long w = __hip_atomic_load(slot + t, __ATOMIC_RELAXED, __HIP_MEMORY_SCOPE_AGENT); mt[t] = __uint_as_float((unsigned)w); m2[t] = __uint_as_float((unsigned)(w >> 32)); ms += mt[t]; }
            const float mean = ms * 0.25f; float q = 0.f;
#pragma unroll
            for (int t = 0; t < 4; ++t) { const float dm = mt[t] - mean; q += m2[t] + 256.0f * dm * dm; }
            S[row] = (f32x2){mean, 1.0f / sqrtf(q * (1.0f / 1024.0f) + eps)};
        }
        asm volatile("s_waitcnt lgkmcnt(0)" ::: "memory"); __builtin_amdgcn_s_barrier(); asm volatile("" ::: "memory");
    }
};
template <bool FINAL> struct EpiResLn {
    static constexpr bool PERM = true;
    const void* base; const float* gate; const float* lg; const float* lb; const float* mod; bf16_t* X1B; bf16_t* XN; float* out; PanelStats st; LAS unsigned char* lds;
    __device__ __forceinline__ void operator()(f32x4 (&acc)[2][2][4][2], const pg8::Unit& u, int wr, int wc, int fr, int fq) const {
        asm volatile("" : "+v"(fr), "+v"(fq));
        const int row0 = u.pm * 256 + wr * 64 + fr, c0 = u.pn * 256 + wc * 32 + 8 * fq;
#pragma unroll
        for (int ai = 0; ai < 2; ++ai)
#pragma unroll
            for (int m = 0; m < 4; ++m) { int rr_ = row0 + ai * 128 + m * 16; asm volatile("" : "+v"(rr_)); const size_t ro = (size_t)rr_ * DM;
#pragma unroll
                for (int bj = 0; bj < 2; ++bj) { int c = c0 + bj * 128; asm volatile("" : "+v"(c)); f32x4 b0, b1;
                    if (FINAL) { const u32x4 bw = *(const u32x4*)((const bf16_t*)base + ro + c); b0 = (f32x4){bflo(bw.x), bfhi(bw.x), bflo(bw.y), bfhi(bw.y)}; b1 = (f32x4){bflo(bw.z), bfhi(bw.z), bflo(bw.w), bfhi(bw.w)}; }
                    else { b0 = *(const f32x4*)((const float*)base + ro + c); b1 = *(const f32x4*)((const float*)base + ro + c + 4); }
                    const f32x4 g0 = *(const f32x4*)(gate + c), g1 = *(const f32x4*)(gate + c + 4);
                    acc[ai][bj][m][0] = b0 * ALPHA + g0 * acc[ai][bj][m][0]; acc[ai][bj][m][1] = b1 * ALPHA + g1 * acc[ai][bj][m][1];
                    asm volatile("" : "+v"(acc[ai][bj][m][0]), "+v"(acc[ai][bj][m][1])); }
                __builtin_amdgcn_sched_barrier(0); }
        st.run(acc, u, wr, wc, fr, fq, lds, wr * 4 + wc, fq * 16 + fr);
        const LAS f32x2* S = (const LAS f32x2*)(lds + LN_LDS + 8192);
#pragma unroll
        for (int ai = 0; ai < 2; ++ai)
#pragma unroll
            for (int m = 0; m < 4; ++m) { int r = ai * 128 + wr * 64 + m * 16 + fr; asm volatile("" : "+v"(r)); const f32x2 sr = S[r]; const size_t ro = (size_t)(u.pm * 256 + r) * DM;
#pragma unroll
                for (int bj = 0; bj < 2; ++bj) { int c = c0 + bj * 128; asm volatile("" : "+v"(c));
                    const f32x4 y0 = (acc[ai][bj][m][0] - sr.x) * sr.y * *(const f32x4*)(lg + c) + *(const f32x4*)(lb + c);
                    const f32x4 y1 = (acc[ai][bj][m][1] - sr.x) * sr.y * *(const f32x4*)(lg + c + 4) + *(const f32x4*)(lb + c + 4);
                    if (FINAL) { *(f32x4*)(out + ro + c) = y0; *(f32x4*)(out + ro + c + 4) = y1; }
                    else { u32x4 w; w.x = pg8::cvt_pk_bf16(y0[0], y0[1]); w.y = pg8::cvt_pk_bf16(y0[2], y0[3]); w.z = pg8::cvt_pk_bf16(y1[0], y1[1]); w.w = pg8::cvt_pk_bf16(y1[2], y1[3]);
                        *(u32x4*)(X1B + ro + c) = w;
                        const f32x4 h0 = y0 * (*(const f32x4*)(mod + 4096 + c) + 1.0f) + *(const f32x4*)(mod + 3072 + c), h1 = y1 * (*(const f32x4*)(mod + 4096 + c + 4) + 1.0f) + *(const f32x4*)(mod + 3072 + c + 4);
                        u32x4 w2; w2.x = pg8::cvt_pk_bf16(h0[0], h0[1]); w2.y = pg8::cvt_pk_bf16(h0[2], h0[3]); w2.z = pg8::cvt_pk_bf16(h1[0], h1[1]); w2.w = pg8::cvt_pk_bf16(h1[2], h1[3]);
                        *(u32x4*)(XN + ro + c) = w2; } }
                __builtin_amdgcn_sched_barrier(0); }
    }
};
struct EpiSlab {
    static constexpr bool PERM = true;
    float* slab;
    __device__ __forceinline__ void operator()(const f32x4 (&acc)[2][2][4][2], const pg8::Unit& u, int wr, int wc, int fr, int fq) const {
        asm volatile("" : "+v"(fr), "+v"(fq));
        const int row0 = wr * 64 + fr, c0 = u.pn * 256 + wc * 32 + 8 * fq; float* sb = slab + (size_t)u.ks * NSMP * DM;
#pragma unroll
        for (int ai = 0; ai < 2; ++ai)
#pragma unroll
            for (int m = 0; m < 4; ++m) { float* op = sb + (size_t)(row0 + ai * 128 + m * 16) * DM + c0;
#pragma unroll
                for (int bj = 0; bj < 2; ++bj) { *(f32x4*)(op + bj * 128) = acc[ai][bj][m][0]; *(f32x4*)(op + bj * 128 + 4) = acc[ai][bj][m][1]; } }
    }
};
struct EpiFfn {
    static constexpr bool PERM = true;
    bf16_t* ACT;
    __device__ __forceinline__ void operator()(const f32x4 (&acc)[2][2][4][2], const pg8::Unit& u, int wr, int wc, int fr, int fq) const {
        asm volatile("" : "+v"(fr), "+v"(fq));
        const int row0 = u.pm * 256 + wr * 64 + fr, c0 = u.pn * 128 + wc * 32 + 8 * fq;
#pragma unroll
        for (int ai = 0; ai < 2; ++ai)
#pragma unroll
            for (int m = 0; m < 4; ++m) { const f32x4 g0 = acc[ai][0][m][0], g1 = acc[ai][0][m][1], u0 = acc[ai][1][m][0], u1 = acc[ai][1][m][1];
                u32x4 w; w.x = pg8::cvt_pk_bf16(siluf_(g0[0]) * u0[0], siluf_(g0[1]) * u0[1]); w.y = pg8::cvt_pk_bf16(siluf_(g0[2]) * u0[2], siluf_(g0[3]) * u0[3]);
                w.z = pg8::cvt_pk_bf16(siluf_(g1[0]) * u1[0], siluf_(g1[1]) * u1[1]); w.w = pg8::cvt_pk_bf16(siluf_(g1[2]) * u1[2], siluf_(g1[3]) * u1[3]);
                *(u32x4*)(ACT + (size_t)(row0 + ai * 128 + m * 16) * DFF + c0) = w; }
    }
};

struct Frame {
    LAS unsigned char* lds; unsigned char* ldsg;
    int tid, lane, wave, G, bid;
    const float* const* in; float* out; unsigned char* ws;
};
enum { I_XP = 0, I_XS, I_CDK, I_CDV, I_CFK, I_CFV, I_CFL, I_CP, I_CS, I_WADA, I_BADA, I_WIN, I_BF, I_LQ1, I_LK1, I_LQ2, I_LK2, I_SUBG, I_RELB, I_WA, I_WB, I_WO, I_LN1G, I_LN1B, I_LN2G, I_LN2B, I_WFI, I_WFO };

__device__ __forceinline__ void tr_item(const float* W, int ldw, int src_n0, int k0, bf16_t* WT, int ldt, int dst_row0, int dst_k0, int dup_off, LAS float* scr, int lane) {
#pragma unroll 8
    for (int i = 0; i < 32; ++i) { const int kk = 2 * i + (lane >> 5); scr[kk * 33 + (lane & 31)] = W[(size_t)(k0 + kk) * ldw + src_n0 + (lane & 31)]; }
    asm volatile("s_waitcnt lgkmcnt(0)" ::: "memory");
    const int c = lane & 7;
#pragma unroll
    for (int j = 0; j < 4; ++j) { const int n = (lane >> 3) + 8 * j; const LAS float* s = scr + (8 * c) * 33 + n;
        u32x4 o; o.x = pk2(s[0 * 33], s[1 * 33]); o.y = pk2(s[2 * 33], s[3 * 33]); o.z = pk2(s[4 * 33], s[5 * 33]); o.w = pk2(s[6 * 33], s[7 * 33]);
        bf16_t* d = WT + (size_t)(dst_row0 + n) * ldt + dst_k0 + 8 * c;
        *(u32x4*)d = o; if (dup_off) *(u32x4*)(d + dup_off) = o; }
    asm volatile("s_waitcnt lgkmcnt(0)" ::: "memory");
}
__device__ __forceinline__ void p0_prologue(Frame& F) {
    if (F.bid < 96) {
        LAS float* sc = (LAS float*)F.lds;
        LAS float* part = sc + 17 * 1024;
        for (int i = F.tid; i < 17 * 1024; i += 512) { const int r = i >> 10, k = i & 1023; const float c = r == 0 ? F.in[I_CP][k] : F.in[I_CS][(r - 1) * 1024 + k]; sc[i] = siluf_(c); }
        __syncthreads();
        const int n = F.bid * 64 + F.lane; const float* wa = F.in[I_WADA] + n;
        float acc[17];
#pragma unroll
        for (int r = 0; r < 17; ++r) acc[r] = 0.f;
        for (int k = F.wave * 128; k < F.wave * 128 + 128; k += 4) {
            const float w0 = wa[(size_t)k * 6144], w1 = wa[(size_t)(k + 1) * 6144], w2 = wa[(size_t)(k + 2) * 6144], w3 = wa[(size_t)(k + 3) * 6144];
#pragma unroll
            for (int r = 0; r < 17; ++r) { const f32x4 s = *(const LAS f32x4*)(sc + r * 1024 + k); acc[r] += s[0] * w0 + s[1] * w1 + s[2] * w2 + s[3] * w3; }
        }
#pragma unroll
        for (int r = 0; r < 17; ++r) part[(F.wave * 17 + r) * 64 + F.lane] = acc[r];
        __syncthreads();
        float* mod = (float*)(F.ws + WS_MOD);
        for (int i = F.tid; i < 17 * 64; i += 512) { const int r = i >> 6, l = i & 63; float s = 0.f;
#pragma unroll
            for (int w = 0; w < 8; ++w) s += part[(w * 17 + r) * 64 + l];
            mod[r * 6144 + F.bid * 64 + l] = s + F.in[I_BADA][F.bid * 64 + l]; }
        asm volatile("s_waitcnt vmcnt(0)" ::: "memory");
        __syncthreads();
        if (F.tid == 0) { __builtin_amdgcn_fence(__ATOMIC_RELEASE, "agent"); asm volatile("s_waitcnt vmcnt(0)" ::: "memory");
            __hip_atomic_fetch_add((unsigned*)(F.ws + WS_CTL) + 320, 1u, __ATOMIC_RELAXED, __HIP_MEMORY_SCOPE_AGENT); }
    }
    LAS float* scr = (LAS float*)(F.lds + F.wave * 16384);
    const int gw = F.bid * 8 + F.wave, NGW = F.G * 8;
    constexpr int I_IN = 16 * (NZ / 32), I_A = 8 * 32, I_B = 8 * 32, I_O = 16 * 32, I_FI = 16 * (NFF2 / 32), I_FO = (DFF / 64) * 32;
    constexpr int NITEMS = I_IN + I_A + I_B + I_O + I_FI + I_FO;
    for (int it = gw; it < NITEMS; it += NGW) {
        int r = it;
        if (r < I_IN) { const int nb = NZ / 32, kb = r / nb, n0 = 32 * (r % nb); tr_item(F.in[I_WIN], WIN_COLS, n0 < 3072 ? n0 : n0 + 8, 64 * kb, (bf16_t*)(F.ws + WS_WIN), 1024, n0, 64 * kb, 0, scr, F.lane); continue; } r -= I_IN;
        if (r < I_A) { const int kb = r / 32, n0 = 32 * (r % 32); tr_item(F.in[I_WA], 1024, n0, 64 * kb, (bf16_t*)(F.ws + WS_WAB), 512, n0, 64 * kb, 0, scr, F.lane); continue; } r -= I_A;
        if (r < I_B) { const int kb = r / 32, n0 = 32 * (r % 32); tr_item(F.in[I_WB], 1024, n0, 64 * kb, (bf16_t*)(F.ws + WS_WAB), 512, 1024 + n0, 64 * kb, 0, scr, F.lane); continue; } r -= I_B;
        if (r < I_O) { const int kb = r / 32, n0 = 32 * (r % 32); tr_item(F.in[I_WO], 1024, n0, 64 * kb, (bf16_t*)(F.ws + WS_WO2), 2048, n0, 64 * kb, 1024, scr, F.lane); continue; } r -= I_O;
        if (r < I_FI) { const int nb = NFF2 / 32, kb = r / nb, n0 = 32 * (r % nb), t = n0 >> 8, j = n0 & 255; const int src = j < 128 ? 128 * t + j : DFF + 128 * t + (j - 128);
            tr_item(F.in[I_WFI], NFF2, src, 64 * kb, (bf16_t*)(F.ws + WS_WFI), 1024, n0, 64 * kb, 0, scr, F.lane); continue; } r -= I_FI;
        { const int kb = r / 32, n0 = 32 * (r % 32); tr_item(F.in[I_WFO], 1024, n0, 64 * kb, (bf16_t*)(F.ws + WS_WFO), DFF, n0, 64 * kb, 0, scr, F.lane); }
    }
}

__device__ __forceinline__ void p1_rows(Frame& F, bool wait_mod) {
    LAS float* wf = (LAS float*)F.lds;
    for (int i = F.tid; i < 1024 * 8; i += 512) wf[i] = F.in[I_WIN][(size_t)(i >> 3) * WIN_COLS + 3072 + (i & 7)];
    __syncthreads();
    const float* mod = (const float*)(F.ws + WS_MOD);
    bf16_t* XN = (bf16_t*)(F.ws + WS_XN);
    const int gw = F.bid * 8 + F.wave, NGW = F.G * 8;
    if (wait_mod) {
        if (F.tid == 0) { unsigned* w = (unsigned*)(F.ws + WS_CTL) + 320; unsigned sp = 0;
            while (__hip_atomic_load(w, __ATOMIC_RELAXED, __HIP_MEMORY_SCOPE_AGENT) < 96u && ++sp < (1u << 22)) __builtin_amdgcn_s_sleep(2);
            __builtin_amdgcn_fence(__ATOMIC_ACQUIRE, "agent"); asm volatile("s_waitcnt vmcnt(0)" ::: "memory"); }
        __syncthreads(); }
    for (int m = gw; m < MT; m += NGW) {
        const bool smp = m >= SEQ; const int rb = smp ? 1 + ((m - SEQ) >> 4) : 0;
        const float* xr = smp ? F.in[I_XS] + (size_t)(m - SEQ) * DM : F.in[I_XP] + (size_t)m * DM;
        const float* sh = mod + (size_t)rb * 6144, *scl = sh + 1024;
        float a8[8];
#pragma unroll
        for (int j = 0; j < 8; ++j) a8[j] = 0.f;
#pragma unroll
        for (int j = 0; j < 4; ++j) { const int k = 4 * F.lane + 256 * j;
            const f32x4 x = *(const f32x4*)(xr + k), s1 = *(const f32x4*)(scl + k), t1 = *(const f32x4*)(sh + k);
            const f32x4 h = x * (s1 + 1.0f) + t1;
            u32x2 w; w.x = pk2(h[0], h[1]); w.y = pk2(h[2], h[3]); *(u32x2*)(XN + (size_t)m * DM + k) = w;
#pragma unroll
            for (int e = 0; e < 4; ++e) { const f32x4 wa = *(const LAS f32x4*)(wf + (k + e) * 8), wb = *(const LAS f32x4*)(wf + (k + e) * 8 + 4);
                a8[0] += h[e] * wa[0]; a8[1] += h[e] * wa[1]; a8[2] += h[e] * wa[2]; a8[3] += h[e] * wa[3];
                a8[4] += h[e] * wb[0]; a8[5] += h[e] * wb[1]; a8[6] += h[e] * wb[2]; a8[7] += h[e] * wb[3]; } }
        float mine = 0.f;
#pragma unroll
        for (int j = 0; j < 8; ++j) { const float s = wave_sum(a8[j]); if (F.lane == j) mine = s; }
        if (F.lane < 8) { const float v = mine + F.in[I_BF][F.lane]; const float lf = fminf(v, 0.f) - log1pf(__expf(-fabsf(v)));
            float* o = smp ? F.out + O_FLS + (size_t)(m - SEQ) * 8 : F.out + O_FLP + (size_t)m * 8; o[F.lane] = lf; }
    }
}

__device__ __forceinline__ float block_excl_scan(Frame& F, float tot, LAS float* sm) {
    float inc = tot;
#pragma unroll
    for (int o = 1; o < 64; o <<= 1) { const float t = __shfl_up(inc, o); if (F.lane >= o) inc += t; }
    if (F.lane == 63) sm[F.wave] = inc;
    __syncthreads();
    float base = 0.f;
    for (int w = 0; w < F.wave; ++w) base += sm[w];
    __syncthreads();
    return base + inc - tot;
}
__device__ __forceinline__ void p2_cumsum(Frame& F) {
    LAS float* sm = (LAS float*)F.lds;
    if (F.bid < 8) {
        const int h = F.bid; const float* lf = F.out + O_FLP; float* Fp = (float*)(F.ws + WS_FP) + (size_t)h * SEQ;
        float v[32]; float run = 0.f;
#pragma unroll
        for (int i = 0; i < 32; ++i) { run += lf[(size_t)(32 * F.tid + i) * 8 + h]; v[i] = run; }
        const float off = block_excl_scan(F, run, sm);
#pragma unroll
        for (int i = 0; i < 32; i += 4) *(f32x4*)(Fp + 32 * F.tid + i) = (f32x4){(off + v[i]) * LOG2E, (off + v[i + 1]) * LOG2E, (off + v[i + 2]) * LOG2E, (off + v[i + 3]) * LOG2E};
    } else if (F.bid < 8 + 128) {
        const int b = (F.bid - 8) >> 3, h = (F.bid - 8) & 7;
        const float* cl = F.in[I_CFL] + (size_t)b * PAST * 8; float* Fs = (float*)(F.ws + WS_FS) + (size_t)(b * 8 + h) * SKV;
        float v[4]; float run = 0.f;
#pragma unroll
        for (int i = 0; i < 4; ++i) { run += cl[(size_t)(4 * F.tid + i) * 8 + h]; v[i] = run; }
        const float off = block_excl_scan(F, run, sm);
        *(f32x4*)(Fs + 4 * F.tid) = (f32x4){(off + v[0]) * LOG2E, (off + v[1]) * LOG2E, (off + v[2]) * LOG2E, (off + v[3]) * LOG2E};
        if (F.tid == 511) { float r2 = off + run; const float* ls = F.out + O_FLS + (size_t)b * DEC_T * 8;
            for (int t = 0; t < DEC_T; ++t) { r2 += ls[t * 8 + h]; Fs[PAST + t] = r2 * LOG2E; } }
    }
}

template <bool FINAL> __device__ __forceinline__ void ln_rows(Frame& F, const float* g, const float* b, int KS, int gate_off) {
    const float* mod = (const float*)(F.ws + WS_MOD);
    const bf16_t* T = (const bf16_t*)(F.ws + WS_TB); bf16_t* X1B = (bf16_t*)(F.ws + WS_X1B); bf16_t* XN = (bf16_t*)(F.ws + WS_XN);
    const int gw = F.wave * F.G + F.bid, NGW = F.G * 8;
    for (int m = SEQ + gw; m < MT; m += NGW) {
        f32x4 v[4]; float s = 0.f;
        if (m < SEQ) {
#pragma unroll
            for (int j = 0; j < 2; ++j) { const u32x4 w = *(const u32x4*)(T + (size_t)m * DM + 8 * F.lane + 512 * j);
                v[2 * j] = (f32x4){bflo(w.x), bfhi(w.x), bflo(w.y), bfhi(w.y)}; v[2 * j + 1] = (f32x4){bflo(w.z), bfhi(w.z), bflo(w.w), bfhi(w.w)}; }
        } else {
            const float* sl = (const float*)(F.ws + WS_SLAB) + (size_t)(m - SEQ) * DM; const float* gp = mod + (size_t)(1 + ((m - SEQ) >> 4)) * 6144 + gate_off;
#pragma unroll
            for (int q = 0; q < 4; ++q) { const int k = 8 * F.lane + 512 * (q >> 1) + 4 * (q & 1); f32x4 a = (f32x4){0.f, 0.f, 0.f, 0.f};
                for (int ks = 0; ks < KS; ++ks) a += *(const f32x4*)(sl + (size_t)ks * NSMP * DM + k);
                f32x4 bs;
                if (FINAL) { const u32x2 w = *(const u32x2*)(X1B + (size_t)m * DM + k); bs = (f32x4){bflo(w.x), bfhi(w.x), bflo(w.y), bfhi(w.y)}; }
                else bs = *(const f32x4*)(F.in[I_XS] + (size_t)(m - SEQ) * DM + k);
                v[q] = bs * ALPHA + *(const f32x4*)(gp + k) * a; } }
#pragma unroll
        for (int q = 0; q < 4; ++q) s += (v[q][0] + v[q][1]) + (v[q][2] + v[q][3]);
        const float mean = wave_sum(s) * (1.f / DM); float s2 = 0.f;
#pragma unroll
        for (int q = 0; q < 4; ++q) { v[q] = v[q] - mean; s2 += (v[q][0] * v[q][0] + v[q][1] * v[q][1]) + (v[q][2] * v[q][2] + v[q][3] * v[q][3]); }
        const float rstd = 1.f / sqrtf(wave_sum(s2) * (1.f / DM) + LN_EPS);
        const int rb = m >= SEQ ? 1 + ((m - SEQ) >> 4) : 0;
#pragma unroll
        for (int q = 0; q < 4; ++q) { const int k = 8 * F.lane + 512 * (q >> 1) + 4 * (q & 1); const f32x4 gg = *(const f32x4*)(g + k), bb = *(const f32x4*)(b + k);
            const f32x4 y = v[q] * rstd * gg + bb;
            if (FINAL) *(f32x4*)(F.out + (size_t)m * DM + k) = y;
            else { u32x2 w; w.x = pk2(y[0], y[1]); w.y = pk2(y[2], y[3]); *(u32x2*)(X1B + (size_t)m * DM + k) = w;
                const f32x4 s2v = *(const f32x4*)(mod + (size_t)rb * 6144 + 4096 + k), t2v = *(const f32x4*)(mod + (size_t)rb * 6144 + 3072 + k);
                const f32x4 h = y * (s2v + 1.0f) + t2v; u32x2 w2; w2.x = pk2(h[0], h[1]); w2.y = pk2(h[2], h[3]); *(u32x2*)(XN + (size_t)m * DM + k) = w2; } }
    }
}

__device__ __forceinline__ int t5_bucket(int rel) {
    const int n = rel < 0 ? -rel : rel; int b;
    if (n < 8) b = n; else if (n < 12) b = 8; else if (n < 16) b = 9; else if (n < 23) b = 10; else if (n < 32) b = 11; else if (n < 46) b = 12; else if (n < 64) b = 13; else if (n < 91) b = 14; else b = 15;
    return b + (rel > 0 ? 16 : 0);
}
constexpr int AT_KB = 8192, AT_VB = 20480, AT_BUF = AT_KB + AT_VB;
constexpr int AT_WS = 2 * AT_BUF, AT_OST = AT_WS + 2048, AT_KEEP = 98304, AT_TAB = 131072, AT_MISC = AT_TAB + 4 * 192 * 4, AT_END = AT_MISC + 64;
__device__ __forceinline__ s16x4 vtr(const LAS char* p) { typedef short v4i16_t __attribute__((ext_vector_type(4))); return __builtin_bit_cast(s16x4, __builtin_amdgcn_ds_read_tr16_b64_v4i16((LAS v4i16_t*)p)); }

typedef __bf16 bf16x2_t_ __attribute__((ext_vector_type(2)));
__device__ __forceinline__ unsigned cvtpk_(float lo, float hi) { f32x2 v = {lo, hi}; bf16x2_t_ b = __builtin_convertvector(v, bf16x2_t_); return __builtin_bit_cast(unsigned, b); }
__device__ __forceinline__ void glds16_asm(const void* gsrc, unsigned lds_dst) { unsigned keep;
    asm volatile("s_mov_b32 %0, m0\n\ts_mov_b32 m0, %2\n\ts_nop 0\n\tglobal_load_lds_dwordx4 %1, off\n\ts_mov_b32 m0, %0" : "=&s"(keep) : "v"(gsrc), "s"(lds_dst) : "memory"); }
template <int OFF> __device__ __forceinline__ void glds16_asm_off(const void* gsrc, unsigned lds_dst) { unsigned keep;
    asm volatile("s_mov_b32 %0, m0\n\ts_mov_b32 m0, %2\n\ts_nop 0\n\tglobal_load_lds_dwordx4 %1, off offset:%3\n\ts_mov_b32 m0, %0" : "=&s"(keep) : "v"(gsrc), "s"(lds_dst), "i"(OFF) : "memory"); }
template <int OFF> __device__ __forceinline__ void glds16_s(const void* sbase, unsigned voff, unsigned lds_dst) { unsigned keep;
    asm volatile("s_mov_b32 %0, m0\n\ts_mov_b32 m0, %3\n\ts_nop 0\n\tglobal_load_lds_dwordx4 %1, %2 offset:%4\n\ts_mov_b32 m0, %0" : "=&s"(keep) : "v"(voff), "s"(sbase), "s"(lds_dst), "i"(OFF) : "memory"); }
__device__ __forceinline__ void glds4_s(const void* sbase, unsigned voff, unsigned lds_dst) { unsigned keep;
    asm volatile("s_mov_b32 %0, m0\n\ts_mov_b32 m0, %3\n\ts_nop 0\n\tglobal_load_lds_dword %1, %2\n\ts_mov_b32 m0, %0" : "=&s"(keep) : "v"(voff), "s"(sbase), "s"(lds_dst) : "memory"); }
__device__ __forceinline__ const void* uniform_ptr(const void* p) { const unsigned long long v = (unsigned long long)p;
    const unsigned lo = (unsigned)__builtin_amdgcn_readfirstlane((int)(unsigned)v), hi = (unsigned)__builtin_amdgcn_readfirstlane((int)(unsigned)(v >> 32)); return (const void*)(((unsigned long long)hi << 32) | lo); }
__device__ __forceinline__ void glds4_asm(const void* gsrc, unsigned lds_dst) { unsigned keep;
    asm volatile("s_mov_b32 %0, m0\n\ts_mov_b32 m0, %2\n\ts_nop 0\n\tglobal_load_lds_dword %1, off\n\ts_mov_b32 m0, %0" : "=&s"(keep) : "v"(gsrc), "s"(lds_dst) : "memory"); }
constexpr int R_V = 0, R_K = 49152, R_F = 73728, R_WS = 79872;
__device__ __forceinline__ float max3f_(float a, float b, float c) { float r; asm("v_max3_f32 %0, %1, %2, %3" : "=v"(r) : "v"(a), "v"(b), "v"(c)); return r; }
__device__ __forceinline__ float max2f_(float a, float b) { float r; asm("v_max_f32_e32 %0, %1, %2" : "=v"(r) : "v"(a), "v"(b)); return r; }
#define AP3_PIN(x) asm volatile("" : "+v"(x))
template <int MODE, int DV, int pv = 0, bool SREF = false>
__device__ __forceinline__ void attn_pass3(Frame& F, const bf16_t* Q, const bf16_t* K, const bf16_t* V, int q0, int NT, const float* Fh, int hb, f32x16 (&o)[DV / 32], int t0 = 0) {
    constexpr int NDB = DV / 32, VS = DV * 128, EPG = 8 / NDB;
    constexpr float THR = 8.0f;
    const int lane = F.lane, r32 = lane & 31, hi = lane >> 5, wid = F.wave;
    const LAS char* lds = (const LAS char*)F.lds;
    LAS float* wsf = (LAS float*)(F.lds + R_WS) + wid * 64;
    const LAS float* tab = (const LAS float*)(F.lds + AT_TAB) + hb * 192;
    const int qrow = q0 + wid * 32 + r32;
    const int tmaxw = (q0 >> 6) + (wid >> 1);
    const char* Ku = (const char*)uniform_ptr(K); const char* Vu = (const char*)uniform_ptr(V); const char* Fu = (const char*)uniform_ptr(MODE == 0 ? (const void*)Fh : (const void*)K);
    const unsigned kvo = (unsigned)(((8 * wid + (lane >> 3)) * 512 + (((lane & 7) ^ (lane >> 3)) << 3)) * 2);
    const unsigned vvo = (unsigned)(((16 * (wid & 3) + (lane >> 2)) * 512 + 32 * (wid >> 2) + 8 * (lane & 3)) * 2);
    const unsigned fvo = (unsigned)(lane * 4);
    const unsigned lds0 = (unsigned)(size_t)F.lds;
    const unsigned dk = (unsigned)__builtin_amdgcn_readfirstlane((int)(lds0 + R_K + wid * 1024)), dv = (unsigned)__builtin_amdgcn_readfirstlane((int)(lds0 + R_V + wid * 1024)),
                   df = (unsigned)__builtin_amdgcn_readfirstlane((int)(lds0 + R_F + wid * 256));
#define AP_ISSUE_K(t, SL) do { glds16_s<0>(Ku + (size_t)(t) * 65536, kvo, dk + (SL) * 8192); if (MODE == 0) glds4_s(Fu + (size_t)(t) * 256, fvo, df + (SL) * 2048); } while (0)
#define AP_ISSUE_V(t, SL) do { glds16_s<0>(Vu + (size_t)(t) * 65536, vvo, dv + (SL) * VS); if (DV == 128) glds16_s<0>(Vu + (size_t)(t) * 65536 + 128, vvo, dv + (SL) * VS + 8192); } while (0)
#define AP_BATCH(t, SL) do { if (pv != 1) { if ((t) + 2 < NT) AP_ISSUE_K((t) + 2, ((SL) + 2) % 3); if ((t) + 1 < NT) AP_ISSUE_V((t) + 1, ((SL) + 1) % 3); } } while (0)
    AP_ISSUE_K(t0, 0); AP_ISSUE_K(t0 + 1, 1); AP_ISSUE_V(t0, 0);
    bf16x8 qr[4];
#pragma unroll
    for (int d0 = 0; d0 < 4; ++d0) qr[d0] = *(const bf16x8*)(Q + (size_t)qrow * 512 + d0 * 16 + hi * 8);
    float fqp = MODE == 0 ? Fh[qrow] : 0.f;
#pragma unroll
    for (int d = 0; d < NDB; ++d) o[d] = f32x16{};
    float m_hat = 0.f, l_run = 0.f;
    f32x16 p0, p1, negm; u32x4 pwv[4];
#pragma unroll
    for (int r = 0; r < 16; ++r) negm[r] = 0.f;
#pragma unroll
    for (int i = 0; i < 4; ++i) pwv[i] = (u32x4){0u, 0u, 0u, 0u};
    const LAS char* kb4[4];
#pragma unroll
    for (int d0 = 0; d0 < 4; ++d0) kb4[d0] = lds + R_K + r32 * 128 + (((2 * d0 + hi) ^ (r32 & 7)) << 4);
    const LAS char* vb1 = lds + R_V + (4 * hi + ((lane & 15) >> 2)) * 64 + (((lane >> 4) & 1) * 16 + (lane & 3) * 4) * 2;
    const LAS char* fb1 = lds + R_F + wid * 256 + 16 * hi;
    asm volatile("s_waitcnt vmcnt(0)" ::: "memory");
    asm volatile("" : "+v"(qr[0]), "+v"(qr[1]), "+v"(qr[2]), "+v"(qr[3]), "+v"(fqp));
    asm volatile("s_waitcnt lgkmcnt(0)\n\ts_barrier" ::: "memory");
#define AP3_VFL(buf, ks, SLV) do { _Pragma("unroll") for (int d = 0; d < NDB; ++d) { buf[2 * d] = vtr(vb1 + (SLV) * VS + d * 4096 + (ks) * 1024); buf[2 * d + 1] = vtr(vb1 + (SLV) * VS + d * 4096 + (ks) * 1024 + 512); } } while (0)
#define AP3_VFL1(buf, d, ks, SLV) do { buf[2 * (d)] = vtr(vb1 + (SLV) * VS + (d) * 4096 + (ks) * 1024); buf[2 * (d) + 1] = vtr(vb1 + (SLV) * VS + (d) * 4096 + (ks) * 1024 + 512); } while (0)
#define AP3_FRAG(buf, d) ((bf16x8){buf[2 * (d)][0], buf[2 * (d)][1], buf[2 * (d)][2], buf[2 * (d)][3], buf[2 * (d) + 1][0], buf[2 * (d) + 1][1], buf[2 * (d) + 1][2], buf[2 * (d) + 1][3]})
#define AP3_GAP(ks, d, VCUR, VNXT, PC, BC, PP, BP, HASPREV, HASNEXT, SLV) do { \
        o[d] = __builtin_amdgcn_mfma_f32_32x32x16_bf16(__builtin_bit_cast(bf16x8, pwv[ks]), AP3_FRAG(VCUR, d), o[d], 0, 0, 0); \
        if (HASNEXT) AP3_VFL1(VNXT, d, (ks) + 1, SLV); \
        _Pragma("unroll") for (int e = 0; e < EPG; ++e) { PC[(BC) + EPG * (d) + e] = __builtin_amdgcn_exp2f(PC[(BC) + EPG * (d) + e]); } \
        if (HASPREV) { _Pragma("unroll") for (int e = 0; e < EPG; ++e) rs += PP[(BP) + EPG * (d) + e]; \
            _Pragma("unroll") for (int e = 0; e < EPG / 2; ++e) pwv[(ks) - 1][(EPG / 2) * (d) + e] = cvtpk_(PP[(BP) + EPG * (d) + 2 * e], PP[(BP) + EPG * (d) + 2 * e + 1]); AP3_PIN(rs); } \
        AP3_PIN(PC); \
        __builtin_amdgcn_sched_barrier(0); } while (0)
#define AP3_GROUP(ks, VCUR, VNXT, PC, BC, PP, BP, HASPREV, HASNEXT, SLV) do { _Pragma("unroll") for (int d = 0; d < NDB; ++d) AP3_GAP(ks, d, VCUR, VNXT, PC, BC, PP, BP, HASPREV, HASNEXT, SLV); } while (0)
#define AP3_OCT(PC, BC, KS) do { _Pragma("unroll") for (int e = 0; e < 8; ++e) { PC[(BC) + e] = __builtin_amdgcn_exp2f(PC[(BC) + e]); rs += PC[(BC) + e]; } \
        _Pragma("unroll") for (int e = 0; e < 4; ++e) pwv[KS][e] = cvtpk_(PC[(BC) + 2 * e], PC[(BC) + 2 * e + 1]); } while (0)
#define AP3_KRD(i, SL) (*(const LAS bf16x8*)(kb4[(i) >> 1] + (SL) * 8192 + ((i) & 1) * 4096))
#define AP3_MM(KF, d0, P) P = __builtin_amdgcn_mfma_f32_32x32x16_bf16(KF, qr[d0], P, 0, 0, 0)
#define AP3_QKF(SL) do { bf16x8 ka = AP3_KRD(0, SL), kb = AP3_KRD(1, SL), kc = AP3_KRD(2, SL); \
        if (MODE == 0) { \
            _Pragma("unroll") for (int g4 = 0; g4 < 4; ++g4) { const f32x4 fa = *(const LAS f32x4*)(fb1 + (SL) * 2048 + 32 * g4), fb = *(const LAS f32x4*)(fb1 + (SL) * 2048 + 128 + 32 * g4); \
                _Pragma("unroll") for (int e = 0; e < 4; ++e) { p0[4 * g4 + e] = fqp - fa[e]; p1[4 * g4 + e] = fqp - fb[e]; } } \
        } else { p0 = f32x16{}; p1 = f32x16{}; } \
        __builtin_amdgcn_sched_barrier(0); \
        AP3_MM(ka, 0, p0); ka = AP3_KRD(3, SL); __builtin_amdgcn_sched_barrier(0); \
        AP3_MM(kb, 0, p1); kb = AP3_KRD(4, SL); __builtin_amdgcn_sched_barrier(0); \
        AP3_MM(kc, 1, p0); kc = AP3_KRD(5, SL); __builtin_amdgcn_sched_barrier(0); \
        AP3_MM(ka, 1, p1); ka = AP3_KRD(6, SL); __builtin_amdgcn_sched_barrier(0); \
        AP3_MM(kb, 2, p0); kb = AP3_KRD(7, SL); __builtin_amdgcn_sched_barrier(0); \
        AP3_MM(kc, 2, p1); __builtin_amdgcn_sched_barrier(0); \
        AP3_MM(ka, 3, p0); __builtin_amdgcn_sched_barrier(0); \
        AP3_MM(kb, 3, p1); \
        asm volatile("" : "+v"(p0), "+v"(p1)); \
    } while (0)
#define AP3_QKS(SL) do { bf16x8 kf[8]; \
        _Pragma("unroll") for (int d0 = 0; d0 < 4; ++d0) { kf[2 * d0] = *(const LAS bf16x8*)(kb4[d0] + (SL) * 8192); kf[2 * d0 + 1] = *(const LAS bf16x8*)(kb4[d0] + (SL) * 8192 + 4096); } \
        if (MODE == 0) { const float sft = fqp - m_hat; \
            _Pragma("unroll") for (int g4 = 0; g4 < 4; ++g4) { const f32x4 fa = *(const LAS f32x4*)(fb1 + (SL) * 2048 + 32 * g4), fb = *(const LAS f32x4*)(fb1 + (SL) * 2048 + 128 + 32 * g4); \
                _Pragma("unroll") for (int e = 0; e < 4; ++e) { p0[4 * g4 + e] = sft - fa[e]; p1[4 * g4 + e] = sft - fb[e]; } } \
            _Pragma("unroll") for (int d0 = 0; d0 < 4; ++d0) { p0 = __builtin_amdgcn_mfma_f32_32x32x16_bf16(kf[2 * d0], qr[d0], p0, 0, 0, 0); p1 = __builtin_amdgcn_mfma_f32_32x32x16_bf16(kf[2 * d0 + 1], qr[d0], p1, 0, 0, 0); } \
        } else { \
            if constexpr (SREF) { p0 = __builtin_amdgcn_mfma_f32_32x32x16_bf16(kf[0], qr[0], f32x16{}, 0, 0, 0); p1 = __builtin_amdgcn_mfma_f32_32x32x16_bf16(kf[1], qr[0], f32x16{}, 0, 0, 0); } \
            else { p0 = __builtin_amdgcn_mfma_f32_32x32x16_bf16(kf[0], qr[0], negm, 0, 0, 0); p1 = __builtin_amdgcn_mfma_f32_32x32x16_bf16(kf[1], qr[0], negm, 0, 0, 0); } \
            _Pragma("unroll") for (int d0 = 1; d0 < 4; ++d0) { p0 = __builtin_amdgcn_mfma_f32_32x32x16_bf16(kf[2 * d0], qr[d0], p0, 0, 0, 0); p1 = __builtin_amdgcn_mfma_f32_32x32x16_bf16(kf[2 * d0 + 1], qr[d0], p1, 0, 0, 0); } } \
        if constexpr (SREF) asm volatile("" : "+v"(p0), "+v"(p1)); else asm volatile("s_nop 15\n\ts_nop 7" : "+v"(p0), "+v"(p1));     \
    } while (0)
#define AP3_QK(SL) do { if constexpr (SREF) AP3_QKF(SL); else AP3_QKS(SL); } while (0)
#define AP3_DECIDE(WITH_TAB) do { \
        if (MODE == 0) { \
            if (t * 64 + 63 > q0 + wid * 32) { const int ln_ = lane_id_opaque(), kv0 = t * 64 + 4 * (ln_ >> 5), qrow_ = q0 + wid * 32 + (ln_ & 31);     \
                _Pragma("unroll") for (int r = 0; r < 16; ++r) { const int kv = kv0 + (r & 3) + 8 * (r >> 2); if (kv > qrow_) p0[r] = -1e30f; if (kv + 32 > qrow_) p1[r] = -1e30f; } } \
        } else if (WITH_TAB) { \
            if (near) { const int ln_ = lane_id_opaque(), kv0 = t * 64 + 4 * (ln_ >> 5), qrow_ = q0 + wid * 32 + (ln_ & 31); const LAS float* tab_ = (const LAS float*)(F.lds + AT_TAB) + hb * 192; \
                _Pragma("unroll") for (int g4 = 0; g4 < 4; ++g4) { \
                    _Pragma("unroll") for (int e = 0; e < 4; ++e) { const int r = 4 * g4 + e; const int rel = kv0 + e + 8 * g4 - qrow_; int i0 = rel + 128, i1 = rel + 160; i0 = i0 < 0 ? 0 : i0; i1 = i1 < 0 ? 0 : i1; \
                        p0[r] += tab_[i0]; p1[r] += tab_[i1]; } \
                    __builtin_amdgcn_sched_barrier(0); } } } \
        if constexpr (!SREF) { \
        float ma = max3f_(p0[0], p0[1], p1[0]), mb = max3f_(p0[2], p0[3], p1[1]); ma = max3f_(ma, p1[2], p1[3]); \
        _Pragma("unroll") for (int r = 4; r < 16; r += 4) { ma = max3f_(ma, p0[r], p0[r + 1]); mb = max3f_(mb, p0[r + 2], p0[r + 3]); ma = max3f_(ma, p1[r], p1[r + 1]); mb = max3f_(mb, p1[r + 2], p1[r + 3]); } \
        float rm = max2f_(ma, mb); \
        { auto rr = __builtin_amdgcn_permlane32_swap(__float_as_uint(rm), __float_as_uint(rm), false, false); rm = max2f_(__uint_as_float(rr[0]), __uint_as_float(rr[1])); } \
        resc = (tz == t0) || __any(rm > THR); \
        if (resc) { const float dl = tz == t0 ? rm : fmaxf(rm, 0.f); m_hat += dl; \
            _Pragma("unroll") for (int r = 0; r < 16; ++r) { p0[r] -= dl; p1[r] -= dl; } \
            if (MODE == 1) { const float nm_ = -m_hat; _Pragma("unroll") for (int r = 0; r < 16; ++r) negm[r] = nm_; } \
            al = tz == t0 ? 1.0f : __builtin_amdgcn_exp2f(-dl); l_run *= al; } } } while (0)
#define AP3_STEP(tt, SL) do { const int t = (tt); if (t > NT) break; int tz = t; asm volatile("" : "+s"(tz)); \
        if (t < NT) AP_BATCH(t, SL); \
        const bool doPV = tz > t0 && t - 1 <= tmaxw, doQK = t < NT && t <= tmaxw; \
        bool resc = false; float al = 1.0f, rs = 0.f; \
        const bool near = MODE == 1 && (t * 64 + 63 + 91 > q0 + wid * 32); \
        if (doQK) AP3_QK(SL); else { p0 = f32x16{}; p1 = f32x16{}; }     \
        __builtin_amdgcn_sched_barrier(0); \
        if (doQK) AP3_DECIDE(true); \
        __builtin_amdgcn_sched_barrier(0); \
        if (doPV) { s16x4 vfa[2 * NDB]; AP3_VFL(vfa, 0, ((SL) + 2) % 3);     \
            AP3_GROUP(0, vfa, vfa, p0, 0, p0, 0, false, true, ((SL) + 2) % 3); \
            AP3_GROUP(1, vfa, vfa, p0, 8, p0, 0, true, true, ((SL) + 2) % 3); \
            AP3_GROUP(2, vfa, vfa, p1, 0, p0, 8, true, true, ((SL) + 2) % 3); \
            AP3_GROUP(3, vfa, vfa, p1, 8, p1, 0, true, false, ((SL) + 2) % 3); \
            _Pragma("unroll") for (int e = 0; e < 8; ++e) rs += p1[8 + e]; \
            _Pragma("unroll") for (int e = 0; e < 4; ++e) pwv[3][e] = cvtpk_(p1[8 + 2 * e], p1[8 + 2 * e + 1]); \
        } else if (doQK) { AP3_OCT(p0, 0, 0); AP3_OCT(p0, 8, 1); AP3_OCT(p1, 0, 2); AP3_OCT(p1, 8, 3); } \
        if (doQK) l_run += rs; \
          \
        if (resc && tz > t0) { \
            if (hi == 0) wsf[r32] = al; \
            asm volatile("s_waitcnt lgkmcnt(0)" ::: "memory"); \
            _Pragma("unroll") for (int g4 = 0; g4 < 4; ++g4) { const f32x4 a4 = *(const LAS f32x4*)(wsf + 8 * g4 + 4 * hi); \
                _Pragma("unroll") for (int d = 0; d < NDB; ++d) \
                    _Pragma("unroll") for (int e = 0; e < 4; ++e) o[d][4 * g4 + e] *= a4[e]; } } \
        if (t == NT) break; \
        if (pv == 6) { if (t + 2 < NT) asm volatile("s_waitcnt vmcnt(3) lgkmcnt(0)" ::: "memory"); else asm volatile("s_waitcnt vmcnt(0) lgkmcnt(0)" ::: "memory"); } \
        else { if (t + 2 < NT) asm volatile("s_waitcnt vmcnt(3) lgkmcnt(0)\n\ts_barrier" ::: "memory"); else asm volatile("s_waitcnt vmcnt(0) lgkmcnt(0)\n\ts_barrier" ::: "memory"); } \
    } while (0)
#define AP3_FSTEP(tt, SL) do { const int t = (tt); \
        AP_ISSUE_K(t + 2, ((SL) + 2) % 3); AP_ISSUE_V(t + 1, ((SL) + 1) % 3); \
        float rs = 0.f; \
        AP3_QKF(SL); \
        __builtin_amdgcn_sched_barrier(0); \
        { s16x4 vfa[2 * NDB]; AP3_VFL(vfa, 0, ((SL) + 2) % 3); \
          AP3_GROUP(0, vfa, vfa, p0, 0, p0, 0, false, true, ((SL) + 2) % 3); \
          AP3_GROUP(1, vfa, vfa, p0, 8, p0, 0, true, true, ((SL) + 2) % 3); \
          AP3_GROUP(2, vfa, vfa, p1, 0, p0, 8, true, true, ((SL) + 2) % 3); \
          AP3_GROUP(3, vfa, vfa, p1, 8, p1, 0, true, false, ((SL) + 2) % 3); \
          _Pragma("unroll") for (int e = 0; e < 8; ++e) rs += p1[8 + e]; \
          _Pragma("unroll") for (int e = 0; e < 4; ++e) pwv[3][e] = cvtpk_(p1[8 + 2 * e], p1[8 + 2 * e + 1]); } \
        l_run += rs; \
        asm volatile("s_waitcnt vmcnt(3) lgkmcnt(0)\n\ts_barrier" ::: "memory"); \
    } while (0)
    if (wid >= 4) __builtin_amdgcn_s_setprio(1);
    int t3 = t0;
    if constexpr (SREF && pv == 0) {
        AP3_STEP(t3, 0); AP3_STEP(t3 + 1, 1); AP3_STEP(t3 + 2, 2); t3 += 3;
        const int tfe = (q0 >> 6) - 3;
        for (; t3 + 2 <= tfe; t3 += 3) { AP3_FSTEP(t3, 0); AP3_FSTEP(t3 + 1, 1); AP3_FSTEP(t3 + 2, 2); }
    }
    for (; t3 <= NT; t3 += 3) { AP3_STEP(t3, 0); AP3_STEP(t3 + 1, 1); AP3_STEP(t3 + 2, 2); }
    if (wid >= 4) __builtin_amdgcn_s_setprio(0);
    asm volatile("s_waitcnt lgkmcnt(0)\n\ts_barrier" ::: "memory");
    l_run += __shfl_xor(l_run, 32);
    if (hi == 0) wsf[r32] = 1.0f / l_run;
    asm volatile("s_waitcnt lgkmcnt(0)" ::: "memory");
#pragma unroll
    for (int g4 = 0; g4 < 4; ++g4) { const f32x4 a4 = *(const LAS f32x4*)(wsf + 8 * g4 + 4 * hi);
#pragma unroll
        for (int d = 0; d < NDB; ++d)
#pragma unroll
            for (int e = 0; e < 4; ++e) o[d][4 * g4 + e] *= a4[e]; }
#undef AP_ISSUE_K
#undef AP_ISSUE_V
#undef AP_BATCH
#undef AP3_VFL
#undef AP3_VFL1
#undef AP3_FRAG
#undef AP3_GAP
#undef AP3_GROUP
#undef AP3_OCT
#undef AP3_STEP
#undef AP3_FSTEP
#undef AP3_QK
#undef AP3_QKF
#undef AP3_QKS
#undef AP3_KRD
#undef AP3_MM
#undef AP3_DECIDE
}

template <int NDB> __device__ __forceinline__ void store_o(const f32x16 (&o)[NDB], LAS unsigned char* stgb  , bf16_t* dst  , int ld, int lane) {
    const int r32 = lane & 31, hi = lane >> 5;
    constexpr int DVC = 32 * NDB;
    LAS bf16_t* stg = (LAS bf16_t*)stgb;
#pragma unroll
    for (int d = 0; d < NDB; ++d)
#pragma unroll
        for (int r = 0; r < 16; ++r) { const int row = (r & 3) + 8 * (r >> 2) + 4 * hi; stg[row * DVC + 32 * d + r32] = (bf16_t)f2bf(o[d][r]); }
    asm volatile("s_waitcnt lgkmcnt(0)" ::: "memory");
    constexpr int CPR = DVC / 8;
#pragma unroll
    for (int i = 0; i < (32 * CPR) / 64; ++i) { const int c = i * 64 + lane, row = c / CPR, ch = c % CPR;
        const u32x4 v = *(const LAS u32x4*)(stg + row * DVC + ch * 8); *(u32x4*)(dst + (size_t)row * ld + ch * 8) = v; }
    asm volatile("s_waitcnt lgkmcnt(0)" ::: "memory");
}

__device__ __forceinline__ float lambda_full(Frame& F) {
    float a = 0.f, b = 0.f;
    for (int i = 0; i < 64; ++i) { a += F.in[I_LQ1][i] * F.in[I_LK1][i]; b += F.in[I_LQ2][i] * F.in[I_LK2][i]; }
    return __expf(a) - __expf(b) + 0.2f;
}

template <int pv = 0> __device__ __forceinline__ void attn_prompt_fox(Frame& F, int h, int qb) {
    const bf16_t* Q = (const bf16_t*)(F.ws + WS_QB) + h * 64; const bf16_t* K = (const bf16_t*)(F.ws + WS_KB) + h * 64; const bf16_t* V = (const bf16_t*)(F.ws + WS_VB) + h * 64;
    f32x16 o[2];
    const float* Fh = (const float*)(F.ws + WS_FP) + (size_t)h * SEQ;
    int t0 = 0; bool fast;
    { const unsigned* nw = (const unsigned*)(F.ws + WS_CTL) + 256;
      const float qn2 = __uint_as_float(nw[h * 2]) + __uint_as_float(nw[h * 2 + 1]), kn2 = __uint_as_float(nw[16 + h * 2]) + __uint_as_float(nw[16 + h * 2 + 1]);
      const float B = sqrtf(qn2 * kn2) * 1.02f + 0.5f;
      const float thresh = -48.0f - 2.0f * B;
      fast = __builtin_amdgcn_readfirstlane(B <= 60.0f ? 1 : 0) != 0;
      volatile LAS int* cnt = (volatile LAS int*)(F.lds + AT_MISC + 32);
      __syncthreads();
      if (F.tid < 256) { const int t = F.tid; const bool sk = t < 4 * qb && (Fh[qb * 256] - Fh[64 * t + 63]) <= thresh;
          const int c = __popcll(__ballot(sk)); if (F.lane == 0) cnt[F.wave] = c; }
      __syncthreads();
      t0 = cnt[0] + cnt[1] + cnt[2] + cnt[3]; t0 -= t0 % 3; }
    if (fast) attn_pass3<0, 64, pv, true>(F, Q, K, V, qb * 256, 4 * qb + 4, Fh, 0, o, t0); else attn_pass3<0, 64, pv, false>(F, Q, K, V, qb * 256, 4 * qb + 4, Fh, 0, o, t0);
    if (pv != 0 && o[0][0] != 1234.5678f) { __syncthreads(); return; }
    bf16_t* AB = (bf16_t*)(F.ws + WS_AB);
    store_o<2>(o, F.lds + F.wave * 8192, AB + (size_t)(qb * 256 + F.wave * 32) * DM + 512 + h * 64, DM, F.lane);
    __syncthreads();
}
template <int pv = 0> __device__ __forceinline__ void attn_prompt_diff_half(Frame& F, int h, int half, int qb) {
    const bf16_t* Q = (const bf16_t*)(F.ws + WS_QA) + h * 128 + 64 * half; const bf16_t* K = (const bf16_t*)(F.ws + WS_KA) + h * 128 + 64 * half; const bf16_t* V = (const bf16_t*)(F.ws + WS_VA) + h * 128;
    f32x16 o[4];
    bool fast;
    { const unsigned* nw = (const unsigned*)(F.ws + WS_CTL) + 288; const int hh = h * 2 + half;
      const float qn2 = __uint_as_float(nw[hh * 2]) + __uint_as_float(nw[hh * 2 + 1]), kn2 = __uint_as_float(nw[16 + hh * 2]) + __uint_as_float(nw[16 + hh * 2 + 1]);
      float bm = 0.f; for (int b = 0; b < 32; ++b) bm = fmaxf(bm, fabsf(F.in[I_RELB][b * 4 + h] - F.in[I_RELB][15 * 4 + h]));
      const float B = sqrtf(qn2 * kn2) * 1.02f + 0.5f + bm * LOG2E;
      fast = __builtin_amdgcn_readfirstlane(B <= 60.0f ? 1 : 0) != 0; }
    if (fast) attn_pass3<1, 128, pv, true>(F, Q, K, V, qb * 256, 4 * qb + 4, nullptr, h, o); else attn_pass3<1, 128, pv, false>(F, Q, K, V, qb * 256, 4 * qb + 4, nullptr, h, o);
    if (pv != 0 && o[0][0] != 1234.5678f) { __syncthreads(); return; }
    bf16_t* OD = (bf16_t*)(F.ws + (half ? WS_OD2 : WS_OD1));
    store_o<4>(o, F.lds + F.wave * 8192, OD + (size_t)(qb * 256 + F.wave * 32) * 512 + h * 128, 512, F.lane);
    __syncthreads();
}
constexpr int PF_STR = 66, PD_STR = 130;
__device__ __forceinline__ void p_combine(Frame& F) {
    const float lam = lambda_full(F);
    const bf16_t* O1 = (const bf16_t*)(F.ws + WS_OD1); const bf16_t* O2 = (const bf16_t*)(F.ws + WS_OD2); bf16_t* AB = (bf16_t*)(F.ws + WS_AB);
    const int gw = F.bid * 8 + F.wave, NGW = F.G * 8;
    const int c0 = 8 * F.lane;
    float sg[8];
#pragma unroll
    for (int i = 0; i < 8; ++i) sg[i] = F.in[I_SUBG][(c0 & 127) + i] * 0.8f;
    for (int m = gw; m < SEQ; m += NGW) {
        const u32x4 a = *(const u32x4*)(O1 + (size_t)m * 512 + c0), b = *(const u32x4*)(O2 + (size_t)m * 512 + c0);
        float v[8];
        v[0] = bflo(a.x) - lam * bflo(b.x); v[1] = bfhi(a.x) - lam * bfhi(b.x); v[2] = bflo(a.y) - lam * bflo(b.y); v[3] = bfhi(a.y) - lam * bfhi(b.y);
        v[4] = bflo(a.z) - lam * bflo(b.z); v[5] = bfhi(a.z) - lam * bfhi(b.z); v[6] = bflo(a.w) - lam * bflo(b.w); v[7] = bfhi(a.w) - lam * bfhi(b.w);
        float ss = 0.f;
#pragma unroll
        for (int i = 0; i < 8; ++i) ss += v[i] * v[i];
#pragma unroll
        for (int ofs = 1; ofs < 16; ofs <<= 1) ss += __shfl_xor(ss, ofs);
        const float rn = 1.0f / sqrtf(ss * (1.0f / 128.0f) + LN_EPS);
        u32x4 w; w.x = pk2(v[0] * rn * sg[0], v[1] * rn * sg[1]); w.y = pk2(v[2] * rn * sg[2], v[3] * rn * sg[3]); w.z = pk2(v[4] * rn * sg[4], v[5] * rn * sg[5]); w.w = pk2(v[6] * rn * sg[6], v[7] * rn * sg[7]);
        *(u32x4*)(AB + (size_t)m * DM + c0) = w;
    }
    for (int it = gw; it < NSMP; it += NGW) {
        const int b = it >> 4, q = it & 15; const size_t row = (size_t)SEQ + it;
        {
            const int h = F.lane >> 3, cc = (F.lane & 7) * 8; const float* P = (const float*)(F.ws + WS_PF);
            float M = -1e30f;
            for (int s = 0; s < 8; ++s) M = fmaxf(M, P[((size_t)((b * 8 + s) * 8 + h) * 16 + q) * PF_STR + 64]);
            float acc[8], L = 0.f;
#pragma unroll
            for (int i = 0; i < 8; ++i) acc[i] = 0.f;
            for (int s = 0; s < 8; ++s) { const float* pr = P + ((size_t)((b * 8 + s) * 8 + h) * 16 + q) * PF_STR; const float wgt = __builtin_amdgcn_exp2f(pr[64] - M); L += wgt * pr[65];
#pragma unroll
                for (int i = 0; i < 8; ++i) acc[i] += wgt * pr[cc + i]; }
            const float inv = 1.0f / L;
            u32x4 w; w.x = pk2(acc[0] * inv, acc[1] * inv); w.y = pk2(acc[2] * inv, acc[3] * inv); w.z = pk2(acc[4] * inv, acc[5] * inv); w.w = pk2(acc[6] * inv, acc[7] * inv);
            *(u32x4*)(AB + row * DM + 512 + c0) = w; }
        {
            const int h = F.lane >> 4, cc = (F.lane & 15) * 8; const float* P = (const float*)(F.ws + WS_PD);
            float v[8];
#pragma unroll
            for (int i = 0; i < 8; ++i) v[i] = 0.f;
#pragma unroll
            for (int half = 0; half < 2; ++half) {
                float M = -1e30f;
                for (int s = 0; s < 8; ++s) M = fmaxf(M, P[((size_t)((b * 8 + s) * 8 + 2 * h + half) * 16 + q) * PD_STR + 128]);
                float acc[8], L = 0.f;
#pragma unroll
                for (int i = 0; i < 8; ++i) acc[i] = 0.f;
                for (int s = 0; s < 8; ++s) { const float* pr = P + ((size_t)((b * 8 + s) * 8 + 2 * h + half) * 16 + q) * PD_STR; const float wgt = __builtin_amdgcn_exp2f(pr[128] - M); L += wgt * pr[129];
#pragma unroll
                    for (int i = 0; i < 8; ++i) acc[i] += wgt * pr[cc + i]; }
                const float sc = (half ? -lam : 1.0f) / L;
#pragma unroll
                for (int i = 0; i < 8; ++i) v[i] += acc[i] * sc; }
            float ss = 0.f;
#pragma unroll
            for (int i = 0; i < 8; ++i) ss += v[i] * v[i];
#pragma unroll
            for (int ofs = 1; ofs < 16; ofs <<= 1) ss += __shfl_xor(ss, ofs);
            const float rn = 1.0f / sqrtf(ss * (1.0f / 128.0f) + LN_EPS);
            u32x4 w; w.x = pk2(v[0] * rn * sg[0], v[1] * rn * sg[1]); w.y = pk2(v[2] * rn * sg[2], v[3] * rn * sg[3]); w.z = pk2(v[4] * rn * sg[4], v[5] * rn * sg[5]); w.w = pk2(v[6] * rn * sg[6], v[7] * rn * sg[7]);
            *(u32x4*)(AB + row * DM + c0) = w; }
    }
}

constexpr int SM_K = 0, SM_V = 32768, SM_F = 81920, SM_WS = 83968;
template <int KIND  > __device__ __forceinline__ void sample_unit(Frame& F, int b, int s) {
    constexpr int DV = KIND == 0 ? 64 : 128, NDB = DV / 32, VSTR = KIND == 0 ? 192 : 320, VSUB = 16 * VSTR;
    const int lane = lane_id_opaque(), r32 = lane & 31, hi = lane >> 5, w = F.wave, tid = w * 64 + lane;
    const LAS char* lds = (const LAS char*)F.lds;
    LAS float* wsf = (LAS float*)(F.lds + SM_WS) + w * 64;
    const int hb = KIND == 0 ? w : (w >> 1);
    const LAS float* tab = (const LAS float*)(F.lds + AT_TAB) + hb * 192;
    const int q = r32 & 15, qpos = PAST + q;
    const size_t qrow = (size_t)SEQ + b * DEC_T + q;
    const bf16_t* Qp = (const bf16_t*)(F.ws + (KIND == 0 ? WS_QB : WS_QA)) + qrow * 512 + w * 64;
    bf16x8 qr[4];
#pragma unroll
    for (int d0 = 0; d0 < 4; ++d0) qr[d0] = *(const bf16x8*)(Qp + d0 * 16 + hi * 8);
    const float* Fs = (const float*)(F.ws + WS_FS) + (size_t)(b * 8 + w) * SKV;
    const float fq = KIND == 0 ? Fs[qpos] : 0.f;
    const float* Kc = F.in[KIND == 0 ? I_CFK : I_CDK] + (size_t)b * PAST * 512; const float* Vc = F.in[KIND == 0 ? I_CFV : I_CDV] + (size_t)b * PAST * 512;
    const float* Kn = F.out + (KIND == 0 ? O_FKS : O_DKS) + (size_t)b * DEC_T * 512; const float* Vn = F.out + (KIND == 0 ? O_FVS : O_DVS) + (size_t)b * DEC_T * 512;
    const int kr = tid >> 5, c16 = (tid & 31) * 16;
    const int ksub = c16 >> 6, kch = (c16 >> 3) & 7;
    const int kdst = SM_K + ksub * 4096 + kr * 128;
    const int vdst = KIND == 0 ? SM_V + ksub * VSUB + kr * VSTR + kch * 16 : SM_V + (c16 >> 7) * VSUB + kr * VSTR + ((c16 >> 3) & 15) * 16;
    f32x16 o[NDB];
#pragma unroll
    for (int d = 0; d < NDB; ++d) o[d] = f32x16{};
    float m_run = -1e30f, l_run = 0.f;
    f32x4 gkA[4], gvA[4], gkB[4], gvB[4]; float gfA = 0.f, gfB = 0.f;
    const int nt = s == 0 ? 17 : 16;
    auto gload = [&](f32x4 (&gk)[4], f32x4 (&gv)[4], float& gf, int t) {
        const float* ks; const float* vs;
        if (t < 128) { ks = Kc + (size_t)(16 * t + kr) * 512 + c16; vs = Vc + (size_t)(16 * t + kr) * 512 + c16; }
        else { ks = Kn + (size_t)kr * 512 + c16; vs = Vn + (size_t)kr * 512 + c16; }
#pragma unroll
        for (int j = 0; j < 4; ++j) { gk[j] = *(const f32x4*)(ks + 4 * j); gv[j] = *(const f32x4*)(vs + 4 * j); }
        if (KIND == 0 && tid < 128) gf = ((const float*)(F.ws + WS_FS))[(size_t)(b * 8 + (tid >> 4)) * SKV + 16 * t + (tid & 15)];
    };
    auto lwrite = [&](const f32x4 (&gk)[4], const f32x4 (&gv)[4], float gf) {
#pragma unroll
        for (int j = 0; j < 2; ++j) { u32x4 wk, wv;
            wk.x = pk2(gk[2 * j][0], gk[2 * j][1]); wk.y = pk2(gk[2 * j][2], gk[2 * j][3]); wk.z = pk2(gk[2 * j + 1][0], gk[2 * j + 1][1]); wk.w = pk2(gk[2 * j + 1][2], gk[2 * j + 1][3]);
            wv.x = pk2(gv[2 * j][0], gv[2 * j][1]); wv.y = pk2(gv[2 * j][2], gv[2 * j][3]); wv.z = pk2(gv[2 * j + 1][0], gv[2 * j + 1][1]); wv.w = pk2(gv[2 * j + 1][2], gv[2 * j + 1][3]);
            *(LAS u32x4*)(F.lds + kdst + (((kch + j) ^ (kr & 7)) << 4)) = wk;
            *(LAS u32x4*)(F.lds + vdst + j * 16) = wv; }
        if (KIND == 0 && tid < 128) ((LAS float*)(F.lds + SM_F))[tid] = gf;
    };
    gload(gkA, gvA, gfA, s); gload(gkB, gvB, gfB, s + 8);
    __syncthreads();
    { const int sub = tid >> 6, rr = 16 + ((tid >> 2) & 15), cq = (tid & 3) * 32;
      *(LAS u32x4*)(F.lds + SM_K + sub * 4096 + rr * 128 + cq) = (u32x4){0u, 0u, 0u, 0u}; *(LAS u32x4*)(F.lds + SM_K + sub * 4096 + rr * 128 + cq + 16) = (u32x4){0u, 0u, 0u, 0u}; }
    const int vb = SM_V + (KIND == 0 ? w : (w >> 1)) * VSUB + (4 * hi + ((lane & 15) >> 2)) * VSTR + (((lane >> 4) & 1) * 16 + (lane & 3) * 4) * 2;
    auto compute = [&](int t) {
        f32x16 p0 = f32x16{};
#pragma unroll
        for (int d0 = 0; d0 < 4; ++d0) { const bf16x8 kf = *(const LAS bf16x8*)(lds + SM_K + w * 4096 + r32 * 128 + (((2 * d0 + hi) ^ (r32 & 7)) << 4));
            p0 = __builtin_amdgcn_mfma_f32_32x32x16_bf16(kf, qr[d0], p0, 0, 0, 0); }
        const int kv0 = 16 * t + 4 * hi;
        float x[8];
        if (KIND == 0) {
#pragma unroll
            for (int g4 = 0; g4 < 2; ++g4) { const f32x4 fa = *(const LAS f32x4*)(lds + SM_F + (w * 16 + 4 * hi + 8 * g4) * 4);
#pragma unroll
                for (int e = 0; e < 4; ++e) x[4 * g4 + e] = p0[4 * g4 + e] + (fq - fa[e]); }
            if (t == 128) {
#pragma unroll
                for (int r = 0; r < 8; ++r) { const int kv = kv0 + (r & 3) + 8 * (r >> 2); if (kv > qpos) x[r] = -1e30f; } }
        } else {
            if (t < 120) {
#pragma unroll
                for (int r = 0; r < 8; ++r) x[r] = p0[r];
            } else {
#pragma unroll
                for (int r = 0; r < 8; ++r) { const int kv = kv0 + (r & 3) + 8 * (r >> 2); int i0 = kv - qpos + 128; i0 = i0 < 0 ? 0 : i0; x[r] = p0[r] + tab[i0]; } }
        }
        float rm = x[0];
#pragma unroll
        for (int r = 1; r < 8; ++r) rm = fmaxf(rm, x[r]);
        rm = fmaxf(rm, __shfl_xor(rm, 32));
        const float m_new = fmaxf(m_run, rm);
        if (__any(m_new > m_run)) { const float al = __builtin_amdgcn_exp2f(m_run - m_new); l_run *= al; m_run = m_new;
            if (hi == 0) wsf[r32] = al;
            asm volatile("s_waitcnt lgkmcnt(0)" ::: "memory");
#pragma unroll
            for (int g4 = 0; g4 < 2; ++g4) { const f32x4 a4 = *(const LAS f32x4*)(wsf + 8 * g4 + 4 * hi);
#pragma unroll
                for (int d = 0; d < NDB; ++d)
#pragma unroll
                    for (int e = 0; e < 4; ++e) o[d][4 * g4 + e] *= a4[e]; } }
        float rs = 0.f;
#pragma unroll
        for (int r = 0; r < 8; ++r) { x[r] = __builtin_amdgcn_exp2f(x[r] - m_run); rs += x[r]; }
        l_run += rs;
        u32x4 w0; w0.x = pg8::cvt_pk_bf16(x[0], x[1]); w0.y = pg8::cvt_pk_bf16(x[2], x[3]); w0.z = pg8::cvt_pk_bf16(x[4], x[5]); w0.w = pg8::cvt_pk_bf16(x[6], x[7]);
        const bf16x8 pa = __builtin_bit_cast(bf16x8, w0);
#pragma unroll
        for (int d = 0; d < NDB; ++d) { const LAS char* vp = lds + vb + d * 64;
            const s16x4 lo = vtr(vp), hi4 = vtr(vp + 8 * VSTR);
            const bf16x8 vf = (bf16x8){lo[0], lo[1], lo[2], lo[3], hi4[0], hi4[1], hi4[2], hi4[3]};
            o[d] = __builtin_amdgcn_mfma_f32_32x32x16_bf16(pa, vf, o[d], 0, 0, 0); }
    };
    for (int i = 0; i < nt; i += 2) {
        const int t = s + 8 * i;
        lwrite(gkA, gvA, gfA); __syncthreads();
        if (i + 2 < nt) gload(gkA, gvA, gfA, t + 16);
        compute(t);
        __syncthreads();
        if (i + 1 >= nt) break;
        lwrite(gkB, gvB, gfB); __syncthreads();
        if (i + 3 < nt) gload(gkB, gvB, gfB, t + 24);
        compute(t + 8);
        __syncthreads();
    }
    l_run += __shfl_xor(l_run, 32);
    float* P = (float*)(F.ws + (KIND == 0 ? WS_PF : WS_PD)) + ((size_t)((b * 8 + s) * 8 + w) * 16) * (DV + 2);
    { float* P0 = P + (size_t)(4 * hi) * (DV + 2) + r32; float* P1 = P0 + 8 * (DV + 2);
#pragma unroll
      for (int d = 0; d < NDB; ++d)
#pragma unroll
          for (int r = 0; r < 4; ++r) { P0[r * (DV + 2) + 32 * d] = o[d][r]; P1[r * (DV + 2) + 32 * d] = o[d][4 + r]; } }
    if (lane < 16) { P[(size_t)lane * (DV + 2) + DV] = m_run; P[(size_t)lane * (DV + 2) + DV + 1] = l_run; }
}

template <int pv = 0> __device__ __forceinline__ void p3_attention(Frame& F, int mask) {
    LAS float* tab = (LAS float*)(F.lds + AT_TAB);
    for (int i = F.tid; i < 4 * 192; i += 512) { const int h = i / 192, rel = (i % 192) - 128; tab[i] = (F.in[I_RELB][t5_bucket(rel) * 4 + h] - F.in[I_RELB][15 * 4 + h]) * LOG2E; }
    const float lam = lambda_full(F);
    __syncthreads();
    const int x = F.bid & 7, p = (F.bid >> 3) & 31;
    const int spos = F.G == 256 ? (x + p) % 5 : 4;
    for (int j = 0; j < 5; ++j) {
        F.lane = lane_id_opaque(); F.tid = F.wave * 64 + F.lane;
        if (j == spos) {
            if (mask & 4) {
                for (int u = F.bid; u < 256; u += F.G) {
                    F.lane = lane_id_opaque(); F.tid = F.wave * 64 + F.lane;
                    if ((u >> 3) & 1) sample_unit<1>(F, u >> 4, u & 7); else sample_unit<0>(F, u >> 4, u & 7);
                }
            }
        } else if (F.bid < 256) {
            const int i = j - (j > spos ? 1 : 0);
            const int qb = (i & 1) ? p : 63 - p;
            if (i < 2) { if (mask & 1) attn_prompt_diff_half<pv>(F, x >> 1, x & 1, qb); }
            else { if (mask & 2) attn_prompt_fox<pv>(F, x, qb); }
        }
    }
}

#define XB_TMO      128
#define XB_XCNT(j)  (256  + 64 * (j))
#define XB_XSUB(j)  (1280 + 64 * (j))
#define XB_XGEN(j)  (2304 + 64 * (j))
#define XB_TOP      3328
#define XB_TOPGEN   3392
#define XCD_BAR_WORDS 3456
#define XB_SPIN_CAP (1u << 20)
__device__ __forceinline__ unsigned xb_ld(unsigned* p)              { return __hip_atomic_load(p, __ATOMIC_RELAXED, __HIP_MEMORY_SCOPE_AGENT); }
__device__ __forceinline__ unsigned xb_add(unsigned* p, unsigned v) { return __hip_atomic_fetch_add(p, v, __ATOMIC_RELAXED, __HIP_MEMORY_SCOPE_AGENT); }
__device__ __forceinline__ unsigned xb_xcc_id() { return (unsigned)__builtin_amdgcn_s_getreg((3 << 11) | 20) & 0xFu; }
#define XB_SPIN(cond, bar) do { unsigned _sp = 0; while (cond) { __builtin_amdgcn_s_sleep(1); \
    if ((++_sp & 255u) == 0u) { if (xb_ld(&(bar)[XB_TMO])) break; if (_sp > XB_SPIN_CAP) { atomicAdd(&(bar)[XB_TMO], 1u); break; } } } } while (0)
struct XcdBarrier { unsigned* bar; unsigned x; volatile LAS unsigned* st; };
__device__ __forceinline__ XcdBarrier xcd_barrier_post(unsigned* bar, volatile LAS unsigned* st) {
    XcdBarrier b; b.bar = bar; b.x = xb_xcc_id(); b.st = st;
    if (threadIdx.x == 0) (void)xb_add(&bar[XB_XCNT(b.x)], 1u);
    return b;
}
__device__ __forceinline__ void xcd_barrier_complete(unsigned* bar, unsigned x, unsigned& nloc, unsigned& nx) {
    const unsigned G = gridDim.x * gridDim.y * gridDim.z;
    unsigned sum, cnt, mine, sp = 0u;
    for (;;) {
        sum = 0u; cnt = 0u; mine = 0u;
#pragma unroll
        for (unsigned j = 0; j < 16; ++j) { const unsigned c = xb_ld(&bar[XB_XCNT(j)]); sum += c; cnt += (c > 0u) ? 1u : 0u; mine = (j == x) ? c : mine; }
        if (sum == G) break;
        __builtin_amdgcn_s_sleep(1);
        if ((++sp & 255u) == 0u) { if (xb_ld(&bar[XB_TMO])) break; if (sp > XB_SPIN_CAP) { atomicAdd(&bar[XB_TMO], 1u); break; } }
    }
    nloc = mine > 0u ? mine : 1u; nx = cnt > 0u ? cnt : 1u;
}
__device__ __forceinline__ void xcd_barrier(const XcdBarrier& b) {
    asm volatile("s_waitcnt vmcnt(0)" ::: "memory");
    __syncthreads();
    if (threadIdx.x == 0) {
        unsigned* bar = b.bar;
        __builtin_amdgcn_s_waitcnt(0);
        unsigned nloc = b.st[0], nx = b.st[1];
        if (nloc == 0u) { xcd_barrier_complete(bar, b.x, nloc, nx); b.st[0] = nloc; b.st[1] = nx; }
        const unsigned old = xb_add(&bar[XB_XSUB(b.x)], 1u);
        const unsigned gen = old / nloc;
        if (old + 1u == (gen + 1u) * nloc) {
            __builtin_amdgcn_fence(__ATOMIC_RELEASE, "agent");
            asm volatile("s_waitcnt vmcnt(0)" ::: "memory");
            const unsigned og = xb_add(&bar[XB_TOP], 1u);
            const unsigned tg = og / nx;
            if (og + 1u == (tg + 1u) * nx) xb_add(&bar[XB_TOPGEN], 1u);
            else XB_SPIN(xb_ld(&bar[XB_TOPGEN]) == tg, bar);
            __builtin_amdgcn_fence(__ATOMIC_ACQUIRE, "agent");
            xb_add(&bar[XB_XGEN(b.x)], 1u);
            asm volatile("s_waitcnt vmcnt(0)" ::: "memory");
        } else {
            XB_SPIN(xb_ld(&bar[XB_XGEN(b.x)]) == gen, bar);
            __builtin_amdgcn_fence(__ATOMIC_ACQUIRE, "agent");
            asm volatile("s_waitcnt vmcnt(0)" ::: "memory");
        }
    }
    __syncthreads();
}

__global__ void __launch_bounds__(512, 2) mega_fwd(Args args) {
    extern __shared__ __attribute__((aligned(16))) unsigned char lds_raw[];
    Frame F;
    F.lds = (LAS unsigned char*)lds_raw; F.ldsg = lds_raw;
    F.tid = threadIdx.x; F.lane = F.tid & 63; F.wave = __builtin_amdgcn_readfirstlane(F.tid >> 6);
    F.G = gridDim.x; F.bid = blockIdx.x;
    F.in = args.in; F.out = args.out; F.ws = args.ws;
    const int lo = args.ph_lo, hi = args.ph_hi;
    cg::grid_group grid = cg::this_grid();
    const bool fused = (hi - lo) > 1;
    volatile LAS unsigned* bst = (volatile LAS unsigned*)(F.lds + AT_MISC + 16);
    if (F.tid == 0) { bst[0] = 0u; bst[1] = 0u; }
    __syncthreads();
    XcdBarrier xbar; xbar.bar = (unsigned*)(F.ws + WS_CTL) + 1024; xbar.x = 0; xbar.st = bst;
    if (fused) xbar = xcd_barrier_post((unsigned*)(F.ws + WS_CTL) + 1024, bst);
#define IN(k) (lo <= (k) && (k) < hi)
#define PB() do { F.lane = lane_id_opaque(); F.tid = F.wave * 64 + F.lane; } while (0)
#define SEAM(k) do { if (IN(k) && IN((k) + 1)) { xcd_barrier(xbar); } } while (0)
    const float* mod = (const float*)(F.ws + WS_MOD);
    if (IN(0)) { PB(); p0_prologue(F); }
    if (IN(0) && IN(1)) __syncthreads(); else SEAM(0);
    if (IN(1)) { PB(); p1_rows(F, IN(0)); } SEAM(1);
    if (IN(2)) { PB();
        p2_cumsum(F);
        __syncthreads();
        pg8::Gemm g{(const bf16_t*)(F.ws + WS_XN), (const bf16_t*)(F.ws + WS_WIN), 1024, 1024, 1024, 1 << 30, 0, 0};
        pg8::StaticOrder S; S.init(MT / 256, NZ / 256, F.G, F.bid, 0);
        EpiZ E{F.out, F.ws};
        pg8::gemm_phase<EpiZ, pg8::StaticOrder>(F.lds, g, S, E, F.wave);
#if PROBE_DUP == 2
        pg8::gemm_phase<EpiZ, pg8::StaticOrder>(F.lds, g, S, E, F.wave);
#endif
    } SEAM(2);
    if (IN(3)) { PB(); p3_attention(F, 7);
#if PROBE_DUP == 3
        p3_attention<PROBE_PV>(F, PROBE_MASK);
#endif
    } SEAM(3);
    if (IN(10)) { PB(); p_combine(F);
#if PROBE_DUP == 10
        p_combine(F);
#endif
    } if (IN(10) && IN(4)) xcd_barrier(xbar);
    if (IN(4)) { PB();
        pg8::Gemm g{(const bf16_t*)(F.ws + WS_AB), (const bf16_t*)(F.ws + WS_WAB), 1024, 512, 512, 4, 512, 0};
        pg8::StaticOrder S; S.init(MT / 256, 8, F.G, F.bid, 0);
        EpiGate E{(bf16_t*)(F.ws + WS_G), (bf16_t*)(F.ws + WS_G)};
#if PROBE_DUP == 4
        { EpiGate E2{(bf16_t*)(F.ws + WS_G), (bf16_t*)(F.ws + WS_QA)}; pg8::gemm_phase<EpiGate, pg8::StaticOrder>(F.lds, g, S, E2, F.wave); }
#endif
        pg8::gemm_phase<EpiGate, pg8::StaticOrder>(F.lds, g, S, E, F.wave);
    } SEAM(4);
    if (IN(5)) { PB();
        { pg8::Gemm g2{(const bf16_t*)(F.ws + WS_G), (const bf16_t*)(F.ws + WS_WO2), 2048, 2048, 256, 1 << 30, 0, 256};
          pg8::SplitOrder S2; S2.init(4, 8, F.G, F.bid, SEQ / 256); EpiSlab E2{(float*)(F.ws + WS_SLAB)};
          pg8::gemm_phase<EpiSlab, pg8::SplitOrder>(F.lds, g2, S2, E2, F.wave); }
        pg8::Gemm g{(const bf16_t*)(F.ws + WS_G), (const bf16_t*)(F.ws + WS_WO2), 2048, 2048, 2048, 1 << 30, 0, 0};
        pg8::StaticOrder S; S.init(SEQ / 256, 4, F.G, F.bid, 0);
        EpiResLn<false> E{(const void*)F.in[I_XP], mod + 2048, F.in[I_LN1G], F.in[I_LN1B], mod, (bf16_t*)(F.ws + WS_X1B), (bf16_t*)(F.ws + WS_XN), nullptr,
                          PanelStats{(unsigned*)(F.ws + WS_XB1), (unsigned*)(F.ws + WS_CTL) + CTL_LN1, LN_EPS}, F.lds};
        pg8::gemm_phase<EpiResLn<false>, pg8::StaticOrder>(F.lds, g, S, E, F.wave);
    } SEAM(5);
    if (IN(6)) { PB(); ln_rows<false>(F, F.in[I_LN1G], F.in[I_LN1B], 8, 2048);
#if PROBE_DUP == 6
        ln_rows<false>(F, F.in[I_LN1G], F.in[I_LN1B], 8, 2048);
#endif
    } SEAM(6);
    if (IN(7)) { PB();
        pg8::Gemm g{(const bf16_t*)(F.ws + WS_XN), (const bf16_t*)(F.ws + WS_WFI), 1024, 1024, 1024, 1 << 30, 0, 0};
        pg8::StaticOrder S; S.init(MT / 256, NFF2 / 256, F.G, F.bid, 0);
        EpiFfn E{(bf16_t*)(F.ws + WS_ACT)};
        pg8::gemm_phase<EpiFfn, pg8::StaticOrder>(F.lds, g, S, E, F.wave);
#if PROBE_DUP == 7
        pg8::gemm_phase<EpiFfn, pg8::StaticOrder>(F.lds, g, S, E, F.wave);
#endif
    } SEAM(7);
    if (IN(8)) { PB();
        { pg8::Gemm g2{(const bf16_t*)(F.ws + WS_ACT), (const bf16_t*)(F.ws + WS_WFO), DFF, DFF, 256, 1 << 30, 0, 256};
          pg8::SplitOrder S2; S2.init(4, 11, F.G, F.bid, SEQ / 256); EpiSlab E2{(float*)(F.ws + WS_SLAB)};
          pg8::gemm_phase<EpiSlab, pg8::SplitOrder>(F.lds, g2, S2, E2, F.wave); }
        pg8::Gemm g{(const bf16_t*)(F.ws + WS_ACT), (const bf16_t*)(F.ws + WS_WFO), DFF, DFF, DFF, 1 << 30, 0, 0};
        pg8::StaticOrder S; S.init(SEQ / 256, 4, F.G, F.bid, 0);
        EpiResLn<true> E{(const void*)(F.ws + WS_X1B), mod + 5120, F.in[I_LN2G], F.in[I_LN2B], mod, nullptr, nullptr, F.out,
                         PanelStats{(unsigned*)(F.ws + WS_XB2), (unsigned*)(F.ws + WS_CTL) + CTL_LN2, LN_EPS}, F.lds};
        pg8::gemm_phase<EpiResLn<true>, pg8::StaticOrder>(F.lds, g, S, E, F.wave);
    } SEAM(8);
    if (IN(9)) { PB(); ln_rows<true>(F, F.in[I_LN2G], F.in[I_LN2B], 11, 5120);
#if PROBE_DUP == 9
        ln_rows<true>(F, F.in[I_LN2G], F.in[I_LN2B], 11, 5120);
#endif
    }
#undef IN
#undef SEAM
}

extern "C" void kernel_launch(void* const* d_in, const int* in_sizes, int n_in, void* d_out, int out_size, void* d_ws, size_t ws_size, hipStream_t stream) {
    static int grid = 0;
    if (grid == 0) {
        if (n_in != 28 || (size_t)out_size != O_END || ws_size < WS_END) { fprintf(stderr, "kernel_launch: unexpected shapes (n_in %d out %d ws %zu)\n", n_in, out_size, ws_size); grid = -1; return; }
        int dev = 0, cus = 0, per_cu = 0;
        hipGetDevice(&dev); hipDeviceGetAttribute(&cus, hipDeviceAttributeMultiprocessorCount, dev);
        hipFuncSetAttribute((const void*)mega_fwd, hipFuncAttributeMaxDynamicSharedMemorySize, LDS_BYTES);
        hipOccupancyMaxActiveBlocksPerMultiprocessor(&per_cu, (const void*)mega_fwd, 512, LDS_BYTES);
        if (per_cu < 1) { fprintf(stderr, "kernel_launch: occupancy query says %d blocks per CU\n", per_cu); per_cu = 1; }
        (void)hipGetLastError();
        grid = cus;
    }
    if (grid < 0) return;
    hipMemsetAsync((char*)d_ws + WS_CTL, 0, CTL_BYTES, stream);
    Args a{};
    for (int i = 0; i < 28; ++i) a.in[i] = (const float*)d_in[i];
    a.out = (float*)d_out; a.ws = (unsigned char*)d_ws;
#if MK_N_LAUNCHES == 1
    a.ph_lo = 0; a.ph_hi = NPH;
    void* kargs[] = {&a};
    hipError_t e = hipLaunchCooperativeKernel((const void*)mega_fwd, dim3(grid), dim3(512), kargs, LDS_BYTES, stream);
    if (e != hipSuccess) fprintf(stderr, "cooperative launch failed: %s\n", hipGetErrorString(e));
#else
    { const int seq[NPH] = {0, 1, 2, 3, 10, 4, 5, 6, 7, 8, 9}; for (int i = 0; i < NPH; ++i) { a.ph_lo = seq[i]; a.ph_hi = seq[i] + 1; hipLaunchKernelGGL(mega_fwd, dim3(grid), dim3(512), LDS_BYTES, stream, a); } }
#endif
}
```

```cpp
#include <hip/hip_runtime.h>
#include <hip/hip_cooperative_groups.h>
#include <cstdint>
#include <cstdio>
namespace cg = cooperative_groups;

#ifndef PROBE_DUP
#define PROBE_DUP -1
#endif
#ifndef PROBE_PV
#define PROBE_PV 0
#endif
#ifndef PROBE_MASK
#define PROBE_MASK 7
#endif
#ifndef MK_N_LAUNCHES
#define MK_N_LAUNCHES 1
#endif

#define LAS __attribute__((address_space(3)))
typedef unsigned short bf16_t;
typedef short bf16x8 __attribute__((ext_vector_type(8)));
typedef short s16x4 __attribute__((ext_vector_type(4)));
typedef float f32x4 __attribute__((ext_vector_type(4)));
typedef float f32x2 __attribute__((ext_vector_type(2)));
typedef float f32x16 __attribute__((ext_vector_type(16)));
typedef unsigned u32x4 __attribute__((ext_vector_type(4)));
typedef unsigned u32x2 __attribute__((ext_vector_type(2)));

constexpr int DM = 1024, SEQ = 16384, DEC_B = 16, DEC_T = 16, NSMP = DEC_B * DEC_T, MT = SEQ + NSMP, PAST = 2048, SKV = PAST + DEC_T;
constexpr int NZ = 5120, DFF = 2816, NFF2 = 2 * DFF, WIN_COLS = 5128;
constexpr float LOG2E = 1.4426950408889634f, C2 = 0.125f * LOG2E, ALPHA = 1.189207115002721f, LN_EPS = 1e-5f;
constexpr int NPH = 11;

constexpr size_t O_Y = 0, O_DKP = (size_t)MT * DM, O_DVP = O_DKP + (size_t)SEQ * 512, O_FKP = O_DVP + (size_t)SEQ * 512, O_FVP = O_FKP + (size_t)SEQ * 512,
                 O_FLP = O_FVP + (size_t)SEQ * 512, O_DKS = O_FLP + (size_t)SEQ * 8, O_DVS = O_DKS + (size_t)NSMP * 512, O_FKS = O_DVS + (size_t)NSMP * 512,
                 O_FVS = O_FKS + (size_t)NSMP * 512, O_FLS = O_FVS + (size_t)NSMP * 512, O_END = O_FLS + (size_t)NSMP * 8;

constexpr size_t MiB = 1u << 20;
constexpr size_t WS_CTL = 0, CTL_BYTES = 64 * 1024;
constexpr size_t WS_MOD = 1 * MiB;
constexpr size_t WS_FP = 2 * MiB;
constexpr size_t WS_FS = 3 * MiB;
constexpr size_t WS_WIN = 8 * MiB;
constexpr size_t WS_WAB = 18 * MiB;
constexpr size_t WS_WO2 = 20 * MiB;
constexpr size_t WS_WFI = 24 * MiB;
constexpr size_t WS_WFO = 35 * MiB;
constexpr size_t WS_XN = 48 * MiB;
constexpr size_t WS_QA = 84 * MiB, WS_KA = 101 * MiB, WS_VA = 118 * MiB, WS_QB = 135 * MiB, WS_KB = 152 * MiB, WS_VB = 169 * MiB;
constexpr size_t WS_ACT = 84 * MiB;
constexpr size_t WS_G = 188 * MiB;
constexpr size_t WS_AB = 254 * MiB;
constexpr size_t WS_OD1 = WS_XN, WS_OD2 = 288 * MiB;
constexpr size_t WS_PF = 304 * MiB, WS_PD = 309 * MiB;
constexpr size_t WS_TB = WS_AB;
constexpr size_t WS_X1B = WS_AB;
constexpr size_t WS_XB1 = 5 * MiB, WS_XB2 = 6 * MiB;
constexpr int CTL_LN1 = 8192, CTL_LN2 = 12288;
constexpr int LN_LDS = 135168;
constexpr size_t WS_SLAB = 288 * MiB;
constexpr size_t WS_END = 320 * MiB;

constexpr int LDS_BYTES = 147456;

struct Args { const float* in[28]; float* out; unsigned char* ws; int ph_lo, ph_hi; };

__device__ __forceinline__ int lane_id_opaque() { int l = (int)__builtin_amdgcn_mbcnt_hi(~0u, __builtin_amdgcn_mbcnt_lo(~0u, 0u)); asm volatile("" : "+v"(l)); return l; }
__device__ __forceinline__ unsigned f2bf(float f) { unsigned u = __builtin_bit_cast(unsigned, f); return (u + 0x7fffu + ((u >> 16) & 1u)) >> 16; }
__device__ __forceinline__ unsigned pk2(float lo, float hi) { return f2bf(lo) | (f2bf(hi) << 16); }
__device__ __forceinline__ float bf2f(unsigned short b) { return __builtin_bit_cast(float, (unsigned)b << 16); }
__device__ __forceinline__ float bflo(unsigned w) { return __builtin_bit_cast(float, w << 16); }
__device__ __forceinline__ float bfhi(unsigned w) { return __builtin_bit_cast(float, w & 0xffff0000u); }
__device__ __forceinline__ float wave_sum(float v) {
#pragma unroll
    for (int o = 1; o < 64; o <<= 1) v += __shfl_xor(v, o);
    return v;
}
__device__ __forceinline__ float sigmoidf_(float x) { return 1.0f / (1.0f + __expf(-x)); }
__device__ __forceinline__ float siluf_(float x) { return x / (1.0f + __expf(-x)); }

namespace pg8 {
constexpr int BM = 256, BK = 64, HALF = 128, HTB = HALF * BK * 2, STAGE_BYTES = 8 * HTB, NXCD = 8, WGM = 8;
__host__ __device__ __forceinline__ int lds_byte(int r, int c) { const int st = (r >> 4) * 2 + (c >> 5), rr = r & 15, cc = c & 31, ob = rr * 64 + cc * 2; return st * 1024 + (ob ^ (((ob >> 9) & 1) << 5)); }
__host__ __device__ __forceinline__ void stage_rc(int b, int& R, int& C) { const int st = b / 1024, sb = b % 1024, swz = sb ^ (((sb >> 9) & 1) << 5); R = (st >> 1) * 16 + swz / 64; C = (st & 1) * 32 + (swz % 64) / 2; }
__host__ __device__ __forceinline__ int perm32(int rho) { const int n = rho >> 4, i = rho & 15; return 8 * (i >> 2) + 4 * n + (i & 3); }

struct Unit { int pm, pn, ks; };
struct Gemm { const bf16_t* A; const bf16_t* Bt; int lda, ldb, K, a_split_pn, a_split_off, kpart; };

struct StaticOrder {
    int nM, nN, nwg, G, c, pm0;
    __device__ void init(int nM_, int nN_, int G_, int c_, int pm0_) { nM = nM_; nN = nN_; nwg = nM * nN; G = G_; c = c_; pm0 = pm0_; }
    __device__ bool next(int i, Unit& u) const {
        const long L = (long)i * G + c; if (L >= nwg) return false;
        int wgid = (int)L; { const int q = nwg / NXCD, r = nwg % NXCD, xcd = wgid % NXCD, off = wgid / NXCD; wgid = (xcd < r ? xcd * (q + 1) : r * (q + 1) + (xcd - r) * q) + off; }
        const int nig = WGM * nN, gid = wgid / nig, fm = gid * WGM, gsz = (nM - fm) < WGM ? (nM - fm) : WGM;
        u.pm = pm0 + fm + ((wgid % nig) % gsz); u.pn = (wgid % nig) / gsz; u.ks = 0; return true;
    }
};

struct SplitOrder {
    int nN, nun, G, c, pm;
    __device__ void init(int nN_, int KS_, int G_, int c_, int pm_) { nN = nN_; nun = nN_ * KS_; G = G_; c = c_; pm = pm_; }
    __device__ bool next(int i, Unit& u) const { const long L = (long)i * G + c; if (L >= nun) return false; u.pm = pm; u.pn = (int)L % nN; u.ks = (int)L / nN; return true; }
};

__device__ __forceinline__ unsigned cvt_pk_bf16(float lo, float hi) { unsigned r; asm volatile("v_cvt_pk_bf16_f32 %0, %1, %2" : "=v"(r) : "v"(lo), "v"(hi)); return r; }

template <class Epi, class Sched, bool ALIGN_EPI = true, bool SP2 = true>
__device__ __forceinline__ void gemm_phase(LAS unsigned char* lds, const Gemm g, const Sched& S, const Epi& E, int wid  ) {
    const int lane = lane_id_opaque(), tid = wid * 64 + lane, wr = wid >> 2, wc = wid & 3; int fr = lane & 15, fq = lane >> 4;
    const int K = g.K, nt = K / BK;
    unsigned voffA[2], voffB[2];
#pragma unroll
    for (int i = 0; i < 2; ++i) { int R, C; stage_rc(tid * 16 + i * 8192, R, C); const int Rb = Epi::PERM ? ((R & ~31) + perm32(R & 31)) : R;
        voffA[i] = (unsigned)(R * g.lda + C) * 2u; voffB[i] = (unsigned)(Rb * g.ldb + C) * 2u; }
    const size_t kstep = (size_t)(BK * 2);
    const size_t hstepA = (size_t)HALF * g.lda * 2, hstepB = (size_t)HALF * g.ldb * 2;
    const size_t tstepA = 2 * hstepA, tstepB = 2 * hstepB;
    const unsigned ldsw = (unsigned)wid * 1024u;
    const int aoff = lds_byte(wr * 64 + fr, fq * 8), boff = lds_byte(wc * 32 + fr, fq * 8);
#define PG8_SA(b, h) (((b) * 2 + (h)) * HTB)
#define PG8_SB(b, h) ((4 + (b) * 2 + (h)) * HTB)
#define PG8_STAGE(bufoff, gbase, voff) do { _Pragma("unroll") for (int _i = 0; _i < 2; ++_i) \
        __builtin_amdgcn_global_load_lds((const unsigned*)((const char*)(gbase) + (voff)[_i]), (LAS unsigned*)(lds + (bufoff) + ldsw + _i * 8192), 16, 0, 0); } while (0)
#define PG8_LDA(dst, b, h) do { _Pragma("unroll") for (int m = 0; m < 4; ++m) _Pragma("unroll") for (int k = 0; k < 2; ++k) dst[m][k] = *(const LAS bf16x8*)(lds + PG8_SA(b, h) + aoff + m * 2048 + k * 1024); } while (0)
#define PG8_LDB(dst, b, h) do { _Pragma("unroll") for (int n = 0; n < 2; ++n) _Pragma("unroll") for (int k = 0; k < 2; ++k) dst[n][k] = *(const LAS bf16x8*)(lds + PG8_SB(b, h) + boff + n * 2048 + k * 1024); } while (0)
#define PG8_MMA(ai, bj, At, Bt) do { __builtin_amdgcn_s_setprio(1); _Pragma("unroll") for (int m = 0; m < 4; ++m) _Pragma("unroll") for (int n = 0; n < 2; ++n) _Pragma("unroll") for (int k = 0; k < 2; ++k) \
        acc[ai][bj][m][n] = __builtin_amdgcn_mfma_f32_16x16x32_bf16(Bt[n][k], At[m][k], acc[ai][bj][m][n], 0, 0, 0); __builtin_amdgcn_s_setprio(0); } while (0)
#define PG8_WAIT_V(n) asm volatile("s_waitcnt vmcnt(" #n ")" ::: "memory")
#define PG8_WAIT_L(n) asm volatile("s_waitcnt lgkmcnt(" #n ")" ::: "memory")
#define PG8_BAR __builtin_amdgcn_s_barrier()
#define PG8_SCHED __builtin_amdgcn_sched_barrier(0)
#define PG8_ABASE(u) ((const char*)g.A + (size_t)(u).pm * tstepA + ((u).pn >= g.a_split_pn ? (size_t)g.a_split_off * 2 : (size_t)0) + (size_t)(u).ks * g.kpart * 2)
#define PG8_BBASE(u) ((const char*)g.Bt + (size_t)(u).pn * tstepB + (size_t)(u).ks * g.kpart * 2)
    Unit cur, nxt; int ui = 0;
    if (!S.next(0, cur)) return;
    f32x4 acc[2][2][4][2];
#pragma unroll
    for (int a = 0; a < 2; ++a)
#pragma unroll
        for (int b = 0; b < 2; ++b)
#pragma unroll
            for (int m = 0; m < 4; ++m)
#pragma unroll
                for (int n = 0; n < 2; ++n) acc[a][b][m][n] = (f32x4){0.f, 0.f, 0.f, 0.f};
    bf16x8 At[4][2], B0[2][2], B1[2][2];
    const char* cA = PG8_ABASE(cur); const char* cB = PG8_BBASE(cur);
    if constexpr (SP2) {
        PG8_STAGE(PG8_SB(0, 0), cB, voffB); PG8_STAGE(PG8_SB(0, 1), cB + hstepB, voffB); PG8_STAGE(PG8_SA(0, 0), cA, voffA); PG8_STAGE(PG8_SA(0, 1), cA + hstepA, voffA);
        if (wr == 1) PG8_BAR;
        PG8_WAIT_V(2); PG8_BAR;
        PG8_STAGE(PG8_SB(1, 0), cB + kstep, voffB); PG8_STAGE(PG8_SA(1, 0), cA + kstep, voffA); PG8_STAGE(PG8_SB(1, 1), cB + hstepB + kstep, voffB);
        PG8_WAIT_V(6); PG8_BAR;
    } else {
        PG8_STAGE(PG8_SB(0, 0), cB, voffB); PG8_STAGE(PG8_SA(0, 0), cA, voffA); PG8_STAGE(PG8_SB(0, 1), cB + hstepB, voffB); PG8_STAGE(PG8_SA(0, 1), cA + hstepA, voffA);
        if (wr == 1) PG8_BAR;
        PG8_WAIT_V(4); PG8_BAR;
        PG8_STAGE(PG8_SB(1, 0), cB + kstep, voffB); PG8_STAGE(PG8_SA(1, 0), cA + kstep, voffA); PG8_STAGE(PG8_SB(1, 1), cB + hstepB + kstep, voffB);
        PG8_WAIT_V(6); PG8_BAR;
    }
    for (;;) {
        const bool has_next = S.next(ui + 1, nxt);
        const char* nA = has_next ? PG8_ABASE(nxt) : cA; const char* nB = has_next ? PG8_BBASE(nxt) : cB;
        for (int t = 0; t < nt; t += 2) {
            const bool last = (t == nt - 2);
            const char* a1 = cA + (size_t)(t + 1) * kstep;
            const char* a2 = last ? nA : cA + (size_t)(t + 2) * kstep; const char* b2 = last ? nB : cB + (size_t)(t + 2) * kstep;
            const char* a3 = a2 + kstep; const char* b3 = b2 + kstep;
            if constexpr (SP2) {
            PG8_LDB(B0, 0, 0); PG8_LDB(B1, 0, 1); PG8_SCHED; PG8_LDA(At, 0, 0); PG8_STAGE(PG8_SA(1, 1), a1 + hstepA, voffA);
            PG8_WAIT_V(8); PG8_WAIT_L(0); PG8_BAR; PG8_MMA(0, 0, At, B0); PG8_MMA(0, 1, At, B1); PG8_BAR; PG8_SCHED;
            PG8_LDA(At, 0, 1); PG8_STAGE(PG8_SB(0, 0), b2, voffB); PG8_STAGE(PG8_SB(0, 1), b2 + hstepB, voffB); PG8_STAGE(PG8_SA(0, 0), a2, voffA);
            PG8_WAIT_V(8); PG8_WAIT_L(0); PG8_BAR; PG8_MMA(1, 0, At, B0); PG8_MMA(1, 1, At, B1); PG8_BAR; PG8_SCHED;
            PG8_LDB(B0, 1, 0); PG8_LDB(B1, 1, 1); PG8_SCHED; PG8_LDA(At, 1, 0); PG8_STAGE(PG8_SA(0, 1), a2 + hstepA, voffA);
            PG8_WAIT_V(8); PG8_WAIT_L(0); PG8_BAR; PG8_MMA(0, 0, At, B0); PG8_MMA(0, 1, At, B1); PG8_BAR; PG8_SCHED;
            PG8_LDA(At, 1, 1); PG8_STAGE(PG8_SB(1, 0), b3, voffB); PG8_STAGE(PG8_SB(1, 1), b3 + hstepB, voffB); PG8_STAGE(PG8_SA(1, 0), a3, voffA);
            PG8_WAIT_V(8); PG8_WAIT_L(0); PG8_BAR; PG8_MMA(1, 0, At, B0); PG8_MMA(1, 1, At, B1); PG8_BAR; PG8_SCHED;
            } else {
            PG8_LDB(B0, 0, 0); PG8_SCHED; PG8_LDA(At, 0, 0); PG8_STAGE(PG8_SA(1, 1), a1 + hstepA, voffA);
            PG8_WAIT_L(8); PG8_BAR; PG8_WAIT_L(0); PG8_MMA(0, 0, At, B0); PG8_BAR; PG8_SCHED;
            PG8_LDB(B1, 0, 1); PG8_STAGE(PG8_SB(0, 0), b2, voffB);
            PG8_BAR; PG8_WAIT_L(0); PG8_MMA(0, 1, At, B1); PG8_BAR;
            PG8_LDA(At, 0, 1); PG8_STAGE(PG8_SA(0, 0), a2, voffA);
            PG8_BAR; PG8_WAIT_L(0); PG8_MMA(1, 0, At, B0); PG8_BAR; PG8_SCHED;
            PG8_STAGE(PG8_SB(0, 1), b2 + hstepB, voffB);
            PG8_WAIT_V(6); PG8_BAR; PG8_MMA(1, 1, At, B1); PG8_BAR;
            PG8_LDB(B0, 1, 0); PG8_SCHED; PG8_LDA(At, 1, 0); PG8_STAGE(PG8_SA(0, 1), a2 + hstepA, voffA);
            PG8_WAIT_L(8); PG8_BAR; PG8_WAIT_L(0); PG8_MMA(0, 0, At, B0); PG8_BAR; PG8_SCHED;
            PG8_LDB(B1, 1, 1); PG8_STAGE(PG8_SB(1, 0), b3, voffB);
            PG8_BAR; PG8_WAIT_L(0); PG8_MMA(0, 1, At, B1); PG8_BAR;
            PG8_LDA(At, 1, 1); PG8_STAGE(PG8_SA(1, 0), a3, voffA);
            PG8_BAR; PG8_WAIT_L(0); PG8_MMA(1, 0, At, B0); PG8_BAR; PG8_SCHED;
            PG8_STAGE(PG8_SB(1, 1), b3 + hstepB, voffB);
            PG8_WAIT_V(6); PG8_BAR; PG8_MMA(1, 1, At, B1); PG8_BAR;
            }
        }
        if constexpr (ALIGN_EPI) { if (wr == 0) PG8_BAR; }
        { const int le_ = lane_id_opaque(); E(acc, cur, wr, wc, le_ & 15, le_ >> 4); }
        if (!has_next) break;
#pragma unroll
        for (int a = 0; a < 2; ++a)
#pragma unroll
            for (int b = 0; b < 2; ++b)
#pragma unroll
                for (int m = 0; m < 4; ++m)
#pragma unroll
                    for (int n = 0; n < 2; ++n) acc[a][b][m][n] = (f32x4){0.f, 0.f, 0.f, 0.f};
        cur = nxt; cA = nA; cB = nB; ++ui;
        if constexpr (ALIGN_EPI) { if (wr == 1) PG8_BAR; }
    }
    PG8_WAIT_V(0);
    if constexpr (!ALIGN_EPI) { if (wr == 0) PG8_BAR; }
    PG8_BAR;
#undef PG8_SA
#undef PG8_SB
#undef PG8_STAGE
#undef PG8_LDA
#undef PG8_LDB
#undef PG8_MMA
#undef PG8_WAIT_V
#undef PG8_WAIT_L
#undef PG8_BAR
#undef PG8_SCHED
#undef PG8_ABASE
#undef PG8_BBASE
}
}

struct EpiZ {
    static constexpr bool PERM = true;
    float* out; unsigned char* ws;
    __device__ __forceinline__ void operator()(const f32x4 (&acc)[2][2][4][2], const pg8::Unit& u, int wr, int wc, int fr, int fq) const {
        asm volatile("" : "+v"(fr), "+v"(fq));
        const int seg = u.pn >> 1;
        const bool smp = u.pm >= SEQ / 256;
        const int row0 = u.pm * 256 + wr * 64 + fr;
        const int cl0 = wc * 32 + 8 * fq;
        if (seg < 6) {
            bf16_t* B = (bf16_t*)(ws + WS_QA + (size_t)seg * (WS_KA - WS_QA));
            const bool isq = (seg == 0 || seg == 3);
            const float sc = isq ? C2 : 1.0f;
            const int kk = seg - 1 - (seg > 3 ? 1 : 0);
            float* ob = isq ? nullptr : (smp ? out + O_DKS + (size_t)kk * NSMP * 512 - (size_t)SEQ * 512 : out + O_DKP + (size_t)kk * SEQ * 512);
            const int cs = (u.pn & 1) * 256 + cl0;
            if (seg == 0 || seg == 1 || seg == 3 || seg == 4) {
                float mx0 = 0.f, mx1 = 0.f;
#pragma unroll
                for (int ai = 0; ai < 2; ++ai)
#pragma unroll
                    for (int m = 0; m < 4; ++m) {
#pragma unroll
                        for (int bj = 0; bj < 2; ++bj) { const f32x4 v0 = acc[ai][bj][m][0] * sc, v1 = acc[ai][bj][m][1] * sc;
                            float ss = (v0[0] * v0[0] + v0[1] * v0[1]) + (v0[2] * v0[2] + v0[3] * v0[3]) + (v1[0] * v1[0] + v1[1] * v1[1]) + (v1[2] * v1[2] + v1[3] * v1[3]);
                            ss += __shfl_xor(ss, 16); ss += __shfl_xor(ss, 32);
                            if (bj == 0) mx0 = fmaxf(mx0, ss); else mx1 = fmaxf(mx1, ss); } }
#pragma unroll
                for (int ofs = 1; ofs < 16; ofs <<= 1) { mx0 = fmaxf(mx0, __shfl_xor(mx0, ofs)); mx1 = fmaxf(mx1, __shfl_xor(mx1, ofs)); }
                if ((fr | fq) == 0) { unsigned* nw = (unsigned*)(ws + WS_CTL) + (seg < 3 ? 288 : 256) + ((seg == 4 || seg == 1) ? 16 : 0);
                    const int h0 = (u.pn & 1) * 4 + (wc >> 1), hf = wc & 1;
                    atomicMax(nw + (h0 * 2 + hf), __float_as_uint(mx0)); atomicMax(nw + ((h0 + 2) * 2 + hf), __float_as_uint(mx1)); }
            }
#pragma unroll
            for (int ai = 0; ai < 2; ++ai)
#pragma unroll
                for (int m = 0; m < 4; ++m) { const size_t r = (size_t)(row0 + ai * 128 + m * 16);
#pragma unroll
                    for (int bj = 0; bj < 2; ++bj) { const f32x4 v0 = acc[ai][bj][m][0], v1 = acc[ai][bj][m][1]; const int c = cs + bj * 128;
                        if (ob) { *(f32x4*)(ob + r * 512 + c) = v0; *(f32x4*)(ob + r * 512 + c + 4) = v1; }
                        u32x4 w; w.x = pg8::cvt_pk_bf16(v0[0] * sc, v0[1] * sc); w.y = pg8::cvt_pk_bf16(v0[2] * sc, v0[3] * sc); w.z = pg8::cvt_pk_bf16(v1[0] * sc, v1[1] * sc); w.w = pg8::cvt_pk_bf16(v1[2] * sc, v1[3] * sc);
                        *(u32x4*)(B + r * 512 + c) = w; } }
        } else {
            bf16_t* G = (bf16_t*)(ws + WS_G);
            const int cs = (u.pn - 12) * 256 + cl0;
#pragma unroll
            for (int ai = 0; ai < 2; ++ai)
#pragma unroll
                for (int m = 0; m < 4; ++m) { const size_t r = (size_t)(row0 + ai * 128 + m * 16);
#pragma unroll
                    for (int bj = 0; bj < 2; ++bj) { const f32x4 v0 = acc[ai][bj][m][0], v1 = acc[ai][bj][m][1]; const int c = cs + bj * 128;
                        u32x4 w; w.x = pg8::cvt_pk_bf16(sigmoidf_(v0[0]), sigmoidf_(v0[1])); w.y = pg8::cvt_pk_bf16(sigmoidf_(v0[2]), sigmoidf_(v0[3]));
                        w.z = pg8::cvt_pk_bf16(sigmoidf_(v1[0]), sigmoidf_(v1[1])); w.w = pg8::cvt_pk_bf16(sigmoidf_(v1[2]), sigmoidf_(v1[3]));
                        *(u32x4*)(G + r * 2048 + c) = w; } }
        }
    }
};
struct EpiGate {
    static constexpr bool PERM = true;
    bf16_t* G; bf16_t* GO;
    __device__ __forceinline__ void operator()(const f32x4 (&acc)[2][2][4][2], const pg8::Unit& u, int wr, int wc, int fr, int fq) const {
        asm volatile("" : "+v"(fr), "+v"(fq));
        const int row0 = u.pm * 256 + wr * 64 + fr, c0 = u.pn * 256 + wc * 32 + 8 * fq;
#pragma unroll
        for (int ai = 0; ai < 2; ++ai)
#pragma unroll
            for (int m = 0; m < 4; ++m) { const size_t ro = (size_t)(row0 + ai * 128 + m * 16) * 2048 + c0; const bf16_t* rp = G + ro; bf16_t* wp = GO + ro;
#pragma unroll
                for (int bj = 0; bj < 2; ++bj) { const f32x4 v0 = acc[ai][bj][m][0], v1 = acc[ai][bj][m][1]; const u32x4 gw = *(const u32x4*)(rp + bj * 128);
                    u32x4 w; w.x = pg8::cvt_pk_bf16(v0[0] * bflo(gw.x), v0[1] * bfhi(gw.x)); w.y = pg8::cvt_pk_bf16(v0[2] * bflo(gw.y), v0[3] * bfhi(gw.y));
                    w.z = pg8::cvt_pk_bf16(v1[0] * bflo(gw.z), v1[1] * bfhi(gw.z)); w.w = pg8::cvt_pk_bf16(v1[2] * bflo(gw.w), v1[3] * bfhi(gw.w));
                    *(u32x4*)(wp + bj * 128) = w; } }
    }
};
template <bool BASE_BF16> struct EpiRes {
    static constexpr bool PERM = true;
    const void* base; bf16_t* T; const float* gate;
    __device__ __forceinline__ void operator()(const f32x4 (&acc)[2][2][4][2], const pg8::Unit& u, int wr, int wc, int fr, int fq) const {
        asm volatile("" : "+v"(fr), "+v"(fq));
        const int row0 = u.pm * 256 + wr * 64 + fr, c0 = u.pn * 256 + wc * 32 + 8 * fq;
#pragma unroll
        for (int ai = 0; ai < 2; ++ai)
#pragma unroll
            for (int m = 0; m < 4; ++m) { const size_t ro = (size_t)(row0 + ai * 128 + m * 16) * DM;
#pragma unroll
                for (int bj = 0; bj < 2; ++bj) { const int c = c0 + bj * 128; f32x4 b0, b1;
                    if (BASE_BF16) { const u32x4 bw = *(const u32x4*)((const bf16_t*)base + ro + c); b0 = (f32x4){bflo(bw.x), bfhi(bw.x), bflo(bw.y), bfhi(bw.y)}; b1 = (f32x4){bflo(bw.z), bfhi(bw.z), bflo(bw.w), bfhi(bw.w)}; }
                    else { b0 = *(const f32x4*)((const float*)base + ro + c); b1 = *(const f32x4*)((const float*)base + ro + c + 4); }
                    const f32x4 g0 = *(const f32x4*)(gate + c), g1 = *(const f32x4*)(gate + c + 4);
                    const f32x4 v0 = b0 * ALPHA + g0 * acc[ai][bj][m][0], v1 = b1 * ALPHA + g1 * acc[ai][bj][m][1];
                    u32x4 w; w.x = pg8::cvt_pk_bf16(v0[0], v0[1]); w.y = pg8::cvt_pk_bf16(v0[2], v0[3]); w.z = pg8::cvt_pk_bf16(v1[0], v1[1]); w.w = pg8::cvt_pk_bf16(v1[2], v1[3]);
                    *(u32x4*)(T + ro + c) = w; } }
    }
};
struct PanelStats {
    unsigned* xbuf; unsigned* cnt; float eps;
    __device__ __forceinline__ void run(const f32x4 (&v)[2][2][4][2], const pg8::Unit& u, int wr, int wc, int fr, int fq, LAS unsigned char* lds, int wid, int lane) const {
        LAS f32x2* P = (LAS f32x2*)(lds + LN_LDS);
        LAS f32x2* S = (LAS f32x2*)(lds + LN_LDS + 8192);
#pragma unroll
        for (int ai = 0; ai < 2; ++ai)
#pragma unroll
            for (int m = 0; m < 4; ++m) {
                float s = 0.f;
#pragma unroll
                for (int bj = 0; bj < 2; ++bj)
#pragma unroll
                    for (int n = 0; n < 2; ++n) { const f32x4 x = v[ai][bj][m][n]; s += (x[0] + x[1]) + (x[2] + x[3]); }
                s += __shfl_xor(s, 16); s += __shfl_xor(s, 32);
                const float mw = s * (1.0f / 64.0f); float q = 0.f;
#pragma unroll
                for (int bj = 0; bj < 2; ++bj)
#pragma unroll
                    for (int n = 0; n < 2; ++n) { const f32x4 d = v[ai][bj][m][n] - mw; q += (d[0] * d[0] + d[1] * d[1]) + (d[2] * d[2] + d[3] * d[3]); }
                q += __shfl_xor(q, 16); q += __shfl_xor(q, 32);
                if (fq == 0) P[(ai * 128 + wr * 64 + m * 16 + fr) * 4 + wc] = (f32x2){mw, q};
                __builtin_amdgcn_sched_barrier(0);
            }
        asm volatile("s_waitcnt lgkmcnt(0)" ::: "memory"); __builtin_amdgcn_s_barrier(); asm volatile("" ::: "memory");
        const int row = wid * 32 + (lane & 31);
        if (lane < 32) {
            const f32x2 a = P[row * 4 + 0], b = P[row * 4 + 1], c = P[row * 4 + 2], d = P[row * 4 + 3];
            const float mt = (a.x + b.x + c.x + d.x) * 0.25f;
            const float da = a.x - mt, db = b.x - mt, dc = c.x - mt, dd = d.x - mt;
            const float m2 = (a.y + b.y) + (c.y + d.y) + 64.0f * ((da * da + db * db) + (dc * dc + dd * dd));
            unsigned long long* slot = (unsigned long long*)xbuf + ((size_t)(u.pm * 256 + row) * 4 + u.pn);
            __hip_atomic_store(slot, ((unsigned long long)__float_as_uint(m2) << 32) | __float_as_uint(mt), __ATOMIC_RELAXED, __HIP_MEMORY_SCOPE_AGENT);
        }
        asm volatile("s_waitcnt vmcnt(0)" ::: "memory");
        if (lane == 0) __hip_atomic_fetch_add(cnt + 64 * u.pm, 1u, __ATOMIC_RELAXED, __HIP_MEMORY_SCOPE_AGENT);
        if (wid == 0) {
            unsigned sp = 0;
            while ((unsigned)__builtin_amdgcn_readfirstlane(__hip_atomic_load(cnt + 64 * u.pm, __ATOMIC_RELAXED, __HIP_MEMORY_SCOPE_AGENT)) < 32u && ++sp < (1u << 21)) __builtin_amdgcn_s_sleep(2);
            __builtin_amdgcn_fence(__ATOMIC_ACQUIRE, "agent");
        }
        asm volatile("s_waitcnt vmcnt(0) lgkmcnt(0)" ::: "memory"); __builtin_amdgcn_s_barrier(); asm volatile("" ::: "memory");
        if (lane < 32) {
            const unsigned long long* slot = (const unsigned long long*)xbuf + (size_t)(u.pm * 256 + row) * 4; float mt[4], m2[4]; float ms = 0.f;
#pragma unroll
            for (int t = 0; t < 4; ++t) { const unsigned long long w = __hip_atomic_load(slot + t, __ATOMIC_RELAXED, __HIP_MEMORY_SCOPE_AGENT); mt[t] = __uint_as_float((unsigned)w); m2[t] = __uint_as_float((unsigned)(w >> 32)); ms += mt[t]; }
            const float mean = ms * 0.25f; float q = 0.f;
#pragma unroll
            for (int t = 0; t < 4; ++t) { const float dm = mt[t] - mean; q += m2[t] + 256.0f * dm * dm; }
            S[row] = (f32x2){mean, 1.0f / sqrtf(q * (1.0f / 1024.0f) + eps)};
        }
        asm volatile("s_waitcnt lgkmcnt(0)" ::: "memory"); __builtin_amdgcn_s_barrier(); asm volatile("" ::: "memory");
    }
};
template <bool FINAL> struct EpiResLn {
    static constexpr bool PERM = true;
    const void* base; const float* gate; const float* lg; const float* lb; const float* mod; bf16_t* X1B; bf16_t* XN; float* out; PanelStats st; LAS unsigned char* lds;
    __device__ __forceinline__ void operator()(f32x4 (&acc)[2][2][4][2], const pg8::Unit& u, int wr, int wc, int fr, int fq) const {
        asm volatile("" : "+v"(fr), "+v"(fq));
        const int row0 = u.pm * 256 + wr * 64 + fr, c0 = u.pn * 256 + wc * 32 + 8 * fq;
#pragma unroll
        for (int ai = 0; ai < 2; ++ai)
#pragma unroll
            for (int m = 0; m < 4; ++m) { int rr_ = row0 + ai * 128 + m * 16; asm volatile("" : "+v"(rr_)); const size_t ro = (size_t)rr_ * DM;
#pragma unroll
                for (int bj = 0; bj < 2; ++bj) { int c = c0 + bj * 128; asm volatile("" : "+v"(c)); f32x4 b0, b1;
                    if (FINAL) { const u32x4 bw = *(const u32x4*)((const bf16_t*)base + ro + c); b0 = (f32x4){bflo(bw.x), bfhi(bw.x), bflo(bw.y), bfhi(bw.y)}; b1 = (f32x4){bflo(bw.z), bfhi(bw.z), bflo(bw.w), bfhi(bw.w)}; }
                    else { b0 = *(const f32x4*)((const float*)base + ro + c); b1 = *(const f32x4*)((const float*)base + ro + c + 4); }
                    const f32x4 g0 = *(const f32x4*)(gate + c), g1 = *(const f32x4*)(gate + c + 4);
                    acc[ai][bj][m][0] = b0 * ALPHA + g0 * acc[ai][bj][m][0]; acc[ai][bj][m][1] = b1 * ALPHA + g1 * acc[ai][bj][m][1];
                    asm volatile("" : "+v"(acc[ai][bj][m][0]), "+v"(acc[ai][bj][m][1])); }
                __builtin_amdgcn_sched_barrier(0); }
        st.run(acc, u, wr, wc, fr, fq, lds, wr * 4 + wc, fq * 16 + fr);
        const LAS f32x2* S = (const LAS f32x2*)(lds + LN_LDS + 8192);
#pragma unroll
        for (int ai = 0; ai < 2; ++ai)
#pragma unroll
            for (int m = 0; m < 4; ++m) { int r = ai * 128 + wr * 64 + m * 16 + fr; asm volatile("" : "+v"(r)); const f32x2 sr = S[r]; const size_t ro = (size_t)(u.pm * 256 + r) * DM;
#pragma unroll
                for (int bj = 0; bj < 2; ++bj) { int c = c0 + bj * 128; asm volatile("" : "+v"(c));
                    const f32x4 y0 = (acc[ai][bj][m][0] - sr.x) * sr.y * *(const f32x4*)(lg + c) + *(const f32x4*)(lb + c);
                    const f32x4 y1 = (acc[ai][bj][m][1] - sr.x) * sr.y * *(const f32x4*)(lg + c + 4) + *(const f32x4*)(lb + c + 4);
                    if (FINAL) { *(f32x4*)(out + ro + c) = y0; *(f32x4*)(out + ro + c + 4) = y1; }
                    else { u32x4 w; w.x = pg8::cvt_pk_bf16(y0[0], y0[1]); w.y = pg8::cvt_pk_bf16(y0[2], y0[3]); w.z = pg8::cvt_pk_bf16(y1[0], y1[1]); w.w = pg8::cvt_pk_bf16(y1[2], y1[3]);
                        *(u32x4*)(X1B + ro + c) = w;
                        const f32x4 h0 = y0 * (*(const f32x4*)(mod + 4096 + c) + 1.0f) + *(const f32x4*)(mod + 3072 + c), h1 = y1 * (*(const f32x4*)(mod + 4096 + c + 4) + 1.0f) + *(const f32x4*)(mod + 3072 + c + 4);
                        u32x4 w2; w2.x = pg8::cvt_pk_bf16(h0[0], h0[1]); w2.y = pg8::cvt_pk_bf16(h0[2], h0[3]); w2.z = pg8::cvt_pk_bf16(h1[0], h1[1]); w2.w = pg8::cvt_pk_bf16(h1[2], h1[3]);
                        *(u32x4*)(XN + ro + c) = w2; } }
                __builtin_amdgcn_sched_barrier(0); }
    }
};
struct EpiSlab {
    static constexpr bool PERM = true;
    float* slab;
    __device__ __forceinline__ void operator()(const f32x4 (&acc)[2][2][4][2], const pg8::Unit& u, int wr, int wc, int fr, int fq) const {
        asm volatile("" : "+v"(fr), "+v"(fq));
        const int row0 = wr * 64 + fr, c0 = u.pn * 256 + wc * 32 + 8 * fq; float* sb = slab + (size_t)u.ks * NSMP * DM;
#pragma unroll
        for (int ai = 0; ai < 2; ++ai)
#pragma unroll
            for (int m = 0; m < 4; ++m) { float* op = sb + (size_t)(row0 + ai * 128 + m * 16) * DM + c0;
#pragma unroll
                for (int bj = 0; bj < 2; ++bj) { *(f32x4*)(op + bj * 128) = acc[ai][bj][m][0]; *(f32x4*)(op + bj * 128 + 4) = acc[ai][bj][m][1]; } }
    }
};
struct EpiFfn {
    static constexpr bool PERM = true;
    bf16_t* ACT;
    __device__ __forceinline__ void operator()(const f32x4 (&acc)[2][2][4][2], const pg8::Unit& u, int wr, int wc, int fr, int fq) const {
        asm volatile("" : "+v"(fr), "+v"(fq));
        const int row0 = u.pm * 256 + wr * 64 + fr, c0 = u.pn * 128 + wc * 32 + 8 * fq;
#pragma unroll
        for (int ai = 0; ai < 2; ++ai)
#pragma unroll
            for (int m = 0; m < 4; ++m) { const f32x4 g0 = acc[ai][0][m][0], g1 = acc[ai][0][m][1], u0 = acc[ai][1][m][0], u1 = acc[ai][1][m][1];
                u32x4 w; w.x = pg8::cvt_pk_bf16(siluf_(g0[0]) * u0[0], siluf_(g0[1]) * u0[1]); w.y = pg8::cvt_pk_bf16(siluf_(g0[2]) * u0[2], siluf_(g0[3]) * u0[3]);
                w.z = pg8::cvt_pk_bf16(siluf_(g1[0]) * u1[0], siluf_(g1[1]) * u1[1]); w.w = pg8::cvt_pk_bf16(siluf_(g1[2]) * u1[2], siluf_(g1[3]) * u1[3]);
                *(u32x4*)(ACT + (size_t)(row0 + ai * 128 + m * 16) * DFF + c0) = w; }
    }
};

struct Frame {
    LAS unsigned char* lds; unsigned char* ldsg;
    int tid, lane, wave, G, bid;
    const float* const* in; float* out; unsigned char* ws;
};
enum { I_XP = 0, I_XS, I_CDK, I_CDV, I_CFK, I_CFV, I_CFL, I_CP, I_CS, I_WADA, I_BADA, I_WIN, I_BF, I_LQ1, I_LK1, I_LQ2, I_LK2, I_SUBG, I_RELB, I_WA, I_WB, I_WO, I_LN1G, I_LN1B, I_LN2G, I_LN2B, I_WFI, I_WFO };

__device__ __forceinline__ void tr_item(const float* W, int ldw, int src_n0, int k0, bf16_t* WT, int ldt, int dst_row0, int dst_k0, int dup_off, LAS float* scr, int lane) {
#pragma unroll 8
    for (int i = 0; i < 32; ++i) { const int kk = 2 * i + (lane >> 5); scr[kk * 33 + (lane & 31)] = W[(size_t)(k0 + kk) * ldw + src_n0 + (lane & 31)]; }
    asm volatile("s_waitcnt lgkmcnt(0)" ::: "memory");
    const int c = lane & 7;
#pragma unroll
    for (int j = 0; j < 4; ++j) { const int n = (lane >> 3) + 8 * j; const LAS float* s = scr + (8 * c) * 33 + n;
        u32x4 o; o.x = pk2(s[0 * 33], s[1 * 33]); o.y = pk2(s[2 * 33], s[3 * 33]); o.z = pk2(s[4 * 33], s[5 * 33]); o.w = pk2(s[6 * 33], s[7 * 33]);
        bf16_t* d = WT + (size_t)(dst_row0 + n) * ldt + dst_k0 + 8 * c;
        *(u32x4*)d = o; if (dup_off) *(u32x4*)(d + dup_off) = o; }
    asm volatile("s_waitcnt lgkmcnt(0)" ::: "memory");
}
__device__ __forceinline__ void p0_prologue(Frame& F) {
    if (F.bid < 96) {
        LAS float* sc = (LAS float*)F.lds;
        LAS float* part = sc + 17 * 1024;
        for (int i = F.tid; i < 17 * 1024; i += 512) { const int r = i >> 10, k = i & 1023; const float c = r == 0 ? F.in[I_CP][k] : F.in[I_CS][(r - 1) * 1024 + k]; sc[i] = siluf_(c); }
        __syncthreads();
        const int n = F.bid * 64 + F.lane; const float* wa = F.in[I_WADA] + n;
        float acc[17];
#pragma unroll
        for (int r = 0; r < 17; ++r) acc[r] = 0.f;
        for (int k = F.wave * 128; k < F.wave * 128 + 128; k += 4) {
            const float w0 = wa[(size_t)k * 6144], w1 = wa[(size_t)(k + 1) * 6144], w2 = wa[(size_t)(k + 2) * 6144], w3 = wa[(size_t)(k + 3) * 6144];
#pragma unroll
            for (int r = 0; r < 17; ++r) { const f32x4 s = *(const LAS f32x4*)(sc + r * 1024 + k); acc[r] += s[0] * w0 + s[1] * w1 + s[2] * w2 + s[3] * w3; }
        }
#pragma unroll
        for (int r = 0; r < 17; ++r) part[(F.wave * 17 + r) * 64 + F.lane] = acc[r];
        __syncthreads();
        float* mod = (float*)(F.ws + WS_MOD);
        for (int i = F.tid; i < 17 * 64; i += 512) { const int r = i >> 6, l = i & 63; float s = 0.f;
#pragma unroll
            for (int w = 0; w < 8; ++w) s += part[(w * 17 + r) * 64 + l];
            mod[r * 6144 + F.bid * 64 + l] = s + F.in[I_BADA][F.bid * 64 + l]; }
        asm volatile("s_waitcnt vmcnt(0)" ::: "memory");
        __syncthreads();
        if (F.tid == 0) { __builtin_amdgcn_fence(__ATOMIC_RELEASE, "agent"); asm volatile("s_waitcnt vmcnt(0)" ::: "memory");
            __hip_atomic_fetch_add((unsigned*)(F.ws + WS_CTL) + 320, 1u, __ATOMIC_RELAXED, __HIP_MEMORY_SCOPE_AGENT); }
    }
    LAS float* scr = (LAS float*)(F.lds + F.wave * 16384);
    const int gw = F.bid * 8 + F.wave, NGW = F.G * 8;
    constexpr int I_IN = 16 * (NZ / 32), I_A = 8 * 32, I_B = 8 * 32, I_O = 16 * 32, I_FI = 16 * (NFF2 / 32), I_FO = (DFF / 64) * 32;
    constexpr int NITEMS = I_IN + I_A + I_B + I_O + I_FI + I_FO;
    for (int it = gw; it < NITEMS; it += NGW) {
        int r = it;
        if (r < I_IN) { const int nb = NZ / 32, kb = r / nb, n0 = 32 * (r % nb); tr_item(F.in[I_WIN], WIN_COLS, n0 < 3072 ? n0 : n0 + 8, 64 * kb, (bf16_t*)(F.ws + WS_WIN), 1024, n0, 64 * kb, 0, scr, F.lane); continue; } r -= I_IN;
        if (r < I_A) { const int kb = r / 32, n0 = 32 * (r % 32); tr_item(F.in[I_WA], 1024, n0, 64 * kb, (bf16_t*)(F.ws + WS_WAB), 512, n0, 64 * kb, 0, scr, F.lane); continue; } r -= I_A;
        if (r < I_B) { const int kb = r / 32, n0 = 32 * (r % 32); tr_item(F.in[I_WB], 1024, n0, 64 * kb, (bf16_t*)(F.ws + WS_WAB), 512, 1024 + n0, 64 * kb, 0, scr, F.lane); continue; } r -= I_B;
        if (r < I_O) { const int kb = r / 32, n0 = 32 * (r % 32); tr_item(F.in[I_WO], 1024, n0, 64 * kb, (bf16_t*)(F.ws + WS_WO2), 2048, n0, 64 * kb, 1024, scr, F.lane); continue; } r -= I_O;
        if (r < I_FI) { const int nb = NFF2 / 32, kb = r / nb, n0 = 32 * (r % nb), t = n0 >> 8, j = n0 & 255; const int src = j < 128 ? 128 * t + j : DFF + 128 * t + (j - 128);
            tr_item(F.in[I_WFI], NFF2, src, 64 * kb, (bf16_t*)(F.ws + WS_WFI), 1024, n0, 64 * kb, 0, scr, F.lane); continue; } r -= I_FI;
        { const int kb = r / 32, n0 = 32 * (r % 32); tr_item(F.in[I_WFO], 1024, n0, 64 * kb, (bf16_t*)(F.ws + WS_WFO), DFF, n0, 64 * kb, 0, scr, F.lane); }
    }
}

__device__ __forceinline__ void p1_rows(Frame& F, bool wait_mod) {
    LAS float* wf = (LAS float*)F.lds;
    for (int i = F.tid; i < 1024 * 8; i += 512) wf[i] = F.in[I_WIN][(size_t)(i >> 3) * WIN_COLS + 3072 + (i & 7)];
    __syncthreads();
    const float* mod = (const float*)(F.ws + WS_MOD);
    bf16_t* XN = (bf16_t*)(F.ws + WS_XN);
    const int gw = F.bid * 8 + F.wave, NGW = F.G * 8;
    if (wait_mod) {
        if (F.tid == 0) { unsigned* w = (unsigned*)(F.ws + WS_CTL) + 320; unsigned sp = 0;
            while (__hip_atomic_load(w, __ATOMIC_RELAXED, __HIP_MEMORY_SCOPE_AGENT) < 96u && ++sp < (1u << 22)) __builtin_amdgcn_s_sleep(2);
            __builtin_amdgcn_fence(__ATOMIC_ACQUIRE, "agent"); asm volatile("s_waitcnt vmcnt(0)" ::: "memory"); }
        __syncthreads(); }
    for (int m = gw; m < MT; m += NGW) {
        const bool smp = m >= SEQ; const int rb = smp ? 1 + ((m - SEQ) >> 4) : 0;
        const float* xr = smp ? F.in[I_XS] + (size_t)(m - SEQ) * DM : F.in[I_XP] + (size_t)m * DM;
        const float* sh = mod + (size_t)rb * 6144, *scl = sh + 1024;
        float a8[8];
#pragma unroll
        for (int j = 0; j < 8; ++j) a8[j] = 0.f;
#pragma unroll
        for (int j = 0; j < 4; ++j) { const int k = 4 * F.lane + 256 * j;
            const f32x4 x = *(const f32x4*)(xr + k), s1 = *(const f32x4*)(scl + k), t1 = *(const f32x4*)(sh + k);
            const f32x4 h = x * (s1 + 1.0f) + t1;
            u32x2 w; w.x = pk2(h[0], h[1]); w.y = pk2(h[2], h[3]); *(u32x2*)(XN + (size_t)m * DM + k) = w;
#pragma unroll
            for (int e = 0; e < 4; ++e) { const f32x4 wa = *(const LAS f32x4*)(wf + (k + e) * 8), wb = *(const LAS f32x4*)(wf + (k + e) * 8 + 4);
                a8[0] += h[e] * wa[0]; a8[1] += h[e] * wa[1]; a8[2] += h[e] * wa[2]; a8[3] += h[e] * wa[3];
                a8[4] += h[e] * wb[0]; a8[5] += h[e] * wb[1]; a8[6] += h[e] * wb[2]; a8[7] += h[e] * wb[3]; } }
        float mine = 0.f;
#pragma unroll
        for (int j = 0; j < 8; ++j) { const float s = wave_sum(a8[j]); if (F.lane == j) mine = s; }
        if (F.lane < 8) { const float v = mine + F.in[I_BF][F.lane]; const float lf = fminf(v, 0.f) - log1pf(__expf(-fabsf(v)));
            float* o = smp ? F.out + O_FLS + (size_t)(m - SEQ) * 8 : F.out + O_FLP + (size_t)m * 8; o[F.lane] = lf; }
    }
}

__device__ __forceinline__ float block_excl_scan(Frame& F, float tot, LAS float* sm) {
    float inc = tot;
#pragma unroll
    for (int o = 1; o < 64; o <<= 1) { const float t = __shfl_up(inc, o); if (F.lane >= o) inc += t; }
    if (F.lane == 63) sm[F.wave] = inc;
    __syncthreads();
    float base = 0.f;
    for (int w = 0; w < F.wave; ++w) base += sm[w];
    __syncthreads();
    return base + inc - tot;
}
__device__ __forceinline__ void p2_cumsum(Frame& F) {
    LAS float* sm = (LAS float*)F.lds;
    if (F.bid < 8) {
        const int h = F.bid; const float* lf = F.out + O_FLP; float* Fp = (float*)(F.ws + WS_FP) + (size_t)h * SEQ;
        float v[32]; float run = 0.f;
#pragma unroll
        for (int i = 0; i < 32; ++i) { run += lf[(size_t)(32 * F.tid + i) * 8 + h]; v[i] = run; }
        const float off = block_excl_scan(F, run, sm);
#pragma unroll
        for (int i = 0; i < 32; i += 4) *(f32x4*)(Fp + 32 * F.tid + i) = (f32x4){(off + v[i]) * LOG2E, (off + v[i + 1]) * LOG2E, (off + v[i + 2]) * LOG2E, (off + v[i + 3]) * LOG2E};
    } else if (F.bid < 8 + 128) {
        const int b = (F.bid - 8) >> 3, h = (F.bid - 8) & 7;
        const float* cl = F.in[I_CFL] + (size_t)b * PAST * 8; float* Fs = (float*)(F.ws + WS_FS) + (size_t)(b * 8 + h) * SKV;
        float v[4]; float run = 0.f;
#pragma unroll
        for (int i = 0; i < 4; ++i) { run += cl[(size_t)(4 * F.tid + i) * 8 + h]; v[i] = run; }
        const float off = block_excl_scan(F, run, sm);
        *(f32x4*)(Fs + 4 * F.tid) = (f32x4){(off + v[0]) * LOG2E, (off + v[1]) * LOG2E, (off + v[2]) * LOG2E, (off + v[3]) * LOG2E};
        if (F.tid == 511) { float r2 = off + run; const float* ls = F.out + O_FLS + (size_t)b * DEC_T * 8;
            for (int t = 0; t < DEC_T; ++t) { r2 += ls[t * 8 + h]; Fs[PAST + t] = r2 * LOG2E; } }
    }
}

template <bool FINAL> __device__ __forceinline__ void ln_rows(Frame& F, const float* g, const float* b, int KS, int gate_off) {
    const float* mod = (const float*)(F.ws + WS_MOD);
    const bf16_t* T = (const bf16_t*)(F.ws + WS_TB); bf16_t* X1B = (bf16_t*)(F.ws + WS_X1B); bf16_t* XN = (bf16_t*)(F.ws + WS_XN);
    const int gw = F.wave * F.G + F.bid, NGW = F.G * 8;
    for (int m = SEQ + gw; m < MT; m += NGW) {
        f32x4 v[4]; float s = 0.f;
        if (m < SEQ) {
#pragma unroll
            for (int j = 0; j < 2; ++j) { const u32x4 w = *(const u32x4*)(T + (size_t)m * DM + 8 * F.lane + 512 * j);
                v[2 * j] = (f32x4){bflo(w.x), bfhi(w.x), bflo(w.y), bfhi(w.y)}; v[2 * j + 1] = (f32x4){bflo(w.z), bfhi(w.z), bflo(w.w), bfhi(w.w)}; }
        } else {
            const float* sl = (const float*)(F.ws + WS_SLAB) + (size_t)(m - SEQ) * DM; const float* gp = mod + (size_t)(1 + ((m - SEQ) >> 4)) * 6144 + gate_off;
#pragma unroll
            for (int q = 0; q < 4; ++q) { const int k = 8 * F.lane + 512 * (q >> 1) + 4 * (q & 1); f32x4 a = (f32x4){0.f, 0.f, 0.f, 0.f};
                for (int ks = 0; ks < KS; ++ks) a += *(const f32x4*)(sl + (size_t)ks * NSMP * DM + k);
                f32x4 bs;
                if (FINAL) { const u32x2 w = *(const u32x2*)(X1B + (size_t)m * DM + k); bs = (f32x4){bflo(w.x), bfhi(w.x), bflo(w.y), bfhi(w.y)}; }
                else bs = *(const f32x4*)(F.in[I_XS] + (size_t)(m - SEQ) * DM + k);
                v[q] = bs * ALPHA + *(const f32x4*)(gp + k) * a; } }
#pragma unroll
        for (int q = 0; q < 4; ++q) s += (v[q][0] + v[q][1]) + (v[q][2] + v[q][3]);
        const float mean = wave_sum(s) * (1.f / DM); float s2 = 0.f;
#pragma unroll
        for (int q = 0; q < 4; ++q) { v[q] = v[q] - mean; s2 += (v[q][0] * v[q][0] + v[q][1] * v[q][1]) + (v[q][2] * v[q][2] + v[q][3] * v[q][3]); }
        const float rstd = 1.f / sqrtf(wave_sum(s2) * (1.f / DM) + LN_EPS);
        const int rb = m >= SEQ ? 1 + ((m - SEQ) >> 4) : 0;
#pragma unroll
        for (int q = 0; q < 4; ++q) { const int k = 8 * F.lane + 512 * (q >> 1) + 4 * (q & 1); const f32x4 gg = *(const f32x4*)(g + k), bb = *(const f32x4*)(b + k);
            const f32x4 y = v[q] * rstd * gg + bb;
            if (FINAL) *(f32x4*)(F.out + (size_t)m * DM + k) = y;
            else { u32x2 w; w.x = pk2(y[0], y[1]); w.y = pk2(y[2], y[3]); *(u32x2*)(X1B + (size_t)m * DM + k) = w;
                const f32x4 s2v = *(const f32x4*)(mod + (size_t)rb * 6144 + 4096 + k), t2v = *(const f32x4*)(mod + (size_t)rb * 6144 + 3072 + k);
                const f32x4 h = y * (s2v + 1.0f) + t2v; u32x2 w2; w2.x = pk2(h[0], h[1]); w2.y = pk2(h[2], h[3]); *(u32x2*)(XN + (size_t)m * DM + k) = w2; } }
    }
}

__device__ __forceinline__ int t5_bucket(int rel) {
    const int n = rel < 0 ? -rel : rel; int b;
    if (n < 8) b = n; else if (n < 12) b = 8; else if (n < 16) b = 9; else if (n < 23) b = 10; else if (n < 32) b = 11; else if (n < 46) b = 12; else if (n < 64) b = 13; else if (n < 91) b = 14; else b = 15;
    return b + (rel > 0 ? 16 : 0);
}
constexpr int AT_KB = 8192, AT_VB = 20480, AT_BUF = AT_KB + AT_VB;
constexpr int AT_WS = 2 * AT_BUF, AT_OST = AT_WS + 2048, AT_KEEP = 98304, AT_TAB = 131072, AT_MISC = AT_TAB + 4 * 192 * 4, AT_END = AT_MISC + 64;
__device__ __forceinline__ s16x4 vtr(const LAS char* p) { typedef short v4i16_t __attribute__((ext_vector_type(4))); return __builtin_bit_cast(s16x4, __builtin_amdgcn_ds_read_tr16_b64_v4i16((LAS v4i16_t*)p)); }

typedef __bf16 bf16x2_t_ __attribute__((ext_vector_type(2)));
__device__ __forceinline__ unsigned cvtpk_(float lo, float hi) { f32x2 v = {lo, hi}; bf16x2_t_ b = __builtin_convertvector(v, bf16x2_t_); return __builtin_bit_cast(unsigned, b); }
__device__ __forceinline__ void glds16_asm(const void* gsrc, unsigned lds_dst) { unsigned keep;
    asm volatile("s_mov_b32 %0, m0\n\ts_mov_b32 m0, %2\n\ts_nop 0\n\tglobal_load_lds_dwordx4 %1, off\n\ts_mov_b32 m0, %0" : "=&s"(keep) : "v"(gsrc), "s"(lds_dst) : "memory"); }
template <int OFF> __device__ __forceinline__ void glds16_asm_off(const void* gsrc, unsigned lds_dst) { unsigned keep;
    asm volatile("s_mov_b32 %0, m0\n\ts_mov_b32 m0, %2\n\ts_nop 0\n\tglobal_load_lds_dwordx4 %1, off offset:%3\n\ts_mov_b32 m0, %0" : "=&s"(keep) : "v"(gsrc), "s"(lds_dst), "i"(OFF) : "memory"); }
template <int OFF> __device__ __forceinline__ void glds16_s(const void* sbase, unsigned voff, unsigned lds_dst) { unsigned keep;
    asm volatile("s_mov_b32 %0, m0\n\ts_mov_b32 m0, %3\n\ts_nop 0\n\tglobal_load_lds_dwordx4 %1, %2 offset:%4\n\ts_mov_b32 m0, %0" : "=&s"(keep) : "v"(voff), "s"(sbase), "s"(lds_dst), "i"(OFF) : "memory"); }
__device__ __forceinline__ void glds4_s(const void* sbase, unsigned voff, unsigned lds_dst) { unsigned keep;
    asm volatile("s_mov_b32 %0, m0\n\ts_mov_b32 m0, %3\n\ts_nop 0\n\tglobal_load_lds_dword %1, %2\n\ts_mov_b32 m0, %0" : "=&s"(keep) : "v"(voff), "s"(sbase), "s"(lds_dst) : "memory"); }
__device__ __forceinline__ const void* uniform_ptr(const void* p) { const unsigned long long v = (unsigned long long)p;
    const unsigned lo = (unsigned)__builtin_amdgcn_readfirstlane((int)(unsigned)v), hi = (unsigned)__builtin_amdgcn_readfirstlane((int)(unsigned)(v >> 32)); return (const void*)(((unsigned long long)hi << 32) | lo); }
__device__ __forceinline__ void glds4_asm(const void* gsrc, unsigned lds_dst) { unsigned keep;
    asm volatile("s_mov_b32 %0, m0\n\ts_mov_b32 m0, %2\n\ts_nop 0\n\tglobal_load_lds_dword %1, off\n\ts_mov_b32 m0, %0" : "=&s"(keep) : "v"(gsrc), "s"(lds_dst) : "memory"); }
constexpr int R_V = 0, R_K = 49152, R_F = 73728, R_WS = 79872;
__device__ __forceinline__ float max3f_(float a, float b, float c) { float r; asm("v_max3_f32 %0, %1, %2, %3" : "=v"(r) : "v"(a), "v"(b), "v"(c)); return r; }
__device__ __forceinline__ float max2f_(float a, float b) { float r; asm("v_max_f32_e32 %0, %1, %2" : "=v"(r) : "v"(a), "v"(b)); return r; }
#define AP3_PIN(x) asm volatile("" : "+v"(x))
template <int MODE, int DV, int pv = 0, bool SREF = false>
__device__ __forceinline__ void attn_pass3(Frame& F, const bf16_t* Q, const bf16_t* K, const bf16_t* V, int q0, int NT, const float* Fh, int hb, f32x16 (&o)[DV / 32], int t0 = 0) {
    constexpr int NDB = DV / 32, VS = DV * 128, EPG = 8 / NDB;
    constexpr float THR = 8.0f;
    const int lane = F.lane, r32 = lane & 31, hi = lane >> 5, wid = F.wave;
    const LAS char* lds = (const LAS char*)F.lds;
    LAS float* wsf = (LAS float*)(F.lds + R_WS) + wid * 64;
    const LAS float* tab = (const LAS float*)(F.lds + AT_TAB) + hb * 192;
    const int qrow = q0 + wid * 32 + r32;
    const int tmaxw = (q0 >> 6) + (wid >> 1);
    const char* Ku = (const char*)uniform_ptr(K); const char* Vu = (const char*)uniform_ptr(V); const char* Fu = (const char*)uniform_ptr(MODE == 0 ? (const void*)Fh : (const void*)K);
    const unsigned kvo = (unsigned)(((8 * wid + (lane >> 3)) * 512 + (((lane & 7) ^ (lane >> 3)) << 3)) * 2);
    const unsigned vvo = (unsigned)(((16 * (wid & 3) + (lane >> 2)) * 512 + 32 * (wid >> 2) + 8 * (lane & 3)) * 2);
    const unsigned fvo = (unsigned)(lane * 4);
    const unsigned lds0 = (unsigned)(size_t)F.lds;
    const unsigned dk = (unsigned)__builtin_amdgcn_readfirstlane((int)(lds0 + R_K + wid * 1024)), dv = (unsigned)__builtin_amdgcn_readfirstlane((int)(lds0 + R_V + wid * 1024)),
                   df = (unsigned)__builtin_amdgcn_readfirstlane((int)(lds0 + R_F + wid * 256));
#define AP_ISSUE_K(t, SL) do { glds16_s<0>(Ku + (size_t)(t) * 65536, kvo, dk + (SL) * 8192); if (MODE == 0) glds4_s(Fu + (size_t)(t) * 256, fvo, df + (SL) * 2048); } while (0)
#define AP_ISSUE_V(t, SL) do { glds16_s<0>(Vu + (size_t)(t) * 65536, vvo, dv + (SL) * VS); if (DV == 128) glds16_s<0>(Vu + (size_t)(t) * 65536 + 128, vvo, dv + (SL) * VS + 8192); } while (0)
#define AP_BATCH(t, SL) do { if (pv != 1) { if ((t) + 2 < NT) AP_ISSUE_K((t) + 2, ((SL) + 2) % 3); if ((t) + 1 < NT) AP_ISSUE_V((t) + 1, ((SL) + 1) % 3); } } while (0)
    AP_ISSUE_K(t0, 0); AP_ISSUE_K(t0 + 1, 1); AP_ISSUE_V(t0, 0);
    bf16x8 qr[4];
#pragma unroll
    for (int d0 = 0; d0 < 4; ++d0) qr[d0] = *(const bf16x8*)(Q + (size_t)qrow * 512 + d0 * 16 + hi * 8);
    float fqp = MODE == 0 ? Fh[qrow] : 0.f;
#pragma unroll
    for (int d = 0; d < NDB; ++d) o[d] = f32x16{};
    float m_hat = 0.f, l_run = 0.f;
    f32x16 p0, p1, negm; u32x4 pwv[4];
#pragma unroll
    for (int r = 0; r < 16; ++r) negm[r] = 0.f;
#pragma unroll
    for (int i = 0; i < 4; ++i) pwv[i] = (u32x4){0u, 0u, 0u, 0u};
    const LAS char* kb4[4];
#pragma unroll
    for (int d0 = 0; d0 < 4; ++d0) kb4[d0] = lds + R_K + r32 * 128 + (((2 * d0 + hi) ^ (r32 & 7)) << 4);
    const LAS char* vb1 = lds + R_V + (4 * hi + ((lane & 15) >> 2)) * 64 + (((lane >> 4) & 1) * 16 + (lane & 3) * 4) * 2;
    const LAS char* fb1 = lds + R_F + wid * 256 + 16 * hi;
    asm volatile("s_waitcnt vmcnt(0)" ::: "memory");
    asm volatile("" : "+v"(qr[0]), "+v"(qr[1]), "+v"(qr[2]), "+v"(qr[3]), "+v"(fqp));
    asm volatile("s_waitcnt lgkmcnt(0)\n\ts_barrier" ::: "memory");
#define AP3_VFL(buf, ks, SLV) do { _Pragma("unroll") for (int d = 0; d < NDB; ++d) { buf[2 * d] = vtr(vb1 + (SLV) * VS + d * 4096 + (ks) * 1024); buf[2 * d + 1] = vtr(vb1 + (SLV) * VS + d * 4096 + (ks) * 1024 + 512); } } while (0)
#define AP3_VFL1(buf, d, ks, SLV) do { buf[2 * (d)] = vtr(vb1 + (SLV) * VS + (d) * 4096 + (ks) * 1024); buf[2 * (d) + 1] = vtr(vb1 + (SLV) * VS + (d) * 4096 + (ks) * 1024 + 512); } while (0)
#define AP3_FRAG(buf, d) ((bf16x8){buf[2 * (d)][0], buf[2 * (d)][1], buf[2 * (d)][2], buf[2 * (d)][3], buf[2 * (d) + 1][0], buf[2 * (d) + 1][1], buf[2 * (d) + 1][2], buf[2 * (d) + 1][3]})
#define AP3_GAP(ks, d, VCUR, VNXT, PC, BC, PP, BP, HASPREV, HASNEXT, SLV) do { \
        o[d] = __builtin_amdgcn_mfma_f32_32x32x16_bf16(__builtin_bit_cast(bf16x8, pwv[ks]), AP3_FRAG(VCUR, d), o[d], 0, 0, 0); \
        if (HASNEXT) AP3_VFL1(VNXT, d, (ks) + 1, SLV); \
        _Pragma("unroll") for (int e = 0; e < EPG; ++e) { PC[(BC) + EPG * (d) + e] = __builtin_amdgcn_exp2f(PC[(BC) + EPG * (d) + e]); } \
        if (HASPREV) { _Pragma("unroll") for (int e = 0; e < EPG; ++e) rs += PP[(BP) + EPG * (d) + e]; \
            _Pragma("unroll") for (int e = 0; e < EPG / 2; ++e) pwv[(ks) - 1][(EPG / 2) * (d) + e] = cvtpk_(PP[(BP) + EPG * (d) + 2 * e], PP[(BP) + EPG * (d) + 2 * e + 1]); AP3_PIN(rs); } \
        AP3_PIN(PC); \
        __builtin_amdgcn_sched_barrier(0); } while (0)
#define AP3_GROUP(ks, VCUR, VNXT, PC, BC, PP, BP, HASPREV, HASNEXT, SLV) do { _Pragma("unroll") for (int d = 0; d < NDB; ++d) AP3_GAP(ks, d, VCUR, VNXT, PC, BC, PP, BP, HASPREV, HASNEXT, SLV); } while (0)
#define AP3_OCT(PC, BC, KS) do { _Pragma("unroll") for (int e = 0; e < 8; ++e) { PC[(BC) + e] = __builtin_amdgcn_exp2f(PC[(BC) + e]); rs += PC[(BC) + e]; } \
        _Pragma("unroll") for (int e = 0; e < 4; ++e) pwv[KS][e] = cvtpk_(PC[(BC) + 2 * e], PC[(BC) + 2 * e + 1]); } while (0)
#define AP3_KRD(i, SL) (*(const LAS bf16x8*)(kb4[(i) >> 1] + (SL) * 8192 + ((i) & 1) * 4096))
#define AP3_MM(KF, d0, P) P = __builtin_amdgcn_mfma_f32_32x32x16_bf16(KF, qr[d0], P, 0, 0, 0)
#define AP3_QKF(SL) do { bf16x8 ka = AP3_KRD(0, SL), kb = AP3_KRD(1, SL), kc = AP3_KRD(2, SL); \
        if (MODE == 0) { \
            _Pragma("unroll") for (int g4 = 0; g4 < 4; ++g4) { const f32x4 fa = *(const LAS f32x4*)(fb1 + (SL) * 2048 + 32 * g4), fb = *(const LAS f32x4*)(fb1 + (SL) * 2048 + 128 + 32 * g4); \
                _Pragma("unroll") for (int e = 0; e < 4; ++e) { p0[4 * g4 + e] = fqp - fa[e]; p1[4 * g4 + e] = fqp - fb[e]; } } \
        } else { p0 = f32x16{}; p1 = f32x16{}; } \
        __builtin_amdgcn_sched_barrier(0); \
        AP3_MM(ka, 0, p0); ka = AP3_KRD(3, SL); __builtin_amdgcn_sched_barrier(0); \
        AP3_MM(kb, 0, p1); kb = AP3_KRD(4, SL); __builtin_amdgcn_sched_barrier(0); \
        AP3_MM(kc, 1, p0); kc = AP3_KRD(5, SL); __builtin_amdgcn_sched_barrier(0); \
        AP3_MM(ka, 1, p1); ka = AP3_KRD(6, SL); __builtin_amdgcn_sched_barrier(0); \
        AP3_MM(kb, 2, p0); kb = AP3_KRD(7, SL); __builtin_amdgcn_sched_barrier(0); \
        AP3_MM(kc, 2, p1); __builtin_amdgcn_sched_barrier(0); \
        AP3_MM(ka, 3, p0); __builtin_amdgcn_sched_barrier(0); \
        AP3_MM(kb, 3, p1); \
        asm volatile("" : "+v"(p0), "+v"(p1)); \
    } while (0)
#define AP3_QKS(SL) do { bf16x8 kf[8]; \
        _Pragma("unroll") for (int d0 = 0; d0 < 4; ++d0) { kf[2 * d0] = *(const LAS bf16x8*)(kb4[d0] + (SL) * 8192); kf[2 * d0 + 1] = *(const LAS bf16x8*)(kb4[d0] + (SL) * 8192 + 4096); } \
        if (MODE == 0) { const float sft = fqp - m_hat; \
            _Pragma("unroll") for (int g4 = 0; g4 < 4; ++g4) { const f32x4 fa = *(const LAS f32x4*)(fb1 + (SL) * 2048 + 32 * g4), fb = *(const LAS f32x4*)(fb1 + (SL) * 2048 + 128 + 32 * g4); \
                _Pragma("unroll") for (int e = 0; e < 4; ++e) { p0[4 * g4 + e] = sft - fa[e]; p1[4 * g4 + e] = sft - fb[e]; } } \
            _Pragma("unroll") for (int d0 = 0; d0 < 4; ++d0) { p0 = __builtin_amdgcn_mfma_f32_32x32x16_bf16(kf[2 * d0], qr[d0], p0, 0, 0, 0); p1 = __builtin_amdgcn_mfma_f32_32x32x16_bf16(kf[2 * d0 + 1], qr[d0], p1, 0, 0, 0); } \
        } else { \
            if constexpr (SREF) { p0 = __builtin_amdgcn_mfma_f32_32x32x16_bf16(kf[0], qr[0], f32x16{}, 0, 0, 0); p1 = __builtin_amdgcn_mfma_f32_32x32x16_bf16(kf[1], qr[0], f32x16{}, 0, 0, 0); } \
            else { p0 = __builtin_amdgcn_mfma_f32_32x32x16_bf16(kf[0], qr[0], negm, 0, 0, 0); p1 = __builtin_amdgcn_mfma_f32_32x32x16_bf16(kf[1], qr[0], negm, 0, 0, 0); } \
            _Pragma("unroll") for (int d0 = 1; d0 < 4; ++d0) { p0 = __builtin_amdgcn_mfma_f32_32x32x16_bf16(kf[2 * d0], qr[d0], p0, 0, 0, 0); p1 = __builtin_amdgcn_mfma_f32_32x32x16_bf16(kf[2 * d0 + 1], qr[d0], p1, 0, 0, 0); } } \
        if constexpr (SREF) asm volatile("" : "+v"(p0), "+v"(p1)); else asm volatile("s_nop 15\n\ts_nop 7" : "+v"(p0), "+v"(p1));     \
    } while (0)
#define AP3_QK(SL) do { if constexpr (SREF) AP3_QKF(SL); else AP3_QKS(SL); } while (0)
#define AP3_DECIDE(WITH_TAB) do { \
        if (MODE == 0) { \
            if (t * 64 + 63 > q0 + wid * 32) { const int ln_ = lane_id_opaque(), kv0 = t * 64 + 4 * (ln_ >> 5), qrow_ = q0 + wid * 32 + (ln_ & 31);     \
                _Pragma("unroll") for (int r = 0; r < 16; ++r) { const int kv = kv0 + (r & 3) + 8 * (r >> 2); if (kv > qrow_) p0[r] = -1e30f; if (kv + 32 > qrow_) p1[r] = -1e30f; } } \
        } else if (WITH_TAB) { \
            if (near) { const int ln_ = lane_id_opaque(), kv0 = t * 64 + 4 * (ln_ >> 5), qrow_ = q0 + wid * 32 + (ln_ & 31); const LAS float* tab_ = (const LAS float*)(F.lds + AT_TAB) + hb * 192; \
                _Pragma("unroll") for (int g4 = 0; g4 < 4; ++g4) { \
                    _Pragma("unroll") for (int e = 0; e < 4; ++e) { const int r = 4 * g4 + e; const int rel = kv0 + e + 8 * g4 - qrow_; int i0 = rel + 128, i1 = rel + 160; i0 = i0 < 0 ? 0 : i0; i1 = i1 < 0 ? 0 : i1; \
                        p0[r] += tab_[i0]; p1[r] += tab_[i1]; } \
                    __builtin_amdgcn_sched_barrier(0); } } } \
        if constexpr (!SREF) { \
        float ma = max3f_(p0[0], p0[1], p1[0]), mb = max3f_(p0[2], p0[3], p1[1]); ma = max3f_(ma, p1[2], p1[3]); \
        _Pragma("unroll") for (int r = 4; r < 16; r += 4) { ma = max3f_(ma, p0[r], p0[r + 1]); mb = max3f_(mb, p0[r + 2], p0[r + 3]); ma = max3f_(ma, p1[r], p1[r + 1]); mb = max3f_(mb, p1[r + 2], p1[r + 3]); } \
        float rm = max2f_(ma, mb); \
        { auto rr = __builtin_amdgcn_permlane32_swap(__float_as_uint(rm), __float_as_uint(rm), false, false); rm = max2f_(__uint_as_float(rr[0]), __uint_as_float(rr[1])); } \
        resc = (tz == t0) || __any(rm > THR); \
        if (resc) { const float dl = tz == t0 ? rm : fmaxf(rm, 0.f); m_hat += dl; \
            _Pragma("unroll") for (int r = 0; r < 16; ++r) { p0[r] -= dl; p1[r] -= dl; } \
            if (MODE == 1) { const float nm_ = -m_hat; _Pragma("unroll") for (int r = 0; r < 16; ++r) negm[r] = nm_; } \
            al = tz == t0 ? 1.0f : __builtin_amdgcn_exp2f(-dl); l_run *= al; } } } while (0)
#define AP3_STEP(tt, SL) do { const int t = (tt); if (t > NT) break; int tz = t; asm volatile("" : "+s"(tz)); \
        if (t < NT) AP_BATCH(t, SL); \
        const bool doPV = tz > t0 && t - 1 <= tmaxw, doQK = t < NT && t <= tmaxw; \
        bool resc = false; float al = 1.0f, rs = 0.f; \
        const bool near = MODE == 1 && (t * 64 + 63 + 91 > q0 + wid * 32); \
        if (doQK) AP3_QK(SL); else { p0 = f32x16{}; p1 = f32x16{}; }     \
        __builtin_amdgcn_sched_barrier(0); \
        if (doQK) AP3_DECIDE(true); \
        __builtin_amdgcn_sched_barrier(0); \
        if (doPV) { s16x4 vfa[2 * NDB]; AP3_VFL(vfa, 0, ((SL) + 2) % 3);     \
            AP3_GROUP(0, vfa, vfa, p0, 0, p0, 0, false, true, ((SL) + 2) % 3); \
            AP3_GROUP(1, vfa, vfa, p0, 8, p0, 0, true, true, ((SL) + 2) % 3); \
            AP3_GROUP(2, vfa, vfa, p1, 0, p0, 8, true, true, ((SL) + 2) % 3); \
            AP3_GROUP(3, vfa, vfa, p1, 8, p1, 0, true, false, ((SL) + 2) % 3); \
            _Pragma("unroll") for (int e = 0; e < 8; ++e) rs += p1[8 + e]; \
            _Pragma("unroll") for (int e = 0; e < 4; ++e) pwv[3][e] = cvtpk_(p1[8 + 2 * e], p1[8 + 2 * e + 1]); \
        } else if (doQK) { AP3_OCT(p0, 0, 0); AP3_OCT(p0, 8, 1); AP3_OCT(p1, 0, 2); AP3_OCT(p1, 8, 3); } \
        if (doQK) l_run += rs; \
          \
        if (resc && tz > t0) { \
            if (hi == 0) wsf[r32] = al; \
            asm volatile("s_waitcnt lgkmcnt(0)" ::: "memory"); \
            _Pragma("unroll") for (int g4 = 0; g4 < 4; ++g4) { const f32x4 a4 = *(const LAS f32x4*)(wsf + 8 * g4 + 4 * hi); \
                _Pragma("unroll") for (int d = 0; d < NDB; ++d) \
                    _Pragma("unroll") for (int e = 0; e < 4; ++e) o[d][4 * g4 + e] *= a4[e]; } } \
        if (t == NT) break; \
        if (pv == 6) { if (t + 2 < NT) asm volatile("s_waitcnt vmcnt(3) lgkmcnt(0)" ::: "memory"); else asm volatile("s_waitcnt vmcnt(0) lgkmcnt(0)" ::: "memory"); } \
        else { if (t + 2 < NT) asm volatile("s_waitcnt vmcnt(3) lgkmcnt(0)\n\ts_barrier" ::: "memory"); else asm volatile("s_waitcnt vmcnt(0) lgkmcnt(0)\n\ts_barrier" ::: "memory"); } \
    } while (0)
#define AP3_FSTEP(tt, SL) do { const int t = (tt); \
        AP_ISSUE_K(t + 2, ((SL) + 2) % 3); AP_ISSUE_V(t + 1, ((SL) + 1) % 3); \
        float rs = 0.f; \
        AP3_QKF(SL); \
        __builtin_amdgcn_sched_barrier(0); \
        { s16x4 vfa[2 * NDB]; AP3_VFL(vfa, 0, ((SL) + 2) % 3); \
          AP3_GROUP(0, vfa, vfa, p0, 0, p0, 0, false, true, ((SL) + 2) % 3); \
          AP3_GROUP(1, vfa, vfa, p0, 8, p0, 0, true, true, ((SL) + 2) % 3); \
          AP3_GROUP(2, vfa, vfa, p1, 0, p0, 8, true, true, ((SL) + 2) % 3); \
          AP3_GROUP(3, vfa, vfa, p1, 8, p1, 0, true, false, ((SL) + 2) % 3); \
          _Pragma("unroll") for (int e = 0; e < 8; ++e) rs += p1[8 + e]; \
          _Pragma("unroll") for (int e = 0; e < 4; ++e) pwv[3][e] = cvtpk_(p1[8 + 2 * e], p1[8 + 2 * e + 1]); } \
        l_run += rs; \
        asm volatile("s_waitcnt vmcnt(3) lgkmcnt(0)\n\ts_barrier" ::: "memory"); \
    } while (0)
    if (wid >= 4) __builtin_amdgcn_s_setprio(1);
    int t3 = t0;
    if constexpr (SREF && pv == 0) {
        AP3_STEP(t3, 0); AP3_STEP(t3 + 1, 1); AP3_STEP(t3 + 2, 2); t3 += 3;
        const int tfe = (q0 >> 6) - 3;
        for (; t3 + 2 <= tfe; t3 += 3) { AP3_FSTEP(t3, 0); AP3_FSTEP(t3 + 1, 1); AP3_FSTEP(t3 + 2, 2); }
    }
    for (; t3 <= NT; t3 += 3) { AP3_STEP(t3, 0); AP3_STEP(t3 + 1, 1); AP3_STEP(t3 + 2, 2); }
    if (wid >= 4) __builtin_amdgcn_s_setprio(0);
    asm volatile("s_waitcnt lgkmcnt(0)\n\ts_barrier" ::: "memory");
    l_run += __shfl_xor(l_run, 32);
    if (hi == 0) wsf[r32] = 1.0f / l_run;
    asm volatile("s_waitcnt lgkmcnt(0)" ::: "memory");
#pragma unroll
    for (int g4 = 0; g4 < 4; ++g4) { const f32x4 a4 = *(const LAS f32x4*)(wsf + 8 * g4 + 4 * hi);
#pragma unroll
        for (int d = 0; d < NDB; ++d)
#pragma unroll
            for (int e = 0; e < 4; ++e) o[d][4 * g4 + e] *= a4[e]; }
#undef AP_ISSUE_K
#undef AP_ISSUE_V
#undef AP_BATCH
#undef AP3_VFL
#undef AP3_VFL1
#undef AP3_FRAG
#undef AP3_GAP
#undef AP3_GROUP
#undef AP3_OCT
#undef AP3_STEP
#undef AP3_FSTEP
#undef AP3_QK
#undef AP3_QKF
#undef AP3_QKS
#undef AP3_KRD
#undef AP3_MM
#undef AP3_DECIDE
}

template <int NDB> __device__ __forceinline__ void store_o(const f32x16 (&o)[NDB], LAS unsigned char* stgb  , bf16_t* dst  , int ld, int lane) {
    const int r32 = lane & 31, hi = lane >> 5;
    constexpr int DVC = 32 * NDB;
    LAS bf16_t* stg = (LAS bf16_t*)stgb;
#pragma unroll
    for (int d = 0; d < NDB; ++d)
#pragma unroll
        for (int r = 0; r < 16; ++r) { const int row = (r & 3) + 8 * (r >> 2) + 4 * hi; stg[row * DVC + 32 * d + r32] = (bf16_t)f2bf(o[d][r]); }
    asm volatile("s_waitcnt lgkmcnt(0)" ::: "memory");
    constexpr int CPR = DVC / 8;
#pragma unroll
    for (int i = 0; i < (32 * CPR) / 64; ++i) { const int c = i * 64 + lane, row = c / CPR, ch = c % CPR;
        const u32x4 v = *(const LAS u32x4*)(stg + row * DVC + ch * 8); *(u32x4*)(dst + (size_t)row * ld + ch * 8) = v; }
    asm volatile("s_waitcnt lgkmcnt(0)" ::: "memory");
}

__device__ __forceinline__ float lambda_full(Frame& F) {
    float a = 0.f, b = 0.f;
    for (int i = 0; i < 64; ++i) { a += F.in[I_LQ1][i] * F.in[I_LK1][i]; b += F.in[I_LQ2][i] * F.in[I_LK2][i]; }
    return __expf(a) - __expf(b) + 0.2f;
}

template <int pv = 0> __device__ __forceinline__ void attn_prompt_fox(Frame& F, int h, int qb) {
    const bf16_t* Q = (const bf16_t*)(F.ws + WS_QB) + h * 64; const bf16_t* K = (const bf16_t*)(F.ws + WS_KB) + h * 64; const bf16_t* V = (const bf16_t*)(F.ws + WS_VB) + h * 64;
    f32x16 o[2];
    const float* Fh = (const float*)(F.ws + WS_FP) + (size_t)h * SEQ;
    int t0 = 0; bool fast;
    { const unsigned* nw = (const unsigned*)(F.ws + WS_CTL) + 256;
      const float qn2 = __uint_as_float(nw[h * 2]) + __uint_as_float(nw[h * 2 + 1]), kn2 = __uint_as_float(nw[16 + h * 2]) + __uint_as_float(nw[16 + h * 2 + 1]);
      const float B = sqrtf(qn2 * kn2) * 1.02f + 0.5f;
      const float thresh = -48.0f - 2.0f * B;
      fast = __builtin_amdgcn_readfirstlane(B <= 60.0f ? 1 : 0) != 0;
      volatile LAS int* cnt = (volatile LAS int*)(F.lds + AT_MISC + 32);
      __syncthreads();
      if (F.tid < 256) { const int t = F.tid; const bool sk = t < 4 * qb && (Fh[qb * 256] - Fh[64 * t + 63]) <= thresh;
          const int c = __popcll(__ballot(sk)); if (F.lane == 0) cnt[F.wave] = c; }
      __syncthreads();
      t0 = cnt[0] + cnt[1] + cnt[2] + cnt[3]; t0 -= t0 % 3; }
    if (fast) attn_pass3<0, 64, pv, true>(F, Q, K, V, qb * 256, 4 * qb + 4, Fh, 0, o, t0); else attn_pass3<0, 64, pv, false>(F, Q, K, V, qb * 256, 4 * qb + 4, Fh, 0, o, t0);
    if (pv != 0 && o[0][0] != 1234.5678f) { __syncthreads(); return; }
    bf16_t* AB = (bf16_t*)(F.ws + WS_AB);
    store_o<2>(o, F.lds + F.wave * 8192, AB + (size_t)(qb * 256 + F.wave * 32) * DM + 512 + h * 64, DM, F.lane);
    __syncthreads();
}
template <int pv = 0> __device__ __forceinline__ void attn_prompt_diff_half(Frame& F, int h, int half, int qb) {
    const bf16_t* Q = (const bf16_t*)(F.ws + WS_QA) + h * 128 + 64 * half; const bf16_t* K = (const bf16_t*)(F.ws + WS_KA) + h * 128 + 64 * half; const bf16_t* V = (const bf16_t*)(F.ws + WS_VA) + h * 128;
    f32x16 o[4];
    bool fast;
    { const unsigned* nw = (const unsigned*)(F.ws + WS_CTL) + 288; const int hh = h * 2 + half;
      const float qn2 = __uint_as_float(nw[hh * 2]) + __uint_as_float(nw[hh * 2 + 1]), kn2 = __uint_as_float(nw[16 + hh * 2]) + __uint_as_float(nw[16 + hh * 2 + 1]);
      float bm = 0.f; for (int b = 0; b < 32; ++b) bm = fmaxf(bm, fabsf(F.in[I_RELB][b * 4 + h] - F.in[I_RELB][15 * 4 + h]));
      const float B = sqrtf(qn2 * kn2) * 1.02f + 0.5f + bm * LOG2E;
      fast = __builtin_amdgcn_readfirstlane(B <= 60.0f ? 1 : 0) != 0; }
    if (fast) attn_pass3<1, 128, pv, true>(F, Q, K, V, qb * 256, 4 * qb + 4, nullptr, h, o); else attn_pass3<1, 128, pv, false>(F, Q, K, V, qb * 256, 4 * qb + 4, nullptr, h, o);
    if (pv != 0 && o[0][0] != 1234.5678f) { __syncthreads(); return; }
    bf16_t* OD = (bf16_t*)(F.ws + (half ? WS_OD2 : WS_OD1));
    store_o<4>(o, F.lds + F.wave * 8192, OD + (size_t)(qb * 256 + F.wave * 32) * 512 + h * 128, 512, F.lane);
    __syncthreads();
}
constexpr int PF_STR = 66, PD_STR = 130;
__device__ __forceinline__ void p_combine(Frame& F) {
    const float lam = lambda_full(F);
    const bf16_t* O1 = (const bf16_t*)(F.ws + WS_OD1); const bf16_t* O2 = (const bf16_t*)(F.ws + WS_OD2); bf16_t* AB = (bf16_t*)(F.ws + WS_AB);
    const int gw = F.bid * 8 + F.wave, NGW = F.G * 8;
    const int c0 = 8 * F.lane;
    float sg[8];
#pragma unroll
    for (int i = 0; i < 8; ++i) sg[i] = F.in[I_SUBG][(c0 & 127) + i] * 0.8f;
    for (int m = gw; m < SEQ; m += NGW) {
        const u32x4 a = *(const u32x4*)(O1 + (size_t)m * 512 + c0), b = *(const u32x4*)(O2 + (size_t)m * 512 + c0);
        float v[8];
        v[0] = bflo(a.x) - lam * bflo(b.x); v[1] = bfhi(a.x) - lam * bfhi(b.x); v[2] = bflo(a.y) - lam * bflo(b.y); v[3] = bfhi(a.y) - lam * bfhi(b.y);
        v[4] = bflo(a.z) - lam * bflo(b.z); v[5] = bfhi(a.z) - lam * bfhi(b.z); v[6] = bflo(a.w) - lam * bflo(b.w); v[7] = bfhi(a.w) - lam * bfhi(b.w);
        float ss = 0.f;
#pragma unroll
        for (int i = 0; i < 8; ++i) ss += v[i] * v[i];
#pragma unroll
        for (int ofs = 1; ofs < 16; ofs <<= 1) ss += __shfl_xor(ss, ofs);
        const float rn = 1.0f / sqrtf(ss * (1.0f / 128.0f) + LN_EPS);
        u32x4 w; w.x = pk2(v[0] * rn * sg[0], v[1] * rn * sg[1]); w.y = pk2(v[2] * rn * sg[2], v[3] * rn * sg[3]); w.z = pk2(v[4] * rn * sg[4], v[5] * rn * sg[5]); w.w = pk2(v[6] * rn * sg[6], v[7] * rn * sg[7]);
        *(u32x4*)(AB + (size_t)m * DM + c0) = w;
    }
    for (int it = gw; it < NSMP; it += NGW) {
        const int b = it >> 4, q = it & 15; const size_t row = (size_t)SEQ + it;
        {
            const int h = F.lane >> 3, cc = (F.lane & 7) * 8; const float* P = (const float*)(F.ws + WS_PF);
            float M = -1e30f;
            for (int s = 0; s < 8; ++s) M = fmaxf(M, P[((size_t)((b * 8 + s) * 8 + h) * 16 + q) * PF_STR + 64]);
            float acc[8], L = 0.f;
#pragma unroll
            for (int i = 0; i < 8; ++i) acc[i] = 0.f;
            for (int s = 0; s < 8; ++s) { const float* pr = P + ((size_t)((b * 8 + s) * 8 + h) * 16 + q) * PF_STR; const float wgt = __builtin_amdgcn_exp2f(pr[64] - M); L += wgt * pr[65];
#pragma unroll
                for (int i = 0; i < 8; ++i) acc[i] += wgt * pr[cc + i]; }
            const float inv = 1.0f / L;
            u32x4 w; w.x = pk2(acc[0] * inv, acc[1] * inv); w.y = pk2(acc[2] * inv, acc[3] * inv); w.z = pk2(acc[4] * inv, acc[5] * inv); w.w = pk2(acc[6] * inv, acc[7] * inv);
            *(u32x4*)(AB + row * DM + 512 + c0) = w; }
        {
            const int h = F.lane >> 4, cc = (F.lane & 15) * 8; const float* P = (const float*)(F.ws + WS_PD);
            float v[8];
#pragma unroll
            for (int i = 0; i < 8; ++i) v[i] = 0.f;
#pragma unroll
            for (int half = 0; half < 2; ++half) {
                float M = -1e30f;
                for (int s = 0; s < 8; ++s) M = fmaxf(M, P[((size_t)((b * 8 + s) * 8 + 2 * h + half) * 16 + q) * PD_STR + 128]);
                float acc[8], L = 0.f;
#pragma unroll
                for (int i = 0; i < 8; ++i) acc[i] = 0.f;
                for (int s = 0; s < 8; ++s) { const float* pr = P + ((size_t)((b * 8 + s) * 8 + 2 * h + half) * 16 + q) * PD_STR; const float wgt = __builtin_amdgcn_exp2f(pr[128] - M); L += wgt * pr[129];
#pragma unroll
                    for (int i = 0; i < 8; ++i) acc[i] += wgt * pr[cc + i]; }
                const float sc = (half ? -lam : 1.0f) / L;
#pragma unroll
                for (int i = 0; i < 8; ++i) v[i] += acc[i] * sc; }
            float ss = 0.f;
#pragma unroll
            for (int i = 0; i < 8; ++i) ss += v[i] * v[i];
#pragma unroll
            for (int ofs = 1; ofs < 16; ofs <<= 1) ss += __shfl_xor(ss, ofs);
            const float rn = 1.0f / sqrtf(ss * (1.0f / 128.0f) + LN_EPS);
            u32x4 w; w.x = pk2(v[0] * rn * sg[0], v[1] * rn * sg[1]); w.y = pk2(v[2] * rn * sg[2], v[3] * rn * sg[3]); w.z = pk2(v[4] * rn * sg[4], v[5] * rn * sg[5]); w.w = pk2(v[6] * rn * sg[6], v[7] * rn * sg[7]);
            *(u32x4*)(AB + row * DM + c0) = w; }
    }
}

constexpr int SM_K = 0, SM_V = 32768, SM_F = 81920, SM_WS = 83968;
template <int KIND  > __device__ __forceinline__ void sample_unit(Frame& F, int b, int s) {
    constexpr int DV = KIND == 0 ? 64 : 128, NDB = DV / 32, VSTR = KIND == 0 ? 192 : 320, VSUB = 16 * VSTR;
    const int lane = lane_id_opaque(), r32 = lane & 31, hi = lane >> 5, w = F.wave, tid = w * 64 + lane;
    const LAS char* lds = (const LAS char*)F.lds;
    LAS float* wsf = (LAS float*)(F.lds + SM_WS) + w * 64;
    const int hb = KIND == 0 ? w : (w >> 1);
    const LAS float* tab = (const LAS float*)(F.lds + AT_TAB) + hb * 192;
    const int q = r32 & 15, qpos = PAST + q;
    const size_t qrow = (size_t)SEQ + b * DEC_T + q;
    const bf16_t* Qp = (const bf16_t*)(F.ws + (KIND == 0 ? WS_QB : WS_QA)) + qrow * 512 + w * 64;
    bf16x8 qr[4];
#pragma unroll
    for (int d0 = 0; d0 < 4; ++d0) qr[d0] = *(const bf16x8*)(Qp + d0 * 16 + hi * 8);
    const float* Fs = (const float*)(F.ws + WS_FS) + (size_t)(b * 8 + w) * SKV;
    const float fq = KIND == 0 ? Fs[qpos] : 0.f;
    const float* Kc = F.in[KIND == 0 ? I_CFK : I_CDK] + (size_t)b * PAST * 512; const float* Vc = F.in[KIND == 0 ? I_CFV : I_CDV] + (size_t)b * PAST * 512;
    const float* Kn = F.out + (KIND == 0 ? O_FKS : O_DKS) + (size_t)b * DEC_T * 512; const float* Vn = F.out + (KIND == 0 ? O_FVS : O_DVS) + (size_t)b * DEC_T * 512;
    const int kr = tid >> 5, c16 = (tid & 31) * 16;
    const int ksub = c16 >> 6, kch = (c16 >> 3) & 7;
    const int kdst = SM_K + ksub * 4096 + kr * 128;
    const int vdst = KIND == 0 ? SM_V + ksub * VSUB + kr * VSTR + kch * 16 : SM_V + (c16 >> 7) * VSUB + kr * VSTR + ((c16 >> 3) & 15) * 16;
    f32x16 o[NDB];
#pragma unroll
    for (int d = 0; d < NDB; ++d) o[d] = f32x16{};
    float m_run = -1e30f, l_run = 0.f;
    f32x4 gkA[4], gvA[4], gkB[4], gvB[4]; float gfA = 0.f, gfB = 0.f;
    const int nt = s == 0 ? 17 : 16;
    auto gload = [&](f32x4 (&gk)[4], f32x4 (&gv)[4], float& gf, int t) {
        const float* ks; const float* vs;
        if (t < 128) { ks = Kc + (size_t)(16 * t + kr) * 512 + c16; vs = Vc + (size_t)(16 * t + kr) * 512 + c16; }
        else { ks = Kn + (size_t)kr * 512 + c16; vs = Vn + (size_t)kr * 512 + c16; }
#pragma unroll
        for (int j = 0; j < 4; ++j) { gk[j] = *(const f32x4*)(ks + 4 * j); gv[j] = *(const f32x4*)(vs + 4 * j); }
        if (KIND == 0 && tid < 128) gf = ((const float*)(F.ws + WS_FS))[(size_t)(b * 8 + (tid >> 4)) * SKV + 16 * t + (tid & 15)];
    };
    auto lwrite = [&](const f32x4 (&gk)[4], const f32x4 (&gv)[4], float gf) {
#pragma unroll
        for (int j = 0; j < 2; ++j) { u32x4 wk, wv;
            wk.x = pk2(gk[2 * j][0], gk[2 * j][1]); wk.y = pk2(gk[2 * j][2], gk[2 * j][3]); wk.z = pk2(gk[2 * j + 1][0], gk[2 * j + 1][1]); wk.w = pk2(gk[2 * j + 1][2], gk[2 * j + 1][3]);
            wv.x = pk2(gv[2 * j][0], gv[2 * j][1]); wv.y = pk2(gv[2 * j][2], gv[2 * j][3]); wv.z = pk2(gv[2 * j + 1][0], gv[2 * j + 1][1]); wv.w = pk2(gv[2 * j + 1][2], gv[2 * j + 1][3]);
            *(LAS u32x4*)(F.lds + kdst + (((kch + j) ^ (kr & 7)) << 4)) = wk;
            *(LAS u32x4*)(F.lds + vdst + j * 16) = wv; }
        if (KIND == 0 && tid < 128) ((LAS float*)(F.lds + SM_F))[tid] = gf;
    };
    gload(gkA, gvA, gfA, s); gload(gkB, gvB, gfB, s + 8);
    __syncthreads();
    { const int sub = tid >> 6, rr = 16 + ((tid >> 2) & 15), cq = (tid & 3) * 32;
      *(LAS u32x4*)(F.lds + SM_K + sub * 4096 + rr * 128 + cq) = (u32x4){0u, 0u, 0u, 0u}; *(LAS u32x4*)(F.lds + SM_K + sub * 4096 + rr * 128 + cq + 16) = (u32x4){0u, 0u, 0u, 0u}; }
    const int vb = SM_V + (KIND == 0 ? w : (w >> 1)) * VSUB + (4 * hi + ((lane & 15) >> 2)) * VSTR + (((lane >> 4) & 1) * 16 + (lane & 3) * 4) * 2;
    auto compute = [&](int t) {
        f32x16 p0 = f32x16{};
#pragma unroll
        for (int d0 = 0; d0 < 4; ++d0) { const bf16x8 kf = *(const LAS bf16x8*)(lds + SM_K + w * 4096 + r32 * 128 + (((2 * d0 + hi) ^ (r32 & 7)) << 4));
            p0 = __builtin_amdgcn_mfma_f32_32x32x16_bf16(kf, qr[d0], p0, 0, 0, 0); }
        const int kv0 = 16 * t + 4 * hi;
        float x[8];
        if (KIND == 0) {
#pragma unroll
            for (int g4 = 0; g4 < 2; ++g4) { const f32x4 fa = *(const LAS f32x4*)(lds + SM_F + (w * 16 + 4 * hi + 8 * g4) * 4);
#pragma unroll
                for (int e = 0; e < 4; ++e) x[4 * g4 + e] = p0[4 * g4 + e] + (fq - fa[e]); }
            if (t == 128) {
#pragma unroll
                for (int r = 0; r < 8; ++r) { const int kv = kv0 + (r & 3) + 8 * (r >> 2); if (kv > qpos) x[r] = -1e30f; } }
        } else {
            if (t < 120) {
#pragma unroll
                for (int r = 0; r < 8; ++r) x[r] = p0[r];
            } else {
#pragma unroll
                for (int r = 0; r < 8; ++r) { const int kv = kv0 + (r & 3) + 8 * (r >> 2); int i0 = kv - qpos + 128; i0 = i0 < 0 ? 0 : i0; x[r] = p0[r] + tab[i0]; } }
        }
        float rm = x[0];
#pragma unroll
        for (int r = 1; r < 8; ++r) rm = fmaxf(rm, x[r]);
        rm = fmaxf(rm, __shfl_xor(rm, 32));
        const float m_new = fmaxf(m_run, rm);
        if (__any(m_new > m_run)) { const float al = __builtin_amdgcn_exp2f(m_run - m_new); l_run *= al; m_run = m_new;
            if (hi == 0) wsf[r32] = al;
            asm volatile("s_waitcnt lgkmcnt(0)" ::: "memory");
#pragma unroll
            for (int g4 = 0; g4 < 2; ++g4) { const f32x4 a4 = *(const LAS f32x4*)(wsf + 8 * g4 + 4 * hi);
#pragma unroll
                for (int d = 0; d < NDB; ++d)
#pragma unroll
                    for (int e = 0; e < 4; ++e) o[d][4 * g4 + e] *= a4[e]; } }
        float rs = 0.f;
#pragma unroll
        for (int r = 0; r < 8; ++r) { x[r] = __builtin_amdgcn_exp2f(x[r] - m_run); rs += x[r]; }
        l_run += rs;
        u32x4 w0; w0.x = pg8::cvt_pk_bf16(x[0], x[1]); w0.y = pg8::cvt_pk_bf16(x[2], x[3]); w0.z = pg8::cvt_pk_bf16(x[4], x[5]); w0.w = pg8::cvt_pk_bf16(x[6], x[7]);
        const bf16x8 pa = __builtin_bit_cast(bf16x8, w0);
#pragma unroll
        for (int d = 0; d < NDB; ++d) { const LAS char* vp = lds + vb + d * 64;
            const s16x4 lo = vtr(vp), hi4 = vtr(vp + 8 * VSTR);
            const bf16x8 vf = (bf16x8){lo[0], lo[1], lo[2], lo[3], hi4[0], hi4[1], hi4[2], hi4[3]};
            o[d] = __builtin_amdgcn_mfma_f32_32x32x16_bf16(pa, vf, o[d], 0, 0, 0); }
    };
    for (int i = 0; i < nt; i += 2) {
        const int t = s + 8 * i;
        lwrite(gkA, gvA, gfA); __syncthreads();
        if (i + 2 < nt) gload(gkA, gvA, gfA, t + 16);
        compute(t);
        __syncthreads();
        if (i + 1 >= nt) break;
        lwrite(gkB, gvB, gfB); __syncthreads();
        if (i + 3 < nt) gload(gkB, gvB, gfB, t + 24);
        compute(t + 8);
        __syncthreads();
    }
    l_run += __shfl_xor(l_run, 32);
    float* P = (float*)(F.ws + (KIND == 0 ? WS_PF : WS_PD)) + ((size_t)((b * 8 + s) * 8 + w) * 16) * (DV + 2);
    { float* P0 = P + (size_t)(4 * hi) * (DV + 2) + r32; float* P1 = P0 + 8 * (DV + 2);
#pragma unroll
      for (int d = 0; d < NDB; ++d)
#pragma unroll
          for (int r = 0; r < 4; ++r) { P0[r * (DV + 2) + 32 * d] = o[d][r]; P1[r * (DV + 2) + 32 * d] = o[d][4 + r]; } }
    if (lane < 16) { P[(size_t)lane * (DV + 2) + DV] = m_run; P[(size_t)lane * (DV + 2) + DV + 1] = l_run; }
}

template <int pv = 0> __device__ __forceinline__ void p3_attention(Frame& F, int mask) {
    LAS float* tab = (LAS float*)(F.lds + AT_TAB);
    for (int i = F.tid; i < 4 * 192; i += 512) { const int h = i / 192, rel = (i % 192) - 128; tab[i] = (F.in[I_RELB][t5_bucket(rel) * 4 + h] - F.in[I_RELB][15 * 4 + h]) * LOG2E; }
    const float lam = lambda_full(F);
    __syncthreads();
    const int x = F.bid & 7, p = (F.bid >> 3) & 31;
    const int spos = F.G == 256 ? (x + p) % 5 : 4;
    for (int j = 0; j < 5; ++j) {
        F.lane = lane_id_opaque(); F.tid = F.wave * 64 + F.lane;
        if (j == spos) {
            if (mask & 4) {
                for (int u = F.bid; u < 256; u += F.G) {
                    F.lane = lane_id_opaque(); F.tid = F.wave * 64 + F.lane;
                    if ((u >> 3) & 1) sample_unit<1>(F, u >> 4, u & 7); else sample_unit<0>(F, u >> 4, u & 7);
                }
            }
        } else if (F.bid < 256) {
            const int i = j - (j > spos ? 1 : 0);
            const int qb = (i & 1) ? p : 63 - p;
            if (i < 2) { if (mask & 1) attn_prompt_diff_half<pv>(F, x >> 1, x & 1, qb); }
            else { if (mask & 2) attn_prompt_fox<pv>(F, x, qb); }
        }
    }
}

__device__ __forceinline__ void slab_publish(Frame& F, int word, int nun) {
    int n = 0; for (int L = F.bid; L < nun; L += F.G) ++n;
    asm volatile("s_waitcnt vmcnt(0)" ::: "memory");
    __syncthreads();
    if (F.tid == 0 && n > 0) { __builtin_amdgcn_fence(__ATOMIC_RELEASE, "agent"); asm volatile("s_waitcnt vmcnt(0)" ::: "memory");
        __hip_atomic_fetch_add((unsigned*)(F.ws + WS_CTL) + word, (unsigned)n, __ATOMIC_RELAXED, __HIP_MEMORY_SCOPE_AGENT); }
}
__device__ __forceinline__ void slab_wait(Frame& F, int word, int nun) {
    if (F.tid == 0) { unsigned* w = (unsigned*)(F.ws + WS_CTL) + word; unsigned sp = 0;
        while (__hip_atomic_load(w, __ATOMIC_RELAXED, __HIP_MEMORY_SCOPE_AGENT) < (unsigned)nun && ++sp < (1u << 22)) __builtin_amdgcn_s_sleep(2);
        __builtin_amdgcn_fence(__ATOMIC_ACQUIRE, "agent"); asm volatile("s_waitcnt vmcnt(0)" ::: "memory"); }
    __syncthreads();
}

#define XB_TMO      128
#define XB_XCNT(j)  (256  + 64 * (j))
#define XB_XSUB(j)  (1280 + 64 * (j))
#define XB_XGEN(j)  (2304 + 64 * (j))
#define XB_TOP      3328
#define XB_TOPGEN   3392
#define XCD_BAR_WORDS 3456
#define XB_SPIN_CAP (1u << 20)
__device__ __forceinline__ unsigned xb_ld(unsigned* p)              { return __hip_atomic_load(p, __ATOMIC_RELAXED, __HIP_MEMORY_SCOPE_AGENT); }
__device__ __forceinline__ unsigned xb_add(unsigned* p, unsigned v) { return __hip_atomic_fetch_add(p, v, __ATOMIC_RELAXED, __HIP_MEMORY_SCOPE_AGENT); }
__device__ __forceinline__ unsigned xb_xcc_id() { return (unsigned)__builtin_amdgcn_s_getreg((3 << 11) | 20) & 0xFu; }
#define XB_SPIN(cond, bar) do { unsigned _sp = 0; while (cond) { __builtin_amdgcn_s_sleep(1); \
    if ((++_sp & 255u) == 0u) { if (xb_ld(&(bar)[XB_TMO])) break; if (_sp > XB_SPIN_CAP) { atomicAdd(&(bar)[XB_TMO], 1u); break; } } } } while (0)
struct XcdBarrier { unsigned* bar; unsigned x; volatile LAS unsigned* st; };
__device__ __forceinline__ XcdBarrier xcd_barrier_post(unsigned* bar, volatile LAS unsigned* st) {
    XcdBarrier b; b.bar = bar; b.x = xb_xcc_id(); b.st = st;
    if (threadIdx.x == 0) (void)xb_add(&bar[XB_XCNT(b.x)], 1u);
    return b;
}
__device__ __forceinline__ void xcd_barrier_complete(unsigned* bar, unsigned x, unsigned& nloc, unsigned& nx) {
    const unsigned G = gridDim.x * gridDim.y * gridDim.z;
    unsigned sum, cnt, mine, sp = 0u;
    for (;;) {
        sum = 0u; cnt = 0u; mine = 0u;
#pragma unroll
        for (unsigned j = 0; j < 16; ++j) { const unsigned c = xb_ld(&bar[XB_XCNT(j)]); sum += c; cnt += (c > 0u) ? 1u : 0u; mine = (j == x) ? c : mine; }
        if (sum == G) break;
        __builtin_amdgcn_s_sleep(1);
        if ((++sp & 255u) == 0u) { if (xb_ld(&bar[XB_TMO])) break; if (sp > XB_SPIN_CAP) { atomicAdd(&bar[XB_TMO], 1u); break; } }
    }
    nloc = mine > 0u ? mine : 1u; nx = cnt > 0u ? cnt : 1u;
}
__device__ __forceinline__ void xcd_barrier(const XcdBarrier& b) {
    asm volatile("s_waitcnt vmcnt(0)" ::: "memory");
    __syncthreads();
    if (threadIdx.x == 0) {
        unsigned* bar = b.bar;
        __builtin_amdgcn_s_waitcnt(0);
        unsigned nloc = b.st[0], nx = b.st[1];
        if (nloc == 0u) { xcd_barrier_complete(bar, b.x, nloc, nx); b.st[0] = nloc; b.st[1] = nx; }
        const unsigned old = xb_add(&bar[XB_XSUB(b.x)], 1u);
        const unsigned gen = old / nloc;
        if (old + 1u == (gen + 1u) * nloc) {
            __builtin_amdgcn_fence(__ATOMIC_RELEASE, "agent");
            asm volatile("s_waitcnt vmcnt(0)" ::: "memory");
            const unsigned og = xb_add(&bar[XB_TOP], 1u);
            const unsigned tg = og / nx;
            if (og + 1u == (tg + 1u) * nx) xb_add(&bar[XB_TOPGEN], 1u);
            else XB_SPIN(xb_ld(&bar[XB_TOPGEN]) == tg, bar);
            __builtin_amdgcn_fence(__ATOMIC_ACQUIRE, "agent");
            xb_add(&bar[XB_XGEN(b.x)], 1u);
            asm volatile("s_waitcnt vmcnt(0)" ::: "memory");
        } else {
            XB_SPIN(xb_ld(&bar[XB_XGEN(b.x)]) == gen, bar);
            __builtin_amdgcn_fence(__ATOMIC_ACQUIRE, "agent");
            asm volatile("s_waitcnt vmcnt(0)" ::: "memory");
        }
    }
    __syncthreads();
}

__global__ void __launch_bounds__(512, 2) mega_fwd(Args args) {
    extern __shared__ __attribute__((aligned(16))) unsigned char lds_raw[];
    Frame F;
    F.lds = (LAS unsigned char*)lds_raw; F.ldsg = lds_raw;
    F.tid = threadIdx.x; F.lane = F.tid & 63; F.wave = __builtin_amdgcn_readfirstlane(F.tid >> 6);
    F.G = gridDim.x; F.bid = blockIdx.x;
    F.in = args.in; F.out = args.out; F.ws = args.ws;
    const int lo = args.ph_lo, hi = args.ph_hi;
    cg::grid_group grid = cg::this_grid();
    const bool fused = (hi - lo) > 1;
    volatile LAS unsigned* bst = (volatile LAS unsigned*)(F.lds + AT_MISC + 16);
    if (F.tid == 0) { bst[0] = 0u; bst[1] = 0u; }
    __syncthreads();
    XcdBarrier xbar; xbar.bar = (unsigned*)(F.ws + WS_CTL) + 1024; xbar.x = 0; xbar.st = bst;
    if (fused) xbar = xcd_barrier_post((unsigned*)(F.ws + WS_CTL) + 1024, bst);
#define IN(k) (lo <= (k) && (k) < hi)
#define PB() do { F.lane = lane_id_opaque(); F.tid = F.wave * 64 + F.lane; } while (0)
#define SEAM(k) do { if (IN(k) && IN((k) + 1)) { xcd_barrier(xbar); } } while (0)
    const float* mod = (const float*)(F.ws + WS_MOD);
    if (IN(0)) { PB(); p0_prologue(F); }
    if (IN(0) && IN(1)) __syncthreads(); else SEAM(0);
    if (IN(1)) { PB(); p1_rows(F, IN(0)); } SEAM(1);
    if (IN(2)) { PB();
        p2_cumsum(F);
        __syncthreads();
        pg8::Gemm g{(const bf16_t*)(F.ws + WS_XN), (const bf16_t*)(F.ws + WS_WIN), 1024, 1024, 1024, 1 << 30, 0, 0};
        pg8::StaticOrder S; S.init(MT / 256, NZ / 256, F.G, F.bid, 0);
        EpiZ E{F.out, F.ws};
        pg8::gemm_phase<EpiZ, pg8::StaticOrder>(F.lds, g, S, E, F.wave);
#if PROBE_DUP == 2
        pg8::gemm_phase<EpiZ, pg8::StaticOrder>(F.lds, g, S, E, F.wave);
#endif
    } SEAM(2);
    if (IN(3)) { PB(); p3_attention(F, 7);
#if PROBE_DUP == 3
        p3_attention<PROBE_PV>(F, PROBE_MASK);
#endif
    } SEAM(3);
    if (IN(10)) { PB(); p_combine(F);
#if PROBE_DUP == 10
        p_combine(F);
#endif
    } if (IN(10) && IN(4)) xcd_barrier(xbar);
    if (IN(4)) { PB();
        pg8::Gemm g{(const bf16_t*)(F.ws + WS_AB), (const bf16_t*)(F.ws + WS_WAB), 1024, 512, 512, 4, 512, 0};
        pg8::StaticOrder S; S.init(MT / 256, 8, F.G, F.bid, 0);
        EpiGate E{(bf16_t*)(F.ws + WS_G), (bf16_t*)(F.ws + WS_G)};
#if PROBE_DUP == 4
        { EpiGate E2{(bf16_t*)(F.ws + WS_G), (bf16_t*)(F.ws + WS_QA)}; pg8::gemm_phase<EpiGate, pg8::StaticOrder>(F.lds, g, S, E2, F.wave); }
#endif
        pg8::gemm_phase<EpiGate, pg8::StaticOrder>(F.lds, g, S, E, F.wave);
    } SEAM(4);
    if (IN(5)) { PB();
        { pg8::Gemm g2{(const bf16_t*)(F.ws + WS_G), (const bf16_t*)(F.ws + WS_WO2), 2048, 2048, 256, 1 << 30, 0, 256};
          pg8::SplitOrder S2; S2.init(4, 8, F.G, F.bid, SEQ / 256); EpiSlab E2{(float*)(F.ws + WS_SLAB)};
          pg8::gemm_phase<EpiSlab, pg8::SplitOrder>(F.lds, g2, S2, E2, F.wave); slab_publish(F, 322, 32); }
        pg8::Gemm g{(const bf16_t*)(F.ws + WS_G), (const bf16_t*)(F.ws + WS_WO2), 2048, 2048, 2048, 1 << 30, 0, 0};
        pg8::StaticOrder S; S.init(SEQ / 256, 4, F.G, F.bid, 0);
        EpiResLn<false> E{(const void*)F.in[I_XP], mod + 2048, F.in[I_LN1G], F.in[I_LN1B], mod, (bf16_t*)(F.ws + WS_X1B), (bf16_t*)(F.ws + WS_XN), nullptr,
                          PanelStats{(unsigned*)(F.ws + WS_XB1), (unsigned*)(F.ws + WS_CTL) + CTL_LN1, LN_EPS}, F.lds};
        pg8::gemm_phase<EpiResLn<false>, pg8::StaticOrder>(F.lds, g, S, E, F.wave);
        PB(); slab_wait(F, 322, 32); ln_rows<false>(F, F.in[I_LN1G], F.in[I_LN1B], 8, 2048);
    } if (IN(5) && IN(7)) xcd_barrier(xbar);

    if (IN(7)) { PB();
        pg8::Gemm g{(const bf16_t*)(F.ws + WS_XN), (const bf16_t*)(F.ws + WS_WFI), 1024, 1024, 1024, 1 << 30, 0, 0};
        pg8::StaticOrder S; S.init(MT / 256, NFF2 / 256, F.G, F.bid, 0);
        EpiFfn E{(bf16_t*)(F.ws + WS_ACT)};
        pg8::gemm_phase<EpiFfn, pg8::StaticOrder>(F.lds, g, S, E, F.wave);
#if PROBE_DUP == 7
        pg8::gemm_phase<EpiFfn, pg8::StaticOrder>(F.lds, g, S, E, F.wave);
#endif
    } SEAM(7);
    if (IN(8)) { PB();
        { pg8::Gemm g2{(const bf16_t*)(F.ws + WS_ACT), (const bf16_t*)(F.ws + WS_WFO), DFF, DFF, 256, 1 << 30, 0, 256};
          pg8::SplitOrder S2; S2.init(4, 11, F.G, F.bid, SEQ / 256); EpiSlab E2{(float*)(F.ws + WS_SLAB)};
          pg8::gemm_phase<EpiSlab, pg8::SplitOrder>(F.lds, g2, S2, E2, F.wave); slab_publish(F, 323, 44); }
        pg8::Gemm g{(const bf16_t*)(F.ws + WS_ACT), (const bf16_t*)(F.ws + WS_WFO), DFF, DFF, DFF, 1 << 30, 0, 0};
        pg8::StaticOrder S; S.init(SEQ / 256, 4, F.G, F.bid, 0);
        EpiResLn<true> E{(const void*)(F.ws + WS_X1B), mod + 5120, F.in[I_LN2G], F.in[I_LN2B], mod, nullptr, nullptr, F.out,
                         PanelStats{(unsigned*)(F.ws + WS_XB2), (unsigned*)(F.ws + WS_CTL) + CTL_LN2, LN_EPS}, F.lds};
        pg8::gemm_phase<EpiResLn<true>, pg8::StaticOrder>(F.lds, g, S, E, F.wave);
        PB(); slab_wait(F, 323, 44); ln_rows<true>(F, F.in[I_LN2G], F.in[I_LN2B], 11, 5120);
    }
#undef IN
#undef SEAM
}

extern "C" void kernel_launch(void* const* d_in, const int* in_sizes, int n_in, void* d_out, int out_size, void* d_ws, size_t ws_size, hipStream_t stream) {
    static int grid = 0;
    if (grid == 0) {
        if (n_in != 28 || (size_t)out_size != O_END || ws_size < WS_END) { fprintf(stderr, "kernel_launch: unexpected shapes (n_in %d out %d ws %zu)\n", n_in, out_size, ws_size); grid = -1; return; }
        int dev = 0, cus = 0, per_cu = 0;
        hipGetDevice(&dev); hipDeviceGetAttribute(&cus, hipDeviceAttributeMultiprocessorCount, dev);
        hipFuncSetAttribute((const void*)mega_fwd, hipFuncAttributeMaxDynamicSharedMemorySize, LDS_BYTES);
        hipOccupancyMaxActiveBlocksPerMultiprocessor(&per_cu, (const void*)mega_fwd, 512, LDS_BYTES);
        if (per_cu < 1) { fprintf(stderr, "kernel_launch: occupancy query says %d blocks per CU\n", per_cu); per_cu = 1; }
        (void)hipGetLastError();
        grid = cus;
    }
    if (grid < 0) return;
    hipMemsetAsync((char*)d_ws + WS_CTL, 0, CTL_BYTES, stream);
    Args a{};
    for (int i = 0; i < 28; ++i) a.in[i] = (const float*)d_in[i];
    a.out = (float*)d_out; a.ws = (unsigned char*)d_ws;
#if MK_N_LAUNCHES == 1
    a.ph_lo = 0; a.ph_hi = NPH;
    void* kargs[] = {&a};
    hipError_t e = hipLaunchCooperativeKernel((const void*)mega_fwd, dim3(grid), dim3(512), kargs, LDS_BYTES, stream);
    if (e != hipSuccess) fprintf(stderr, "cooperative launch failed: %s\n", hipGetErrorString(e));
#else
    { const int seq[NPH] = {0, 1, 2, 3, 10, 4, 5, 6, 7, 8, 9}; for (int i = 0; i < NPH; ++i) { a.ph_lo = seq[i]; a.ph_hi = seq[i] + 1; hipLaunchKernelGGL(mega_fwd, dim3(grid), dim3(512), LDS_BYTES, stream, a); } }
#endif
}
```

```cpp
#include <hip/hip_runtime.h>
#include <hip/hip_cooperative_groups.h>
#include <cstdint>
#include <cstdio>
namespace cg = cooperative_groups;

#ifndef PROBE_DUP
#define PROBE_DUP -1
#endif
#ifndef PROBE_PV
#define PROBE_PV 0
#endif
#ifndef PROBE_MASK
#define PROBE_MASK 7
#endif
#ifndef MK_N_LAUNCHES
#define MK_N_LAUNCHES 1
#endif

#define LAS __attribute__((address_space(3)))
typedef unsigned short bf16_t;
typedef short bf16x8 __attribute__((ext_vector_type(8)));
typedef short s16x4 __attribute__((ext_vector_type(4)));
typedef float f32x4 __attribute__((ext_vector_type(4)));
typedef float f32x2 __attribute__((ext_vector_type(2)));
typedef float f32x16 __attribute__((ext_vector_type(16)));
typedef unsigned u32x4 __attribute__((ext_vector_type(4)));
typedef unsigned u32x2 __attribute__((ext_vector_type(2)));

constexpr int DM = 1024, SEQ = 16384, DEC_B = 16, DEC_T = 16, NSMP = DEC_B * DEC_T, MT = SEQ + NSMP, PAST = 2048, SKV = PAST + DEC_T;
constexpr int NZ = 5120, DFF = 2816, NFF2 = 2 * DFF, WIN_COLS = 5128;
constexpr float LOG2E = 1.4426950408889634f, C2 = 0.125f * LOG2E, ALPHA = 1.189207115002721f, LN_EPS = 1e-5f;
constexpr int NPH = 11;

constexpr size_t O_Y = 0, O_DKP = (size_t)MT * DM, O_DVP = O_DKP + (size_t)SEQ * 512, O_FKP = O_DVP + (size_t)SEQ * 512, O_FVP = O_FKP + (size_t)SEQ * 512,
                 O_FLP = O_FVP + (size_t)SEQ * 512, O_DKS = O_FLP + (size_t)SEQ * 8, O_DVS = O_DKS + (size_t)NSMP * 512, O_FKS = O_DVS + (size_t)NSMP * 512,
                 O_FVS = O_FKS + (size_t)NSMP * 512, O_FLS = O_FVS + (size_t)NSMP * 512, O_END = O_FLS + (size_t)NSMP * 8;

constexpr size_t MiB = 1u << 20;
constexpr size_t WS_CTL = 0, CTL_BYTES = 64 * 1024;
constexpr size_t WS_MOD = 1 * MiB;
constexpr size_t WS_FP = 2 * MiB;
constexpr size_t WS_FS = 3 * MiB;
constexpr size_t WS_WIN = 8 * MiB;
constexpr size_t WS_WAB = 18 * MiB;
constexpr size_t WS_WO2 = 20 * MiB;
constexpr size_t WS_WFI = 24 * MiB;
constexpr size_t WS_WFO = 35 * MiB;
constexpr size_t WS_XN = 48 * MiB;
constexpr size_t WS_QA = 84 * MiB, WS_KA = 101 * MiB, WS_VA = 118 * MiB, WS_QB = 135 * MiB, WS_KB = 152 * MiB, WS_VB = 169 * MiB;
constexpr size_t WS_ACT = 84 * MiB;
constexpr size_t WS_G = 188 * MiB;
constexpr size_t WS_AB = 254 * MiB;
constexpr size_t WS_OD1 = WS_XN, WS_OD2 = 288 * MiB;
constexpr size_t WS_PF = 304 * MiB, WS_PD = 309 * MiB;
constexpr size_t WS_TB = WS_AB;
constexpr size_t WS_X1B = WS_AB;
constexpr size_t WS_XB1 = 5 * MiB, WS_XB2 = 6 * MiB;
constexpr int CTL_LN1 = 8192, CTL_LN2 = 12288;
constexpr int LN_LDS = 135168;
constexpr size_t WS_SLAB = 288 * MiB;
constexpr size_t WS_END = 320 * MiB;

constexpr int LDS_BYTES = 147456;

struct Args { const float* in[28]; float* out; unsigned char* ws; int ph_lo, ph_hi; };

__device__ __forceinline__ int lane_id_opaque() { int l = (int)__builtin_amdgcn_mbcnt_hi(~0u, __builtin_amdgcn_mbcnt_lo(~0u, 0u)); asm volatile("" : "+v"(l)); return l; }
__device__ __forceinline__ unsigned f2bf(float f) { unsigned u = __builtin_bit_cast(unsigned, f); return (u + 0x7fffu + ((u >> 16) & 1u)) >> 16; }
__device__ __forceinline__ unsigned pk2(float lo, float hi) { return f2bf(lo) | (f2bf(hi) << 16); }
__device__ __forceinline__ float bf2f(unsigned short b) { return __builtin_bit_cast(float, (unsigned)b << 16); }
__device__ __forceinline__ float bflo(unsigned w) { return __builtin_bit_cast(float, w << 16); }
__device__ __forceinline__ float bfhi(unsigned w) { return __builtin_bit_cast(float, w & 0xffff0000u); }
__device__ __forceinline__ float wave_sum(float v) {
#pragma unroll
    for (int o = 1; o < 64; o <<= 1) v += __shfl_xor(v, o);
    return v;
}
__device__ __forceinline__ float sigmoidf_(float x) { return 1.0f / (1.0f + __expf(-x)); }
__device__ __forceinline__ float siluf_(float x) { return x / (1.0f + __expf(-x)); }

namespace pg8 {
constexpr int BM = 256, BK = 64, HALF = 128, HTB = HALF * BK * 2, STAGE_BYTES = 8 * HTB, NXCD = 8, WGM = 8;
__host__ __device__ __forceinline__ int lds_byte(int r, int c) { const int st = (r >> 4) * 2 + (c >> 5), rr = r & 15, cc = c & 31, ob = rr * 64 + cc * 2; return st * 1024 + (ob ^ (((ob >> 9) & 1) << 5)); }
__host__ __device__ __forceinline__ void stage_rc(int b, int& R, int& C) { const int st = b / 1024, sb = b % 1024, swz = sb ^ (((sb >> 9) & 1) << 5); R = (st >> 1) * 16 + swz / 64; C = (st & 1) * 32 + (swz % 64) / 2; }
__host__ __device__ __forceinline__ int perm32(int rho) { const int n = rho >> 4, i = rho & 15; return 8 * (i >> 2) + 4 * n + (i & 3); }

struct Unit { int pm, pn, ks; };
struct Gemm { const bf16_t* A; const bf16_t* Bt; int lda, ldb, K, a_split_pn, a_split_off, kpart; };

struct StaticOrder {
    int nM, nN, nwg, G, c, pm0;
    __device__ void init(int nM_, int nN_, int G_, int c_, int pm0_) { nM = nM_; nN = nN_; nwg = nM * nN; G = G_; c = c_; pm0 = pm0_; }
    __device__ bool next(int i, Unit& u) const {
        const long L = (long)i * G + c; if (L >= nwg) return false;
        int wgid = (int)L; { const int q = nwg / NXCD, r = nwg % NXCD, xcd = wgid % NXCD, off = wgid / NXCD; wgid = (xcd < r ? xcd * (q + 1) : r * (q + 1) + (xcd - r) * q) + off; }
        const int nig = WGM * nN, gid = wgid / nig, fm = gid * WGM, gsz = (nM - fm) < WGM ? (nM - fm) : WGM;
        u.pm = pm0 + fm + ((wgid % nig) % gsz); u.pn = (wgid % nig) / gsz; u.ks = 0; return true;
    }
};

struct SplitOrder {
    int nN, nun, G, c, pm;
    __device__ void init(int nN_, int KS_, int G_, int c_, int pm_) { nN = nN_; nun = nN_ * KS_; G = G_; c = c_; pm = pm_; }
    __device__ bool next(int i, Unit& u) const { const long L = (long)i * G + c; if (L >= nun) return false; u.pm = pm; u.pn = (int)L % nN; u.ks = (int)L / nN; return true; }
};

__device__ __forceinline__ unsigned cvt_pk_bf16(float lo, float hi) { unsigned r; asm volatile("v_cvt_pk_bf16_f32 %0, %1, %2" : "=v"(r) : "v"(lo), "v"(hi)); return r; }

template <class Epi, class Sched, bool ALIGN_EPI = true, bool SP2 = true>
__device__ __forceinline__ void gemm_phase(LAS unsigned char* lds, const Gemm g, const Sched& S, const Epi& E, int wid  ) {
    const int lane = lane_id_opaque(), tid = wid * 64 + lane, wr = wid >> 2, wc = wid & 3; int fr = lane & 15, fq = lane >> 4;
    const int K = g.K, nt = K / BK;
    unsigned voffA[2], voffB[2];
#pragma unroll
    for (int i = 0; i < 2; ++i) { int R, C; stage_rc(tid * 16 + i * 8192, R, C); const int Rb = Epi::PERM ? ((R & ~31) + perm32(R & 31)) : R;
        voffA[i] = (unsigned)(R * g.lda + C) * 2u; voffB[i] = (unsigned)(Rb * g.ldb + C) * 2u; }
    const size_t kstep = (size_t)(BK * 2);
    const size_t hstepA = (size_t)HALF * g.lda * 2, hstepB = (size_t)HALF * g.ldb * 2;
    const size_t tstepA = 2 * hstepA, tstepB = 2 * hstepB;
    const unsigned ldsw = (unsigned)wid * 1024u;
    const int aoff = lds_byte(wr * 64 + fr, fq * 8), boff = lds_byte(wc * 32 + fr, fq * 8);
#define PG8_SA(b, h) (((b) * 2 + (h)) * HTB)
#define PG8_SB(b, h) ((4 + (b) * 2 + (h)) * HTB)
#define PG8_STAGE(bufoff, gbase, voff) do { _Pragma("unroll") for (int _i = 0; _i < 2; ++_i) \
        __builtin_amdgcn_global_load_lds((const unsigned*)((const char*)(gbase) + (voff)[_i]), (LAS unsigned*)(lds + (bufoff) + ldsw + _i * 8192), 16, 0, 0); } while (0)
#define PG8_LDA(dst, b, h) do { _Pragma("unroll") for (int m = 0; m < 4; ++m) _Pragma("unroll") for (int k = 0; k < 2; ++k) dst[m][k] = *(const LAS bf16x8*)(lds + PG8_SA(b, h) + aoff + m * 2048 + k * 1024); } while (0)
#define PG8_LDB(dst, b, h) do { _Pragma("unroll") for (int n = 0; n < 2; ++n) _Pragma("unroll") for (int k = 0; k < 2; ++k) dst[n][k] = *(const LAS bf16x8*)(lds + PG8_SB(b, h) + boff + n * 2048 + k * 1024); } while (0)
#define PG8_MMA(ai, bj, At, Bt) do { __builtin_amdgcn_s_setprio(1); _Pragma("unroll") for (int m = 0; m < 4; ++m) _Pragma("unroll") for (int n = 0; n < 2; ++n) _Pragma("unroll") for (int k = 0; k < 2; ++k) \
        acc[ai][bj][m][n] = __builtin_amdgcn_mfma_f32_16x16x32_bf16(Bt[n][k], At[m][k], acc[ai][bj][m][n], 0, 0, 0); __builtin_amdgcn_s_setprio(0); } while (0)
#define PG8_WAIT_V(n) asm volatile("s_waitcnt vmcnt(" #n ")" ::: "memory")
#define PG8_WAIT_L(n) asm volatile("s_waitcnt lgkmcnt(" #n ")" ::: "memory")
#define PG8_BAR __builtin_amdgcn_s_barrier()
#define PG8_SCHED __builtin_amdgcn_sched_barrier(0)
#define PG8_ABASE(u) ((const char*)g.A + (size_t)(u).pm * tstepA + ((u).pn >= g.a_split_pn ? (size_t)g.a_split_off * 2 : (size_t)0) + (size_t)(u).ks * g.kpart * 2)
#define PG8_BBASE(u) ((const char*)g.Bt + (size_t)(u).pn * tstepB + (size_t)(u).ks * g.kpart * 2)
    Unit cur, nxt; int ui = 0;
    if (!S.next(0, cur)) return;
    f32x4 acc[2][2][4][2];
#pragma unroll
    for (int a = 0; a < 2; ++a)
#pragma unroll
        for (int b = 0; b < 2; ++b)
#pragma unroll
            for (int m = 0; m < 4; ++m)
#pragma unroll
                for (int n = 0; n < 2; ++n) acc[a][b][m][n] = (f32x4){0.f, 0.f, 0.f, 0.f};
    bf16x8 At[4][2], B0[2][2], B1[2][2];
    const char* cA = PG8_ABASE(cur); const char* cB = PG8_BBASE(cur);
    if constexpr (SP2) {
        PG8_STAGE(PG8_SB(0, 0), cB, voffB); PG8_STAGE(PG8_SB(0, 1), cB + hstepB, voffB); PG8_STAGE(PG8_SA(0, 0), cA, voffA); PG8_STAGE(PG8_SA(0, 1), cA + hstepA, voffA);
        if (wr == 1) PG8_BAR;
        PG8_WAIT_V(2); PG8_BAR;
        PG8_STAGE(PG8_SB(1, 0), cB + kstep, voffB); PG8_STAGE(PG8_SA(1, 0), cA + kstep, voffA); PG8_STAGE(PG8_SB(1, 1), cB + hstepB + kstep, voffB);
        PG8_WAIT_V(6); PG8_BAR;
    } else {
        PG8_STAGE(PG8_SB(0, 0), cB, voffB); PG8_STAGE(PG8_SA(0, 0), cA, voffA); PG8_STAGE(PG8_SB(0, 1), cB + hstepB, voffB); PG8_STAGE(PG8_SA(0, 1), cA + hstepA, voffA);
        if (wr == 1) PG8_BAR;
        PG8_WAIT_V(4); PG8_BAR;
        PG8_STAGE(PG8_SB(1, 0), cB + kstep, voffB); PG8_STAGE(PG8_SA(1, 0), cA + kstep, voffA); PG8_STAGE(PG8_SB(1, 1), cB + hstepB + kstep, voffB);
        PG8_WAIT_V(6); PG8_BAR;
    }
    for (;;) {
        const bool has_next = S.next(ui + 1, nxt);
        const char* nA = has_next ? PG8_ABASE(nxt) : cA; const char* nB = has_next ? PG8_BBASE(nxt) : cB;
        for (int t = 0; t < nt; t += 2) {
            const bool last = (t == nt - 2);
            const char* a1 = cA + (size_t)(t + 1) * kstep;
            const char* a2 = last ? nA : cA + (size_t)(t + 2) * kstep; const char* b2 = last ? nB : cB + (size_t)(t + 2) * kstep;
            const char* a3 = a2 + kstep; const char* b3 = b2 + kstep;
            if constexpr (SP2) {
            PG8_LDB(B0, 0, 0); PG8_LDB(B1, 0, 1); PG8_SCHED; PG8_LDA(At, 0, 0); PG8_STAGE(PG8_SA(1, 1), a1 + hstepA, voffA);
            PG8_WAIT_V(8); PG8_WAIT_L(0); PG8_BAR; PG8_MMA(0, 0, At, B0); PG8_MMA(0, 1, At, B1); PG8_BAR; PG8_SCHED;
            PG8_LDA(At, 0, 1); PG8_STAGE(PG8_SB(0, 0), b2, voffB); PG8_STAGE(PG8_SB(0, 1), b2 + hstepB, voffB); PG8_STAGE(PG8_SA(0, 0), a2, voffA);
            PG8_WAIT_V(8); PG8_WAIT_L(0); PG8_BAR; PG8_MMA(1, 0, At, B0); PG8_MMA(1, 1, At, B1); PG8_BAR; PG8_SCHED;
            PG8_LDB(B0, 1, 0); PG8_LDB(B1, 1, 1); PG8_SCHED; PG8_LDA(At, 1, 0); PG8_STAGE(PG8_SA(0, 1), a2 + hstepA, voffA);
            PG8_WAIT_V(8); PG8_WAIT_L(0); PG8_BAR; PG8_MMA(0, 0, At, B0); PG8_MMA(0, 1, At, B1); PG8_BAR; PG8_SCHED;
            PG8_LDA(At, 1, 1); PG8_STAGE(PG8_SB(1, 0), b3, voffB); PG8_STAGE(PG8_SB(1, 1), b3 + hstepB, voffB); PG8_STAGE(PG8_SA(1, 0), a3, voffA);
            PG8_WAIT_V(8); PG8_WAIT_L(0); PG8_BAR; PG8_MMA(1, 0, At, B0); PG8_MMA(1, 1, At, B1); PG8_BAR; PG8_SCHED;
            } else {
            PG8_LDB(B0, 0, 0); PG8_SCHED; PG8_LDA(At, 0, 0); PG8_STAGE(PG8_SA(1, 1), a1 + hstepA, voffA);
            PG8_WAIT_L(8); PG8_BAR; PG8_WAIT_L(0); PG8_MMA(0, 0, At, B0); PG8_BAR; PG8_SCHED;
            PG8_LDB(B1, 0, 1); PG8_STAGE(PG8_SB(0, 0), b2, voffB);
            PG8_BAR; PG8_WAIT_L(0); PG8_MMA(0, 1, At, B1); PG8_BAR;
            PG8_LDA(At, 0, 1); PG8_STAGE(PG8_SA(0, 0), a2, voffA);
            PG8_BAR; PG8_WAIT_L(0); PG8_MMA(1, 0, At, B0); PG8_BAR; PG8_SCHED;
            PG8_STAGE(PG8_SB(0, 1), b2 + hstepB, voffB);
            PG8_WAIT_V(6); PG8_BAR; PG8_MMA(1, 1, At, B1); PG8_BAR;
            PG8_LDB(B0, 1, 0); PG8_SCHED; PG8_LDA(At, 1, 0); PG8_STAGE(PG8_SA(0, 1), a2 + hstepA, voffA);
            PG8_WAIT_L(8); PG8_BAR; PG8_WAIT_L(0); PG8_MMA(0, 0, At, B0); PG8_BAR; PG8_SCHED;
            PG8_LDB(B1, 1, 1); PG8_STAGE(PG8_SB(1, 0), b3, voffB);
            PG8_BAR; PG8_WAIT_L(0); PG8_MMA(0, 1, At, B1); PG8_BAR;
            PG8_LDA(At, 1, 1); PG8_STAGE(PG8_SA(1, 0), a3, voffA);
            PG8_BAR; PG8_WAIT_L(0); PG8_MMA(1, 0, At, B0); PG8_BAR; PG8_SCHED;
            PG8_STAGE(PG8_SB(1, 1), b3 + hstepB, voffB);
            PG8_WAIT_V(6); PG8_BAR; PG8_MMA(1, 1, At, B1); PG8_BAR;
            }
        }
        if constexpr (ALIGN_EPI) { if (wr == 0) PG8_BAR; }
        { const int le_ = lane_id_opaque(); E(acc, cur, wr, wc, le_ & 15, le_ >> 4); }
        if (!has_next) break;
#pragma unroll
        for (int a = 0; a < 2; ++a)
#pragma unroll
            for (int b = 0; b < 2; ++b)
#pragma unroll
                for (int m = 0; m < 4; ++m)
#pragma unroll
                    for (int n = 0; n < 2; ++n) acc[a][b][m][n] = (f32x4){0.f, 0.f, 0.f, 0.f};
        cur = nxt; cA = nA; cB = nB; ++ui;
        if constexpr (ALIGN_EPI) { if (wr == 1) PG8_BAR; }
    }
    PG8_WAIT_V(0);
    if constexpr (!ALIGN_EPI) { if (wr == 0) PG8_BAR; }
    PG8_BAR;
#undef PG8_SA
#undef PG8_SB
#undef PG8_STAGE
#undef PG8_LDA
#undef PG8_LDB
#undef PG8_MMA
#undef PG8_WAIT_V
#undef PG8_WAIT_L
#undef PG8_BAR
#undef PG8_SCHED
#undef PG8_ABASE
#undef PG8_BBASE
}
}

struct EpiZ {
    static constexpr bool PERM = true;
    float* out; unsigned char* ws;
    __device__ __forceinline__ void operator()(const f32x4 (&acc)[2][2][4][2], const pg8::Unit& u, int wr, int wc, int fr, int fq) const {
        asm volatile("" : "+v"(fr), "+v"(fq));
        const int seg = u.pn >> 1;
        const bool smp = u.pm >= SEQ / 256;
        const int row0 = u.pm * 256 + wr * 64 + fr;
        const int cl0 = wc * 32 + 8 * fq;
        if (seg < 6) {
            bf16_t* B = (bf16_t*)(ws + WS_QA + (size_t)seg * (WS_KA - WS_QA));
            const bool isq = (seg == 0 || seg == 3);
            const float sc = isq ? C2 : 1.0f;
            const int kk = seg - 1 - (seg > 3 ? 1 : 0);
            float* ob = isq ? nullptr : (smp ? out + O_DKS + (size_t)kk * NSMP * 512 - (size_t)SEQ * 512 : out + O_DKP + (size_t)kk * SEQ * 512);
            const int cs = (u.pn & 1) * 256 + cl0;
            if (seg == 0 || seg == 1 || seg == 3 || seg == 4) {
                float mx0 = 0.f, mx1 = 0.f;
#pragma unroll
                for (int ai = 0; ai < 2; ++ai)
#pragma unroll
                    for (int m = 0; m < 4; ++m) {
#pragma unroll
                        for (int bj = 0; bj < 2; ++bj) { const f32x4 v0 = acc[ai][bj][m][0] * sc, v1 = acc[ai][bj][m][1] * sc;
                            float ss = (v0[0] * v0[0] + v0[1] * v0[1]) + (v0[2] * v0[2] + v0[3] * v0[3]) + (v1[0] * v1[0] + v1[1] * v1[1]) + (v1[2] * v1[2] + v1[3] * v1[3]);
                            ss += __shfl_xor(ss, 16); ss += __shfl_xor(ss, 32);
                            if (bj == 0) mx0 = fmaxf(mx0, ss); else mx1 = fmaxf(mx1, ss); } }
#pragma unroll
                for (int ofs = 1; ofs < 16; ofs <<= 1) { mx0 = fmaxf(mx0, __shfl_xor(mx0, ofs)); mx1 = fmaxf(mx1, __shfl_xor(mx1, ofs)); }
                if ((fr | fq) == 0) { unsigned* nw = (unsigned*)(ws + WS_CTL) + (seg < 3 ? 288 : 256) + ((seg == 4 || seg == 1) ? 16 : 0);
                    const int h0 = (u.pn & 1) * 4 + (wc >> 1), hf = wc & 1;
                    atomicMax(nw + (h0 * 2 + hf), __float_as_uint(mx0)); atomicMax(nw + ((h0 + 2) * 2 + hf), __float_as_uint(mx1)); }
            }
#pragma unroll
            for (int ai = 0; ai < 2; ++ai)
#pragma unroll
                for (int m = 0; m < 4; ++m) { const size_t r = (size_t)(row0 + ai * 128 + m * 16);
#pragma unroll
                    for (int bj = 0; bj < 2; ++bj) { const f32x4 v0 = acc[ai][bj][m][0], v1 = acc[ai][bj][m][1]; const int c = cs + bj * 128;
                        if (ob) { *(f32x4*)(ob + r * 512 + c) = v0; *(f32x4*)(ob + r * 512 + c + 4) = v1; }
                        u32x4 w; w.x = pg8::cvt_pk_bf16(v0[0] * sc, v0[1] * sc); w.y = pg8::cvt_pk_bf16(v0[2] * sc, v0[3] * sc); w.z = pg8::cvt_pk_bf16(v1[0] * sc, v1[1] * sc); w.w = pg8::cvt_pk_bf16(v1[2] * sc, v1[3] * sc);
                        *(u32x4*)(B + r * 512 + c) = w; } }
        } else {
            bf16_t* G = (bf16_t*)(ws + WS_G);
            const int cs = (u.pn - 12) * 256 + cl0;
#pragma unroll
            for (int ai = 0; ai < 2; ++ai)
#pragma unroll
                for (int m = 0; m < 4; ++m) { const size_t r = (size_t)(row0 + ai * 128 + m * 16);
#pragma unroll
                    for (int bj = 0; bj < 2; ++bj) { const f32x4 v0 = acc[ai][bj][m][0], v1 = acc[ai][bj][m][1]; const int c = cs + bj * 128;
                        u32x4 w; w.x = pg8::cvt_pk_bf16(sigmoidf_(v0[0]), sigmoidf_(v0[1])); w.y = pg8::cvt_pk_bf16(sigmoidf_(v0[2]), sigmoidf_(v0[3]));
                        w.z = pg8::cvt_pk_bf16(sigmoidf_(v1[0]), sigmoidf_(v1[1])); w.w = pg8::cvt_pk_bf16(sigmoidf_(v1[2]), sigmoidf_(v1[3]));
                        *(u32x4*)(G + r * 2048 + c) = w; } }
        }
    }
};
struct EpiGate {
    static constexpr bool PERM = true;
    bf16_t* G; bf16_t* GO;
    __device__ __forceinline__ void operator()(const f32x4 (&acc)[2][2][4][2], const pg8::Unit& u, int wr, int wc, int fr, int fq) const {
        asm volatile("" : "+v"(fr), "+v"(fq));
        const int row0 = u.pm * 256 + wr * 64 + fr, c0 = u.pn * 256 + wc * 32 + 8 * fq;
#pragma unroll
        for (int ai = 0; ai < 2; ++ai)
#pragma unroll
            for (int m = 0; m < 4; ++m) { const size_t ro = (size_t)(row0 + ai * 128 + m * 16) * 2048 + c0; const bf16_t* rp = G + ro; bf16_t* wp = GO + ro;
#pragma unroll
                for (int bj = 0; bj < 2; ++bj) { const f32x4 v0 = acc[ai][bj][m][0], v1 = acc[ai][bj][m][1]; const u32x4 gw = *(const u32x4*)(rp + bj * 128);
                    u32x4 w; w.x = pg8::cvt_pk_bf16(v0[0] * bflo(gw.x), v0[1] * bfhi(gw.x)); w.y = pg8::cvt_pk_bf16(v0[2] * bflo(gw.y), v0[3] * bfhi(gw.y));
                    w.z = pg8::cvt_pk_bf16(v1[0] * bflo(gw.z), v1[1] * bfhi(gw.z)); w.w = pg8::cvt_pk_bf16(v1[2] * bflo(gw.w), v1[3] * bfhi(gw.w));
                    *(u32x4*)(wp + bj * 128) = w; } }
    }
};
template <bool BASE_BF16> struct EpiRes {
    static constexpr bool PERM = true;
    const void* base; bf16_t* T; const float* gate;
    __device__ __forceinline__ void operator()(const f32x4 (&acc)[2][2][4][2], const pg8::Unit& u, int wr, int wc, int fr, int fq) const {
        asm volatile("" : "+v"(fr), "+v"(fq));
        const int row0 = u.pm * 256 + wr * 64 + fr, c0 = u.pn * 256 + wc * 32 + 8 * fq;
#pragma unroll
        for (int ai = 0; ai < 2; ++ai)
#pragma unroll
            for (int m = 0; m < 4; ++m) { const size_t ro = (size_t)(row0 + ai * 128 + m * 16) * DM;
#pragma unroll
                for (int bj = 0; bj < 2; ++bj) { const int c = c0 + bj * 128; f32x4 b0, b1;
                    if (BASE_BF16) { const u32x4 bw = *(const u32x4*)((const bf16_t*)base + ro + c); b0 = (f32x4){bflo(bw.x), bfhi(bw.x), bflo(bw.y), bfhi(bw.y)}; b1 = (f32x4){bflo(bw.z), bfhi(bw.z), bflo(bw.w), bfhi(bw.w)}; }
                    else { b0 = *(const f32x4*)((const float*)base + ro + c); b1 = *(const f32x4*)((const float*)base + ro + c + 4); }
                    const f32x4 g0 = *(const f32x4*)(gate + c), g1 = *(const f32x4*)(gate + c + 4);
                    const f32x4 v0 = b0 * ALPHA + g0 * acc[ai][bj][m][0], v1 = b1 * ALPHA + g1 * acc[ai][bj][m][1];
                    u32x4 w; w.x = pg8::cvt_pk_bf16(v0[0], v0[1]); w.y = pg8::cvt_pk_bf16(v0[2], v0[3]); w.z = pg8::cvt_pk_bf16(v1[0], v1[1]); w.w = pg8::cvt_pk_bf16(v1[2], v1[3]);
                    *(u32x4*)(T + ro + c) = w; } }
    }
};
struct PanelStats {
    unsigned* xbuf; unsigned* cnt; float eps;
    __device__ __forceinline__ void run(const f32x4 (&v)[2][2][4][2], const pg8::Unit& u, int wr, int wc, int fr, int fq, LAS unsigned char* lds, int wid, int lane) const {
        LAS f32x2* P = (LAS f32x2*)(lds + LN_LDS);
        LAS f32x2* S = (LAS f32x2*)(lds + LN_LDS + 8192);
#pragma unroll
        for (int ai = 0; ai < 2; ++ai)
#pragma unroll
            for (int m = 0; m < 4; ++m) {
                float s = 0.f;
#pragma unroll
                for (int bj = 0; bj < 2; ++bj)
#pragma unroll
                    for (int n = 0; n < 2; ++n) { const f32x4 x = v[ai][bj][m][n]; s += (x[0] + x[1]) + (x[2] + x[3]); }
                s += __shfl_xor(s, 16); s += __shfl_xor(s, 32);
                const float mw = s * (1.0f / 64.0f); float q = 0.f;
#pragma unroll
                for (int bj = 0; bj < 2; ++bj)
#pragma unroll
                    for (int n = 0; n < 2; ++n) { const f32x4 d = v[ai][bj][m][n] - mw; q += (d[0] * d[0] + d[1] * d[1]) + (d[2] * d[2] + d[3] * d[3]); }
                q += __shfl_xor(q, 16); q += __shfl_xor(q, 32);
                if (fq == 0) P[(ai * 128 + wr * 64 + m * 16 + fr) * 4 + wc] = (f32x2){mw, q};
                __builtin_amdgcn_sched_barrier(0);
            }
        asm volatile("s_waitcnt lgkmcnt(0)" ::: "memory"); __builtin_amdgcn_s_barrier(); asm volatile("" ::: "memory");
        const int row = wid * 32 + (lane & 31);
        if (lane < 32) {
            const f32x2 a = P[row * 4 + 0], b = P[row * 4 + 1], c = P[row * 4 + 2], d = P[row * 4 + 3];
            const float mt = (a.x + b.x + c.x + d.x) * 0.25f;
            const float da = a.x - mt, db = b.x - mt, dc = c.x - mt, dd = d.x - mt;
            const float m2 = (a.y + b.y) + (c.y + d.y) + 64.0f * ((da * da + db * db) + (dc * dc + dd * dd));
            unsigned long long* slot = (unsigned long long*)xbuf + ((size_t)(u.pm * 256 + row) * 4 + u.pn);
            __hip_atomic_store(slot, ((unsigned long long)__float_as_uint(m2) << 32) | __float_as_uint(mt), __ATOMIC_RELAXED, __HIP_MEMORY_SCOPE_AGENT);
        }
        asm volatile("s_waitcnt vmcnt(0)" ::: "memory");
        if (lane == 0) __hip_atomic_fetch_add(cnt + 64 * u.pm, 1u, __ATOMIC_RELAXED, __HIP_MEMORY_SCOPE_AGENT);
        if (wid == 0) {
            unsigned sp = 0;
            while ((unsigned)__builtin_amdgcn_readfirstlane(__hip_atomic_load(cnt + 64 * u.pm, __ATOMIC_RELAXED, __HIP_MEMORY_SCOPE_AGENT)) < 32u && ++sp < (1u << 21)) __builtin_amdgcn_s_sleep(2);
            __builtin_amdgcn_fence(__ATOMIC_ACQUIRE, "agent");
        }
        asm volatile("s_waitcnt vmcnt(0) lgkmcnt(0)" ::: "memory"); __builtin_amdgcn_s_barrier(); asm volatile("" ::: "memory");
        if (lane < 32) {
            const unsigned long long* slot = (const unsigned long long*)xbuf + (size_t)(u.pm * 256 + row) * 4; float mt[4], m2[4]; float ms = 0.f;
#pragma unroll
            for (int t = 0; t < 4; ++t) { const unsigned long long w = __hip_atomic_load(slot + t, __ATOMIC_RELAXED, __HIP_MEMORY_SCOPE_AGENT); mt[t] = __uint_as_float((unsigned)w); m2[t] = __uint_as_float((unsigned)(w >> 32)); ms += mt[t]; }
            const float mean = ms * 0.25f; float q = 0.f;
#pragma unroll
            for (int t = 0; t < 4; ++t) { const float dm = mt[t] - mean; q += m2[t] + 256.0f * dm * dm; }
            S[row] = (f32x2){mean, 1.0f / sqrtf(q * (1.0f / 1024.0f) + eps)};
        }
        asm volatile("s_waitcnt lgkmcnt(0)" ::: "memory"); __builtin_amdgcn_s_barrier(); asm volatile("" ::: "memory");
    }
};
template <bool FINAL> struct EpiResLn {
    static constexpr bool PERM = true;
    const void* base; const float* gate; const float* lg; const float* lb; const float* mod; bf16_t* X1B; bf16_t* XN; float* out; PanelStats st; LAS unsigned char* lds;
    __device__ __forceinline__ void operator()(f32x4 (&acc)[2][2][4][2], const pg8::Unit& u, int wr, int wc, int fr, int fq) const {
        asm volatile("" : "+v"(fr), "+v"(fq));
        const int row0 = u.pm * 256 + wr * 64 + fr, c0 = u.pn * 256 + wc * 32 + 8 * fq;
#pragma unroll
        for (int ai = 0; ai < 2; ++ai)
#pragma unroll
            for (int m = 0; m < 4; ++m) { int rr_ = row0 + ai * 128 + m * 16; asm volatile("" : "+v"(rr_)); const size_t ro = (size_t)rr_ * DM;
#pragma unroll
                for (int bj = 0; bj < 2; ++bj) { int c = c0 + bj * 128; asm volatile("" : "+v"(c)); f32x4 b0, b1;
                    if (FINAL) { const u32x4 bw = *(const u32x4*)((const bf16_t*)base + ro + c); b0 = (f32x4){bflo(bw.x), bfhi(bw.x), bflo(bw.y), bfhi(bw.y)}; b1 = (f32x4){bflo(bw.z), bfhi(bw.z), bflo(bw.w), bfhi(bw.w)}; }
                    else { b0 = *(const f32x4*)((const float*)base + ro + c); b1 = *(const f32x4*)((const float*)base + ro + c + 4); }
                    const f32x4 g0 = *(const f32x4*)(gate + c), g1 = *(const f32x4*)(gate + c + 4);
                    acc[ai][bj][m][0] = b0 * ALPHA + g0 * acc[ai][bj][m][0]; acc[ai][bj][m][1] = b1 * ALPHA + g1 * acc[ai][bj][m][1];
                    asm volatile("" : "+v"(acc[ai][bj][m][0]), "+v"(acc[ai][bj][m][1])); }
                __builtin_amdgcn_sched_barrier(0); }
        st.run(acc, u, wr, wc, fr, fq, lds, wr * 4 + wc, fq * 16 + fr);
        const LAS f32x2* S = (const LAS f32x2*)(lds + LN_LDS + 8192);
#pragma unroll
        for (int ai = 0; ai < 2; ++ai)
#pragma unroll
            for (int m = 0; m < 4; ++m) { int r = ai * 128 + wr * 64 + m * 16 + fr; asm volatile("" : "+v"(r)); const f32x2 sr = S[r]; const size_t ro = (size_t)(u.pm * 256 + r) * DM;
#pragma unroll
                for (int bj = 0; bj < 2; ++bj) { int c = c0 + bj * 128; asm volatile("" : "+v"(c));
                    const f32x4 y0 = (acc[ai][bj][m][0] - sr.x) * sr.y * *(const f32x4*)(lg + c) + *(const f32x4*)(lb + c);
                    const f32x4 y1 = (acc[ai][bj][m][1] - sr.x) * sr.y * *(const f32x4*)(lg + c + 4) + *(const f32x4*)(lb + c + 4);
                    if (FINAL) { *(f32x4*)(out + ro + c) = y0; *(f32x4*)(out + ro + c + 4) = y1; }
                    else { u32x4 w; w.x = pg8::cvt_pk_bf16(y0[0], y0[1]); w.y = pg8::cvt_pk_bf16(y0[2], y0[3]); w.z = pg8::cvt_pk_bf16(y1[0], y1[1]); w.w = pg8::cvt_pk_bf16(y1[2], y1[3]);
                        *(u32x4*)(X1B + ro + c) = w;
                        const f32x4 h0 = y0 * (*(const f32x4*)(mod + 4096 + c) + 1.0f) + *(const f32x4*)(mod + 3072 + c), h1 = y1 * (*(const f32x4*)(mod + 4096 + c + 4) + 1.0f) + *(const f32x4*)(mod + 3072 + c + 4);
                        u32x4 w2; w2.x = pg8::cvt_pk_bf16(h0[0], h0[1]); w2.y = pg8::cvt_pk_bf16(h0[2], h0[3]); w2.z = pg8::cvt_pk_bf16(h1[0], h1[1]); w2.w = pg8::cvt_pk_bf16(h1[2], h1[3]);
                        *(u32x4*)(XN + ro + c) = w2; } }
                __builtin_amdgcn_sched_barrier(0); }
    }
};
struct EpiSlab {
    static constexpr bool PERM = true;
    float* slab;
    __device__ __forceinline__ void operator()(const f32x4 (&acc)[2][2][4][2], const pg8::Unit& u, int wr, int wc, int fr, int fq) const {
        asm volatile("" : "+v"(fr), "+v"(fq));
        const int row0 = wr * 64 + fr, c0 = u.pn * 256 + wc * 32 + 8 * fq; float* sb = slab + (size_t)u.ks * NSMP * DM;
#pragma unroll
        for (int ai = 0; ai < 2; ++ai)
#pragma unroll
            for (int m = 0; m < 4; ++m) { float* op = sb + (size_t)(row0 + ai * 128 + m * 16) * DM + c0;
#pragma unroll
                for (int bj = 0; bj < 2; ++bj) { *(f32x4*)(op + bj * 128) = acc[ai][bj][m][0]; *(f32x4*)(op + bj * 128 + 4) = acc[ai][bj][m][1]; } }
    }
};
struct EpiFfn {
    static constexpr bool PERM = true;
    bf16_t* ACT;
    __device__ __forceinline__ void operator()(const f32x4 (&acc)[2][2][4][2], const pg8::Unit& u, int wr, int wc, int fr, int fq) const {
        asm volatile("" : "+v"(fr), "+v"(fq));
        const int row0 = u.pm * 256 + wr * 64 + fr, c0 = u.pn * 128 + wc * 32 + 8 * fq;
#pragma unroll
        for (int ai = 0; ai < 2; ++ai)
#pragma unroll
            for (int m = 0; m < 4; ++m) { const f32x4 g0 = acc[ai][0][m][0], g1 = acc[ai][0][m][1], u0 = acc[ai][1][m][0], u1 = acc[ai][1][m][1];
                u32x4 w; w.x = pg8::cvt_pk_bf16(siluf_(g0[0]) * u0[0], siluf_(g0[1]) * u0[1]); w.y = pg8::cvt_pk_bf16(siluf_(g0[2]) * u0[2], siluf_(g0[3]) * u0[3]);
                w.z = pg8::cvt_pk_bf16(siluf_(g1[0]) * u1[0], siluf_(g1[1]) * u1[1]); w.w = pg8::cvt_pk_bf16(siluf_(g1[2]) * u1[2], siluf_(g1[3]) * u1[3]);
                *(u32x4*)(ACT + (size_t)(row0 + ai * 128 + m * 16) * DFF + c0) = w; }
    }
};

struct Frame {
    LAS unsigned char* lds; unsigned char* ldsg;
    int tid, lane, wave, G, bid;
    const float* const* in; float* out; unsigned char* ws;
};
enum { I_XP = 0, I_XS, I_CDK, I_CDV, I_CFK, I_CFV, I_CFL, I_CP, I_CS, I_WADA, I_BADA, I_WIN, I_BF, I_LQ1, I_LK1, I_LQ2, I_LK2, I_SUBG, I_RELB, I_WA, I_WB, I_WO, I_LN1G, I_LN1B, I_LN2G, I_LN2B, I_WFI, I_WFO };

__device__ __forceinline__ void tr_item(const float* W, int ldw, int src_n0, int k0, bf16_t* WT, int ldt, int dst_row0, int dst_k0, int dup_off, LAS float* scr, int lane) {
#pragma unroll 8
    for (int i = 0; i < 32; ++i) { const int kk = 2 * i + (lane >> 5); scr[kk * 33 + (lane & 31)] = W[(size_t)(k0 + kk) * ldw + src_n0 + (lane & 31)]; }
    asm volatile("s_waitcnt lgkmcnt(0)" ::: "memory");
    const int c = lane & 7;
#pragma unroll
    for (int j = 0; j < 4; ++j) { const int n = (lane >> 3) + 8 * j; const LAS float* s = scr + (8 * c) * 33 + n;
        u32x4 o; o.x = pk2(s[0 * 33], s[1 * 33]); o.y = pk2(s[2 * 33], s[3 * 33]); o.z = pk2(s[4 * 33], s[5 * 33]); o.w = pk2(s[6 * 33], s[7 * 33]);
        bf16_t* d = WT + (size_t)(dst_row0 + n) * ldt + dst_k0 + 8 * c;
        *(u32x4*)d = o; if (dup_off) *(u32x4*)(d + dup_off) = o; }
    asm volatile("s_waitcnt lgkmcnt(0)" ::: "memory");
}
__device__ __forceinline__ void weight_copies(Frame& F, int c, int n, int it0, int it1) {
    LAS float* scr = (LAS float*)(F.lds + F.wave * 16384);
    const int gw = c * 8 + F.wave, NGW = n * 8;
    constexpr int I_IN = 16 * (NZ / 32), I_A = 8 * 32, I_B = 8 * 32, I_O = 16 * 32, I_FI = 16 * (NFF2 / 32), I_FO = (DFF / 64) * 32;
    for (int it = it0 + gw; it < it1; it += NGW) {
        int r = it;
        if (r < I_IN) { const int nb = NZ / 32, kb = r / nb, n0 = 32 * (r % nb); tr_item(F.in[I_WIN], WIN_COLS, n0 < 3072 ? n0 : n0 + 8, 64 * kb, (bf16_t*)(F.ws + WS_WIN), 1024, n0, 64 * kb, 0, scr, F.lane); continue; } r -= I_IN;
        if (r < I_A) { const int kb = r / 32, n0 = 32 * (r % 32); tr_item(F.in[I_WA], 1024, n0, 64 * kb, (bf16_t*)(F.ws + WS_WAB), 512, n0, 64 * kb, 0, scr, F.lane); continue; } r -= I_A;
        if (r < I_B) { const int kb = r / 32, n0 = 32 * (r % 32); tr_item(F.in[I_WB], 1024, n0, 64 * kb, (bf16_t*)(F.ws + WS_WAB), 512, 1024 + n0, 64 * kb, 0, scr, F.lane); continue; } r -= I_B;
        if (r < I_O) { const int kb = r / 32, n0 = 32 * (r % 32); tr_item(F.in[I_WO], 1024, n0, 64 * kb, (bf16_t*)(F.ws + WS_WO2), 2048, n0, 64 * kb, 1024, scr, F.lane); continue; } r -= I_O;
        if (r < I_FI) { const int nb = NFF2 / 32, kb = r / nb, n0 = 32 * (r % nb), t = n0 >> 8, j = n0 & 255; const int src = j < 128 ? 128 * t + j : DFF + 128 * t + (j - 128);
            tr_item(F.in[I_WFI], NFF2, src, 64 * kb, (bf16_t*)(F.ws + WS_WFI), 1024, n0, 64 * kb, 0, scr, F.lane); continue; } r -= I_FI;
        { const int kb = r / 32, n0 = 32 * (r % 32); tr_item(F.in[I_WFO], 1024, n0, 64 * kb, (bf16_t*)(F.ws + WS_WFO), DFF, n0, 64 * kb, 0, scr, F.lane); }
    }
}
constexpr int WC_IN = 16 * (NZ / 32), WC_ALL = WC_IN + 8 * 32 + 8 * 32 + 16 * 32 + 16 * (NFF2 / 32) + (DFF / 64) * 32;
__device__ __forceinline__ void p0_prologue(Frame& F) {
    if (F.bid < 96) {
        LAS float* sc = (LAS float*)F.lds;
        LAS float* part = sc + 17 * 1024;
        for (int i = F.tid; i < 17 * 1024; i += 512) { const int r = i >> 10, k = i & 1023; const float c = r == 0 ? F.in[I_CP][k] : F.in[I_CS][(r - 1) * 1024 + k]; sc[i] = siluf_(c); }
        __syncthreads();
        const int n = F.bid * 64 + F.lane; const float* wa = F.in[I_WADA] + n;
        float acc[17];
#pragma unroll
        for (int r = 0; r < 17; ++r) acc[r] = 0.f;
        for (int k = F.wave * 128; k < F.wave * 128 + 128; k += 4) {
            const float w0 = wa[(size_t)k * 6144], w1 = wa[(size_t)(k + 1) * 6144], w2 = wa[(size_t)(k + 2) * 6144], w3 = wa[(size_t)(k + 3) * 6144];
#pragma unroll
            for (int r = 0; r < 17; ++r) { const f32x4 s = *(const LAS f32x4*)(sc + r * 1024 + k); acc[r] += s[0] * w0 + s[1] * w1 + s[2] * w2 + s[3] * w3; }
        }
#pragma unroll
        for (int r = 0; r < 17; ++r) part[(F.wave * 17 + r) * 64 + F.lane] = acc[r];
        __syncthreads();
        float* mod = (float*)(F.ws + WS_MOD);
        for (int i = F.tid; i < 17 * 64; i += 512) { const int r = i >> 6, l = i & 63; float s = 0.f;
#pragma unroll
            for (int w = 0; w < 8; ++w) s += part[(w * 17 + r) * 64 + l];
            mod[r * 6144 + F.bid * 64 + l] = s + F.in[I_BADA][F.bid * 64 + l]; }
        asm volatile("s_waitcnt vmcnt(0)" ::: "memory");
        __syncthreads();
        if (F.tid == 0) { __builtin_amdgcn_fence(__ATOMIC_RELEASE, "agent"); asm volatile("s_waitcnt vmcnt(0)" ::: "memory");
            __hip_atomic_fetch_add((unsigned*)(F.ws + WS_CTL) + 320, 1u, __ATOMIC_RELAXED, __HIP_MEMORY_SCOPE_AGENT); }
    }
    weight_copies(F, F.bid, F.G, 0, 16 * (NZ / 32));
}

__device__ __forceinline__ void p1_rows(Frame& F, bool wait_mod) {
    LAS float* wf = (LAS float*)F.lds;
    for (int i = F.tid; i < 1024 * 8; i += 512) wf[i] = F.in[I_WIN][(size_t)(i >> 3) * WIN_COLS + 3072 + (i & 7)];
    __syncthreads();
    const float* mod = (const float*)(F.ws + WS_MOD);
    bf16_t* XN = (bf16_t*)(F.ws + WS_XN);
    const int gw = F.bid * 8 + F.wave, NGW = F.G * 8;
    if (wait_mod) {
        if (F.tid == 0) { unsigned* w = (unsigned*)(F.ws + WS_CTL) + 320; unsigned sp = 0;
            while (__hip_atomic_load(w, __ATOMIC_RELAXED, __HIP_MEMORY_SCOPE_AGENT) < 96u && ++sp < (1u << 22)) __builtin_amdgcn_s_sleep(2);
            __builtin_amdgcn_fence(__ATOMIC_ACQUIRE, "agent"); asm volatile("s_waitcnt vmcnt(0)" ::: "memory"); }
        __syncthreads(); }
    for (int m = gw; m < MT; m += NGW) {
        const bool smp = m >= SEQ; const int rb = smp ? 1 + ((m - SEQ) >> 4) : 0;
        const float* xr = smp ? F.in[I_XS] + (size_t)(m - SEQ) * DM : F.in[I_XP] + (size_t)m * DM;
        const float* sh = mod + (size_t)rb * 6144, *scl = sh + 1024;
        float a8[8];
#pragma unroll
        for (int j = 0; j < 8; ++j) a8[j] = 0.f;
#pragma unroll
        for (int j = 0; j < 4; ++j) { const int k = 4 * F.lane + 256 * j;
            const f32x4 x = *(const f32x4*)(xr + k), s1 = *(const f32x4*)(scl + k), t1 = *(const f32x4*)(sh + k);
            const f32x4 h = x * (s1 + 1.0f) + t1;
            u32x2 w; w.x = pk2(h[0], h[1]); w.y = pk2(h[2], h[3]); *(u32x2*)(XN + (size_t)m * DM + k) = w;
#pragma unroll
            for (int e = 0; e < 4; ++e) { const f32x4 wa = *(const LAS f32x4*)(wf + (k + e) * 8), wb = *(const LAS f32x4*)(wf + (k + e) * 8 + 4);
                a8[0] += h[e] * wa[0]; a8[1] += h[e] * wa[1]; a8[2] += h[e] * wa[2]; a8[3] += h[e] * wa[3];
                a8[4] += h[e] * wb[0]; a8[5] += h[e] * wb[1]; a8[6] += h[e] * wb[2]; a8[7] += h[e] * wb[3]; } }
        float mine = 0.f;
#pragma unroll
        for (int j = 0; j < 8; ++j) { const float s = wave_sum(a8[j]); if (F.lane == j) mine = s; }
        if (F.lane < 8) { const float v = mine + F.in[I_BF][F.lane]; const float lf = fminf(v, 0.f) - log1pf(__expf(-fabsf(v)));
            float* o = smp ? F.out + O_FLS + (size_t)(m - SEQ) * 8 : F.out + O_FLP + (size_t)m * 8; o[F.lane] = lf; }
    }
}

__device__ __forceinline__ float block_excl_scan(Frame& F, float tot, LAS float* sm) {
    float inc = tot;
#pragma unroll
    for (int o = 1; o < 64; o <<= 1) { const float t = __shfl_up(inc, o); if (F.lane >= o) inc += t; }
    if (F.lane == 63) sm[F.wave] = inc;
    __syncthreads();
    float base = 0.f;
    for (int w = 0; w < F.wave; ++w) base += sm[w];
    __syncthreads();
    return base + inc - tot;
}
__device__ __forceinline__ void p2_cumsum(Frame& F) {
    LAS float* sm = (LAS float*)F.lds;
    if (F.bid < 8) {
        const int h = F.bid; const float* lf = F.out + O_FLP; float* Fp = (float*)(F.ws + WS_FP) + (size_t)h * SEQ;
        float v[32]; float run = 0.f;
#pragma unroll
        for (int i = 0; i < 32; ++i) { run += lf[(size_t)(32 * F.tid + i) * 8 + h]; v[i] = run; }
        const float off = block_excl_scan(F, run, sm);
#pragma unroll
        for (int i = 0; i < 32; i += 4) *(f32x4*)(Fp + 32 * F.tid + i) = (f32x4){(off + v[i]) * LOG2E, (off + v[i + 1]) * LOG2E, (off + v[i + 2]) * LOG2E, (off + v[i + 3]) * LOG2E};
    } else if (F.bid < 8 + 128) {
        const int b = (F.bid - 8) >> 3, h = (F.bid - 8) & 7;
        const float* cl = F.in[I_CFL] + (size_t)b * PAST * 8; float* Fs = (float*)(F.ws + WS_FS) + (size_t)(b * 8 + h) * SKV;
        float v[4]; float run = 0.f;
#pragma unroll
        for (int i = 0; i < 4; ++i) { run += cl[(size_t)(4 * F.tid + i) * 8 + h]; v[i] = run; }
        const float off = block_excl_scan(F, run, sm);
        *(f32x4*)(Fs + 4 * F.tid) = (f32x4){(off + v[0]) * LOG2E, (off + v[1]) * LOG2E, (off + v[2]) * LOG2E, (off + v[3]) * LOG2E};
        if (F.tid == 511) { float r2 = off + run; const float* ls = F.out + O_FLS + (size_t)b * DEC_T * 8;
            for (int t = 0; t < DEC_T; ++t) { r2 += ls[t * 8 + h]; Fs[PAST + t] = r2 * LOG2E; } }
    }
}

template <bool FINAL> __device__ __forceinline__ void ln_rows(Frame& F, const float* g, const float* b, int KS, int gate_off) {
    const float* mod = (const float*)(F.ws + WS_MOD);
    const bf16_t* T = (const bf16_t*)(F.ws + WS_TB); bf16_t* X1B = (bf16_t*)(F.ws + WS_X1B); bf16_t* XN = (bf16_t*)(F.ws + WS_XN);
    const int gw = F.wave * F.G + F.bid, NGW = F.G * 8;
    for (int m = SEQ + gw; m < MT; m += NGW) {
        f32x4 v[4]; float s = 0.f;
        if (m < SEQ) {
#pragma unroll
            for (int j = 0; j < 2; ++j) { const u32x4 w = *(const u32x4*)(T + (size_t)m * DM + 8 * F.lane + 512 * j);
                v[2 * j] = (f32x4){bflo(w.x), bfhi(w.x), bflo(w.y), bfhi(w.y)}; v[2 * j + 1] = (f32x4){bflo(w.z), bfhi(w.z), bflo(w.w), bfhi(w.w)}; }
        } else {
            const float* sl = (const float*)(F.ws + WS_SLAB) + (size_t)(m - SEQ) * DM; const float* gp = mod + (size_t)(1 + ((m - SEQ) >> 4)) * 6144 + gate_off;
#pragma unroll
            for (int q = 0; q < 4; ++q) { const int k = 8 * F.lane + 512 * (q >> 1) + 4 * (q & 1); f32x4 a = (f32x4){0.f, 0.f, 0.f, 0.f};
                for (int ks = 0; ks < KS; ++ks) a += *(const f32x4*)(sl + (size_t)ks * NSMP * DM + k);
                f32x4 bs;
                if (FINAL) { const u32x2 w = *(const u32x2*)(X1B + (size_t)m * DM + k); bs = (f32x4){bflo(w.x), bfhi(w.x), bflo(w.y), bfhi(w.y)}; }
                else bs = *(const f32x4*)(F.in[I_XS] + (size_t)(m - SEQ) * DM + k);
                v[q] = bs * ALPHA + *(const f32x4*)(gp + k) * a; } }
#pragma unroll
        for (int q = 0; q < 4; ++q) s += (v[q][0] + v[q][1]) + (v[q][2] + v[q][3]);
        const float mean = wave_sum(s) * (1.f / DM); float s2 = 0.f;
#pragma unroll
        for (int q = 0; q < 4; ++q) { v[q] = v[q] - mean; s2 += (v[q][0] * v[q][0] + v[q][1] * v[q][1]) + (v[q][2] * v[q][2] + v[q][3] * v[q][3]); }
        const float rstd = 1.f / sqrtf(wave_sum(s2) * (1.f / DM) + LN_EPS);
        const int rb = m >= SEQ ? 1 + ((m - SEQ) >> 4) : 0;
#pragma unroll
        for (int q = 0; q < 4; ++q) { const int k = 8 * F.lane + 512 * (q >> 1) + 4 * (q & 1); const f32x4 gg = *(const f32x4*)(g + k), bb = *(const f32x4*)(b + k);
            const f32x4 y = v[q] * rstd * gg + bb;
            if (FINAL) *(f32x4*)(F.out + (size_t)m * DM + k) = y;
            else { u32x2 w; w.x = pk2(y[0], y[1]); w.y = pk2(y[2], y[3]); *(u32x2*)(X1B + (size_t)m * DM + k) = w;
                const f32x4 s2v = *(const f32x4*)(mod + (size_t)rb * 6144 + 4096 + k), t2v = *(const f32x4*)(mod + (size_t)rb * 6144 + 3072 + k);
                const f32x4 h = y * (s2v + 1.0f) + t2v; u32x2 w2; w2.x = pk2(h[0], h[1]); w2.y = pk2(h[2], h[3]); *(u32x2*)(XN + (size_t)m * DM + k) = w2; } }
    }
}

__device__ __forceinline__ int t5_bucket(int rel) {
    const int n = rel < 0 ? -rel : rel; int b;
    if (n < 8) b = n; else if (n < 12) b = 8; else if (n < 16) b = 9; else if (n < 23) b = 10; else if (n < 32) b = 11; else if (n < 46) b = 12; else if (n < 64) b = 13; else if (n < 91) b = 14; else b = 15;
    return b + (rel > 0 ? 16 : 0);
}
constexpr int AT_KB = 8192, AT_VB = 20480, AT_BUF = AT_KB + AT_VB;
constexpr int AT_WS = 2 * AT_BUF, AT_OST = AT_WS + 2048, AT_KEEP = 98304, AT_TAB = 131072, AT_MISC = AT_TAB + 4 * 192 * 4, AT_END = AT_MISC + 64;
__device__ __forceinline__ s16x4 vtr(const LAS char* p) { typedef short v4i16_t __attribute__((ext_vector_type(4))); return __builtin_bit_cast(s16x4, __builtin_amdgcn_ds_read_tr16_b64_v4i16((LAS v4i16_t*)p)); }

typedef __bf16 bf16x2_t_ __attribute__((ext_vector_type(2)));
__device__ __forceinline__ unsigned cvtpk_(float lo, float hi) { f32x2 v = {lo, hi}; bf16x2_t_ b = __builtin_convertvector(v, bf16x2_t_); return __builtin_bit_cast(unsigned, b); }
__device__ __forceinline__ void glds16_asm(const void* gsrc, unsigned lds_dst) { unsigned keep;
    asm volatile("s_mov_b32 %0, m0\n\ts_mov_b32 m0, %2\n\ts_nop 0\n\tglobal_load_lds_dwordx4 %1, off\n\ts_mov_b32 m0, %0" : "=&s"(keep) : "v"(gsrc), "s"(lds_dst) : "memory"); }
template <int OFF> __device__ __forceinline__ void glds16_asm_off(const void* gsrc, unsigned lds_dst) { unsigned keep;
    asm volatile("s_mov_b32 %0, m0\n\ts_mov_b32 m0, %2\n\ts_nop 0\n\tglobal_load_lds_dwordx4 %1, off offset:%3\n\ts_mov_b32 m0, %0" : "=&s"(keep) : "v"(gsrc), "s"(lds_dst), "i"(OFF) : "memory"); }
template <int OFF> __device__ __forceinline__ void glds16_s(const void* sbase, unsigned voff, unsigned lds_dst) { unsigned keep;
    asm volatile("s_mov_b32 %0, m0\n\ts_mov_b32 m0, %3\n\ts_nop 0\n\tglobal_load_lds_dwordx4 %1, %2 offset:%4\n\ts_mov_b32 m0, %0" : "=&s"(keep) : "v"(voff), "s"(sbase), "s"(lds_dst), "i"(OFF) : "memory"); }
__device__ __forceinline__ void glds4_s(const void* sbase, unsigned voff, unsigned lds_dst) { unsigned keep;
    asm volatile("s_mov_b32 %0, m0\n\ts_mov_b32 m0, %3\n\ts_nop 0\n\tglobal_load_lds_dword %1, %2\n\ts_mov_b32 m0, %0" : "=&s"(keep) : "v"(voff), "s"(sbase), "s"(lds_dst) : "memory"); }
__device__ __forceinline__ const void* uniform_ptr(const void* p) { const unsigned long long v = (unsigned long long)p;
    const unsigned lo = (unsigned)__builtin_amdgcn_readfirstlane((int)(unsigned)v), hi = (unsigned)__builtin_amdgcn_readfirstlane((int)(unsigned)(v >> 32)); return (const void*)(((unsigned long long)hi << 32) | lo); }
__device__ __forceinline__ void glds4_asm(const void* gsrc, unsigned lds_dst) { unsigned keep;
    asm volatile("s_mov_b32 %0, m0\n\ts_mov_b32 m0, %2\n\ts_nop 0\n\tglobal_load_lds_dword %1, off\n\ts_mov_b32 m0, %0" : "=&s"(keep) : "v"(gsrc), "s"(lds_dst) : "memory"); }
constexpr int R_V = 0, R_K = 49152, R_F = 73728, R_WS = 79872;
__device__ __forceinline__ float max3f_(float a, float b, float c) { float r; asm("v_max3_f32 %0, %1, %2, %3" : "=v"(r) : "v"(a), "v"(b), "v"(c)); return r; }
__device__ __forceinline__ float max2f_(float a, float b) { float r; asm("v_max_f32_e32 %0, %1, %2" : "=v"(r) : "v"(a), "v"(b)); return r; }
#define AP3_PIN(x) asm volatile("" : "+v"(x))
template <int MODE, int DV, int pv = 0, bool SREF = false>
__device__ __forceinline__ void attn_pass3(Frame& F, const bf16_t* Q, const bf16_t* K, const bf16_t* V, int q0, int NT, const float* Fh, int hb, f32x16 (&o)[DV / 32], int t0 = 0) {
    constexpr int NDB = DV / 32, VS = DV * 128, EPG = 8 / NDB;
    constexpr float THR = 8.0f;
    const int lane = F.lane, r32 = lane & 31, hi = lane >> 5, wid = F.wave;
    const LAS char* lds = (const LAS char*)F.lds;
    LAS float* wsf = (LAS float*)(F.lds + R_WS) + wid * 64;
    const LAS float* tab = (const LAS float*)(F.lds + AT_TAB) + hb * 192;
    const int qrow = q0 + wid * 32 + r32;
    const int tmaxw = (q0 >> 6) + (wid >> 1);
    const char* Ku = (const char*)uniform_ptr(K); const char* Vu = (const char*)uniform_ptr(V); const char* Fu = (const char*)uniform_ptr(MODE == 0 ? (const void*)Fh : (const void*)K);
    const unsigned kvo = (unsigned)(((8 * wid + (lane >> 3)) * 512 + (((lane & 7) ^ (lane >> 3)) << 3)) * 2);
    const unsigned vvo = (unsigned)(((16 * (wid & 3) + (lane >> 2)) * 512 + 32 * (wid >> 2) + 8 * (lane & 3)) * 2);
    const unsigned fvo = (unsigned)(lane * 4);
    const unsigned lds0 = (unsigned)(size_t)F.lds;
    const unsigned dk = (unsigned)__builtin_amdgcn_readfirstlane((int)(lds0 + R_K + wid * 1024)), dv = (unsigned)__builtin_amdgcn_readfirstlane((int)(lds0 + R_V + wid * 1024)),
                   df = (unsigned)__builtin_amdgcn_readfirstlane((int)(lds0 + R_F + wid * 256));
#define AP_ISSUE_K(t, SL) do { glds16_s<0>(Ku + (size_t)(t) * 65536, kvo, dk + (SL) * 8192); if (MODE == 0) glds4_s(Fu + (size_t)(t) * 256, fvo, df + (SL) * 2048); } while (0)
#define AP_ISSUE_V(t, SL) do { glds16_s<0>(Vu + (size_t)(t) * 65536, vvo, dv + (SL) * VS); if (DV == 128) glds16_s<0>(Vu + (size_t)(t) * 65536 + 128, vvo, dv + (SL) * VS + 8192); } while (0)
#define AP_BATCH(t, SL) do { if (pv != 1) { if ((t) + 2 < NT) AP_ISSUE_K((t) + 2, ((SL) + 2) % 3); if ((t) + 1 < NT) AP_ISSUE_V((t) + 1, ((SL) + 1) % 3); } } while (0)
    AP_ISSUE_K(t0, 0); AP_ISSUE_K(t0 + 1, 1); AP_ISSUE_V(t0, 0);
    bf16x8 qr[4];
#pragma unroll
    for (int d0 = 0; d0 < 4; ++d0) qr[d0] = *(const bf16x8*)(Q + (size_t)qrow * 512 + d0 * 16 + hi * 8);
    float fqp = MODE == 0 ? Fh[qrow] : 0.f;
#pragma unroll
    for (int d = 0; d < NDB; ++d) o[d] = f32x16{};
    float m_hat = 0.f, l_run = 0.f;
    f32x16 p0, p1, negm; u32x4 pwv[4];
#pragma unroll
    for (int r = 0; r < 16; ++r) negm[r] = 0.f;
#pragma unroll
    for (int i = 0; i < 4; ++i) pwv[i] = (u32x4){0u, 0u, 0u, 0u};
    const LAS char* kb4[4];
#pragma unroll
    for (int d0 = 0; d0 < 4; ++d0) kb4[d0] = lds + R_K + r32 * 128 + (((2 * d0 + hi) ^ (r32 & 7)) << 4);
    const LAS char* vb1 = lds + R_V + (4 * hi + ((lane & 15) >> 2)) * 64 + (((lane >> 4) & 1) * 16 + (lane & 3) * 4) * 2;
    const LAS char* fb1 = lds + R_F + wid * 256 + 16 * hi;
    asm volatile("s_waitcnt vmcnt(0)" ::: "memory");
    asm volatile("" : "+v"(qr[0]), "+v"(qr[1]), "+v"(qr[2]), "+v"(qr[3]), "+v"(fqp));
    asm volatile("s_waitcnt lgkmcnt(0)\n\ts_barrier" ::: "memory");
#define AP3_VFL(buf, ks, SLV) do { _Pragma("unroll") for (int d = 0; d < NDB; ++d) { buf[2 * d] = vtr(vb1 + (SLV) * VS + d * 4096 + (ks) * 1024); buf[2 * d + 1] = vtr(vb1 + (SLV) * VS + d * 4096 + (ks) * 1024 + 512); } } while (0)
#define AP3_VFL1(buf, d, ks, SLV) do { buf[2 * (d)] = vtr(vb1 + (SLV) * VS + (d) * 4096 + (ks) * 1024); buf[2 * (d) + 1] = vtr(vb1 + (SLV) * VS + (d) * 4096 + (ks) * 1024 + 512); } while (0)
#define AP3_FRAG(buf, d) ((bf16x8){buf[2 * (d)][0], buf[2 * (d)][1], buf[2 * (d)][2], buf[2 * (d)][3], buf[2 * (d) + 1][0], buf[2 * (d) + 1][1], buf[2 * (d) + 1][2], buf[2 * (d) + 1][3]})
#define AP3_GAP(ks, d, VCUR, VNXT, PC, BC, PP, BP, HASPREV, HASNEXT, SLV) do { \
        o[d] = __builtin_amdgcn_mfma_f32_32x32x16_bf16(__builtin_bit_cast(bf16x8, pwv[ks]), AP3_FRAG(VCUR, d), o[d], 0, 0, 0); \
        if (HASNEXT) AP3_VFL1(VNXT, d, (ks) + 1, SLV); \
        _Pragma("unroll") for (int e = 0; e < EPG; ++e) { PC[(BC) + EPG * (d) + e] = __builtin_amdgcn_exp2f(PC[(BC) + EPG * (d) + e]); } \
        if (HASPREV) { _Pragma("unroll") for (int e = 0; e < EPG; ++e) rs += PP[(BP) + EPG * (d) + e]; \
            _Pragma("unroll") for (int e = 0; e < EPG / 2; ++e) pwv[(ks) - 1][(EPG / 2) * (d) + e] = cvtpk_(PP[(BP) + EPG * (d) + 2 * e], PP[(BP) + EPG * (d) + 2 * e + 1]); AP3_PIN(rs); } \
        AP3_PIN(PC); \
        __builtin_amdgcn_sched_barrier(0); } while (0)
#define AP3_GROUP(ks, VCUR, VNXT, PC, BC, PP, BP, HASPREV, HASNEXT, SLV) do { _Pragma("unroll") for (int d = 0; d < NDB; ++d) AP3_GAP(ks, d, VCUR, VNXT, PC, BC, PP, BP, HASPREV, HASNEXT, SLV); } while (0)
#define AP3_OCT(PC, BC, KS) do { _Pragma("unroll") for (int e = 0; e < 8; ++e) { PC[(BC) + e] = __builtin_amdgcn_exp2f(PC[(BC) + e]); rs += PC[(BC) + e]; } \
        _Pragma("unroll") for (int e = 0; e < 4; ++e) pwv[KS][e] = cvtpk_(PC[(BC) + 2 * e], PC[(BC) + 2 * e + 1]); } while (0)
#define AP3_KRD(i, SL) (*(const LAS bf16x8*)(kb4[(i) >> 1] + (SL) * 8192 + ((i) & 1) * 4096))
#define AP3_MM(KF, d0, P) P = __builtin_amdgcn_mfma_f32_32x32x16_bf16(KF, qr[d0], P, 0, 0, 0)
#define AP3_QKF(SL) do { bf16x8 ka = AP3_KRD(0, SL), kb = AP3_KRD(1, SL), kc = AP3_KRD(2, SL); \
        if (MODE == 0) { \
            _Pragma("unroll") for (int g4 = 0; g4 < 4; ++g4) { const f32x4 fa = *(const LAS f32x4*)(fb1 + (SL) * 2048 + 32 * g4), fb = *(const LAS f32x4*)(fb1 + (SL) * 2048 + 128 + 32 * g4); \
                _Pragma("unroll") for (int e = 0; e < 4; ++e) { p0[4 * g4 + e] = fqp - fa[e]; p1[4 * g4 + e] = fqp - fb[e]; } } \
        } else { p0 = f32x16{}; p1 = f32x16{}; } \
        __builtin_amdgcn_sched_barrier(0); \
        AP3_MM(ka, 0, p0); ka = AP3_KRD(3, SL); __builtin_amdgcn_sched_barrier(0); \
        AP3_MM(kb, 0, p1); kb = AP3_KRD(4, SL); __builtin_amdgcn_sched_barrier(0); \
        AP3_MM(kc, 1, p0); kc = AP3_KRD(5, SL); __builtin_amdgcn_sched_barrier(0); \
        AP3_MM(ka, 1, p1); ka = AP3_KRD(6, SL); __builtin_amdgcn_sched_barrier(0); \
        AP3_MM(kb, 2, p0); kb = AP3_KRD(7, SL); __builtin_amdgcn_sched_barrier(0); \
        AP3_MM(kc, 2, p1); __builtin_amdgcn_sched_barrier(0); \
        AP3_MM(ka, 3, p0); __builtin_amdgcn_sched_barrier(0); \
        AP3_MM(kb, 3, p1); \
        asm volatile("" : "+v"(p0), "+v"(p1)); \
    } while (0)
#define AP3_QKS(SL) do { bf16x8 kf[8]; \
        _Pragma("unroll") for (int d0 = 0; d0 < 4; ++d0) { kf[2 * d0] = *(const LAS bf16x8*)(kb4[d0] + (SL) * 8192); kf[2 * d0 + 1] = *(const LAS bf16x8*)(kb4[d0] + (SL) * 8192 + 4096); } \
        if (MODE == 0) { const float sft = fqp - m_hat; \
            _Pragma("unroll") for (int g4 = 0; g4 < 4; ++g4) { const f32x4 fa = *(const LAS f32x4*)(fb1 + (SL) * 2048 + 32 * g4), fb = *(const LAS f32x4*)(fb1 + (SL) * 2048 + 128 + 32 * g4); \
                _Pragma("unroll") for (int e = 0; e < 4; ++e) { p0[4 * g4 + e] = sft - fa[e]; p1[4 * g4 + e] = sft - fb[e]; } } \
            _Pragma("unroll") for (int d0 = 0; d0 < 4; ++d0) { p0 = __builtin_amdgcn_mfma_f32_32x32x16_bf16(kf[2 * d0], qr[d0], p0, 0, 0, 0); p1 = __builtin_amdgcn_mfma_f32_32x32x16_bf16(kf[2 * d0 + 1], qr[d0], p1, 0, 0, 0); } \
        } else { \
            if constexpr (SREF) { p0 = __builtin_amdgcn_mfma_f32_32x32x16_bf16(kf[0], qr[0], f32x16{}, 0, 0, 0); p1 = __builtin_amdgcn_mfma_f32_32x32x16_bf16(kf[1], qr[0], f32x16{}, 0, 0, 0); } \
            else { p0 = __builtin_amdgcn_mfma_f32_32x32x16_bf16(kf[0], qr[0], negm, 0, 0, 0); p1 = __builtin_amdgcn_mfma_f32_32x32x16_bf16(kf[1], qr[0], negm, 0, 0, 0); } \
            _Pragma("unroll") for (int d0 = 1; d0 < 4; ++d0) { p0 = __builtin_amdgcn_mfma_f32_32x32x16_bf16(kf[2 * d0], qr[d0], p0, 0, 0, 0); p1 = __builtin_amdgcn_mfma_f32_32x32x16_bf16(kf[2 * d0 + 1], qr[d0], p1, 0, 0, 0); } } \
        if constexpr (SREF) asm volatile("" : "+v"(p0), "+v"(p1)); else asm volatile("s_nop 15\n\ts_nop 7" : "+v"(p0), "+v"(p1));     \
    } while (0)
#define AP3_QK(SL) do { if constexpr (SREF) AP3_QKF(SL); else AP3_QKS(SL); } while (0)
#define AP3_DECIDE(WITH_TAB) do { \
        if (MODE == 0) { \
            if (t * 64 + 63 > q0 + wid * 32) { const int ln_ = lane_id_opaque(), kv0 = t * 64 + 4 * (ln_ >> 5), qrow_ = q0 + wid * 32 + (ln_ & 31);     \
                _Pragma("unroll") for (int r = 0; r < 16; ++r) { const int kv = kv0 + (r & 3) + 8 * (r >> 2); if (kv > qrow_) p0[r] = -1e30f; if (kv + 32 > qrow_) p1[r] = -1e30f; } } \
        } else if (WITH_TAB) { \
            if (near) { const int ln_ = lane_id_opaque(), kv0 = t * 64 + 4 * (ln_ >> 5), qrow_ = q0 + wid * 32 + (ln_ & 31); const LAS float* tab_ = (const LAS float*)(F.lds + AT_TAB) + hb * 192; \
                _Pragma("unroll") for (int g4 = 0; g4 < 4; ++g4) { \
                    _Pragma("unroll") for (int e = 0; e < 4; ++e) { const int r = 4 * g4 + e; const int rel = kv0 + e + 8 * g4 - qrow_; int i0 = rel + 128, i1 = rel + 160; i0 = i0 < 0 ? 0 : i0; i1 = i1 < 0 ? 0 : i1; \
                        p0[r] += tab_[i0]; p1[r] += tab_[i1]; } \
                    __builtin_amdgcn_sched_barrier(0); } } } \
        if constexpr (!SREF) { \
        float ma = max3f_(p0[0], p0[1], p1[0]), mb = max3f_(p0[2], p0[3], p1[1]); ma = max3f_(ma, p1[2], p1[3]); \
        _Pragma("unroll") for (int r = 4; r < 16; r += 4) { ma = max3f_(ma, p0[r], p0[r + 1]); mb = max3f_(mb, p0[r + 2], p0[r + 3]); ma = max3f_(ma, p1[r], p1[r + 1]); mb = max3f_(mb, p1[r + 2], p1[r + 3]); } \
        float rm = max2f_(ma, mb); \
        { auto rr = __builtin_amdgcn_permlane32_swap(__float_as_uint(rm), __float_as_uint(rm), false, false); rm = max2f_(__uint_as_float(rr[0]), __uint_as_float(rr[1])); } \
        resc = (tz == t0) || __any(rm > THR); \
        if (resc) { const float dl = tz == t0 ? rm : fmaxf(rm, 0.f); m_hat += dl; \
            _Pragma("unroll") for (int r = 0; r < 16; ++r) { p0[r] -= dl; p1[r] -= dl; } \
            if (MODE == 1) { const float nm_ = -m_hat; _Pragma("unroll") for (int r = 0; r < 16; ++r) negm[r] = nm_; } \
            al = tz == t0 ? 1.0f : __builtin_amdgcn_exp2f(-dl); l_run *= al; } } } while (0)
#define AP3_STEP(tt, SL) do { const int t = (tt); if (t > NT) break; int tz = t; asm volatile("" : "+s"(tz)); \
        if (t < NT) AP_BATCH(t, SL); \
        const bool doPV = tz > t0 && t - 1 <= tmaxw, doQK = t < NT && t <= tmaxw; \
        bool resc = false; float al = 1.0f, rs = 0.f; \
        const bool near = MODE == 1 && (t * 64 + 63 + 91 > q0 + wid * 32); \
        if (doQK) AP3_QK(SL); else { p0 = f32x16{}; p1 = f32x16{}; }     \
        __builtin_amdgcn_sched_barrier(0); \
        if (doQK) AP3_DECIDE(true); \
        __builtin_amdgcn_sched_barrier(0); \
        if (doPV) { s16x4 vfa[2 * NDB]; AP3_VFL(vfa, 0, ((SL) + 2) % 3);     \
            AP3_GROUP(0, vfa, vfa, p0, 0, p0, 0, false, true, ((SL) + 2) % 3); \
            AP3_GROUP(1, vfa, vfa, p0, 8, p0, 0, true, true, ((SL) + 2) % 3); \
            AP3_GROUP(2, vfa, vfa, p1, 0, p0, 8, true, true, ((SL) + 2) % 3); \
            AP3_GROUP(3, vfa, vfa, p1, 8, p1, 0, true, false, ((SL) + 2) % 3); \
            _Pragma("unroll") for (int e = 0; e < 8; ++e) rs += p1[8 + e]; \
            _Pragma("unroll") for (int e = 0; e < 4; ++e) pwv[3][e] = cvtpk_(p1[8 + 2 * e], p1[8 + 2 * e + 1]); \
        } else if (doQK) { AP3_OCT(p0, 0, 0); AP3_OCT(p0, 8, 1); AP3_OCT(p1, 0, 2); AP3_OCT(p1, 8, 3); } \
        if (doQK) l_run += rs; \
          \
        if (resc && tz > t0) { \
            if (hi == 0) wsf[r32] = al; \
            asm volatile("s_waitcnt lgkmcnt(0)" ::: "memory"); \
            _Pragma("unroll") for (int g4 = 0; g4 < 4; ++g4) { const f32x4 a4 = *(const LAS f32x4*)(wsf + 8 * g4 + 4 * hi); \
                _Pragma("unroll") for (int d = 0; d < NDB; ++d) \
                    _Pragma("unroll") for (int e = 0; e < 4; ++e) o[d][4 * g4 + e] *= a4[e]; } } \
        if (t == NT) break; \
        if (pv == 6) { if (t + 2 < NT) asm volatile("s_waitcnt vmcnt(3) lgkmcnt(0)" ::: "memory"); else asm volatile("s_waitcnt vmcnt(0) lgkmcnt(0)" ::: "memory"); } \
        else { if (t + 2 < NT) asm volatile("s_waitcnt vmcnt(3) lgkmcnt(0)\n\ts_barrier" ::: "memory"); else asm volatile("s_waitcnt vmcnt(0) lgkmcnt(0)\n\ts_barrier" ::: "memory"); } \
    } while (0)
#define AP3_FSTEP(tt, SL) do { const int t = (tt); \
        AP_ISSUE_K(t + 2, ((SL) + 2) % 3); AP_ISSUE_V(t + 1, ((SL) + 1) % 3); \
        float rs = 0.f; \
        AP3_QKF(SL); \
        __builtin_amdgcn_sched_barrier(0); \
        { s16x4 vfa[2 * NDB]; AP3_VFL(vfa, 0, ((SL) + 2) % 3); \
          AP3_GROUP(0, vfa, vfa, p0, 0, p0, 0, false, true, ((SL) + 2) % 3); \
          AP3_GROUP(1, vfa, vfa, p0, 8, p0, 0, true, true, ((SL) + 2) % 3); \
          AP3_GROUP(2, vfa, vfa, p1, 0, p0, 8, true, true, ((SL) + 2) % 3); \
          AP3_GROUP(3, vfa, vfa, p1, 8, p1, 0, true, false, ((SL) + 2) % 3); \
          _Pragma("unroll") for (int e = 0; e < 8; ++e) rs += p1[8 + e]; \
          _Pragma("unroll") for (int e = 0; e < 4; ++e) pwv[3][e] = cvtpk_(p1[8 + 2 * e], p1[8 + 2 * e + 1]); } \
        l_run += rs; \
        asm volatile("s_waitcnt vmcnt(3) lgkmcnt(0)\n\ts_barrier" ::: "memory"); \
    } while (0)
    if (wid >= 4) __builtin_amdgcn_s_setprio(1);
    int t3 = t0;
    if constexpr (SREF && pv == 0) {
        AP3_STEP(t3, 0); AP3_STEP(t3 + 1, 1); AP3_STEP(t3 + 2, 2); t3 += 3;
        const int tfe = (q0 >> 6) - 3;
        for (; t3 + 2 <= tfe; t3 += 3) { AP3_FSTEP(t3, 0); AP3_FSTEP(t3 + 1, 1); AP3_FSTEP(t3 + 2, 2); }
    }
    for (; t3 <= NT; t3 += 3) { AP3_STEP(t3, 0); AP3_STEP(t3 + 1, 1); AP3_STEP(t3 + 2, 2); }
    if (wid >= 4) __builtin_amdgcn_s_setprio(0);
    asm volatile("s_waitcnt lgkmcnt(0)\n\ts_barrier" ::: "memory");
    l_run += __shfl_xor(l_run, 32);
    if (hi == 0) wsf[r32] = 1.0f / l_run;
    asm volatile("s_waitcnt lgkmcnt(0)" ::: "memory");
#pragma unroll
    for (int g4 = 0; g4 < 4; ++g4) { const f32x4 a4 = *(const LAS f32x4*)(wsf + 8 * g4 + 4 * hi);
#pragma unroll
        for (int d = 0; d < NDB; ++d)
#pragma unroll
            for (int e = 0; e < 4; ++e) o[d][4 * g4 + e] *= a4[e]; }
#undef AP_ISSUE_K
#undef AP_ISSUE_V
#undef AP_BATCH
#undef AP3_VFL
#undef AP3_VFL1
#undef AP3_FRAG
#undef AP3_GAP
#undef AP3_GROUP
#undef AP3_OCT
#undef AP3_STEP
#undef AP3_FSTEP
#undef AP3_QK
#undef AP3_QKF
#undef AP3_QKS
#undef AP3_KRD
#undef AP3_MM
#undef AP3_DECIDE
}

template <int NDB> __device__ __forceinline__ void store_o(const f32x16 (&o)[NDB], LAS unsigned char* stgb  , bf16_t* dst  , int ld, int lane) {
    const int r32 = lane & 31, hi = lane >> 5;
    constexpr int DVC = 32 * NDB;
    LAS bf16_t* stg = (LAS bf16_t*)stgb;
#pragma unroll
    for (int d = 0; d < NDB; ++d)
#pragma unroll
        for (int r = 0; r < 16; ++r) { const int row = (r & 3) + 8 * (r >> 2) + 4 * hi; stg[row * DVC + 32 * d + r32] = (bf16_t)f2bf(o[d][r]); }
    asm volatile("s_waitcnt lgkmcnt(0)" ::: "memory");
    constexpr int CPR = DVC / 8;
#pragma unroll
    for (int i = 0; i < (32 * CPR) / 64; ++i) { const int c = i * 64 + lane, row = c / CPR, ch = c % CPR;
        const u32x4 v = *(const LAS u32x4*)(stg + row * DVC + ch * 8); *(u32x4*)(dst + (size_t)row * ld + ch * 8) = v; }
    asm volatile("s_waitcnt lgkmcnt(0)" ::: "memory");
}

__device__ __forceinline__ float lambda_full(Frame& F) {
    float a = 0.f, b = 0.f;
    for (int i = 0; i < 64; ++i) { a += F.in[I_LQ1][i] * F.in[I_LK1][i]; b += F.in[I_LQ2][i] * F.in[I_LK2][i]; }
    return __expf(a) - __expf(b) + 0.2f;
}

template <int pv = 0> __device__ __forceinline__ void attn_prompt_fox(Frame& F, int h, int qb) {
    const bf16_t* Q = (const bf16_t*)(F.ws + WS_QB) + h * 64; const bf16_t* K = (const bf16_t*)(F.ws + WS_KB) + h * 64; const bf16_t* V = (const bf16_t*)(F.ws + WS_VB) + h * 64;
    f32x16 o[2];
    const float* Fh = (const float*)(F.ws + WS_FP) + (size_t)h * SEQ;
    int t0 = 0; bool fast;
    { const unsigned* nw = (const unsigned*)(F.ws + WS_CTL) + 256;
      const float qn2 = __uint_as_float(nw[h * 2]) + __uint_as_float(nw[h * 2 + 1]), kn2 = __uint_as_float(nw[16 + h * 2]) + __uint_as_float(nw[16 + h * 2 + 1]);
      const float B = sqrtf(qn2 * kn2) * 1.02f + 0.5f;
      const float thresh = -48.0f - 2.0f * B;
      fast = __builtin_amdgcn_readfirstlane(B <= 60.0f ? 1 : 0) != 0;
      volatile LAS int* cnt = (volatile LAS int*)(F.lds + AT_MISC + 32);
      __syncthreads();
      if (F.tid < 256) { const int t = F.tid; const bool sk = t < 4 * qb && (Fh[qb * 256] - Fh[64 * t + 63]) <= thresh;
          const int c = __popcll(__ballot(sk)); if (F.lane == 0) cnt[F.wave] = c; }
      __syncthreads();
      t0 = cnt[0] + cnt[1] + cnt[2] + cnt[3]; t0 -= t0 % 3; }
    if (fast) attn_pass3<0, 64, pv, true>(F, Q, K, V, qb * 256, 4 * qb + 4, Fh, 0, o, t0); else attn_pass3<0, 64, pv, false>(F, Q, K, V, qb * 256, 4 * qb + 4, Fh, 0, o, t0);
    if (pv != 0 && o[0][0] != 1234.5678f) { __syncthreads(); return; }
    bf16_t* AB = (bf16_t*)(F.ws + WS_AB);
    store_o<2>(o, F.lds + F.wave * 8192, AB + (size_t)(qb * 256 + F.wave * 32) * DM + 512 + h * 64, DM, F.lane);
    __syncthreads();
}
template <int pv = 0> __device__ __forceinline__ void attn_prompt_diff_half(Frame& F, int h, int half, int qb) {
    const bf16_t* Q = (const bf16_t*)(F.ws + WS_QA) + h * 128 + 64 * half; const bf16_t* K = (const bf16_t*)(F.ws + WS_KA) + h * 128 + 64 * half; const bf16_t* V = (const bf16_t*)(F.ws + WS_VA) + h * 128;
    f32x16 o[4];
    bool fast;
    { const unsigned* nw = (const unsigned*)(F.ws + WS_CTL) + 288; const int hh = h * 2 + half;
      const float qn2 = __uint_as_float(nw[hh * 2]) + __uint_as_float(nw[hh * 2 + 1]), kn2 = __uint_as_float(nw[16 + hh * 2]) + __uint_as_float(nw[16 + hh * 2 + 1]);
      float bm = 0.f; for (int b = 0; b < 32; ++b) bm = fmaxf(bm, fabsf(F.in[I_RELB][b * 4 + h] - F.in[I_RELB][15 * 4 + h]));
      const float B = sqrtf(qn2 * kn2) * 1.02f + 0.5f + bm * LOG2E;
      fast = __builtin_amdgcn_readfirstlane(B <= 60.0f ? 1 : 0) != 0; }
    if (fast) attn_pass3<1, 128, pv, true>(F, Q, K, V, qb * 256, 4 * qb + 4, nullptr, h, o); else attn_pass3<1, 128, pv, false>(F, Q, K, V, qb * 256, 4 * qb + 4, nullptr, h, o);
    if (pv != 0 && o[0][0] != 1234.5678f) { __syncthreads(); return; }
    bf16_t* OD = (bf16_t*)(F.ws + (half ? WS_OD2 : WS_OD1));
    store_o<4>(o, F.lds + F.wave * 8192, OD + (size_t)(qb * 256 + F.wave * 32) * 512 + h * 128, 512, F.lane);
    __syncthreads();
}
constexpr int PF_STR = 66, PD_STR = 130;
__device__ __forceinline__ void p_combine(Frame& F) {
    const float lam = lambda_full(F);
    const bf16_t* O1 = (const bf16_t*)(F.ws + WS_OD1); const bf16_t* O2 = (const bf16_t*)(F.ws + WS_OD2); bf16_t* AB = (bf16_t*)(F.ws + WS_AB);
    const int gw = F.bid * 8 + F.wave, NGW = F.G * 8;
    const int c0 = 8 * F.lane;
    float sg[8];
#pragma unroll
    for (int i = 0; i < 8; ++i) sg[i] = F.in[I_SUBG][(c0 & 127) + i] * 0.8f;
    for (int m = gw; m < SEQ; m += NGW) {
        const u32x4 a = *(const u32x4*)(O1 + (size_t)m * 512 + c0), b = *(const u32x4*)(O2 + (size_t)m * 512 + c0);
        float v[8];
        v[0] = bflo(a.x) - lam * bflo(b.x); v[1] = bfhi(a.x) - lam * bfhi(b.x); v[2] = bflo(a.y) - lam * bflo(b.y); v[3] = bfhi(a.y) - lam * bfhi(b.y);
        v[4] = bflo(a.z) - lam * bflo(b.z); v[5] = bfhi(a.z) - lam * bfhi(b.z); v[6] = bflo(a.w) - lam * bflo(b.w); v[7] = bfhi(a.w) - lam * bfhi(b.w);
        float ss = 0.f;
#pragma unroll
        for (int i = 0; i < 8; ++i) ss += v[i] * v[i];
#pragma unroll
        for (int ofs = 1; ofs < 16; ofs <<= 1) ss += __shfl_xor(ss, ofs);
        const float rn = 1.0f / sqrtf(ss * (1.0f / 128.0f) + LN_EPS);
        u32x4 w; w.x = pk2(v[0] * rn * sg[0], v[1] * rn * sg[1]); w.y = pk2(v[2] * rn * sg[2], v[3] * rn * sg[3]); w.z = pk2(v[4] * rn * sg[4], v[5] * rn * sg[5]); w.w = pk2(v[6] * rn * sg[6], v[7] * rn * sg[7]);
        *(u32x4*)(AB + (size_t)m * DM + c0) = w;
    }
    for (int it = gw; it < NSMP; it += NGW) {
        const int b = it >> 4, q = it & 15; const size_t row = (size_t)SEQ + it;
        {
            const int h = F.lane >> 3, cc = (F.lane & 7) * 8; const float* P = (const float*)(F.ws + WS_PF);
            float M = -1e30f;
            for (int s = 0; s < 8; ++s) M = fmaxf(M, P[((size_t)((b * 8 + s) * 8 + h) * 16 + q) * PF_STR + 64]);
            float acc[8], L = 0.f;
#pragma unroll
            for (int i = 0; i < 8; ++i) acc[i] = 0.f;
            for (int s = 0; s < 8; ++s) { const float* pr = P + ((size_t)((b * 8 + s) * 8 + h) * 16 + q) * PF_STR; const float wgt = __builtin_amdgcn_exp2f(pr[64] - M); L += wgt * pr[65];
#pragma unroll
                for (int i = 0; i < 8; ++i) acc[i] += wgt * pr[cc + i]; }
            const float inv = 1.0f / L;
            u32x4 w; w.x = pk2(acc[0] * inv, acc[1] * inv); w.y = pk2(acc[2] * inv, acc[3] * inv); w.z = pk2(acc[4] * inv, acc[5] * inv); w.w = pk2(acc[6] * inv, acc[7] * inv);
            *(u32x4*)(AB + row * DM + 512 + c0) = w; }
        {
            const int h = F.lane >> 4, cc = (F.lane & 15) * 8; const float* P = (const float*)(F.ws + WS_PD);
            float v[8];
#pragma unroll
            for (int i = 0; i < 8; ++i) v[i] = 0.f;
#pragma unroll
            for (int half = 0; half < 2; ++half) {
                float M = -1e30f;
                for (int s = 0; s < 8; ++s) M = fmaxf(M, P[((size_t)((b * 8 + s) * 8 + 2 * h + half) * 16 + q) * PD_STR + 128]);
                float acc[8], L = 0.f;
#pragma unroll
                for (int i = 0; i < 8; ++i) acc[i] = 0.f;
                for (int s = 0; s < 8; ++s) { const float* pr = P + ((size_t)((b * 8 + s) * 8 + 2 * h + half) * 16 + q) * PD_STR; const float wgt = __builtin_amdgcn_exp2f(pr[128] - M); L += wgt * pr[129];
#pragma unroll
                    for (int i = 0; i < 8; ++i) acc[i] += wgt * pr[cc + i]; }
                const float sc = (half ? -lam : 1.0f) / L;
#pragma unroll
                for (int i = 0; i < 8; ++i) v[i] += acc[i] * sc; }
            float ss = 0.f;
#pragma unroll
            for (int i = 0; i < 8; ++i) ss += v[i] * v[i];
#pragma unroll
            for (int ofs = 1; ofs < 16; ofs <<= 1) ss += __shfl_xor(ss, ofs);
            const float rn = 1.0f / sqrtf(ss * (1.0f / 128.0f) + LN_EPS);
            u32x4 w; w.x = pk2(v[0] * rn * sg[0], v[1] * rn * sg[1]); w.y = pk2(v[2] * rn * sg[2], v[3] * rn * sg[3]); w.z = pk2(v[4] * rn * sg[4], v[5] * rn * sg[5]); w.w = pk2(v[6] * rn * sg[6], v[7] * rn * sg[7]);
            *(u32x4*)(AB + row * DM + c0) = w; }
    }
}

constexpr int SM_K = 0, SM_V = 32768, SM_F = 81920, SM_WS = 83968;
template <int KIND  > __device__ __forceinline__ void sample_unit(Frame& F, int b, int s) {
    constexpr int DV = KIND == 0 ? 64 : 128, NDB = DV / 32, VSTR = KIND == 0 ? 192 : 320, VSUB = 16 * VSTR;
    const int lane = lane_id_opaque(), r32 = lane & 31, hi = lane >> 5, w = F.wave, tid = w * 64 + lane;
    const LAS char* lds = (const LAS char*)F.lds;
    LAS float* wsf = (LAS float*)(F.lds + SM_WS) + w * 64;
    const int hb = KIND == 0 ? w : (w >> 1);
    const LAS float* tab = (const LAS float*)(F.lds + AT_TAB) + hb * 192;
    const int q = r32 & 15, qpos = PAST + q;
    const size_t qrow = (size_t)SEQ + b * DEC_T + q;
    const bf16_t* Qp = (const bf16_t*)(F.ws + (KIND == 0 ? WS_QB : WS_QA)) + qrow * 512 + w * 64;
    bf16x8 qr[4];
#pragma unroll
    for (int d0 = 0; d0 < 4; ++d0) qr[d0] = *(const bf16x8*)(Qp + d0 * 16 + hi * 8);
    const float* Fs = (const float*)(F.ws + WS_FS) + (size_t)(b * 8 + w) * SKV;
    const float fq = KIND == 0 ? Fs[qpos] : 0.f;
    const float* Kc = F.in[KIND == 0 ? I_CFK : I_CDK] + (size_t)b * PAST * 512; const float* Vc = F.in[KIND == 0 ? I_CFV : I_CDV] + (size_t)b * PAST * 512;
    const float* Kn = F.out + (KIND == 0 ? O_FKS : O_DKS) + (size_t)b * DEC_T * 512; const float* Vn = F.out + (KIND == 0 ? O_FVS : O_DVS) + (size_t)b * DEC_T * 512;
    const int kr = tid >> 5, c16 = (tid & 31) * 16;
    const int ksub = c16 >> 6, kch = (c16 >> 3) & 7;
    const int kdst = SM_K + ksub * 4096 + kr * 128;
    const int vdst = KIND == 0 ? SM_V + ksub * VSUB + kr * VSTR + kch * 16 : SM_V + (c16 >> 7) * VSUB + kr * VSTR + ((c16 >> 3) & 15) * 16;
    f32x16 o[NDB];
#pragma unroll
    for (int d = 0; d < NDB; ++d) o[d] = f32x16{};
    float m_run = -1e30f, l_run = 0.f;
    f32x4 gkA[4], gvA[4], gkB[4], gvB[4]; float gfA = 0.f, gfB = 0.f;
    const int nt = s == 0 ? 17 : 16;
    auto gload = [&](f32x4 (&gk)[4], f32x4 (&gv)[4], float& gf, int t) {
        const float* ks; const float* vs;
        if (t < 128) { ks = Kc + (size_t)(16 * t + kr) * 512 + c16; vs = Vc + (size_t)(16 * t + kr) * 512 + c16; }
        else { ks = Kn + (size_t)kr * 512 + c16; vs = Vn + (size_t)kr * 512 + c16; }
#pragma unroll
        for (int j = 0; j < 4; ++j) { gk[j] = *(const f32x4*)(ks + 4 * j); gv[j] = *(const f32x4*)(vs + 4 * j); }
        if (KIND == 0 && tid < 128) gf = ((const float*)(F.ws + WS_FS))[(size_t)(b * 8 + (tid >> 4)) * SKV + 16 * t + (tid & 15)];
    };
    auto lwrite = [&](const f32x4 (&gk)[4], const f32x4 (&gv)[4], float gf) {
#pragma unroll
        for (int j = 0; j < 2; ++j) { u32x4 wk, wv;
            wk.x = pk2(gk[2 * j][0], gk[2 * j][1]); wk.y = pk2(gk[2 * j][2], gk[2 * j][3]); wk.z = pk2(gk[2 * j + 1][0], gk[2 * j + 1][1]); wk.w = pk2(gk[2 * j + 1][2], gk[2 * j + 1][3]);
            wv.x = pk2(gv[2 * j][0], gv[2 * j][1]); wv.y = pk2(gv[2 * j][2], gv[2 * j][3]); wv.z = pk2(gv[2 * j + 1][0], gv[2 * j + 1][1]); wv.w = pk2(gv[2 * j + 1][2], gv[2 * j + 1][3]);
            *(LAS u32x4*)(F.lds + kdst + (((kch + j) ^ (kr & 7)) << 4)) = wk;
            *(LAS u32x4*)(F.lds + vdst + j * 16) = wv; }
        if (KIND == 0 && tid < 128) ((LAS float*)(F.lds + SM_F))[tid] = gf;
    };
    gload(gkA, gvA, gfA, s); gload(gkB, gvB, gfB, s + 8);
    __syncthreads();
    { const int sub = tid >> 6, rr = 16 + ((tid >> 2) & 15), cq = (tid & 3) * 32;
      *(LAS u32x4*)(F.lds + SM_K + sub * 4096 + rr * 128 + cq) = (u32x4){0u, 0u, 0u, 0u}; *(LAS u32x4*)(F.lds + SM_K + sub * 4096 + rr * 128 + cq + 16) = (u32x4){0u, 0u, 0u, 0u}; }
    const int vb = SM_V + (KIND == 0 ? w : (w >> 1)) * VSUB + (4 * hi + ((lane & 15) >> 2)) * VSTR + (((lane >> 4) & 1) * 16 + (lane & 3) * 4) * 2;
    auto compute = [&](int t) {
        f32x16 p0 = f32x16{};
#pragma unroll
        for (int d0 = 0; d0 < 4; ++d0) { const bf16x8 kf = *(const LAS bf16x8*)(lds + SM_K + w * 4096 + r32 * 128 + (((2 * d0 + hi) ^ (r32 & 7)) << 4));
            p0 = __builtin_amdgcn_mfma_f32_32x32x16_bf16(kf, qr[d0], p0, 0, 0, 0); }
        const int kv0 = 16 * t + 4 * hi;
        float x[8];
        if (KIND == 0) {
#pragma unroll
            for (int g4 = 0; g4 < 2; ++g4) { const f32x4 fa = *(const LAS f32x4*)(lds + SM_F + (w * 16 + 4 * hi + 8 * g4) * 4);
#pragma unroll
                for (int e = 0; e < 4; ++e) x[4 * g4 + e] = p0[4 * g4 + e] + (fq - fa[e]); }
            if (t == 128) {
#pragma unroll
                for (int r = 0; r < 8; ++r) { const int kv = kv0 + (r & 3) + 8 * (r >> 2); if (kv > qpos) x[r] = -1e30f; } }
        } else {
            if (t < 120) {
#pragma unroll
                for (int r = 0; r < 8; ++r) x[r] = p0[r];
            } else {
#pragma unroll
                for (int r = 0; r < 8; ++r) { const int kv = kv0 + (r & 3) + 8 * (r >> 2); int i0 = kv - qpos + 128; i0 = i0 < 0 ? 0 : i0; x[r] = p0[r] + tab[i0]; } }
        }
        float rm = x[0];
#pragma unroll
        for (int r = 1; r < 8; ++r) rm = fmaxf(rm, x[r]);
        rm = fmaxf(rm, __shfl_xor(rm, 32));
        const float m_new = fmaxf(m_run, rm);
        if (__any(m_new > m_run)) { const float al = __builtin_amdgcn_exp2f(m_run - m_new); l_run *= al; m_run = m_new;
            if (hi == 0) wsf[r32] = al;
            asm volatile("s_waitcnt lgkmcnt(0)" ::: "memory");
#pragma unroll
            for (int g4 = 0; g4 < 2; ++g4) { const f32x4 a4 = *(const LAS f32x4*)(wsf + 8 * g4 + 4 * hi);
#pragma unroll
                for (int d = 0; d < NDB; ++d)
#pragma unroll
                    for (int e = 0; e < 4; ++e) o[d][4 * g4 + e] *= a4[e]; } }
        float rs = 0.f;
#pragma unroll
        for (int r = 0; r < 8; ++r) { x[r] = __builtin_amdgcn_exp2f(x[r] - m_run); rs += x[r]; }
        l_run += rs;
        u32x4 w0; w0.x = pg8::cvt_pk_bf16(x[0], x[1]); w0.y = pg8::cvt_pk_bf16(x[2], x[3]); w0.z = pg8::cvt_pk_bf16(x[4], x[5]); w0.w = pg8::cvt_pk_bf16(x[6], x[7]);
        const bf16x8 pa = __builtin_bit_cast(bf16x8, w0);
#pragma unroll
        for (int d = 0; d < NDB; ++d) { const LAS char* vp = lds + vb + d * 64;
            const s16x4 lo = vtr(vp), hi4 = vtr(vp + 8 * VSTR);
            const bf16x8 vf = (bf16x8){lo[0], lo[1], lo[2], lo[3], hi4[0], hi4[1], hi4[2], hi4[3]};
            o[d] = __builtin_amdgcn_mfma_f32_32x32x16_bf16(pa, vf, o[d], 0, 0, 0); }
    };
    for (int i = 0; i < nt; i += 2) {
        const int t = s + 8 * i;
        lwrite(gkA, gvA, gfA); __syncthreads();
        if (i + 2 < nt) gload(gkA, gvA, gfA, t + 16);
        compute(t);
        __syncthreads();
        if (i + 1 >= nt) break;
        lwrite(gkB, gvB, gfB); __syncthreads();
        if (i + 3 < nt) gload(gkB, gvB, gfB, t + 24);
        compute(t + 8);
        __syncthreads();
    }
    l_run += __shfl_xor(l_run, 32);
    float* P = (float*)(F.ws + (KIND == 0 ? WS_PF : WS_PD)) + ((size_t)((b * 8 + s) * 8 + w) * 16) * (DV + 2);
    { float* P0 = P + (size_t)(4 * hi) * (DV + 2) + r32; float* P1 = P0 + 8 * (DV + 2);
#pragma unroll
      for (int d = 0; d < NDB; ++d)
#pragma unroll
          for (int r = 0; r < 4; ++r) { P0[r * (DV + 2) + 32 * d] = o[d][r]; P1[r * (DV + 2) + 32 * d] = o[d][4 + r]; } }
    if (lane < 16) { P[(size_t)lane * (DV + 2) + DV] = m_run; P[(size_t)lane * (DV + 2) + DV + 1] = l_run; }
}

template <int pv = 0> __device__ __forceinline__ void p3_attention(Frame& F, int mask) {
    LAS float* tab = (LAS float*)(F.lds + AT_TAB);
    for (int i = F.tid; i < 4 * 192; i += 512) { const int h = i / 192, rel = (i % 192) - 128; tab[i] = (F.in[I_RELB][t5_bucket(rel) * 4 + h] - F.in[I_RELB][15 * 4 + h]) * LOG2E; }
    const float lam = lambda_full(F);
    __syncthreads();
    const int x = F.bid & 7, p = (F.bid >> 3) & 31;
    const int spos = F.G == 256 ? (x + p) % 5 : 4;
    for (int j = 0; j < 5; ++j) {
        F.lane = lane_id_opaque(); F.tid = F.wave * 64 + F.lane;
        if (j == spos) {
            if (mask & 4) {
                for (int u = F.bid; u < 256; u += F.G) {
                    F.lane = lane_id_opaque(); F.tid = F.wave * 64 + F.lane;
                    if ((u >> 3) & 1) sample_unit<1>(F, u >> 4, u & 7); else sample_unit<0>(F, u >> 4, u & 7);
                }
            }
        } else if (F.bid < 256) {
            const int i = j - (j > spos ? 1 : 0);
            const int qb = (i & 1) ? p : 63 - p;
            if (i < 2) { if (mask & 1) attn_prompt_diff_half<pv>(F, x >> 1, x & 1, qb); }
            else { if (mask & 2) attn_prompt_fox<pv>(F, x, qb); }
        }
    }
}

__device__ __forceinline__ void slab_publish(Frame& F, int word, int nun) {
    int n = 0; for (int L = F.bid; L < nun; L += F.G) ++n;
    asm volatile("s_waitcnt vmcnt(0)" ::: "memory");
    __syncthreads();
    if (F.tid == 0 && n > 0) { __builtin_amdgcn_fence(__ATOMIC_RELEASE, "agent"); asm volatile("s_waitcnt vmcnt(0)" ::: "memory");
        __hip_atomic_fetch_add((unsigned*)(F.ws + WS_CTL) + word, (unsigned)n, __ATOMIC_RELAXED, __HIP_MEMORY_SCOPE_AGENT); }
}
__device__ __forceinline__ void slab_wait(Frame& F, int word, int nun) {
    if (F.tid == 0) { unsigned* w = (unsigned*)(F.ws + WS_CTL) + word; unsigned sp = 0;
        while (__hip_atomic_load(w, __ATOMIC_RELAXED, __HIP_MEMORY_SCOPE_AGENT) < (unsigned)nun && ++sp < (1u << 22)) __builtin_amdgcn_s_sleep(2);
        __builtin_amdgcn_fence(__ATOMIC_ACQUIRE, "agent"); asm volatile("s_waitcnt vmcnt(0)" ::: "memory"); }
    __syncthreads();
}

#define XB_TMO      128
#define XB_XCNT(j)  (256  + 64 * (j))
#define XB_XSUB(j)  (1280 + 64 * (j))
#define XB_XGEN(j)  (2304 + 64 * (j))
#define XB_TOP      3328
#define XB_TOPGEN   3392
#define XCD_BAR_WORDS 3456
#define XB_SPIN_CAP (1u << 20)
__device__ __forceinline__ unsigned xb_ld(unsigned* p)              { return __hip_atomic_load(p, __ATOMIC_RELAXED, __HIP_MEMORY_SCOPE_AGENT); }
__device__ __forceinline__ unsigned xb_add(unsigned* p, unsigned v) { return __hip_atomic_fetch_add(p, v, __ATOMIC_RELAXED, __HIP_MEMORY_SCOPE_AGENT); }
__device__ __forceinline__ unsigned xb_xcc_id() { return (unsigned)__builtin_amdgcn_s_getreg((3 << 11) | 20) & 0xFu; }
#define XB_SPIN(cond, bar) do { unsigned _sp = 0; while (cond) { __builtin_amdgcn_s_sleep(1); \
    if ((++_sp & 255u) == 0u) { if (xb_ld(&(bar)[XB_TMO])) break; if (_sp > XB_SPIN_CAP) { atomicAdd(&(bar)[XB_TMO], 1u); break; } } } } while (0)
struct XcdBarrier { unsigned* bar; unsigned x; volatile LAS unsigned* st; };
__device__ __forceinline__ XcdBarrier xcd_barrier_post(unsigned* bar, volatile LAS unsigned* st) {
    XcdBarrier b; b.bar = bar; b.x = xb_xcc_id(); b.st = st;
    if (threadIdx.x == 0) (void)xb_add(&bar[XB_XCNT(b.x)], 1u);
    return b;
}
__device__ __forceinline__ void xcd_barrier_complete(unsigned* bar, unsigned x, unsigned& nloc, unsigned& nx) {
    const unsigned G = gridDim.x * gridDim.y * gridDim.z;
    unsigned sum, cnt, mine, sp = 0u;
    for (;;) {
        sum = 0u; cnt = 0u; mine = 0u;
#pragma unroll
        for (unsigned j = 0; j < 16; ++j) { const unsigned c = xb_ld(&bar[XB_XCNT(j)]); sum += c; cnt += (c > 0u) ? 1u : 0u; mine = (j == x) ? c : mine; }
        if (sum == G) break;
        __builtin_amdgcn_s_sleep(1);
        if ((++sp & 255u) == 0u) { if (xb_ld(&bar[XB_TMO])) break; if (sp > XB_SPIN_CAP) { atomicAdd(&bar[XB_TMO], 1u); break; } }
    }
    nloc = mine > 0u ? mine : 1u; nx = cnt > 0u ? cnt : 1u;
}
__device__ __forceinline__ void xcd_barrier(const XcdBarrier& b) {
    asm volatile("s_waitcnt vmcnt(0)" ::: "memory");
    __syncthreads();
    if (threadIdx.x == 0) {
        unsigned* bar = b.bar;
        __builtin_amdgcn_s_waitcnt(0);
        unsigned nloc = b.st[0], nx = b.st[1];
        if (nloc == 0u) { xcd_barrier_complete(bar, b.x, nloc, nx); b.st[0] = nloc; b.st[1] = nx; }
        const unsigned old = xb_add(&bar[XB_XSUB(b.x)], 1u);
        const unsigned gen = old / nloc;
        if (old + 1u == (gen + 1u) * nloc) {
            __builtin_amdgcn_fence(__ATOMIC_RELEASE, "agent");
            asm volatile("s_waitcnt vmcnt(0)" ::: "memory");
            const unsigned og = xb_add(&bar[XB_TOP], 1u);
            const unsigned tg = og / nx;
            if (og + 1u == (tg + 1u) * nx) xb_add(&bar[XB_TOPGEN], 1u);
            else XB_SPIN(xb_ld(&bar[XB_TOPGEN]) == tg, bar);
            __builtin_amdgcn_fence(__ATOMIC_ACQUIRE, "agent");
            xb_add(&bar[XB_XGEN(b.x)], 1u);
            asm volatile("s_waitcnt vmcnt(0)" ::: "memory");
        } else {
            XB_SPIN(xb_ld(&bar[XB_XGEN(b.x)]) == gen, bar);
            __builtin_amdgcn_fence(__ATOMIC_ACQUIRE, "agent");
            asm volatile("s_waitcnt vmcnt(0)" ::: "memory");
        }
    }
    __syncthreads();
}

__global__ void __launch_bounds__(512, 2) mega_fwd(Args args) {
    extern __shared__ __attribute__((aligned(16))) unsigned char lds_raw[];
    Frame F;
    F.lds = (LAS unsigned char*)lds_raw; F.ldsg = lds_raw;
    F.tid = threadIdx.x; F.lane = F.tid & 63; F.wave = __builtin_amdgcn_readfirstlane(F.tid >> 6);
    F.G = gridDim.x; F.bid = blockIdx.x;
    F.in = args.in; F.out = args.out; F.ws = args.ws;
    const int lo = args.ph_lo, hi = args.ph_hi;
    cg::grid_group grid = cg::this_grid();
    const bool fused = (hi - lo) > 1;
    volatile LAS unsigned* bst = (volatile LAS unsigned*)(F.lds + AT_MISC + 16);
    if (F.tid == 0) { bst[0] = 0u; bst[1] = 0u; }
    __syncthreads();
    XcdBarrier xbar; xbar.bar = (unsigned*)(F.ws + WS_CTL) + 1024; xbar.x = 0; xbar.st = bst;
    if (fused) xbar = xcd_barrier_post((unsigned*)(F.ws + WS_CTL) + 1024, bst);
#define IN(k) (lo <= (k) && (k) < hi)
#define PB() do { F.lane = lane_id_opaque(); F.tid = F.wave * 64 + F.lane; } while (0)
#define SEAM(k) do { if (IN(k) && IN((k) + 1)) { xcd_barrier(xbar); } } while (0)
    const float* mod = (const float*)(F.ws + WS_MOD);
    if (IN(0)) { PB(); p0_prologue(F); }
    if (IN(0) && IN(1)) __syncthreads(); else SEAM(0);
    if (IN(1)) { PB(); p1_rows(F, IN(0)); } SEAM(1);
    if (IN(2)) { PB();
        p2_cumsum(F);
        __syncthreads();
        pg8::Gemm g{(const bf16_t*)(F.ws + WS_XN), (const bf16_t*)(F.ws + WS_WIN), 1024, 1024, 1024, 1 << 30, 0, 0};
        pg8::StaticOrder S; S.init(MT / 256, NZ / 256, F.G, F.bid, 0);
        EpiZ E{F.out, F.ws};
        pg8::gemm_phase<EpiZ, pg8::StaticOrder>(F.lds, g, S, E, F.wave);
#if PROBE_DUP == 2
        pg8::gemm_phase<EpiZ, pg8::StaticOrder>(F.lds, g, S, E, F.wave);
#endif
        { const int nun = (MT / 256) * (NZ / 256), nlong = nun - (nun / F.G) * F.G;
          if (nlong > 0 && nlong < F.G) { if (F.bid >= nlong) { PB(); weight_copies(F, F.bid - nlong, F.G - nlong, WC_IN, WC_ALL); } }
          else { PB(); weight_copies(F, F.bid, F.G, WC_IN, WC_ALL); } }
    } SEAM(2);
    if (IN(3)) { PB(); p3_attention(F, 7);
#if PROBE_DUP == 3
        p3_attention<PROBE_PV>(F, PROBE_MASK);
#endif
    } SEAM(3);
    if (IN(10)) { PB(); p_combine(F);
#if PROBE_DUP == 10
        p_combine(F);
#endif
    } if (IN(10) && IN(4)) xcd_barrier(xbar);
    if (IN(4)) { PB();
        pg8::Gemm g{(const bf16_t*)(F.ws + WS_AB), (const bf16_t*)(F.ws + WS_WAB), 1024, 512, 512, 4, 512, 0};
        pg8::StaticOrder S; S.init(MT / 256, 8, F.G, F.bid, 0);
        EpiGate E{(bf16_t*)(F.ws + WS_G), (bf16_t*)(F.ws + WS_G)};
#if PROBE_DUP == 4
        { EpiGate E2{(bf16_t*)(F.ws + WS_G), (bf16_t*)(F.ws + WS_QA)}; pg8::gemm_phase<EpiGate, pg8::StaticOrder>(F.lds, g, S, E2, F.wave); }
#endif
        pg8::gemm_phase<EpiGate, pg8::StaticOrder>(F.lds, g, S, E, F.wave);
    } SEAM(4);
    if (IN(5)) { PB();
        { pg8::Gemm g2{(const bf16_t*)(F.ws + WS_G), (const bf16_t*)(F.ws + WS_WO2), 2048, 2048, 256, 1 << 30, 0, 256};
          pg8::SplitOrder S2; S2.init(4, 8, F.G, F.bid, SEQ / 256); EpiSlab E2{(float*)(F.ws + WS_SLAB)};
          pg8::gemm_phase<EpiSlab, pg8::SplitOrder>(F.lds, g2, S2, E2, F.wave); slab_publish(F, 322, 32); }
        pg8::Gemm g{(const bf16_t*)(F.ws + WS_G), (const bf16_t*)(F.ws + WS_WO2), 2048, 2048, 2048, 1 << 30, 0, 0};
        pg8::StaticOrder S; S.init(SEQ / 256, 4, F.G, F.bid, 0);
        EpiResLn<false> E{(const void*)F.in[I_XP], mod + 2048, F.in[I_LN1G], F.in[I_LN1B], mod, (bf16_t*)(F.ws + WS_X1B), (bf16_t*)(F.ws + WS_XN), nullptr,
                          PanelStats{(unsigned*)(F.ws + WS_XB1), (unsigned*)(F.ws + WS_CTL) + CTL_LN1, LN_EPS}, F.lds};
        pg8::gemm_phase<EpiResLn<false>, pg8::StaticOrder>(F.lds, g, S, E, F.wave);
        PB(); slab_wait(F, 322, 32); ln_rows<false>(F, F.in[I_LN1G], F.in[I_LN1B], 8, 2048);
    } if (IN(5) && IN(7)) xcd_barrier(xbar);

    if (IN(7)) { PB();
        pg8::Gemm g{(const bf16_t*)(F.ws + WS_XN), (const bf16_t*)(F.ws + WS_WFI), 1024, 1024, 1024, 1 << 30, 0, 0};
        pg8::StaticOrder S; S.init(MT / 256, NFF2 / 256, F.G, F.bid, 0);
        EpiFfn E{(bf16_t*)(F.ws + WS_ACT)};
        pg8::gemm_phase<EpiFfn, pg8::StaticOrder>(F.lds, g, S, E, F.wave);
#if PROBE_DUP == 7
        pg8::gemm_phase<EpiFfn, pg8::StaticOrder>(F.lds, g, S, E, F.wave);
#endif
    } SEAM(7);
    if (IN(8)) { PB();
        { pg8::Gemm g2{(const bf16_t*)(F.ws + WS_ACT), (const bf16_t*)(F.ws + WS_WFO), DFF, DFF, 256, 1 << 30, 0, 256};
          pg8::SplitOrder S2; S2.init(4, 11, F.G, F.bid, SEQ / 256); EpiSlab E2{(float*)(F.ws + WS_SLAB)};
          pg8::gemm_phase<EpiSlab, pg8::SplitOrder>(F.lds, g2, S2, E2, F.wave); slab_publish(F, 323, 44); }
        pg8::Gemm g{(const bf16_t*)(F.ws + WS_ACT), (const bf16_t*)(F.ws + WS_WFO), DFF, DFF, DFF, 1 << 30, 0, 0};
        pg8::StaticOrder S; S.init(SEQ / 256, 4, F.G, F.bid, 0);
        EpiResLn<true> E{(const void*)(F.ws + WS_X1B), mod + 5120, F.in[I_LN2G], F.in[I_LN2B], mod, nullptr, nullptr, F.out,
                         PanelStats{(unsigned*)(F.ws + WS_XB2), (unsigned*)(F.ws + WS_CTL) + CTL_LN2, LN_EPS}, F.lds};
        pg8::gemm_phase<EpiResLn<true>, pg8::StaticOrder>(F.lds, g, S, E, F.wave);
        PB(); slab_wait(F, 323, 44); ln_rows<true>(F, F.in[I_LN2G], F.in[I_LN2B], 11, 5120);
    }
#undef IN
#undef SEAM
}

extern "C" void kernel_launch(void* const* d_in, const int* in_sizes, int n_in, void* d_out, int out_size, void* d_ws, size_t ws_size, hipStream_t stream) {
    static int grid = 0;
    if (grid == 0) {
        if (n_in != 28 || (size_t)out_size != O_END || ws_size < WS_END) { fprintf(stderr, "kernel_launch: unexpected shapes (n_in %d out %d ws %zu)\n", n_in, out_size, ws_size); grid = -1; return; }
        int dev = 0, cus = 0, per_cu = 0;
        hipGetDevice(&dev); hipDeviceGetAttribute(&cus, hipDeviceAttributeMultiprocessorCount, dev);
        hipFuncSetAttribute((const void*)mega_fwd, hipFuncAttributeMaxDynamicSharedMemorySize, LDS_BYTES);
        hipOccupancyMaxActiveBlocksPerMultiprocessor(&per_cu, (const void*)mega_fwd, 512, LDS_BYTES);
        if (per_cu < 1) { fprintf(stderr, "kernel_launch: occupancy query says %d blocks per CU\n", per_cu); per_cu = 1; }
        (void)hipGetLastError();
        grid = cus;
    }
    if (grid < 0) return;
    hipMemsetAsync((char*)d_ws + WS_CTL, 0, CTL_BYTES, stream);
    Args a{};
    for (int i = 0; i < 28; ++i) a.in[i] = (const float*)d_in[i];
    a.out = (float*)d_out; a.ws = (unsigned char*)d_ws;
#if MK_N_LAUNCHES == 1
    a.ph_lo = 0; a.ph_hi = NPH;
    void* kargs[] = {&a};
    hipError_t e = hipLaunchCooperativeKernel((const void*)mega_fwd, dim3(grid), dim3(512), kargs, LDS_BYTES, stream);
    if (e != hipSuccess) fprintf(stderr, "cooperative launch failed: %s\n", hipGetErrorString(e));
#else
    { const int seq[NPH] = {0, 1, 2, 3, 10, 4, 5, 6, 7, 8, 9}; for (int i = 0; i < NPH; ++i) { a.ph_lo = seq[i]; a.ph_hi = seq[i] + 1; hipLaunchKernelGGL(mega_fwd, dim3(grid), dim3(512), LDS_BYTES, stream, a); } }
#endif
}
```

```cpp
#include <hip/hip_runtime.h>
#include <hip/hip_cooperative_groups.h>
#include <cstdint>
#include <cstdio>
namespace cg = cooperative_groups;

#ifndef PROBE_DUP
#define PROBE_DUP -1
#endif
#ifndef PROBE_PV
#define PROBE_PV 0
#endif
#ifndef PROBE_MASK
#define PROBE_MASK 7
#endif
#ifndef MK_N_LAUNCHES
#define MK_N_LAUNCHES 1
#endif

#define LAS __attribute__((address_space(3)))
typedef unsigned short bf16_t;
typedef short bf16x8 __attribute__((ext_vector_type(8)));
typedef short s16x4 __attribute__((ext_vector_type(4)));
typedef float f32x4 __attribute__((ext_vector_type(4)));
typedef float f32x2 __attribute__((ext_vector_type(2)));
typedef float f32x16 __attribute__((ext_vector_type(16)));
typedef unsigned u32x4 __attribute__((ext_vector_type(4)));
typedef unsigned u32x2 __attribute__((ext_vector_type(2)));

constexpr int DM = 1024, SEQ = 16384, DEC_B = 16, DEC_T = 16, NSMP = DEC_B * DEC_T, MT = SEQ + NSMP, PAST = 2048, SKV = PAST + DEC_T;
constexpr int NZ = 5120, DFF = 2816, NFF2 = 2 * DFF, WIN_COLS = 5128;
constexpr float LOG2E = 1.4426950408889634f, C2 = 0.125f * LOG2E, ALPHA = 1.189207115002721f, LN_EPS = 1e-5f;
constexpr int NPH = 11;

constexpr size_t O_Y = 0, O_DKP = (size_t)MT * DM, O_DVP = O_DKP + (size_t)SEQ * 512, O_FKP = O_DVP + (size_t)SEQ * 512, O_FVP = O_FKP + (size_t)SEQ * 512,
                 O_FLP = O_FVP + (size_t)SEQ * 512, O_DKS = O_FLP + (size_t)SEQ * 8, O_DVS = O_DKS + (size_t)NSMP * 512, O_FKS = O_DVS + (size_t)NSMP * 512,
                 O_FVS = O_FKS + (size_t)NSMP * 512, O_FLS = O_FVS + (size_t)NSMP * 512, O_END = O_FLS + (size_t)NSMP * 8;

constexpr size_t MiB = 1u << 20;
constexpr size_t WS_CTL = 0, CTL_BYTES = 64 * 1024;
constexpr size_t WS_MOD = 1 * MiB;
constexpr size_t WS_FP = 2 * MiB;
constexpr size_t WS_FS = 3 * MiB;
constexpr size_t WS_WIN = 8 * MiB;
constexpr size_t WS_WAB = 18 * MiB;
constexpr size_t WS_WO2 = 20 * MiB;
constexpr size_t WS_WFI = 24 * MiB;
constexpr size_t WS_WFO = 35 * MiB;
constexpr size_t WS_XN = 48 * MiB;
constexpr size_t WS_QA = 84 * MiB, WS_KA = 101 * MiB, WS_VA = 118 * MiB, WS_QB = 135 * MiB, WS_KB = 152 * MiB, WS_VB = 169 * MiB;
constexpr size_t WS_ACT = 84 * MiB;
constexpr size_t WS_G = 188 * MiB;
constexpr size_t WS_AB = 254 * MiB;
constexpr size_t WS_OD1 = WS_XN, WS_OD2 = 288 * MiB;
constexpr size_t WS_PF = 304 * MiB, WS_PD = 309 * MiB;
constexpr size_t WS_TB = WS_AB;
constexpr size_t WS_X1B = WS_AB;
constexpr size_t WS_XB1 = 5 * MiB, WS_XB2 = 6 * MiB;
constexpr int CTL_LN1 = 8192, CTL_LN2 = 12288;
constexpr int LN_LDS = 135168;
constexpr size_t WS_SLAB = 288 * MiB;
constexpr size_t WS_END = 320 * MiB;

constexpr int LDS_BYTES = 147456;

struct Args { const float* in[28]; float* out; unsigned char* ws; int ph_lo, ph_hi; };

__device__ __forceinline__ int lane_id_opaque() { int l = (int)__builtin_amdgcn_mbcnt_hi(~0u, __builtin_amdgcn_mbcnt_lo(~0u, 0u)); asm volatile("" : "+v"(l)); return l; }
__device__ __forceinline__ unsigned f2bf(float f) { unsigned u = __builtin_bit_cast(unsigned, f); return (u + 0x7fffu + ((u >> 16) & 1u)) >> 16; }
__device__ __forceinline__ unsigned pk2(float lo, float hi) { return f2bf(lo) | (f2bf(hi) << 16); }
__device__ __forceinline__ float bf2f(unsigned short b) { return __builtin_bit_cast(float, (unsigned)b << 16); }
__device__ __forceinline__ float bflo(unsigned w) { return __builtin_bit_cast(float, w << 16); }
__device__ __forceinline__ float bfhi(unsigned w) { return __builtin_bit_cast(float, w & 0xffff0000u); }
__device__ __forceinline__ float wave_sum(float v) {
#pragma unroll
    for (int o = 1; o < 64; o <<= 1) v += __shfl_xor(v, o);
    return v;
}
__device__ __forceinline__ float sigmoidf_(float x) { return 1.0f / (1.0f + __expf(-x)); }
__device__ __forceinline__ float siluf_(float x) { return x / (1.0f + __expf(-x)); }

namespace pg8 {
constexpr int BM = 256, BK = 64, HALF = 128, HTB = HALF * BK * 2, STAGE_BYTES = 8 * HTB, NXCD = 8, WGM = 8;
__host__ __device__ __forceinline__ int lds_byte(int r, int c) { const int st = (r >> 4) * 2 + (c >> 5), rr = r & 15, cc = c & 31, ob = rr * 64 + cc * 2; return st * 1024 + (ob ^ (((ob >> 9) & 1) << 5)); }
__host__ __device__ __forceinline__ void stage_rc(int b, int& R, int& C) { const int st = b / 1024, sb = b % 1024, swz = sb ^ (((sb >> 9) & 1) << 5); R = (st >> 1) * 16 + swz / 64; C = (st & 1) * 32 + (swz % 64) / 2; }
__host__ __device__ __forceinline__ int perm32(int rho) { const int n = rho >> 4, i = rho & 15; return 8 * (i >> 2) + 4 * n + (i & 3); }

struct Unit { int pm, pn, ks; };
struct Gemm { const bf16_t* A; const bf16_t* Bt; int lda, ldb, K, a_split_pn, a_split_off, kpart; };

struct StaticOrder {
    int nM, nN, nwg, G, c, pm0;
    __device__ void init(int nM_, int nN_, int G_, int c_, int pm0_) { nM = nM_; nN = nN_; nwg = nM * nN; G = G_; c = c_; pm0 = pm0_; }
    __device__ bool next(int i, Unit& u) const {
        const long L = (long)i * G + c; if (L >= nwg) return false;
        int wgid = (int)L; { const int q = nwg / NXCD, r = nwg % NXCD, xcd = wgid % NXCD, off = wgid / NXCD; wgid = (xcd < r ? xcd * (q + 1) : r * (q + 1) + (xcd - r) * q) + off; }
        const int nig = WGM * nN, gid = wgid / nig, fm = gid * WGM, gsz = (nM - fm) < WGM ? (nM - fm) : WGM;
        u.pm = pm0 + fm + ((wgid % nig) % gsz); u.pn = (wgid % nig) / gsz; u.ks = 0; return true;
    }
};

struct SplitOrder {
    int nN, nun, G, c, pm;
    __device__ void init(int nN_, int KS_, int G_, int c_, int pm_) { nN = nN_; nun = nN_ * KS_; G = G_; c = c_; pm = pm_; }
    __device__ bool next(int i, Unit& u) const { const long L = (long)i * G + c; if (L >= nun) return false; u.pm = pm; u.pn = (int)L % nN; u.ks = (int)L / nN; return true; }
};

__device__ __forceinline__ unsigned cvt_pk_bf16(float lo, float hi) { unsigned r; asm volatile("v_cvt_pk_bf16_f32 %0, %1, %2" : "=v"(r) : "v"(lo), "v"(hi)); return r; }

template <class Epi, class Sched, bool ALIGN_EPI = true, bool SP2 = true>
__device__ __forceinline__ void gemm_phase(LAS unsigned char* lds, const Gemm g, const Sched& S, const Epi& E, int wid  ) {
    const int lane = lane_id_opaque(), tid = wid * 64 + lane, wr = wid >> 2, wc = wid & 3; int fr = lane & 15, fq = lane >> 4;
    const int K = g.K, nt = K / BK;
    unsigned voffA[2], voffB[2];
#pragma unroll
    for (int i = 0; i < 2; ++i) { int R, C; stage_rc(tid * 16 + i * 8192, R, C); const int Rb = Epi::PERM ? ((R & ~31) + perm32(R & 31)) : R;
        voffA[i] = (unsigned)(R * g.lda + C) * 2u; voffB[i] = (unsigned)(Rb * g.ldb + C) * 2u; }
    const size_t kstep = (size_t)(BK * 2);
    const size_t hstepA = (size_t)HALF * g.lda * 2, hstepB = (size_t)HALF * g.ldb * 2;
    const size_t tstepA = 2 * hstepA, tstepB = 2 * hstepB;
    const unsigned ldsw = (unsigned)wid * 1024u;
    const int aoff = lds_byte(wr * 64 + fr, fq * 8), boff = lds_byte(wc * 32 + fr, fq * 8);
#define PG8_SA(b, h) (((b) * 2 + (h)) * HTB)
#define PG8_SB(b, h) ((4 + (b) * 2 + (h)) * HTB)
#define PG8_STAGE(bufoff, gbase, voff) do { _Pragma("unroll") for (int _i = 0; _i < 2; ++_i) \
        __builtin_amdgcn_global_load_lds((const unsigned*)((const char*)(gbase) + (voff)[_i]), (LAS unsigned*)(lds + (bufoff) + ldsw + _i * 8192), 16, 0, 0); } while (0)
#define PG8_LDA(dst, b, h) do { _Pragma("unroll") for (int m = 0; m < 4; ++m) _Pragma("unroll") for (int k = 0; k < 2; ++k) dst[m][k] = *(const LAS bf16x8*)(lds + PG8_SA(b, h) + aoff + m * 2048 + k * 1024); } while (0)
#define PG8_LDB(dst, b, h) do { _Pragma("unroll") for (int n = 0; n < 2; ++n) _Pragma("unroll") for (int k = 0; k < 2; ++k) dst[n][k] = *(const LAS bf16x8*)(lds + PG8_SB(b, h) + boff + n * 2048 + k * 1024); } while (0)
#define PG8_MMA(ai, bj, At, Bt) do { __builtin_amdgcn_s_setprio(1); _Pragma("unroll") for (int m = 0; m < 4; ++m) _Pragma("unroll") for (int n = 0; n < 2; ++n) _Pragma("unroll") for (int k = 0; k < 2; ++k) \
        acc[ai][bj][m][n] = __builtin_amdgcn_mfma_f32_16x16x32_bf16(Bt[n][k], At[m][k], acc[ai][bj][m][n], 0, 0, 0); __builtin_amdgcn_s_setprio(0); } while (0)
#define PG8_WAIT_V(n) asm volatile("s_waitcnt vmcnt(" #n ")" ::: "memory")
#define PG8_WAIT_L(n) asm volatile("s_waitcnt lgkmcnt(" #n ")" ::: "memory")
#define PG8_BAR __builtin_amdgcn_s_barrier()
#define PG8_SCHED __builtin_amdgcn_sched_barrier(0)
#define PG8_ABASE(u) ((const char*)g.A + (size_t)(u).pm * tstepA + ((u).pn >= g.a_split_pn ? (size_t)g.a_split_off * 2 : (size_t)0) + (size_t)(u).ks * g.kpart * 2)
#define PG8_BBASE(u) ((const char*)g.Bt + (size_t)(u).pn * tstepB + (size_t)(u).ks * g.kpart * 2)
    Unit cur, nxt; int ui = 0;
    if (!S.next(0, cur)) return;
    f32x4 acc[2][2][4][2];
#pragma unroll
    for (int a = 0; a < 2; ++a)
#pragma unroll
        for (int b = 0; b < 2; ++b)
#pragma unroll
            for (int m = 0; m < 4; ++m)
#pragma unroll
                for (int n = 0; n < 2; ++n) acc[a][b][m][n] = (f32x4){0.f, 0.f, 0.f, 0.f};
    bf16x8 At[4][2], B0[2][2], B1[2][2];
    const char* cA = PG8_ABASE(cur); const char* cB = PG8_BBASE(cur);
    if constexpr (SP2) {
        PG8_STAGE(PG8_SB(0, 0), cB, voffB); PG8_STAGE(PG8_SB(0, 1), cB + hstepB, voffB); PG8_STAGE(PG8_SA(0, 0), cA, voffA); PG8_STAGE(PG8_SA(0, 1), cA + hstepA, voffA);
        if (wr == 1) PG8_BAR;
        PG8_WAIT_V(2); PG8_BAR;
        PG8_STAGE(PG8_SB(1, 0), cB + kstep, voffB); PG8_STAGE(PG8_SA(1, 0), cA + kstep, voffA); PG8_STAGE(PG8_SB(1, 1), cB + hstepB + kstep, voffB);
        PG8_WAIT_V(6); PG8_BAR;
    } else {
        PG8_STAGE(PG8_SB(0, 0), cB, voffB); PG8_STAGE(PG8_SA(0, 0), cA, voffA); PG8_STAGE(PG8_SB(0, 1), cB + hstepB, voffB); PG8_STAGE(PG8_SA(0, 1), cA + hstepA, voffA);
        if (wr == 1) PG8_BAR;
        PG8_WAIT_V(4); PG8_BAR;
        PG8_STAGE(PG8_SB(1, 0), cB + kstep, voffB); PG8_STAGE(PG8_SA(1, 0), cA + kstep, voffA); PG8_STAGE(PG8_SB(1, 1), cB + hstepB + kstep, voffB);
        PG8_WAIT_V(6); PG8_BAR;
    }
    for (;;) {
        const bool has_next = S.next(ui + 1, nxt);
        const char* nA = has_next ? PG8_ABASE(nxt) : cA; const char* nB = has_next ? PG8_BBASE(nxt) : cB;
        for (int t = 0; t < nt; t += 2) {
            const bool last = (t == nt - 2);
            const char* a1 = cA + (size_t)(t + 1) * kstep;
            const char* a2 = last ? nA : cA + (size_t)(t + 2) * kstep; const char* b2 = last ? nB : cB + (size_t)(t + 2) * kstep;
            const char* a3 = a2 + kstep; const char* b3 = b2 + kstep;
            if constexpr (SP2) {
            PG8_LDB(B0, 0, 0); PG8_LDB(B1, 0, 1); PG8_SCHED; PG8_LDA(At, 0, 0); PG8_STAGE(PG8_SA(1, 1), a1 + hstepA, voffA);
            PG8_WAIT_V(8); PG8_WAIT_L(0); PG8_BAR; PG8_MMA(0, 0, At, B0); PG8_MMA(0, 1, At, B1); PG8_BAR; PG8_SCHED;
            PG8_LDA(At, 0, 1); PG8_STAGE(PG8_SB(0, 0), b2, voffB); PG8_STAGE(PG8_SB(0, 1), b2 + hstepB, voffB); PG8_STAGE(PG8_SA(0, 0), a2, voffA);
            PG8_WAIT_V(8); PG8_WAIT_L(0); PG8_BAR; PG8_MMA(1, 0, At, B0); PG8_MMA(1, 1, At, B1); PG8_BAR; PG8_SCHED;
            PG8_LDB(B0, 1, 0); PG8_LDB(B1, 1, 1); PG8_SCHED; PG8_LDA(At, 1, 0); PG8_STAGE(PG8_SA(0, 1), a2 + hstepA, voffA);
            PG8_WAIT_V(8); PG8_WAIT_L(0); PG8_BAR; PG8_MMA(0, 0, At, B0); PG8_MMA(0, 1, At, B1); PG8_BAR; PG8_SCHED;
            PG8_LDA(At, 1, 1); PG8_STAGE(PG8_SB(1, 0), b3, voffB); PG8_STAGE(PG8_SB(1, 1), b3 + hstepB, voffB); PG8_STAGE(PG8_SA(1, 0), a3, voffA);
            PG8_WAIT_V(8); PG8_WAIT_L(0); PG8_BAR; PG8_MMA(1, 0, At, B0); PG8_MMA(1, 1, At, B1); PG8_BAR; PG8_SCHED;
            } else {
            PG8_LDB(B0, 0, 0); PG8_SCHED; PG8_LDA(At, 0, 0); PG8_STAGE(PG8_SA(1, 1), a1 + hstepA, voffA);
            PG8_WAIT_L(8); PG8_BAR; PG8_WAIT_L(0); PG8_MMA(0, 0, At, B0); PG8_BAR; PG8_SCHED;
            PG8_LDB(B1, 0, 1); PG8_STAGE(PG8_SB(0, 0), b2, voffB);
            PG8_BAR; PG8_WAIT_L(0); PG8_MMA(0, 1, At, B1); PG8_BAR;
            PG8_LDA(At, 0, 1); PG8_STAGE(PG8_SA(0, 0), a2, voffA);
            PG8_BAR; PG8_WAIT_L(0); PG8_MMA(1, 0, At, B0); PG8_BAR; PG8_SCHED;
            PG8_STAGE(PG8_SB(0, 1), b2 + hstepB, voffB);
            PG8_WAIT_V(6); PG8_BAR; PG8_MMA(1, 1, At, B1); PG8_BAR;
            PG8_LDB(B0, 1, 0); PG8_SCHED; PG8_LDA(At, 1, 0); PG8_STAGE(PG8_SA(0, 1), a2 + hstepA, voffA);
            PG8_WAIT_L(8); PG8_BAR; PG8_WAIT_L(0); PG8_MMA(0, 0, At, B0); PG8_BAR; PG8_SCHED;
            PG8_LDB(B1, 1, 1); PG8_STAGE(PG8_SB(1, 0), b3, voffB);
            PG8_BAR; PG8_WAIT_L(0); PG8_MMA(0, 1, At, B1); PG8_BAR;
            PG8_LDA(At, 1, 1); PG8_STAGE(PG8_SA(1, 0), a3, voffA);
            PG8_BAR; PG8_WAIT_L(0); PG8_MMA(1, 0, At, B0); PG8_BAR; PG8_SCHED;
            PG8_STAGE(PG8_SB(1, 1), b3 + hstepB, voffB);
            PG8_WAIT_V(6); PG8_BAR; PG8_MMA(1, 1, At, B1); PG8_BAR;
            }
        }
        if constexpr (ALIGN_EPI) { if (wr == 0) PG8_BAR; }
        { const int le_ = lane_id_opaque(); E(acc, cur, wr, wc, le_ & 15, le_ >> 4); }
        if (!has_next) break;
#pragma unroll
        for (int a = 0; a < 2; ++a)
#pragma unroll
            for (int b = 0; b < 2; ++b)
#pragma unroll
                for (int m = 0; m < 4; ++m)
#pragma unroll
                    for (int n = 0; n < 2; ++n) acc[a][b][m][n] = (f32x4){0.f, 0.f, 0.f, 0.f};
        cur = nxt; cA = nA; cB = nB; ++ui;
        if constexpr (ALIGN_EPI) { if (wr == 1) PG8_BAR; }
    }
    PG8_WAIT_V(0);
    if constexpr (!ALIGN_EPI) { if (wr == 0) PG8_BAR; }
    PG8_BAR;
#undef PG8_SA
#undef PG8_SB
#undef PG8_STAGE
#undef PG8_LDA
#undef PG8_LDB
#undef PG8_MMA
#undef PG8_WAIT_V
#undef PG8_WAIT_L
#undef PG8_BAR
#undef PG8_SCHED
#undef PG8_ABASE
#undef PG8_BBASE
}
}

struct EpiZ {
    static constexpr bool PERM = true;
    float* out; unsigned char* ws;
    __device__ __forceinline__ void operator()(const f32x4 (&acc)[2][2][4][2], const pg8::Unit& u, int wr, int wc, int fr, int fq) const {
        asm volatile("" : "+v"(fr), "+v"(fq));
        const int seg = u.pn >> 1;
        const bool smp = u.pm >= SEQ / 256;
        const int row0 = u.pm * 256 + wr * 64 + fr;
        const int cl0 = wc * 32 + 8 * fq;
        if (seg < 6) {
            bf16_t* B = (bf16_t*)(ws + WS_QA + (size_t)seg * (WS_KA - WS_QA));
            const bool isq = (seg == 0 || seg == 3);
            const float sc = isq ? C2 : 1.0f;
            const int kk = seg - 1 - (seg > 3 ? 1 : 0);
            float* ob = isq ? nullptr : (smp ? out + O_DKS + (size_t)kk * NSMP * 512 - (size_t)SEQ * 512 : out + O_DKP + (size_t)kk * SEQ * 512);
            const int cs = (u.pn & 1) * 256 + cl0;
            if (seg == 0 || seg == 1 || seg == 3 || seg == 4) {
                float mx0 = 0.f, mx1 = 0.f;
#pragma unroll
                for (int ai = 0; ai < 2; ++ai)
#pragma unroll
                    for (int m = 0; m < 4; ++m) {
#pragma unroll
                        for (int bj = 0; bj < 2; ++bj) { const f32x4 v0 = acc[ai][bj][m][0] * sc, v1 = acc[ai][bj][m][1] * sc;
                            float ss = (v0[0] * v0[0] + v0[1] * v0[1]) + (v0[2] * v0[2] + v0[3] * v0[3]) + (v1[0] * v1[0] + v1[1] * v1[1]) + (v1[2] * v1[2] + v1[3] * v1[3]);
                            ss += __shfl_xor(ss, 16); ss += __shfl_xor(ss, 32);
                            if (bj == 0) mx0 = fmaxf(mx0, ss); else mx1 = fmaxf(mx1, ss); } }
#pragma unroll
                for (int ofs = 1; ofs < 16; ofs <<= 1) { mx0 = fmaxf(mx0, __shfl_xor(mx0, ofs)); mx1 = fmaxf(mx1, __shfl_xor(mx1, ofs)); }
                if ((fr | fq) == 0) { unsigned* nw = (unsigned*)(ws + WS_CTL) + (seg < 3 ? 288 : 256) + ((seg == 4 || seg == 1) ? 16 : 0);
                    const int h0 = (u.pn & 1) * 4 + (wc >> 1), hf = wc & 1;
                    atomicMax(nw + (h0 * 2 + hf), __float_as_uint(mx0)); atomicMax(nw + ((h0 + 2) * 2 + hf), __float_as_uint(mx1)); }
            }
#pragma unroll
            for (int ai = 0; ai < 2; ++ai)
#pragma unroll
                for (int m = 0; m < 4; ++m) { const size_t r = (size_t)(row0 + ai * 128 + m * 16);
#pragma unroll
                    for (int bj = 0; bj < 2; ++bj) { const f32x4 v0 = acc[ai][bj][m][0], v1 = acc[ai][bj][m][1]; const int c = cs + bj * 128;
                        if (ob) { __builtin_nontemporal_store(v0, (f32x4*)(ob + r * 512 + c)); __builtin_nontemporal_store(v1, (f32x4*)(ob + r * 512 + c + 4)); }
                        u32x4 w; w.x = pg8::cvt_pk_bf16(v0[0] * sc, v0[1] * sc); w.y = pg8::cvt_pk_bf16(v0[2] * sc, v0[3] * sc); w.z = pg8::cvt_pk_bf16(v1[0] * sc, v1[1] * sc); w.w = pg8::cvt_pk_bf16(v1[2] * sc, v1[3] * sc);
                        *(u32x4*)(B + r * 512 + c) = w; } }
        } else {
            bf16_t* G = (bf16_t*)(ws + WS_G);
            const int cs = (u.pn - 12) * 256 + cl0;
#pragma unroll
            for (int ai = 0; ai < 2; ++ai)
#pragma unroll
                for (int m = 0; m < 4; ++m) { const size_t r = (size_t)(row0 + ai * 128 + m * 16);
#pragma unroll
                    for (int bj = 0; bj < 2; ++bj) { const f32x4 v0 = acc[ai][bj][m][0], v1 = acc[ai][bj][m][1]; const int c = cs + bj * 128;
                        u32x4 w; w.x = pg8::cvt_pk_bf16(sigmoidf_(v0[0]), sigmoidf_(v0[1])); w.y = pg8::cvt_pk_bf16(sigmoidf_(v0[2]), sigmoidf_(v0[3]));
                        w.z = pg8::cvt_pk_bf16(sigmoidf_(v1[0]), sigmoidf_(v1[1])); w.w = pg8::cvt_pk_bf16(sigmoidf_(v1[2]), sigmoidf_(v1[3]));
                        *(u32x4*)(G + r * 2048 + c) = w; } }
        }
    }
};
struct EpiGate {
    static constexpr bool PERM = true;
    bf16_t* G; bf16_t* GO;
    __device__ __forceinline__ void operator()(const f32x4 (&acc)[2][2][4][2], const pg8::Unit& u, int wr, int wc, int fr, int fq) const {
        asm volatile("" : "+v"(fr), "+v"(fq));
        const int row0 = u.pm * 256 + wr * 64 + fr, c0 = u.pn * 256 + wc * 32 + 8 * fq;
#pragma unroll
        for (int ai = 0; ai < 2; ++ai)
#pragma unroll
            for (int m = 0; m < 4; ++m) { const size_t ro = (size_t)(row0 + ai * 128 + m * 16) * 2048 + c0; const bf16_t* rp = G + ro; bf16_t* wp = GO + ro;
#pragma unroll
                for (int bj = 0; bj < 2; ++bj) { const f32x4 v0 = acc[ai][bj][m][0], v1 = acc[ai][bj][m][1]; const u32x4 gw = *(const u32x4*)(rp + bj * 128);
                    u32x4 w; w.x = pg8::cvt_pk_bf16(v0[0] * bflo(gw.x), v0[1] * bfhi(gw.x)); w.y = pg8::cvt_pk_bf16(v0[2] * bflo(gw.y), v0[3] * bfhi(gw.y));
                    w.z = pg8::cvt_pk_bf16(v1[0] * bflo(gw.z), v1[1] * bfhi(gw.z)); w.w = pg8::cvt_pk_bf16(v1[2] * bflo(gw.w), v1[3] * bfhi(gw.w));
                    *(u32x4*)(wp + bj * 128) = w; } }
    }
};
template <bool BASE_BF16> struct EpiRes {
    static constexpr bool PERM = true;
    const void* base; bf16_t* T; const float* gate;
    __device__ __forceinline__ void operator()(const f32x4 (&acc)[2][2][4][2], const pg8::Unit& u, int wr, int wc, int fr, int fq) const {
        asm volatile("" : "+v"(fr), "+v"(fq));
        const int row0 = u.pm * 256 + wr * 64 + fr, c0 = u.pn * 256 + wc * 32 + 8 * fq;
#pragma unroll
        for (int ai = 0; ai < 2; ++ai)
#pragma unroll
            for (int m = 0; m < 4; ++m) { const size_t ro = (size_t)(row0 + ai * 128 + m * 16) * DM;
#pragma unroll
                for (int bj = 0; bj < 2; ++bj) { const int c = c0 + bj * 128; f32x4 b0, b1;
                    if (BASE_BF16) { const u32x4 bw = *(const u32x4*)((const bf16_t*)base + ro + c); b0 = (f32x4){bflo(bw.x), bfhi(bw.x), bflo(bw.y), bfhi(bw.y)}; b1 = (f32x4){bflo(bw.z), bfhi(bw.z), bflo(bw.w), bfhi(bw.w)}; }
                    else { b0 = *(const f32x4*)((const float*)base + ro + c); b1 = *(const f32x4*)((const float*)base + ro + c + 4); }
                    const f32x4 g0 = *(const f32x4*)(gate + c), g1 = *(const f32x4*)(gate + c + 4);
                    const f32x4 v0 = b0 * ALPHA + g0 * acc[ai][bj][m][0], v1 = b1 * ALPHA + g1 * acc[ai][bj][m][1];
                    u32x4 w; w.x = pg8::cvt_pk_bf16(v0[0], v0[1]); w.y = pg8::cvt_pk_bf16(v0[2], v0[3]); w.z = pg8::cvt_pk_bf16(v1[0], v1[1]); w.w = pg8::cvt_pk_bf16(v1[2], v1[3]);
                    *(u32x4*)(T + ro + c) = w; } }
    }
};
struct PanelStats {
    unsigned* xbuf; unsigned* cnt; float eps;
    __device__ __forceinline__ void run(const f32x4 (&v)[2][2][4][2], const pg8::Unit& u, int wr, int wc, int fr, int fq, LAS unsigned char* lds, int wid, int lane) const {
        LAS f32x2* P = (LAS f32x2*)(lds + LN_LDS);
        LAS f32x2* S = (LAS f32x2*)(lds + LN_LDS + 8192);
#pragma unroll
        for (int ai = 0; ai < 2; ++ai)
#pragma unroll
            for (int m = 0; m < 4; ++m) {
                float s = 0.f;
#pragma unroll
                for (int bj = 0; bj < 2; ++bj)
#pragma unroll
                    for (int n = 0; n < 2; ++n) { const f32x4 x = v[ai][bj][m][n]; s += (x[0] + x[1]) + (x[2] + x[3]); }
                s += __shfl_xor(s, 16); s += __shfl_xor(s, 32);
                const float mw = s * (1.0f / 64.0f); float q = 0.f;
#pragma unroll
                for (int bj = 0; bj < 2; ++bj)
#pragma unroll
                    for (int n = 0; n < 2; ++n) { const f32x4 d = v[ai][bj][m][n] - mw; q += (d[0] * d[0] + d[1] * d[1]) + (d[2] * d[2] + d[3] * d[3]); }
                q += __shfl_xor(q, 16); q += __shfl_xor(q, 32);
                if (fq == 0) P[(ai * 128 + wr * 64 + m * 16 + fr) * 4 + wc] = (f32x2){mw, q};
                __builtin_amdgcn_sched_barrier(0);
            }
        asm volatile("s_waitcnt lgkmcnt(0)" ::: "memory"); __builtin_amdgcn_s_barrier(); asm volatile("" ::: "memory");
        const int row = wid * 32 + (lane & 31);
        if (lane < 32) {
            const f32x2 a = P[row * 4 + 0], b = P[row * 4 + 1], c = P[row * 4 + 2], d = P[row * 4 + 3];
            const float mt = (a.x + b.x + c.x + d.x) * 0.25f;
            const float da = a.x - mt, db = b.x - mt, dc = c.x - mt, dd = d.x - mt;
            const float m2 = (a.y + b.y) + (c.y + d.y) + 64.0f * ((da * da + db * db) + (dc * dc + dd * dd));
            unsigned long long* slot = (unsigned long long*)xbuf + ((size_t)(u.pm * 256 + row) * 4 + u.pn);
            __hip_atomic_store(slot, ((unsigned long long)__float_as_uint(m2) << 32) | __float_as_uint(mt), __ATOMIC_RELAXED, __HIP_MEMORY_SCOPE_AGENT);
        }
        asm volatile("s_waitcnt vmcnt(0)" ::: "memory");
        if (lane == 0) __hip_atomic_fetch_add(cnt + 64 * u.pm, 1u, __ATOMIC_RELAXED, __HIP_MEMORY_SCOPE_AGENT);
        if (wid == 0) {
            unsigned sp = 0;
            while ((unsigned)__builtin_amdgcn_readfirstlane(__hip_atomic_load(cnt + 64 * u.pm, __ATOMIC_RELAXED, __HIP_MEMORY_SCOPE_AGENT)) < 32u && ++sp < (1u << 21)) __builtin_amdgcn_s_sleep(2);
            __builtin_amdgcn_fence(__ATOMIC_ACQUIRE, "agent");
        }
        asm volatile("s_waitcnt vmcnt(0) lgkmcnt(0)" ::: "memory"); __builtin_amdgcn_s_barrier(); asm volatile("" ::: "memory");
        if (lane < 32) {
            const unsigned long long* slot = (const unsigned long long*)xbuf + (size_t)(u.pm * 256 + row) * 4; float mt[4], m2[4]; float ms = 0.f;
#pragma unroll
            for (int t = 0; t < 4; ++t) { const unsigned long long w = __hip_atomic_load(slot + t, __ATOMIC_RELAXED, __HIP_MEMORY_SCOPE_AGENT); mt[t] = __uint_as_float((unsigned)w); m2[t] = __uint_as_float((unsigned)(w >> 32)); ms += mt[t]; }
            const float mean = ms * 0.25f; float q = 0.f;
#pragma unroll
            for (int t = 0; t < 4; ++t) { const float dm = mt[t] - mean; q += m2[t] + 256.0f * dm * dm; }
            S[row] = (f32x2){mean, 1.0f / sqrtf(q * (1.0f / 1024.0f) + eps)};
        }
        asm volatile("s_waitcnt lgkmcnt(0)" ::: "memory"); __builtin_amdgcn_s_barrier(); asm volatile("" ::: "memory");
    }
};
template <bool FINAL> struct EpiResLn {
    static constexpr bool PERM = true;
    const void* base; const float* gate; const float* lg; const float* lb; const float* mod; bf16_t* X1B; bf16_t* XN; float* out; PanelStats st; LAS unsigned char* lds;
    __device__ __forceinline__ void operator()(f32x4 (&acc)[2][2][4][2], const pg8::Unit& u, int wr, int wc, int fr, int fq) const {
        asm volatile("" : "+v"(fr), "+v"(fq));
        const int row0 = u.pm * 256 + wr * 64 + fr, c0 = u.pn * 256 + wc * 32 + 8 * fq;
#pragma unroll
        for (int ai = 0; ai < 2; ++ai)
#pragma unroll
            for (int m = 0; m < 4; ++m) { int rr_ = row0 + ai * 128 + m * 16; asm volatile("" : "+v"(rr_)); const size_t ro = (size_t)rr_ * DM;
#pragma unroll
                for (int bj = 0; bj < 2; ++bj) { int c = c0 + bj * 128; asm volatile("" : "+v"(c)); f32x4 b0, b1;
                    if (FINAL) { const u32x4 bw = *(const u32x4*)((const bf16_t*)base + ro + c); b0 = (f32x4){bflo(bw.x), bfhi(bw.x), bflo(bw.y), bfhi(bw.y)}; b1 = (f32x4){bflo(bw.z), bfhi(bw.z), bflo(bw.w), bfhi(bw.w)}; }
                    else { b0 = *(const f32x4*)((const float*)base + ro + c); b1 = *(const f32x4*)((const float*)base + ro + c + 4); }
                    const f32x4 g0 = *(const f32x4*)(gate + c), g1 = *(const f32x4*)(gate + c + 4);
                    acc[ai][bj][m][0] = b0 * ALPHA + g0 * acc[ai][bj][m][0]; acc[ai][bj][m][1] = b1 * ALPHA + g1 * acc[ai][bj][m][1];
                    asm volatile("" : "+v"(acc[ai][bj][m][0]), "+v"(acc[ai][bj][m][1])); }
                __builtin_amdgcn_sched_barrier(0); }
        st.run(acc, u, wr, wc, fr, fq, lds, wr * 4 + wc, fq * 16 + fr);
        const LAS f32x2* S = (const LAS f32x2*)(lds + LN_LDS + 8192);
#pragma unroll
        for (int ai = 0; ai < 2; ++ai)
#pragma unroll
            for (int m = 0; m < 4; ++m) { int r = ai * 128 + wr * 64 + m * 16 + fr; asm volatile("" : "+v"(r)); const f32x2 sr = S[r]; const size_t ro = (size_t)(u.pm * 256 + r) * DM;
#pragma unroll
                for (int bj = 0; bj < 2; ++bj) { int c = c0 + bj * 128; asm volatile("" : "+v"(c));
                    const f32x4 y0 = (acc[ai][bj][m][0] - sr.x) * sr.y * *(const f32x4*)(lg + c) + *(const f32x4*)(lb + c);
                    const f32x4 y1 = (acc[ai][bj][m][1] - sr.x) * sr.y * *(const f32x4*)(lg + c + 4) + *(const f32x4*)(lb + c + 4);
                    if (FINAL) { __builtin_nontemporal_store(y0, (f32x4*)(out + ro + c)); __builtin_nontemporal_store(y1, (f32x4*)(out + ro + c + 4)); }
                    else { u32x4 w; w.x = pg8::cvt_pk_bf16(y0[0], y0[1]); w.y = pg8::cvt_pk_bf16(y0[2], y0[3]); w.z = pg8::cvt_pk_bf16(y1[0], y1[1]); w.w = pg8::cvt_pk_bf16(y1[2], y1[3]);
                        *(u32x4*)(X1B + ro + c) = w;
                        const f32x4 h0 = y0 * (*(const f32x4*)(mod + 4096 + c) + 1.0f) + *(const f32x4*)(mod + 3072 + c), h1 = y1 * (*(const f32x4*)(mod + 4096 + c + 4) + 1.0f) + *(const f32x4*)(mod + 3072 + c + 4);
                        u32x4 w2; w2.x = pg8::cvt_pk_bf16(h0[0], h0[1]); w2.y = pg8::cvt_pk_bf16(h0[2], h0[3]); w2.z = pg8::cvt_pk_bf16(h1[0], h1[1]); w2.w = pg8::cvt_pk_bf16(h1[2], h1[3]);
                        *(u32x4*)(XN + ro + c) = w2; } }
                __builtin_amdgcn_sched_barrier(0); }
    }
};
struct EpiSlab {
    static constexpr bool PERM = true;
    float* slab;
    __device__ __forceinline__ void operator()(const f32x4 (&acc)[2][2][4][2], const pg8::Unit& u, int wr, int wc, int fr, int fq) const {
        asm volatile("" : "+v"(fr), "+v"(fq));
        const int row0 = wr * 64 + fr, c0 = u.pn * 256 + wc * 32 + 8 * fq; float* sb = slab + (size_t)u.ks * NSMP * DM;
#pragma unroll
        for (int ai = 0; ai < 2; ++ai)
#pragma unroll
            for (int m = 0; m < 4; ++m) { float* op = sb + (size_t)(row0 + ai * 128 + m * 16) * DM + c0;
#pragma unroll
                for (int bj = 0; bj < 2; ++bj) { *(f32x4*)(op + bj * 128) = acc[ai][bj][m][0]; *(f32x4*)(op + bj * 128 + 4) = acc[ai][bj][m][1]; } }
    }
};
struct EpiFfn {
    static constexpr bool PERM = true;
    bf16_t* ACT;
    __device__ __forceinline__ void operator()(const f32x4 (&acc)[2][2][4][2], const pg8::Unit& u, int wr, int wc, int fr, int fq) const {
        asm volatile("" : "+v"(fr), "+v"(fq));
        const int row0 = u.pm * 256 + wr * 64 + fr, c0 = u.pn * 128 + wc * 32 + 8 * fq;
#pragma unroll
        for (int ai = 0; ai < 2; ++ai)
#pragma unroll
            for (int m = 0; m < 4; ++m) { const f32x4 g0 = acc[ai][0][m][0], g1 = acc[ai][0][m][1], u0 = acc[ai][1][m][0], u1 = acc[ai][1][m][1];
                u32x4 w; w.x = pg8::cvt_pk_bf16(siluf_(g0[0]) * u0[0], siluf_(g0[1]) * u0[1]); w.y = pg8::cvt_pk_bf16(siluf_(g0[2]) * u0[2], siluf_(g0[3]) * u0[3]);
                w.z = pg8::cvt_pk_bf16(siluf_(g1[0]) * u1[0], siluf_(g1[1]) * u1[1]); w.w = pg8::cvt_pk_bf16(siluf_(g1[2]) * u1[2], siluf_(g1[3]) * u1[3]);
                *(u32x4*)(ACT + (size_t)(row0 + ai * 128 + m * 16) * DFF + c0) = w; }
    }
};

struct Frame {
    LAS unsigned char* lds; unsigned char* ldsg;
    int tid, lane, wave, G, bid;
    const float* const* in; float* out; unsigned char* ws;
};
enum { I_XP = 0, I_XS, I_CDK, I_CDV, I_CFK, I_CFV, I_CFL, I_CP, I_CS, I_WADA, I_BADA, I_WIN, I_BF, I_LQ1, I_LK1, I_LQ2, I_LK2, I_SUBG, I_RELB, I_WA, I_WB, I_WO, I_LN1G, I_LN1B, I_LN2G, I_LN2B, I_WFI, I_WFO };

__device__ __forceinline__ void tr_item(const float* W, int ldw, int src_n0, int k0, bf16_t* WT, int ldt, int dst_row0, int dst_k0, int dup_off, LAS float* scr, int lane) {
#pragma unroll 8
    for (int i = 0; i < 32; ++i) { const int kk = 2 * i + (lane >> 5); scr[kk * 33 + (lane & 31)] = W[(size_t)(k0 + kk) * ldw + src_n0 + (lane & 31)]; }
    asm volatile("s_waitcnt lgkmcnt(0)" ::: "memory");
    const int c = lane & 7;
#pragma unroll
    for (int j = 0; j < 4; ++j) { const int n = (lane >> 3) + 8 * j; const LAS float* s = scr + (8 * c) * 33 + n;
        u32x4 o; o.x = pk2(s[0 * 33], s[1 * 33]); o.y = pk2(s[2 * 33], s[3 * 33]); o.z = pk2(s[4 * 33], s[5 * 33]); o.w = pk2(s[6 * 33], s[7 * 33]);
        bf16_t* d = WT + (size_t)(dst_row0 + n) * ldt + dst_k0 + 8 * c;
        *(u32x4*)d = o; if (dup_off) *(u32x4*)(d + dup_off) = o; }
    asm volatile("s_waitcnt lgkmcnt(0)" ::: "memory");
}
__device__ __forceinline__ void weight_copies(Frame& F, int c, int n, int it0, int it1) {
    LAS float* scr = (LAS float*)(F.lds + F.wave * 16384);
    const int gw = c * 8 + F.wave, NGW = n * 8;
    constexpr int I_IN = 16 * (NZ / 32), I_A = 8 * 32, I_B = 8 * 32, I_O = 16 * 32, I_FI = 16 * (NFF2 / 32), I_FO = (DFF / 64) * 32;
    for (int it = it0 + gw; it < it1; it += NGW) {
        int r = it;
        if (r < I_IN) { const int nb = NZ / 32, kb = r / nb, n0 = 32 * (r % nb); tr_item(F.in[I_WIN], WIN_COLS, n0 < 3072 ? n0 : n0 + 8, 64 * kb, (bf16_t*)(F.ws + WS_WIN), 1024, n0, 64 * kb, 0, scr, F.lane); continue; } r -= I_IN;
        if (r < I_A) { const int kb = r / 32, n0 = 32 * (r % 32); tr_item(F.in[I_WA], 1024, n0, 64 * kb, (bf16_t*)(F.ws + WS_WAB), 512, n0, 64 * kb, 0, scr, F.lane); continue; } r -= I_A;
        if (r < I_B) { const int kb = r / 32, n0 = 32 * (r % 32); tr_item(F.in[I_WB], 1024, n0, 64 * kb, (bf16_t*)(F.ws + WS_WAB), 512, 1024 + n0, 64 * kb, 0, scr, F.lane); continue; } r -= I_B;
        if (r < I_O) { const int kb = r / 32, n0 = 32 * (r % 32); tr_item(F.in[I_WO], 1024, n0, 64 * kb, (bf16_t*)(F.ws + WS_WO2), 2048, n0, 64 * kb, 1024, scr, F.lane); continue; } r -= I_O;
        if (r < I_FI) { const int nb = NFF2 / 32, kb = r / nb, n0 = 32 * (r % nb), t = n0 >> 8, j = n0 & 255; const int src = j < 128 ? 128 * t + j : DFF + 128 * t + (j - 128);
            tr_item(F.in[I_WFI], NFF2, src, 64 * kb, (bf16_t*)(F.ws + WS_WFI), 1024, n0, 64 * kb, 0, scr, F.lane); continue; } r -= I_FI;
        { const int kb = r / 32, n0 = 32 * (r % 32); tr_item(F.in[I_WFO], 1024, n0, 64 * kb, (bf16_t*)(F.ws + WS_WFO), DFF, n0, 64 * kb, 0, scr, F.lane); }
    }
}
constexpr int WC_IN = 16 * (NZ / 32), WC_ALL = WC_IN + 8 * 32 + 8 * 32 + 16 * 32 + 16 * (NFF2 / 32) + (DFF / 64) * 32;
__device__ __forceinline__ void p0_prologue(Frame& F) {
    if (F.bid < 96) {
        LAS float* sc = (LAS float*)F.lds;
        LAS float* part = sc + 17 * 1024;
        for (int i = F.tid; i < 17 * 1024; i += 512) { const int r = i >> 10, k = i & 1023; const float c = r == 0 ? F.in[I_CP][k] : F.in[I_CS][(r - 1) * 1024 + k]; sc[i] = siluf_(c); }
        __syncthreads();
        const int n = F.bid * 64 + F.lane; const float* wa = F.in[I_WADA] + n;
        float acc[17];
#pragma unroll
        for (int r = 0; r < 17; ++r) acc[r] = 0.f;
        for (int k = F.wave * 128; k < F.wave * 128 + 128; k += 4) {
            const float w0 = wa[(size_t)k * 6144], w1 = wa[(size_t)(k + 1) * 6144], w2 = wa[(size_t)(k + 2) * 6144], w3 = wa[(size_t)(k + 3) * 6144];
#pragma unroll
            for (int r = 0; r < 17; ++r) { const f32x4 s = *(const LAS f32x4*)(sc + r * 1024 + k); acc[r] += s[0] * w0 + s[1] * w1 + s[2] * w2 + s[3] * w3; }
        }
#pragma unroll
        for (int r = 0; r < 17; ++r) part[(F.wave * 17 + r) * 64 + F.lane] = acc[r];
        __syncthreads();
        float* mod = (float*)(F.ws + WS_MOD);
        for (int i = F.tid; i < 17 * 64; i += 512) { const int r = i >> 6, l = i & 63; float s = 0.f;
#pragma unroll
            for (int w = 0; w < 8; ++w) s += part[(w * 17 + r) * 64 + l];
            mod[r * 6144 + F.bid * 64 + l] = s + F.in[I_BADA][F.bid * 64 + l]; }
        asm volatile("s_waitcnt vmcnt(0)" ::: "memory");
        __syncthreads();
        if (F.tid == 0) { __builtin_amdgcn_fence(__ATOMIC_RELEASE, "agent"); asm volatile("s_waitcnt vmcnt(0)" ::: "memory");
            __hip_atomic_fetch_add((unsigned*)(F.ws + WS_CTL) + 320, 1u, __ATOMIC_RELAXED, __HIP_MEMORY_SCOPE_AGENT); }
    }
    weight_copies(F, F.bid, F.G, 0, 16 * (NZ / 32));
}

__device__ __forceinline__ void p1_rows(Frame& F, bool wait_mod) {
    LAS float* wf = (LAS float*)F.lds;
    for (int i = F.tid; i < 1024 * 8; i += 512) wf[i] = F.in[I_WIN][(size_t)(i >> 3) * WIN_COLS + 3072 + (i & 7)];
    __syncthreads();
    const float* mod = (const float*)(F.ws + WS_MOD);
    bf16_t* XN = (bf16_t*)(F.ws + WS_XN);
    const int gw = F.bid * 8 + F.wave, NGW = F.G * 8;
    if (wait_mod) {
        if (F.tid == 0) { unsigned* w = (unsigned*)(F.ws + WS_CTL) + 320; unsigned sp = 0;
            while (__hip_atomic_load(w, __ATOMIC_RELAXED, __HIP_MEMORY_SCOPE_AGENT) < 96u && ++sp < (1u << 22)) __builtin_amdgcn_s_sleep(2);
            __builtin_amdgcn_fence(__ATOMIC_ACQUIRE, "agent"); asm volatile("s_waitcnt vmcnt(0)" ::: "memory"); }
        __syncthreads(); }
    for (int m = gw; m < MT; m += NGW) {
        const bool smp = m >= SEQ; const int rb = smp ? 1 + ((m - SEQ) >> 4) : 0;
        const float* xr = smp ? F.in[I_XS] + (size_t)(m - SEQ) * DM : F.in[I_XP] + (size_t)m * DM;
        const float* sh = mod + (size_t)rb * 6144, *scl = sh + 1024;
        float a8[8];
#pragma unroll
        for (int j = 0; j < 8; ++j) a8[j] = 0.f;
#pragma unroll
        for (int j = 0; j < 4; ++j) { const int k = 4 * F.lane + 256 * j;
            const f32x4 x = *(const f32x4*)(xr + k), s1 = *(const f32x4*)(scl + k), t1 = *(const f32x4*)(sh + k);
            const f32x4 h = x * (s1 + 1.0f) + t1;
            u32x2 w; w.x = pk2(h[0], h[1]); w.y = pk2(h[2], h[3]); *(u32x2*)(XN + (size_t)m * DM + k) = w;
#pragma unroll
            for (int e = 0; e < 4; ++e) { const f32x4 wa = *(const LAS f32x4*)(wf + (k + e) * 8), wb = *(const LAS f32x4*)(wf + (k + e) * 8 + 4);
                a8[0] += h[e] * wa[0]; a8[1] += h[e] * wa[1]; a8[2] += h[e] * wa[2]; a8[3] += h[e] * wa[3];
                a8[4] += h[e] * wb[0]; a8[5] += h[e] * wb[1]; a8[6] += h[e] * wb[2]; a8[7] += h[e] * wb[3]; } }
        float mine = 0.f;
#pragma unroll
        for (int j = 0; j < 8; ++j) { const float s = wave_sum(a8[j]); if (F.lane == j) mine = s; }
        if (F.lane < 8) { const float v = mine + F.in[I_BF][F.lane]; const float lf = fminf(v, 0.f) - log1pf(__expf(-fabsf(v)));
            float* o = smp ? F.out + O_FLS + (size_t)(m - SEQ) * 8 : F.out + O_FLP + (size_t)m * 8; o[F.lane] = lf; }
    }
}

__device__ __forceinline__ float block_excl_scan(Frame& F, float tot, LAS float* sm) {
    float inc = tot;
#pragma unroll
    for (int o = 1; o < 64; o <<= 1) { const float t = __shfl_up(inc, o); if (F.lane >= o) inc += t; }
    if (F.lane == 63) sm[F.wave] = inc;
    __syncthreads();
    float base = 0.f;
    for (int w = 0; w < F.wave; ++w) base += sm[w];
    __syncthreads();
    return base + inc - tot;
}
__device__ __forceinline__ void p2_cumsum(Frame& F) {
    LAS float* sm = (LAS float*)F.lds;
    if (F.bid < 8) {
        const int h = F.bid; const float* lf = F.out + O_FLP; float* Fp = (float*)(F.ws + WS_FP) + (size_t)h * SEQ;
        float v[32]; float run = 0.f;
#pragma unroll
        for (int i = 0; i < 32; ++i) { run += lf[(size_t)(32 * F.tid + i) * 8 + h]; v[i] = run; }
        const float off = block_excl_scan(F, run, sm);
#pragma unroll
        for (int i = 0; i < 32; i += 4) *(f32x4*)(Fp + 32 * F.tid + i) = (f32x4){(off + v[i]) * LOG2E, (off + v[i + 1]) * LOG2E, (off + v[i + 2]) * LOG2E, (off + v[i + 3]) * LOG2E};
    } else if (F.bid < 8 + 128) {
        const int b = (F.bid - 8) >> 3, h = (F.bid - 8) & 7;
        const float* cl = F.in[I_CFL] + (size_t)b * PAST * 8; float* Fs = (float*)(F.ws + WS_FS) + (size_t)(b * 8 + h) * SKV;
        float v[4]; float run = 0.f;
#pragma unroll
        for (int i = 0; i < 4; ++i) { run += cl[(size_t)(4 * F.tid + i) * 8 + h]; v[i] = run; }
        const float off = block_excl_scan(F, run, sm);
        *(f32x4*)(Fs + 4 * F.tid) = (f32x4){(off + v[0]) * LOG2E, (off + v[1]) * LOG2E, (off + v[2]) * LOG2E, (off + v[3]) * LOG2E};
        if (F.tid == 511) { float r2 = off + run; const float* ls = F.out + O_FLS + (size_t)b * DEC_T * 8;
            for (int t = 0; t < DEC_T; ++t) { r2 += ls[t * 8 + h]; Fs[PAST + t] = r2 * LOG2E; } }
    }
}

template <bool FINAL> __device__ __forceinline__ void ln_rows(Frame& F, const float* g, const float* b, int KS, int gate_off) {
    const float* mod = (const float*)(F.ws + WS_MOD);
    const bf16_t* T = (const bf16_t*)(F.ws + WS_TB); bf16_t* X1B = (bf16_t*)(F.ws + WS_X1B); bf16_t* XN = (bf16_t*)(F.ws + WS_XN);
    const int gw = F.wave * F.G + F.bid, NGW = F.G * 8;
    for (int m = SEQ + gw; m < MT; m += NGW) {
        f32x4 v[4]; float s = 0.f;
        if (m < SEQ) {
#pragma unroll
            for (int j = 0; j < 2; ++j) { const u32x4 w = *(const u32x4*)(T + (size_t)m * DM + 8 * F.lane + 512 * j);
                v[2 * j] = (f32x4){bflo(w.x), bfhi(w.x), bflo(w.y), bfhi(w.y)}; v[2 * j + 1] = (f32x4){bflo(w.z), bfhi(w.z), bflo(w.w), bfhi(w.w)}; }
        } else {
            const float* sl = (const float*)(F.ws + WS_SLAB) + (size_t)(m - SEQ) * DM; const float* gp = mod + (size_t)(1 + ((m - SEQ) >> 4)) * 6144 + gate_off;
#pragma unroll
            for (int q = 0; q < 4; ++q) { const int k = 8 * F.lane + 512 * (q >> 1) + 4 * (q & 1); f32x4 a = (f32x4){0.f, 0.f, 0.f, 0.f};
                for (int ks = 0; ks < KS; ++ks) a += *(const f32x4*)(sl + (size_t)ks * NSMP * DM + k);
                f32x4 bs;
                if (FINAL) { const u32x2 w = *(const u32x2*)(X1B + (size_t)m * DM + k); bs = (f32x4){bflo(w.x), bfhi(w.x), bflo(w.y), bfhi(w.y)}; }
                else bs = *(const f32x4*)(F.in[I_XS] + (size_t)(m - SEQ) * DM + k);
                v[q] = bs * ALPHA + *(const f32x4*)(gp + k) * a; } }
#pragma unroll
        for (int q = 0; q < 4; ++q) s += (v[q][0] + v[q][1]) + (v[q][2] + v[q][3]);
        const float mean = wave_sum(s) * (1.f / DM); float s2 = 0.f;
#pragma unroll
        for (int q = 0; q < 4; ++q) { v[q] = v[q] - mean; s2 += (v[q][0] * v[q][0] + v[q][1] * v[q][1]) + (v[q][2] * v[q][2] + v[q][3] * v[q][3]); }
        const float rstd = 1.f / sqrtf(wave_sum(s2) * (1.f / DM) + LN_EPS);
        const int rb = m >= SEQ ? 1 + ((m - SEQ) >> 4) : 0;
#pragma unroll
        for (int q = 0; q < 4; ++q) { const int k = 8 * F.lane + 512 * (q >> 1) + 4 * (q & 1); const f32x4 gg = *(const f32x4*)(g + k), bb = *(const f32x4*)(b + k);
            const f32x4 y = v[q] * rstd * gg + bb;
            if (FINAL) *(f32x4*)(F.out + (size_t)m * DM + k) = y;
            else { u32x2 w; w.x = pk2(y[0], y[1]); w.y = pk2(y[2], y[3]); *(u32x2*)(X1B + (size_t)m * DM + k) = w;
                const f32x4 s2v = *(const f32x4*)(mod + (size_t)rb * 6144 + 4096 + k), t2v = *(const f32x4*)(mod + (size_t)rb * 6144 + 3072 + k);
                const f32x4 h = y * (s2v + 1.0f) + t2v; u32x2 w2; w2.x = pk2(h[0], h[1]); w2.y = pk2(h[2], h[3]); *(u32x2*)(XN + (size_t)m * DM + k) = w2; } }
    }
}

__device__ __forceinline__ int t5_bucket(int rel) {
    const int n = rel < 0 ? -rel : rel; int b;
    if (n < 8) b = n; else if (n < 12) b = 8; else if (n < 16) b = 9; else if (n < 23) b = 10; else if (n < 32) b = 11; else if (n < 46) b = 12; else if (n < 64) b = 13; else if (n < 91) b = 14; else b = 15;
    return b + (rel > 0 ? 16 : 0);
}
constexpr int AT_KB = 8192, AT_VB = 20480, AT_BUF = AT_KB + AT_VB;
constexpr int AT_WS = 2 * AT_BUF, AT_OST = AT_WS + 2048, AT_KEEP = 98304, AT_TAB = 131072, AT_MISC = AT_TAB + 4 * 192 * 4, AT_END = AT_MISC + 64;
__device__ __forceinline__ s16x4 vtr(const LAS char* p) { typedef short v4i16_t __attribute__((ext_vector_type(4))); return __builtin_bit_cast(s16x4, __builtin_amdgcn_ds_read_tr16_b64_v4i16((LAS v4i16_t*)p)); }

typedef __bf16 bf16x2_t_ __attribute__((ext_vector_type(2)));
__device__ __forceinline__ unsigned cvtpk_(float lo, float hi) { f32x2 v = {lo, hi}; bf16x2_t_ b = __builtin_convertvector(v, bf16x2_t_); return __builtin_bit_cast(unsigned, b); }
__device__ __forceinline__ void glds16_asm(const void* gsrc, unsigned lds_dst) { unsigned keep;
    asm volatile("s_mov_b32 %0, m0\n\ts_mov_b32 m0, %2\n\ts_nop 0\n\tglobal_load_lds_dwordx4 %1, off\n\ts_mov_b32 m0, %0" : "=&s"(keep) : "v"(gsrc), "s"(lds_dst) : "memory"); }
template <int OFF> __device__ __forceinline__ void glds16_asm_off(const void* gsrc, unsigned lds_dst) { unsigned keep;
    asm volatile("s_mov_b32 %0, m0\n\ts_mov_b32 m0, %2\n\ts_nop 0\n\tglobal_load_lds_dwordx4 %1, off offset:%3\n\ts_mov_b32 m0, %0" : "=&s"(keep) : "v"(gsrc), "s"(lds_dst), "i"(OFF) : "memory"); }
template <int OFF> __device__ __forceinline__ void glds16_s(const void* sbase, unsigned voff, unsigned lds_dst) { unsigned keep;
    asm volatile("s_mov_b32 %0, m0\n\ts_mov_b32 m0, %3\n\ts_nop 0\n\tglobal_load_lds_dwordx4 %1, %2 offset:%4\n\ts_mov_b32 m0, %0" : "=&s"(keep) : "v"(voff), "s"(sbase), "s"(lds_dst), "i"(OFF) : "memory"); }
__device__ __forceinline__ void glds4_s(const void* sbase, unsigned voff, unsigned lds_dst) { unsigned keep;
    asm volatile("s_mov_b32 %0, m0\n\ts_mov_b32 m0, %3\n\ts_nop 0\n\tglobal_load_lds_dword %1, %2\n\ts_mov_b32 m0, %0" : "=&s"(keep) : "v"(voff), "s"(sbase), "s"(lds_dst) : "memory"); }
__device__ __forceinline__ const void* uniform_ptr(const void* p) { const unsigned long long v = (unsigned long long)p;
    const unsigned lo = (unsigned)__builtin_amdgcn_readfirstlane((int)(unsigned)v), hi = (unsigned)__builtin_amdgcn_readfirstlane((int)(unsigned)(v >> 32)); return (const void*)(((unsigned long long)hi << 32) | lo); }
__device__ __forceinline__ void glds4_asm(const void* gsrc, unsigned lds_dst) { unsigned keep;
    asm volatile("s_mov_b32 %0, m0\n\ts_mov_b32 m0, %2\n\ts_nop 0\n\tglobal_load_lds_dword %1, off\n\ts_mov_b32 m0, %0" : "=&s"(keep) : "v"(gsrc), "s"(lds_dst) : "memory"); }
constexpr int R_V = 0, R_K = 49152, R_F = 73728, R_WS = 79872;
__device__ __forceinline__ float max3f_(float a, float b, float c) { float r; asm("v_max3_f32 %0, %1, %2, %3" : "=v"(r) : "v"(a), "v"(b), "v"(c)); return r; }
__device__ __forceinline__ float max2f_(float a, float b) { float r; asm("v_max_f32_e32 %0, %1, %2" : "=v"(r) : "v"(a), "v"(b)); return r; }
#define AP3_PIN(x) asm volatile("" : "+v"(x))
template <int MODE, int DV, int pv = 0, bool SREF = false>
__device__ __forceinline__ void attn_pass3(Frame& F, const bf16_t* Q, const bf16_t* K, const bf16_t* V, int q0, int NT, const float* Fh, int hb, f32x16 (&o)[DV / 32], int t0 = 0) {
    constexpr int NDB = DV / 32, VS = DV * 128, EPG = 8 / NDB;
    constexpr float THR = 8.0f;
    const int lane = F.lane, r32 = lane & 31, hi = lane >> 5, wid = F.wave;
    const LAS char* lds = (const LAS char*)F.lds;
    LAS float* wsf = (LAS float*)(F.lds + R_WS) + wid * 64;
    const LAS float* tab = (const LAS float*)(F.lds + AT_TAB) + hb * 192;
    const int qrow = q0 + wid * 32 + r32;
    const int tmaxw = (q0 >> 6) + (wid >> 1);
    const char* Ku = (const char*)uniform_ptr(K); const char* Vu = (const char*)uniform_ptr(V); const char* Fu = (const char*)uniform_ptr(MODE == 0 ? (const void*)Fh : (const void*)K);
    const unsigned kvo = (unsigned)(((8 * wid + (lane >> 3)) * 512 + (((lane & 7) ^ (lane >> 3)) << 3)) * 2);
    const unsigned vvo = (unsigned)(((16 * (wid & 3) + (lane >> 2)) * 512 + 32 * (wid >> 2) + 8 * (lane & 3)) * 2);
    const unsigned fvo = (unsigned)(lane * 4);
    const unsigned lds0 = (unsigned)(size_t)F.lds;
    const unsigned dk = (unsigned)__builtin_amdgcn_readfirstlane((int)(lds0 + R_K + wid * 1024)), dv = (unsigned)__builtin_amdgcn_readfirstlane((int)(lds0 + R_V + wid * 1024)),
                   df = (unsigned)__builtin_amdgcn_readfirstlane((int)(lds0 + R_F + wid * 256));
#define AP_ISSUE_K(t, SL) do { glds16_s<0>(Ku + (size_t)(t) * 65536, kvo, dk + (SL) * 8192); if (MODE == 0) glds4_s(Fu + (size_t)(t) * 256, fvo, df + (SL) * 2048); } while (0)
#define AP_ISSUE_V(t, SL) do { glds16_s<0>(Vu + (size_t)(t) * 65536, vvo, dv + (SL) * VS); if (DV == 128) glds16_s<0>(Vu + (size_t)(t) * 65536 + 128, vvo, dv + (SL) * VS + 8192); } while (0)
#define AP_BATCH(t, SL) do { if (pv != 1) { if ((t) + 2 < NT) AP_ISSUE_K((t) + 2, ((SL) + 2) % 3); if ((t) + 1 < NT) AP_ISSUE_V((t) + 1, ((SL) + 1) % 3); } } while (0)
    AP_ISSUE_K(t0, 0); AP_ISSUE_K(t0 + 1, 1); AP_ISSUE_V(t0, 0);
    bf16x8 qr[4];
#pragma unroll
    for (int d0 = 0; d0 < 4; ++d0) qr[d0] = *(const bf16x8*)(Q + (size_t)qrow * 512 + d0 * 16 + hi * 8);
    float fqp = MODE == 0 ? Fh[qrow] : 0.f;
#pragma unroll
    for (int d = 0; d < NDB; ++d) o[d] = f32x16{};
    float m_hat = 0.f, l_run = 0.f;
    f32x16 p0, p1, negm; u32x4 pwv[4];
#pragma unroll
    for (int r = 0; r < 16; ++r) negm[r] = 0.f;
#pragma unroll
    for (int i = 0; i < 4; ++i) pwv[i] = (u32x4){0u, 0u, 0u, 0u};
    const LAS char* kb4[4];
#pragma unroll
    for (int d0 = 0; d0 < 4; ++d0) kb4[d0] = lds + R_K + r32 * 128 + (((2 * d0 + hi) ^ (r32 & 7)) << 4);
    const LAS char* vb1 = lds + R_V + (4 * hi + ((lane & 15) >> 2)) * 64 + (((lane >> 4) & 1) * 16 + (lane & 3) * 4) * 2;
    const LAS char* fb1 = lds + R_F + wid * 256 + 16 * hi;
    asm volatile("s_waitcnt vmcnt(0)" ::: "memory");
    asm volatile("" : "+v"(qr[0]), "+v"(qr[1]), "+v"(qr[2]), "+v"(qr[3]), "+v"(fqp));
    asm volatile("s_waitcnt lgkmcnt(0)\n\ts_barrier" ::: "memory");
#define AP3_VFL(buf, ks, SLV) do { _Pragma("unroll") for (int d = 0; d < NDB; ++d) { buf[2 * d] = vtr(vb1 + (SLV) * VS + d * 4096 + (ks) * 1024); buf[2 * d + 1] = vtr(vb1 + (SLV) * VS + d * 4096 + (ks) * 1024 + 512); } } while (0)
#define AP3_VFL1(buf, d, ks, SLV) do { buf[2 * (d)] = vtr(vb1 + (SLV) * VS + (d) * 4096 + (ks) * 1024); buf[2 * (d) + 1] = vtr(vb1 + (SLV) * VS + (d) * 4096 + (ks) * 1024 + 512); } while (0)
#define AP3_FRAG(buf, d) ((bf16x8){buf[2 * (d)][0], buf[2 * (d)][1], buf[2 * (d)][2], buf[2 * (d)][3], buf[2 * (d) + 1][0], buf[2 * (d) + 1][1], buf[2 * (d) + 1][2], buf[2 * (d) + 1][3]})
#define AP3_GAP(ks, d, VCUR, VNXT, PC, BC, PP, BP, HASPREV, HASNEXT, SLV) do { \
        o[d] = __builtin_amdgcn_mfma_f32_32x32x16_bf16(__builtin_bit_cast(bf16x8, pwv[ks]), AP3_FRAG(VCUR, d), o[d], 0, 0, 0); \
        if (HASNEXT) AP3_VFL1(VNXT, d, (ks) + 1, SLV); \
        _Pragma("unroll") for (int e = 0; e < EPG; ++e) { PC[(BC) + EPG * (d) + e] = __builtin_amdgcn_exp2f(PC[(BC) + EPG * (d) + e]); } \
        if (HASPREV) { _Pragma("unroll") for (int e = 0; e < EPG; ++e) rs += PP[(BP) + EPG * (d) + e]; \
            _Pragma("unroll") for (int e = 0; e < EPG / 2; ++e) pwv[(ks) - 1][(EPG / 2) * (d) + e] = cvtpk_(PP[(BP) + EPG * (d) + 2 * e], PP[(BP) + EPG * (d) + 2 * e + 1]); AP3_PIN(rs); } \
        AP3_PIN(PC); \
        __builtin_amdgcn_sched_barrier(0); } while (0)
#define AP3_GROUP(ks, VCUR, VNXT, PC, BC, PP, BP, HASPREV, HASNEXT, SLV) do { _Pragma("unroll") for (int d = 0; d < NDB; ++d) AP3_GAP(ks, d, VCUR, VNXT, PC, BC, PP, BP, HASPREV, HASNEXT, SLV); } while (0)
#define AP3_OCT(PC, BC, KS) do { _Pragma("unroll") for (int e = 0; e < 8; ++e) { PC[(BC) + e] = __builtin_amdgcn_exp2f(PC[(BC) + e]); rs += PC[(BC) + e]; } \
        _Pragma("unroll") for (int e = 0; e < 4; ++e) pwv[KS][e] = cvtpk_(PC[(BC) + 2 * e], PC[(BC) + 2 * e + 1]); } while (0)
#define AP3_KRD(i, SL) (*(const LAS bf16x8*)(kb4[(i) >> 1] + (SL) * 8192 + ((i) & 1) * 4096))
#define AP3_MM(KF, d0, P) P = __builtin_amdgcn_mfma_f32_32x32x16_bf16(KF, qr[d0], P, 0, 0, 0)
#define AP3_QKF(SL) do { bf16x8 ka = AP3_KRD(0, SL), kb = AP3_KRD(1, SL), kc = AP3_KRD(2, SL); \
        if (MODE == 0) { \
            _Pragma("unroll") for (int g4 = 0; g4 < 4; ++g4) { const f32x4 fa = *(const LAS f32x4*)(fb1 + (SL) * 2048 + 32 * g4), fb = *(const LAS f32x4*)(fb1 + (SL) * 2048 + 128 + 32 * g4); \
                _Pragma("unroll") for (int e = 0; e < 4; ++e) { p0[4 * g4 + e] = fqp - fa[e]; p1[4 * g4 + e] = fqp - fb[e]; } } \
        } else { p0 = f32x16{}; p1 = f32x16{}; } \
        __builtin_amdgcn_sched_barrier(0); \
        AP3_MM(ka, 0, p0); ka = AP3_KRD(3, SL); __builtin_amdgcn_sched_barrier(0); \
        AP3_MM(kb, 0, p1); kb = AP3_KRD(4, SL); __builtin_amdgcn_sched_barrier(0); \
        AP3_MM(kc, 1, p0); kc = AP3_KRD(5, SL); __builtin_amdgcn_sched_barrier(0); \
        AP3_MM(ka, 1, p1); ka = AP3_KRD(6, SL); __builtin_amdgcn_sched_barrier(0); \
        AP3_MM(kb, 2, p0); kb = AP3_KRD(7, SL); __builtin_amdgcn_sched_barrier(0); \
        AP3_MM(kc, 2, p1); __builtin_amdgcn_sched_barrier(0); \
        AP3_MM(ka, 3, p0); __builtin_amdgcn_sched_barrier(0); \
        AP3_MM(kb, 3, p1); \
        asm volatile("" : "+v"(p0), "+v"(p1)); \
    } while (0)
#define AP3_QKS(SL) do { bf16x8 kf[8]; \
        _Pragma("unroll") for (int d0 = 0; d0 < 4; ++d0) { kf[2 * d0] = *(const LAS bf16x8*)(kb4[d0] + (SL) * 8192); kf[2 * d0 + 1] = *(const LAS bf16x8*)(kb4[d0] + (SL) * 8192 + 4096); } \
        if (MODE == 0) { const float sft = fqp - m_hat; \
            _Pragma("unroll") for (int g4 = 0; g4 < 4; ++g4) { const f32x4 fa = *(const LAS f32x4*)(fb1 + (SL) * 2048 + 32 * g4), fb = *(const LAS f32x4*)(fb1 + (SL) * 2048 + 128 + 32 * g4); \
                _Pragma("unroll") for (int e = 0; e < 4; ++e) { p0[4 * g4 + e] = sft - fa[e]; p1[4 * g4 + e] = sft - fb[e]; } } \
            _Pragma("unroll") for (int d0 = 0; d0 < 4; ++d0) { p0 = __builtin_amdgcn_mfma_f32_32x32x16_bf16(kf[2 * d0], qr[d0], p0, 0, 0, 0); p1 = __builtin_amdgcn_mfma_f32_32x32x16_bf16(kf[2 * d0 + 1], qr[d0], p1, 0, 0, 0); } \
        } else { \
            if constexpr (SREF) { p0 = __builtin_amdgcn_mfma_f32_32x32x16_bf16(kf[0], qr[0], f32x16{}, 0, 0, 0); p1 = __builtin_amdgcn_mfma_f32_32x32x16_bf16(kf[1], qr[0], f32x16{}, 0, 0, 0); } \
            else { p0 = __builtin_amdgcn_mfma_f32_32x32x16_bf16(kf[0], qr[0], negm, 0, 0, 0); p1 = __builtin_amdgcn_mfma_f32_32x32x16_bf16(kf[1], qr[0], negm, 0, 0, 0); } \
            _Pragma("unroll") for (int d0 = 1; d0 < 4; ++d0) { p0 = __builtin_amdgcn_mfma_f32_32x32x16_bf16(kf[2 * d0], qr[d0], p0, 0, 0, 0); p1 = __builtin_amdgcn_mfma_f32_32x32x16_bf16(kf[2 * d0 + 1], qr[d0], p1, 0, 0, 0); } } \
        if constexpr (SREF) asm volatile("" : "+v"(p0), "+v"(p1)); else asm volatile("s_nop 15\n\ts_nop 7" : "+v"(p0), "+v"(p1));     \
    } while (0)
#define AP3_QK(SL) do { if constexpr (SREF) AP3_QKF(SL); else AP3_QKS(SL); } while (0)
#define AP3_DECIDE(WITH_TAB) do { \
        if (MODE == 0) { \
            if (t * 64 + 63 > q0 + wid * 32) { const int ln_ = lane_id_opaque(), kv0 = t * 64 + 4 * (ln_ >> 5), qrow_ = q0 + wid * 32 + (ln_ & 31);     \
                _Pragma("unroll") for (int r = 0; r < 16; ++r) { const int kv = kv0 + (r & 3) + 8 * (r >> 2); if (kv > qrow_) p0[r] = -1e30f; if (kv + 32 > qrow_) p1[r] = -1e30f; } } \
        } else if (WITH_TAB) { \
            if (near) { const int ln_ = lane_id_opaque(), kv0 = t * 64 + 4 * (ln_ >> 5), qrow_ = q0 + wid * 32 + (ln_ & 31); const LAS float* tab_ = (const LAS float*)(F.lds + AT_TAB) + hb * 192; \
                _Pragma("unroll") for (int g4 = 0; g4 < 4; ++g4) { \
                    _Pragma("unroll") for (int e = 0; e < 4; ++e) { const int r = 4 * g4 + e; const int rel = kv0 + e + 8 * g4 - qrow_; int i0 = rel + 128, i1 = rel + 160; i0 = i0 < 0 ? 0 : i0; i1 = i1 < 0 ? 0 : i1; \
                        p0[r] += tab_[i0]; p1[r] += tab_[i1]; } \
                    __builtin_amdgcn_sched_barrier(0); } } } \
        if constexpr (!SREF) { \
        float ma = max3f_(p0[0], p0[1], p1[0]), mb = max3f_(p0[2], p0[3], p1[1]); ma = max3f_(ma, p1[2], p1[3]); \
        _Pragma("unroll") for (int r = 4; r < 16; r += 4) { ma = max3f_(ma, p0[r], p0[r + 1]); mb = max3f_(mb, p0[r + 2], p0[r + 3]); ma = max3f_(ma, p1[r], p1[r + 1]); mb = max3f_(mb, p1[r + 2], p1[r + 3]); } \
        float rm = max2f_(ma, mb); \
        { auto rr = __builtin_amdgcn_permlane32_swap(__float_as_uint(rm), __float_as_uint(rm), false, false); rm = max2f_(__uint_as_float(rr[0]), __uint_as_float(rr[1])); } \
        resc = (tz == t0) || __any(rm > THR); \
        if (resc) { const float dl = tz == t0 ? rm : fmaxf(rm, 0.f); m_hat += dl; \
            _Pragma("unroll") for (int r = 0; r < 16; ++r) { p0[r] -= dl; p1[r] -= dl; } \
            if (MODE == 1) { const float nm_ = -m_hat; _Pragma("unroll") for (int r = 0; r < 16; ++r) negm[r] = nm_; } \
            al = tz == t0 ? 1.0f : __builtin_amdgcn_exp2f(-dl); l_run *= al; } } } while (0)
#define AP3_STEP(tt, SL) do { const int t = (tt); if (t > NT) break; int tz = t; asm volatile("" : "+s"(tz)); \
        if (t < NT) AP_BATCH(t, SL); \
        const bool doPV = tz > t0 && t - 1 <= tmaxw, doQK = t < NT && t <= tmaxw; \
        bool resc = false; float al = 1.0f, rs = 0.f; \
        const bool near = MODE == 1 && (t * 64 + 63 + 91 > q0 + wid * 32); \
        if (doQK) AP3_QK(SL); else { p0 = f32x16{}; p1 = f32x16{}; }     \
        __builtin_amdgcn_sched_barrier(0); \
        if (doQK) AP3_DECIDE(true); \
        __builtin_amdgcn_sched_barrier(0); \
        if (doPV) { s16x4 vfa[2 * NDB]; AP3_VFL(vfa, 0, ((SL) + 2) % 3);     \
            AP3_GROUP(0, vfa, vfa, p0, 0, p0, 0, false, true, ((SL) + 2) % 3); \
            AP3_GROUP(1, vfa, vfa, p0, 8, p0, 0, true, true, ((SL) + 2) % 3); \
            AP3_GROUP(2, vfa, vfa, p1, 0, p0, 8, true, true, ((SL) + 2) % 3); \
            AP3_GROUP(3, vfa, vfa, p1, 8, p1, 0, true, false, ((SL) + 2) % 3); \
            _Pragma("unroll") for (int e = 0; e < 8; ++e) rs += p1[8 + e]; \
            _Pragma("unroll") for (int e = 0; e < 4; ++e) pwv[3][e] = cvtpk_(p1[8 + 2 * e], p1[8 + 2 * e + 1]); \
        } else if (doQK) { AP3_OCT(p0, 0, 0); AP3_OCT(p0, 8, 1); AP3_OCT(p1, 0, 2); AP3_OCT(p1, 8, 3); } \
        if (doQK) l_run += rs; \
          \
        if (resc && tz > t0) { \
            if (hi == 0) wsf[r32] = al; \
            asm volatile("s_waitcnt lgkmcnt(0)" ::: "memory"); \
            _Pragma("unroll") for (int g4 = 0; g4 < 4; ++g4) { const f32x4 a4 = *(const LAS f32x4*)(wsf + 8 * g4 + 4 * hi); \
                _Pragma("unroll") for (int d = 0; d < NDB; ++d) \
                    _Pragma("unroll") for (int e = 0; e < 4; ++e) o[d][4 * g4 + e] *= a4[e]; } } \
        if (t == NT) break; \
        if (pv == 6) { if (t + 2 < NT) asm volatile("s_waitcnt vmcnt(3) lgkmcnt(0)" ::: "memory"); else asm volatile("s_waitcnt vmcnt(0) lgkmcnt(0)" ::: "memory"); } \
        else { if (t + 2 < NT) asm volatile("s_waitcnt vmcnt(3) lgkmcnt(0)\n\ts_barrier" ::: "memory"); else asm volatile("s_waitcnt vmcnt(0) lgkmcnt(0)\n\ts_barrier" ::: "memory"); } \
    } while (0)
#define AP3_FSTEP(tt, SL) do { const int t = (tt); \
        AP_ISSUE_K(t + 2, ((SL) + 2) % 3); AP_ISSUE_V(t + 1, ((SL) + 1) % 3); \
        float rs = 0.f; \
        AP3_QKF(SL); \
        __builtin_amdgcn_sched_barrier(0); \
        { s16x4 vfa[2 * NDB]; AP3_VFL(vfa, 0, ((SL) + 2) % 3); \
          AP3_GROUP(0, vfa, vfa, p0, 0, p0, 0, false, true, ((SL) + 2) % 3); \
          AP3_GROUP(1, vfa, vfa, p0, 8, p0, 0, true, true, ((SL) + 2) % 3); \
          AP3_GROUP(2, vfa, vfa, p1, 0, p0, 8, true, true, ((SL) + 2) % 3); \
          AP3_GROUP(3, vfa, vfa, p1, 8, p1, 0, true, false, ((SL) + 2) % 3); \
          _Pragma("unroll") for (int e = 0; e < 8; ++e) rs += p1[8 + e]; \
          _Pragma("unroll") for (int e = 0; e < 4; ++e) pwv[3][e] = cvtpk_(p1[8 + 2 * e], p1[8 + 2 * e + 1]); } \
        l_run += rs; \
        asm volatile("s_waitcnt vmcnt(3) lgkmcnt(0)\n\ts_barrier" ::: "memory"); \
    } while (0)
    if (wid >= 4) __builtin_amdgcn_s_setprio(1);
    int t3 = t0;
    if constexpr (SREF && pv == 0) {
        AP3_STEP(t3, 0); AP3_STEP(t3 + 1, 1); AP3_STEP(t3 + 2, 2); t3 += 3;
        const int tfe = (q0 >> 6) - 3;
        for (; t3 + 2 <= tfe; t3 += 3) { AP3_FSTEP(t3, 0); AP3_FSTEP(t3 + 1, 1); AP3_FSTEP(t3 + 2, 2); }
    }
    for (; t3 <= NT; t3 += 3) { AP3_STEP(t3, 0); AP3_STEP(t3 + 1, 1); AP3_STEP(t3 + 2, 2); }
    if (wid >= 4) __builtin_amdgcn_s_setprio(0);
    asm volatile("s_waitcnt lgkmcnt(0)\n\ts_barrier" ::: "memory");
    l_run += __shfl_xor(l_run, 32);
    if (hi == 0) wsf[r32] = 1.0f / l_run;
    asm volatile("s_waitcnt lgkmcnt(0)" ::: "memory");
#pragma unroll
    for (int g4 = 0; g4 < 4; ++g4) { const f32x4 a4 = *(const LAS f32x4*)(wsf + 8 * g4 + 4 * hi);
#pragma unroll
        for (int d = 0; d < NDB; ++d)
#pragma unroll
            for (int e = 0; e < 4; ++e) o[d][4 * g4 + e] *= a4[e]; }
#undef AP_ISSUE_K
#undef AP_ISSUE_V
#undef AP_BATCH
#undef AP3_VFL
#undef AP3_VFL1
#undef AP3_FRAG
#undef AP3_GAP
#undef AP3_GROUP
#undef AP3_OCT
#undef AP3_STEP
#undef AP3_FSTEP
#undef AP3_QK
#undef AP3_QKF
#undef AP3_QKS
#undef AP3_KRD
#undef AP3_MM
#undef AP3_DECIDE
}

template <int NDB> __device__ __forceinline__ void store_o(const f32x16 (&o)[NDB], LAS unsigned char* stgb  , bf16_t* dst  , int ld, int lane) {
    const int r32 = lane & 31, hi = lane >> 5;
    constexpr int DVC = 32 * NDB;
    LAS bf16_t* stg = (LAS bf16_t*)stgb;
#pragma unroll
    for (int d = 0; d < NDB; ++d)
#pragma unroll
        for (int r = 0; r < 16; ++r) { const int row = (r & 3) + 8 * (r >> 2) + 4 * hi; stg[row * DVC + 32 * d + r32] = (bf16_t)f2bf(o[d][r]); }
    asm volatile("s_waitcnt lgkmcnt(0)" ::: "memory");
    constexpr int CPR = DVC / 8;
#pragma unroll
    for (int i = 0; i < (32 * CPR) / 64; ++i) { const int c = i * 64 + lane, row = c / CPR, ch = c % CPR;
        const u32x4 v = *(const LAS u32x4*)(stg + row * DVC + ch * 8); *(u32x4*)(dst + (size_t)row * ld + ch * 8) = v; }
    asm volatile("s_waitcnt lgkmcnt(0)" ::: "memory");
}

__device__ __forceinline__ float lambda_full(Frame& F) {
    float a = 0.f, b = 0.f;
    for (int i = 0; i < 64; ++i) { a += F.in[I_LQ1][i] * F.in[I_LK1][i]; b += F.in[I_LQ2][i] * F.in[I_LK2][i]; }
    return __expf(a) - __expf(b) + 0.2f;
}

template <int pv = 0> __device__ __forceinline__ void attn_prompt_fox(Frame& F, int h, int qb) {
    const bf16_t* Q = (const bf16_t*)(F.ws + WS_QB) + h * 64; const bf16_t* K = (const bf16_t*)(F.ws + WS_KB) + h * 64; const bf16_t* V = (const bf16_t*)(F.ws + WS_VB) + h * 64;
    f32x16 o[2];
    const float* Fh = (const float*)(F.ws + WS_FP) + (size_t)h * SEQ;
    int t0 = 0; bool fast;
    { const unsigned* nw = (const unsigned*)(F.ws + WS_CTL) + 256;
      const float qn2 = __uint_as_float(nw[h * 2]) + __uint_as_float(nw[h * 2 + 1]), kn2 = __uint_as_float(nw[16 + h * 2]) + __uint_as_float(nw[16 + h * 2 + 1]);
      const float B = sqrtf(qn2 * kn2) * 1.02f + 0.5f;
      const float thresh = -48.0f - 2.0f * B;
      fast = __builtin_amdgcn_readfirstlane(B <= 60.0f ? 1 : 0) != 0;
      volatile LAS int* cnt = (volatile LAS int*)(F.lds + AT_MISC + 32);
      __syncthreads();
      if (F.tid < 256) { const int t = F.tid; const bool sk = t < 4 * qb && (Fh[qb * 256] - Fh[64 * t + 63]) <= thresh;
          const int c = __popcll(__ballot(sk)); if (F.lane == 0) cnt[F.wave] = c; }
      __syncthreads();
      t0 = cnt[0] + cnt[1] + cnt[2] + cnt[3]; t0 -= t0 % 3; }
    if (fast) attn_pass3<0, 64, pv, true>(F, Q, K, V, qb * 256, 4 * qb + 4, Fh, 0, o, t0); else attn_pass3<0, 64, pv, false>(F, Q, K, V, qb * 256, 4 * qb + 4, Fh, 0, o, t0);
    if (pv != 0 && o[0][0] != 1234.5678f) { __syncthreads(); return; }
    bf16_t* AB = (bf16_t*)(F.ws + WS_AB);
    store_o<2>(o, F.lds + F.wave * 8192, AB + (size_t)(qb * 256 + F.wave * 32) * DM + 512 + h * 64, DM, F.lane);
    __syncthreads();
}
template <int pv = 0> __device__ __forceinline__ void attn_prompt_diff_half(Frame& F, int h, int half, int qb) {
    const bf16_t* Q = (const bf16_t*)(F.ws + WS_QA) + h * 128 + 64 * half; const bf16_t* K = (const bf16_t*)(F.ws + WS_KA) + h * 128 + 64 * half; const bf16_t* V = (const bf16_t*)(F.ws + WS_VA) + h * 128;
    f32x16 o[4];
    bool fast;
    { const unsigned* nw = (const unsigned*)(F.ws + WS_CTL) + 288; const int hh = h * 2 + half;
      const float qn2 = __uint_as_float(nw[hh * 2]) + __uint_as_float(nw[hh * 2 + 1]), kn2 = __uint_as_float(nw[16 + hh * 2]) + __uint_as_float(nw[16 + hh * 2 + 1]);
      float bm = 0.f; for (int b = 0; b < 32; ++b) bm = fmaxf(bm, fabsf(F.in[I_RELB][b * 4 + h] - F.in[I_RELB][15 * 4 + h]));
      const float B = sqrtf(qn2 * kn2) * 1.02f + 0.5f + bm * LOG2E;
      fast = __builtin_amdgcn_readfirstlane(B <= 60.0f ? 1 : 0) != 0; }
    if (fast) attn_pass3<1, 128, pv, true>(F, Q, K, V, qb * 256, 4 * qb + 4, nullptr, h, o); else attn_pass3<1, 128, pv, false>(F, Q, K, V, qb * 256, 4 * qb + 4, nullptr, h, o);
    if (pv != 0 && o[0][0] != 1234.5678f) { __syncthreads(); return; }
    bf16_t* OD = (bf16_t*)(F.ws + (half ? WS_OD2 : WS_OD1));
    store_o<4>(o, F.lds + F.wave * 8192, OD + (size_t)(qb * 256 + F.wave * 32) * 512 + h * 128, 512, F.lane);
    __syncthreads();
}
constexpr int PF_STR = 66, PD_STR = 130;
__device__ __forceinline__ void p_combine(Frame& F) {
    const float lam = lambda_full(F);
    const bf16_t* O1 = (const bf16_t*)(F.ws + WS_OD1); const bf16_t* O2 = (const bf16_t*)(F.ws + WS_OD2); bf16_t* AB = (bf16_t*)(F.ws + WS_AB);
    const int gw = F.bid * 8 + F.wave, NGW = F.G * 8;
    const int c0 = 8 * F.lane;
    float sg[8];
#pragma unroll
    for (int i = 0; i < 8; ++i) sg[i] = F.in[I_SUBG][(c0 & 127) + i] * 0.8f;
    for (int m = gw; m < SEQ; m += NGW) {
        const u32x4 a = *(const u32x4*)(O1 + (size_t)m * 512 + c0), b = *(const u32x4*)(O2 + (size_t)m * 512 + c0);
        float v[8];
        v[0] = bflo(a.x) - lam * bflo(b.x); v[1] = bfhi(a.x) - lam * bfhi(b.x); v[2] = bflo(a.y) - lam * bflo(b.y); v[3] = bfhi(a.y) - lam * bfhi(b.y);
        v[4] = bflo(a.z) - lam * bflo(b.z); v[5] = bfhi(a.z) - lam * bfhi(b.z); v[6] = bflo(a.w) - lam * bflo(b.w); v[7] = bfhi(a.w) - lam * bfhi(b.w);
        float ss = 0.f;
#pragma unroll
        for (int i = 0; i < 8; ++i) ss += v[i] * v[i];
#pragma unroll
        for (int ofs = 1; ofs < 16; ofs <<= 1) ss += __shfl_xor(ss, ofs);
        const float rn = 1.0f / sqrtf(ss * (1.0f / 128.0f) + LN_EPS);
        u32x4 w; w.x = pk2(v[0] * rn * sg[0], v[1] * rn * sg[1]); w.y = pk2(v[2] * rn * sg[2], v[3] * rn * sg[3]); w.z = pk2(v[4] * rn * sg[4], v[5] * rn * sg[5]); w.w = pk2(v[6] * rn * sg[6], v[7] * rn * sg[7]);
        *(u32x4*)(AB + (size_t)m * DM + c0) = w;
    }
    for (int it = gw; it < NSMP; it += NGW) {
        const int b = it >> 4, q = it & 15; const size_t row = (size_t)SEQ + it;
        {
            const int h = F.lane >> 3, cc = (F.lane & 7) * 8; const float* P = (const float*)(F.ws + WS_PF);
            float M = -1e30f;
            for (int s = 0; s < 8; ++s) M = fmaxf(M, P[((size_t)((b * 8 + s) * 8 + h) * 16 + q) * PF_STR + 64]);
            float acc[8], L = 0.f;
#pragma unroll
            for (int i = 0; i < 8; ++i) acc[i] = 0.f;
            for (int s = 0; s < 8; ++s) { const float* pr = P + ((size_t)((b * 8 + s) * 8 + h) * 16 + q) * PF_STR; const float wgt = __builtin_amdgcn_exp2f(pr[64] - M); L += wgt * pr[65];
#pragma unroll
                for (int i = 0; i < 8; ++i) acc[i] += wgt * pr[cc + i]; }
            const float inv = 1.0f / L;
            u32x4 w; w.x = pk2(acc[0] * inv, acc[1] * inv); w.y = pk2(acc[2] * inv, acc[3] * inv); w.z = pk2(acc[4] * inv, acc[5] * inv); w.w = pk2(acc[6] * inv, acc[7] * inv);
            *(u32x4*)(AB + row * DM + 512 + c0) = w; }
        {
            const int h = F.lane >> 4, cc = (F.lane & 15) * 8; const float* P = (const float*)(F.ws + WS_PD);
            float v[8];
#pragma unroll
            for (int i = 0; i < 8; ++i) v[i] = 0.f;
#pragma unroll
            for (int half = 0; half < 2; ++half) {
                float M = -1e30f;
                for (int s = 0; s < 8; ++s) M = fmaxf(M, P[((size_t)((b * 8 + s) * 8 + 2 * h + half) * 16 + q) * PD_STR + 128]);
                float acc[8], L = 0.f;
#pragma unroll
                for (int i = 0; i < 8; ++i) acc[i] = 0.f;
                for (int s = 0; s < 8; ++s) { const float* pr = P + ((size_t)((b * 8 + s) * 8 + 2 * h + half) * 16 + q) * PD_STR; const float wgt = __builtin_amdgcn_exp2f(pr[128] - M); L += wgt * pr[129];
#pragma unroll
                    for (int i = 0; i < 8; ++i) acc[i] += wgt * pr[cc + i]; }
                const float sc = (half ? -lam : 1.0f) / L;
#pragma unroll
                for (int i = 0; i < 8; ++i) v[i] += acc[i] * sc; }
            float ss = 0.f;
#pragma unroll
            for (int i = 0; i < 8; ++i) ss += v[i] * v[i];
#pragma unroll
            for (int ofs = 1; ofs < 16; ofs <<= 1) ss += __shfl_xor(ss, ofs);
            const float rn = 1.0f / sqrtf(ss * (1.0f / 128.0f) + LN_EPS);
            u32x4 w; w.x = pk2(v[0] * rn * sg[0], v[1] * rn * sg[1]); w.y = pk2(v[2] * rn * sg[2], v[3] * rn * sg[3]); w.z = pk2(v[4] * rn * sg[4], v[5] * rn * sg[5]); w.w = pk2(v[6] * rn * sg[6], v[7] * rn * sg[7]);
            *(u32x4*)(AB + row * DM + c0) = w; }
    }
}

constexpr int SM_K = 0, SM_V = 32768, SM_F = 81920, SM_WS = 83968;
template <int KIND  > __device__ __forceinline__ void sample_unit(Frame& F, int b, int s) {
    constexpr int DV = KIND == 0 ? 64 : 128, NDB = DV / 32, VSTR = KIND == 0 ? 192 : 320, VSUB = 16 * VSTR;
    const int lane = lane_id_opaque(), r32 = lane & 31, hi = lane >> 5, w = F.wave, tid = w * 64 + lane;
    const LAS char* lds = (const LAS char*)F.lds;
    LAS float* wsf = (LAS float*)(F.lds + SM_WS) + w * 64;
    const int hb = KIND == 0 ? w : (w >> 1);
    const LAS float* tab = (const LAS float*)(F.lds + AT_TAB) + hb * 192;
    const int q = r32 & 15, qpos = PAST + q;
    const size_t qrow = (size_t)SEQ + b * DEC_T + q;
    const bf16_t* Qp = (const bf16_t*)(F.ws + (KIND == 0 ? WS_QB : WS_QA)) + qrow * 512 + w * 64;
    bf16x8 qr[4];
#pragma unroll
    for (int d0 = 0; d0 < 4; ++d0) qr[d0] = *(const bf16x8*)(Qp + d0 * 16 + hi * 8);
    const float* Fs = (const float*)(F.ws + WS_FS) + (size_t)(b * 8 + w) * SKV;
    const float fq = KIND == 0 ? Fs[qpos] : 0.f;
    const float* Kc = F.in[KIND == 0 ? I_CFK : I_CDK] + (size_t)b * PAST * 512; const float* Vc = F.in[KIND == 0 ? I_CFV : I_CDV] + (size_t)b * PAST * 512;
    const float* Kn = F.out + (KIND == 0 ? O_FKS : O_DKS) + (size_t)b * DEC_T * 512; const float* Vn = F.out + (KIND == 0 ? O_FVS : O_DVS) + (size_t)b * DEC_T * 512;
    const int kr = tid >> 5, c16 = (tid & 31) * 16;
    const int ksub = c16 >> 6, kch = (c16 >> 3) & 7;
    const int kdst = SM_K + ksub * 4096 + kr * 128;
    const int vdst = KIND == 0 ? SM_V + ksub * VSUB + kr * VSTR + kch * 16 : SM_V + (c16 >> 7) * VSUB + kr * VSTR + ((c16 >> 3) & 15) * 16;
    f32x16 o[NDB];
#pragma unroll
    for (int d = 0; d < NDB; ++d) o[d] = f32x16{};
    float m_run = -1e30f, l_run = 0.f;
    f32x4 gkA[4], gvA[4], gkB[4], gvB[4]; float gfA = 0.f, gfB = 0.f;
    const int nt = s == 0 ? 17 : 16;
    auto gload = [&](f32x4 (&gk)[4], f32x4 (&gv)[4], float& gf, int t) {
        const float* ks; const float* vs;
        if (t < 128) { ks = Kc + (size_t)(16 * t + kr) * 512 + c16; vs = Vc + (size_t)(16 * t + kr) * 512 + c16; }
        else { ks = Kn + (size_t)kr * 512 + c16; vs = Vn + (size_t)kr * 512 + c16; }
#pragma unroll
        for (int j = 0; j < 4; ++j) { gk[j] = *(const f32x4*)(ks + 4 * j); gv[j] = *(const f32x4*)(vs + 4 * j); }
        if (KIND == 0 && tid < 128) gf = ((const float*)(F.ws + WS_FS))[(size_t)(b * 8 + (tid >> 4)) * SKV + 16 * t + (tid & 15)];
    };
    auto lwrite = [&](const f32x4 (&gk)[4], const f32x4 (&gv)[4], float gf) {
#pragma unroll
        for (int j = 0; j < 2; ++j) { u32x4 wk, wv;
            wk.x = pk2(gk[2 * j][0], gk[2 * j][1]); wk.y = pk2(gk[2 * j][2], gk[2 * j][3]); wk.z = pk2(gk[2 * j + 1][0], gk[2 * j + 1][1]); wk.w = pk2(gk[2 * j + 1][2], gk[2 * j + 1][3]);
            wv.x = pk2(gv[2 * j][0], gv[2 * j][1]); wv.y = pk2(gv[2 * j][2], gv[2 * j][3]); wv.z = pk2(gv[2 * j + 1][0], gv[2 * j + 1][1]); wv.w = pk2(gv[2 * j + 1][2], gv[2 * j + 1][3]);
            *(LAS u32x4*)(F.lds + kdst + (((kch + j) ^ (kr & 7)) << 4)) = wk;
            *(LAS u32x4*)(F.lds + vdst + j * 16) = wv; }
        if (KIND == 0 && tid < 128) ((LAS float*)(F.lds + SM_F))[tid] = gf;
    };
    gload(gkA, gvA, gfA, s); gload(gkB, gvB, gfB, s + 8);
    __syncthreads();
    { const int sub = tid >> 6, rr = 16 + ((tid >> 2) & 15), cq = (tid & 3) * 32;
      *(LAS u32x4*)(F.lds + SM_K + sub * 4096 + rr * 128 + cq) = (u32x4){0u, 0u, 0u, 0u}; *(LAS u32x4*)(F.lds + SM_K + sub * 4096 + rr * 128 + cq + 16) = (u32x4){0u, 0u, 0u, 0u}; }
    const int vb = SM_V + (KIND == 0 ? w : (w >> 1)) * VSUB + (4 * hi + ((lane & 15) >> 2)) * VSTR + (((lane >> 4) & 1) * 16 + (lane & 3) * 4) * 2;
    auto compute = [&](int t) {
        f32x16 p0 = f32x16{};
#pragma unroll
        for (int d0 = 0; d0 < 4; ++d0) { const bf16x8 kf = *(const LAS bf16x8*)(lds + SM_K + w * 4096 + r32 * 128 + (((2 * d0 + hi) ^ (r32 & 7)) << 4));
            p0 = __builtin_amdgcn_mfma_f32_32x32x16_bf16(kf, qr[d0], p0, 0, 0, 0); }
        const int kv0 = 16 * t + 4 * hi;
        float x[8];
        if (KIND == 0) {
#pragma unroll
            for (int g4 = 0; g4 < 2; ++g4) { const f32x4 fa = *(const LAS f32x4*)(lds + SM_F + (w * 16 + 4 * hi + 8 * g4) * 4);
#pragma unroll
                for (int e = 0; e < 4; ++e) x[4 * g4 + e] = p0[4 * g4 + e] + (fq - fa[e]); }
            if (t == 128) {
#pragma unroll
                for (int r = 0; r < 8; ++r) { const int kv = kv0 + (r & 3) + 8 * (r >> 2); if (kv > qpos) x[r] = -1e30f; } }
        } else {
            if (t < 120) {
#pragma unroll
                for (int r = 0; r < 8; ++r) x[r] = p0[r];
            } else {
#pragma unroll
                for (int r = 0; r < 8; ++r) { const int kv = kv0 + (r & 3) + 8 * (r >> 2); int i0 = kv - qpos + 128; i0 = i0 < 0 ? 0 : i0; x[r] = p0[r] + tab[i0]; } }
        }
        float rm = x[0];
#pragma unroll
        for (int r = 1; r < 8; ++r) rm = fmaxf(rm, x[r]);
        rm = fmaxf(rm, __shfl_xor(rm, 32));
        const float m_new = fmaxf(m_run, rm);
        if (__any(m_new > m_run)) { const float al = __builtin_amdgcn_exp2f(m_run - m_new); l_run *= al; m_run = m_new;
            if (hi == 0) wsf[r32] = al;
            asm volatile("s_waitcnt lgkmcnt(0)" ::: "memory");
#pragma unroll
            for (int g4 = 0; g4 < 2; ++g4) { const f32x4 a4 = *(const LAS f32x4*)(wsf + 8 * g4 + 4 * hi);
#pragma unroll
                for (int d = 0; d < NDB; ++d)
#pragma unroll
                    for (int e = 0; e < 4; ++e) o[d][4 * g4 + e] *= a4[e]; } }
        float rs = 0.f;
#pragma unroll
        for (int r = 0; r < 8; ++r) { x[r] = __builtin_amdgcn_exp2f(x[r] - m_run); rs += x[r]; }
        l_run += rs;
        u32x4 w0; w0.x = pg8::cvt_pk_bf16(x[0], x[1]); w0.y = pg8::cvt_pk_bf16(x[2], x[3]); w0.z = pg8::cvt_pk_bf16(x[4], x[5]); w0.w = pg8::cvt_pk_bf16(x[6], x[7]);
        const bf16x8 pa = __builtin_bit_cast(bf16x8, w0);
#pragma unroll
        for (int d = 0; d < NDB; ++d) { const LAS char* vp = lds + vb + d * 64;
            const s16x4 lo = vtr(vp), hi4 = vtr(vp + 8 * VSTR);
            const bf16x8 vf = (bf16x8){lo[0], lo[1], lo[2], lo[3], hi4[0], hi4[1], hi4[2], hi4[3]};
            o[d] = __builtin_amdgcn_mfma_f32_32x32x16_bf16(pa, vf, o[d], 0, 0, 0); }
    };
    for (int i = 0; i < nt; i += 2) {
        const int t = s + 8 * i;
        lwrite(gkA, gvA, gfA); __syncthreads();
        if (i + 2 < nt) gload(gkA, gvA, gfA, t + 16);
        compute(t);
        __syncthreads();
        if (i + 1 >= nt) break;
        lwrite(gkB, gvB, gfB); __syncthreads();
        if (i + 3 < nt) gload(gkB, gvB, gfB, t + 24);
        compute(t + 8);
        __syncthreads();
    }
    l_run += __shfl_xor(l_run, 32);
    float* P = (float*)(F.ws + (KIND == 0 ? WS_PF : WS_PD)) + ((size_t)((b * 8 + s) * 8 + w) * 16) * (DV + 2);
    { float* P0 = P + (size_t)(4 * hi) * (DV + 2) + r32; float* P1 = P0 + 8 * (DV + 2);
#pragma unroll
      for (int d = 0; d < NDB; ++d)
#pragma unroll
          for (int r = 0; r < 4; ++r) { P0[r * (DV + 2) + 32 * d] = o[d][r]; P1[r * (DV + 2) + 32 * d] = o[d][4 + r]; } }
    if (lane < 16) { P[(size_t)lane * (DV + 2) + DV] = m_run; P[(size_t)lane * (DV + 2) + DV + 1] = l_run; }
}

template <int pv = 0> __device__ __forceinline__ void p3_attention(Frame& F, int mask) {
    LAS float* tab = (LAS float*)(F.lds + AT_TAB);
    for (int i = F.tid; i < 4 * 192; i += 512) { const int h = i / 192, rel = (i % 192) - 128; tab[i] = (F.in[I_RELB][t5_bucket(rel) * 4 + h] - F.in[I_RELB][15 * 4 + h]) * LOG2E; }
    const float lam = lambda_full(F);
    __syncthreads();
    const int x = F.bid & 7, p = (F.bid >> 3) & 31;
    const int spos = F.G == 256 ? (x + p) % 5 : 4;
    for (int j = 0; j < 5; ++j) {
        F.lane = lane_id_opaque(); F.tid = F.wave * 64 + F.lane;
        if (j == spos) {
            if (mask & 4) {
                for (int u = F.bid; u < 256; u += F.G) {
                    F.lane = lane_id_opaque(); F.tid = F.wave * 64 + F.lane;
                    if ((u >> 3) & 1) sample_unit<1>(F, u >> 4, u & 7); else sample_unit<0>(F, u >> 4, u & 7);
                }
            }
        } else if (F.bid < 256) {
            const int i = j - (j > spos ? 1 : 0);
            const int qb = (i & 1) ? p : 63 - p;
            if (i < 2) { if (mask & 1) attn_prompt_diff_half<pv>(F, x >> 1, x & 1, qb); }
            else { if (mask & 2) attn_prompt_fox<pv>(F, x, qb); }
        }
    }
}

__device__ __forceinline__ void slab_publish(Frame& F, int word, int nun) {
    int n = 0; for (int L = F.bid; L < nun; L += F.G) ++n;
    asm volatile("s_waitcnt vmcnt(0)" ::: "memory");
    __syncthreads();
    if (F.tid == 0 && n > 0) { __builtin_amdgcn_fence(__ATOMIC_RELEASE, "agent"); asm volatile("s_waitcnt vmcnt(0)" ::: "memory");
        __hip_atomic_fetch_add((unsigned*)(F.ws + WS_CTL) + word, (unsigned)n, __ATOMIC_RELAXED, __HIP_MEMORY_SCOPE_AGENT); }
}
__device__ __forceinline__ void slab_wait(Frame& F, int word, int nun) {
    if (F.tid == 0) { unsigned* w = (unsigned*)(F.ws + WS_CTL) + word; unsigned sp = 0;
        while (__hip_atomic_load(w, __ATOMIC_RELAXED, __HIP_MEMORY_SCOPE_AGENT) < (unsigned)nun && ++sp < (1u << 22)) __builtin_amdgcn_s_sleep(2);
        __builtin_amdgcn_fence(__ATOMIC_ACQUIRE, "agent"); asm volatile("s_waitcnt vmcnt(0)" ::: "memory"); }
    __syncthreads();
}

#define XB_TMO      128
#define XB_XCNT(j)  (256  + 64 * (j))
#define XB_XSUB(j)  (1280 + 64 * (j))
#define XB_XGEN(j)  (2304 + 64 * (j))
#define XB_TOP      3328
#define XB_TOPGEN   3392
#define XCD_BAR_WORDS 3456
#define XB_SPIN_CAP (1u << 20)
__device__ __forceinline__ unsigned xb_ld(unsigned* p)              { return __hip_atomic_load(p, __ATOMIC_RELAXED, __HIP_MEMORY_SCOPE_AGENT); }
__device__ __forceinline__ unsigned xb_add(unsigned* p, unsigned v) { return __hip_atomic_fetch_add(p, v, __ATOMIC_RELAXED, __HIP_MEMORY_SCOPE_AGENT); }
__device__ __forceinline__ unsigned xb_xcc_id() { return (unsigned)__builtin_amdgcn_s_getreg((3 << 11) | 20) & 0xFu; }
#define XB_SPIN(cond, bar) do { unsigned _sp = 0; while (cond) { __builtin_amdgcn_s_sleep(1); \
    if ((++_sp & 255u) == 0u) { if (xb_ld(&(bar)[XB_TMO])) break; if (_sp > XB_SPIN_CAP) { atomicAdd(&(bar)[XB_TMO], 1u); break; } } } } while (0)
struct XcdBarrier { unsigned* bar; unsigned x; volatile LAS unsigned* st; };
__device__ __forceinline__ XcdBarrier xcd_barrier_post(unsigned* bar, volatile LAS unsigned* st) {
    XcdBarrier b; b.bar = bar; b.x = xb_xcc_id(); b.st = st;
    if (threadIdx.x == 0) (void)xb_add(&bar[XB_XCNT(b.x)], 1u);
    return b;
}
__device__ __forceinline__ void xcd_barrier_complete(unsigned* bar, unsigned x, unsigned& nloc, unsigned& nx) {
    const unsigned G = gridDim.x * gridDim.y * gridDim.z;
    unsigned sum, cnt, mine, sp = 0u;
    for (;;) {
        sum = 0u; cnt = 0u; mine = 0u;
#pragma unroll
        for (unsigned j = 0; j < 16; ++j) { const unsigned c = xb_ld(&bar[XB_XCNT(j)]); sum += c; cnt += (c > 0u) ? 1u : 0u; mine = (j == x) ? c : mine; }
        if (sum == G) break;
        __builtin_amdgcn_s_sleep(1);
        if ((++sp & 255u) == 0u) { if (xb_ld(&bar[XB_TMO])) break; if (sp > XB_SPIN_CAP) { atomicAdd(&bar[XB_TMO], 1u); break; } }
    }
    nloc = mine > 0u ? mine : 1u; nx = cnt > 0u ? cnt : 1u;
}
__device__ __forceinline__ void xcd_barrier(const XcdBarrier& b) {
    asm volatile("s_waitcnt vmcnt(0)" ::: "memory");
    __syncthreads();
    if (threadIdx.x == 0) {
        unsigned* bar = b.bar;
        __builtin_amdgcn_s_waitcnt(0);
        unsigned nloc = b.st[0], nx = b.st[1];
        if (nloc == 0u) { xcd_barrier_complete(bar, b.x, nloc, nx); b.st[0] = nloc; b.st[1] = nx; }
        const unsigned old = xb_add(&bar[XB_XSUB(b.x)], 1u);
        const unsigned gen = old / nloc;
        if (old + 1u == (gen + 1u) * nloc) {
            __builtin_amdgcn_fence(__ATOMIC_RELEASE, "agent");
            asm volatile("s_waitcnt vmcnt(0)" ::: "memory");
            const unsigned og = xb_add(&bar[XB_TOP], 1u);
            const unsigned tg = og / nx;
            if (og + 1u == (tg + 1u) * nx) xb_add(&bar[XB_TOPGEN], 1u);
            else XB_SPIN(xb_ld(&bar[XB_TOPGEN]) == tg, bar);
            __builtin_amdgcn_fence(__ATOMIC_ACQUIRE, "agent");
            xb_add(&bar[XB_XGEN(b.x)], 1u);
            asm volatile("s_waitcnt vmcnt(0)" ::: "memory");
        } else {
            XB_SPIN(xb_ld(&bar[XB_XGEN(b.x)]) == gen, bar);
            __builtin_amdgcn_fence(__ATOMIC_ACQUIRE, "agent");
            asm volatile("s_waitcnt vmcnt(0)" ::: "memory");
        }
    }
    __syncthreads();
}

__global__ void __launch_bounds__(512, 2) mega_fwd(Args args) {
    extern __shared__ __attribute__((aligned(16))) unsigned char lds_raw[];
    Frame F;
    F.lds = (LAS unsigned char*)lds_raw; F.ldsg = lds_raw;
    F.tid = threadIdx.x; F.lane = F.tid & 63; F.wave = __builtin_amdgcn_readfirstlane(F.tid >> 6);
    F.G = gridDim.x; F.bid = blockIdx.x;
    F.in = args.in; F.out = args.out; F.ws = args.ws;
    const int lo = args.ph_lo, hi = args.ph_hi;
    cg::grid_group grid = cg::this_grid();
    const bool fused = (hi - lo) > 1;
    volatile LAS unsigned* bst = (volatile LAS unsigned*)(F.lds + AT_MISC + 16);
    if (F.tid == 0) { bst[0] = 0u; bst[1] = 0u; }
    __syncthreads();
    XcdBarrier xbar; xbar.bar = (unsigned*)(F.ws + WS_CTL) + 1024; xbar.x = 0; xbar.st = bst;
    if (fused) xbar = xcd_barrier_post((unsigned*)(F.ws + WS_CTL) + 1024, bst);
#define IN(k) (lo <= (k) && (k) < hi)
#define PB() do { F.lane = lane_id_opaque(); F.tid = F.wave * 64 + F.lane; } while (0)
#define SEAM(k) do { if (IN(k) && IN((k) + 1)) { xcd_barrier(xbar); } } while (0)
    const float* mod = (const float*)(F.ws + WS_MOD);
    if (IN(0)) { PB(); p0_prologue(F); }
    if (IN(0) && IN(1)) __syncthreads(); else SEAM(0);
    if (IN(1)) { PB(); p1_rows(F, IN(0)); } SEAM(1);
    if (IN(2)) { PB();
        p2_cumsum(F);
        __syncthreads();
        pg8::Gemm g{(const bf16_t*)(F.ws + WS_XN), (const bf16_t*)(F.ws + WS_WIN), 1024, 1024, 1024, 1 << 30, 0, 0};
        pg8::StaticOrder S; S.init(MT / 256, NZ / 256, F.G, F.bid, 0);
        EpiZ E{F.out, F.ws};
        pg8::gemm_phase<EpiZ, pg8::StaticOrder>(F.lds, g, S, E, F.wave);
#if PROBE_DUP == 2
        pg8::gemm_phase<EpiZ, pg8::StaticOrder>(F.lds, g, S, E, F.wave);
#endif
        { const int nun = (MT / 256) * (NZ / 256), nlong = nun - (nun / F.G) * F.G;
          if (nlong > 0 && nlong < F.G) { if (F.bid >= nlong) { PB(); weight_copies(F, F.bid - nlong, F.G - nlong, WC_IN, WC_ALL); } }
          else { PB(); weight_copies(F, F.bid, F.G, WC_IN, WC_ALL); } }
    } SEAM(2);
    if (IN(3)) { PB(); p3_attention(F, 7);
#if PROBE_DUP == 3
        p3_attention<PROBE_PV>(F, PROBE_MASK);
#endif
    } SEAM(3);
    if (IN(10)) { PB(); p_combine(F);
#if PROBE_DUP == 10
        p_combine(F);
#endif
    } if (IN(10) && IN(4)) xcd_barrier(xbar);
    if (IN(4)) { PB();
        pg8::Gemm g{(const bf16_t*)(F.ws + WS_AB), (const bf16_t*)(F.ws + WS_WAB), 1024, 512, 512, 4, 512, 0};
        pg8::StaticOrder S; S.init(MT / 256, 8, F.G, F.bid, 0);
        EpiGate E{(bf16_t*)(F.ws + WS_G), (bf16_t*)(F.ws + WS_G)};
#if PROBE_DUP == 4
        { EpiGate E2{(bf16_t*)(F.ws + WS_G), (bf16_t*)(F.ws + WS_QA)}; pg8::gemm_phase<EpiGate, pg8::StaticOrder>(F.lds, g, S, E2, F.wave); }
#endif
        pg8::gemm_phase<EpiGate, pg8::StaticOrder>(F.lds, g, S, E, F.wave);
    } SEAM(4);
    if (IN(5)) { PB();
        { pg8::Gemm g2{(const bf16_t*)(F.ws + WS_G), (const bf16_t*)(F.ws + WS_WO2), 2048, 2048, 256, 1 << 30, 0, 256};
          pg8::SplitOrder S2; S2.init(4, 8, F.G, F.bid, SEQ / 256); EpiSlab E2{(float*)(F.ws + WS_SLAB)};
          pg8::gemm_phase<EpiSlab, pg8::SplitOrder>(F.lds, g2, S2, E2, F.wave); slab_publish(F, 322, 32); }
        pg8::Gemm g{(const bf16_t*)(F.ws + WS_G), (const bf16_t*)(F.ws + WS_WO2), 2048, 2048, 2048, 1 << 30, 0, 0};
        pg8::StaticOrder S; S.init(SEQ / 256, 4, F.G, F.bid, 0);
        EpiResLn<false> E{(const void*)F.in[I_XP], mod + 2048, F.in[I_LN1G], F.in[I_LN1B], mod, (bf16_t*)(F.ws + WS_X1B), (bf16_t*)(F.ws + WS_XN), nullptr,
                          PanelStats{(unsigned*)(F.ws + WS_XB1), (unsigned*)(F.ws + WS_CTL) + CTL_LN1, LN_EPS}, F.lds};
        pg8::gemm_phase<EpiResLn<false>, pg8::StaticOrder>(F.lds, g, S, E, F.wave);
        PB(); slab_wait(F, 322, 32); ln_rows<false>(F, F.in[I_LN1G], F.in[I_LN1B], 8, 2048);
    } if (IN(5) && IN(7)) xcd_barrier(xbar);

    if (IN(7)) { PB();
        pg8::Gemm g{(const bf16_t*)(F.ws + WS_XN), (const bf16_t*)(F.ws + WS_WFI), 1024, 1024, 1024, 1 << 30, 0, 0};
        pg8::StaticOrder S; S.init(MT / 256, NFF2 / 256, F.G, F.bid, 0);
        EpiFfn E{(bf16_t*)(F.ws + WS_ACT)};
        pg8::gemm_phase<EpiFfn, pg8::StaticOrder>(F.lds, g, S, E, F.wave);
#if PROBE_DUP == 7
        pg8::gemm_phase<EpiFfn, pg8::StaticOrder>(F.lds, g, S, E, F.wave);
#endif
    } SEAM(7);
    if (IN(8)) { PB();
        { pg8::Gemm g2{(const bf16_t*)(F.ws + WS_ACT), (const bf16_t*)(F.ws + WS_WFO), DFF, DFF, 256, 1 << 30, 0, 256};
          pg8::SplitOrder S2; S2.init(4, 11, F.G, F.bid, SEQ / 256); EpiSlab E2{(float*)(F.ws + WS_SLAB)};
          pg8::gemm_phase<EpiSlab, pg8::SplitOrder>(F.lds, g2, S2, E2, F.wave); slab_publish(F, 323, 44); }
        pg8::Gemm g{(const bf16_t*)(F.ws + WS_ACT), (const bf16_t*)(F.ws + WS_WFO), DFF, DFF, DFF, 1 << 30, 0, 0};
        pg8::StaticOrder S; S.init(SEQ / 256, 4, F.G, F.bid, 0);
        EpiResLn<true> E{(const void*)(F.ws + WS_X1B), mod + 5120, F.in[I_LN2G], F.in[I_LN2B], mod, nullptr, nullptr, F.out,
                         PanelStats{(unsigned*)(F.ws + WS_XB2), (unsigned*)(F.ws + WS_CTL) + CTL_LN2, LN_EPS}, F.lds};
        pg8::gemm_phase<EpiResLn<true>, pg8::StaticOrder>(F.lds, g, S, E, F.wave);
        PB(); slab_wait(F, 323, 44); ln_rows<true>(F, F.in[I_LN2G], F.in[I_LN2B], 11, 5120);
    }
#undef IN
#undef SEAM
}

extern "C" void kernel_launch(void* const* d_in, const int* in_sizes, int n_in, void* d_out, int out_size, void* d_ws, size_t ws_size, hipStream_t stream) {
    static int grid = 0;
    if (grid == 0) {
        if (n_in != 28 || (size_t)out_size != O_END || ws_size < WS_END) { fprintf(stderr, "kernel_launch: unexpected shapes (n_in %d out %d ws %zu)\n", n_in, out_size, ws_size); grid = -1; return; }
        int dev = 0, cus = 0, per_cu = 0;
        hipGetDevice(&dev); hipDeviceGetAttribute(&cus, hipDeviceAttributeMultiprocessorCount, dev);
        hipFuncSetAttribute((const void*)mega_fwd, hipFuncAttributeMaxDynamicSharedMemorySize, LDS_BYTES);
        hipOccupancyMaxActiveBlocksPerMultiprocessor(&per_cu, (const void*)mega_fwd, 512, LDS_BYTES);
        if (per_cu < 1) { fprintf(stderr, "kernel_launch: occupancy query says %d blocks per CU\n", per_cu); per_cu = 1; }
        (void)hipGetLastError();
        grid = cus;
    }
    if (grid < 0) return;
    hipMemsetAsync((char*)d_ws + WS_CTL, 0, CTL_BYTES, stream);
    Args a{};
    for (int i = 0; i < 28; ++i) a.in[i] = (const float*)d_in[i];
    a.out = (float*)d_out; a.ws = (unsigned char*)d_ws;
#if MK_N_LAUNCHES == 1
    a.ph_lo = 0; a.ph_hi = NPH;
    void* kargs[] = {&a};
    hipError_t e = hipLaunchCooperativeKernel((const void*)mega_fwd, dim3(grid), dim3(512), kargs, LDS_BYTES, stream);
    if (e != hipSuccess) fprintf(stderr, "cooperative launch failed: %s\n", hipGetErrorString(e));
#else
    { const int seq[NPH] = {0, 1, 2, 3, 10, 4, 5, 6, 7, 8, 9}; for (int i = 0; i < NPH; ++i) { a.ph_lo = seq[i]; a.ph_hi = seq[i] + 1; hipLaunchKernelGGL(mega_fwd, dim3(grid), dim3(512), LDS_BYTES, stream, a); } }
#endif
}
```

```cpp
#include <hip/hip_runtime.h>
#include <hip/hip_cooperative_groups.h>
#include <cstdint>
#include <cstdio>
namespace cg = cooperative_groups;

#ifndef PROBE_DUP
#define PROBE_DUP -1
#endif
#ifndef PROBE_PV
#define PROBE_PV 0
#endif
#ifndef PROBE_MASK
#define PROBE_MASK 7
#endif
#ifndef MK_N_LAUNCHES
#define MK_N_LAUNCHES 1
#endif

#define LAS __attribute__((address_space(3)))
typedef unsigned short bf16_t;
typedef short bf16x8 __attribute__((ext_vector_type(8)));
typedef short s16x4 __attribute__((ext_vector_type(4)));
typedef float f32x4 __attribute__((ext_vector_type(4)));
typedef float f32x2 __attribute__((ext_vector_type(2)));
typedef float f32x16 __attribute__((ext_vector_type(16)));
typedef unsigned u32x4 __attribute__((ext_vector_type(4)));
typedef unsigned u32x2 __attribute__((ext_vector_type(2)));

constexpr int DM = 1024, SEQ = 16384, DEC_B = 16, DEC_T = 16, NSMP = DEC_B * DEC_T, MT = SEQ + NSMP, PAST = 2048, SKV = PAST + DEC_T;
constexpr int NZ = 5120, DFF = 2816, NFF2 = 2 * DFF, WIN_COLS = 5128;
constexpr float LOG2E = 1.4426950408889634f, C2 = 0.125f * LOG2E, ALPHA = 1.189207115002721f, LN_EPS = 1e-5f;
constexpr int NPH = 11;

constexpr size_t O_Y = 0, O_DKP = (size_t)MT * DM, O_DVP = O_DKP + (size_t)SEQ * 512, O_FKP = O_DVP + (size_t)SEQ * 512, O_FVP = O_FKP + (size_t)SEQ * 512,
                 O_FLP = O_FVP + (size_t)SEQ * 512, O_DKS = O_FLP + (size_t)SEQ * 8, O_DVS = O_DKS + (size_t)NSMP * 512, O_FKS = O_DVS + (size_t)NSMP * 512,
                 O_FVS = O_FKS + (size_t)NSMP * 512, O_FLS = O_FVS + (size_t)NSMP * 512, O_END = O_FLS + (size_t)NSMP * 8;

constexpr size_t MiB = 1u << 20;
constexpr size_t WS_CTL = 0, CTL_BYTES = 64 * 1024;
constexpr size_t WS_MOD = 1 * MiB;
constexpr size_t WS_FP = 2 * MiB;
constexpr size_t WS_FS = 3 * MiB;
constexpr size_t WS_WIN = 8 * MiB;
constexpr size_t WS_WAB = 18 * MiB;
constexpr size_t WS_WO2 = 20 * MiB;
constexpr size_t WS_WFI = 24 * MiB;
constexpr size_t WS_WFO = 35 * MiB;
constexpr size_t WS_XN = 48 * MiB;
constexpr size_t WS_QA = 84 * MiB, WS_KA = 101 * MiB, WS_VA = 118 * MiB, WS_QB = 135 * MiB, WS_KB = 152 * MiB, WS_VB = 169 * MiB;
constexpr size_t WS_ACT = 84 * MiB;
constexpr size_t WS_G = 188 * MiB;
constexpr size_t WS_AB = 254 * MiB;
constexpr size_t WS_OD1 = WS_XN, WS_OD2 = 288 * MiB;
constexpr size_t WS_PF = 304 * MiB, WS_PD = 309 * MiB;
constexpr size_t WS_TB = WS_AB;
constexpr size_t WS_X1B = WS_AB;
constexpr size_t WS_XB1 = 5 * MiB, WS_XB2 = 6 * MiB;
constexpr int CTL_LN1 = 8192, CTL_LN2 = 12288;
constexpr int LN_LDS = 135168;
constexpr size_t WS_SLAB = 288 * MiB;
constexpr size_t WS_END = 320 * MiB;

constexpr int LDS_BYTES = 147456;

struct Args { const float* in[28]; float* out; unsigned char* ws; int ph_lo, ph_hi; };

__device__ __forceinline__ int lane_id_opaque() { int l = (int)__builtin_amdgcn_mbcnt_hi(~0u, __builtin_amdgcn_mbcnt_lo(~0u, 0u)); asm volatile("" : "+v"(l)); return l; }
__device__ __forceinline__ unsigned f2bf(float f) { unsigned u = __builtin_bit_cast(unsigned, f); return (u + 0x7fffu + ((u >> 16) & 1u)) >> 16; }
__device__ __forceinline__ unsigned pk2(float lo, float hi) { return f2bf(lo) | (f2bf(hi) << 16); }
__device__ __forceinline__ float bf2f(unsigned short b) { return __builtin_bit_cast(float, (unsigned)b << 16); }
__device__ __forceinline__ float bflo(unsigned w) { return __builtin_bit_cast(float, w << 16); }
__device__ __forceinline__ float bfhi(unsigned w) { return __builtin_bit_cast(float, w & 0xffff0000u); }
__device__ __forceinline__ float wave_sum(float v) {
#pragma unroll
    for (int o = 1; o < 64; o <<= 1) v += __shfl_xor(v, o);
    return v;
}
__device__ __forceinline__ float sigmoidf_(float x) { return 1.0f / (1.0f + __expf(-x)); }
__device__ __forceinline__ float siluf_(float x) { return x / (1.0f + __expf(-x)); }

namespace pg8 {
constexpr int BM = 256, BK = 64, HALF = 128, HTB = HALF * BK * 2, STAGE_BYTES = 8 * HTB, NXCD = 8, WGM = 8;
__host__ __device__ __forceinline__ int lds_byte(int r, int c) { const int st = (r >> 4) * 2 + (c >> 5), rr = r & 15, cc = c & 31, ob = rr * 64 + cc * 2; return st * 1024 + (ob ^ (((ob >> 9) & 1) << 5)); }
__host__ __device__ __forceinline__ void stage_rc(int b, int& R, int& C) { const int st = b / 1024, sb = b % 1024, swz = sb ^ (((sb >> 9) & 1) << 5); R = (st >> 1) * 16 + swz / 64; C = (st & 1) * 32 + (swz % 64) / 2; }
__host__ __device__ __forceinline__ int perm32(int rho) { const int n = rho >> 4, i = rho & 15; return 8 * (i >> 2) + 4 * n + (i & 3); }

struct Unit { int pm, pn, ks; };
struct Gemm { const bf16_t* A; const bf16_t* Bt; int lda, ldb, K, a_split_pn, a_split_off, kpart; };

struct StaticOrder {
    int nM, nN, nwg, G, c, pm0;
    __device__ void init(int nM_, int nN_, int G_, int c_, int pm0_) { nM = nM_; nN = nN_; nwg = nM * nN; G = G_; c = c_; pm0 = pm0_; }
    __device__ bool next(int i, Unit& u) const {
        const long L = (long)i * G + c; if (L >= nwg) return false;
        int wgid = (int)L; { const int q = nwg / NXCD, r = nwg % NXCD, xcd = wgid % NXCD, off = wgid / NXCD; wgid = (xcd < r ? xcd * (q + 1) : r * (q + 1) + (xcd - r) * q) + off; }
        const int nig = WGM * nN, gid = wgid / nig, fm = gid * WGM, gsz = (nM - fm) < WGM ? (nM - fm) : WGM;
        u.pm = pm0 + fm + ((wgid % nig) % gsz); u.pn = (wgid % nig) / gsz; u.ks = 0; return true;
    }
};

struct SplitOrder {
    int nN, nun, G, c, pm;
    __device__ void init(int nN_, int KS_, int G_, int c_, int pm_) { nN = nN_; nun = nN_ * KS_; G = G_; c = c_; pm = pm_; }
    __device__ bool next(int i, Unit& u) const { const long L = (long)i * G + c; if (L >= nun) return false; u.pm = pm; u.pn = (int)L % nN; u.ks = (int)L / nN; return true; }
};

__device__ __forceinline__ unsigned cvt_pk_bf16(float lo, float hi) { unsigned r; asm volatile("v_cvt_pk_bf16_f32 %0, %1, %2" : "=v"(r) : "v"(lo), "v"(hi)); return r; }

template <class Epi, class Sched, bool ALIGN_EPI = true, bool SP2 = true>
__device__ __forceinline__ void gemm_phase(LAS unsigned char* lds, const Gemm g, const Sched& S, const Epi& E, int wid  ) {
    const int lane = lane_id_opaque(), tid = wid * 64 + lane, wr = wid >> 2, wc = wid & 3; int fr = lane & 15, fq = lane >> 4;
    const int K = g.K, nt = K / BK;
    unsigned voffA[2], voffB[2];
#pragma unroll
    for (int i = 0; i < 2; ++i) { int R, C; stage_rc(tid * 16 + i * 8192, R, C); const int Rb = Epi::PERM ? ((R & ~31) + perm32(R & 31)) : R;
        voffA[i] = (unsigned)(R * g.lda + C) * 2u; voffB[i] = (unsigned)(Rb * g.ldb + C) * 2u; }
    const size_t kstep = (size_t)(BK * 2);
    const size_t hstepA = (size_t)HALF * g.lda * 2, hstepB = (size_t)HALF * g.ldb * 2;
    const size_t tstepA = 2 * hstepA, tstepB = 2 * hstepB;
    const unsigned ldsw = (unsigned)wid * 1024u;
    const int aoff = lds_byte(wr * 64 + fr, fq * 8), boff = lds_byte(wc * 32 + fr, fq * 8);
#define PG8_SA(b, h) (((b) * 2 + (h)) * HTB)
#define PG8_SB(b, h) ((4 + (b) * 2 + (h)) * HTB)
#define PG8_STAGE(bufoff, gbase, voff) do { _Pragma("unroll") for (int _i = 0; _i < 2; ++_i) \
        __builtin_amdgcn_global_load_lds((const unsigned*)((const char*)(gbase) + (voff)[_i]), (LAS unsigned*)(lds + (bufoff) + ldsw + _i * 8192), 16, 0, 0); } while (0)
#define PG8_LDA(dst, b, h) do { _Pragma("unroll") for (int m = 0; m < 4; ++m) _Pragma("unroll") for (int k = 0; k < 2; ++k) dst[m][k] = *(const LAS bf16x8*)(lds + PG8_SA(b, h) + aoff + m * 2048 + k * 1024); } while (0)
#define PG8_LDB(dst, b, h) do { _Pragma("unroll") for (int n = 0; n < 2; ++n) _Pragma("unroll") for (int k = 0; k < 2; ++k) dst[n][k] = *(const LAS bf16x8*)(lds + PG8_SB(b, h) + boff + n * 2048 + k * 1024); } while (0)
#define PG8_MMA(ai, bj, At, Bt) do { __builtin_amdgcn_s_setprio(1); _Pragma("unroll") for (int m = 0; m < 4; ++m) _Pragma("unroll") for (int n = 0; n < 2; ++n) _Pragma("unroll") for (int k = 0; k < 2; ++k) \
        acc[ai][bj][m][n] = __builtin_amdgcn_mfma_f32_16x16x32_bf16(Bt[n][k], At[m][k], acc[ai][bj][m][n], 0, 0, 0); __builtin_amdgcn_s_setprio(0); } while (0)
#define PG8_WAIT_V(n) asm volatile("s_waitcnt vmcnt(" #n ")" ::: "memory")
#define PG8_WAIT_L(n) asm volatile("s_waitcnt lgkmcnt(" #n ")" ::: "memory")
#define PG8_BAR __builtin_amdgcn_s_barrier()
#define PG8_SCHED __builtin_amdgcn_sched_barrier(0)
#define PG8_ABASE(u) ((const char*)g.A + (size_t)(u).pm * tstepA + ((u).pn >= g.a_split_pn ? (size_t)g.a_split_off * 2 : (size_t)0) + (size_t)(u).ks * g.kpart * 2)
#define PG8_BBASE(u) ((const char*)g.Bt + (size_t)(u).pn * tstepB + (size_t)(u).ks * g.kpart * 2)
    Unit cur, nxt; int ui = 0;
    if (!S.next(0, cur)) return;
    f32x4 acc[2][2][4][2];
#pragma unroll
    for (int a = 0; a < 2; ++a)
#pragma unroll
        for (int b = 0; b < 2; ++b)
#pragma unroll
            for (int m = 0; m < 4; ++m)
#pragma unroll
                for (int n = 0; n < 2; ++n) acc[a][b][m][n] = (f32x4){0.f, 0.f, 0.f, 0.f};
    bf16x8 At[4][2], B0[2][2], B1[2][2];
    const char* cA = PG8_ABASE(cur); const char* cB = PG8_BBASE(cur);
    if constexpr (SP2) {
        PG8_STAGE(PG8_SB(0, 0), cB, voffB); PG8_STAGE(PG8_SB(0, 1), cB + hstepB, voffB); PG8_STAGE(PG8_SA(0, 0), cA, voffA); PG8_STAGE(PG8_SA(0, 1), cA + hstepA, voffA);
        if (wr == 1) PG8_BAR;
        PG8_WAIT_V(2); PG8_BAR;
        PG8_STAGE(PG8_SB(1, 0), cB + kstep, voffB); PG8_STAGE(PG8_SA(1, 0), cA + kstep, voffA); PG8_STAGE(PG8_SB(1, 1), cB + hstepB + kstep, voffB);
        PG8_WAIT_V(6); PG8_BAR;
    } else {
        PG8_STAGE(PG8_SB(0, 0), cB, voffB); PG8_STAGE(PG8_SA(0, 0), cA, voffA); PG8_STAGE(PG8_SB(0, 1), cB + hstepB, voffB); PG8_STAGE(PG8_SA(0, 1), cA + hstepA, voffA);
        if (wr == 1) PG8_BAR;
        PG8_WAIT_V(4); PG8_BAR;
        PG8_STAGE(PG8_SB(1, 0), cB + kstep, voffB); PG8_STAGE(PG8_SA(1, 0), cA + kstep, voffA); PG8_STAGE(PG8_SB(1, 1), cB + hstepB + kstep, voffB);
        PG8_WAIT_V(6); PG8_BAR;
    }
    for (;;) {
        const bool has_next = S.next(ui + 1, nxt);
        const char* nA = has_next ? PG8_ABASE(nxt) : cA; const char* nB = has_next ? PG8_BBASE(nxt) : cB;
        for (int t = 0; t < nt; t += 2) {
            const bool last = (t == nt - 2);
            const char* a1 = cA + (size_t)(t + 1) * kstep;
            const char* a2 = last ? nA : cA + (size_t)(t + 2) * kstep; const char* b2 = last ? nB : cB + (size_t)(t + 2) * kstep;
            const char* a3 = a2 + kstep; const char* b3 = b2 + kstep;
            if constexpr (SP2) {
            PG8_LDB(B0, 0, 0); PG8_LDB(B1, 0, 1); PG8_SCHED; PG8_LDA(At, 0, 0); PG8_STAGE(PG8_SA(1, 1), a1 + hstepA, voffA);
            PG8_WAIT_V(8); PG8_WAIT_L(0); PG8_BAR; PG8_MMA(0, 0, At, B0); PG8_MMA(0, 1, At, B1); PG8_BAR; PG8_SCHED;
            PG8_LDA(At, 0, 1); PG8_STAGE(PG8_SB(0, 0), b2, voffB); PG8_STAGE(PG8_SB(0, 1), b2 + hstepB, voffB); PG8_STAGE(PG8_SA(0, 0), a2, voffA);
            PG8_WAIT_V(8); PG8_WAIT_L(0); PG8_BAR; PG8_MMA(1, 0, At, B0); PG8_MMA(1, 1, At, B1); PG8_BAR; PG8_SCHED;
            PG8_LDB(B0, 1, 0); PG8_LDB(B1, 1, 1); PG8_SCHED; PG8_LDA(At, 1, 0); PG8_STAGE(PG8_SA(0, 1), a2 + hstepA, voffA);
            PG8_WAIT_V(8); PG8_WAIT_L(0); PG8_BAR; PG8_MMA(0, 0, At, B0); PG8_MMA(0, 1, At, B1); PG8_BAR; PG8_SCHED;
            PG8_LDA(At, 1, 1); PG8_STAGE(PG8_SB(1, 0), b3, voffB); PG8_STAGE(PG8_SB(1, 1), b3 + hstepB, voffB); PG8_STAGE(PG8_SA(1, 0), a3, voffA);
            PG8_WAIT_V(8); PG8_WAIT_L(0); PG8_BAR; PG8_MMA(1, 0, At, B0); PG8_MMA(1, 1, At, B1); PG8_BAR; PG8_SCHED;
            } else {
            PG8_LDB(B0, 0, 0); PG8_SCHED; PG8_LDA(At, 0, 0); PG8_STAGE(PG8_SA(1, 1), a1 + hstepA, voffA);
            PG8_WAIT_L(8); PG8_BAR; PG8_WAIT_L(0); PG8_MMA(0, 0, At, B0); PG8_BAR; PG8_SCHED;
            PG8_LDB(B1, 0, 1); PG8_STAGE(PG8_SB(0, 0), b2, voffB);
            PG8_BAR; PG8_WAIT_L(0); PG8_MMA(0, 1, At, B1); PG8_BAR;
            PG8_LDA(At, 0, 1); PG8_STAGE(PG8_SA(0, 0), a2, voffA);
            PG8_BAR; PG8_WAIT_L(0); PG8_MMA(1, 0, At, B0); PG8_BAR; PG8_SCHED;
            PG8_STAGE(PG8_SB(0, 1), b2 + hstepB, voffB);
            PG8_WAIT_V(6); PG8_BAR; PG8_MMA(1, 1, At, B1); PG8_BAR;
            PG8_LDB(B0, 1, 0); PG8_SCHED; PG8_LDA(At, 1, 0); PG8_STAGE(PG8_SA(0, 1), a2 + hstepA, voffA);
            PG8_WAIT_L(8); PG8_BAR; PG8_WAIT_L(0); PG8_MMA(0, 0, At, B0); PG8_BAR; PG8_SCHED;
            PG8_LDB(B1, 1, 1); PG8_STAGE(PG8_SB(1, 0), b3, voffB);
            PG8_BAR; PG8_WAIT_L(0); PG8_MMA(0, 1, At, B1); PG8_BAR;
            PG8_LDA(At, 1, 1); PG8_STAGE(PG8_SA(1, 0), a3, voffA);
            PG8_BAR; PG8_WAIT_L(0); PG8_MMA(1, 0, At, B0); PG8_BAR; PG8_SCHED;
            PG8_STAGE(PG8_SB(1, 1), b3 + hstepB, voffB);
            PG8_WAIT_V(6); PG8_BAR; PG8_MMA(1, 1, At, B1); PG8_BAR;
            }
        }
        if constexpr (ALIGN_EPI) { if (wr == 0) PG8_BAR; }
        { const int le_ = lane_id_opaque(); E(acc, cur, wr, wc, le_ & 15, le_ >> 4); }
        if (!has_next) break;
#pragma unroll
        for (int a = 0; a < 2; ++a)
#pragma unroll
            for (int b = 0; b < 2; ++b)
#pragma unroll
                for (int m = 0; m < 4; ++m)
#pragma unroll
                    for (int n = 0; n < 2; ++n) acc[a][b][m][n] = (f32x4){0.f, 0.f, 0.f, 0.f};
        cur = nxt; cA = nA; cB = nB; ++ui;
        if constexpr (ALIGN_EPI) { if (wr == 1) PG8_BAR; }
    }
    PG8_WAIT_V(0);
    if constexpr (!ALIGN_EPI) { if (wr == 0) PG8_BAR; }
    PG8_BAR;
#undef PG8_SA
#undef PG8_SB
#undef PG8_STAGE
#undef PG8_LDA
#undef PG8_LDB
#undef PG8_MMA
#undef PG8_WAIT_V
#undef PG8_WAIT_L
#undef PG8_BAR
#undef PG8_SCHED
#undef PG8_ABASE
#undef PG8_BBASE
}
}

struct EpiZ {
    static constexpr bool PERM = true;
    float* out; unsigned char* ws;
    __device__ __forceinline__ void operator()(const f32x4 (&acc)[2][2][4][2], const pg8::Unit& u, int wr, int wc, int fr, int fq) const {
        asm volatile("" : "+v"(fr), "+v"(fq));
        const int seg = u.pn >> 1;
        const bool smp = u.pm >= SEQ / 256;
        const int row0 = u.pm * 256 + wr * 64 + fr;
        const int cl0 = wc * 32 + 8 * fq;
        if (seg < 6) {
            bf16_t* B = (bf16_t*)(ws + WS_QA + (size_t)seg * (WS_KA - WS_QA));
            const bool isq = (seg == 0 || seg == 3);
            const float sc = isq ? C2 : 1.0f;
            const int kk = seg - 1 - (seg > 3 ? 1 : 0);
            float* ob = isq ? nullptr : (smp ? out + O_DKS + (size_t)kk * NSMP * 512 - (size_t)SEQ * 512 : out + O_DKP + (size_t)kk * SEQ * 512);
            const int cs = (u.pn & 1) * 256 + cl0;
            if (seg == 0 || seg == 1 || seg == 3 || seg == 4) {
                float mx0 = 0.f, mx1 = 0.f;
#pragma unroll
                for (int ai = 0; ai < 2; ++ai)
#pragma unroll
                    for (int m = 0; m < 4; ++m) {
#pragma unroll
                        for (int bj = 0; bj < 2; ++bj) { const f32x4 v0 = acc[ai][bj][m][0] * sc, v1 = acc[ai][bj][m][1] * sc;
                            float ss = (v0[0] * v0[0] + v0[1] * v0[1]) + (v0[2] * v0[2] + v0[3] * v0[3]) + (v1[0] * v1[0] + v1[1] * v1[1]) + (v1[2] * v1[2] + v1[3] * v1[3]);
                            ss += __shfl_xor(ss, 16); ss += __shfl_xor(ss, 32);
                            if (bj == 0) mx0 = fmaxf(mx0, ss); else mx1 = fmaxf(mx1, ss); } }
#pragma unroll
                for (int ofs = 1; ofs < 16; ofs <<= 1) { mx0 = fmaxf(mx0, __shfl_xor(mx0, ofs)); mx1 = fmaxf(mx1, __shfl_xor(mx1, ofs)); }
                if ((fr | fq) == 0) { unsigned* nw = (unsigned*)(ws + WS_CTL) + (seg < 3 ? 288 : 256) + ((seg == 4 || seg == 1) ? 16 : 0);
                    const int h0 = (u.pn & 1) * 4 + (wc >> 1), hf = wc & 1;
                    atomicMax(nw + (h0 * 2 + hf), __float_as_uint(mx0)); atomicMax(nw + ((h0 + 2) * 2 + hf), __float_as_uint(mx1)); }
            }
#pragma unroll
            for (int ai = 0; ai < 2; ++ai)
#pragma unroll
                for (int m = 0; m < 4; ++m) { const size_t r = (size_t)(row0 + ai * 128 + m * 16);
#pragma unroll
                    for (int bj = 0; bj < 2; ++bj) { const f32x4 v0 = acc[ai][bj][m][0], v1 = acc[ai][bj][m][1]; const int c = cs + bj * 128;
                        if (ob) { __builtin_nontemporal_store(v0, (f32x4*)(ob + r * 512 + c)); __builtin_nontemporal_store(v1, (f32x4*)(ob + r * 512 + c + 4)); }
                        u32x4 w; w.x = pg8::cvt_pk_bf16(v0[0] * sc, v0[1] * sc); w.y = pg8::cvt_pk_bf16(v0[2] * sc, v0[3] * sc); w.z = pg8::cvt_pk_bf16(v1[0] * sc, v1[1] * sc); w.w = pg8::cvt_pk_bf16(v1[2] * sc, v1[3] * sc);
                        *(u32x4*)(B + r * 512 + c) = w; } }
        } else {
            bf16_t* G = (bf16_t*)(ws + WS_G);
            const int cs = (u.pn - 12) * 256 + cl0;
#pragma unroll
            for (int ai = 0; ai < 2; ++ai)
#pragma unroll
                for (int m = 0; m < 4; ++m) { const size_t r = (size_t)(row0 + ai * 128 + m * 16);
#pragma unroll
                    for (int bj = 0; bj < 2; ++bj) { const f32x4 v0 = acc[ai][bj][m][0], v1 = acc[ai][bj][m][1]; const int c = cs + bj * 128;
                        u32x4 w; w.x = pg8::cvt_pk_bf16(sigmoidf_(v0[0]), sigmoidf_(v0[1])); w.y = pg8::cvt_pk_bf16(sigmoidf_(v0[2]), sigmoidf_(v0[3]));
                        w.z = pg8::cvt_pk_bf16(sigmoidf_(v1[0]), sigmoidf_(v1[1])); w.w = pg8::cvt_pk_bf16(sigmoidf_(v1[2]), sigmoidf_(v1[3]));
                        *(u32x4*)(G + r * 2048 + c) = w; } }
        }
    }
};
struct EpiGate {
    static constexpr bool PERM = true;
    bf16_t* G; bf16_t* GO;
    __device__ __forceinline__ void operator()(const f32x4 (&acc)[2][2][4][2], const pg8::Unit& u, int wr, int wc, int fr, int fq) const {
        asm volatile("" : "+v"(fr), "+v"(fq));
        const int row0 = u.pm * 256 + wr * 64 + fr, c0 = u.pn * 256 + wc * 32 + 8 * fq;
#pragma unroll
        for (int ai = 0; ai < 2; ++ai)
#pragma unroll
            for (int m = 0; m < 4; ++m) { const size_t ro = (size_t)(row0 + ai * 128 + m * 16) * 2048 + c0; const bf16_t* rp = G + ro; bf16_t* wp = GO + ro;
#pragma unroll
                for (int bj = 0; bj < 2; ++bj) { const f32x4 v0 = acc[ai][bj][m][0], v1 = acc[ai][bj][m][1]; const u32x4 gw = *(const u32x4*)(rp + bj * 128);
                    u32x4 w; w.x = pg8::cvt_pk_bf16(v0[0] * bflo(gw.x), v0[1] * bfhi(gw.x)); w.y = pg8::cvt_pk_bf16(v0[2] * bflo(gw.y), v0[3] * bfhi(gw.y));
                    w.z = pg8::cvt_pk_bf16(v1[0] * bflo(gw.z), v1[1] * bfhi(gw.z)); w.w = pg8::cvt_pk_bf16(v1[2] * bflo(gw.w), v1[3] * bfhi(gw.w));
                    *(u32x4*)(wp + bj * 128) = w; } }
    }
};
template <bool BASE_BF16> struct EpiRes {
    static constexpr bool PERM = true;
    const void* base; bf16_t* T; const float* gate;
    __device__ __forceinline__ void operator()(const f32x4 (&acc)[2][2][4][2], const pg8::Unit& u, int wr, int wc, int fr, int fq) const {
        asm volatile("" : "+v"(fr), "+v"(fq));
        const int row0 = u.pm * 256 + wr * 64 + fr, c0 = u.pn * 256 + wc * 32 + 8 * fq;
#pragma unroll
        for (int ai = 0; ai < 2; ++ai)
#pragma unroll
            for (int m = 0; m < 4; ++m) { const size_t ro = (size_t)(row0 + ai * 128 + m * 16) * DM;
#pragma unroll
                for (int bj = 0; bj < 2; ++bj) { const int c = c0 + bj * 128; f32x4 b0, b1;
                    if (BASE_BF16) { const u32x4 bw = *(const u32x4*)((const bf16_t*)base + ro + c); b0 = (f32x4){bflo(bw.x), bfhi(bw.x), bflo(bw.y), bfhi(bw.y)}; b1 = (f32x4){bflo(bw.z), bfhi(bw.z), bflo(bw.w), bfhi(bw.w)}; }
                    else { b0 = *(const f32x4*)((const float*)base + ro + c); b1 = *(const f32x4*)((const float*)base + ro + c + 4); }
                    const f32x4 g0 = *(const f32x4*)(gate + c), g1 = *(const f32x4*)(gate + c + 4);
                    const f32x4 v0 = b0 * ALPHA + g0 * acc[ai][bj][m][0], v1 = b1 * ALPHA + g1 * acc[ai][bj][m][1];
                    u32x4 w; w.x = pg8::cvt_pk_bf16(v0[0], v0[1]); w.y = pg8::cvt_pk_bf16(v0[2], v0[3]); w.z = pg8::cvt_pk_bf16(v1[0], v1[1]); w.w = pg8::cvt_pk_bf16(v1[2], v1[3]);
                    *(u32x4*)(T + ro + c) = w; } }
    }
};
struct PanelStats {
    unsigned* xbuf; unsigned* cnt; float eps;
    __device__ __forceinline__ void run(const f32x4 (&v)[2][2][4][2], const pg8::Unit& u, int wr, int wc, int fr, int fq, LAS unsigned char* lds, int wid, int lane) const {
        LAS f32x2* P = (LAS f32x2*)(lds + LN_LDS);
        LAS f32x2* S = (LAS f32x2*)(lds + LN_LDS + 8192);
#pragma unroll
        for (int ai = 0; ai < 2; ++ai)
#pragma unroll
            for (int m = 0; m < 4; ++m) {
                float s = 0.f;
#pragma unroll
                for (int bj = 0; bj < 2; ++bj)
#pragma unroll
                    for (int n = 0; n < 2; ++n) { const f32x4 x = v[ai][bj][m][n]; s += (x[0] + x[1]) + (x[2] + x[3]); }
                s += __shfl_xor(s, 16); s += __shfl_xor(s, 32);
                const float mw = s * (1.0f / 64.0f); float q = 0.f;
#pragma unroll
                for (int bj = 0; bj < 2; ++bj)
#pragma unroll
                    for (int n = 0; n < 2; ++n) { const f32x4 d = v[ai][bj][m][n] - mw; q += (d[0] * d[0] + d[1] * d[1]) + (d[2] * d[2] + d[3] * d[3]); }
                q += __shfl_xor(q, 16); q += __shfl_xor(q, 32);
                if (fq == 0) P[(ai * 128 + wr * 64 + m * 16 + fr) * 4 + wc] = (f32x2){mw, q};
                __builtin_amdgcn_sched_barrier(0);
            }
        asm volatile("s_waitcnt lgkmcnt(0)" ::: "memory"); __builtin_amdgcn_s_barrier(); asm volatile("" ::: "memory");
        const int row = wid * 32 + (lane & 31);
        if (lane < 32) {
            const f32x2 a = P[row * 4 + 0], b = P[row * 4 + 1], c = P[row * 4 + 2], d = P[row * 4 + 3];
            const float mt = (a.x + b.x + c.x + d.x) * 0.25f;
            const float da = a.x - mt, db = b.x - mt, dc = c.x - mt, dd = d.x - mt;
            const float m2 = (a.y + b.y) + (c.y + d.y) + 64.0f * ((da * da + db * db) + (dc * dc + dd * dd));
            unsigned long long* slot = (unsigned long long*)xbuf + ((size_t)(u.pm * 256 + row) * 4 + u.pn);
            __hip_atomic_store(slot, ((unsigned long long)__float_as_uint(m2) << 32) | __float_as_uint(mt), __ATOMIC_RELAXED, __HIP_MEMORY_SCOPE_AGENT);
        }
        asm volatile("s_waitcnt vmcnt(0)" ::: "memory");
        if (lane == 0) __hip_atomic_fetch_add(cnt + 64 * u.pm, 1u, __ATOMIC_RELAXED, __HIP_MEMORY_SCOPE_AGENT);
        if (wid == 0) {
            unsigned sp = 0;
            while ((unsigned)__builtin_amdgcn_readfirstlane(__hip_atomic_load(cnt + 64 * u.pm, __ATOMIC_RELAXED, __HIP_MEMORY_SCOPE_AGENT)) < 32u && ++sp < (1u << 21)) __builtin_amdgcn_s_sleep(2);
            __builtin_amdgcn_fence(__ATOMIC_ACQUIRE, "agent");
        }
        asm volatile("s_waitcnt vmcnt(0) lgkmcnt(0)" ::: "memory"); __builtin_amdgcn_s_barrier(); asm volatile("" ::: "memory");
        if (lane < 32) {
            const unsigned long long* slot = (const unsigned long long*)xbuf + (size_t)(u.pm * 256 + row) * 4; float mt[4], m2[4]; float ms = 0.f;
#pragma unroll
            for (int t = 0; t < 4; ++t) { const unsigned long long w = __hip_atomic_load(slot + t, __ATOMIC_RELAXED, __HIP_MEMORY_SCOPE_AGENT); mt[t] = __uint_as_float((unsigned)w); m2[t] = __uint_as_float((unsigned)(w >> 32)); ms += mt[t]; }
            const float mean = ms * 0.25f; float q = 0.f;
#pragma unroll
            for (int t = 0; t < 4; ++t) { const float dm = mt[t] - mean; q += m2[t] + 256.0f * dm * dm; }
            S[row] = (f32x2){mean, 1.0f / sqrtf(q * (1.0f / 1024.0f) + eps)};
        }
        asm volatile("s_waitcnt lgkmcnt(0)" ::: "memory"); __builtin_amdgcn_s_barrier(); asm volatile("" ::: "memory");
    }
};
template <bool FINAL> struct EpiResLn {
    static constexpr bool PERM = true;
    const void* base; const float* gate; const float* lg; const float* lb; const float* mod; bf16_t* X1B; bf16_t* XN; float* out; PanelStats st; LAS unsigned char* lds;
    __device__ __forceinline__ void operator()(f32x4 (&acc)[2][2][4][2], const pg8::Unit& u, int wr, int wc, int fr, int fq) const {
        asm volatile("" : "+v"(fr), "+v"(fq));
        const int row0 = u.pm * 256 + wr * 64 + fr, c0 = u.pn * 256 + wc * 32 + 8 * fq;
#pragma unroll
        for (int ai = 0; ai < 2; ++ai)
#pragma unroll
            for (int m = 0; m < 4; ++m) { int rr_ = row0 + ai * 128 + m * 16; asm volatile("" : "+v"(rr_)); const size_t ro = (size_t)rr_ * DM;
#pragma unroll
                for (int bj = 0; bj < 2; ++bj) { int c = c0 + bj * 128; asm volatile("" : "+v"(c)); f32x4 b0, b1;
                    if (FINAL) { const u32x4 bw = *(const u32x4*)((const bf16_t*)base + ro + c); b0 = (f32x4){bflo(bw.x), bfhi(bw.x), bflo(bw.y), bfhi(bw.y)}; b1 = (f32x4){bflo(bw.z), bfhi(bw.z), bflo(bw.w), bfhi(bw.w)}; }
                    else { b0 = *(const f32x4*)((const float*)base + ro + c); b1 = *(const f32x4*)((const float*)base + ro + c + 4); }
                    const f32x4 g0 = *(const f32x4*)(gate + c), g1 = *(const f32x4*)(gate + c + 4);
                    acc[ai][bj][m][0] = b0 * ALPHA + g0 * acc[ai][bj][m][0]; acc[ai][bj][m][1] = b1 * ALPHA + g1 * acc[ai][bj][m][1];
                    asm volatile("" : "+v"(acc[ai][bj][m][0]), "+v"(acc[ai][bj][m][1])); }
                __builtin_amdgcn_sched_barrier(0); }
        st.run(acc, u, wr, wc, fr, fq, lds, wr * 4 + wc, fq * 16 + fr);
        const LAS f32x2* S = (const LAS f32x2*)(lds + LN_LDS + 8192);
#pragma unroll
        for (int ai = 0; ai < 2; ++ai)
#pragma unroll
            for (int m = 0; m < 4; ++m) { int r = ai * 128 + wr * 64 + m * 16 + fr; asm volatile("" : "+v"(r)); const f32x2 sr = S[r]; const size_t ro = (size_t)(u.pm * 256 + r) * DM;
#pragma unroll
                for (int bj = 0; bj < 2; ++bj) { int c = c0 + bj * 128; asm volatile("" : "+v"(c));
                    const f32x4 y0 = (acc[ai][bj][m][0] - sr.x) * sr.y * *(const f32x4*)(lg + c) + *(const f32x4*)(lb + c);
                    const f32x4 y1 = (acc[ai][bj][m][1] - sr.x) * sr.y * *(const f32x4*)(lg + c + 4) + *(const f32x4*)(lb + c + 4);
                    if (FINAL) { __builtin_nontemporal_store(y0, (f32x4*)(out + ro + c)); __builtin_nontemporal_store(y1, (f32x4*)(out + ro + c + 4)); }
                    else { u32x4 w; w.x = pg8::cvt_pk_bf16(y0[0], y0[1]); w.y = pg8::cvt_pk_bf16(y0[2], y0[3]); w.z = pg8::cvt_pk_bf16(y1[0], y1[1]); w.w = pg8::cvt_pk_bf16(y1[2], y1[3]);
                        *(u32x4*)(X1B + ro + c) = w;
                        const f32x4 h0 = y0 * (*(const f32x4*)(mod + 4096 + c) + 1.0f) + *(const f32x4*)(mod + 3072 + c), h1 = y1 * (*(const f32x4*)(mod + 4096 + c + 4) + 1.0f) + *(const f32x4*)(mod + 3072 + c + 4);
                        u32x4 w2; w2.x = pg8::cvt_pk_bf16(h0[0], h0[1]); w2.y = pg8::cvt_pk_bf16(h0[2], h0[3]); w2.z = pg8::cvt_pk_bf16(h1[0], h1[1]); w2.w = pg8::cvt_pk_bf16(h1[2], h1[3]);
                        *(u32x4*)(XN + ro + c) = w2; } }
                __builtin_amdgcn_sched_barrier(0); }
    }
};
struct EpiSlab {
    static constexpr bool PERM = true;
    float* slab;
    __device__ __forceinline__ void operator()(const f32x4 (&acc)[2][2][4][2], const pg8::Unit& u, int wr, int wc, int fr, int fq) const {
        asm volatile("" : "+v"(fr), "+v"(fq));
        const int row0 = wr * 64 + fr, c0 = u.pn * 256 + wc * 32 + 8 * fq; float* sb = slab + (size_t)u.ks * NSMP * DM;
#pragma unroll
        for (int ai = 0; ai < 2; ++ai)
#pragma unroll
            for (int m = 0; m < 4; ++m) { float* op = sb + (size_t)(row0 + ai * 128 + m * 16) * DM + c0;
#pragma unroll
                for (int bj = 0; bj < 2; ++bj) { *(f32x4*)(op + bj * 128) = acc[ai][bj][m][0]; *(f32x4*)(op + bj * 128 + 4) = acc[ai][bj][m][1]; } }
    }
};
struct EpiFfn {
    static constexpr bool PERM = true;
    bf16_t* ACT;
    __device__ __forceinline__ void operator()(const f32x4 (&acc)[2][2][4][2], const pg8::Unit& u, int wr, int wc, int fr, int fq) const {
        asm volatile("" : "+v"(fr), "+v"(fq));
        const int row0 = u.pm * 256 + wr * 64 + fr, c0 = u.pn * 128 + wc * 32 + 8 * fq;
#pragma unroll
        for (int ai = 0; ai < 2; ++ai)
#pragma unroll
            for (int m = 0; m < 4; ++m) { const f32x4 g0 = acc[ai][0][m][0], g1 = acc[ai][0][m][1], u0 = acc[ai][1][m][0], u1 = acc[ai][1][m][1];
                u32x4 w; w.x = pg8::cvt_pk_bf16(siluf_(g0[0]) * u0[0], siluf_(g0[1]) * u0[1]); w.y = pg8::cvt_pk_bf16(siluf_(g0[2]) * u0[2], siluf_(g0[3]) * u0[3]);
                w.z = pg8::cvt_pk_bf16(siluf_(g1[0]) * u1[0], siluf_(g1[1]) * u1[1]); w.w = pg8::cvt_pk_bf16(siluf_(g1[2]) * u1[2], siluf_(g1[3]) * u1[3]);
                *(u32x4*)(ACT + (size_t)(row0 + ai * 128 + m * 16) * DFF + c0) = w; }
    }
};

struct Frame {
    LAS unsigned char* lds; unsigned char* ldsg;
    int tid, lane, wave, G, bid;
    const float* const* in; float* out; unsigned char* ws;
};
enum { I_XP = 0, I_XS, I_CDK, I_CDV, I_CFK, I_CFV, I_CFL, I_CP, I_CS, I_WADA, I_BADA, I_WIN, I_BF, I_LQ1, I_LK1, I_LQ2, I_LK2, I_SUBG, I_RELB, I_WA, I_WB, I_WO, I_LN1G, I_LN1B, I_LN2G, I_LN2B, I_WFI, I_WFO };

__device__ __forceinline__ void tr_item(const float* W, int ldw, int src_n0, int k0, bf16_t* WT, int ldt, int dst_row0, int dst_k0, int dup_off, LAS float* scr, int lane) {
#pragma unroll 8
    for (int i = 0; i < 32; ++i) { const int kk = 2 * i + (lane >> 5); scr[kk * 33 + (lane & 31)] = W[(size_t)(k0 + kk) * ldw + src_n0 + (lane & 31)]; }
    asm volatile("s_waitcnt lgkmcnt(0)" ::: "memory");
    const int c = lane & 7;
#pragma unroll
    for (int j = 0; j < 4; ++j) { const int n = (lane >> 3) + 8 * j; const LAS float* s = scr + (8 * c) * 33 + n;
        u32x4 o; o.x = pk2(s[0 * 33], s[1 * 33]); o.y = pk2(s[2 * 33], s[3 * 33]); o.z = pk2(s[4 * 33], s[5 * 33]); o.w = pk2(s[6 * 33], s[7 * 33]);
        bf16_t* d = WT + (size_t)(dst_row0 + n) * ldt + dst_k0 + 8 * c;
        *(u32x4*)d = o; if (dup_off) *(u32x4*)(d + dup_off) = o; }
    asm volatile("s_waitcnt lgkmcnt(0)" ::: "memory");
}
__device__ __forceinline__ void weight_copies(Frame& F, int c, int n, int it0, int it1) {
    LAS float* scr = (LAS float*)(F.lds + F.wave * 16384);
    const int gw = c * 8 + F.wave, NGW = n * 8;
    constexpr int I_IN = 16 * (NZ / 32), I_A = 8 * 32, I_B = 8 * 32, I_O = 16 * 32, I_FI = 16 * (NFF2 / 32), I_FO = (DFF / 64) * 32;
    for (int it = it0 + gw; it < it1; it += NGW) {
        int r = it;
        if (r < I_IN) { const int nb = NZ / 32, kb = r / nb, n0 = 32 * (r % nb); tr_item(F.in[I_WIN], WIN_COLS, n0 < 3072 ? n0 : n0 + 8, 64 * kb, (bf16_t*)(F.ws + WS_WIN), 1024, n0, 64 * kb, 0, scr, F.lane); continue; } r -= I_IN;
        if (r < I_A) { const int kb = r / 32, n0 = 32 * (r % 32); tr_item(F.in[I_WA], 1024, n0, 64 * kb, (bf16_t*)(F.ws + WS_WAB), 512, n0, 64 * kb, 0, scr, F.lane); continue; } r -= I_A;
        if (r < I_B) { const int kb = r / 32, n0 = 32 * (r % 32); tr_item(F.in[I_WB], 1024, n0, 64 * kb, (bf16_t*)(F.ws + WS_WAB), 512, 1024 + n0, 64 * kb, 0, scr, F.lane); continue; } r -= I_B;
        if (r < I_O) { const int kb = r / 32, n0 = 32 * (r % 32); tr_item(F.in[I_WO], 1024, n0, 64 * kb, (bf16_t*)(F.ws + WS_WO2), 2048, n0, 64 * kb, 1024, scr, F.lane); continue; } r -= I_O;
        if (r < I_FI) { const int nb = NFF2 / 32, kb = r / nb, n0 = 32 * (r % nb), t = n0 >> 8, j = n0 & 255; const int src = j < 128 ? 128 * t + j : DFF + 128 * t + (j - 128);
            tr_item(F.in[I_WFI], NFF2, src, 64 * kb, (bf16_t*)(F.ws + WS_WFI), 1024, n0, 64 * kb, 0, scr, F.lane); continue; } r -= I_FI;
        { const int kb = r / 32, n0 = 32 * (r % 32); tr_item(F.in[I_WFO], 1024, n0, 64 * kb, (bf16_t*)(F.ws + WS_WFO), DFF, n0, 64 * kb, 0, scr, F.lane); }
    }
}
constexpr int WC_IN = 16 * (NZ / 32), WC_ALL = WC_IN + 8 * 32 + 8 * 32 + 16 * 32 + 16 * (NFF2 / 32) + (DFF / 64) * 32;
__device__ __forceinline__ void p0_prologue(Frame& F) {
    if (F.bid < 96) {
        LAS float* sc = (LAS float*)F.lds;
        LAS float* part = sc + 17 * 1024;
        for (int i = F.tid; i < 17 * 1024; i += 512) { const int r = i >> 10, k = i & 1023; const float c = r == 0 ? F.in[I_CP][k] : F.in[I_CS][(r - 1) * 1024 + k]; sc[i] = siluf_(c); }
        __syncthreads();
        const int n = F.bid * 64 + F.lane; const float* wa = F.in[I_WADA] + n;
        float acc[17];
#pragma unroll
        for (int r = 0; r < 17; ++r) acc[r] = 0.f;
        for (int k = F.wave * 128; k < F.wave * 128 + 128; k += 4) {
            const float w0 = wa[(size_t)k * 6144], w1 = wa[(size_t)(k + 1) * 6144], w2 = wa[(size_t)(k + 2) * 6144], w3 = wa[(size_t)(k + 3) * 6144];
#pragma unroll
            for (int r = 0; r < 17; ++r) { const f32x4 s = *(const LAS f32x4*)(sc + r * 1024 + k); acc[r] += s[0] * w0 + s[1] * w1 + s[2] * w2 + s[3] * w3; }
        }
#pragma unroll
        for (int r = 0; r < 17; ++r) part[(F.wave * 17 + r) * 64 + F.lane] = acc[r];
        __syncthreads();
        float* mod = (float*)(F.ws + WS_MOD);
        for (int i = F.tid; i < 17 * 64; i += 512) { const int r = i >> 6, l = i & 63; float s = 0.f;
#pragma unroll
            for (int w = 0; w < 8; ++w) s += part[(w * 17 + r) * 64 + l];
            mod[r * 6144 + F.bid * 64 + l] = s + F.in[I_BADA][F.bid * 64 + l]; }
        asm volatile("s_waitcnt vmcnt(0)" ::: "memory");
        __syncthreads();
        if (F.tid == 0) { __builtin_amdgcn_fence(__ATOMIC_RELEASE, "agent"); asm volatile("s_waitcnt vmcnt(0)" ::: "memory");
            __hip_atomic_fetch_add((unsigned*)(F.ws + WS_CTL) + 320, 1u, __ATOMIC_RELAXED, __HIP_MEMORY_SCOPE_AGENT); }
    }
    weight_copies(F, F.bid, F.G, 0, 16 * (NZ / 32));
}

__device__ __forceinline__ void p1_rows(Frame& F, bool wait_mod) {
    LAS float* wf = (LAS float*)F.lds;
    for (int i = F.tid; i < 1024 * 8; i += 512) wf[i] = F.in[I_WIN][(size_t)(i >> 3) * WIN_COLS + 3072 + (i & 7)];
    __syncthreads();
    const float* mod = (const float*)(F.ws + WS_MOD);
    bf16_t* XN = (bf16_t*)(F.ws + WS_XN);
    const int gw = F.bid * 8 + F.wave, NGW = F.G * 8;
    if (wait_mod) {
        if (F.tid == 0) { unsigned* w = (unsigned*)(F.ws + WS_CTL) + 320; unsigned sp = 0;
            while (__hip_atomic_load(w, __ATOMIC_RELAXED, __HIP_MEMORY_SCOPE_AGENT) < 96u && ++sp < (1u << 22)) __builtin_amdgcn_s_sleep(2);
            __builtin_amdgcn_fence(__ATOMIC_ACQUIRE, "agent"); asm volatile("s_waitcnt vmcnt(0)" ::: "memory"); }
        __syncthreads(); }
    int m = gw;
    for (; m + NGW < SEQ; m += 2 * NGW) {
        const float* xr0 = F.in[I_XP] + (size_t)m * DM; const float* xr1 = xr0 + (size_t)NGW * DM;
        float a8[2][8];
#pragma unroll
        for (int j = 0; j < 8; ++j) { a8[0][j] = 0.f; a8[1][j] = 0.f; }
#pragma unroll
        for (int j = 0; j < 4; ++j) { const int k = 4 * F.lane + 256 * j;
            const f32x4 x0 = *(const f32x4*)(xr0 + k), x1 = *(const f32x4*)(xr1 + k), s1 = *(const f32x4*)(mod + 1024 + k), t1 = *(const f32x4*)(mod + k);
            const f32x4 h0 = x0 * (s1 + 1.0f) + t1, h1 = x1 * (s1 + 1.0f) + t1;
            u32x2 w; w.x = pk2(h0[0], h0[1]); w.y = pk2(h0[2], h0[3]); *(u32x2*)(XN + (size_t)m * DM + k) = w;
            w.x = pk2(h1[0], h1[1]); w.y = pk2(h1[2], h1[3]); *(u32x2*)(XN + (size_t)(m + NGW) * DM + k) = w;
#pragma unroll
            for (int e = 0; e < 4; ++e) { const f32x4 wa = *(const LAS f32x4*)(wf + (k + e) * 8), wb = *(const LAS f32x4*)(wf + (k + e) * 8 + 4);
#pragma unroll
                for (int c = 0; c < 4; ++c) { a8[0][c] += h0[e] * wa[c]; a8[0][4 + c] += h0[e] * wb[c]; a8[1][c] += h1[e] * wa[c]; a8[1][4 + c] += h1[e] * wb[c]; } } }
        float mine = 0.f;
#pragma unroll
        for (int j = 0; j < 8; ++j) { const float s0 = wave_sum(a8[0][j]), s1 = wave_sum(a8[1][j]); if (F.lane == j) mine = s0; if (F.lane == 8 + j) mine = s1; }
        if (F.lane < 16) { const int rr = F.lane >> 3, c = F.lane & 7; const float v = mine + F.in[I_BF][c]; const float lf = fminf(v, 0.f) - log1pf(__expf(-fabsf(v)));
            F.out[O_FLP + (size_t)(m + rr * NGW) * 8 + c] = lf; }
    }
    for (; m < MT; m += NGW) {
        const bool smp = m >= SEQ; const int rb = smp ? 1 + ((m - SEQ) >> 4) : 0;
        const float* xr = smp ? F.in[I_XS] + (size_t)(m - SEQ) * DM : F.in[I_XP] + (size_t)m * DM;
        const float* sh = mod + (size_t)rb * 6144, *scl = sh + 1024;
        float a8[8];
#pragma unroll
        for (int j = 0; j < 8; ++j) a8[j] = 0.f;
#pragma unroll
        for (int j = 0; j < 4; ++j) { const int k = 4 * F.lane + 256 * j;
            const f32x4 x = *(const f32x4*)(xr + k), s1 = *(const f32x4*)(scl + k), t1 = *(const f32x4*)(sh + k);
            const f32x4 h = x * (s1 + 1.0f) + t1;
            u32x2 w; w.x = pk2(h[0], h[1]); w.y = pk2(h[2], h[3]); *(u32x2*)(XN + (size_t)m * DM + k) = w;
#pragma unroll
            for (int e = 0; e < 4; ++e) { const f32x4 wa = *(const LAS f32x4*)(wf + (k + e) * 8), wb = *(const LAS f32x4*)(wf + (k + e) * 8 + 4);
                a8[0] += h[e] * wa[0]; a8[1] += h[e] * wa[1]; a8[2] += h[e] * wa[2]; a8[3] += h[e] * wa[3];
                a8[4] += h[e] * wb[0]; a8[5] += h[e] * wb[1]; a8[6] += h[e] * wb[2]; a8[7] += h[e] * wb[3]; } }
        float mine = 0.f;
#pragma unroll
        for (int j = 0; j < 8; ++j) { const float s = wave_sum(a8[j]); if (F.lane == j) mine = s; }
        if (F.lane < 8) { const float v = mine + F.in[I_BF][F.lane]; const float lf = fminf(v, 0.f) - log1pf(__expf(-fabsf(v)));
            float* o = smp ? F.out + O_FLS + (size_t)(m - SEQ) * 8 : F.out + O_FLP + (size_t)m * 8; o[F.lane] = lf; }
    }
}

__device__ __forceinline__ float block_excl_scan(Frame& F, float tot, LAS float* sm) {
    float inc = tot;
#pragma unroll
    for (int o = 1; o < 64; o <<= 1) { const float t = __shfl_up(inc, o); if (F.lane >= o) inc += t; }
    if (F.lane == 63) sm[F.wave] = inc;
    __syncthreads();
    float base = 0.f;
    for (int w = 0; w < F.wave; ++w) base += sm[w];
    __syncthreads();
    return base + inc - tot;
}
__device__ __forceinline__ void p2_cumsum(Frame& F) {
    LAS float* sm = (LAS float*)F.lds;
    if (F.bid < 8) {
        const int h = F.bid; const float* lf = F.out + O_FLP; float* Fp = (float*)(F.ws + WS_FP) + (size_t)h * SEQ;
        float v[32]; float run = 0.f;
#pragma unroll
        for (int i = 0; i < 32; ++i) { run += lf[(size_t)(32 * F.tid + i) * 8 + h]; v[i] = run; }
        const float off = block_excl_scan(F, run, sm);
#pragma unroll
        for (int i = 0; i < 32; i += 4) *(f32x4*)(Fp + 32 * F.tid + i) = (f32x4){(off + v[i]) * LOG2E, (off + v[i + 1]) * LOG2E, (off + v[i + 2]) * LOG2E, (off + v[i + 3]) * LOG2E};
    } else if (F.bid < 8 + 128) {
        const int b = (F.bid - 8) >> 3, h = (F.bid - 8) & 7;
        const float* cl = F.in[I_CFL] + (size_t)b * PAST * 8; float* Fs = (float*)(F.ws + WS_FS) + (size_t)(b * 8 + h) * SKV;
        float v[4]; float run = 0.f;
#pragma unroll
        for (int i = 0; i < 4; ++i) { run += cl[(size_t)(4 * F.tid + i) * 8 + h]; v[i] = run; }
        const float off = block_excl_scan(F, run, sm);
        *(f32x4*)(Fs + 4 * F.tid) = (f32x4){(off + v[0]) * LOG2E, (off + v[1]) * LOG2E, (off + v[2]) * LOG2E, (off + v[3]) * LOG2E};
        if (F.tid == 511) { float r2 = off + run; const float* ls = F.out + O_FLS + (size_t)b * DEC_T * 8;
            for (int t = 0; t < DEC_T; ++t) { r2 += ls[t * 8 + h]; Fs[PAST + t] = r2 * LOG2E; } }
    }
}

template <bool FINAL> __device__ __forceinline__ void ln_rows(Frame& F, const float* g, const float* b, int KS, int gate_off) {
    const float* mod = (const float*)(F.ws + WS_MOD);
    const bf16_t* T = (const bf16_t*)(F.ws + WS_TB); bf16_t* X1B = (bf16_t*)(F.ws + WS_X1B); bf16_t* XN = (bf16_t*)(F.ws + WS_XN);
    const int gw = F.wave * F.G + F.bid, NGW = F.G * 8;
    for (int m = SEQ + gw; m < MT; m += NGW) {
        f32x4 v[4]; float s = 0.f;
        if (m < SEQ) {
#pragma unroll
            for (int j = 0; j < 2; ++j) { const u32x4 w = *(const u32x4*)(T + (size_t)m * DM + 8 * F.lane + 512 * j);
                v[2 * j] = (f32x4){bflo(w.x), bfhi(w.x), bflo(w.y), bfhi(w.y)}; v[2 * j + 1] = (f32x4){bflo(w.z), bfhi(w.z), bflo(w.w), bfhi(w.w)}; }
        } else {
            const float* sl = (const float*)(F.ws + WS_SLAB) + (size_t)(m - SEQ) * DM; const float* gp = mod + (size_t)(1 + ((m - SEQ) >> 4)) * 6144 + gate_off;
#pragma unroll
            for (int q = 0; q < 4; ++q) { const int k = 8 * F.lane + 512 * (q >> 1) + 4 * (q & 1); f32x4 a = (f32x4){0.f, 0.f, 0.f, 0.f};
                for (int ks = 0; ks < KS; ++ks) a += *(const f32x4*)(sl + (size_t)ks * NSMP * DM + k);
                f32x4 bs;
                if (FINAL) { const u32x2 w = *(const u32x2*)(X1B + (size_t)m * DM + k); bs = (f32x4){bflo(w.x), bfhi(w.x), bflo(w.y), bfhi(w.y)}; }
                else bs = *(const f32x4*)(F.in[I_XS] + (size_t)(m - SEQ) * DM + k);
                v[q] = bs * ALPHA + *(const f32x4*)(gp + k) * a; } }
#pragma unroll
        for (int q = 0; q < 4; ++q) s += (v[q][0] + v[q][1]) + (v[q][2] + v[q][3]);
        const float mean = wave_sum(s) * (1.f / DM); float s2 = 0.f;
#pragma unroll
        for (int q = 0; q < 4; ++q) { v[q] = v[q] - mean; s2 += (v[q][0] * v[q][0] + v[q][1] * v[q][1]) + (v[q][2] * v[q][2] + v[q][3] * v[q][3]); }
        const float rstd = 1.f / sqrtf(wave_sum(s2) * (1.f / DM) + LN_EPS);
        const int rb = m >= SEQ ? 1 + ((m - SEQ) >> 4) : 0;
#pragma unroll
        for (int q = 0; q < 4; ++q) { const int k = 8 * F.lane + 512 * (q >> 1) + 4 * (q & 1); const f32x4 gg = *(const f32x4*)(g + k), bb = *(const f32x4*)(b + k);
            const f32x4 y = v[q] * rstd * gg + bb;
            if (FINAL) *(f32x4*)(F.out + (size_t)m * DM + k) = y;
            else { u32x2 w; w.x = pk2(y[0], y[1]); w.y = pk2(y[2], y[3]); *(u32x2*)(X1B + (size_t)m * DM + k) = w;
                const f32x4 s2v = *(const f32x4*)(mod + (size_t)rb * 6144 + 4096 + k), t2v = *(const f32x4*)(mod + (size_t)rb * 6144 + 3072 + k);
                const f32x4 h = y * (s2v + 1.0f) + t2v; u32x2 w2; w2.x = pk2(h[0], h[1]); w2.y = pk2(h[2], h[3]); *(u32x2*)(XN + (size_t)m * DM + k) = w2; } }
    }
}

__device__ __forceinline__ int t5_bucket(int rel) {
    const int n = rel < 0 ? -rel : rel; int b;
    if (n < 8) b = n; else if (n < 12) b = 8; else if (n < 16) b = 9; else if (n < 23) b = 10; else if (n < 32) b = 11; else if (n < 46) b = 12; else if (n < 64) b = 13; else if (n < 91) b = 14; else b = 15;
    return b + (rel > 0 ? 16 : 0);
}
constexpr int AT_KB = 8192, AT_VB = 20480, AT_BUF = AT_KB + AT_VB;
constexpr int AT_WS = 2 * AT_BUF, AT_OST = AT_WS + 2048, AT_KEEP = 98304, AT_TAB = 131072, AT_MISC = AT_TAB + 4 * 192 * 4, AT_END = AT_MISC + 64;
__device__ __forceinline__ s16x4 vtr(const LAS char* p) { typedef short v4i16_t __attribute__((ext_vector_type(4))); return __builtin_bit_cast(s16x4, __builtin_amdgcn_ds_read_tr16_b64_v4i16((LAS v4i16_t*)p)); }

typedef __bf16 bf16x2_t_ __attribute__((ext_vector_type(2)));
__device__ __forceinline__ unsigned cvtpk_(float lo, float hi) { f32x2 v = {lo, hi}; bf16x2_t_ b = __builtin_convertvector(v, bf16x2_t_); return __builtin_bit_cast(unsigned, b); }
__device__ __forceinline__ void glds16_asm(const void* gsrc, unsigned lds_dst) { unsigned keep;
    asm volatile("s_mov_b32 %0, m0\n\ts_mov_b32 m0, %2\n\ts_nop 0\n\tglobal_load_lds_dwordx4 %1, off\n\ts_mov_b32 m0, %0" : "=&s"(keep) : "v"(gsrc), "s"(lds_dst) : "memory"); }
template <int OFF> __device__ __forceinline__ void glds16_asm_off(const void* gsrc, unsigned lds_dst) { unsigned keep;
    asm volatile("s_mov_b32 %0, m0\n\ts_mov_b32 m0, %2\n\ts_nop 0\n\tglobal_load_lds_dwordx4 %1, off offset:%3\n\ts_mov_b32 m0, %0" : "=&s"(keep) : "v"(gsrc), "s"(lds_dst), "i"(OFF) : "memory"); }
template <int OFF> __device__ __forceinline__ void glds16_s(const void* sbase, unsigned voff, unsigned lds_dst) { unsigned keep;
    asm volatile("s_mov_b32 %0, m0\n\ts_mov_b32 m0, %3\n\ts_nop 0\n\tglobal_load_lds_dwordx4 %1, %2 offset:%4\n\ts_mov_b32 m0, %0" : "=&s"(keep) : "v"(voff), "s"(sbase), "s"(lds_dst), "i"(OFF) : "memory"); }
__device__ __forceinline__ void glds4_s(const void* sbase, unsigned voff, unsigned lds_dst) { unsigned keep;
    asm volatile("s_mov_b32 %0, m0\n\ts_mov_b32 m0, %3\n\ts_nop 0\n\tglobal_load_lds_dword %1, %2\n\ts_mov_b32 m0, %0" : "=&s"(keep) : "v"(voff), "s"(sbase), "s"(lds_dst) : "memory"); }
__device__ __forceinline__ const void* uniform_ptr(const void* p) { const unsigned long long v = (unsigned long long)p;
    const unsigned lo = (unsigned)__builtin_amdgcn_readfirstlane((int)(unsigned)v), hi = (unsigned)__builtin_amdgcn_readfirstlane((int)(unsigned)(v >> 32)); return (const void*)(((unsigned long long)hi << 32) | lo); }
__device__ __forceinline__ void glds4_asm(const void* gsrc, unsigned lds_dst) { unsigned keep;
    asm volatile("s_mov_b32 %0, m0\n\ts_mov_b32 m0, %2\n\ts_nop 0\n\tglobal_load_lds_dword %1, off\n\ts_mov_b32 m0, %0" : "=&s"(keep) : "v"(gsrc), "s"(lds_dst) : "memory"); }
constexpr int R_V = 0, R_K = 49152, R_F = 73728, R_WS = 79872;
__device__ __forceinline__ float max3f_(float a, float b, float c) { float r; asm("v_max3_f32 %0, %1, %2, %3" : "=v"(r) : "v"(a), "v"(b), "v"(c)); return r; }
__device__ __forceinline__ float max2f_(float a, float b) { float r; asm("v_max_f32_e32 %0, %1, %2" : "=v"(r) : "v"(a), "v"(b)); return r; }
#define AP3_PIN(x) asm volatile("" : "+v"(x))
template <int MODE, int DV, int pv = 0, bool SREF = false>
__device__ __forceinline__ void attn_pass3(Frame& F, const bf16_t* Q, const bf16_t* K, const bf16_t* V, int q0, int NT, const float* Fh, int hb, f32x16 (&o)[DV / 32], int t0 = 0) {
    constexpr int NDB = DV / 32, VS = DV * 128, EPG = 8 / NDB;
    constexpr float THR = 8.0f;
    const int lane = F.lane, r32 = lane & 31, hi = lane >> 5, wid = F.wave;
    const LAS char* lds = (const LAS char*)F.lds;
    LAS float* wsf = (LAS float*)(F.lds + R_WS) + wid * 64;
    const LAS float* tab = (const LAS float*)(F.lds + AT_TAB) + hb * 192;
    const int qrow = q0 + wid * 32 + r32;
    const int tmaxw = (q0 >> 6) + (wid >> 1);
    const char* Ku = (const char*)uniform_ptr(K); const char* Vu = (const char*)uniform_ptr(V); const char* Fu = (const char*)uniform_ptr(MODE == 0 ? (const void*)Fh : (const void*)K);
    const unsigned kvo = (unsigned)(((8 * wid + (lane >> 3)) * 512 + (((lane & 7) ^ (lane >> 3)) << 3)) * 2);
    const unsigned vvo = (unsigned)(((16 * (wid & 3) + (lane >> 2)) * 512 + 32 * (wid >> 2) + 8 * (lane & 3)) * 2);
    const unsigned fvo = (unsigned)(lane * 4);
    const unsigned lds0 = (unsigned)(size_t)F.lds;
    const unsigned dk = (unsigned)__builtin_amdgcn_readfirstlane((int)(lds0 + R_K + wid * 1024)), dv = (unsigned)__builtin_amdgcn_readfirstlane((int)(lds0 + R_V + wid * 1024)),
                   df = (unsigned)__builtin_amdgcn_readfirstlane((int)(lds0 + R_F + wid * 256));
#define AP_ISSUE_K(t, SL) do { glds16_s<0>(Ku + (size_t)(t) * 65536, kvo, dk + (SL) * 8192); if (MODE == 0) glds4_s(Fu + (size_t)(t) * 256, fvo, df + (SL) * 2048); } while (0)
#define AP_ISSUE_V(t, SL) do { glds16_s<0>(Vu + (size_t)(t) * 65536, vvo, dv + (SL) * VS); if (DV == 128) glds16_s<0>(Vu + (size_t)(t) * 65536 + 128, vvo, dv + (SL) * VS + 8192); } while (0)
#define AP_BATCH(t, SL) do { if (pv != 1) { if ((t) + 2 < NT) AP_ISSUE_K((t) + 2, ((SL) + 2) % 3); if ((t) + 1 < NT) AP_ISSUE_V((t) + 1, ((SL) + 1) % 3); } } while (0)
    AP_ISSUE_K(t0, 0); AP_ISSUE_K(t0 + 1, 1); AP_ISSUE_V(t0, 0);
    bf16x8 qr[4];
#pragma unroll
    for (int d0 = 0; d0 < 4; ++d0) qr[d0] = *(const bf16x8*)(Q + (size_t)qrow * 512 + d0 * 16 + hi * 8);
    float fqp = MODE == 0 ? Fh[qrow] : 0.f;
#pragma unroll
    for (int d = 0; d < NDB; ++d) o[d] = f32x16{};
    float m_hat = 0.f, l_run = 0.f;
    f32x16 p0, p1, negm; u32x4 pwv[4];
#pragma unroll
    for (int r = 0; r < 16; ++r) negm[r] = 0.f;
#pragma unroll
    for (int i = 0; i < 4; ++i) pwv[i] = (u32x4){0u, 0u, 0u, 0u};
    const LAS char* kb4[4];
#pragma unroll
    for (int d0 = 0; d0 < 4; ++d0) kb4[d0] = lds + R_K + r32 * 128 + (((2 * d0 + hi) ^ (r32 & 7)) << 4);
    const LAS char* vb1 = lds + R_V + (4 * hi + ((lane & 15) >> 2)) * 64 + (((lane >> 4) & 1) * 16 + (lane & 3) * 4) * 2;
    const LAS char* fb1 = lds + R_F + wid * 256 + 16 * hi;
    asm volatile("s_waitcnt vmcnt(0)" ::: "memory");
    asm volatile("" : "+v"(qr[0]), "+v"(qr[1]), "+v"(qr[2]), "+v"(qr[3]), "+v"(fqp));
    asm volatile("s_waitcnt lgkmcnt(0)\n\ts_barrier" ::: "memory");
#define AP3_VFL(buf, ks, SLV) do { _Pragma("unroll") for (int d = 0; d < NDB; ++d) { buf[2 * d] = vtr(vb1 + (SLV) * VS + d * 4096 + (ks) * 1024); buf[2 * d + 1] = vtr(vb1 + (SLV) * VS + d * 4096 + (ks) * 1024 + 512); } } while (0)
#define AP3_VFL1(buf, d, ks, SLV) do { buf[2 * (d)] = vtr(vb1 + (SLV) * VS + (d) * 4096 + (ks) * 1024); buf[2 * (d) + 1] = vtr(vb1 + (SLV) * VS + (d) * 4096 + (ks) * 1024 + 512); } while (0)
#define AP3_FRAG(buf, d) ((bf16x8){buf[2 * (d)][0], buf[2 * (d)][1], buf[2 * (d)][2], buf[2 * (d)][3], buf[2 * (d) + 1][0], buf[2 * (d) + 1][1], buf[2 * (d) + 1][2], buf[2 * (d) + 1][3]})
#define AP3_GAP(ks, d, VCUR, VNXT, PC, BC, PP, BP, HASPREV, HASNEXT, SLV) do { \
        o[d] = __builtin_amdgcn_mfma_f32_32x32x16_bf16(__builtin_bit_cast(bf16x8, pwv[ks]), AP3_FRAG(VCUR, d), o[d], 0, 0, 0); \
        if (HASNEXT) AP3_VFL1(VNXT, d, (ks) + 1, SLV); \
        _Pragma("unroll") for (int e = 0; e < EPG; ++e) { PC[(BC) + EPG * (d) + e] = __builtin_amdgcn_exp2f(PC[(BC) + EPG * (d) + e]); } \
        if (HASPREV) { _Pragma("unroll") for (int e = 0; e < EPG; ++e) rs += PP[(BP) + EPG * (d) + e]; \
            _Pragma("unroll") for (int e = 0; e < EPG / 2; ++e) pwv[(ks) - 1][(EPG / 2) * (d) + e] = cvtpk_(PP[(BP) + EPG * (d) + 2 * e], PP[(BP) + EPG * (d) + 2 * e + 1]); AP3_PIN(rs); } \
        AP3_PIN(PC); \
        __builtin_amdgcn_sched_barrier(0); } while (0)
#define AP3_GROUP(ks, VCUR, VNXT, PC, BC, PP, BP, HASPREV, HASNEXT, SLV) do { _Pragma("unroll") for (int d = 0; d < NDB; ++d) AP3_GAP(ks, d, VCUR, VNXT, PC, BC, PP, BP, HASPREV, HASNEXT, SLV); } while (0)
#define AP3_OCT(PC, BC, KS) do { _Pragma("unroll") for (int e = 0; e < 8; ++e) { PC[(BC) + e] = __builtin_amdgcn_exp2f(PC[(BC) + e]); rs += PC[(BC) + e]; } \
        _Pragma("unroll") for (int e = 0; e < 4; ++e) pwv[KS][e] = cvtpk_(PC[(BC) + 2 * e], PC[(BC) + 2 * e + 1]); } while (0)
#define AP3_KRD(i, SL) (*(const LAS bf16x8*)(kb4[(i) >> 1] + (SL) * 8192 + ((i) & 1) * 4096))
#define AP3_MM(KF, d0, P) P = __builtin_amdgcn_mfma_f32_32x32x16_bf16(KF, qr[d0], P, 0, 0, 0)
#define AP3_QKF(SL) do { bf16x8 ka = AP3_KRD(0, SL), kb = AP3_KRD(1, SL), kc = AP3_KRD(2, SL); \
        if (MODE == 0) { \
            _Pragma("unroll") for (int g4 = 0; g4 < 4; ++g4) { const f32x4 fa = *(const LAS f32x4*)(fb1 + (SL) * 2048 + 32 * g4), fb = *(const LAS f32x4*)(fb1 + (SL) * 2048 + 128 + 32 * g4); \
                _Pragma("unroll") for (int e = 0; e < 4; ++e) { p0[4 * g4 + e] = fqp - fa[e]; p1[4 * g4 + e] = fqp - fb[e]; } } \
        } else { p0 = f32x16{}; p1 = f32x16{}; } \
        __builtin_amdgcn_sched_barrier(0); \
        AP3_MM(ka, 0, p0); ka = AP3_KRD(3, SL); __builtin_amdgcn_sched_barrier(0); \
        AP3_MM(kb, 0, p1); kb = AP3_KRD(4, SL); __builtin_amdgcn_sched_barrier(0); \
        AP3_MM(kc, 1, p0); kc = AP3_KRD(5, SL); __builtin_amdgcn_sched_barrier(0); \
        AP3_MM(ka, 1, p1); ka = AP3_KRD(6, SL); __builtin_amdgcn_sched_barrier(0); \
        AP3_MM(kb, 2, p0); kb = AP3_KRD(7, SL); __builtin_amdgcn_sched_barrier(0); \
        AP3_MM(kc, 2, p1); __builtin_amdgcn_sched_barrier(0); \
        AP3_MM(ka, 3, p0); __builtin_amdgcn_sched_barrier(0); \
        AP3_MM(kb, 3, p1); \
        asm volatile("" : "+v"(p0), "+v"(p1)); \
    } while (0)
#define AP3_QKS(SL) do { bf16x8 kf[8]; \
        _Pragma("unroll") for (int d0 = 0; d0 < 4; ++d0) { kf[2 * d0] = *(const LAS bf16x8*)(kb4[d0] + (SL) * 8192); kf[2 * d0 + 1] = *(const LAS bf16x8*)(kb4[d0] + (SL) * 8192 + 4096); } \
        if (MODE == 0) { const float sft = fqp - m_hat; \
            _Pragma("unroll") for (int g4 = 0; g4 < 4; ++g4) { const f32x4 fa = *(const LAS f32x4*)(fb1 + (SL) * 2048 + 32 * g4), fb = *(const LAS f32x4*)(fb1 + (SL) * 2048 + 128 + 32 * g4); \
                _Pragma("unroll") for (int e = 0; e < 4; ++e) { p0[4 * g4 + e] = sft - fa[e]; p1[4 * g4 + e] = sft - fb[e]; } } \
            _Pragma("unroll") for (int d0 = 0; d0 < 4; ++d0) { p0 = __builtin_amdgcn_mfma_f32_32x32x16_bf16(kf[2 * d0], qr[d0], p0, 0, 0, 0); p1 = __builtin_amdgcn_mfma_f32_32x32x16_bf16(kf[2 * d0 + 1], qr[d0], p1, 0, 0, 0); } \
        } else { \
            if constexpr (SREF) { p0 = __builtin_amdgcn_mfma_f32_32x32x16_bf16(kf[0], qr[0], f32x16{}, 0, 0, 0); p1 = __builtin_amdgcn_mfma_f32_32x32x16_bf16(kf[1], qr[0], f32x16{}, 0, 0, 0); } \
            else { p0 = __builtin_amdgcn_mfma_f32_32x32x16_bf16(kf[0], qr[0], negm, 0, 0, 0); p1 = __builtin_amdgcn_mfma_f32_32x32x16_bf16(kf[1], qr[0], negm, 0, 0, 0); } \
            _Pragma("unroll") for (int d0 = 1; d0 < 4; ++d0) { p0 = __builtin_amdgcn_mfma_f32_32x32x16_bf16(kf[2 * d0], qr[d0], p0, 0, 0, 0); p1 = __builtin_amdgcn_mfma_f32_32x32x16_bf16(kf[2 * d0 + 1], qr[d0], p1, 0, 0, 0); } } \
        if constexpr (SREF) asm volatile("" : "+v"(p0), "+v"(p1)); else asm volatile("s_nop 15\n\ts_nop 7" : "+v"(p0), "+v"(p1));     \
    } while (0)
#define AP3_QK(SL) do { if constexpr (SREF) AP3_QKF(SL); else AP3_QKS(SL); } while (0)
#define AP3_DECIDE(WITH_TAB) do { \
        if (MODE == 0) { \
            if (t * 64 + 63 > q0 + wid * 32) { const int ln_ = lane_id_opaque(), kv0 = t * 64 + 4 * (ln_ >> 5), qrow_ = q0 + wid * 32 + (ln_ & 31);     \
                _Pragma("unroll") for (int r = 0; r < 16; ++r) { const int kv = kv0 + (r & 3) + 8 * (r >> 2); if (kv > qrow_) p0[r] = -1e30f; if (kv + 32 > qrow_) p1[r] = -1e30f; } } \
        } else if (WITH_TAB) { \
            if (near) { const int ln_ = lane_id_opaque(), kv0 = t * 64 + 4 * (ln_ >> 5), qrow_ = q0 + wid * 32 + (ln_ & 31); const LAS float* tab_ = (const LAS float*)(F.lds + AT_TAB) + hb * 192; \
                _Pragma("unroll") for (int g4 = 0; g4 < 4; ++g4) { \
                    _Pragma("unroll") for (int e = 0; e < 4; ++e) { const int r = 4 * g4 + e; const int rel = kv0 + e + 8 * g4 - qrow_; int i0 = rel + 128, i1 = rel + 160; i0 = i0 < 0 ? 0 : i0; i1 = i1 < 0 ? 0 : i1; \
                        p0[r] += tab_[i0]; p1[r] += tab_[i1]; } \
                    __builtin_amdgcn_sched_barrier(0); } } } \
        if constexpr (!SREF) { \
        float ma = max3f_(p0[0], p0[1], p1[0]), mb = max3f_(p0[2], p0[3], p1[1]); ma = max3f_(ma, p1[2], p1[3]); \
        _Pragma("unroll") for (int r = 4; r < 16; r += 4) { ma = max3f_(ma, p0[r], p0[r + 1]); mb = max3f_(mb, p0[r + 2], p0[r + 3]); ma = max3f_(ma, p1[r], p1[r + 1]); mb = max3f_(mb, p1[r + 2], p1[r + 3]); } \
        float rm = max2f_(ma, mb); \
        { auto rr = __builtin_amdgcn_permlane32_swap(__float_as_uint(rm), __float_as_uint(rm), false, false); rm = max2f_(__uint_as_float(rr[0]), __uint_as_float(rr[1])); } \
        resc = (tz == t0) || __any(rm > THR); \
        if (resc) { const float dl = tz == t0 ? rm : fmaxf(rm, 0.f); m_hat += dl; \
            _Pragma("unroll") for (int r = 0; r < 16; ++r) { p0[r] -= dl; p1[r] -= dl; } \
            if (MODE == 1) { const float nm_ = -m_hat; _Pragma("unroll") for (int r = 0; r < 16; ++r) negm[r] = nm_; } \
            al = tz == t0 ? 1.0f : __builtin_amdgcn_exp2f(-dl); l_run *= al; } } } while (0)
#define AP3_STEP(tt, SL) do { const int t = (tt); if (t > NT) break; int tz = t; asm volatile("" : "+s"(tz)); \
        if (t < NT) AP_BATCH(t, SL); \
        const bool doPV = tz > t0 && t - 1 <= tmaxw, doQK = t < NT && t <= tmaxw; \
        bool resc = false; float al = 1.0f, rs = 0.f; \
        const bool near = MODE == 1 && (t * 64 + 63 + 91 > q0 + wid * 32); \
        if (doQK) AP3_QK(SL); else { p0 = f32x16{}; p1 = f32x16{}; }     \
        __builtin_amdgcn_sched_barrier(0); \
        if (doQK) AP3_DECIDE(true); \
        __builtin_amdgcn_sched_barrier(0); \
        if (doPV) { s16x4 vfa[2 * NDB]; AP3_VFL(vfa, 0, ((SL) + 2) % 3);     \
            AP3_GROUP(0, vfa, vfa, p0, 0, p0, 0, false, true, ((SL) + 2) % 3); \
            AP3_GROUP(1, vfa, vfa, p0, 8, p0, 0, true, true, ((SL) + 2) % 3); \
            AP3_GROUP(2, vfa, vfa, p1, 0, p0, 8, true, true, ((SL) + 2) % 3); \
            AP3_GROUP(3, vfa, vfa, p1, 8, p1, 0, true, false, ((SL) + 2) % 3); \
            _Pragma("unroll") for (int e = 0; e < 8; ++e) rs += p1[8 + e]; \
            _Pragma("unroll") for (int e = 0; e < 4; ++e) pwv[3][e] = cvtpk_(p1[8 + 2 * e], p1[8 + 2 * e + 1]); \
        } else if (doQK) { AP3_OCT(p0, 0, 0); AP3_OCT(p0, 8, 1); AP3_OCT(p1, 0, 2); AP3_OCT(p1, 8, 3); } \
        if (doQK) l_run += rs; \
          \
        if (resc && tz > t0) { \
            if (hi == 0) wsf[r32] = al; \
            asm volatile("s_waitcnt lgkmcnt(0)" ::: "memory"); \
            _Pragma("unroll") for (int g4 = 0; g4 < 4; ++g4) { const f32x4 a4 = *(const LAS f32x4*)(wsf + 8 * g4 + 4 * hi); \
                _Pragma("unroll") for (int d = 0; d < NDB; ++d) \
                    _Pragma("unroll") for (int e = 0; e < 4; ++e) o[d][4 * g4 + e] *= a4[e]; } } \
        if (t == NT) break; \
        if (pv == 6) { if (t + 2 < NT) asm volatile("s_waitcnt vmcnt(3) lgkmcnt(0)" ::: "memory"); else asm volatile("s_waitcnt vmcnt(0) lgkmcnt(0)" ::: "memory"); } \
        else { if (t + 2 < NT) asm volatile("s_waitcnt vmcnt(3) lgkmcnt(0)\n\ts_barrier" ::: "memory"); else asm volatile("s_waitcnt vmcnt(0) lgkmcnt(0)\n\ts_barrier" ::: "memory"); } \
    } while (0)
#define AP3_FSTEP(tt, SL) do { const int t = (tt); \
        AP_ISSUE_K(t + 2, ((SL) + 2) % 3); AP_ISSUE_V(t + 1, ((SL) + 1) % 3); \
        float rs = 0.f; \
        AP3_QKF(SL); \
        __builtin_amdgcn_sched_barrier(0); \
        { s16x4 vfa[2 * NDB]; AP3_VFL(vfa, 0, ((SL) + 2) % 3); \
          AP3_GROUP(0, vfa, vfa, p0, 0, p0, 0, false, true, ((SL) + 2) % 3); \
          AP3_GROUP(1, vfa, vfa, p0, 8, p0, 0, true, true, ((SL) + 2) % 3); \
          AP3_GROUP(2, vfa, vfa, p1, 0, p0, 8, true, true, ((SL) + 2) % 3); \
          AP3_GROUP(3, vfa, vfa, p1, 8, p1, 0, true, false, ((SL) + 2) % 3); \
          _Pragma("unroll") for (int e = 0; e < 8; ++e) rs += p1[8 + e]; \
          _Pragma("unroll") for (int e = 0; e < 4; ++e) pwv[3][e] = cvtpk_(p1[8 + 2 * e], p1[8 + 2 * e + 1]); } \
        l_run += rs; \
        asm volatile("s_waitcnt vmcnt(3) lgkmcnt(0)\n\ts_barrier" ::: "memory"); \
    } while (0)
    if (wid >= 4) __builtin_amdgcn_s_setprio(1);
    int t3 = t0;
    if constexpr (SREF && pv == 0) {
        AP3_STEP(t3, 0); AP3_STEP(t3 + 1, 1); AP3_STEP(t3 + 2, 2); t3 += 3;
        const int tfe = (q0 >> 6) - 3;
        for (; t3 + 2 <= tfe; t3 += 3) { AP3_FSTEP(t3, 0); AP3_FSTEP(t3 + 1, 1); AP3_FSTEP(t3 + 2, 2); }
    }
    for (; t3 <= NT; t3 += 3) { AP3_STEP(t3, 0); AP3_STEP(t3 + 1, 1); AP3_STEP(t3 + 2, 2); }
    if (wid >= 4) __builtin_amdgcn_s_setprio(0);
    asm volatile("s_waitcnt lgkmcnt(0)\n\ts_barrier" ::: "memory");
    l_run += __shfl_xor(l_run, 32);
    if (hi == 0) wsf[r32] = 1.0f / l_run;
    asm volatile("s_waitcnt lgkmcnt(0)" ::: "memory");
#pragma unroll
    for (int g4 = 0; g4 < 4; ++g4) { const f32x4 a4 = *(const LAS f32x4*)(wsf + 8 * g4 + 4 * hi);
#pragma unroll
        for (int d = 0; d < NDB; ++d)
#pragma unroll
            for (int e = 0; e < 4; ++e) o[d][4 * g4 + e] *= a4[e]; }
#undef AP_ISSUE_K
#undef AP_ISSUE_V
#undef AP_BATCH
#undef AP3_VFL
#undef AP3_VFL1
#undef AP3_FRAG
#undef AP3_GAP
#undef AP3_GROUP
#undef AP3_OCT
#undef AP3_STEP
#undef AP3_FSTEP
#undef AP3_QK
#undef AP3_QKF
#undef AP3_QKS
#undef AP3_KRD
#undef AP3_MM
#undef AP3_DECIDE
}

template <int NDB> __device__ __forceinline__ void store_o(const f32x16 (&o)[NDB], LAS unsigned char* stgb  , bf16_t* dst  , int ld, int lane) {
    const int r32 = lane & 31, hi = lane >> 5;
    constexpr int DVC = 32 * NDB;
    LAS bf16_t* stg = (LAS bf16_t*)stgb;
#pragma unroll
    for (int d = 0; d < NDB; ++d)
#pragma unroll
        for (int r = 0; r < 16; ++r) { const int row = (r & 3) + 8 * (r >> 2) + 4 * hi; stg[row * DVC + 32 * d + r32] = (bf16_t)f2bf(o[d][r]); }
    asm volatile("s_waitcnt lgkmcnt(0)" ::: "memory");
    constexpr int CPR = DVC / 8;
#pragma unroll
    for (int i = 0; i < (32 * CPR) / 64; ++i) { const int c = i * 64 + lane, row = c / CPR, ch = c % CPR;
        const u32x4 v = *(const LAS u32x4*)(stg + row * DVC + ch * 8); *(u32x4*)(dst + (size_t)row * ld + ch * 8) = v; }
    asm volatile("s_waitcnt lgkmcnt(0)" ::: "memory");
}

__device__ __forceinline__ float lambda_full(Frame& F) {
    float a = 0.f, b = 0.f;
    for (int i = 0; i < 64; ++i) { a += F.in[I_LQ1][i] * F.in[I_LK1][i]; b += F.in[I_LQ2][i] * F.in[I_LK2][i]; }
    return __expf(a) - __expf(b) + 0.2f;
}

template <int pv = 0> __device__ __forceinline__ void attn_prompt_fox(Frame& F, int h, int qb) {
    const bf16_t* Q = (const bf16_t*)(F.ws + WS_QB) + h * 64; const bf16_t* K = (const bf16_t*)(F.ws + WS_KB) + h * 64; const bf16_t* V = (const bf16_t*)(F.ws + WS_VB) + h * 64;
    f32x16 o[2];
    const float* Fh = (const float*)(F.ws + WS_FP) + (size_t)h * SEQ;
    int t0 = 0; bool fast;
    { const unsigned* nw = (const unsigned*)(F.ws + WS_CTL) + 256;
      const float qn2 = __uint_as_float(nw[h * 2]) + __uint_as_float(nw[h * 2 + 1]), kn2 = __uint_as_float(nw[16 + h * 2]) + __uint_as_float(nw[16 + h * 2 + 1]);
      const float B = sqrtf(qn2 * kn2) * 1.02f + 0.5f;
      const float thresh = -48.0f - 2.0f * B;
      fast = __builtin_amdgcn_readfirstlane(B <= 60.0f ? 1 : 0) != 0;
      volatile LAS int* cnt = (volatile LAS int*)(F.lds + AT_MISC + 32);
      __syncthreads();
      if (F.tid < 256) { const int t = F.tid; const bool sk = t < 4 * qb && (Fh[qb * 256] - Fh[64 * t + 63]) <= thresh;
          const int c = __popcll(__ballot(sk)); if (F.lane == 0) cnt[F.wave] = c; }
      __syncthreads();
      t0 = cnt[0] + cnt[1] + cnt[2] + cnt[3]; t0 -= t0 % 3; }
    if (fast) attn_pass3<0, 64, pv, true>(F, Q, K, V, qb * 256, 4 * qb + 4, Fh, 0, o, t0); else attn_pass3<0, 64, pv, false>(F, Q, K, V, qb * 256, 4 * qb + 4, Fh, 0, o, t0);
    if (pv != 0 && o[0][0] != 1234.5678f) { __syncthreads(); return; }
    bf16_t* AB = (bf16_t*)(F.ws + WS_AB);
    store_o<2>(o, F.lds + F.wave * 8192, AB + (size_t)(qb * 256 + F.wave * 32) * DM + 512 + h * 64, DM, F.lane);
    __syncthreads();
}
template <int pv = 0> __device__ __forceinline__ void attn_prompt_diff_half(Frame& F, int h, int half, int qb) {
    const bf16_t* Q = (const bf16_t*)(F.ws + WS_QA) + h * 128 + 64 * half; const bf16_t* K = (const bf16_t*)(F.ws + WS_KA) + h * 128 + 64 * half; const bf16_t* V = (const bf16_t*)(F.ws + WS_VA) + h * 128;
    f32x16 o[4];
    bool fast;
    { const unsigned* nw = (const unsigned*)(F.ws + WS_CTL) + 288; const int hh = h * 2 + half;
      const float qn2 = __uint_as_float(nw[hh * 2]) + __uint_as_float(nw[hh * 2 + 1]), kn2 = __uint_as_float(nw[16 + hh * 2]) + __uint_as_float(nw[16 + hh * 2 + 1]);
      float bm = 0.f; for (int b = 0; b < 32; ++b) bm = fmaxf(bm, fabsf(F.in[I_RELB][b * 4 + h] - F.in[I_RELB][15 * 4 + h]));
      const float B = sqrtf(qn2 * kn2) * 1.02f + 0.5f + bm * LOG2E;
      fast = __builtin_amdgcn_readfirstlane(B <= 60.0f ? 1 : 0) != 0; }
    if (fast) attn_pass3<1, 128, pv, true>(F, Q, K, V, qb * 256, 4 * qb + 4, nullptr, h, o); else attn_pass3<1, 128, pv, false>(F, Q, K, V, qb * 256, 4 * qb + 4, nullptr, h, o);
    if (pv != 0 && o[0][0] != 1234.5678f) { __syncthreads(); return; }
    bf16_t* OD = (bf16_t*)(F.ws + (half ? WS_OD2 : WS_OD1));
    store_o<4>(o, F.lds + F.wave * 8192, OD + (size_t)(qb * 256 + F.wave * 32) * 512 + h * 128, 512, F.lane);
    __syncthreads();
}
constexpr int PF_STR = 66, PD_STR = 130;
__device__ __forceinline__ void p_combine(Frame& F) {
    const float lam = lambda_full(F);
    const bf16_t* O1 = (const bf16_t*)(F.ws + WS_OD1); const bf16_t* O2 = (const bf16_t*)(F.ws + WS_OD2); bf16_t* AB = (bf16_t*)(F.ws + WS_AB);
    const int gw = F.bid * 8 + F.wave, NGW = F.G * 8;
    const int c0 = 8 * F.lane;
    float sg[8];
#pragma unroll
    for (int i = 0; i < 8; ++i) sg[i] = F.in[I_SUBG][(c0 & 127) + i] * 0.8f;
    for (int m0 = gw; m0 < SEQ; m0 += 4 * NGW) {
        u32x4 a[4], b[4];
#pragma unroll
        for (int r = 0; r < 4; ++r) { const int m = m0 + r * NGW; if (m < SEQ) { a[r] = *(const u32x4*)(O1 + (size_t)m * 512 + c0); b[r] = *(const u32x4*)(O2 + (size_t)m * 512 + c0); } else { a[r] = (u32x4){0u, 0u, 0u, 0u}; b[r] = a[r]; } }
#pragma unroll
        for (int r = 0; r < 4; ++r) { const int m = m0 + r * NGW;
            float v[8];
            v[0] = bflo(a[r].x) - lam * bflo(b[r].x); v[1] = bfhi(a[r].x) - lam * bfhi(b[r].x); v[2] = bflo(a[r].y) - lam * bflo(b[r].y); v[3] = bfhi(a[r].y) - lam * bfhi(b[r].y);
            v[4] = bflo(a[r].z) - lam * bflo(b[r].z); v[5] = bfhi(a[r].z) - lam * bfhi(b[r].z); v[6] = bflo(a[r].w) - lam * bflo(b[r].w); v[7] = bfhi(a[r].w) - lam * bfhi(b[r].w);
            float ss = 0.f;
#pragma unroll
            for (int i = 0; i < 8; ++i) ss += v[i] * v[i];
#pragma unroll
            for (int ofs = 1; ofs < 16; ofs <<= 1) ss += __shfl_xor(ss, ofs);
            const float rn = 1.0f / sqrtf(ss * (1.0f / 128.0f) + LN_EPS);
            u32x4 w; w.x = pk2(v[0] * rn * sg[0], v[1] * rn * sg[1]); w.y = pk2(v[2] * rn * sg[2], v[3] * rn * sg[3]); w.z = pk2(v[4] * rn * sg[4], v[5] * rn * sg[5]); w.w = pk2(v[6] * rn * sg[6], v[7] * rn * sg[7]);
            if (m < SEQ) *(u32x4*)(AB + (size_t)m * DM + c0) = w; }
    }
    for (int it = gw; it < NSMP; it += NGW) {
        const int b = it >> 4, q = it & 15; const size_t row = (size_t)SEQ + it;
        {
            const int h = F.lane >> 3, cc = (F.lane & 7) * 8; const float* P = (const float*)(F.ws + WS_PF);
            float M = -1e30f;
            for (int s = 0; s < 8; ++s) M = fmaxf(M, P[((size_t)((b * 8 + s) * 8 + h) * 16 + q) * PF_STR + 64]);
            float acc[8], L = 0.f;
#pragma unroll
            for (int i = 0; i < 8; ++i) acc[i] = 0.f;
            for (int s = 0; s < 8; ++s) { const float* pr = P + ((size_t)((b * 8 + s) * 8 + h) * 16 + q) * PF_STR; const float wgt = __builtin_amdgcn_exp2f(pr[64] - M); L += wgt * pr[65];
#pragma unroll
                for (int i = 0; i < 8; ++i) acc[i] += wgt * pr[cc + i]; }
            const float inv = 1.0f / L;
            u32x4 w; w.x = pk2(acc[0] * inv, acc[1] * inv); w.y = pk2(acc[2] * inv, acc[3] * inv); w.z = pk2(acc[4] * inv, acc[5] * inv); w.w = pk2(acc[6] * inv, acc[7] * inv);
            *(u32x4*)(AB + row * DM + 512 + c0) = w; }
        {
            const int h = F.lane >> 4, cc = (F.lane & 15) * 8; const float* P = (const float*)(F.ws + WS_PD);
            float v[8];
#pragma unroll
            for (int i = 0; i < 8; ++i) v[i] = 0.f;
#pragma unroll
            for (int half = 0; half < 2; ++half) {
                float M = -1e30f;
                for (int s = 0; s < 8; ++s) M = fmaxf(M, P[((size_t)((b * 8 + s) * 8 + 2 * h + half) * 16 + q) * PD_STR + 128]);
                float acc[8], L = 0.f;
#pragma unroll
                for (int i = 0; i < 8; ++i) acc[i] = 0.f;
                for (int s = 0; s < 8; ++s) { const float* pr = P + ((size_t)((b * 8 + s) * 8 + 2 * h + half) * 16 + q) * PD_STR; const float wgt = __builtin_amdgcn_exp2f(pr[128] - M); L += wgt * pr[129];
#pragma unroll
                    for (int i = 0; i < 8; ++i) acc[i] += wgt * pr[cc + i]; }
                const float sc = (half ? -lam : 1.0f) / L;
#pragma unroll
                for (int i = 0; i < 8; ++i) v[i] += acc[i] * sc; }
            float ss = 0.f;
#pragma unroll
            for (int i = 0; i < 8; ++i) ss += v[i] * v[i];
#pragma unroll
            for (int ofs = 1; ofs < 16; ofs <<= 1) ss += __shfl_xor(ss, ofs);
            const float rn = 1.0f / sqrtf(ss * (1.0f / 128.0f) + LN_EPS);
            u32x4 w; w.x = pk2(v[0] * rn * sg[0], v[1] * rn * sg[1]); w.y = pk2(v[2] * rn * sg[2], v[3] * rn * sg[3]); w.z = pk2(v[4] * rn * sg[4], v[5] * rn * sg[5]); w.w = pk2(v[6] * rn * sg[6], v[7] * rn * sg[7]);
            *(u32x4*)(AB + row * DM + c0) = w; }
    }
}

constexpr int SM_K = 0, SM_V = 32768, SM_F = 81920, SM_WS = 83968;
template <int KIND  > __device__ __forceinline__ void sample_unit(Frame& F, int b, int s) {
    constexpr int DV = KIND == 0 ? 64 : 128, NDB = DV / 32, VSTR = KIND == 0 ? 192 : 320, VSUB = 16 * VSTR;
    const int lane = lane_id_opaque(), r32 = lane & 31, hi = lane >> 5, w = F.wave, tid = w * 64 + lane;
    const LAS char* lds = (const LAS char*)F.lds;
    LAS float* wsf = (LAS float*)(F.lds + SM_WS) + w * 64;
    const int hb = KIND == 0 ? w : (w >> 1);
    const LAS float* tab = (const LAS float*)(F.lds + AT_TAB) + hb * 192;
    const int q = r32 & 15, qpos = PAST + q;
    const size_t qrow = (size_t)SEQ + b * DEC_T + q;
    const bf16_t* Qp = (const bf16_t*)(F.ws + (KIND == 0 ? WS_QB : WS_QA)) + qrow * 512 + w * 64;
    bf16x8 qr[4];
#pragma unroll
    for (int d0 = 0; d0 < 4; ++d0) qr[d0] = *(const bf16x8*)(Qp + d0 * 16 + hi * 8);
    const float* Fs = (const float*)(F.ws + WS_FS) + (size_t)(b * 8 + w) * SKV;
    const float fq = KIND == 0 ? Fs[qpos] : 0.f;
    const float* Kc = F.in[KIND == 0 ? I_CFK : I_CDK] + (size_t)b * PAST * 512; const float* Vc = F.in[KIND == 0 ? I_CFV : I_CDV] + (size_t)b * PAST * 512;
    const float* Kn = F.out + (KIND == 0 ? O_FKS : O_DKS) + (size_t)b * DEC_T * 512; const float* Vn = F.out + (KIND == 0 ? O_FVS : O_DVS) + (size_t)b * DEC_T * 512;
    const int kr = tid >> 5, c16 = (tid & 31) * 16;
    const int ksub = c16 >> 6, kch = (c16 >> 3) & 7;
    const int kdst = SM_K + ksub * 4096 + kr * 128;
    const int vdst = KIND == 0 ? SM_V + ksub * VSUB + kr * VSTR + kch * 16 : SM_V + (c16 >> 7) * VSUB + kr * VSTR + ((c16 >> 3) & 15) * 16;
    f32x16 o[NDB];
#pragma unroll
    for (int d = 0; d < NDB; ++d) o[d] = f32x16{};
    float m_run = -1e30f, l_run = 0.f;
    f32x4 gkA[4], gvA[4], gkB[4], gvB[4]; float gfA = 0.f, gfB = 0.f;
    const int nt = s == 0 ? 17 : 16;
    auto gload = [&](f32x4 (&gk)[4], f32x4 (&gv)[4], float& gf, int t) {
        const float* ks; const float* vs;
        if (t < 128) { ks = Kc + (size_t)(16 * t + kr) * 512 + c16; vs = Vc + (size_t)(16 * t + kr) * 512 + c16; }
        else { ks = Kn + (size_t)kr * 512 + c16; vs = Vn + (size_t)kr * 512 + c16; }
#pragma unroll
        for (int j = 0; j < 4; ++j) { gk[j] = *(const f32x4*)(ks + 4 * j); gv[j] = *(const f32x4*)(vs + 4 * j); }
        if (KIND == 0 && tid < 128) gf = ((const float*)(F.ws + WS_FS))[(size_t)(b * 8 + (tid >> 4)) * SKV + 16 * t + (tid & 15)];
    };
    auto lwrite = [&](const f32x4 (&gk)[4], const f32x4 (&gv)[4], float gf) {
#pragma unroll
        for (int j = 0; j < 2; ++j) { u32x4 wk, wv;
            wk.x = pk2(gk[2 * j][0], gk[2 * j][1]); wk.y = pk2(gk[2 * j][2], gk[2 * j][3]); wk.z = pk2(gk[2 * j + 1][0], gk[2 * j + 1][1]); wk.w = pk2(gk[2 * j + 1][2], gk[2 * j + 1][3]);
            wv.x = pk2(gv[2 * j][0], gv[2 * j][1]); wv.y = pk2(gv[2 * j][2], gv[2 * j][3]); wv.z = pk2(gv[2 * j + 1][0], gv[2 * j + 1][1]); wv.w = pk2(gv[2 * j + 1][2], gv[2 * j + 1][3]);
            *(LAS u32x4*)(F.lds + kdst + (((kch + j) ^ (kr & 7)) << 4)) = wk;
            *(LAS u32x4*)(F.lds + vdst + j * 16) = wv; }
        if (KIND == 0 && tid < 128) ((LAS float*)(F.lds + SM_F))[tid] = gf;
    };
    gload(gkA, gvA, gfA, s); gload(gkB, gvB, gfB, s + 8);
    __syncthreads();
    { const int sub = tid >> 6, rr = 16 + ((tid >> 2) & 15), cq = (tid & 3) * 32;
      *(LAS u32x4*)(F.lds + SM_K + sub * 4096 + rr * 128 + cq) = (u32x4){0u, 0u, 0u, 0u}; *(LAS u32x4*)(F.lds + SM_K + sub * 4096 + rr * 128 + cq + 16) = (u32x4){0u, 0u, 0u, 0u}; }
    const int vb = SM_V + (KIND == 0 ? w : (w >> 1)) * VSUB + (4 * hi + ((lane & 15) >> 2)) * VSTR + (((lane >> 4) & 1) * 16 + (lane & 3) * 4) * 2;
    auto compute = [&](int t) {
        f32x16 p0 = f32x16{};
#pragma unroll
        for (int d0 = 0; d0 < 4; ++d0) { const bf16x8 kf = *(const LAS bf16x8*)(lds + SM_K + w * 4096 + r32 * 128 + (((2 * d0 + hi) ^ (r32 & 7)) << 4));
            p0 = __builtin_amdgcn_mfma_f32_32x32x16_bf16(kf, qr[d0], p0, 0, 0, 0); }
        const int kv0 = 16 * t + 4 * hi;
        float x[8];
        if (KIND == 0) {
#pragma unroll
            for (int g4 = 0; g4 < 2; ++g4) { const f32x4 fa = *(const LAS f32x4*)(lds + SM_F + (w * 16 + 4 * hi + 8 * g4) * 4);
#pragma unroll
                for (int e = 0; e < 4; ++e) x[4 * g4 + e] = p0[4 * g4 + e] + (fq - fa[e]); }
            if (t == 128) {
#pragma unroll
                for (int r = 0; r < 8; ++r) { const int kv = kv0 + (r & 3) + 8 * (r >> 2); if (kv > qpos) x[r] = -1e30f; } }
        } else {
            if (t < 120) {
#pragma unroll
                for (int r = 0; r < 8; ++r) x[r] = p0[r];
            } else {
#pragma unroll
                for (int r = 0; r < 8; ++r) { const int kv = kv0 + (r & 3) + 8 * (r >> 2); int i0 = kv - qpos + 128; i0 = i0 < 0 ? 0 : i0; x[r] = p0[r] + tab[i0]; } }
        }
        float rm = x[0];
#pragma unroll
        for (int r = 1; r < 8; ++r) rm = fmaxf(rm, x[r]);
        rm = fmaxf(rm, __shfl_xor(rm, 32));
        const float m_new = fmaxf(m_run, rm);
        if (__any(m_new > m_run)) { const float al = __builtin_amdgcn_exp2f(m_run - m_new); l_run *= al; m_run = m_new;
            if (hi == 0) wsf[r32] = al;
            asm volatile("s_waitcnt lgkmcnt(0)" ::: "memory");
#pragma unroll
            for (int g4 = 0; g4 < 2; ++g4) { const f32x4 a4 = *(const LAS f32x4*)(wsf + 8 * g4 + 4 * hi);
#pragma unroll
                for (int d = 0; d < NDB; ++d)
#pragma unroll
                    for (int e = 0; e < 4; ++e) o[d][4 * g4 + e] *= a4[e]; } }
        float rs = 0.f;
#pragma unroll
        for (int r = 0; r < 8; ++r) { x[r] = __builtin_amdgcn_exp2f(x[r] - m_run); rs += x[r]; }
        l_run += rs;
        u32x4 w0; w0.x = pg8::cvt_pk_bf16(x[0], x[1]); w0.y = pg8::cvt_pk_bf16(x[2], x[3]); w0.z = pg8::cvt_pk_bf16(x[4], x[5]); w0.w = pg8::cvt_pk_bf16(x[6], x[7]);
        const bf16x8 pa = __builtin_bit_cast(bf16x8, w0);
#pragma unroll
        for (int d = 0; d < NDB; ++d) { const LAS char* vp = lds + vb + d * 64;
            const s16x4 lo = vtr(vp), hi4 = vtr(vp + 8 * VSTR);
            const bf16x8 vf = (bf16x8){lo[0], lo[1], lo[2], lo[3], hi4[0], hi4[1], hi4[2], hi4[3]};
            o[d] = __builtin_amdgcn_mfma_f32_32x32x16_bf16(pa, vf, o[d], 0, 0, 0); }
    };
    for (int i = 0; i < nt; i += 2) {
        const int t = s + 8 * i;
        lwrite(gkA, gvA, gfA); __syncthreads();
        if (i + 2 < nt) gload(gkA, gvA, gfA, t + 16);
        compute(t);
        __syncthreads();
        if (i + 1 >= nt) break;
        lwrite(gkB, gvB, gfB); __syncthreads();
        if (i + 3 < nt) gload(gkB, gvB, gfB, t + 24);
        compute(t + 8);
        __syncthreads();
    }
    l_run += __shfl_xor(l_run, 32);
    float* P = (float*)(F.ws + (KIND == 0 ? WS_PF : WS_PD)) + ((size_t)((b * 8 + s) * 8 + w) * 16) * (DV + 2);
    { float* P0 = P + (size_t)(4 * hi) * (DV + 2) + r32; float* P1 = P0 + 8 * (DV + 2);
#pragma unroll
      for (int d = 0; d < NDB; ++d)
#pragma unroll
          for (int r = 0; r < 4; ++r) { P0[r * (DV + 2) + 32 * d] = o[d][r]; P1[r * (DV + 2) + 32 * d] = o[d][4 + r]; } }
    if (lane < 16) { P[(size_t)lane * (DV + 2) + DV] = m_run; P[(size_t)lane * (DV + 2) + DV + 1] = l_run; }
}

template <int pv = 0> __device__ __forceinline__ void p3_attention(Frame& F, int mask) {
    LAS float* tab = (LAS float*)(F.lds + AT_TAB);
    for (int i = F.tid; i < 4 * 192; i += 512) { const int h = i / 192, rel = (i % 192) - 128; tab[i] = (F.in[I_RELB][t5_bucket(rel) * 4 + h] - F.in[I_RELB][15 * 4 + h]) * LOG2E; }
    const float lam = lambda_full(F);
    __syncthreads();
    const int x = F.bid & 7, p = (F.bid >> 3) & 31;
    const int spos = F.G == 256 ? (x + p) % 5 : 4;
    for (int j = 0; j < 5; ++j) {
        F.lane = lane_id_opaque(); F.tid = F.wave * 64 + F.lane;
        if (j == spos) {
            if (mask & 4) {
                for (int u = F.bid; u < 256; u += F.G) {
                    F.lane = lane_id_opaque(); F.tid = F.wave * 64 + F.lane;
                    if ((u >> 3) & 1) sample_unit<1>(F, u >> 4, u & 7); else sample_unit<0>(F, u >> 4, u & 7);
                }
            }
        } else if (F.bid < 256) {
            const int i = j - (j > spos ? 1 : 0);
            const int qb = (i & 1) ? p : 63 - p;
            if (i < 2) { if (mask & 1) attn_prompt_diff_half<pv>(F, x >> 1, x & 1, qb); }
            else { if (mask & 2) attn_prompt_fox<pv>(F, x, qb); }
        }
    }
}

__device__ __forceinline__ void slab_publish(Frame& F, int word, int nun) {
    int n = 0; for (int L = F.bid; L < nun; L += F.G) ++n;
    asm volatile("s_waitcnt vmcnt(0)" ::: "memory");
    __syncthreads();
    if (F.tid == 0 && n > 0) { __builtin_amdgcn_fence(__ATOMIC_RELEASE, "agent"); asm volatile("s_waitcnt vmcnt(0)" ::: "memory");
        __hip_atomic_fetch_add((unsigned*)(F.ws + WS_CTL) + word, (unsigned)n, __ATOMIC_RELAXED, __HIP_MEMORY_SCOPE_AGENT); }
}
__device__ __forceinline__ void slab_wait(Frame& F, int word, int nun) {
    if (F.tid == 0) { unsigned* w = (unsigned*)(F.ws + WS_CTL) + word; unsigned sp = 0;
        while (__hip_atomic_load(w, __ATOMIC_RELAXED, __HIP_MEMORY_SCOPE_AGENT) < (unsigned)nun && ++sp < (1u << 22)) __builtin_amdgcn_s_sleep(2);
        __builtin_amdgcn_fence(__ATOMIC_ACQUIRE, "agent"); asm volatile("s_waitcnt vmcnt(0)" ::: "memory"); }
    __syncthreads();
}

#define XB_TMO      128
#define XB_XCNT(j)  (256  + 64 * (j))
#define XB_XSUB(j)  (1280 + 64 * (j))
#define XB_XGEN(j)  (2304 + 64 * (j))
#define XB_TOP      3328
#define XB_TOPGEN   3392
#define XCD_BAR_WORDS 3456
#define XB_SPIN_CAP (1u << 20)
__device__ __forceinline__ unsigned xb_ld(unsigned* p)              { return __hip_atomic_load(p, __ATOMIC_RELAXED, __HIP_MEMORY_SCOPE_AGENT); }
__device__ __forceinline__ unsigned xb_add(unsigned* p, unsigned v) { return __hip_atomic_fetch_add(p, v, __ATOMIC_RELAXED, __HIP_MEMORY_SCOPE_AGENT); }
__device__ __forceinline__ unsigned xb_xcc_id() { return (unsigned)__builtin_amdgcn_s_getreg((3 << 11) | 20) & 0xFu; }
#define XB_SPIN(cond, bar) do { unsigned _sp = 0; while (cond) { __builtin_amdgcn_s_sleep(1); \
    if ((++_sp & 255u) == 0u) { if (xb_ld(&(bar)[XB_TMO])) break; if (_sp > XB_SPIN_CAP) { atomicAdd(&(bar)[XB_TMO], 1u); break; } } } } while (0)
struct XcdBarrier { unsigned* bar; unsigned x; volatile LAS unsigned* st; };
__device__ __forceinline__ XcdBarrier xcd_barrier_post(unsigned* bar, volatile LAS unsigned* st) {
    XcdBarrier b; b.bar = bar; b.x = xb_xcc_id(); b.st = st;
    if (threadIdx.x == 0) (void)xb_add(&bar[XB_XCNT(b.x)], 1u);
    return b;
}
__device__ __forceinline__ void xcd_barrier_complete(unsigned* bar, unsigned x, unsigned& nloc, unsigned& nx) {
    const unsigned G = gridDim.x * gridDim.y * gridDim.z;
    unsigned sum, cnt, mine, sp = 0u;
    for (;;) {
        sum = 0u; cnt = 0u; mine = 0u;
#pragma unroll
        for (unsigned j = 0; j < 16; ++j) { const unsigned c = xb_ld(&bar[XB_XCNT(j)]); sum += c; cnt += (c > 0u) ? 1u : 0u; mine = (j == x) ? c : mine; }
        if (sum == G) break;
        __builtin_amdgcn_s_sleep(1);
        if ((++sp & 255u) == 0u) { if (xb_ld(&bar[XB_TMO])) break; if (sp > XB_SPIN_CAP) { atomicAdd(&bar[XB_TMO], 1u); break; } }
    }
    nloc = mine > 0u ? mine : 1u; nx = cnt > 0u ? cnt : 1u;
}
__device__ __forceinline__ void xcd_barrier(const XcdBarrier& b) {
    asm volatile("s_waitcnt vmcnt(0)" ::: "memory");
    __syncthreads();
    if (threadIdx.x == 0) {
        unsigned* bar = b.bar;
        __builtin_amdgcn_s_waitcnt(0);
        unsigned nloc = b.st[0], nx = b.st[1];
        if (nloc == 0u) { xcd_barrier_complete(bar, b.x, nloc, nx); b.st[0] = nloc; b.st[1] = nx; }
        const unsigned old = xb_add(&bar[XB_XSUB(b.x)], 1u);
        const unsigned gen = old / nloc;
        if (old + 1u == (gen + 1u) * nloc) {
            __builtin_amdgcn_fence(__ATOMIC_RELEASE, "agent");
            asm volatile("s_waitcnt vmcnt(0)" ::: "memory");
            const unsigned og = xb_add(&bar[XB_TOP], 1u);
            const unsigned tg = og / nx;
            if (og + 1u == (tg + 1u) * nx) xb_add(&bar[XB_TOPGEN], 1u);
            else XB_SPIN(xb_ld(&bar[XB_TOPGEN]) == tg, bar);
            __builtin_amdgcn_fence(__ATOMIC_ACQUIRE, "agent");
            xb_add(&bar[XB_XGEN(b.x)], 1u);
            asm volatile("s_waitcnt vmcnt(0)" ::: "memory");
        } else {
            XB_SPIN(xb_ld(&bar[XB_XGEN(b.x)]) == gen, bar);
            __builtin_amdgcn_fence(__ATOMIC_ACQUIRE, "agent");
            asm volatile("s_waitcnt vmcnt(0)" ::: "memory");
        }
    }
    __syncthreads();
}

__global__ void __launch_bounds__(512, 2) mega_fwd(Args args) {
    extern __shared__ __attribute__((aligned(16))) unsigned char lds_raw[];
    Frame F;
    F.lds = (LAS unsigned char*)lds_raw; F.ldsg = lds_raw;
    F.tid = threadIdx.x; F.lane = F.tid & 63; F.wave = __builtin_amdgcn_readfirstlane(F.tid >> 6);
    F.G = gridDim.x; F.bid = blockIdx.x;
    F.in = args.in; F.out = args.out; F.ws = args.ws;
    const int lo = args.ph_lo, hi = args.ph_hi;
    cg::grid_group grid = cg::this_grid();
    const bool fused = (hi - lo) > 1;
    volatile LAS unsigned* bst = (volatile LAS unsigned*)(F.lds + AT_MISC + 16);
    if (F.tid == 0) { bst[0] = 0u; bst[1] = 0u; }
    __syncthreads();
    XcdBarrier xbar; xbar.bar = (unsigned*)(F.ws + WS_CTL) + 1024; xbar.x = 0; xbar.st = bst;
    if (fused) xbar = xcd_barrier_post((unsigned*)(F.ws + WS_CTL) + 1024, bst);
#define IN(k) (lo <= (k) && (k) < hi)
#define PB() do { F.lane = lane_id_opaque(); F.tid = F.wave * 64 + F.lane; } while (0)
#define SEAM(k) do { if (IN(k) && IN((k) + 1)) { xcd_barrier(xbar); } } while (0)
    const float* mod = (const float*)(F.ws + WS_MOD);
    if (IN(0)) { PB(); p0_prologue(F); }
    if (IN(0) && IN(1)) __syncthreads(); else SEAM(0);
    if (IN(1)) { PB(); p1_rows(F, IN(0)); } SEAM(1);
    if (IN(2)) { PB();
        p2_cumsum(F);
        __syncthreads();
        pg8::Gemm g{(const bf16_t*)(F.ws + WS_XN), (const bf16_t*)(F.ws + WS_WIN), 1024, 1024, 1024, 1 << 30, 0, 0};
        pg8::StaticOrder S; S.init(MT / 256, NZ / 256, F.G, F.bid, 0);
        EpiZ E{F.out, F.ws};
        pg8::gemm_phase<EpiZ, pg8::StaticOrder>(F.lds, g, S, E, F.wave);
#if PROBE_DUP == 2
        pg8::gemm_phase<EpiZ, pg8::StaticOrder>(F.lds, g, S, E, F.wave);
#endif
        { const int nun = (MT / 256) * (NZ / 256), nlong = nun - (nun / F.G) * F.G;
          if (nlong > 0 && nlong < F.G) { if (F.bid >= nlong) { PB(); weight_copies(F, F.bid - nlong, F.G - nlong, WC_IN, WC_ALL); } }
          else { PB(); weight_copies(F, F.bid, F.G, WC_IN, WC_ALL); } }
    } SEAM(2);
    if (IN(3)) { PB(); p3_attention(F, 7);
#if PROBE_DUP == 3
        p3_attention<PROBE_PV>(F, PROBE_MASK);
#endif
    } SEAM(3);
    if (IN(10)) { PB(); p_combine(F);
#if PROBE_DUP == 10
        p_combine(F);
#endif
    } if (IN(10) && IN(4)) xcd_barrier(xbar);
    if (IN(4)) { PB();
        pg8::Gemm g{(const bf16_t*)(F.ws + WS_AB), (const bf16_t*)(F.ws + WS_WAB), 1024, 512, 512, 4, 512, 0};
        pg8::StaticOrder S; S.init(MT / 256, 8, F.G, F.bid, 0);
        EpiGate E{(bf16_t*)(F.ws + WS_G), (bf16_t*)(F.ws + WS_G)};
#if PROBE_DUP == 4
        { EpiGate E2{(bf16_t*)(F.ws + WS_G), (bf16_t*)(F.ws + WS_QA)}; pg8::gemm_phase<EpiGate, pg8::StaticOrder>(F.lds, g, S, E2, F.wave); }
#endif
        pg8::gemm_phase<EpiGate, pg8::StaticOrder>(F.lds, g, S, E, F.wave);
    } SEAM(4);
    if (IN(5)) { PB();
        { pg8::Gemm g2{(const bf16_t*)(F.ws + WS_G), (const bf16_t*)(F.ws + WS_WO2), 2048, 2048, 256, 1 << 30, 0, 256};
          pg8::SplitOrder S2; S2.init(4, 8, F.G, F.bid, SEQ / 256); EpiSlab E2{(float*)(F.ws + WS_SLAB)};
          pg8::gemm_phase<EpiSlab, pg8::SplitOrder>(F.lds, g2, S2, E2, F.wave); slab_publish(F, 322, 32); }
        pg8::Gemm g{(const bf16_t*)(F.ws + WS_G), (const bf16_t*)(F.ws + WS_WO2), 2048, 2048, 2048, 1 << 30, 0, 0};
        pg8::StaticOrder S; S.init(SEQ / 256, 4, F.G, F.bid, 0);
        EpiResLn<false> E{(const void*)F.in[I_XP], mod + 2048, F.in[I_LN1G], F.in[I_LN1B], mod, (bf16_t*)(F.ws + WS_X1B), (bf16_t*)(F.ws + WS_XN), nullptr,
                          PanelStats{(unsigned*)(F.ws + WS_XB1), (unsigned*)(F.ws + WS_CTL) + CTL_LN1, LN_EPS}, F.lds};
        pg8::gemm_phase<EpiResLn<false>, pg8::StaticOrder>(F.lds, g, S, E, F.wave);
        PB(); slab_wait(F, 322, 32); ln_rows<false>(F, F.in[I_LN1G], F.in[I_LN1B], 8, 2048);
    } if (IN(5) && IN(7)) xcd_barrier(xbar);

    if (IN(7)) { PB();
        pg8::Gemm g{(const bf16_t*)(F.ws + WS_XN), (const bf16_t*)(F.ws + WS_WFI), 1024, 1024, 1024, 1 << 30, 0, 0};
        pg8::StaticOrder S; S.init(MT / 256, NFF2 / 256, F.G, F.bid, 0);
        EpiFfn E{(bf16_t*)(F.ws + WS_ACT)};
        pg8::gemm_phase<EpiFfn, pg8::StaticOrder>(F.lds, g, S, E, F.wave);
#if PROBE_DUP == 7
        pg8::gemm_phase<EpiFfn, pg8::StaticOrder>(F.lds, g, S, E, F.wave);
#endif
    } SEAM(7);
    if (IN(8)) { PB();
        { pg8::Gemm g2{(const bf16_t*)(F.ws + WS_ACT), (const bf16_t*)(F.ws + WS_WFO), DFF, DFF, 256, 1 << 30, 0, 256};
          pg8::SplitOrder S2; S2.init(4, 11, F.G, F.bid, SEQ / 256); EpiSlab E2{(float*)(F.ws + WS_SLAB)};
          pg8::gemm_phase<EpiSlab, pg8::SplitOrder>(F.lds, g2, S2, E2, F.wave); slab_publish(F, 323, 44); }
        pg8::Gemm g{(const bf16_t*)(F.ws + WS_ACT), (const bf16_t*)(F.ws + WS_WFO), DFF, DFF, DFF, 1 << 30, 0, 0};
        pg8::StaticOrder S; S.init(SEQ / 256, 4, F.G, F.bid, 0);
        EpiResLn<true> E{(const void*)(F.ws + WS_X1B), mod + 5120, F.in[I_LN2G], F.in[I_LN2B], mod, nullptr, nullptr, F.out,
                         PanelStats{(unsigned*)(F.ws + WS_XB2), (unsigned*)(F.ws + WS_CTL) + CTL_LN2, LN_EPS}, F.lds};
        pg8::gemm_phase<EpiResLn<true>, pg8::StaticOrder>(F.lds, g, S, E, F.wave);
        PB(); slab_wait(F, 323, 44); ln_rows<true>(F, F.in[I_LN2G], F.in[I_LN2B], 11, 5120);
    }
#undef IN
#undef SEAM
}

extern "C" void kernel_launch(void* const* d_in, const int* in_sizes, int n_in, void* d_out, int out_size, void* d_ws, size_t ws_size, hipStream_t stream) {
    static int grid = 0;
    if (grid == 0) {
        if (n_in != 28 || (size_t)out_size != O_END || ws_size < WS_END) { fprintf(stderr, "kernel_launch: unexpected shapes (n_in %d out %d ws %zu)\n", n_in, out_size, ws_size); grid = -1; return; }
        int dev = 0, cus = 0, per_cu = 0;
        hipGetDevice(&dev); hipDeviceGetAttribute(&cus, hipDeviceAttributeMultiprocessorCount, dev);
        hipFuncSetAttribute((const void*)mega_fwd, hipFuncAttributeMaxDynamicSharedMemorySize, LDS_BYTES);
        hipOccupancyMaxActiveBlocksPerMultiprocessor(&per_cu, (const void*)mega_fwd, 512, LDS_BYTES);
        if (per_cu < 1) { fprintf(stderr, "kernel_launch: occupancy query says %d blocks per CU\n", per_cu); per_cu = 1; }
        (void)hipGetLastError();
        grid = cus;
    }
    if (grid < 0) return;
    hipMemsetAsync((char*)d_ws + WS_CTL, 0, CTL_BYTES, stream);
    Args a{};
    for (int i = 0; i < 28; ++i) a.in[i] = (const float*)d_in[i];
    a.out = (float*)d_out; a.ws = (unsigned char*)d_ws;
#if MK_N_LAUNCHES == 1
    a.ph_lo = 0; a.ph_hi = NPH;
    void* kargs[] = {&a};
    hipError_t e = hipLaunchCooperativeKernel((const void*)mega_fwd, dim3(grid), dim3(512), kargs, LDS_BYTES, stream);
    if (e != hipSuccess) fprintf(stderr, "cooperative launch failed: %s\n", hipGetErrorString(e));
#else
    { const int seq[NPH] = {0, 1, 2, 3, 10, 4, 5, 6, 7, 8, 9}; for (int i = 0; i < NPH; ++i) { a.ph_lo = seq[i]; a.ph_hi = seq[i] + 1; hipLaunchKernelGGL(mega_fwd, dim3(grid), dim3(512), LDS_BYTES, stream, a); } }
#endif
}
```

```cpp
#include <hip/hip_runtime.h>
#include <hip/hip_cooperative_groups.h>
#include <cstdint>
#include <cstdio>
namespace cg = cooperative_groups;

#ifndef PROBE_DUP
#define PROBE_DUP -1
#endif
#ifndef PROBE_PV
#define PROBE_PV 0
#endif
#ifndef PROBE_MASK
#define PROBE_MASK 7
#endif
#ifndef MK_N_LAUNCHES
#define MK_N_LAUNCHES 1
#endif

#define LAS __attribute__((address_space(3)))
typedef unsigned short bf16_t;
typedef short bf16x8 __attribute__((ext_vector_type(8)));
typedef short s16x4 __attribute__((ext_vector_type(4)));
typedef float f32x4 __attribute__((ext_vector_type(4)));
typedef float f32x2 __attribute__((ext_vector_type(2)));
typedef float f32x16 __attribute__((ext_vector_type(16)));
typedef unsigned u32x4 __attribute__((ext_vector_type(4)));
typedef unsigned u32x2 __attribute__((ext_vector_type(2)));

constexpr int DM = 1024, SEQ = 16384, DEC_B = 16, DEC_T = 16, NSMP = DEC_B * DEC_T, MT = SEQ + NSMP, PAST = 2048, SKV = PAST + DEC_T;
constexpr int NZ = 5120, DFF = 2816, NFF2 = 2 * DFF, WIN_COLS = 5128;
constexpr float LOG2E = 1.4426950408889634f, C2 = 0.125f * LOG2E, ALPHA = 1.189207115002721f, LN_EPS = 1e-5f;
constexpr int NPH = 11;

constexpr size_t O_Y = 0, O_DKP = (size_t)MT * DM, O_DVP = O_DKP + (size_t)SEQ * 512, O_FKP = O_DVP + (size_t)SEQ * 512, O_FVP = O_FKP + (size_t)SEQ * 512,
                 O_FLP = O_FVP + (size_t)SEQ * 512, O_DKS = O_FLP + (size_t)SEQ * 8, O_DVS = O_DKS + (size_t)NSMP * 512, O_FKS = O_DVS + (size_t)NSMP * 512,
                 O_FVS = O_FKS + (size_t)NSMP * 512, O_FLS = O_FVS + (size_t)NSMP * 512, O_END = O_FLS + (size_t)NSMP * 8;

constexpr size_t MiB = 1u << 20;
constexpr size_t WS_CTL = 0, CTL_BYTES = 64 * 1024;
constexpr size_t WS_MOD = 1 * MiB;
constexpr size_t WS_FP = 2 * MiB;
constexpr size_t WS_FS = 3 * MiB;
constexpr size_t WS_WIN = 8 * MiB;
constexpr size_t WS_WAB = 18 * MiB;
constexpr size_t WS_WO2 = 20 * MiB;
constexpr size_t WS_WFI = 24 * MiB;
constexpr size_t WS_WFO = 35 * MiB;
constexpr size_t WS_XN = 48 * MiB;
constexpr size_t WS_QA = 84 * MiB, WS_KA = 101 * MiB, WS_VA = 118 * MiB, WS_QB = 135 * MiB, WS_KB = 152 * MiB, WS_VB = 169 * MiB;
constexpr size_t WS_ACT = 84 * MiB;
constexpr size_t WS_G = 188 * MiB;
constexpr size_t WS_AB = 254 * MiB;
constexpr size_t WS_OD1 = WS_XN, WS_OD2 = 288 * MiB;
constexpr size_t WS_PF = 304 * MiB, WS_PD = 309 * MiB;
constexpr size_t WS_TB = WS_AB;
constexpr size_t WS_X1B = WS_AB;
constexpr size_t WS_XB1 = 5 * MiB, WS_XB2 = 6 * MiB;
constexpr int CTL_LN1 = 8192, CTL_LN2 = 12288;
constexpr int LN_LDS = 135168;
constexpr size_t WS_SLAB = 288 * MiB;
constexpr size_t WS_END = 320 * MiB;

constexpr int LDS_BYTES = 147456;

struct Args { const float* in[28]; float* out; unsigned char* ws; int ph_lo, ph_hi; };

__device__ __forceinline__ int lane_id_opaque() { int l = (int)__builtin_amdgcn_mbcnt_hi(~0u, __builtin_amdgcn_mbcnt_lo(~0u, 0u)); asm volatile("" : "+v"(l)); return l; }
__device__ __forceinline__ unsigned f2bf(float f) { unsigned u = __builtin_bit_cast(unsigned, f); return (u + 0x7fffu + ((u >> 16) & 1u)) >> 16; }
__device__ __forceinline__ unsigned pk2(float lo, float hi) { return f2bf(lo) | (f2bf(hi) << 16); }
__device__ __forceinline__ float bf2f(unsigned short b) { return __builtin_bit_cast(float, (unsigned)b << 16); }
__device__ __forceinline__ float bflo(unsigned w) { return __builtin_bit_cast(float, w << 16); }
__device__ __forceinline__ float bfhi(unsigned w) { return __builtin_bit_cast(float, w & 0xffff0000u); }
__device__ __forceinline__ float wave_sum(float v) {
#pragma unroll
    for (int o = 1; o < 64; o <<= 1) v += __shfl_xor(v, o);
    return v;
}
__device__ __forceinline__ float sigmoidf_(float x) { return 1.0f / (1.0f + __expf(-x)); }
__device__ __forceinline__ float siluf_(float x) { return x / (1.0f + __expf(-x)); }

namespace pg8 {
constexpr int BM = 256, BK = 64, HALF = 128, HTB = HALF * BK * 2, STAGE_BYTES = 8 * HTB, NXCD = 8, WGM = 8;
__host__ __device__ __forceinline__ int lds_byte(int r, int c) { const int st = (r >> 4) * 2 + (c >> 5), rr = r & 15, cc = c & 31, ob = rr * 64 + cc * 2; return st * 1024 + (ob ^ (((ob >> 9) & 1) << 5)); }
__host__ __device__ __forceinline__ void stage_rc(int b, int& R, int& C) { const int st = b / 1024, sb = b % 1024, swz = sb ^ (((sb >> 9) & 1) << 5); R = (st >> 1) * 16 + swz / 64; C = (st & 1) * 32 + (swz % 64) / 2; }
__host__ __device__ __forceinline__ int perm32(int rho) { const int n = rho >> 4, i = rho & 15; return 8 * (i >> 2) + 4 * n + (i & 3); }

struct Unit { int pm, pn, ks; };
struct Gemm { const bf16_t* A; const bf16_t* Bt; int lda, ldb, K, a_split_pn, a_split_off, kpart; };

struct StaticOrder {
    int nM, nN, nwg, G, c, pm0;
    __device__ void init(int nM_, int nN_, int G_, int c_, int pm0_) { nM = nM_; nN = nN_; nwg = nM * nN; G = G_; c = c_; pm0 = pm0_; }
    __device__ bool next(int i, Unit& u) const {
        const long L = (long)i * G + c; if (L >= nwg) return false;
        int wgid = (int)L; { const int q = nwg / NXCD, r = nwg % NXCD, xcd = wgid % NXCD, off = wgid / NXCD; wgid = (xcd < r ? xcd * (q + 1) : r * (q + 1) + (xcd - r) * q) + off; }
        const int nig = WGM * nN, gid = wgid / nig, fm = gid * WGM, gsz = (nM - fm) < WGM ? (nM - fm) : WGM;
        u.pm = pm0 + fm + ((wgid % nig) % gsz); u.pn = (wgid % nig) / gsz; u.ks = 0; return true;
    }
};

struct SplitOrder {
    int nN, nun, G, c, pm;
    __device__ void init(int nN_, int KS_, int G_, int c_, int pm_) { nN = nN_; nun = nN_ * KS_; G = G_; c = c_; pm = pm_; }
    __device__ bool next(int i, Unit& u) const { const long L = (long)i * G + c; if (L >= nun) return false; u.pm = pm; u.pn = (int)L % nN; u.ks = (int)L / nN; return true; }
};

__device__ __forceinline__ unsigned cvt_pk_bf16(float lo, float hi) { unsigned r; asm volatile("v_cvt_pk_bf16_f32 %0, %1, %2" : "=v"(r) : "v"(lo), "v"(hi)); return r; }

template <class Epi, class Sched, bool ALIGN_EPI = true, bool SP2 = true>
__device__ __forceinline__ void gemm_phase(LAS unsigned char* lds, const Gemm g, const Sched& S, const Epi& E, int wid  ) {
    const int lane = lane_id_opaque(), tid = wid * 64 + lane, wr = wid >> 2, wc = wid & 3; int fr = lane & 15, fq = lane >> 4;
    const int K = g.K, nt = K / BK;
    unsigned voffA[2], voffB[2];
#pragma unroll
    for (int i = 0; i < 2; ++i) { int R, C; stage_rc(tid * 16 + i * 8192, R, C); const int Rb = Epi::PERM ? ((R & ~31) + perm32(R & 31)) : R;
        voffA[i] = (unsigned)(R * g.lda + C) * 2u; voffB[i] = (unsigned)(Rb * g.ldb + C) * 2u; }
    const size_t kstep = (size_t)(BK * 2);
    const size_t hstepA = (size_t)HALF * g.lda * 2, hstepB = (size_t)HALF * g.ldb * 2;
    const size_t tstepA = 2 * hstepA, tstepB = 2 * hstepB;
    const unsigned ldsw = (unsigned)wid * 1024u;
    const int aoff = lds_byte(wr * 64 + fr, fq * 8), boff = lds_byte(wc * 32 + fr, fq * 8);
#define PG8_SA(b, h) (((b) * 2 + (h)) * HTB)
#define PG8_SB(b, h) ((4 + (b) * 2 + (h)) * HTB)
#define PG8_STAGE(bufoff, gbase, voff) do { _Pragma("unroll") for (int _i = 0; _i < 2; ++_i) \
        __builtin_amdgcn_global_load_lds((const unsigned*)((const char*)(gbase) + (voff)[_i]), (LAS unsigned*)(lds + (bufoff) + ldsw + _i * 8192), 16, 0, 0); } while (0)
#define PG8_LDA(dst, b, h) do { _Pragma("unroll") for (int m = 0; m < 4; ++m) _Pragma("unroll") for (int k = 0; k < 2; ++k) dst[m][k] = *(const LAS bf16x8*)(lds + PG8_SA(b, h) + aoff + m * 2048 + k * 1024); } while (0)
#define PG8_LDB(dst, b, h) do { _Pragma("unroll") for (int n = 0; n < 2; ++n) _Pragma("unroll") for (int k = 0; k < 2; ++k) dst[n][k] = *(const LAS bf16x8*)(lds + PG8_SB(b, h) + boff + n * 2048 + k * 1024); } while (0)
#define PG8_MMA(ai, bj, At, Bt) do { __builtin_amdgcn_s_setprio(1); _Pragma("unroll") for (int m = 0; m < 4; ++m) _Pragma("unroll") for (int n = 0; n < 2; ++n) _Pragma("unroll") for (int k = 0; k < 2; ++k) \
        acc[ai][bj][m][n] = __builtin_amdgcn_mfma_f32_16x16x32_bf16(Bt[n][k], At[m][k], acc[ai][bj][m][n], 0, 0, 0); __builtin_amdgcn_s_setprio(0); } while (0)
#define PG8_WAIT_V(n) asm volatile("s_waitcnt vmcnt(" #n ")" ::: "memory")
#define PG8_WAIT_L(n) asm volatile("s_waitcnt lgkmcnt(" #n ")" ::: "memory")
#define PG8_BAR __builtin_amdgcn_s_barrier()
#define PG8_SCHED __builtin_amdgcn_sched_barrier(0)
#define PG8_ABASE(u) ((const char*)g.A + (size_t)(u).pm * tstepA + ((u).pn >= g.a_split_pn ? (size_t)g.a_split_off * 2 : (size_t)0) + (size_t)(u).ks * g.kpart * 2)
#define PG8_BBASE(u) ((const char*)g.Bt + (size_t)(u).pn * tstepB + (size_t)(u).ks * g.kpart * 2)
    Unit cur, nxt; int ui = 0;
    if (!S.next(0, cur)) return;
    f32x4 acc[2][2][4][2];
#pragma unroll
    for (int a = 0; a < 2; ++a)
#pragma unroll
        for (int b = 0; b < 2; ++b)
#pragma unroll
            for (int m = 0; m < 4; ++m)
#pragma unroll
                for (int n = 0; n < 2; ++n) acc[a][b][m][n] = (f32x4){0.f, 0.f, 0.f, 0.f};
    bf16x8 At[4][2], B0[2][2], B1[2][2];
    const char* cA = PG8_ABASE(cur); const char* cB = PG8_BBASE(cur);
    if constexpr (SP2) {
        PG8_STAGE(PG8_SB(0, 0), cB, voffB); PG8_STAGE(PG8_SB(0, 1), cB + hstepB, voffB); PG8_STAGE(PG8_SA(0, 0), cA, voffA); PG8_STAGE(PG8_SA(0, 1), cA + hstepA, voffA);
        if (wr == 1) PG8_BAR;
        PG8_WAIT_V(2); PG8_BAR;
        PG8_STAGE(PG8_SB(1, 0), cB + kstep, voffB); PG8_STAGE(PG8_SA(1, 0), cA + kstep, voffA); PG8_STAGE(PG8_SB(1, 1), cB + hstepB + kstep, voffB);
        PG8_WAIT_V(6); PG8_BAR;
    } else {
        PG8_STAGE(PG8_SB(0, 0), cB, voffB); PG8_STAGE(PG8_SA(0, 0), cA, voffA); PG8_STAGE(PG8_SB(0, 1), cB + hstepB, voffB); PG8_STAGE(PG8_SA(0, 1), cA + hstepA, voffA);
        if (wr == 1) PG8_BAR;
        PG8_WAIT_V(4); PG8_BAR;
        PG8_STAGE(PG8_SB(1, 0), cB + kstep, voffB); PG8_STAGE(PG8_SA(1, 0), cA + kstep, voffA); PG8_STAGE(PG8_SB(1, 1), cB + hstepB + kstep, voffB);
        PG8_WAIT_V(6); PG8_BAR;
    }
    for (;;) {
        const bool has_next = S.next(ui + 1, nxt);
        const char* nA = has_next ? PG8_ABASE(nxt) : cA; const char* nB = has_next ? PG8_BBASE(nxt) : cB;
        for (int t = 0; t < nt; t += 2) {
            const bool last = (t == nt - 2);
            const char* a1 = cA + (size_t)(t + 1) * kstep;
            const char* a2 = last ? nA : cA + (size_t)(t + 2) * kstep; const char* b2 = last ? nB : cB + (size_t)(t + 2) * kstep;
            const char* a3 = a2 + kstep; const char* b3 = b2 + kstep;
            if constexpr (SP2) {
            PG8_LDB(B0, 0, 0); PG8_LDB(B1, 0, 1); PG8_SCHED; PG8_LDA(At, 0, 0); PG8_STAGE(PG8_SA(1, 1), a1 + hstepA, voffA);
            PG8_WAIT_V(8); PG8_WAIT_L(0); PG8_BAR; PG8_MMA(0, 0, At, B0); PG8_MMA(0, 1, At, B1); PG8_BAR; PG8_SCHED;
            PG8_LDA(At, 0, 1); PG8_STAGE(PG8_SB(0, 0), b2, voffB); PG8_STAGE(PG8_SB(0, 1), b2 + hstepB, voffB); PG8_STAGE(PG8_SA(0, 0), a2, voffA);
            PG8_WAIT_V(8); PG8_WAIT_L(0); PG8_BAR; PG8_MMA(1, 0, At, B0); PG8_MMA(1, 1, At, B1); PG8_BAR; PG8_SCHED;
            PG8_LDB(B0, 1, 0); PG8_LDB(B1, 1, 1); PG8_SCHED; PG8_LDA(At, 1, 0); PG8_STAGE(PG8_SA(0, 1), a2 + hstepA, voffA);
            PG8_WAIT_V(8); PG8_WAIT_L(0); PG8_BAR; PG8_MMA(0, 0, At, B0); PG8_MMA(0, 1, At, B1); PG8_BAR; PG8_SCHED;
            PG8_LDA(At, 1, 1); PG8_STAGE(PG8_SB(1, 0), b3, voffB); PG8_STAGE(PG8_SB(1, 1), b3 + hstepB, voffB); PG8_STAGE(PG8_SA(1, 0), a3, voffA);
            PG8_WAIT_V(8); PG8_WAIT_L(0); PG8_BAR; PG8_MMA(1, 0, At, B0); PG8_MMA(1, 1, At, B1); PG8_BAR; PG8_SCHED;
            } else {
            PG8_LDB(B0, 0, 0); PG8_SCHED; PG8_LDA(At, 0, 0); PG8_STAGE(PG8_SA(1, 1), a1 + hstepA, voffA);
            PG8_WAIT_L(8); PG8_BAR; PG8_WAIT_L(0); PG8_MMA(0, 0, At, B0); PG8_BAR; PG8_SCHED;
            PG8_LDB(B1, 0, 1); PG8_STAGE(PG8_SB(0, 0), b2, voffB);
            PG8_BAR; PG8_WAIT_L(0); PG8_MMA(0, 1, At, B1); PG8_BAR;
            PG8_LDA(At, 0, 1); PG8_STAGE(PG8_SA(0, 0), a2, voffA);
            PG8_BAR; PG8_WAIT_L(0); PG8_MMA(1, 0, At, B0); PG8_BAR; PG8_SCHED;
            PG8_STAGE(PG8_SB(0, 1), b2 + hstepB, voffB);
            PG8_WAIT_V(6); PG8_BAR; PG8_MMA(1, 1, At, B1); PG8_BAR;
            PG8_LDB(B0, 1, 0); PG8_SCHED; PG8_LDA(At, 1, 0); PG8_STAGE(PG8_SA(0, 1), a2 + hstepA, voffA);
            PG8_WAIT_L(8); PG8_BAR; PG8_WAIT_L(0); PG8_MMA(0, 0, At, B0); PG8_BAR; PG8_SCHED;
            PG8_LDB(B1, 1, 1); PG8_STAGE(PG8_SB(1, 0), b3, voffB);
            PG8_BAR; PG8_WAIT_L(0); PG8_MMA(0, 1, At, B1); PG8_BAR;
            PG8_LDA(At, 1, 1); PG8_STAGE(PG8_SA(1, 0), a3, voffA);
            PG8_BAR; PG8_WAIT_L(0); PG8_MMA(1, 0, At, B0); PG8_BAR; PG8_SCHED;
            PG8_STAGE(PG8_SB(1, 1), b3 + hstepB, voffB);
            PG8_WAIT_V(6); PG8_BAR; PG8_MMA(1, 1, At, B1); PG8_BAR;
            }
        }
        if constexpr (ALIGN_EPI) { if (wr == 0) PG8_BAR; }
        { const int le_ = lane_id_opaque(); E(acc, cur, wr, wc, le_ & 15, le_ >> 4); }
        if (!has_next) break;
#pragma unroll
        for (int a = 0; a < 2; ++a)
#pragma unroll
            for (int b = 0; b < 2; ++b)
#pragma unroll
                for (int m = 0; m < 4; ++m)
#pragma unroll
                    for (int n = 0; n < 2; ++n) acc[a][b][m][n] = (f32x4){0.f, 0.f, 0.f, 0.f};
        cur = nxt; cA = nA; cB = nB; ++ui;
        if constexpr (ALIGN_EPI) { if (wr == 1) PG8_BAR; }
    }
    PG8_WAIT_V(0);
    if constexpr (!ALIGN_EPI) { if (wr == 0) PG8_BAR; }
    PG8_BAR;
#undef PG8_SA
#undef PG8_SB
#undef PG8_STAGE
#undef PG8_LDA
#undef PG8_LDB
#undef PG8_MMA
#undef PG8_WAIT_V
#undef PG8_WAIT_L
#undef PG8_BAR
#undef PG8_SCHED
#undef PG8_ABASE
#undef PG8_BBASE
}
}

struct EpiZ {
    static constexpr bool PERM = true;
    float* out; unsigned char* ws;
    __device__ __forceinline__ void operator()(const f32x4 (&acc)[2][2][4][2], const pg8::Unit& u, int wr, int wc, int fr, int fq) const {
        asm volatile("" : "+v"(fr), "+v"(fq));
        const int seg = u.pn >> 1;
        const bool smp = u.pm >= SEQ / 256;
        const int row0 = u.pm * 256 + wr * 64 + fr;
        const int cl0 = wc * 32 + 8 * fq;
        if (seg < 6) {
            bf16_t* B = (bf16_t*)(ws + WS_QA + (size_t)seg * (WS_KA - WS_QA));
            const bool isq = (seg == 0 || seg == 3);
            const float sc = isq ? C2 : 1.0f;
            const int kk = seg - 1 - (seg > 3 ? 1 : 0);
            float* ob = isq ? nullptr : (smp ? out + O_DKS + (size_t)kk * NSMP * 512 - (size_t)SEQ * 512 : out + O_DKP + (size_t)kk * SEQ * 512);
            const int cs = (u.pn & 1) * 256 + cl0;
            if (seg == 0 || seg == 1 || seg == 3 || seg == 4) {
                float mx0 = 0.f, mx1 = 0.f;
#pragma unroll
                for (int ai = 0; ai < 2; ++ai)
#pragma unroll
                    for (int m = 0; m < 4; ++m) {
#pragma unroll
                        for (int bj = 0; bj < 2; ++bj) { const f32x4 v0 = acc[ai][bj][m][0] * sc, v1 = acc[ai][bj][m][1] * sc;
                            float ss = (v0[0] * v0[0] + v0[1] * v0[1]) + (v0[2] * v0[2] + v0[3] * v0[3]) + (v1[0] * v1[0] + v1[1] * v1[1]) + (v1[2] * v1[2] + v1[3] * v1[3]);
                            ss += __shfl_xor(ss, 16); ss += __shfl_xor(ss, 32);
                            if (bj == 0) mx0 = fmaxf(mx0, ss); else mx1 = fmaxf(mx1, ss); } }
#pragma unroll
                for (int ofs = 1; ofs < 16; ofs <<= 1) { mx0 = fmaxf(mx0, __shfl_xor(mx0, ofs)); mx1 = fmaxf(mx1, __shfl_xor(mx1, ofs)); }
                if ((fr | fq) == 0) { unsigned* nw = (unsigned*)(ws + WS_CTL) + (seg < 3 ? 288 : 256) + ((seg == 4 || seg == 1) ? 16 : 0);
                    const int h0 = (u.pn & 1) * 4 + (wc >> 1), hf = wc & 1;
                    atomicMax(nw + (h0 * 2 + hf), __float_as_uint(mx0)); atomicMax(nw + ((h0 + 2) * 2 + hf), __float_as_uint(mx1)); }
            }
#pragma unroll
            for (int ai = 0; ai < 2; ++ai)
#pragma unroll
                for (int m = 0; m < 4; ++m) { const size_t r = (size_t)(row0 + ai * 128 + m * 16);
#pragma unroll
                    for (int bj = 0; bj < 2; ++bj) { const f32x4 v0 = acc[ai][bj][m][0], v1 = acc[ai][bj][m][1]; const int c = cs + bj * 128;
                        if (ob) { __builtin_nontemporal_store(v0, (f32x4*)(ob + r * 512 + c)); __builtin_nontemporal_store(v1, (f32x4*)(ob + r * 512 + c + 4)); }
                        u32x4 w; w.x = pg8::cvt_pk_bf16(v0[0] * sc, v0[1] * sc); w.y = pg8::cvt_pk_bf16(v0[2] * sc, v0[3] * sc); w.z = pg8::cvt_pk_bf16(v1[0] * sc, v1[1] * sc); w.w = pg8::cvt_pk_bf16(v1[2] * sc, v1[3] * sc);
                        *(u32x4*)(B + r * 512 + c) = w; } }
        } else {
            bf16_t* G = (bf16_t*)(ws + WS_G);
            const int cs = (u.pn - 12) * 256 + cl0;
#pragma unroll
            for (int ai = 0; ai < 2; ++ai)
#pragma unroll
                for (int m = 0; m < 4; ++m) { const size_t r = (size_t)(row0 + ai * 128 + m * 16);
#pragma unroll
                    for (int bj = 0; bj < 2; ++bj) { const f32x4 v0 = acc[ai][bj][m][0], v1 = acc[ai][bj][m][1]; const int c = cs + bj * 128;
                        u32x4 w; w.x = pg8::cvt_pk_bf16(sigmoidf_(v0[0]), sigmoidf_(v0[1])); w.y = pg8::cvt_pk_bf16(sigmoidf_(v0[2]), sigmoidf_(v0[3]));
                        w.z = pg8::cvt_pk_bf16(sigmoidf_(v1[0]), sigmoidf_(v1[1])); w.w = pg8::cvt_pk_bf16(sigmoidf_(v1[2]), sigmoidf_(v1[3]));
                        *(u32x4*)(G + r * 2048 + c) = w; } }
        }
    }
};
struct EpiGate {
    static constexpr bool PERM = true;
    bf16_t* G; bf16_t* GO;
    __device__ __forceinline__ void operator()(const f32x4 (&acc)[2][2][4][2], const pg8::Unit& u, int wr, int wc, int fr, int fq) const {
        asm volatile("" : "+v"(fr), "+v"(fq));
        const int row0 = u.pm * 256 + wr * 64 + fr, c0 = u.pn * 256 + wc * 32 + 8 * fq;
#pragma unroll
        for (int ai = 0; ai < 2; ++ai)
#pragma unroll
            for (int m = 0; m < 4; ++m) { const size_t ro = (size_t)(row0 + ai * 128 + m * 16) * 2048 + c0; const bf16_t* rp = G + ro; bf16_t* wp = GO + ro;
#pragma unroll
                for (int bj = 0; bj < 2; ++bj) { const f32x4 v0 = acc[ai][bj][m][0], v1 = acc[ai][bj][m][1]; const u32x4 gw = *(const u32x4*)(rp + bj * 128);
                    u32x4 w; w.x = pg8::cvt_pk_bf16(v0[0] * bflo(gw.x), v0[1] * bfhi(gw.x)); w.y = pg8::cvt_pk_bf16(v0[2] * bflo(gw.y), v0[3] * bfhi(gw.y));
                    w.z = pg8::cvt_pk_bf16(v1[0] * bflo(gw.z), v1[1] * bfhi(gw.z)); w.w = pg8::cvt_pk_bf16(v1[2] * bflo(gw.w), v1[3] * bfhi(gw.w));
                    *(u32x4*)(wp + bj * 128) = w; } }
    }
};
template <bool BASE_BF16> struct EpiRes {
    static constexpr bool PERM = true;
    const void* base; bf16_t* T; const float* gate;
    __device__ __forceinline__ void operator()(const f32x4 (&acc)[2][2][4][2], const pg8::Unit& u, int wr, int wc, int fr, int fq) const {
        asm volatile("" : "+v"(fr), "+v"(fq));
        const int row0 = u.pm * 256 + wr * 64 + fr, c0 = u.pn * 256 + wc * 32 + 8 * fq;
#pragma unroll
        for (int ai = 0; ai < 2; ++ai)
#pragma unroll
            for (int m = 0; m < 4; ++m) { const size_t ro = (size_t)(row0 + ai * 128 + m * 16) * DM;
#pragma unroll
                for (int bj = 0; bj < 2; ++bj) { const int c = c0 + bj * 128; f32x4 b0, b1;
                    if (BASE_BF16) { const u32x4 bw = *(const u32x4*)((const bf16_t*)base + ro + c); b0 = (f32x4){bflo(bw.x), bfhi(bw.x), bflo(bw.y), bfhi(bw.y)}; b1 = (f32x4){bflo(bw.z), bfhi(bw.z), bflo(bw.w), bfhi(bw.w)}; }
                    else { b0 = *(const f32x4*)((const float*)base + ro + c); b1 = *(const f32x4*)((const float*)base + ro + c + 4); }
                    const f32x4 g0 = *(const f32x4*)(gate + c), g1 = *(const f32x4*)(gate + c + 4);
                    const f32x4 v0 = b0 * ALPHA + g0 * acc[ai][bj][m][0], v1 = b1 * ALPHA + g1 * acc[ai][bj][m][1];
                    u32x4 w; w.x = pg8::cvt_pk_bf16(v0[0], v0[1]); w.y = pg8::cvt_pk_bf16(v0[2], v0[3]); w.z = pg8::cvt_pk_bf16(v1[0], v1[1]); w.w = pg8::cvt_pk_bf16(v1[2], v1[3]);
                    *(u32x4*)(T + ro + c) = w; } }
    }
};
struct PanelStats {
    unsigned* xbuf; unsigned* cnt; float eps;
    __device__ __forceinline__ void run(const f32x4 (&v)[2][2][4][2], const pg8::Unit& u, int wr, int wc, int fr, int fq, LAS unsigned char* lds, int wid, int lane) const {
        LAS f32x2* P = (LAS f32x2*)(lds + LN_LDS);
        LAS f32x2* S = (LAS f32x2*)(lds + LN_LDS + 8192);
#pragma unroll
        for (int ai = 0; ai < 2; ++ai)
#pragma unroll
            for (int m = 0; m < 4; ++m) {
                float s = 0.f;
#pragma unroll
                for (int bj = 0; bj < 2; ++bj)
#pragma unroll
                    for (int n = 0; n < 2; ++n) { const f32x4 x = v[ai][bj][m][n]; s += (x[0] + x[1]) + (x[2] + x[3]); }
                s += __shfl_xor(s, 16); s += __shfl_xor(s, 32);
                const float mw = s * (1.0f / 64.0f); float q = 0.f;
#pragma unroll
                for (int bj = 0; bj < 2; ++bj)
#pragma unroll
                    for (int n = 0; n < 2; ++n) { const f32x4 d = v[ai][bj][m][n] - mw; q += (d[0] * d[0] + d[1] * d[1]) + (d[2] * d[2] + d[3] * d[3]); }
                q += __shfl_xor(q, 16); q += __shfl_xor(q, 32);
                if (fq == 0) P[(ai * 128 + wr * 64 + m * 16 + fr) * 4 + wc] = (f32x2){mw, q};
                __builtin_amdgcn_sched_barrier(0);
            }
        asm volatile("s_waitcnt lgkmcnt(0)" ::: "memory"); __builtin_amdgcn_s_barrier(); asm volatile("" ::: "memory");
        const int row = wid * 32 + (lane & 31);
        if (lane < 32) {
            const f32x2 a = P[row * 4 + 0], b = P[row * 4 + 1], c = P[row * 4 + 2], d = P[row * 4 + 3];
            const float mt = (a.x + b.x + c.x + d.x) * 0.25f;
            const float da = a.x - mt, db = b.x - mt, dc = c.x - mt, dd = d.x - mt;
            const float m2 = (a.y + b.y) + (c.y + d.y) + 64.0f * ((da * da + db * db) + (dc * dc + dd * dd));
            unsigned long long* slot = (unsigned long long*)xbuf + ((size_t)(u.pm * 256 + row) * 4 + u.pn);
            __hip_atomic_store(slot, ((unsigned long long)__float_as_uint(m2) << 32) | __float_as_uint(mt), __ATOMIC_RELAXED, __HIP_MEMORY_SCOPE_AGENT);
        }
        asm volatile("s_waitcnt vmcnt(0)" ::: "memory");
        if (lane == 0) __hip_atomic_fetch_add(cnt + 64 * u.pm, 1u, __ATOMIC_RELAXED, __HIP_MEMORY_SCOPE_AGENT);
        if (wid == 0) {
            unsigned sp = 0;
            while ((unsigned)__builtin_amdgcn_readfirstlane(__hip_atomic_load(cnt + 64 * u.pm, __ATOMIC_RELAXED, __HIP_MEMORY_SCOPE_AGENT)) < 32u && ++sp < (1u << 21)) __builtin_amdgcn_s_sleep(2);
            __builtin_amdgcn_fence(__ATOMIC_ACQUIRE, "agent");
        }
        asm volatile("s_waitcnt vmcnt(0) lgkmcnt(0)" ::: "memory"); __builtin_amdgcn_s_barrier(); asm volatile("" ::: "memory");
        if (lane < 32) {
            const unsigned long long* slot = (const unsigned long long*)xbuf + (size_t)(u.pm * 256 + row) * 4; float mt[4], m2[4]; float ms = 0.f;
#pragma unroll
            for (int t = 0; t < 4; ++t) { const unsigned long long w = __hip_atomic_load(slot + t, __ATOMIC_RELAXED, __HIP_MEMORY_SCOPE_AGENT); mt[t] = __uint_as_float((unsigned)w); m2[t] = __uint_as_float((unsigned)(w >> 32)); ms += mt[t]; }
            const float mean = ms * 0.25f; float q = 0.f;
#pragma unroll
            for (int t = 0; t < 4; ++t) { const float dm = mt[t] - mean; q += m2[t] + 256.0f * dm * dm; }
            S[row] = (f32x2){mean, 1.0f / sqrtf(q * (1.0f / 1024.0f) + eps)};
        }
        asm volatile("s_waitcnt lgkmcnt(0)" ::: "memory"); __builtin_amdgcn_s_barrier(); asm volatile("" ::: "memory");
    }
};
template <bool FINAL> struct EpiResLn {
    static constexpr bool PERM = true;
    const void* base; const float* gate; const float* lg; const float* lb; const float* mod; bf16_t* X1B; bf16_t* XN; float* out; PanelStats st; LAS unsigned char* lds;
    __device__ __forceinline__ void operator()(f32x4 (&acc)[2][2][4][2], const pg8::Unit& u, int wr, int wc, int fr, int fq) const {
        asm volatile("" : "+v"(fr), "+v"(fq));
        const int row0 = u.pm * 256 + wr * 64 + fr, c0 = u.pn * 256 + wc * 32 + 8 * fq;
#pragma unroll
        for (int ai = 0; ai < 2; ++ai)
#pragma unroll
            for (int m = 0; m < 4; ++m) { int rr_ = row0 + ai * 128 + m * 16; asm volatile("" : "+v"(rr_)); const size_t ro = (size_t)rr_ * DM;
#pragma unroll
                for (int bj = 0; bj < 2; ++bj) { int c = c0 + bj * 128; asm volatile("" : "+v"(c)); f32x4 b0, b1;
                    if (FINAL) { const u32x4 bw = *(const u32x4*)((const bf16_t*)base + ro + c); b0 = (f32x4){bflo(bw.x), bfhi(bw.x), bflo(bw.y), bfhi(bw.y)}; b1 = (f32x4){bflo(bw.z), bfhi(bw.z), bflo(bw.w), bfhi(bw.w)}; }
                    else { b0 = *(const f32x4*)((const float*)base + ro + c); b1 = *(const f32x4*)((const float*)base + ro + c + 4); }
                    const f32x4 g0 = *(const f32x4*)(gate + c), g1 = *(const f32x4*)(gate + c + 4);
                    acc[ai][bj][m][0] = b0 * ALPHA + g0 * acc[ai][bj][m][0]; acc[ai][bj][m][1] = b1 * ALPHA + g1 * acc[ai][bj][m][1];
                    asm volatile("" : "+v"(acc[ai][bj][m][0]), "+v"(acc[ai][bj][m][1])); }
                __builtin_amdgcn_sched_barrier(0); }
        st.run(acc, u, wr, wc, fr, fq, lds, wr * 4 + wc, fq * 16 + fr);
        const LAS f32x2* S = (const LAS f32x2*)(lds + LN_LDS + 8192);
#pragma unroll
        for (int ai = 0; ai < 2; ++ai)
#pragma unroll
            for (int m = 0; m < 4; ++m) { int r = ai * 128 + wr * 64 + m * 16 + fr; asm volatile("" : "+v"(r)); const f32x2 sr = S[r]; const size_t ro = (size_t)(u.pm * 256 + r) * DM;
#pragma unroll
                for (int bj = 0; bj < 2; ++bj) { int c = c0 + bj * 128; asm volatile("" : "+v"(c));
                    const f32x4 y0 = (acc[ai][bj][m][0] - sr.x) * sr.y * *(const f32x4*)(lg + c) + *(const f32x4*)(lb + c);
                    const f32x4 y1 = (acc[ai][bj][m][1] - sr.x) * sr.y * *(const f32x4*)(lg + c + 4) + *(const f32x4*)(lb + c + 4);
                    if (FINAL) { __builtin_nontemporal_store(y0, (f32x4*)(out + ro + c)); __builtin_nontemporal_store(y1, (f32x4*)(out + ro + c + 4)); }
                    else { u32x4 w; w.x = pg8::cvt_pk_bf16(y0[0], y0[1]); w.y = pg8::cvt_pk_bf16(y0[2], y0[3]); w.z = pg8::cvt_pk_bf16(y1[0], y1[1]); w.w = pg8::cvt_pk_bf16(y1[2], y1[3]);
                        *(u32x4*)(X1B + ro + c) = w;
                        const f32x4 h0 = y0 * (*(const f32x4*)(mod + 4096 + c) + 1.0f) + *(const f32x4*)(mod + 3072 + c), h1 = y1 * (*(const f32x4*)(mod + 4096 + c + 4) + 1.0f) + *(const f32x4*)(mod + 3072 + c + 4);
                        u32x4 w2; w2.x = pg8::cvt_pk_bf16(h0[0], h0[1]); w2.y = pg8::cvt_pk_bf16(h0[2], h0[3]); w2.z = pg8::cvt_pk_bf16(h1[0], h1[1]); w2.w = pg8::cvt_pk_bf16(h1[2], h1[3]);
                        *(u32x4*)(XN + ro + c) = w2; } }
                __builtin_amdgcn_sched_barrier(0); }
    }
};
struct EpiSlab {
    static constexpr bool PERM = true;
    float* slab;
    __device__ __forceinline__ void operator()(const f32x4 (&acc)[2][2][4][2], const pg8::Unit& u, int wr, int wc, int fr, int fq) const {
        asm volatile("" : "+v"(fr), "+v"(fq));
        const int row0 = wr * 64 + fr, c0 = u.pn * 256 + wc * 32 + 8 * fq; float* sb = slab + (size_t)u.ks * NSMP * DM;
#pragma unroll
        for (int ai = 0; ai < 2; ++ai)
#pragma unroll
            for (int m = 0; m < 4; ++m) { float* op = sb + (size_t)(row0 + ai * 128 + m * 16) * DM + c0;
#pragma unroll
                for (int bj = 0; bj < 2; ++bj) { *(f32x4*)(op + bj * 128) = acc[ai][bj][m][0]; *(f32x4*)(op + bj * 128 + 4) = acc[ai][bj][m][1]; } }
    }
};
struct EpiFfn {
    static constexpr bool PERM = true;
    bf16_t* ACT;
    __device__ __forceinline__ void operator()(const f32x4 (&acc)[2][2][4][2], const pg8::Unit& u, int wr, int wc, int fr, int fq) const {
        asm volatile("" : "+v"(fr), "+v"(fq));
        const int row0 = u.pm * 256 + wr * 64 + fr, c0 = u.pn * 128 + wc * 32 + 8 * fq;
#pragma unroll
        for (int ai = 0; ai < 2; ++ai)
#pragma unroll
            for (int m = 0; m < 4; ++m) { const f32x4 g0 = acc[ai][0][m][0], g1 = acc[ai][0][m][1], u0 = acc[ai][1][m][0], u1 = acc[ai][1][m][1];
                u32x4 w; w.x = pg8::cvt_pk_bf16(siluf_(g0[0]) * u0[0], siluf_(g0[1]) * u0[1]); w.y = pg8::cvt_pk_bf16(siluf_(g0[2]) * u0[2], siluf_(g0[3]) * u0[3]);
                w.z = pg8::cvt_pk_bf16(siluf_(g1[0]) * u1[0], siluf_(g1[1]) * u1[1]); w.w = pg8::cvt_pk_bf16(siluf_(g1[2]) * u1[2], siluf_(g1[3]) * u1[3]);
                *(u32x4*)(ACT + (size_t)(row0 + ai * 128 + m * 16) * DFF + c0) = w; }
    }
};

struct Frame {
    LAS unsigned char* lds; unsigned char* ldsg;
    int tid, lane, wave, G, bid;
    const float* const* in; float* out; unsigned char* ws;
};
enum { I_XP = 0, I_XS, I_CDK, I_CDV, I_CFK, I_CFV, I_CFL, I_CP, I_CS, I_WADA, I_BADA, I_WIN, I_BF, I_LQ1, I_LK1, I_LQ2, I_LK2, I_SUBG, I_RELB, I_WA, I_WB, I_WO, I_LN1G, I_LN1B, I_LN2G, I_LN2B, I_WFI, I_WFO };

__device__ __forceinline__ void tr_item(const float* W, int ldw, int src_n0, int k0, bf16_t* WT, int ldt, int dst_row0, int dst_k0, int dup_off, LAS float* scr, int lane) {
#pragma unroll 8
    for (int i = 0; i < 32; ++i) { const int kk = 2 * i + (lane >> 5); scr[kk * 33 + (lane & 31)] = W[(size_t)(k0 + kk) * ldw + src_n0 + (lane & 31)]; }
    asm volatile("s_waitcnt lgkmcnt(0)" ::: "memory");
    const int c = lane & 7;
#pragma unroll
    for (int j = 0; j < 4; ++j) { const int n = (lane >> 3) + 8 * j; const LAS float* s = scr + (8 * c) * 33 + n;
        u32x4 o; o.x = pk2(s[0 * 33], s[1 * 33]); o.y = pk2(s[2 * 33], s[3 * 33]); o.z = pk2(s[4 * 33], s[5 * 33]); o.w = pk2(s[6 * 33], s[7 * 33]);
        bf16_t* d = WT + (size_t)(dst_row0 + n) * ldt + dst_k0 + 8 * c;
        *(u32x4*)d = o; if (dup_off) *(u32x4*)(d + dup_off) = o; }
    asm volatile("s_waitcnt lgkmcnt(0)" ::: "memory");
}
__device__ __forceinline__ void weight_copies(Frame& F, int c, int n, int it0, int it1) {
    LAS float* scr = (LAS float*)(F.lds + F.wave * 16384);
    const int gw = c * 8 + F.wave, NGW = n * 8;
    constexpr int I_IN = 16 * (NZ / 32), I_A = 8 * 32, I_B = 8 * 32, I_O = 16 * 32, I_FI = 16 * (NFF2 / 32), I_FO = (DFF / 64) * 32;
    for (int it = it0 + gw; it < it1; it += NGW) {
        int r = it;
        if (r < I_IN) { const int nb = NZ / 32, kb = r / nb, n0 = 32 * (r % nb); tr_item(F.in[I_WIN], WIN_COLS, n0 < 3072 ? n0 : n0 + 8, 64 * kb, (bf16_t*)(F.ws + WS_WIN), 1024, n0, 64 * kb, 0, scr, F.lane); continue; } r -= I_IN;
        if (r < I_A) { const int kb = r / 32, n0 = 32 * (r % 32); tr_item(F.in[I_WA], 1024, n0, 64 * kb, (bf16_t*)(F.ws + WS_WAB), 512, n0, 64 * kb, 0, scr, F.lane); continue; } r -= I_A;
        if (r < I_B) { const int kb = r / 32, n0 = 32 * (r % 32); tr_item(F.in[I_WB], 1024, n0, 64 * kb, (bf16_t*)(F.ws + WS_WAB), 512, 1024 + n0, 64 * kb, 0, scr, F.lane); continue; } r -= I_B;
        if (r < I_O) { const int kb = r / 32, n0 = 32 * (r % 32); tr_item(F.in[I_WO], 1024, n0, 64 * kb, (bf16_t*)(F.ws + WS_WO2), 2048, n0, 64 * kb, 1024, scr, F.lane); continue; } r -= I_O;
        if (r < I_FI) { const int nb = NFF2 / 32, kb = r / nb, n0 = 32 * (r % nb), t = n0 >> 8, j = n0 & 255; const int src = j < 128 ? 128 * t + j : DFF + 128 * t + (j - 128);
            tr_item(F.in[I_WFI], NFF2, src, 64 * kb, (bf16_t*)(F.ws + WS_WFI), 1024, n0, 64 * kb, 0, scr, F.lane); continue; } r -= I_FI;
        { const int kb = r / 32, n0 = 32 * (r % 32); tr_item(F.in[I_WFO], 1024, n0, 64 * kb, (bf16_t*)(F.ws + WS_WFO), DFF, n0, 64 * kb, 0, scr, F.lane); }
    }
}
constexpr int WC_IN = 16 * (NZ / 32), WC_ALL = WC_IN + 8 * 32 + 8 * 32 + 16 * 32 + 16 * (NFF2 / 32) + (DFF / 64) * 32;
__device__ __forceinline__ void p0_prologue(Frame& F) {
    if (F.bid < 96) {
        LAS float* sc = (LAS float*)F.lds;
        LAS float* part = sc + 17 * 1024;
        for (int i = F.tid; i < 17 * 1024; i += 512) { const int r = i >> 10, k = i & 1023; const float c = r == 0 ? F.in[I_CP][k] : F.in[I_CS][(r - 1) * 1024 + k]; sc[i] = siluf_(c); }
        __syncthreads();
        const int n = F.bid * 64 + F.lane; const float* wa = F.in[I_WADA] + n;
        float acc[17];
#pragma unroll
        for (int r = 0; r < 17; ++r) acc[r] = 0.f;
        for (int k = F.wave * 128; k < F.wave * 128 + 128; k += 4) {
            const float w0 = wa[(size_t)k * 6144], w1 = wa[(size_t)(k + 1) * 6144], w2 = wa[(size_t)(k + 2) * 6144], w3 = wa[(size_t)(k + 3) * 6144];
#pragma unroll
            for (int r = 0; r < 17; ++r) { const f32x4 s = *(const LAS f32x4*)(sc + r * 1024 + k); acc[r] += s[0] * w0 + s[1] * w1 + s[2] * w2 + s[3] * w3; }
        }
#pragma unroll
        for (int r = 0; r < 17; ++r) part[(F.wave * 17 + r) * 64 + F.lane] = acc[r];
        __syncthreads();
        float* mod = (float*)(F.ws + WS_MOD);
        for (int i = F.tid; i < 17 * 64; i += 512) { const int r = i >> 6, l = i & 63; float s = 0.f;
#pragma unroll
            for (int w = 0; w < 8; ++w) s += part[(w * 17 + r) * 64 + l];
            mod[r * 6144 + F.bid * 64 + l] = s + F.in[I_BADA][F.bid * 64 + l]; }
        asm volatile("s_waitcnt vmcnt(0)" ::: "memory");
        __syncthreads();
        if (F.tid == 0) { __builtin_amdgcn_fence(__ATOMIC_RELEASE, "agent"); asm volatile("s_waitcnt vmcnt(0)" ::: "memory");
            __hip_atomic_fetch_add((unsigned*)(F.ws + WS_CTL) + 320, 1u, __ATOMIC_RELAXED, __HIP_MEMORY_SCOPE_AGENT); }
    }
    weight_copies(F, F.bid, F.G, 0, 16 * (NZ / 32));
}

__device__ __forceinline__ void p1_rows(Frame& F, bool wait_mod) {
    LAS float* wf = (LAS float*)F.lds;
    for (int i = F.tid; i < 1024 * 8; i += 512) wf[i] = F.in[I_WIN][(size_t)(i >> 3) * WIN_COLS + 3072 + (i & 7)];
    __syncthreads();
    const float* mod = (const float*)(F.ws + WS_MOD);
    bf16_t* XN = (bf16_t*)(F.ws + WS_XN);
    const int gw = F.bid * 8 + F.wave, NGW = F.G * 8;
    if (wait_mod) {
        if (F.tid == 0) { unsigned* w = (unsigned*)(F.ws + WS_CTL) + 320; unsigned sp = 0;
            while (__hip_atomic_load(w, __ATOMIC_RELAXED, __HIP_MEMORY_SCOPE_AGENT) < 96u && ++sp < (1u << 22)) __builtin_amdgcn_s_sleep(2);
            __builtin_amdgcn_fence(__ATOMIC_ACQUIRE, "agent"); asm volatile("s_waitcnt vmcnt(0)" ::: "memory"); }
        __syncthreads(); }
    int m = gw;
    for (; m + NGW < SEQ; m += 2 * NGW) {
        const float* xr0 = F.in[I_XP] + (size_t)m * DM; const float* xr1 = xr0 + (size_t)NGW * DM;
        float a8[2][8];
#pragma unroll
        for (int j = 0; j < 8; ++j) { a8[0][j] = 0.f; a8[1][j] = 0.f; }
#pragma unroll
        for (int j = 0; j < 4; ++j) { const int k = 4 * F.lane + 256 * j;
            const f32x4 x0 = *(const f32x4*)(xr0 + k), x1 = *(const f32x4*)(xr1 + k), s1 = *(const f32x4*)(mod + 1024 + k), t1 = *(const f32x4*)(mod + k);
            const f32x4 h0 = x0 * (s1 + 1.0f) + t1, h1 = x1 * (s1 + 1.0f) + t1;
            u32x2 w; w.x = pk2(h0[0], h0[1]); w.y = pk2(h0[2], h0[3]); *(u32x2*)(XN + (size_t)m * DM + k) = w;
            w.x = pk2(h1[0], h1[1]); w.y = pk2(h1[2], h1[3]); *(u32x2*)(XN + (size_t)(m + NGW) * DM + k) = w;
#pragma unroll
            for (int e = 0; e < 4; ++e) { const f32x4 wa = *(const LAS f32x4*)(wf + (k + e) * 8), wb = *(const LAS f32x4*)(wf + (k + e) * 8 + 4);
#pragma unroll
                for (int c = 0; c < 4; ++c) { a8[0][c] += h0[e] * wa[c]; a8[0][4 + c] += h0[e] * wb[c]; a8[1][c] += h1[e] * wa[c]; a8[1][4 + c] += h1[e] * wb[c]; } } }
        float mine = 0.f;
#pragma unroll
        for (int j = 0; j < 8; ++j) { const float s0 = wave_sum(a8[0][j]), s1 = wave_sum(a8[1][j]); if (F.lane == j) mine = s0; if (F.lane == 8 + j) mine = s1; }
        if (F.lane < 16) { const int rr = F.lane >> 3, c = F.lane & 7; const float v = mine + F.in[I_BF][c]; const float lf = fminf(v, 0.f) - log1pf(__expf(-fabsf(v)));
            F.out[O_FLP + (size_t)(m + rr * NGW) * 8 + c] = lf; }
    }
    for (; m < MT; m += NGW) {
        const bool smp = m >= SEQ; const int rb = smp ? 1 + ((m - SEQ) >> 4) : 0;
        const float* xr = smp ? F.in[I_XS] + (size_t)(m - SEQ) * DM : F.in[I_XP] + (size_t)m * DM;
        const float* sh = mod + (size_t)rb * 6144, *scl = sh + 1024;
        float a8[8];
#pragma unroll
        for (int j = 0; j < 8; ++j) a8[j] = 0.f;
#pragma unroll
        for (int j = 0; j < 4; ++j) { const int k = 4 * F.lane + 256 * j;
            const f32x4 x = *(const f32x4*)(xr + k), s1 = *(const f32x4*)(scl + k), t1 = *(const f32x4*)(sh + k);
            const f32x4 h = x * (s1 + 1.0f) + t1;
            u32x2 w; w.x = pk2(h[0], h[1]); w.y = pk2(h[2], h[3]); *(u32x2*)(XN + (size_t)m * DM + k) = w;
#pragma unroll
            for (int e = 0; e < 4; ++e) { const f32x4 wa = *(const LAS f32x4*)(wf + (k + e) * 8), wb = *(const LAS f32x4*)(wf + (k + e) * 8 + 4);
                a8[0] += h[e] * wa[0]; a8[1] += h[e] * wa[1]; a8[2] += h[e] * wa[2]; a8[3] += h[e] * wa[3];
                a8[4] += h[e] * wb[0]; a8[5] += h[e] * wb[1]; a8[6] += h[e] * wb[2]; a8[7] += h[e] * wb[3]; } }
        float mine = 0.f;
#pragma unroll
        for (int j = 0; j < 8; ++j) { const float s = wave_sum(a8[j]); if (F.lane == j) mine = s; }
        if (F.lane < 8) { const float v = mine + F.in[I_BF][F.lane]; const float lf = fminf(v, 0.f) - log1pf(__expf(-fabsf(v)));
            float* o = smp ? F.out + O_FLS + (size_t)(m - SEQ) * 8 : F.out + O_FLP + (size_t)m * 8; o[F.lane] = lf; }
    }
}

__device__ __forceinline__ float block_excl_scan(Frame& F, float tot, LAS float* sm) {
    float inc = tot;
#pragma unroll
    for (int o = 1; o < 64; o <<= 1) { const float t = __shfl_up(inc, o); if (F.lane >= o) inc += t; }
    if (F.lane == 63) sm[F.wave] = inc;
    __syncthreads();
    float base = 0.f;
    for (int w = 0; w < F.wave; ++w) base += sm[w];
    __syncthreads();
    return base + inc - tot;
}
__device__ __forceinline__ void p2_cumsum(Frame& F) {
    LAS float* sm = (LAS float*)F.lds;
    const int rb_ = F.G >= 160 ? F.bid - 20 : F.bid;
    if (rb_ < 0) return;
    if (rb_ < 8) {
        const int h = rb_; const float* lf = F.out + O_FLP; float* Fp = (float*)(F.ws + WS_FP) + (size_t)h * SEQ;
        float v[32]; float run = 0.f;
#pragma unroll
        for (int i = 0; i < 32; ++i) { run += lf[(size_t)(32 * F.tid + i) * 8 + h]; v[i] = run; }
        const float off = block_excl_scan(F, run, sm);
#pragma unroll
        for (int i = 0; i < 32; i += 4) *(f32x4*)(Fp + 32 * F.tid + i) = (f32x4){(off + v[i]) * LOG2E, (off + v[i + 1]) * LOG2E, (off + v[i + 2]) * LOG2E, (off + v[i + 3]) * LOG2E};
    } else if (rb_ < 8 + 128) {
        const int b = (rb_ - 8) >> 3, h = (rb_ - 8) & 7;
        const float* cl = F.in[I_CFL] + (size_t)b * PAST * 8; float* Fs = (float*)(F.ws + WS_FS) + (size_t)(b * 8 + h) * SKV;
        float v[4]; float run = 0.f;
#pragma unroll
        for (int i = 0; i < 4; ++i) { run += cl[(size_t)(4 * F.tid + i) * 8 + h]; v[i] = run; }
        const float off = block_excl_scan(F, run, sm);
        *(f32x4*)(Fs + 4 * F.tid) = (f32x4){(off + v[0]) * LOG2E, (off + v[1]) * LOG2E, (off + v[2]) * LOG2E, (off + v[3]) * LOG2E};
        if (F.tid == 511) { float r2 = off + run; const float* ls = F.out + O_FLS + (size_t)b * DEC_T * 8;
            for (int t = 0; t < DEC_T; ++t) { r2 += ls[t * 8 + h]; Fs[PAST + t] = r2 * LOG2E; } }
    }
}

template <bool FINAL> __device__ __forceinline__ void ln_rows(Frame& F, const float* g, const float* b, int KS, int gate_off) {
    const float* mod = (const float*)(F.ws + WS_MOD);
    const bf16_t* T = (const bf16_t*)(F.ws + WS_TB); bf16_t* X1B = (bf16_t*)(F.ws + WS_X1B); bf16_t* XN = (bf16_t*)(F.ws + WS_XN);
    const int gw = F.wave * F.G + F.bid, NGW = F.G * 8;
    for (int m = SEQ + gw; m < MT; m += NGW) {
        f32x4 v[4]; float s = 0.f;
        if (m < SEQ) {
#pragma unroll
            for (int j = 0; j < 2; ++j) { const u32x4 w = *(const u32x4*)(T + (size_t)m * DM + 8 * F.lane + 512 * j);
                v[2 * j] = (f32x4){bflo(w.x), bfhi(w.x), bflo(w.y), bfhi(w.y)}; v[2 * j + 1] = (f32x4){bflo(w.z), bfhi(w.z), bflo(w.w), bfhi(w.w)}; }
        } else {
            const float* sl = (const float*)(F.ws + WS_SLAB) + (size_t)(m - SEQ) * DM; const float* gp = mod + (size_t)(1 + ((m - SEQ) >> 4)) * 6144 + gate_off;
#pragma unroll
            for (int q = 0; q < 4; ++q) { const int k = 8 * F.lane + 512 * (q >> 1) + 4 * (q & 1); f32x4 a = (f32x4){0.f, 0.f, 0.f, 0.f};
                for (int ks = 0; ks < KS; ++ks) a += *(const f32x4*)(sl + (size_t)ks * NSMP * DM + k);
                f32x4 bs;
                if (FINAL) { const u32x2 w = *(const u32x2*)(X1B + (size_t)m * DM + k); bs = (f32x4){bflo(w.x), bfhi(w.x), bflo(w.y), bfhi(w.y)}; }
                else bs = *(const f32x4*)(F.in[I_XS] + (size_t)(m - SEQ) * DM + k);
                v[q] = bs * ALPHA + *(const f32x4*)(gp + k) * a; } }
#pragma unroll
        for (int q = 0; q < 4; ++q) s += (v[q][0] + v[q][1]) + (v[q][2] + v[q][3]);
        const float mean = wave_sum(s) * (1.f / DM); float s2 = 0.f;
#pragma unroll
        for (int q = 0; q < 4; ++q) { v[q] = v[q] - mean; s2 += (v[q][0] * v[q][0] + v[q][1] * v[q][1]) + (v[q][2] * v[q][2] + v[q][3] * v[q][3]); }
        const float rstd = 1.f / sqrtf(wave_sum(s2) * (1.f / DM) + LN_EPS);
        const int rb = m >= SEQ ? 1 + ((m - SEQ) >> 4) : 0;
#pragma unroll
        for (int q = 0; q < 4; ++q) { const int k = 8 * F.lane + 512 * (q >> 1) + 4 * (q & 1); const f32x4 gg = *(const f32x4*)(g + k), bb = *(const f32x4*)(b + k);
            const f32x4 y = v[q] * rstd * gg + bb;
            if (FINAL) *(f32x4*)(F.out + (size_t)m * DM + k) = y;
            else { u32x2 w; w.x = pk2(y[0], y[1]); w.y = pk2(y[2], y[3]); *(u32x2*)(X1B + (size_t)m * DM + k) = w;
                const f32x4 s2v = *(const f32x4*)(mod + (size_t)rb * 6144 + 4096 + k), t2v = *(const f32x4*)(mod + (size_t)rb * 6144 + 3072 + k);
                const f32x4 h = y * (s2v + 1.0f) + t2v; u32x2 w2; w2.x = pk2(h[0], h[1]); w2.y = pk2(h[2], h[3]); *(u32x2*)(XN + (size_t)m * DM + k) = w2; } }
    }
}

__device__ __forceinline__ int t5_bucket(int rel) {
    const int n = rel < 0 ? -rel : rel; int b;
    if (n < 8) b = n; else if (n < 12) b = 8; else if (n < 16) b = 9; else if (n < 23) b = 10; else if (n < 32) b = 11; else if (n < 46) b = 12; else if (n < 64) b = 13; else if (n < 91) b = 14; else b = 15;
    return b + (rel > 0 ? 16 : 0);
}
constexpr int AT_KB = 8192, AT_VB = 20480, AT_BUF = AT_KB + AT_VB;
constexpr int AT_WS = 2 * AT_BUF, AT_OST = AT_WS + 2048, AT_KEEP = 98304, AT_TAB = 131072, AT_MISC = AT_TAB + 4 * 192 * 4, AT_END = AT_MISC + 64;
__device__ __forceinline__ s16x4 vtr(const LAS char* p) { typedef short v4i16_t __attribute__((ext_vector_type(4))); return __builtin_bit_cast(s16x4, __builtin_amdgcn_ds_read_tr16_b64_v4i16((LAS v4i16_t*)p)); }

typedef __bf16 bf16x2_t_ __attribute__((ext_vector_type(2)));
__device__ __forceinline__ unsigned cvtpk_(float lo, float hi) { f32x2 v = {lo, hi}; bf16x2_t_ b = __builtin_convertvector(v, bf16x2_t_); return __builtin_bit_cast(unsigned, b); }
__device__ __forceinline__ void glds16_asm(const void* gsrc, unsigned lds_dst) { unsigned keep;
    asm volatile("s_mov_b32 %0, m0\n\ts_mov_b32 m0, %2\n\ts_nop 0\n\tglobal_load_lds_dwordx4 %1, off\n\ts_mov_b32 m0, %0" : "=&s"(keep) : "v"(gsrc), "s"(lds_dst) : "memory"); }
template <int OFF> __device__ __forceinline__ void glds16_asm_off(const void* gsrc, unsigned lds_dst) { unsigned keep;
    asm volatile("s_mov_b32 %0, m0\n\ts_mov_b32 m0, %2\n\ts_nop 0\n\tglobal_load_lds_dwordx4 %1, off offset:%3\n\ts_mov_b32 m0, %0" : "=&s"(keep) : "v"(gsrc), "s"(lds_dst), "i"(OFF) : "memory"); }
template <int OFF> __device__ __forceinline__ void glds16_s(const void* sbase, unsigned voff, unsigned lds_dst) { unsigned keep;
    asm volatile("s_mov_b32 %0, m0\n\ts_mov_b32 m0, %3\n\ts_nop 0\n\tglobal_load_lds_dwordx4 %1, %2 offset:%4\n\ts_mov_b32 m0, %0" : "=&s"(keep) : "v"(voff), "s"(sbase), "s"(lds_dst), "i"(OFF) : "memory"); }
__device__ __forceinline__ void glds4_s(const void* sbase, unsigned voff, unsigned lds_dst) { unsigned keep;
    asm volatile("s_mov_b32 %0, m0\n\ts_mov_b32 m0, %3\n\ts_nop 0\n\tglobal_load_lds_dword %1, %2\n\ts_mov_b32 m0, %0" : "=&s"(keep) : "v"(voff), "s"(sbase), "s"(lds_dst) : "memory"); }
__device__ __forceinline__ const void* uniform_ptr(const void* p) { const unsigned long long v = (unsigned long long)p;
    const unsigned lo = (unsigned)__builtin_amdgcn_readfirstlane((int)(unsigned)v), hi = (unsigned)__builtin_amdgcn_readfirstlane((int)(unsigned)(v >> 32)); return (const void*)(((unsigned long long)hi << 32) | lo); }
__device__ __forceinline__ void glds4_asm(const void* gsrc, unsigned lds_dst) { unsigned keep;
    asm volatile("s_mov_b32 %0, m0\n\ts_mov_b32 m0, %2\n\ts_nop 0\n\tglobal_load_lds_dword %1, off\n\ts_mov_b32 m0, %0" : "=&s"(keep) : "v"(gsrc), "s"(lds_dst) : "memory"); }
constexpr int R_V = 0, R_K = 49152, R_F = 73728, R_WS = 79872;
__device__ __forceinline__ float max3f_(float a, float b, float c) { float r; asm("v_max3_f32 %0, %1, %2, %3" : "=v"(r) : "v"(a), "v"(b), "v"(c)); return r; }
__device__ __forceinline__ float max2f_(float a, float b) { float r; asm("v_max_f32_e32 %0, %1, %2" : "=v"(r) : "v"(a), "v"(b)); return r; }
#define AP3_PIN(x) asm volatile("" : "+v"(x))
template <int MODE, int DV, int pv = 0, bool SREF = false>
__device__ __forceinline__ void attn_pass3(Frame& F, const bf16_t* Q, const bf16_t* K, const bf16_t* V, int q0, int NT, const float* Fh, int hb, f32x16 (&o)[DV / 32], int t0 = 0) {
    constexpr int NDB = DV / 32, VS = DV * 128, EPG = 8 / NDB;
    constexpr float THR = 8.0f;
    const int lane = F.lane, r32 = lane & 31, hi = lane >> 5, wid = F.wave;
    const LAS char* lds = (const LAS char*)F.lds;
    LAS float* wsf = (LAS float*)(F.lds + R_WS) + wid * 64;
    const LAS float* tab = (const LAS float*)(F.lds + AT_TAB) + hb * 192;
    const int qrow = q0 + wid * 32 + r32;
    const int tmaxw = (q0 >> 6) + (wid >> 1);
    const char* Ku = (const char*)uniform_ptr(K); const char* Vu = (const char*)uniform_ptr(V); const char* Fu = (const char*)uniform_ptr(MODE == 0 ? (const void*)Fh : (const void*)K);
    const unsigned kvo = (unsigned)(((8 * wid + (lane >> 3)) * 512 + (((lane & 7) ^ (lane >> 3)) << 3)) * 2);
    const unsigned vvo = (unsigned)(((16 * (wid & 3) + (lane >> 2)) * 512 + 32 * (wid >> 2) + 8 * (lane & 3)) * 2);
    const unsigned fvo = (unsigned)(lane * 4);
    const unsigned lds0 = (unsigned)(size_t)F.lds;
    const unsigned dk = (unsigned)__builtin_amdgcn_readfirstlane((int)(lds0 + R_K + wid * 1024)), dv = (unsigned)__builtin_amdgcn_readfirstlane((int)(lds0 + R_V + wid * 1024)),
                   df = (unsigned)__builtin_amdgcn_readfirstlane((int)(lds0 + R_F + wid * 256));
#define AP_ISSUE_K(t, SL) do { glds16_s<0>(Ku + (size_t)(t) * 65536, kvo, dk + (SL) * 8192); if (MODE == 0) glds4_s(Fu + (size_t)(t) * 256, fvo, df + (SL) * 2048); } while (0)
#define AP_ISSUE_V(t, SL) do { glds16_s<0>(Vu + (size_t)(t) * 65536, vvo, dv + (SL) * VS); if (DV == 128) glds16_s<0>(Vu + (size_t)(t) * 65536 + 128, vvo, dv + (SL) * VS + 8192); } while (0)
#define AP_BATCH(t, SL) do { if (pv != 1) { if ((t) + 2 < NT) AP_ISSUE_K((t) + 2, ((SL) + 2) % 3); if ((t) + 1 < NT) AP_ISSUE_V((t) + 1, ((SL) + 1) % 3); } } while (0)
    AP_ISSUE_K(t0, 0); AP_ISSUE_K(t0 + 1, 1); AP_ISSUE_V(t0, 0);
    bf16x8 qr[4];
#pragma unroll
    for (int d0 = 0; d0 < 4; ++d0) qr[d0] = *(const bf16x8*)(Q + (size_t)qrow * 512 + d0 * 16 + hi * 8);
    float fqp = MODE == 0 ? Fh[qrow] : 0.f;
#pragma unroll
    for (int d = 0; d < NDB; ++d) o[d] = f32x16{};
    float m_hat = 0.f, l_run = 0.f;
    f32x16 p0, p1, negm; u32x4 pwv[4];
#pragma unroll
    for (int r = 0; r < 16; ++r) negm[r] = 0.f;
#pragma unroll
    for (int i = 0; i < 4; ++i) pwv[i] = (u32x4){0u, 0u, 0u, 0u};
    const LAS char* kb4[4];
#pragma unroll
    for (int d0 = 0; d0 < 4; ++d0) kb4[d0] = lds + R_K + r32 * 128 + (((2 * d0 + hi) ^ (r32 & 7)) << 4);
    const LAS char* vb1 = lds + R_V + (4 * hi + ((lane & 15) >> 2)) * 64 + (((lane >> 4) & 1) * 16 + (lane & 3) * 4) * 2;
    const LAS char* fb1 = lds + R_F + wid * 256 + 16 * hi;
    asm volatile("s_waitcnt vmcnt(0)" ::: "memory");
    asm volatile("" : "+v"(qr[0]), "+v"(qr[1]), "+v"(qr[2]), "+v"(qr[3]), "+v"(fqp));
    asm volatile("s_waitcnt lgkmcnt(0)\n\ts_barrier" ::: "memory");
#define AP3_VFL(buf, ks, SLV) do { _Pragma("unroll") for (int d = 0; d < NDB; ++d) { buf[2 * d] = vtr(vb1 + (SLV) * VS + d * 4096 + (ks) * 1024); buf[2 * d + 1] = vtr(vb1 + (SLV) * VS + d * 4096 + (ks) * 1024 + 512); } } while (0)
#define AP3_VFL1(buf, d, ks, SLV) do { buf[2 * (d)] = vtr(vb1 + (SLV) * VS + (d) * 4096 + (ks) * 1024); buf[2 * (d) + 1] = vtr(vb1 + (SLV) * VS + (d) * 4096 + (ks) * 1024 + 512); } while (0)
#define AP3_FRAG(buf, d) ((bf16x8){buf[2 * (d)][0], buf[2 * (d)][1], buf[2 * (d)][2], buf[2 * (d)][3], buf[2 * (d) + 1][0], buf[2 * (d) + 1][1], buf[2 * (d) + 1][2], buf[2 * (d) + 1][3]})
#define AP3_GAP(ks, d, VCUR, VNXT, PC, BC, PP, BP, HASPREV, HASNEXT, SLV) do { \
        o[d] = __builtin_amdgcn_mfma_f32_32x32x16_bf16(__builtin_bit_cast(bf16x8, pwv[ks]), AP3_FRAG(VCUR, d), o[d], 0, 0, 0); \
        if (HASNEXT) AP3_VFL1(VNXT, d, (ks) + 1, SLV); \
        _Pragma("unroll") for (int e = 0; e < EPG; ++e) { PC[(BC) + EPG * (d) + e] = __builtin_amdgcn_exp2f(PC[(BC) + EPG * (d) + e]); } \
        if (HASPREV) { _Pragma("unroll") for (int e = 0; e < EPG; ++e) rs += PP[(BP) + EPG * (d) + e]; \
            _Pragma("unroll") for (int e = 0; e < EPG / 2; ++e) pwv[(ks) - 1][(EPG / 2) * (d) + e] = cvtpk_(PP[(BP) + EPG * (d) + 2 * e], PP[(BP) + EPG * (d) + 2 * e + 1]); AP3_PIN(rs); } \
        AP3_PIN(PC); \
        __builtin_amdgcn_sched_barrier(0); } while (0)
#define AP3_GROUP(ks, VCUR, VNXT, PC, BC, PP, BP, HASPREV, HASNEXT, SLV) do { _Pragma("unroll") for (int d = 0; d < NDB; ++d) AP3_GAP(ks, d, VCUR, VNXT, PC, BC, PP, BP, HASPREV, HASNEXT, SLV); } while (0)
#define AP3_OCT(PC, BC, KS) do { _Pragma("unroll") for (int e = 0; e < 8; ++e) { PC[(BC) + e] = __builtin_amdgcn_exp2f(PC[(BC) + e]); rs += PC[(BC) + e]; } \
        _Pragma("unroll") for (int e = 0; e < 4; ++e) pwv[KS][e] = cvtpk_(PC[(BC) + 2 * e], PC[(BC) + 2 * e + 1]); } while (0)
#define AP3_KRD(i, SL) (*(const LAS bf16x8*)(kb4[(i) >> 1] + (SL) * 8192 + ((i) & 1) * 4096))
#define AP3_MM(KF, d0, P) P = __builtin_amdgcn_mfma_f32_32x32x16_bf16(KF, qr[d0], P, 0, 0, 0)
#define AP3_QKF(SL) do { bf16x8 ka = AP3_KRD(0, SL), kb = AP3_KRD(1, SL), kc = AP3_KRD(2, SL); \
        if (MODE == 0) { \
            _Pragma("unroll") for (int g4 = 0; g4 < 4; ++g4) { const f32x4 fa = *(const LAS f32x4*)(fb1 + (SL) * 2048 + 32 * g4), fb = *(const LAS f32x4*)(fb1 + (SL) * 2048 + 128 + 32 * g4); \
                _Pragma("unroll") for (int e = 0; e < 4; ++e) { p0[4 * g4 + e] = fqp - fa[e]; p1[4 * g4 + e] = fqp - fb[e]; } } \
        } else { p0 = f32x16{}; p1 = f32x16{}; } \
        __builtin_amdgcn_sched_barrier(0); \
        AP3_MM(ka, 0, p0); ka = AP3_KRD(3, SL); __builtin_amdgcn_sched_barrier(0); \
        AP3_MM(kb, 0, p1); kb = AP3_KRD(4, SL); __builtin_amdgcn_sched_barrier(0); \
        AP3_MM(kc, 1, p0); kc = AP3_KRD(5, SL); __builtin_amdgcn_sched_barrier(0); \
        AP3_MM(ka, 1, p1); ka = AP3_KRD(6, SL); __builtin_amdgcn_sched_barrier(0); \
        AP3_MM(kb, 2, p0); kb = AP3_KRD(7, SL); __builtin_amdgcn_sched_barrier(0); \
        AP3_MM(kc, 2, p1); __builtin_amdgcn_sched_barrier(0); \
        AP3_MM(ka, 3, p0); __builtin_amdgcn_sched_barrier(0); \
        AP3_MM(kb, 3, p1); \
        asm volatile("" : "+v"(p0), "+v"(p1)); \
    } while (0)
#define AP3_QKS(SL) do { bf16x8 kf[8]; \
        _Pragma("unroll") for (int d0 = 0; d0 < 4; ++d0) { kf[2 * d0] = *(const LAS bf16x8*)(kb4[d0] + (SL) * 8192); kf[2 * d0 + 1] = *(const LAS bf16x8*)(kb4[d0] + (SL) * 8192 + 4096); } \
        if (MODE == 0) { const float sft = fqp - m_hat; \
            _Pragma("unroll") for (int g4 = 0; g4 < 4; ++g4) { const f32x4 fa = *(const LAS f32x4*)(fb1 + (SL) * 2048 + 32 * g4), fb = *(const LAS f32x4*)(fb1 + (SL) * 2048 + 128 + 32 * g4); \
                _Pragma("unroll") for (int e = 0; e < 4; ++e) { p0[4 * g4 + e] = sft - fa[e]; p1[4 * g4 + e] = sft - fb[e]; } } \
            _Pragma("unroll") for (int d0 = 0; d0 < 4; ++d0) { p0 = __builtin_amdgcn_mfma_f32_32x32x16_bf16(kf[2 * d0], qr[d0], p0, 0, 0, 0); p1 = __builtin_amdgcn_mfma_f32_32x32x16_bf16(kf[2 * d0 + 1], qr[d0], p1, 0, 0, 0); } \
        } else { \
            if constexpr (SREF) { p0 = __builtin_amdgcn_mfma_f32_32x32x16_bf16(kf[0], qr[0], f32x16{}, 0, 0, 0); p1 = __builtin_amdgcn_mfma_f32_32x32x16_bf16(kf[1], qr[0], f32x16{}, 0, 0, 0); } \
            else { p0 = __builtin_amdgcn_mfma_f32_32x32x16_bf16(kf[0], qr[0], negm, 0, 0, 0); p1 = __builtin_amdgcn_mfma_f32_32x32x16_bf16(kf[1], qr[0], negm, 0, 0, 0); } \
            _Pragma("unroll") for (int d0 = 1; d0 < 4; ++d0) { p0 = __builtin_amdgcn_mfma_f32_32x32x16_bf16(kf[2 * d0], qr[d0], p0, 0, 0, 0); p1 = __builtin_amdgcn_mfma_f32_32x32x16_bf16(kf[2 * d0 + 1], qr[d0], p1, 0, 0, 0); } } \
        if constexpr (SREF) asm volatile("" : "+v"(p0), "+v"(p1)); else asm volatile("s_nop 15\n\ts_nop 7" : "+v"(p0), "+v"(p1));     \
    } while (0)
#define AP3_QK(SL) do { if constexpr (SREF) AP3_QKF(SL); else AP3_QKS(SL); } while (0)
#define AP3_DECIDE(WITH_TAB) do { \
        if (MODE == 0) { \
            if (t * 64 + 63 > q0 + wid * 32) { const int ln_ = lane_id_opaque(), kv0 = t * 64 + 4 * (ln_ >> 5), qrow_ = q0 + wid * 32 + (ln_ & 31);     \
                _Pragma("unroll") for (int r = 0; r < 16; ++r) { const int kv = kv0 + (r & 3) + 8 * (r >> 2); if (kv > qrow_) p0[r] = -1e30f; if (kv + 32 > qrow_) p1[r] = -1e30f; } } \
        } else if (WITH_TAB) { \
            if (near) { const int ln_ = lane_id_opaque(), kv0 = t * 64 + 4 * (ln_ >> 5), qrow_ = q0 + wid * 32 + (ln_ & 31); const LAS float* tab_ = (const LAS float*)(F.lds + AT_TAB) + hb * 192; \
                _Pragma("unroll") for (int g4 = 0; g4 < 4; ++g4) { \
                    _Pragma("unroll") for (int e = 0; e < 4; ++e) { const int r = 4 * g4 + e; const int rel = kv0 + e + 8 * g4 - qrow_; int i0 = rel + 128, i1 = rel + 160; i0 = i0 < 0 ? 0 : i0; i1 = i1 < 0 ? 0 : i1; \
                        p0[r] += tab_[i0]; p1[r] += tab_[i1]; } \
                    __builtin_amdgcn_sched_barrier(0); } } } \
        if constexpr (!SREF) { \
        float ma = max3f_(p0[0], p0[1], p1[0]), mb = max3f_(p0[2], p0[3], p1[1]); ma = max3f_(ma, p1[2], p1[3]); \
        _Pragma("unroll") for (int r = 4; r < 16; r += 4) { ma = max3f_(ma, p0[r], p0[r + 1]); mb = max3f_(mb, p0[r + 2], p0[r + 3]); ma = max3f_(ma, p1[r], p1[r + 1]); mb = max3f_(mb, p1[r + 2], p1[r + 3]); } \
        float rm = max2f_(ma, mb); \
        { auto rr = __builtin_amdgcn_permlane32_swap(__float_as_uint(rm), __float_as_uint(rm), false, false); rm = max2f_(__uint_as_float(rr[0]), __uint_as_float(rr[1])); } \
        resc = (tz == t0) || __any(rm > THR); \
        if (resc) { const float dl = tz == t0 ? rm : fmaxf(rm, 0.f); m_hat += dl; \
            _Pragma("unroll") for (int r = 0; r < 16; ++r) { p0[r] -= dl; p1[r] -= dl; } \
            if (MODE == 1) { const float nm_ = -m_hat; _Pragma("unroll") for (int r = 0; r < 16; ++r) negm[r] = nm_; } \
            al = tz == t0 ? 1.0f : __builtin_amdgcn_exp2f(-dl); l_run *= al; } } } while (0)
#define AP3_STEP(tt, SL) do { const int t = (tt); if (t > NT) break; int tz = t; asm volatile("" : "+s"(tz)); \
        if (t < NT) AP_BATCH(t, SL); \
        const bool doPV = tz > t0 && t - 1 <= tmaxw, doQK = t < NT && t <= tmaxw; \
        bool resc = false; float al = 1.0f, rs = 0.f; \
        const bool near = MODE == 1 && (t * 64 + 63 + 91 > q0 + wid * 32); \
        if (doQK) AP3_QK(SL); else { p0 = f32x16{}; p1 = f32x16{}; }     \
        __builtin_amdgcn_sched_barrier(0); \
        if (doQK) AP3_DECIDE(true); \
        __builtin_amdgcn_sched_barrier(0); \
        if (doPV) { s16x4 vfa[2 * NDB]; AP3_VFL(vfa, 0, ((SL) + 2) % 3);     \
            AP3_GROUP(0, vfa, vfa, p0, 0, p0, 0, false, true, ((SL) + 2) % 3); \
            AP3_GROUP(1, vfa, vfa, p0, 8, p0, 0, true, true, ((SL) + 2) % 3); \
            AP3_GROUP(2, vfa, vfa, p1, 0, p0, 8, true, true, ((SL) + 2) % 3); \
            AP3_GROUP(3, vfa, vfa, p1, 8, p1, 0, true, false, ((SL) + 2) % 3); \
            _Pragma("unroll") for (int e = 0; e < 8; ++e) rs += p1[8 + e]; \
            _Pragma("unroll") for (int e = 0; e < 4; ++e) pwv[3][e] = cvtpk_(p1[8 + 2 * e], p1[8 + 2 * e + 1]); \
        } else if (doQK) { AP3_OCT(p0, 0, 0); AP3_OCT(p0, 8, 1); AP3_OCT(p1, 0, 2); AP3_OCT(p1, 8, 3); } \
        if (doQK) l_run += rs; \
          \
        if (resc && tz > t0) { \
            if (hi == 0) wsf[r32] = al; \
            asm volatile("s_waitcnt lgkmcnt(0)" ::: "memory"); \
            _Pragma("unroll") for (int g4 = 0; g4 < 4; ++g4) { const f32x4 a4 = *(const LAS f32x4*)(wsf + 8 * g4 + 4 * hi); \
                _Pragma("unroll") for (int d = 0; d < NDB; ++d) \
                    _Pragma("unroll") for (int e = 0; e < 4; ++e) o[d][4 * g4 + e] *= a4[e]; } } \
        if (t == NT) break; \
        if (pv == 6) { if (t + 2 < NT) asm volatile("s_waitcnt vmcnt(3) lgkmcnt(0)" ::: "memory"); else asm volatile("s_waitcnt vmcnt(0) lgkmcnt(0)" ::: "memory"); } \
        else { if (t + 2 < NT) asm volatile("s_waitcnt vmcnt(3) lgkmcnt(0)\n\ts_barrier" ::: "memory"); else asm volatile("s_waitcnt vmcnt(0) lgkmcnt(0)\n\ts_barrier" ::: "memory"); } \
    } while (0)
#define AP3_FSTEP(tt, SL) do { const int t = (tt); \
        AP_ISSUE_K(t + 2, ((SL) + 2) % 3); AP_ISSUE_V(t + 1, ((SL) + 1) % 3); \
        float rs = 0.f; \
        AP3_QKF(SL); \
        __builtin_amdgcn_sched_barrier(0); \
        { s16x4 vfa[2 * NDB]; AP3_VFL(vfa, 0, ((SL) + 2) % 3); \
          AP3_GROUP(0, vfa, vfa, p0, 0, p0, 0, false, true, ((SL) + 2) % 3); \
          AP3_GROUP(1, vfa, vfa, p0, 8, p0, 0, true, true, ((SL) + 2) % 3); \
          AP3_GROUP(2, vfa, vfa, p1, 0, p0, 8, true, true, ((SL) + 2) % 3); \
          AP3_GROUP(3, vfa, vfa, p1, 8, p1, 0, true, false, ((SL) + 2) % 3); \
          _Pragma("unroll") for (int e = 0; e < 8; ++e) rs += p1[8 + e]; \
          _Pragma("unroll") for (int e = 0; e < 4; ++e) pwv[3][e] = cvtpk_(p1[8 + 2 * e], p1[8 + 2 * e + 1]); } \
        l_run += rs; \
        asm volatile("s_waitcnt vmcnt(3) lgkmcnt(0)\n\ts_barrier" ::: "memory"); \
    } while (0)
    if (wid >= 4) __builtin_amdgcn_s_setprio(1);
    int t3 = t0;
    if constexpr (SREF && pv == 0) {
        AP3_STEP(t3, 0); AP3_STEP(t3 + 1, 1); AP3_STEP(t3 + 2, 2); t3 += 3;
        const int tfe = (q0 >> 6) - 3;
        for (; t3 + 2 <= tfe; t3 += 3) { AP3_FSTEP(t3, 0); AP3_FSTEP(t3 + 1, 1); AP3_FSTEP(t3 + 2, 2); }
    }
    for (; t3 <= NT; t3 += 3) { AP3_STEP(t3, 0); AP3_STEP(t3 + 1, 1); AP3_STEP(t3 + 2, 2); }
    if (wid >= 4) __builtin_amdgcn_s_setprio(0);
    asm volatile("s_waitcnt lgkmcnt(0)\n\ts_barrier" ::: "memory");
    l_run += __shfl_xor(l_run, 32);
    if (hi == 0) wsf[r32] = 1.0f / l_run;
    asm volatile("s_waitcnt lgkmcnt(0)" ::: "memory");
#pragma unroll
    for (int g4 = 0; g4 < 4; ++g4) { const f32x4 a4 = *(const LAS f32x4*)(wsf + 8 * g4 + 4 * hi);
#pragma unroll
        for (int d = 0; d < NDB; ++d)
#pragma unroll
            for (int e = 0; e < 4; ++e) o[d][4 * g4 + e] *= a4[e]; }
#undef AP_ISSUE_K
#undef AP_ISSUE_V
#undef AP_BATCH
#undef AP3_VFL
#undef AP3_VFL1
#undef AP3_FRAG
#undef AP3_GAP
#undef AP3_GROUP
#undef AP3_OCT
#undef AP3_STEP
#undef AP3_FSTEP
#undef AP3_QK
#undef AP3_QKF
#undef AP3_QKS
#undef AP3_KRD
#undef AP3_MM
#undef AP3_DECIDE
}

template <int NDB> __device__ __forceinline__ void store_o(const f32x16 (&o)[NDB], LAS unsigned char* stgb  , bf16_t* dst  , int ld, int lane) {
    const int r32 = lane & 31, hi = lane >> 5;
    constexpr int DVC = 32 * NDB;
    LAS bf16_t* stg = (LAS bf16_t*)stgb;
#pragma unroll
    for (int d = 0; d < NDB; ++d)
#pragma unroll
        for (int r = 0; r < 16; ++r) { const int row = (r & 3) + 8 * (r >> 2) + 4 * hi; stg[row * DVC + 32 * d + r32] = (bf16_t)f2bf(o[d][r]); }
    asm volatile("s_waitcnt lgkmcnt(0)" ::: "memory");
    constexpr int CPR = DVC / 8;
#pragma unroll
    for (int i = 0; i < (32 * CPR) / 64; ++i) { const int c = i * 64 + lane, row = c / CPR, ch = c % CPR;
        const u32x4 v = *(const LAS u32x4*)(stg + row * DVC + ch * 8); *(u32x4*)(dst + (size_t)row * ld + ch * 8) = v; }
    asm volatile("s_waitcnt lgkmcnt(0)" ::: "memory");
}

__device__ __forceinline__ float lambda_full(Frame& F) {
    float a = 0.f, b = 0.f;
    for (int i = 0; i < 64; ++i) { a += F.in[I_LQ1][i] * F.in[I_LK1][i]; b += F.in[I_LQ2][i] * F.in[I_LK2][i]; }
    return __expf(a) - __expf(b) + 0.2f;
}

template <int pv = 0> __device__ __forceinline__ void attn_prompt_fox(Frame& F, int h, int qb) {
    const bf16_t* Q = (const bf16_t*)(F.ws + WS_QB) + h * 64; const bf16_t* K = (const bf16_t*)(F.ws + WS_KB) + h * 64; const bf16_t* V = (const bf16_t*)(F.ws + WS_VB) + h * 64;
    f32x16 o[2];
    const float* Fh = (const float*)(F.ws + WS_FP) + (size_t)h * SEQ;
    int t0 = 0; bool fast;
    { const unsigned* nw = (const unsigned*)(F.ws + WS_CTL) + 256;
      const float qn2 = __uint_as_float(nw[h * 2]) + __uint_as_float(nw[h * 2 + 1]), kn2 = __uint_as_float(nw[16 + h * 2]) + __uint_as_float(nw[16 + h * 2 + 1]);
      const float B = sqrtf(qn2 * kn2) * 1.02f + 0.5f;
      const float thresh = -48.0f - 2.0f * B;
      fast = __builtin_amdgcn_readfirstlane(B <= 60.0f ? 1 : 0) != 0;
      volatile LAS int* cnt = (volatile LAS int*)(F.lds + AT_MISC + 32);
      __syncthreads();
      if (F.tid < 256) { const int t = F.tid; const bool sk = t < 4 * qb && (Fh[qb * 256] - Fh[64 * t + 63]) <= thresh;
          const int c = __popcll(__ballot(sk)); if (F.lane == 0) cnt[F.wave] = c; }
      __syncthreads();
      t0 = cnt[0] + cnt[1] + cnt[2] + cnt[3]; t0 -= t0 % 3; }
    if (fast) attn_pass3<0, 64, pv, true>(F, Q, K, V, qb * 256, 4 * qb + 4, Fh, 0, o, t0); else attn_pass3<0, 64, pv, false>(F, Q, K, V, qb * 256, 4 * qb + 4, Fh, 0, o, t0);
    if (pv != 0 && o[0][0] != 1234.5678f) { __syncthreads(); return; }
    bf16_t* AB = (bf16_t*)(F.ws + WS_AB);
    store_o<2>(o, F.lds + F.wave * 8192, AB + (size_t)(qb * 256 + F.wave * 32) * DM + 512 + h * 64, DM, F.lane);
    __syncthreads();
}
template <int pv = 0> __device__ __forceinline__ void attn_prompt_diff_half(Frame& F, int h, int half, int qb) {
    const bf16_t* Q = (const bf16_t*)(F.ws + WS_QA) + h * 128 + 64 * half; const bf16_t* K = (const bf16_t*)(F.ws + WS_KA) + h * 128 + 64 * half; const bf16_t* V = (const bf16_t*)(F.ws + WS_VA) + h * 128;
    f32x16 o[4];
    bool fast;
    { const unsigned* nw = (const unsigned*)(F.ws + WS_CTL) + 288; const int hh = h * 2 + half;
      const float qn2 = __uint_as_float(nw[hh * 2]) + __uint_as_float(nw[hh * 2 + 1]), kn2 = __uint_as_float(nw[16 + hh * 2]) + __uint_as_float(nw[16 + hh * 2 + 1]);
      float bm = 0.f; for (int b = 0; b < 32; ++b) bm = fmaxf(bm, fabsf(F.in[I_RELB][b * 4 + h] - F.in[I_RELB][15 * 4 + h]));
      const float B = sqrtf(qn2 * kn2) * 1.02f + 0.5f + bm * LOG2E;
      fast = __builtin_amdgcn_readfirstlane(B <= 60.0f ? 1 : 0) != 0; }
    if (fast) attn_pass3<1, 128, pv, true>(F, Q, K, V, qb * 256, 4 * qb + 4, nullptr, h, o); else attn_pass3<1, 128, pv, false>(F, Q, K, V, qb * 256, 4 * qb + 4, nullptr, h, o);
    if (pv != 0 && o[0][0] != 1234.5678f) { __syncthreads(); return; }
    bf16_t* OD = (bf16_t*)(F.ws + (half ? WS_OD2 : WS_OD1));
    store_o<4>(o, F.lds + F.wave * 8192, OD + (size_t)(qb * 256 + F.wave * 32) * 512 + h * 128, 512, F.lane);
    __syncthreads();
}
constexpr int PF_STR = 66, PD_STR = 130;
__device__ __forceinline__ void p_combine(Frame& F) {
    const float lam = lambda_full(F);
    const bf16_t* O1 = (const bf16_t*)(F.ws + WS_OD1); const bf16_t* O2 = (const bf16_t*)(F.ws + WS_OD2); bf16_t* AB = (bf16_t*)(F.ws + WS_AB);
    const int gw = F.bid * 8 + F.wave, NGW = F.G * 8;
    const int c0 = 8 * F.lane;
    float sg[8];
#pragma unroll
    for (int i = 0; i < 8; ++i) sg[i] = F.in[I_SUBG][(c0 & 127) + i] * 0.8f;
    for (int m0 = gw; m0 < SEQ; m0 += 4 * NGW) {
        u32x4 a[4], b[4];
#pragma unroll
        for (int r = 0; r < 4; ++r) { const int m = m0 + r * NGW; if (m < SEQ) { a[r] = *(const u32x4*)(O1 + (size_t)m * 512 + c0); b[r] = *(const u32x4*)(O2 + (size_t)m * 512 + c0); } else { a[r] = (u32x4){0u, 0u, 0u, 0u}; b[r] = a[r]; } }
#pragma unroll
        for (int r = 0; r < 4; ++r) { const int m = m0 + r * NGW;
            float v[8];
            v[0] = bflo(a[r].x) - lam * bflo(b[r].x); v[1] = bfhi(a[r].x) - lam * bfhi(b[r].x); v[2] = bflo(a[r].y) - lam * bflo(b[r].y); v[3] = bfhi(a[r].y) - lam * bfhi(b[r].y);
            v[4] = bflo(a[r].z) - lam * bflo(b[r].z); v[5] = bfhi(a[r].z) - lam * bfhi(b[r].z); v[6] = bflo(a[r].w) - lam * bflo(b[r].w); v[7] = bfhi(a[r].w) - lam * bfhi(b[r].w);
            float ss = 0.f;
#pragma unroll
            for (int i = 0; i < 8; ++i) ss += v[i] * v[i];
#pragma unroll
            for (int ofs = 1; ofs < 16; ofs <<= 1) ss += __shfl_xor(ss, ofs);
            const float rn = 1.0f / sqrtf(ss * (1.0f / 128.0f) + LN_EPS);
            u32x4 w; w.x = pk2(v[0] * rn * sg[0], v[1] * rn * sg[1]); w.y = pk2(v[2] * rn * sg[2], v[3] * rn * sg[3]); w.z = pk2(v[4] * rn * sg[4], v[5] * rn * sg[5]); w.w = pk2(v[6] * rn * sg[6], v[7] * rn * sg[7]);
            if (m < SEQ) *(u32x4*)(AB + (size_t)m * DM + c0) = w; }
    }
    for (int it = F.bid; it < NSMP; it += F.G) {
        const int b = it >> 4, q = it & 15; const size_t row = (size_t)SEQ + it;
        if (F.wave == 0) {
            const int h = F.lane >> 3, cc = (F.lane & 7) * 8; const float* P = (const float*)(F.ws + WS_PF);
            float M = -1e30f;
#pragma unroll
            for (int s = 0; s < 8; ++s) M = fmaxf(M, P[((size_t)((b * 8 + s) * 8 + h) * 16 + q) * PF_STR + 64]);
            float acc[8], L = 0.f;
#pragma unroll
            for (int i = 0; i < 8; ++i) acc[i] = 0.f;
#pragma unroll
            for (int s = 0; s < 8; ++s) { const float* pr = P + ((size_t)((b * 8 + s) * 8 + h) * 16 + q) * PF_STR; const float wgt = __builtin_amdgcn_exp2f(pr[64] - M); L += wgt * pr[65];
#pragma unroll
                for (int i = 0; i < 8; ++i) acc[i] += wgt * pr[cc + i]; }
            const float inv = 1.0f / L;
            u32x4 w; w.x = pk2(acc[0] * inv, acc[1] * inv); w.y = pk2(acc[2] * inv, acc[3] * inv); w.z = pk2(acc[4] * inv, acc[5] * inv); w.w = pk2(acc[6] * inv, acc[7] * inv);
            *(u32x4*)(AB + row * DM + 512 + c0) = w; }
        if (F.wave == 1) {
            const int h = F.lane >> 4, cc = (F.lane & 15) * 8; const float* P = (const float*)(F.ws + WS_PD);
            float v[8];
#pragma unroll
            for (int i = 0; i < 8; ++i) v[i] = 0.f;
#pragma unroll
            for (int half = 0; half < 2; ++half) {
                float M = -1e30f;
#pragma unroll
                for (int s = 0; s < 8; ++s) M = fmaxf(M, P[((size_t)((b * 8 + s) * 8 + 2 * h + half) * 16 + q) * PD_STR + 128]);
                float acc[8], L = 0.f;
#pragma unroll
                for (int i = 0; i < 8; ++i) acc[i] = 0.f;
#pragma unroll
                for (int s = 0; s < 8; ++s) { const float* pr = P + ((size_t)((b * 8 + s) * 8 + 2 * h + half) * 16 + q) * PD_STR; const float wgt = __builtin_amdgcn_exp2f(pr[128] - M); L += wgt * pr[129];
#pragma unroll
                    for (int i = 0; i < 8; ++i) acc[i] += wgt * pr[cc + i]; }
                const float sc = (half ? -lam : 1.0f) / L;
#pragma unroll
                for (int i = 0; i < 8; ++i) v[i] += acc[i] * sc; }
            float ss = 0.f;
#pragma unroll
            for (int i = 0; i < 8; ++i) ss += v[i] * v[i];
#pragma unroll
            for (int ofs = 1; ofs < 16; ofs <<= 1) ss += __shfl_xor(ss, ofs);
            const float rn = 1.0f / sqrtf(ss * (1.0f / 128.0f) + LN_EPS);
            u32x4 w; w.x = pk2(v[0] * rn * sg[0], v[1] * rn * sg[1]); w.y = pk2(v[2] * rn * sg[2], v[3] * rn * sg[3]); w.z = pk2(v[4] * rn * sg[4], v[5] * rn * sg[5]); w.w = pk2(v[6] * rn * sg[6], v[7] * rn * sg[7]);
            *(u32x4*)(AB + row * DM + c0) = w; }
    }
}

constexpr int SM_K = 0, SM_V = 32768, SM_F = 81920, SM_WS = 83968;
template <int KIND  > __device__ __forceinline__ void sample_unit(Frame& F, int b, int s) {
    constexpr int DV = KIND == 0 ? 64 : 128, NDB = DV / 32, VSTR = KIND == 0 ? 192 : 320, VSUB = 16 * VSTR;
    const int lane = lane_id_opaque(), r32 = lane & 31, hi = lane >> 5, w = F.wave, tid = w * 64 + lane;
    const LAS char* lds = (const LAS char*)F.lds;
    LAS float* wsf = (LAS float*)(F.lds + SM_WS) + w * 64;
    const int hb = KIND == 0 ? w : (w >> 1);
    const LAS float* tab = (const LAS float*)(F.lds + AT_TAB) + hb * 192;
    const int q = r32 & 15, qpos = PAST + q;
    const size_t qrow = (size_t)SEQ + b * DEC_T + q;
    const bf16_t* Qp = (const bf16_t*)(F.ws + (KIND == 0 ? WS_QB : WS_QA)) + qrow * 512 + w * 64;
    bf16x8 qr[4];
#pragma unroll
    for (int d0 = 0; d0 < 4; ++d0) qr[d0] = *(const bf16x8*)(Qp + d0 * 16 + hi * 8);
    const float* Fs = (const float*)(F.ws + WS_FS) + (size_t)(b * 8 + w) * SKV;
    const float fq = KIND == 0 ? Fs[qpos] : 0.f;
    const float* Kc = F.in[KIND == 0 ? I_CFK : I_CDK] + (size_t)b * PAST * 512; const float* Vc = F.in[KIND == 0 ? I_CFV : I_CDV] + (size_t)b * PAST * 512;
    const float* Kn = F.out + (KIND == 0 ? O_FKS : O_DKS) + (size_t)b * DEC_T * 512; const float* Vn = F.out + (KIND == 0 ? O_FVS : O_DVS) + (size_t)b * DEC_T * 512;
    const int kr = tid >> 5, c16 = (tid & 31) * 16;
    const int ksub = c16 >> 6, kch = (c16 >> 3) & 7;
    const int kdst = SM_K + ksub * 4096 + kr * 128;
    const int vdst = KIND == 0 ? SM_V + ksub * VSUB + kr * VSTR + kch * 16 : SM_V + (c16 >> 7) * VSUB + kr * VSTR + ((c16 >> 3) & 15) * 16;
    f32x16 o[NDB];
#pragma unroll
    for (int d = 0; d < NDB; ++d) o[d] = f32x16{};
    float m_run = -1e30f, l_run = 0.f;
    f32x4 gkA[4], gvA[4], gkB[4], gvB[4]; float gfA = 0.f, gfB = 0.f;
    const int nt = s == 0 ? 17 : 16;
    auto gload = [&](f32x4 (&gk)[4], f32x4 (&gv)[4], float& gf, int t) {
        const float* ks; const float* vs;
        if (t < 128) { ks = Kc + (size_t)(16 * t + kr) * 512 + c16; vs = Vc + (size_t)(16 * t + kr) * 512 + c16; }
        else { ks = Kn + (size_t)kr * 512 + c16; vs = Vn + (size_t)kr * 512 + c16; }
#pragma unroll
        for (int j = 0; j < 4; ++j) { gk[j] = *(const f32x4*)(ks + 4 * j); gv[j] = *(const f32x4*)(vs + 4 * j); }
        if (KIND == 0 && tid < 128) gf = ((const float*)(F.ws + WS_FS))[(size_t)(b * 8 + (tid >> 4)) * SKV + 16 * t + (tid & 15)];
    };
    auto lwrite = [&](const f32x4 (&gk)[4], const f32x4 (&gv)[4], float gf) {
#pragma unroll
        for (int j = 0; j < 2; ++j) { u32x4 wk, wv;
            wk.x = pk2(gk[2 * j][0], gk[2 * j][1]); wk.y = pk2(gk[2 * j][2], gk[2 * j][3]); wk.z = pk2(gk[2 * j + 1][0], gk[2 * j + 1][1]); wk.w = pk2(gk[2 * j + 1][2], gk[2 * j + 1][3]);
            wv.x = pk2(gv[2 * j][0], gv[2 * j][1]); wv.y = pk2(gv[2 * j][2], gv[2 * j][3]); wv.z = pk2(gv[2 * j + 1][0], gv[2 * j + 1][1]); wv.w = pk2(gv[2 * j + 1][2], gv[2 * j + 1][3]);
            *(LAS u32x4*)(F.lds + kdst + (((kch + j) ^ (kr & 7)) << 4)) = wk;
            *(LAS u32x4*)(F.lds + vdst + j * 16) = wv; }
        if (KIND == 0 && tid < 128) ((LAS float*)(F.lds + SM_F))[tid] = gf;
    };
    gload(gkA, gvA, gfA, s); gload(gkB, gvB, gfB, s + 8);
    __syncthreads();
    { const int sub = tid >> 6, rr = 16 + ((tid >> 2) & 15), cq = (tid & 3) * 32;
      *(LAS u32x4*)(F.lds + SM_K + sub * 4096 + rr * 128 + cq) = (u32x4){0u, 0u, 0u, 0u}; *(LAS u32x4*)(F.lds + SM_K + sub * 4096 + rr * 128 + cq + 16) = (u32x4){0u, 0u, 0u, 0u}; }
    const int vb = SM_V + (KIND == 0 ? w : (w >> 1)) * VSUB + (4 * hi + ((lane & 15) >> 2)) * VSTR + (((lane >> 4) & 1) * 16 + (lane & 3) * 4) * 2;
    auto compute = [&](int t) {
        f32x16 p0 = f32x16{};
#pragma unroll
        for (int d0 = 0; d0 < 4; ++d0) { const bf16x8 kf = *(const LAS bf16x8*)(lds + SM_K + w * 4096 + r32 * 128 + (((2 * d0 + hi) ^ (r32 & 7)) << 4));
            p0 = __builtin_amdgcn_mfma_f32_32x32x16_bf16(kf, qr[d0], p0, 0, 0, 0); }
        const int kv0 = 16 * t + 4 * hi;
        float x[8];
        if (KIND == 0) {
#pragma unroll
            for (int g4 = 0; g4 < 2; ++g4) { const f32x4 fa = *(const LAS f32x4*)(lds + SM_F + (w * 16 + 4 * hi + 8 * g4) * 4);
#pragma unroll
                for (int e = 0; e < 4; ++e) x[4 * g4 + e] = p0[4 * g4 + e] + (fq - fa[e]); }
            if (t == 128) {
#pragma unroll
                for (int r = 0; r < 8; ++r) { const int kv = kv0 + (r & 3) + 8 * (r >> 2); if (kv > qpos) x[r] = -1e30f; } }
        } else {
            if (t < 120) {
#pragma unroll
                for (int r = 0; r < 8; ++r) x[r] = p0[r];
            } else {
#pragma unroll
                for (int r = 0; r < 8; ++r) { const int kv = kv0 + (r & 3) + 8 * (r >> 2); int i0 = kv - qpos + 128; i0 = i0 < 0 ? 0 : i0; x[r] = p0[r] + tab[i0]; } }
        }
        float rm = x[0];
#pragma unroll
        for (int r = 1; r < 8; ++r) rm = fmaxf(rm, x[r]);
        rm = fmaxf(rm, __shfl_xor(rm, 32));
        const float m_new = fmaxf(m_run, rm);
        if (__any(m_new > m_run)) { const float al = __builtin_amdgcn_exp2f(m_run - m_new); l_run *= al; m_run = m_new;
            if (hi == 0) wsf[r32] = al;
            asm volatile("s_waitcnt lgkmcnt(0)" ::: "memory");
#pragma unroll
            for (int g4 = 0; g4 < 2; ++g4) { const f32x4 a4 = *(const LAS f32x4*)(wsf + 8 * g4 + 4 * hi);
#pragma unroll
                for (int d = 0; d < NDB; ++d)
#pragma unroll
                    for (int e = 0; e < 4; ++e) o[d][4 * g4 + e] *= a4[e]; } }
        float rs = 0.f;
#pragma unroll
        for (int r = 0; r < 8; ++r) { x[r] = __builtin_amdgcn_exp2f(x[r] - m_run); rs += x[r]; }
        l_run += rs;
        u32x4 w0; w0.x = pg8::cvt_pk_bf16(x[0], x[1]); w0.y = pg8::cvt_pk_bf16(x[2], x[3]); w0.z = pg8::cvt_pk_bf16(x[4], x[5]); w0.w = pg8::cvt_pk_bf16(x[6], x[7]);
        const bf16x8 pa = __builtin_bit_cast(bf16x8, w0);
#pragma unroll
        for (int d = 0; d < NDB; ++d) { const LAS char* vp = lds + vb + d * 64;
            const s16x4 lo = vtr(vp), hi4 = vtr(vp + 8 * VSTR);
            const bf16x8 vf = (bf16x8){lo[0], lo[1], lo[2], lo[3], hi4[0], hi4[1], hi4[2], hi4[3]};
            o[d] = __builtin_amdgcn_mfma_f32_32x32x16_bf16(pa, vf, o[d], 0, 0, 0); }
    };
    for (int i = 0; i < nt; i += 2) {
        const int t = s + 8 * i;
        lwrite(gkA, gvA, gfA); __syncthreads();
        if (i + 2 < nt) gload(gkA, gvA, gfA, t + 16);
        compute(t);
        __syncthreads();
        if (i + 1 >= nt) break;
        lwrite(gkB, gvB, gfB); __syncthreads();
        if (i + 3 < nt) gload(gkB, gvB, gfB, t + 24);
        compute(t + 8);
        __syncthreads();
    }
    l_run += __shfl_xor(l_run, 32);
    float* P = (float*)(F.ws + (KIND == 0 ? WS_PF : WS_PD)) + ((size_t)((b * 8 + s) * 8 + w) * 16) * (DV + 2);
    { float* P0 = P + (size_t)(4 * hi) * (DV + 2) + r32; float* P1 = P0 + 8 * (DV + 2);
#pragma unroll
      for (int d = 0; d < NDB; ++d)
#pragma unroll
          for (int r = 0; r < 4; ++r) { P0[r * (DV + 2) + 32 * d] = o[d][r]; P1[r * (DV + 2) + 32 * d] = o[d][4 + r]; } }
    if (lane < 16) { P[(size_t)lane * (DV + 2) + DV] = m_run; P[(size_t)lane * (DV + 2) + DV + 1] = l_run; }
}

template <int pv = 0> __device__ __forceinline__ void p3_attention(Frame& F, int mask) {
    LAS float* tab = (LAS float*)(F.lds + AT_TAB);
    for (int i = F.tid; i < 4 * 192; i += 512) { const int h = i / 192, rel = (i % 192) - 128; tab[i] = (F.in[I_RELB][t5_bucket(rel) * 4 + h] - F.in[I_RELB][15 * 4 + h]) * LOG2E; }
    const float lam = lambda_full(F);
    __syncthreads();
    const int x = F.bid & 7, p = (F.bid >> 3) & 31;
    const int spos = F.G == 256 ? (x + p) % 5 : 4;
    for (int j = 0; j < 5; ++j) {
        F.lane = lane_id_opaque(); F.tid = F.wave * 64 + F.lane;
        if (j == spos) {
            if (mask & 4) {
                for (int u = F.bid; u < 256; u += F.G) {
                    F.lane = lane_id_opaque(); F.tid = F.wave * 64 + F.lane;
                    if ((u >> 3) & 1) sample_unit<1>(F, u >> 4, u & 7); else sample_unit<0>(F, u >> 4, u & 7);
                }
            }
        } else if (F.bid < 256) {
            const int i = j - (j > spos ? 1 : 0);
            const int qb = (i & 1) ? p : 63 - p;
            if (i < 2) { if (mask & 1) attn_prompt_diff_half<pv>(F, x >> 1, x & 1, qb); }
            else { if (mask & 2) attn_prompt_fox<pv>(F, x, qb); }
        }
    }
}

__device__ __forceinline__ void slab_publish(Frame& F, int word, int nun) {
    int n = 0; for (int L = F.bid; L < nun; L += F.G) ++n;
    asm volatile("s_waitcnt vmcnt(0)" ::: "memory");
    __syncthreads();
    if (F.tid == 0 && n > 0) { __builtin_amdgcn_fence(__ATOMIC_RELEASE, "agent"); asm volatile("s_waitcnt vmcnt(0)" ::: "memory");
        __hip_atomic_fetch_add((unsigned*)(F.ws + WS_CTL) + word, (unsigned)n, __ATOMIC_RELAXED, __HIP_MEMORY_SCOPE_AGENT); }
}
__device__ __forceinline__ void slab_wait(Frame& F, int word, int nun) {
    if (F.tid == 0) { unsigned* w = (unsigned*)(F.ws + WS_CTL) + word; unsigned sp = 0;
        while (__hip_atomic_load(w, __ATOMIC_RELAXED, __HIP_MEMORY_SCOPE_AGENT) < (unsigned)nun && ++sp < (1u << 22)) __builtin_amdgcn_s_sleep(2);
        __builtin_amdgcn_fence(__ATOMIC_ACQUIRE, "agent"); asm volatile("s_waitcnt vmcnt(0)" ::: "memory"); }
    __syncthreads();
}

#define XB_TMO      128
#define XB_XCNT(j)  (256  + 64 * (j))
#define XB_XSUB(j)  (1280 + 64 * (j))
#define XB_XGEN(j)  (2304 + 64 * (j))
#define XB_TOP      3328
#define XB_TOPGEN   3392
#define XCD_BAR_WORDS 3456
#define XB_SPIN_CAP (1u << 20)
__device__ __forceinline__ unsigned xb_ld(unsigned* p)              { return __hip_atomic_load(p, __ATOMIC_RELAXED, __HIP_MEMORY_SCOPE_AGENT); }
__device__ __forceinline__ unsigned xb_add(unsigned* p, unsigned v) { return __hip_atomic_fetch_add(p, v, __ATOMIC_RELAXED, __HIP_MEMORY_SCOPE_AGENT); }
__device__ __forceinline__ unsigned xb_xcc_id() { return (unsigned)__builtin_amdgcn_s_getreg((3 << 11) | 20) & 0xFu; }
#define XB_SPIN(cond, bar) do { unsigned _sp = 0; while (cond) { __builtin_amdgcn_s_sleep(1); \
    if ((++_sp & 255u) == 0u) { if (xb_ld(&(bar)[XB_TMO])) break; if (_sp > XB_SPIN_CAP) { atomicAdd(&(bar)[XB_TMO], 1u); break; } } } } while (0)
struct XcdBarrier { unsigned* bar; unsigned x; volatile LAS unsigned* st; };
__device__ __forceinline__ XcdBarrier xcd_barrier_post(unsigned* bar, volatile LAS unsigned* st) {
    XcdBarrier b; b.bar = bar; b.x = xb_xcc_id(); b.st = st;
    if (threadIdx.x == 0) (void)xb_add(&bar[XB_XCNT(b.x)], 1u);
    return b;
}
__device__ __forceinline__ void xcd_barrier_complete(unsigned* bar, unsigned x, unsigned& nloc, unsigned& nx) {
    const unsigned G = gridDim.x * gridDim.y * gridDim.z;
    unsigned sum, cnt, mine, sp = 0u;
    for (;;) {
        sum = 0u; cnt = 0u; mine = 0u;
#pragma unroll
        for (unsigned j = 0; j < 16; ++j) { const unsigned c = xb_ld(&bar[XB_XCNT(j)]); sum += c; cnt += (c > 0u) ? 1u : 0u; mine = (j == x) ? c : mine; }
        if (sum == G) break;
        __builtin_amdgcn_s_sleep(1);
        if ((++sp & 255u) == 0u) { if (xb_ld(&bar[XB_TMO])) break; if (sp > XB_SPIN_CAP) { atomicAdd(&bar[XB_TMO], 1u); break; } }
    }
    nloc = mine > 0u ? mine : 1u; nx = cnt > 0u ? cnt : 1u;
}
__device__ __forceinline__ void xcd_barrier(const XcdBarrier& b) {
    asm volatile("s_waitcnt vmcnt(0)" ::: "memory");
    __syncthreads();
    if (threadIdx.x == 0) {
        unsigned* bar = b.bar;
        __builtin_amdgcn_s_waitcnt(0);
        unsigned nloc = b.st[0], nx = b.st[1];
        if (nloc == 0u) { xcd_barrier_complete(bar, b.x, nloc, nx); b.st[0] = nloc; b.st[1] = nx; }
        const unsigned old = xb_add(&bar[XB_XSUB(b.x)], 1u);
        const unsigned gen = old / nloc;
        if (old + 1u == (gen + 1u) * nloc) {
            __builtin_amdgcn_fence(__ATOMIC_RELEASE, "agent");
            asm volatile("s_waitcnt vmcnt(0)" ::: "memory");
            const unsigned og = xb_add(&bar[XB_TOP], 1u);
            const unsigned tg = og / nx;
            if (og + 1u == (tg + 1u) * nx) xb_add(&bar[XB_TOPGEN], 1u);
            else XB_SPIN(xb_ld(&bar[XB_TOPGEN]) == tg, bar);
            __builtin_amdgcn_fence(__ATOMIC_ACQUIRE, "agent");
            xb_add(&bar[XB_XGEN(b.x)], 1u);
            asm volatile("s_waitcnt vmcnt(0)" ::: "memory");
        } else {
            XB_SPIN(xb_ld(&bar[XB_XGEN(b.x)]) == gen, bar);
            __builtin_amdgcn_fence(__ATOMIC_ACQUIRE, "agent");
            asm volatile("s_waitcnt vmcnt(0)" ::: "memory");
        }
    }
    __syncthreads();
}

__global__ void __launch_bounds__(512, 2) mega_fwd(Args args) {
    extern __shared__ __attribute__((aligned(16))) unsigned char lds_raw[];
    Frame F;
    F.lds = (LAS unsigned char*)lds_raw; F.ldsg = lds_raw;
    F.tid = threadIdx.x; F.lane = F.tid & 63; F.wave = __builtin_amdgcn_readfirstlane(F.tid >> 6);
    F.G = gridDim.x; F.bid = blockIdx.x;
    F.in = args.in; F.out = args.out; F.ws = args.ws;
    const int lo = args.ph_lo, hi = args.ph_hi;
    cg::grid_group grid = cg::this_grid();
    const bool fused = (hi - lo) > 1;
    volatile LAS unsigned* bst = (volatile LAS unsigned*)(F.lds + AT_MISC + 16);
    if (F.tid == 0) { bst[0] = 0u; bst[1] = 0u; }
    __syncthreads();
    XcdBarrier xbar; xbar.bar = (unsigned*)(F.ws + WS_CTL) + 1024; xbar.x = 0; xbar.st = bst;
    if (fused) xbar = xcd_barrier_post((unsigned*)(F.ws + WS_CTL) + 1024, bst);
#define IN(k) (lo <= (k) && (k) < hi)
#define PB() do { F.lane = lane_id_opaque(); F.tid = F.wave * 64 + F.lane; } while (0)
#define SEAM(k) do { if (IN(k) && IN((k) + 1)) { xcd_barrier(xbar); } } while (0)
    const float* mod = (const float*)(F.ws + WS_MOD);
    if (IN(0)) { PB(); p0_prologue(F); }
    if (IN(0) && IN(1)) __syncthreads(); else SEAM(0);
    if (IN(1)) { PB(); p1_rows(F, IN(0)); } SEAM(1);
    if (IN(2)) { PB();
        p2_cumsum(F);
        __syncthreads();
        pg8::Gemm g{(const bf16_t*)(F.ws + WS_XN), (const bf16_t*)(F.ws + WS_WIN), 1024, 1024, 1024, 1 << 30, 0, 0};
        pg8::StaticOrder S; S.init(MT / 256, NZ / 256, F.G, F.bid, 0);
        EpiZ E{F.out, F.ws};
        pg8::gemm_phase<EpiZ, pg8::StaticOrder>(F.lds, g, S, E, F.wave);
#if PROBE_DUP == 2
        pg8::gemm_phase<EpiZ, pg8::StaticOrder>(F.lds, g, S, E, F.wave);
#endif
        { const int nun = (MT / 256) * (NZ / 256), nlong = nun - (nun / F.G) * F.G;
          if (nlong > 0 && nlong < F.G) { if (F.bid >= nlong) { PB(); weight_copies(F, F.bid - nlong, F.G - nlong, WC_IN, WC_ALL); } }
          else { PB(); weight_copies(F, F.bid, F.G, WC_IN, WC_ALL); } }
    } SEAM(2);
    if (IN(3)) { PB(); p3_attention(F, 7);
#if PROBE_DUP == 3
        p3_attention<PROBE_PV>(F, PROBE_MASK);
#endif
    } SEAM(3);
    if (IN(10)) { PB(); p_combine(F);
#if PROBE_DUP == 10
        p_combine(F);
#endif
    } if (IN(10) && IN(4)) xcd_barrier(xbar);
    if (IN(4)) { PB();
        pg8::Gemm g{(const bf16_t*)(F.ws + WS_AB), (const bf16_t*)(F.ws + WS_WAB), 1024, 512, 512, 4, 512, 0};
        pg8::StaticOrder S; S.init(MT / 256, 8, F.G, F.bid, 0);
        EpiGate E{(bf16_t*)(F.ws + WS_G), (bf16_t*)(F.ws + WS_G)};
#if PROBE_DUP == 4
        { EpiGate E2{(bf16_t*)(F.ws + WS_G), (bf16_t*)(F.ws + WS_QA)}; pg8::gemm_phase<EpiGate, pg8::StaticOrder>(F.lds, g, S, E2, F.wave); }
#endif
        pg8::gemm_phase<EpiGate, pg8::StaticOrder>(F.lds, g, S, E, F.wave);
    } SEAM(4);
    if (IN(5)) { PB();
        { pg8::Gemm g2{(const bf16_t*)(F.ws + WS_G), (const bf16_t*)(F.ws + WS_WO2), 2048, 2048, 256, 1 << 30, 0, 256};
          pg8::SplitOrder S2; S2.init(4, 8, F.G, F.bid, SEQ / 256); EpiSlab E2{(float*)(F.ws + WS_SLAB)};
          pg8::gemm_phase<EpiSlab, pg8::SplitOrder>(F.lds, g2, S2, E2, F.wave); slab_publish(F, 322, 32); }
        pg8::Gemm g{(const bf16_t*)(F.ws + WS_G), (const bf16_t*)(F.ws + WS_WO2), 2048, 2048, 2048, 1 << 30, 0, 0};
        pg8::StaticOrder S; S.init(SEQ / 256, 4, F.G, F.bid, 0);
        EpiResLn<false> E{(const void*)F.in[I_XP], mod + 2048, F.in[I_LN1G], F.in[I_LN1B], mod, (bf16_t*)(F.ws + WS_X1B), (bf16_t*)(F.ws + WS_XN), nullptr,
                          PanelStats{(unsigned*)(F.ws + WS_XB1), (unsigned*)(F.ws + WS_CTL) + CTL_LN1, LN_EPS}, F.lds};
        pg8::gemm_phase<EpiResLn<false>, pg8::StaticOrder>(F.lds, g, S, E, F.wave);
        PB(); slab_wait(F, 322, 32); ln_rows<false>(F, F.in[I_LN1G], F.in[I_LN1B], 8, 2048);
    } if (IN(5) && IN(7)) xcd_barrier(xbar);

    if (IN(7)) { PB();
        pg8::Gemm g{(const bf16_t*)(F.ws + WS_XN), (const bf16_t*)(F.ws + WS_WFI), 1024, 1024, 1024, 1 << 30, 0, 0};
        pg8::StaticOrder S; S.init(MT / 256, NFF2 / 256, F.G, F.bid, 0);
        EpiFfn E{(bf16_t*)(F.ws + WS_ACT)};
        pg8::gemm_phase<EpiFfn, pg8::StaticOrder>(F.lds, g, S, E, F.wave);
#if PROBE_DUP == 7
        pg8::gemm_phase<EpiFfn, pg8::StaticOrder>(F.lds, g, S, E, F.wave);
#endif
    } SEAM(7);
    if (IN(8)) { PB();
        { pg8::Gemm g2{(const bf16_t*)(F.ws + WS_ACT), (const bf16_t*)(F.ws + WS_WFO), DFF, DFF, 256, 1 << 30, 0, 256};
          pg8::SplitOrder S2; S2.init(4, 11, F.G, F.bid, SEQ / 256); EpiSlab E2{(float*)(F.ws + WS_SLAB)};
          pg8::gemm_phase<EpiSlab, pg8::SplitOrder>(F.lds, g2, S2, E2, F.wave); slab_publish(F, 323, 44); }
        pg8::Gemm g{(const bf16_t*)(F.ws + WS_ACT), (const bf16_t*)(F.ws + WS_WFO), DFF, DFF, DFF, 1 << 30, 0, 0};
        pg8::StaticOrder S; S.init(SEQ / 256, 4, F.G, F.bid, 0);
        EpiResLn<true> E{(const void*)(F.ws + WS_X1B), mod + 5120, F.in[I_LN2G], F.in[I_LN2B], mod, nullptr, nullptr, F.out,
                         PanelStats{(unsigned*)(F.ws + WS_XB2), (unsigned*)(F.ws + WS_CTL) + CTL_LN2, LN_EPS}, F.lds};
        pg8::gemm_phase<EpiResLn<true>, pg8::StaticOrder>(F.lds, g, S, E, F.wave);
        PB(); slab_wait(F, 323, 44); ln_rows<true>(F, F.in[I_LN2G], F.in[I_LN2B], 11, 5120);
    }
#undef IN
#undef SEAM
}

extern "C" void kernel_launch(void* const* d_in, const int* in_sizes, int n_in, void* d_out, int out_size, void* d_ws, size_t ws_size, hipStream_t stream) {
    static int grid = 0;
    if (grid == 0) {
        if (n_in != 28 || (size_t)out_size != O_END || ws_size < WS_END) { fprintf(stderr, "kernel_launch: unexpected shapes (n_in %d out %d ws %zu)\n", n_in, out_size, ws_size); grid = -1; return; }
        int dev = 0, cus = 0, per_cu = 0;
        hipGetDevice(&dev); hipDeviceGetAttribute(&cus, hipDeviceAttributeMultiprocessorCount, dev);
        hipFuncSetAttribute((const void*)mega_fwd, hipFuncAttributeMaxDynamicSharedMemorySize, LDS_BYTES);
        hipOccupancyMaxActiveBlocksPerMultiprocessor(&per_cu, (const void*)mega_fwd, 512, LDS_BYTES);
        if (per_cu < 1) { fprintf(stderr, "kernel_launch: occupancy query says %d blocks per CU\n", per_cu); per_cu = 1; }
        (void)hipGetLastError();
        grid = cus;
    }
    if (grid < 0) return;
    hipMemsetAsync((char*)d_ws + WS_CTL, 0, CTL_BYTES, stream);
    Args a{};
    for (int i = 0; i < 28; ++i) a.in[i] = (const float*)d_in[i];
    a.out = (float*)d_out; a.ws = (unsigned char*)d_ws;
#if MK_N_LAUNCHES == 1
    a.ph_lo = 0; a.ph_hi = NPH;
    void* kargs[] = {&a};
    hipError_t e = hipLaunchCooperativeKernel((const void*)mega_fwd, dim3(grid), dim3(512), kargs, LDS_BYTES, stream);
    if (e != hipSuccess) fprintf(stderr, "cooperative launch failed: %s\n", hipGetErrorString(e));
#else
    { const int seq[NPH] = {0, 1, 2, 3, 10, 4, 5, 6, 7, 8, 9}; for (int i = 0; i < NPH; ++i) { a.ph_lo = seq[i]; a.ph_hi = seq[i] + 1; hipLaunchKernelGGL(mega_fwd, dim3(grid), dim3(512), LDS_BYTES, stream, a); } }
#endif
}
```

```cpp
#include <hip/hip_runtime.h>
#include <hip/hip_cooperative_groups.h>
#include <cstdint>
#include <cstdio>
namespace cg = cooperative_groups;

#ifndef PROBE_DUP
#define PROBE_DUP -1
#endif
#ifndef PROBE_PV
#define PROBE_PV 0
#endif
#ifndef PROBE_MASK
#define PROBE_MASK 7
#endif
#ifndef MK_N_LAUNCHES
#define MK_N_LAUNCHES 1
#endif

#define LAS __attribute__((address_space(3)))
typedef unsigned short bf16_t;
typedef short bf16x8 __attribute__((ext_vector_type(8)));
typedef short s16x4 __attribute__((ext_vector_type(4)));
typedef float f32x4 __attribute__((ext_vector_type(4)));
typedef float f32x2 __attribute__((ext_vector_type(2)));
typedef float f32x16 __attribute__((ext_vector_type(16)));
typedef unsigned u32x4 __attribute__((ext_vector_type(4)));
typedef unsigned u32x2 __attribute__((ext_vector_type(2)));

constexpr int DM = 1024, SEQ = 16384, DEC_B = 16, DEC_T = 16, NSMP = DEC_B * DEC_T, MT = SEQ + NSMP, PAST = 2048, SKV = PAST + DEC_T;
constexpr int NZ = 5120, DFF = 2816, NFF2 = 2 * DFF, WIN_COLS = 5128;
constexpr float LOG2E = 1.4426950408889634f, C2 = 0.125f * LOG2E, ALPHA = 1.189207115002721f, LN_EPS = 1e-5f;
constexpr int NPH = 11;

constexpr size_t O_Y = 0, O_DKP = (size_t)MT * DM, O_DVP = O_DKP + (size_t)SEQ * 512, O_FKP = O_DVP + (size_t)SEQ * 512, O_FVP = O_FKP + (size_t)SEQ * 512,
                 O_FLP = O_FVP + (size_t)SEQ * 512, O_DKS = O_FLP + (size_t)SEQ * 8, O_DVS = O_DKS + (size_t)NSMP * 512, O_FKS = O_DVS + (size_t)NSMP * 512,
                 O_FVS = O_FKS + (size_t)NSMP * 512, O_FLS = O_FVS + (size_t)NSMP * 512, O_END = O_FLS + (size_t)NSMP * 8;

constexpr size_t MiB = 1u << 20;
constexpr size_t WS_CTL = 0, CTL_BYTES = 64 * 1024;
constexpr size_t WS_MOD = 1 * MiB;
constexpr size_t WS_FP = 2 * MiB;
constexpr size_t WS_FS = 3 * MiB;
constexpr size_t WS_WIN = 8 * MiB;
constexpr size_t WS_WAB = 18 * MiB;
constexpr size_t WS_WO2 = 20 * MiB;
constexpr size_t WS_WFI = 24 * MiB;
constexpr size_t WS_WFO = 35 * MiB;
constexpr size_t WS_XN = 48 * MiB;
constexpr size_t WS_QA = 84 * MiB, WS_KA = 101 * MiB, WS_VA = 118 * MiB, WS_QB = 135 * MiB, WS_KB = 152 * MiB, WS_VB = 169 * MiB;
constexpr size_t WS_ACT = 84 * MiB;
constexpr size_t WS_G = 188 * MiB;
constexpr size_t WS_AB = 254 * MiB;
constexpr size_t WS_OD1 = WS_XN, WS_OD2 = 288 * MiB;
constexpr size_t WS_PF = 304 * MiB, WS_PD = 309 * MiB;
constexpr size_t WS_TB = WS_AB;
constexpr size_t WS_X1B = WS_AB;
constexpr size_t WS_XB1 = 5 * MiB, WS_XB2 = 6 * MiB;
constexpr int CTL_LN1 = 8192, CTL_LN2 = 12288;
constexpr int LN_LDS = 135168;
constexpr size_t WS_SLAB = 288 * MiB;
constexpr size_t WS_END = 320 * MiB;

constexpr int LDS_BYTES = 147456;

struct Args { const float* in[28]; float* out; unsigned char* ws; int ph_lo, ph_hi; };

__device__ __forceinline__ int lane_id_opaque() { int l = (int)__builtin_amdgcn_mbcnt_hi(~0u, __builtin_amdgcn_mbcnt_lo(~0u, 0u)); asm volatile("" : "+v"(l)); return l; }
__device__ __forceinline__ unsigned f2bf(float f) { unsigned u = __builtin_bit_cast(unsigned, f); return (u + 0x7fffu + ((u >> 16) & 1u)) >> 16; }
__device__ __forceinline__ unsigned pk2(float lo, float hi) { return f2bf(lo) | (f2bf(hi) << 16); }
__device__ __forceinline__ float bf2f(unsigned short b) { return __builtin_bit_cast(float, (unsigned)b << 16); }
__device__ __forceinline__ float bflo(unsigned w) { return __builtin_bit_cast(float, w << 16); }
__device__ __forceinline__ float bfhi(unsigned w) { return __builtin_bit_cast(float, w & 0xffff0000u); }
__device__ __forceinline__ float wave_sum(float v) {
#pragma unroll
    for (int o = 1; o < 64; o <<= 1) v += __shfl_xor(v, o);
    return v;
}
__device__ __forceinline__ float sigmoidf_(float x) { return 1.0f / (1.0f + __expf(-x)); }
__device__ __forceinline__ float siluf_(float x) { return x / (1.0f + __expf(-x)); }

namespace pg8 {
constexpr int BM = 256, BK = 64, HALF = 128, HTB = HALF * BK * 2, STAGE_BYTES = 8 * HTB, NXCD = 8, WGM = 8;
__host__ __device__ __forceinline__ int lds_byte(int r, int c) { const int st = (r >> 4) * 2 + (c >> 5), rr = r & 15, cc = c & 31, ob = rr * 64 + cc * 2; return st * 1024 + (ob ^ (((ob >> 9) & 1) << 5)); }
__host__ __device__ __forceinline__ void stage_rc(int b, int& R, int& C) { const int st = b / 1024, sb = b % 1024, swz = sb ^ (((sb >> 9) & 1) << 5); R = (st >> 1) * 16 + swz / 64; C = (st & 1) * 32 + (swz % 64) / 2; }
__host__ __device__ __forceinline__ int perm32(int rho) { const int n = rho >> 4, i = rho & 15; return 8 * (i >> 2) + 4 * n + (i & 3); }

struct Unit { int pm, pn, ks; };
struct Gemm { const bf16_t* A; const bf16_t* Bt; int lda, ldb, K, a_split_pn, a_split_off, kpart; };

struct StaticOrder {
    int nM, nN, nwg, G, c, pm0;
    __device__ void init(int nM_, int nN_, int G_, int c_, int pm0_) { nM = nM_; nN = nN_; nwg = nM * nN; G = G_; c = c_; pm0 = pm0_; }
    __device__ bool next(int i, Unit& u) const {
        const long L = (long)i * G + c; if (L >= nwg) return false;
        int wgid = (int)L; { const int q = nwg / NXCD, r = nwg % NXCD, xcd = wgid % NXCD, off = wgid / NXCD; wgid = (xcd < r ? xcd * (q + 1) : r * (q + 1) + (xcd - r) * q) + off; }
        const int nig = WGM * nN, gid = wgid / nig, fm = gid * WGM, gsz = (nM - fm) < WGM ? (nM - fm) : WGM;
        u.pm = pm0 + fm + ((wgid % nig) % gsz); u.pn = (wgid % nig) / gsz; u.ks = 0; return true;
    }
};

struct SplitOrder {
    int nN, nun, G, c, pm;
    __device__ void init(int nN_, int KS_, int G_, int c_, int pm_) { nN = nN_; nun = nN_ * KS_; G = G_; c = c_; pm = pm_; }
    __device__ bool next(int i, Unit& u) const { const long L = (long)i * G + c; if (L >= nun) return false; u.pm = pm; u.pn = (int)L % nN; u.ks = (int)L / nN; return true; }
};

__device__ __forceinline__ unsigned cvt_pk_bf16(float lo, float hi) { unsigned r; asm volatile("v_cvt_pk_bf16_f32 %0, %1, %2" : "=v"(r) : "v"(lo), "v"(hi)); return r; }

template <class Epi, class Sched, bool ALIGN_EPI = true, bool SP2 = true>
__device__ __forceinline__ void gemm_phase(LAS unsigned char* lds, const Gemm g, const Sched& S, const Epi& E, int wid  ) {
    const int lane = lane_id_opaque(), tid = wid * 64 + lane, wr = wid >> 2, wc = wid & 3; int fr = lane & 15, fq = lane >> 4;
    const int K = g.K, nt = K / BK;
    unsigned voffA[2], voffB[2];
#pragma unroll
    for (int i = 0; i < 2; ++i) { int R, C; stage_rc(tid * 16 + i * 8192, R, C); const int Rb = Epi::PERM ? ((R & ~31) + perm32(R & 31)) : R;
        voffA[i] = (unsigned)(R * g.lda + C) * 2u; voffB[i] = (unsigned)(Rb * g.ldb + C) * 2u; }
    const size_t kstep = (size_t)(BK * 2);
    const size_t hstepA = (size_t)HALF * g.lda * 2, hstepB = (size_t)HALF * g.ldb * 2;
    const size_t tstepA = 2 * hstepA, tstepB = 2 * hstepB;
    const unsigned ldsw = (unsigned)wid * 1024u;
    const int aoff = lds_byte(wr * 64 + fr, fq * 8), boff = lds_byte(wc * 32 + fr, fq * 8);
#define PG8_SA(b, h) (((b) * 2 + (h)) * HTB)
#define PG8_SB(b, h) ((4 + (b) * 2 + (h)) * HTB)
#define PG8_STAGE(bufoff, gbase, voff) do { _Pragma("unroll") for (int _i = 0; _i < 2; ++_i) \
        __builtin_amdgcn_global_load_lds((const unsigned*)((const char*)(gbase) + (voff)[_i]), (LAS unsigned*)(lds + (bufoff) + ldsw + _i * 8192), 16, 0, 0); } while (0)
#define PG8_LDA(dst, b, h) do { _Pragma("unroll") for (int m = 0; m < 4; ++m) _Pragma("unroll") for (int k = 0; k < 2; ++k) dst[m][k] = *(const LAS bf16x8*)(lds + PG8_SA(b, h) + aoff + m * 2048 + k * 1024); } while (0)
#define PG8_LDB(dst, b, h) do { _Pragma("unroll") for (int n = 0; n < 2; ++n) _Pragma("unroll") for (int k = 0; k < 2; ++k) dst[n][k] = *(const LAS bf16x8*)(lds + PG8_SB(b, h) + boff + n * 2048 + k * 1024); } while (0)
#define PG8_MMA(ai, bj, At, Bt) do { __builtin_amdgcn_s_setprio(1); _Pragma("unroll") for (int m = 0; m < 4; ++m) _Pragma("unroll") for (int n = 0; n < 2; ++n) _Pragma("unroll") for (int k = 0; k < 2; ++k) \
        acc[ai][bj][m][n] = __builtin_amdgcn_mfma_f32_16x16x32_bf16(Bt[n][k], At[m][k], acc[ai][bj][m][n], 0, 0, 0); __builtin_amdgcn_s_setprio(0); } while (0)
#define PG8_WAIT_V(n) asm volatile("s_waitcnt vmcnt(" #n ")" ::: "memory")
#define PG8_WAIT_L(n) asm volatile("s_waitcnt lgkmcnt(" #n ")" ::: "memory")
#define PG8_BAR __builtin_amdgcn_s_barrier()
#define PG8_SCHED __builtin_amdgcn_sched_barrier(0)
#define PG8_ABASE(u) ((const char*)g.A + (size_t)(u).pm * tstepA + ((u).pn >= g.a_split_pn ? (size_t)g.a_split_off * 2 : (size_t)0) + (size_t)(u).ks * g.kpart * 2)
#define PG8_BBASE(u) ((const char*)g.Bt + (size_t)(u).pn * tstepB + (size_t)(u).ks * g.kpart * 2)
    Unit cur, nxt; int ui = 0;
    if (!S.next(0, cur)) return;
    f32x4 acc[2][2][4][2];
#pragma unroll
    for (int a = 0; a < 2; ++a)
#pragma unroll
        for (int b = 0; b < 2; ++b)
#pragma unroll
            for (int m = 0; m < 4; ++m)
#pragma unroll
                for (int n = 0; n < 2; ++n) acc[a][b][m][n] = (f32x4){0.f, 0.f, 0.f, 0.f};
    bf16x8 At[4][2], B0[2][2], B1[2][2];
    const char* cA = PG8_ABASE(cur); const char* cB = PG8_BBASE(cur);
    if constexpr (SP2) {
        PG8_STAGE(PG8_SB(0, 0), cB, voffB); PG8_STAGE(PG8_SB(0, 1), cB + hstepB, voffB); PG8_STAGE(PG8_SA(0, 0), cA, voffA); PG8_STAGE(PG8_SA(0, 1), cA + hstepA, voffA);
        if (wr == 1) PG8_BAR;
        PG8_WAIT_V(2); PG8_BAR;
        PG8_STAGE(PG8_SB(1, 0), cB + kstep, voffB); PG8_STAGE(PG8_SA(1, 0), cA + kstep, voffA); PG8_STAGE(PG8_SB(1, 1), cB + hstepB + kstep, voffB);
        PG8_WAIT_V(6); PG8_BAR;
    } else {
        PG8_STAGE(PG8_SB(0, 0), cB, voffB); PG8_STAGE(PG8_SA(0, 0), cA, voffA); PG8_STAGE(PG8_SB(0, 1), cB + hstepB, voffB); PG8_STAGE(PG8_SA(0, 1), cA + hstepA, voffA);
        if (wr == 1) PG8_BAR;
        PG8_WAIT_V(4); PG8_BAR;
        PG8_STAGE(PG8_SB(1, 0), cB + kstep, voffB); PG8_STAGE(PG8_SA(1, 0), cA + kstep, voffA); PG8_STAGE(PG8_SB(1, 1), cB + hstepB + kstep, voffB);
        PG8_WAIT_V(6); PG8_BAR;
    }
    for (;;) {
        const bool has_next = S.next(ui + 1, nxt);
        const char* nA = has_next ? PG8_ABASE(nxt) : cA; const char* nB = has_next ? PG8_BBASE(nxt) : cB;
        for (int t = 0; t < nt; t += 2) {
            const bool last = (t == nt - 2);
            const char* a1 = cA + (size_t)(t + 1) * kstep;
            const char* a2 = last ? nA : cA + (size_t)(t + 2) * kstep; const char* b2 = last ? nB : cB + (size_t)(t + 2) * kstep;
            const char* a3 = a2 + kstep; const char* b3 = b2 + kstep;
            if constexpr (SP2) {
            PG8_LDB(B0, 0, 0); PG8_LDB(B1, 0, 1); PG8_SCHED; PG8_LDA(At, 0, 0); PG8_STAGE(PG8_SA(1, 1), a1 + hstepA, voffA);
            PG8_WAIT_V(8); PG8_WAIT_L(0); PG8_BAR; PG8_MMA(0, 0, At, B0); PG8_MMA(0, 1, At, B1); PG8_BAR; PG8_SCHED;
            PG8_LDA(At, 0, 1); PG8_STAGE(PG8_SB(0, 0), b2, voffB); PG8_STAGE(PG8_SB(0, 1), b2 + hstepB, voffB); PG8_STAGE(PG8_SA(0, 0), a2, voffA);
            PG8_WAIT_V(8); PG8_WAIT_L(0); PG8_BAR; PG8_MMA(1, 0, At, B0); PG8_MMA(1, 1, At, B1); PG8_BAR; PG8_SCHED;
            PG8_LDB(B0, 1, 0); PG8_LDB(B1, 1, 1); PG8_SCHED; PG8_LDA(At, 1, 0); PG8_STAGE(PG8_SA(0, 1), a2 + hstepA, voffA);
            PG8_WAIT_V(8); PG8_WAIT_L(0); PG8_BAR; PG8_MMA(0, 0, At, B0); PG8_MMA(0, 1, At, B1); PG8_BAR; PG8_SCHED;
            PG8_LDA(At, 1, 1); PG8_STAGE(PG8_SB(1, 0), b3, voffB); PG8_STAGE(PG8_SB(1, 1), b3 + hstepB, voffB); PG8_STAGE(PG8_SA(1, 0), a3, voffA);
            PG8_WAIT_V(8); PG8_WAIT_L(0); PG8_BAR; PG8_MMA(1, 0, At, B0); PG8_MMA(1, 1, At, B1); PG8_BAR; PG8_SCHED;
            } else {
            PG8_LDB(B0, 0, 0); PG8_SCHED; PG8_LDA(At, 0, 0); PG8_STAGE(PG8_SA(1, 1), a1 + hstepA, voffA);
            PG8_WAIT_L(8); PG8_BAR; PG8_WAIT_L(0); PG8_MMA(0, 0, At, B0); PG8_BAR; PG8_SCHED;
            PG8_LDB(B1, 0, 1); PG8_STAGE(PG8_SB(0, 0), b2, voffB);
            PG8_BAR; PG8_WAIT_L(0); PG8_MMA(0, 1, At, B1); PG8_BAR;
            PG8_LDA(At, 0, 1); PG8_STAGE(PG8_SA(0, 0), a2, voffA);
            PG8_BAR; PG8_WAIT_L(0); PG8_MMA(1, 0, At, B0); PG8_BAR; PG8_SCHED;
            PG8_STAGE(PG8_SB(0, 1), b2 + hstepB, voffB);
            PG8_WAIT_V(6); PG8_BAR; PG8_MMA(1, 1, At, B1); PG8_BAR;
            PG8_LDB(B0, 1, 0); PG8_SCHED; PG8_LDA(At, 1, 0); PG8_STAGE(PG8_SA(0, 1), a2 + hstepA, voffA);
            PG8_WAIT_L(8); PG8_BAR; PG8_WAIT_L(0); PG8_MMA(0, 0, At, B0); PG8_BAR; PG8_SCHED;
            PG8_LDB(B1, 1, 1); PG8_STAGE(PG8_SB(1, 0), b3, voffB);
            PG8_BAR; PG8_WAIT_L(0); PG8_MMA(0, 1, At, B1); PG8_BAR;
            PG8_LDA(At, 1, 1); PG8_STAGE(PG8_SA(1, 0), a3, voffA);
            PG8_BAR; PG8_WAIT_L(0); PG8_MMA(1, 0, At, B0); PG8_BAR; PG8_SCHED;
            PG8_STAGE(PG8_SB(1, 1), b3 + hstepB, voffB);
            PG8_WAIT_V(6); PG8_BAR; PG8_MMA(1, 1, At, B1); PG8_BAR;
            }
        }
        if constexpr (ALIGN_EPI) { if (wr == 0) PG8_BAR; }
        { const int le_ = lane_id_opaque(); E(acc, cur, wr, wc, le_ & 15, le_ >> 4); }
        if (!has_next) break;
#pragma unroll
        for (int a = 0; a < 2; ++a)
#pragma unroll
            for (int b = 0; b < 2; ++b)
#pragma unroll
                for (int m = 0; m < 4; ++m)
#pragma unroll
                    for (int n = 0; n < 2; ++n) acc[a][b][m][n] = (f32x4){0.f, 0.f, 0.f, 0.f};
        cur = nxt; cA = nA; cB = nB; ++ui;
        if constexpr (ALIGN_EPI) { if (wr == 1) PG8_BAR; }
    }
    PG8_WAIT_V(0);
    if constexpr (!ALIGN_EPI) { if (wr == 0) PG8_BAR; }
    PG8_BAR;
#undef PG8_SA
#undef PG8_SB
#undef PG8_STAGE
#undef PG8_LDA
#undef PG8_LDB
#undef PG8_MMA
#undef PG8_WAIT_V
#undef PG8_WAIT_L
#undef PG8_BAR
#undef PG8_SCHED
#undef PG8_ABASE
#undef PG8_BBASE
}
}

struct EpiZ {
    static constexpr bool PERM = true;
    float* out; unsigned char* ws;
    __device__ __forceinline__ void operator()(const f32x4 (&acc)[2][2][4][2], const pg8::Unit& u, int wr, int wc, int fr, int fq) const {
        asm volatile("" : "+v"(fr), "+v"(fq));
        const int seg = u.pn >> 1;
        const bool smp = u.pm >= SEQ / 256;
        const int row0 = u.pm * 256 + wr * 64 + fr;
        const int cl0 = wc * 32 + 8 * fq;
        if (seg < 6) {
            bf16_t* B = (bf16_t*)(ws + WS_QA + (size_t)seg * (WS_KA - WS_QA));
            const bool isq = (seg == 0 || seg == 3);
            const float sc = isq ? C2 : 1.0f;
            const int kk = seg - 1 - (seg > 3 ? 1 : 0);
            float* ob = isq ? nullptr : (smp ? out + O_DKS + (size_t)kk * NSMP * 512 - (size_t)SEQ * 512 : out + O_DKP + (size_t)kk * SEQ * 512);
            const int cs = (u.pn & 1) * 256 + cl0;
            if (seg == 0 || seg == 1 || seg == 3 || seg == 4) {
                float mx0 = 0.f, mx1 = 0.f;
#pragma unroll
                for (int ai = 0; ai < 2; ++ai)
#pragma unroll
                    for (int m = 0; m < 4; ++m) {
#pragma unroll
                        for (int bj = 0; bj < 2; ++bj) { const f32x4 v0 = acc[ai][bj][m][0] * sc, v1 = acc[ai][bj][m][1] * sc;
                            float ss = (v0[0] * v0[0] + v0[1] * v0[1]) + (v0[2] * v0[2] + v0[3] * v0[3]) + (v1[0] * v1[0] + v1[1] * v1[1]) + (v1[2] * v1[2] + v1[3] * v1[3]);
                            ss += __shfl_xor(ss, 16); ss += __shfl_xor(ss, 32);
                            if (bj == 0) mx0 = fmaxf(mx0, ss); else mx1 = fmaxf(mx1, ss); } }
#pragma unroll
                for (int ofs = 1; ofs < 16; ofs <<= 1) { mx0 = fmaxf(mx0, __shfl_xor(mx0, ofs)); mx1 = fmaxf(mx1, __shfl_xor(mx1, ofs)); }
                if ((fr | fq) == 0) { unsigned* nw = (unsigned*)(ws + WS_CTL) + (seg < 3 ? 288 : 256) + ((seg == 4 || seg == 1) ? 16 : 0);
                    const int h0 = (u.pn & 1) * 4 + (wc >> 1), hf = wc & 1;
                    atomicMax(nw + (h0 * 2 + hf), __float_as_uint(mx0)); atomicMax(nw + ((h0 + 2) * 2 + hf), __float_as_uint(mx1)); }
            }
#pragma unroll
            for (int ai = 0; ai < 2; ++ai)
#pragma unroll
                for (int m = 0; m < 4; ++m) { const size_t r = (size_t)(row0 + ai * 128 + m * 16);
#pragma unroll
                    for (int bj = 0; bj < 2; ++bj) { const f32x4 v0 = acc[ai][bj][m][0], v1 = acc[ai][bj][m][1]; const int c = cs + bj * 128;
                        if (ob) { __builtin_nontemporal_store(v0, (f32x4*)(ob + r * 512 + c)); __builtin_nontemporal_store(v1, (f32x4*)(ob + r * 512 + c + 4)); }
                        u32x4 w; w.x = pg8::cvt_pk_bf16(v0[0] * sc, v0[1] * sc); w.y = pg8::cvt_pk_bf16(v0[2] * sc, v0[3] * sc); w.z = pg8::cvt_pk_bf16(v1[0] * sc, v1[1] * sc); w.w = pg8::cvt_pk_bf16(v1[2] * sc, v1[3] * sc);
                        *(u32x4*)(B + r * 512 + c) = w; } }
        } else {
            bf16_t* G = (bf16_t*)(ws + WS_G);
            const int cs = (u.pn - 12) * 256 + cl0;
#pragma unroll
            for (int ai = 0; ai < 2; ++ai)
#pragma unroll
                for (int m = 0; m < 4; ++m) { const size_t r = (size_t)(row0 + ai * 128 + m * 16);
#pragma unroll
                    for (int bj = 0; bj < 2; ++bj) { const f32x4 v0 = acc[ai][bj][m][0], v1 = acc[ai][bj][m][1]; const int c = cs + bj * 128;
                        u32x4 w; w.x = pg8::cvt_pk_bf16(sigmoidf_(v0[0]), sigmoidf_(v0[1])); w.y = pg8::cvt_pk_bf16(sigmoidf_(v0[2]), sigmoidf_(v0[3]));
                        w.z = pg8::cvt_pk_bf16(sigmoidf_(v1[0]), sigmoidf_(v1[1])); w.w = pg8::cvt_pk_bf16(sigmoidf_(v1[2]), sigmoidf_(v1[3]));
                        *(u32x4*)(G + r * 2048 + c) = w; } }
        }
    }
};
struct EpiGate {
    static constexpr bool PERM = true;
    bf16_t* G; bf16_t* GO;
    __device__ __forceinline__ void operator()(const f32x4 (&acc)[2][2][4][2], const pg8::Unit& u, int wr, int wc, int fr, int fq) const {
        asm volatile("" : "+v"(fr), "+v"(fq));
        const int row0 = u.pm * 256 + wr * 64 + fr, c0 = u.pn * 256 + wc * 32 + 8 * fq;
#pragma unroll
        for (int ai = 0; ai < 2; ++ai)
#pragma unroll
            for (int m = 0; m < 4; ++m) { const size_t ro = (size_t)(row0 + ai * 128 + m * 16) * 2048 + c0; const bf16_t* rp = G + ro; bf16_t* wp = GO + ro;
#pragma unroll
                for (int bj = 0; bj < 2; ++bj) { const f32x4 v0 = acc[ai][bj][m][0], v1 = acc[ai][bj][m][1]; const u32x4 gw = *(const u32x4*)(rp + bj * 128);
                    u32x4 w; w.x = pg8::cvt_pk_bf16(v0[0] * bflo(gw.x), v0[1] * bfhi(gw.x)); w.y = pg8::cvt_pk_bf16(v0[2] * bflo(gw.y), v0[3] * bfhi(gw.y));
                    w.z = pg8::cvt_pk_bf16(v1[0] * bflo(gw.z), v1[1] * bfhi(gw.z)); w.w = pg8::cvt_pk_bf16(v1[2] * bflo(gw.w), v1[3] * bfhi(gw.w));
                    *(u32x4*)(wp + bj * 128) = w; } }
    }
};
template <bool BASE_BF16> struct EpiRes {
    static constexpr bool PERM = true;
    const void* base; bf16_t* T; const float* gate;
    __device__ __forceinline__ void operator()(const f32x4 (&acc)[2][2][4][2], const pg8::Unit& u, int wr, int wc, int fr, int fq) const {
        asm volatile("" : "+v"(fr), "+v"(fq));
        const int row0 = u.pm * 256 + wr * 64 + fr, c0 = u.pn * 256 + wc * 32 + 8 * fq;
#pragma unroll
        for (int ai = 0; ai < 2; ++ai)
#pragma unroll
            for (int m = 0; m < 4; ++m) { const size_t ro = (size_t)(row0 + ai * 128 + m * 16) * DM;
#pragma unroll
                for (int bj = 0; bj < 2; ++bj) { const int c = c0 + bj * 128; f32x4 b0, b1;
                    if (BASE_BF16) { const u32x4 bw = *(const u32x4*)((const bf16_t*)base + ro + c); b0 = (f32x4){bflo(bw.x), bfhi(bw.x), bflo(bw.y), bfhi(bw.y)}; b1 = (f32x4){bflo(bw.z), bfhi(bw.z), bflo(bw.w), bfhi(bw.w)}; }
                    else { b0 = *(const f32x4*)((const float*)base + ro + c); b1 = *(const f32x4*)((const float*)base + ro + c + 4); }
                    const f32x4 g0 = *(const f32x4*)(gate + c), g1 = *(const f32x4*)(gate + c + 4);
                    const f32x4 v0 = b0 * ALPHA + g0 * acc[ai][bj][m][0], v1 = b1 * ALPHA + g1 * acc[ai][bj][m][1];
                    u32x4 w; w.x = pg8::cvt_pk_bf16(v0[0], v0[1]); w.y = pg8::cvt_pk_bf16(v0[2], v0[3]); w.z = pg8::cvt_pk_bf16(v1[0], v1[1]); w.w = pg8::cvt_pk_bf16(v1[2], v1[3]);
                    *(u32x4*)(T + ro + c) = w; } }
    }
};
struct PanelStats {
    unsigned* xbuf; unsigned* cnt; float eps;
    __device__ __forceinline__ void run(const f32x4 (&v)[2][2][4][2], const pg8::Unit& u, int wr, int wc, int fr, int fq, LAS unsigned char* lds, int wid, int lane) const {
        LAS f32x2* P = (LAS f32x2*)(lds + LN_LDS);
        LAS f32x2* S = (LAS f32x2*)(lds + LN_LDS + 8192);
#pragma unroll
        for (int ai = 0; ai < 2; ++ai)
#pragma unroll
            for (int m = 0; m < 4; ++m) {
                float s = 0.f;
#pragma unroll
                for (int bj = 0; bj < 2; ++bj)
#pragma unroll
                    for (int n = 0; n < 2; ++n) { const f32x4 x = v[ai][bj][m][n]; s += (x[0] + x[1]) + (x[2] + x[3]); }
                s += __shfl_xor(s, 16); s += __shfl_xor(s, 32);
                const float mw = s * (1.0f / 64.0f); float q = 0.f;
#pragma unroll
                for (int bj = 0; bj < 2; ++bj)
#pragma unroll
                    for (int n = 0; n < 2; ++n) { const f32x4 d = v[ai][bj][m][n] - mw; q += (d[0] * d[0] + d[1] * d[1]) + (d[2] * d[2] + d[3] * d[3]); }
                q += __shfl_xor(q, 16); q += __shfl_xor(q, 32);
                if (fq == 0) P[(ai * 128 + wr * 64 + m * 16 + fr) * 4 + wc] = (f32x2){mw, q};
                __builtin_amdgcn_sched_barrier(0);
            }
        asm volatile("s_waitcnt lgkmcnt(0)" ::: "memory"); __builtin_amdgcn_s_barrier(); asm volatile("" ::: "memory");
        const int row = wid * 32 + (lane & 31);
        if (lane < 32) {
            const f32x2 a = P[row * 4 + 0], b = P[row * 4 + 1], c = P[row * 4 + 2], d = P[row * 4 + 3];
            const float mt = (a.x + b.x + c.x + d.x) * 0.25f;
            const float da = a.x - mt, db = b.x - mt, dc = c.x - mt, dd = d.x - mt;
            const float m2 = (a.y + b.y) + (c.y + d.y) + 64.0f * ((da * da + db * db) + (dc * dc + dd * dd));
            unsigned long long* slot = (unsigned long long*)xbuf + ((size_t)(u.pm * 256 + row) * 4 + u.pn);
            __hip_atomic_store(slot, ((unsigned long long)__float_as_uint(m2) << 32) | __float_as_uint(mt), __ATOMIC_RELAXED, __HIP_MEMORY_SCOPE_AGENT);
        }
        asm volatile("s_waitcnt vmcnt(0)" ::: "memory");
        if (lane == 0) __hip_atomic_fetch_add(cnt + 64 * u.pm, 1u, __ATOMIC_RELAXED, __HIP_MEMORY_SCOPE_AGENT);
        if (wid == 0) {
            unsigned sp = 0;
            while ((unsigned)__builtin_amdgcn_readfirstlane(__hip_atomic_load(cnt + 64 * u.pm, __ATOMIC_RELAXED, __HIP_MEMORY_SCOPE_AGENT)) < 32u && ++sp < (1u << 21)) __builtin_amdgcn_s_sleep(2);
            __builtin_amdgcn_fence(__ATOMIC_ACQUIRE, "agent");
        }
        asm volatile("s_waitcnt vmcnt(0) lgkmcnt(0)" ::: "memory"); __builtin_amdgcn_s_barrier(); asm volatile("" ::: "memory");
        if (lane < 32) {
            const unsigned long long* slot = (const unsigned long long*)xbuf + (size_t)(u.pm * 256 + row) * 4; float mt[4], m2[4]; float ms = 0.f;
#pragma unroll
            for (int t = 0; t < 4; ++t) { const unsigned long long w = __hip_atomic_load(slot + t, __ATOMIC_RELAXED, __HIP_MEMORY_SCOPE_AGENT); mt[t] = __uint_as_float((unsigned)w); m2[t] = __uint_as_float((unsigned)(w >> 32)); ms += mt[t]; }
            const float mean = ms * 0.25f; float q = 0.f;
#pragma unroll
            for (int t = 0; t < 4; ++t) { const float dm = mt[t] - mean; q += m2[t] + 256.0f * dm * dm; }
            S[row] = (f32x2){mean, 1.0f / sqrtf(q * (1.0f / 1024.0f) + eps)};
        }
        asm volatile("s_waitcnt lgkmcnt(0)" ::: "memory"); __builtin_amdgcn_s_barrier(); asm volatile("" ::: "memory");
    }
};
template <bool FINAL> struct EpiResLn {
    static constexpr bool PERM = true;
    const void* base; const float* gate; const float* lg; const float* lb; const float* mod; bf16_t* X1B; bf16_t* XN; float* out; PanelStats st; LAS unsigned char* lds;
    __device__ __forceinline__ void operator()(f32x4 (&acc)[2][2][4][2], const pg8::Unit& u, int wr, int wc, int fr, int fq) const {
        asm volatile("" : "+v"(fr), "+v"(fq));
        const int row0 = u.pm * 256 + wr * 64 + fr, c0 = u.pn * 256 + wc * 32 + 8 * fq;
#pragma unroll
        for (int ai = 0; ai < 2; ++ai)
#pragma unroll
            for (int m = 0; m < 4; ++m) { int rr_ = row0 + ai * 128 + m * 16; asm volatile("" : "+v"(rr_)); const size_t ro = (size_t)rr_ * DM;
#pragma unroll
                for (int bj = 0; bj < 2; ++bj) { int c = c0 + bj * 128; asm volatile("" : "+v"(c)); f32x4 b0, b1;
                    if (FINAL) { const u32x4 bw = *(const u32x4*)((const bf16_t*)base + ro + c); b0 = (f32x4){bflo(bw.x), bfhi(bw.x), bflo(bw.y), bfhi(bw.y)}; b1 = (f32x4){bflo(bw.z), bfhi(bw.z), bflo(bw.w), bfhi(bw.w)}; }
                    else { b0 = *(const f32x4*)((const float*)base + ro + c); b1 = *(const f32x4*)((const float*)base + ro + c + 4); }
                    const f32x4 g0 = *(const f32x4*)(gate + c), g1 = *(const f32x4*)(gate + c + 4);
                    acc[ai][bj][m][0] = b0 * ALPHA + g0 * acc[ai][bj][m][0]; acc[ai][bj][m][1] = b1 * ALPHA + g1 * acc[ai][bj][m][1];
                    asm volatile("" : "+v"(acc[ai][bj][m][0]), "+v"(acc[ai][bj][m][1])); }
                __builtin_amdgcn_sched_barrier(0); }
        st.run(acc, u, wr, wc, fr, fq, lds, wr * 4 + wc, fq * 16 + fr);
        const LAS f32x2* S = (const LAS f32x2*)(lds + LN_LDS + 8192);
#pragma unroll
        for (int ai = 0; ai < 2; ++ai)
#pragma unroll
            for (int m = 0; m < 4; ++m) { int r = ai * 128 + wr * 64 + m * 16 + fr; asm volatile("" : "+v"(r)); const f32x2 sr = S[r]; const size_t ro = (size_t)(u.pm * 256 + r) * DM;
#pragma unroll
                for (int bj = 0; bj < 2; ++bj) { int c = c0 + bj * 128; asm volatile("" : "+v"(c));
                    const f32x4 y0 = (acc[ai][bj][m][0] - sr.x) * sr.y * *(const f32x4*)(lg + c) + *(const f32x4*)(lb + c);
                    const f32x4 y1 = (acc[ai][bj][m][1] - sr.x) * sr.y * *(const f32x4*)(lg + c + 4) + *(const f32x4*)(lb + c + 4);
                    if (FINAL) { __builtin_nontemporal_store(y0, (f32x4*)(out + ro + c)); __builtin_nontemporal_store(y1, (f32x4*)(out + ro + c + 4)); }
                    else { u32x4 w; w.x = pg8::cvt_pk_bf16(y0[0], y0[1]); w.y = pg8::cvt_pk_bf16(y0[2], y0[3]); w.z = pg8::cvt_pk_bf16(y1[0], y1[1]); w.w = pg8::cvt_pk_bf16(y1[2], y1[3]);
                        *(u32x4*)(X1B + ro + c) = w;
                        const f32x4 h0 = y0 * (*(const f32x4*)(mod + 4096 + c) + 1.0f) + *(const f32x4*)(mod + 3072 + c), h1 = y1 * (*(const f32x4*)(mod + 4096 + c + 4) + 1.0f) + *(const f32x4*)(mod + 3072 + c + 4);
                        u32x4 w2; w2.x = pg8::cvt_pk_bf16(h0[0], h0[1]); w2.y = pg8::cvt_pk_bf16(h0[2], h0[3]); w2.z = pg8::cvt_pk_bf16(h1[0], h1[1]); w2.w = pg8::cvt_pk_bf16(h1[2], h1[3]);
                        *(u32x4*)(XN + ro + c) = w2; } }
                __builtin_amdgcn_sched_barrier(0); }
    }
};
struct EpiSlab {
    static constexpr bool PERM = true;
    float* slab;
    __device__ __forceinline__ void operator()(const f32x4 (&acc)[2][2][4][2], const pg8::Unit& u, int wr, int wc, int fr, int fq) const {
        asm volatile("" : "+v"(fr), "+v"(fq));
        const int row0 = wr * 64 + fr, c0 = u.pn * 256 + wc * 32 + 8 * fq; float* sb = slab + (size_t)u.ks * NSMP * DM;
#pragma unroll
        for (int ai = 0; ai < 2; ++ai)
#pragma unroll
            for (int m = 0; m < 4; ++m) { float* op = sb + (size_t)(row0 + ai * 128 + m * 16) * DM + c0;
#pragma unroll
                for (int bj = 0; bj < 2; ++bj) { *(f32x4*)(op + bj * 128) = acc[ai][bj][m][0]; *(f32x4*)(op + bj * 128 + 4) = acc[ai][bj][m][1]; } }
    }
};
struct EpiFfn {
    static constexpr bool PERM = true;
    bf16_t* ACT;
    __device__ __forceinline__ void operator()(const f32x4 (&acc)[2][2][4][2], const pg8::Unit& u, int wr, int wc, int fr, int fq) const {
        asm volatile("" : "+v"(fr), "+v"(fq));
        const int row0 = u.pm * 256 + wr * 64 + fr, c0 = u.pn * 128 + wc * 32 + 8 * fq;
#pragma unroll
        for (int ai = 0; ai < 2; ++ai)
#pragma unroll
            for (int m = 0; m < 4; ++m) { const f32x4 g0 = acc[ai][0][m][0], g1 = acc[ai][0][m][1], u0 = acc[ai][1][m][0], u1 = acc[ai][1][m][1];
                u32x4 w; w.x = pg8::cvt_pk_bf16(siluf_(g0[0]) * u0[0], siluf_(g0[1]) * u0[1]); w.y = pg8::cvt_pk_bf16(siluf_(g0[2]) * u0[2], siluf_(g0[3]) * u0[3]);
                w.z = pg8::cvt_pk_bf16(siluf_(g1[0]) * u1[0], siluf_(g1[1]) * u1[1]); w.w = pg8::cvt_pk_bf16(siluf_(g1[2]) * u1[2], siluf_(g1[3]) * u1[3]);
                *(u32x4*)(ACT + (size_t)(row0 + ai * 128 + m * 16) * DFF + c0) = w; }
    }
};

struct Frame {
    LAS unsigned char* lds; unsigned char* ldsg;
    int tid, lane, wave, G, bid;
    const float* const* in; float* out; unsigned char* ws;
};
enum { I_XP = 0, I_XS, I_CDK, I_CDV, I_CFK, I_CFV, I_CFL, I_CP, I_CS, I_WADA, I_BADA, I_WIN, I_BF, I_LQ1, I_LK1, I_LQ2, I_LK2, I_SUBG, I_RELB, I_WA, I_WB, I_WO, I_LN1G, I_LN1B, I_LN2G, I_LN2B, I_WFI, I_WFO };

__device__ __forceinline__ void tr_item(const float* W, int ldw, int src_n0, int k0, bf16_t* WT, int ldt, int dst_row0, int dst_k0, int dup_off, LAS float* scr, int lane) {
#pragma unroll 8
    for (int i = 0; i < 32; ++i) { const int kk = 2 * i + (lane >> 5); scr[kk * 33 + (lane & 31)] = W[(size_t)(k0 + kk) * ldw + src_n0 + (lane & 31)]; }
    asm volatile("s_waitcnt lgkmcnt(0)" ::: "memory");
    const int c = lane & 7;
#pragma unroll
    for (int j = 0; j < 4; ++j) { const int n = (lane >> 3) + 8 * j; const LAS float* s = scr + (8 * c) * 33 + n;
        u32x4 o; o.x = pk2(s[0 * 33], s[1 * 33]); o.y = pk2(s[2 * 33], s[3 * 33]); o.z = pk2(s[4 * 33], s[5 * 33]); o.w = pk2(s[6 * 33], s[7 * 33]);
        bf16_t* d = WT + (size_t)(dst_row0 + n) * ldt + dst_k0 + 8 * c;
        *(u32x4*)d = o; if (dup_off) *(u32x4*)(d + dup_off) = o; }
    asm volatile("s_waitcnt lgkmcnt(0)" ::: "memory");
}
__device__ __forceinline__ void weight_copies(Frame& F, int c, int n, int it0, int it1) {
    LAS float* scr = (LAS float*)(F.lds + F.wave * 16384);
    const int gw = c * 8 + F.wave, NGW = n * 8;
    constexpr int I_IN = 16 * (NZ / 32), I_A = 8 * 32, I_B = 8 * 32, I_O = 16 * 32, I_FI = 16 * (NFF2 / 32), I_FO = (DFF / 64) * 32;
    for (int it = it0 + gw; it < it1; it += NGW) {
        int r = it;
        if (r < I_IN) { const int nb = NZ / 32, kb = r / nb, n0 = 32 * (r % nb); tr_item(F.in[I_WIN], WIN_COLS, n0 < 3072 ? n0 : n0 + 8, 64 * kb, (bf16_t*)(F.ws + WS_WIN), 1024, n0, 64 * kb, 0, scr, F.lane); continue; } r -= I_IN;
        if (r < I_A) { const int kb = r / 32, n0 = 32 * (r % 32); tr_item(F.in[I_WA], 1024, n0, 64 * kb, (bf16_t*)(F.ws + WS_WAB), 512, n0, 64 * kb, 0, scr, F.lane); continue; } r -= I_A;
        if (r < I_B) { const int kb = r / 32, n0 = 32 * (r % 32); tr_item(F.in[I_WB], 1024, n0, 64 * kb, (bf16_t*)(F.ws + WS_WAB), 512, 1024 + n0, 64 * kb, 0, scr, F.lane); continue; } r -= I_B;
        if (r < I_O) { const int kb = r / 32, n0 = 32 * (r % 32); tr_item(F.in[I_WO], 1024, n0, 64 * kb, (bf16_t*)(F.ws + WS_WO2), 2048, n0, 64 * kb, 1024, scr, F.lane); continue; } r -= I_O;
        if (r < I_FI) { const int nb = NFF2 / 32, kb = r / nb, n0 = 32 * (r % nb), t = n0 >> 8, j = n0 & 255; const int src = j < 128 ? 128 * t + j : DFF + 128 * t + (j - 128);
            tr_item(F.in[I_WFI], NFF2, src, 64 * kb, (bf16_t*)(F.ws + WS_WFI), 1024, n0, 64 * kb, 0, scr, F.lane); continue; } r -= I_FI;
        { const int kb = r / 32, n0 = 32 * (r % 32); tr_item(F.in[I_WFO], 1024, n0, 64 * kb, (bf16_t*)(F.ws + WS_WFO), DFF, n0, 64 * kb, 0, scr, F.lane); }
    }
}
constexpr int WC_IN = 16 * (NZ / 32), WC_ALL = WC_IN + 8 * 32 + 8 * 32 + 16 * 32 + 16 * (NFF2 / 32) + (DFF / 64) * 32;
__device__ __forceinline__ void p0_prologue(Frame& F) {
    if (F.bid < 96) {
        LAS float* sc = (LAS float*)F.lds;
        LAS float* part = sc + 17 * 1024;
        { float cv[34];
#pragma unroll
          for (int j = 0; j < 34; ++j) { const int i = F.tid + 512 * j, r = i >> 10, k = i & 1023; cv[j] = r == 0 ? F.in[I_CP][k] : F.in[I_CS][(r - 1) * 1024 + k]; }
#pragma unroll
          for (int j = 0; j < 34; ++j) sc[F.tid + 512 * j] = siluf_(cv[j]); }
        __syncthreads();
        const int n = F.bid * 64 + F.lane; const float* wa = F.in[I_WADA] + n;
        float acc[17];
#pragma unroll
        for (int r = 0; r < 17; ++r) acc[r] = 0.f;
#pragma unroll 8
        for (int k = F.wave * 128; k < F.wave * 128 + 128; k += 4) {
            const float w0 = wa[(size_t)k * 6144], w1 = wa[(size_t)(k + 1) * 6144], w2 = wa[(size_t)(k + 2) * 6144], w3 = wa[(size_t)(k + 3) * 6144];
#pragma unroll
            for (int r = 0; r < 17; ++r) { const f32x4 s = *(const LAS f32x4*)(sc + r * 1024 + k); acc[r] += s[0] * w0 + s[1] * w1 + s[2] * w2 + s[3] * w3; }
        }
#pragma unroll
        for (int r = 0; r < 17; ++r) part[(F.wave * 17 + r) * 64 + F.lane] = acc[r];
        __syncthreads();
        float* mod = (float*)(F.ws + WS_MOD);
        for (int i = F.tid; i < 17 * 64; i += 512) { const int r = i >> 6, l = i & 63; float s = 0.f;
#pragma unroll
            for (int w = 0; w < 8; ++w) s += part[(w * 17 + r) * 64 + l];
            mod[r * 6144 + F.bid * 64 + l] = s + F.in[I_BADA][F.bid * 64 + l]; }
        asm volatile("s_waitcnt vmcnt(0)" ::: "memory");
        __syncthreads();
        if (F.tid == 0) { __builtin_amdgcn_fence(__ATOMIC_RELEASE, "agent"); asm volatile("s_waitcnt vmcnt(0)" ::: "memory");
            __hip_atomic_fetch_add((unsigned*)(F.ws + WS_CTL) + 320, 1u, __ATOMIC_RELAXED, __HIP_MEMORY_SCOPE_AGENT); }
    }
    if (F.G >= 192) { if (F.bid >= 96) weight_copies(F, F.bid - 96, F.G - 96, 0, 16 * (NZ / 32)); }
    else weight_copies(F, F.bid, F.G, 0, 16 * (NZ / 32));
}

__device__ __forceinline__ void p1_rows(Frame& F, bool wait_mod) {
    LAS float* wf = (LAS float*)F.lds;
    for (int i = F.tid; i < 1024 * 8; i += 512) wf[i] = F.in[I_WIN][(size_t)(i >> 3) * WIN_COLS + 3072 + (i & 7)];
    __syncthreads();
    const float* mod = (const float*)(F.ws + WS_MOD);
    bf16_t* XN = (bf16_t*)(F.ws + WS_XN);
    const int gw = F.bid * 8 + F.wave, NGW = F.G * 8;
    if (wait_mod) {
        if (F.tid == 0) { unsigned* w = (unsigned*)(F.ws + WS_CTL) + 320; unsigned sp = 0;
            while (__hip_atomic_load(w, __ATOMIC_RELAXED, __HIP_MEMORY_SCOPE_AGENT) < 96u && ++sp < (1u << 22)) __builtin_amdgcn_s_sleep(2);
            __builtin_amdgcn_fence(__ATOMIC_ACQUIRE, "agent"); asm volatile("s_waitcnt vmcnt(0)" ::: "memory"); }
        __syncthreads(); }
    int m = gw;
    for (; m + NGW < SEQ; m += 2 * NGW) {
        const float* xr0 = F.in[I_XP] + (size_t)m * DM; const float* xr1 = xr0 + (size_t)NGW * DM;
        float a8[2][8];
#pragma unroll
        for (int j = 0; j < 8; ++j) { a8[0][j] = 0.f; a8[1][j] = 0.f; }
#pragma unroll
        for (int j = 0; j < 4; ++j) { const int k = 4 * F.lane + 256 * j;
            const f32x4 x0 = *(const f32x4*)(xr0 + k), x1 = *(const f32x4*)(xr1 + k), s1 = *(const f32x4*)(mod + 1024 + k), t1 = *(const f32x4*)(mod + k);
            const f32x4 h0 = x0 * (s1 + 1.0f) + t1, h1 = x1 * (s1 + 1.0f) + t1;
            u32x2 w; w.x = pk2(h0[0], h0[1]); w.y = pk2(h0[2], h0[3]); *(u32x2*)(XN + (size_t)m * DM + k) = w;
            w.x = pk2(h1[0], h1[1]); w.y = pk2(h1[2], h1[3]); *(u32x2*)(XN + (size_t)(m + NGW) * DM + k) = w;
#pragma unroll
            for (int e = 0; e < 4; ++e) { const f32x4 wa = *(const LAS f32x4*)(wf + (k + e) * 8), wb = *(const LAS f32x4*)(wf + (k + e) * 8 + 4);
#pragma unroll
                for (int c = 0; c < 4; ++c) { a8[0][c] += h0[e] * wa[c]; a8[0][4 + c] += h0[e] * wb[c]; a8[1][c] += h1[e] * wa[c]; a8[1][4 + c] += h1[e] * wb[c]; } } }
        float mine = 0.f;
#pragma unroll
        for (int j = 0; j < 8; ++j) { const float s0 = wave_sum(a8[0][j]), s1 = wave_sum(a8[1][j]); if (F.lane == j) mine = s0; if (F.lane == 8 + j) mine = s1; }
        if (F.lane < 16) { const int rr = F.lane >> 3, c = F.lane & 7; const float v = mine + F.in[I_BF][c]; const float lf = fminf(v, 0.f) - log1pf(__expf(-fabsf(v)));
            F.out[O_FLP + (size_t)(m + rr * NGW) * 8 + c] = lf; }
    }
    for (; m < MT; m += NGW) {
        const bool smp = m >= SEQ; const int rb = smp ? 1 + ((m - SEQ) >> 4) : 0;
        const float* xr = smp ? F.in[I_XS] + (size_t)(m - SEQ) * DM : F.in[I_XP] + (size_t)m * DM;
        const float* sh = mod + (size_t)rb * 6144, *scl = sh + 1024;
        float a8[8];
#pragma unroll
        for (int j = 0; j < 8; ++j) a8[j] = 0.f;
#pragma unroll
        for (int j = 0; j < 4; ++j) { const int k = 4 * F.lane + 256 * j;
            const f32x4 x = *(const f32x4*)(xr + k), s1 = *(const f32x4*)(scl + k), t1 = *(const f32x4*)(sh + k);
            const f32x4 h = x * (s1 + 1.0f) + t1;
            u32x2 w; w.x = pk2(h[0], h[1]); w.y = pk2(h[2], h[3]); *(u32x2*)(XN + (size_t)m * DM + k) = w;
#pragma unroll
            for (int e = 0; e < 4; ++e) { const f32x4 wa = *(const LAS f32x4*)(wf + (k + e) * 8), wb = *(const LAS f32x4*)(wf + (k + e) * 8 + 4);
                a8[0] += h[e] * wa[0]; a8[1] += h[e] * wa[1]; a8[2] += h[e] * wa[2]; a8[3] += h[e] * wa[3];
                a8[4] += h[e] * wb[0]; a8[5] += h[e] * wb[1]; a8[6] += h[e] * wb[2]; a8[7] += h[e] * wb[3]; } }
        float mine = 0.f;
#pragma unroll
        for (int j = 0; j < 8; ++j) { const float s = wave_sum(a8[j]); if (F.lane == j) mine = s; }
        if (F.lane < 8) { const float v = mine + F.in[I_BF][F.lane]; const float lf = fminf(v, 0.f) - log1pf(__expf(-fabsf(v)));
            float* o = smp ? F.out + O_FLS + (size_t)(m - SEQ) * 8 : F.out + O_FLP + (size_t)m * 8; o[F.lane] = lf; }
    }
}

__device__ __forceinline__ float block_excl_scan(Frame& F, float tot, LAS float* sm) {
    float inc = tot;
#pragma unroll
    for (int o = 1; o < 64; o <<= 1) { const float t = __shfl_up(inc, o); if (F.lane >= o) inc += t; }
    if (F.lane == 63) sm[F.wave] = inc;
    __syncthreads();
    float base = 0.f;
    for (int w = 0; w < F.wave; ++w) base += sm[w];
    __syncthreads();
    return base + inc - tot;
}
__device__ __forceinline__ void p2_cumsum(Frame& F) {
    LAS float* sm = (LAS float*)F.lds;
    const int rb_ = F.G >= 160 ? F.bid - 20 : F.bid;
    if (rb_ < 0) return;
    if (rb_ < 8) {
        const int h = rb_; const float* lf = F.out + O_FLP; float* Fp = (float*)(F.ws + WS_FP) + (size_t)h * SEQ;
        float v[32]; float run = 0.f;
#pragma unroll
        for (int i = 0; i < 32; ++i) { run += lf[(size_t)(32 * F.tid + i) * 8 + h]; v[i] = run; }
        const float off = block_excl_scan(F, run, sm);
#pragma unroll
        for (int i = 0; i < 32; i += 4) *(f32x4*)(Fp + 32 * F.tid + i) = (f32x4){(off + v[i]) * LOG2E, (off + v[i + 1]) * LOG2E, (off + v[i + 2]) * LOG2E, (off + v[i + 3]) * LOG2E};
    } else if (rb_ < 8 + 128) {
        const int b = (rb_ - 8) >> 3, h = (rb_ - 8) & 7;
        const float* cl = F.in[I_CFL] + (size_t)b * PAST * 8; float* Fs = (float*)(F.ws + WS_FS) + (size_t)(b * 8 + h) * SKV;
        float v[4]; float run = 0.f;
#pragma unroll
        for (int i = 0; i < 4; ++i) { run += cl[(size_t)(4 * F.tid + i) * 8 + h]; v[i] = run; }
        const float off = block_excl_scan(F, run, sm);
        *(f32x4*)(Fs + 4 * F.tid) = (f32x4){(off + v[0]) * LOG2E, (off + v[1]) * LOG2E, (off + v[2]) * LOG2E, (off + v[3]) * LOG2E};
        if (F.tid == 511) { float r2 = off + run; const float* ls = F.out + O_FLS + (size_t)b * DEC_T * 8;
            for (int t = 0; t < DEC_T; ++t) { r2 += ls[t * 8 + h]; Fs[PAST + t] = r2 * LOG2E; } }
    }
}

template <bool FINAL> __device__ __forceinline__ void ln_rows(Frame& F, const float* g, const float* b, int KS, int gate_off) {
    const float* mod = (const float*)(F.ws + WS_MOD);
    const bf16_t* T = (const bf16_t*)(F.ws + WS_TB); bf16_t* X1B = (bf16_t*)(F.ws + WS_X1B); bf16_t* XN = (bf16_t*)(F.ws + WS_XN);
    const int gw = F.wave * F.G + F.bid, NGW = F.G * 8;
    for (int m = SEQ + gw; m < MT; m += NGW) {
        f32x4 v[4]; float s = 0.f;
        if (m < SEQ) {
#pragma unroll
            for (int j = 0; j < 2; ++j) { const u32x4 w = *(const u32x4*)(T + (size_t)m * DM + 8 * F.lane + 512 * j);
                v[2 * j] = (f32x4){bflo(w.x), bfhi(w.x), bflo(w.y), bfhi(w.y)}; v[2 * j + 1] = (f32x4){bflo(w.z), bfhi(w.z), bflo(w.w), bfhi(w.w)}; }
        } else {
            const float* sl = (const float*)(F.ws + WS_SLAB) + (size_t)(m - SEQ) * DM; const float* gp = mod + (size_t)(1 + ((m - SEQ) >> 4)) * 6144 + gate_off;
#pragma unroll
            for (int q = 0; q < 4; ++q) { const int k = 8 * F.lane + 512 * (q >> 1) + 4 * (q & 1); f32x4 a = (f32x4){0.f, 0.f, 0.f, 0.f};
                for (int ks = 0; ks < KS; ++ks) a += *(const f32x4*)(sl + (size_t)ks * NSMP * DM + k);
                f32x4 bs;
                if (FINAL) { const u32x2 w = *(const u32x2*)(X1B + (size_t)m * DM + k); bs = (f32x4){bflo(w.x), bfhi(w.x), bflo(w.y), bfhi(w.y)}; }
                else bs = *(const f32x4*)(F.in[I_XS] + (size_t)(m - SEQ) * DM + k);
                v[q] = bs * ALPHA + *(const f32x4*)(gp + k) * a; } }
#pragma unroll
        for (int q = 0; q < 4; ++q) s += (v[q][0] + v[q][1]) + (v[q][2] + v[q][3]);
        const float mean = wave_sum(s) * (1.f / DM); float s2 = 0.f;
#pragma unroll
        for (int q = 0; q < 4; ++q) { v[q] = v[q] - mean; s2 += (v[q][0] * v[q][0] + v[q][1] * v[q][1]) + (v[q][2] * v[q][2] + v[q][3] * v[q][3]); }
        const float rstd = 1.f / sqrtf(wave_sum(s2) * (1.f / DM) + LN_EPS);
        const int rb = m >= SEQ ? 1 + ((m - SEQ) >> 4) : 0;
#pragma unroll
        for (int q = 0; q < 4; ++q) { const int k = 8 * F.lane + 512 * (q >> 1) + 4 * (q & 1); const f32x4 gg = *(const f32x4*)(g + k), bb = *(const f32x4*)(b + k);
            const f32x4 y = v[q] * rstd * gg + bb;
            if (FINAL) *(f32x4*)(F.out + (size_t)m * DM + k) = y;
            else { u32x2 w; w.x = pk2(y[0], y[1]); w.y = pk2(y[2], y[3]); *(u32x2*)(X1B + (size_t)m * DM + k) = w;
                const f32x4 s2v = *(const f32x4*)(mod + (size_t)rb * 6144 + 4096 + k), t2v = *(const f32x4*)(mod + (size_t)rb * 6144 + 3072 + k);
                const f32x4 h = y * (s2v + 1.0f) + t2v; u32x2 w2; w2.x = pk2(h[0], h[1]); w2.y = pk2(h[2], h[3]); *(u32x2*)(XN + (size_t)m * DM + k) = w2; } }
    }
}

__device__ __forceinline__ int t5_bucket(int rel) {
    const int n = rel < 0 ? -rel : rel; int b;
    if (n < 8) b = n; else if (n < 12) b = 8; else if (n < 16) b = 9; else if (n < 23) b = 10; else if (n < 32) b = 11; else if (n < 46) b = 12; else if (n < 64) b = 13; else if (n < 91) b = 14; else b = 15;
    return b + (rel > 0 ? 16 : 0);
}
constexpr int AT_KB = 8192, AT_VB = 20480, AT_BUF = AT_KB + AT_VB;
constexpr int AT_WS = 2 * AT_BUF, AT_OST = AT_WS + 2048, AT_KEEP = 98304, AT_TAB = 131072, AT_MISC = AT_TAB + 4 * 192 * 4, AT_END = AT_MISC + 64;
__device__ __forceinline__ s16x4 vtr(const LAS char* p) { typedef short v4i16_t __attribute__((ext_vector_type(4))); return __builtin_bit_cast(s16x4, __builtin_amdgcn_ds_read_tr16_b64_v4i16((LAS v4i16_t*)p)); }

typedef __bf16 bf16x2_t_ __attribute__((ext_vector_type(2)));
__device__ __forceinline__ unsigned cvtpk_(float lo, float hi) { f32x2 v = {lo, hi}; bf16x2_t_ b = __builtin_convertvector(v, bf16x2_t_); return __builtin_bit_cast(unsigned, b); }
__device__ __forceinline__ void glds16_asm(const void* gsrc, unsigned lds_dst) { unsigned keep;
    asm volatile("s_mov_b32 %0, m0\n\ts_mov_b32 m0, %2\n\ts_nop 0\n\tglobal_load_lds_dwordx4 %1, off\n\ts_mov_b32 m0, %0" : "=&s"(keep) : "v"(gsrc), "s"(lds_dst) : "memory"); }
template <int OFF> __device__ __forceinline__ void glds16_asm_off(const void* gsrc, unsigned lds_dst) { unsigned keep;
    asm volatile("s_mov_b32 %0, m0\n\ts_mov_b32 m0, %2\n\ts_nop 0\n\tglobal_load_lds_dwordx4 %1, off offset:%3\n\ts_mov_b32 m0, %0" : "=&s"(keep) : "v"(gsrc), "s"(lds_dst), "i"(OFF) : "memory"); }
template <int OFF> __device__ __forceinline__ void glds16_s(const void* sbase, unsigned voff, unsigned lds_dst) { unsigned keep;
    asm volatile("s_mov_b32 %0, m0\n\ts_mov_b32 m0, %3\n\ts_nop 0\n\tglobal_load_lds_dwordx4 %1, %2 offset:%4\n\ts_mov_b32 m0, %0" : "=&s"(keep) : "v"(voff), "s"(sbase), "s"(lds_dst), "i"(OFF) : "memory"); }
__device__ __forceinline__ void glds4_s(const void* sbase, unsigned voff, unsigned lds_dst) { unsigned keep;
    asm volatile("s_mov_b32 %0, m0\n\ts_mov_b32 m0, %3\n\ts_nop 0\n\tglobal_load_lds_dword %1, %2\n\ts_mov_b32 m0, %0" : "=&s"(keep) : "v"(voff), "s"(sbase), "s"(lds_dst) : "memory"); }
__device__ __forceinline__ const void* uniform_ptr(const void* p) { const unsigned long long v = (unsigned long long)p;
    const unsigned lo = (unsigned)__builtin_amdgcn_readfirstlane((int)(unsigned)v), hi = (unsigned)__builtin_amdgcn_readfirstlane((int)(unsigned)(v >> 32)); return (const void*)(((unsigned long long)hi << 32) | lo); }
__device__ __forceinline__ void glds4_asm(const void* gsrc, unsigned lds_dst) { unsigned keep;
    asm volatile("s_mov_b32 %0, m0\n\ts_mov_b32 m0, %2\n\ts_nop 0\n\tglobal_load_lds_dword %1, off\n\ts_mov_b32 m0, %0" : "=&s"(keep) : "v"(gsrc), "s"(lds_dst) : "memory"); }
constexpr int R_V = 0, R_K = 49152, R_F = 73728, R_WS = 79872;
__device__ __forceinline__ float max3f_(float a, float b, float c) { float r; asm("v_max3_f32 %0, %1, %2, %3" : "=v"(r) : "v"(a), "v"(b), "v"(c)); return r; }
__device__ __forceinline__ float max2f_(float a, float b) { float r; asm("v_max_f32_e32 %0, %1, %2" : "=v"(r) : "v"(a), "v"(b)); return r; }
#define AP3_PIN(x) asm volatile("" : "+v"(x))
template <int MODE, int DV, int pv = 0, bool SREF = false>
__device__ __forceinline__ void attn_pass3(Frame& F, const bf16_t* Q, const bf16_t* K, const bf16_t* V, int q0, int NT, const float* Fh, int hb, f32x16 (&o)[DV / 32], int t0 = 0) {
    constexpr int NDB = DV / 32, VS = DV * 128, EPG = 8 / NDB;
    constexpr float THR = 8.0f;
    const int lane = F.lane, r32 = lane & 31, hi = lane >> 5, wid = F.wave;
    const LAS char* lds = (const LAS char*)F.lds;
    LAS float* wsf = (LAS float*)(F.lds + R_WS) + wid * 64;
    const LAS float* tab = (const LAS float*)(F.lds + AT_TAB) + hb * 192;
    const int qrow = q0 + wid * 32 + r32;
    const int tmaxw = (q0 >> 6) + (wid >> 1);
    const char* Ku = (const char*)uniform_ptr(K); const char* Vu = (const char*)uniform_ptr(V); const char* Fu = (const char*)uniform_ptr(MODE == 0 ? (const void*)Fh : (const void*)K);
    const unsigned kvo = (unsigned)(((8 * wid + (lane >> 3)) * 512 + (((lane & 7) ^ (lane >> 3)) << 3)) * 2);
    const unsigned vvo = (unsigned)(((16 * (wid & 3) + (lane >> 2)) * 512 + 32 * (wid >> 2) + 8 * (lane & 3)) * 2);
    const unsigned fvo = (unsigned)(lane * 4);
    const unsigned lds0 = (unsigned)(size_t)F.lds;
    const unsigned dk = (unsigned)__builtin_amdgcn_readfirstlane((int)(lds0 + R_K + wid * 1024)), dv = (unsigned)__builtin_amdgcn_readfirstlane((int)(lds0 + R_V + wid * 1024)),
                   df = (unsigned)__builtin_amdgcn_readfirstlane((int)(lds0 + R_F + wid * 256));
#define AP_ISSUE_K(t, SL) do { glds16_s<0>(Ku + (size_t)(t) * 65536, kvo, dk + (SL) * 8192); if (MODE == 0) glds4_s(Fu + (size_t)(t) * 256, fvo, df + (SL) * 2048); } while (0)
#define AP_ISSUE_V(t, SL) do { glds16_s<0>(Vu + (size_t)(t) * 65536, vvo, dv + (SL) * VS); if (DV == 128) glds16_s<0>(Vu + (size_t)(t) * 65536 + 128, vvo, dv + (SL) * VS + 8192); } while (0)
#define AP_BATCH(t, SL) do { if (pv != 1) { if ((t) + 2 < NT) AP_ISSUE_K((t) + 2, ((SL) + 2) % 3); if ((t) + 1 < NT) AP_ISSUE_V((t) + 1, ((SL) + 1) % 3); } } while (0)
    AP_ISSUE_K(t0, 0); AP_ISSUE_K(t0 + 1, 1); AP_ISSUE_V(t0, 0);
    bf16x8 qr[4];
#pragma unroll
    for (int d0 = 0; d0 < 4; ++d0) qr[d0] = *(const bf16x8*)(Q + (size_t)qrow * 512 + d0 * 16 + hi * 8);
    float fqp = MODE == 0 ? Fh[qrow] : 0.f;
#pragma unroll
    for (int d = 0; d < NDB; ++d) o[d] = f32x16{};
    float m_hat = 0.f, l_run = 0.f;
    f32x16 p0, p1, negm; u32x4 pwv[4];
#pragma unroll
    for (int r = 0; r < 16; ++r) negm[r] = 0.f;
#pragma unroll
    for (int i = 0; i < 4; ++i) pwv[i] = (u32x4){0u, 0u, 0u, 0u};
    const LAS char* kb4[4];
#pragma unroll
    for (int d0 = 0; d0 < 4; ++d0) kb4[d0] = lds + R_K + r32 * 128 + (((2 * d0 + hi) ^ (r32 & 7)) << 4);
    const LAS char* vb1 = lds + R_V + (4 * hi + ((lane & 15) >> 2)) * 64 + (((lane >> 4) & 1) * 16 + (lane & 3) * 4) * 2;
    const LAS char* fb1 = lds + R_F + wid * 256 + 16 * hi;
    asm volatile("s_waitcnt vmcnt(0)" ::: "memory");
    asm volatile("" : "+v"(qr[0]), "+v"(qr[1]), "+v"(qr[2]), "+v"(qr[3]), "+v"(fqp));
    asm volatile("s_waitcnt lgkmcnt(0)\n\ts_barrier" ::: "memory");
#define AP3_VFL(buf, ks, SLV) do { _Pragma("unroll") for (int d = 0; d < NDB; ++d) { buf[2 * d] = vtr(vb1 + (SLV) * VS + d * 4096 + (ks) * 1024); buf[2 * d + 1] = vtr(vb1 + (SLV) * VS + d * 4096 + (ks) * 1024 + 512); } } while (0)
#define AP3_VFL1(buf, d, ks, SLV) do { buf[2 * (d)] = vtr(vb1 + (SLV) * VS + (d) * 4096 + (ks) * 1024); buf[2 * (d) + 1] = vtr(vb1 + (SLV) * VS + (d) * 4096 + (ks) * 1024 + 512); } while (0)
#define AP3_FRAG(buf, d) ((bf16x8){buf[2 * (d)][0], buf[2 * (d)][1], buf[2 * (d)][2], buf[2 * (d)][3], buf[2 * (d) + 1][0], buf[2 * (d) + 1][1], buf[2 * (d) + 1][2], buf[2 * (d) + 1][3]})
#define AP3_GAP(ks, d, VCUR, VNXT, PC, BC, PP, BP, HASPREV, HASNEXT, SLV) do { \
        o[d] = __builtin_amdgcn_mfma_f32_32x32x16_bf16(__builtin_bit_cast(bf16x8, pwv[ks]), AP3_FRAG(VCUR, d), o[d], 0, 0, 0); \
        if (HASNEXT) AP3_VFL1(VNXT, d, (ks) + 1, SLV); \
        _Pragma("unroll") for (int e = 0; e < EPG; ++e) { PC[(BC) + EPG * (d) + e] = __builtin_amdgcn_exp2f(PC[(BC) + EPG * (d) + e]); } \
        if (HASPREV) { _Pragma("unroll") for (int e = 0; e < EPG; ++e) rs += PP[(BP) + EPG * (d) + e]; \
            _Pragma("unroll") for (int e = 0; e < EPG / 2; ++e) pwv[(ks) - 1][(EPG / 2) * (d) + e] = cvtpk_(PP[(BP) + EPG * (d) + 2 * e], PP[(BP) + EPG * (d) + 2 * e + 1]); AP3_PIN(rs); } \
        AP3_PIN(PC); \
        __builtin_amdgcn_sched_barrier(0); } while (0)
#define AP3_GROUP(ks, VCUR, VNXT, PC, BC, PP, BP, HASPREV, HASNEXT, SLV) do { _Pragma("unroll") for (int d = 0; d < NDB; ++d) AP3_GAP(ks, d, VCUR, VNXT, PC, BC, PP, BP, HASPREV, HASNEXT, SLV); } while (0)
#define AP3_OCT(PC, BC, KS) do { _Pragma("unroll") for (int e = 0; e < 8; ++e) { PC[(BC) + e] = __builtin_amdgcn_exp2f(PC[(BC) + e]); rs += PC[(BC) + e]; } \
        _Pragma("unroll") for (int e = 0; e < 4; ++e) pwv[KS][e] = cvtpk_(PC[(BC) + 2 * e], PC[(BC) + 2 * e + 1]); } while (0)
#define AP3_KRD(i, SL) (*(const LAS bf16x8*)(kb4[(i) >> 1] + (SL) * 8192 + ((i) & 1) * 4096))
#define AP3_MM(KF, d0, P) P = __builtin_amdgcn_mfma_f32_32x32x16_bf16(KF, qr[d0], P, 0, 0, 0)
#define AP3_QKF(SL) do { bf16x8 ka = AP3_KRD(0, SL), kb = AP3_KRD(1, SL), kc = AP3_KRD(2, SL); \
        if (MODE == 0) { \
            _Pragma("unroll") for (int g4 = 0; g4 < 4; ++g4) { const f32x4 fa = *(const LAS f32x4*)(fb1 + (SL) * 2048 + 32 * g4), fb = *(const LAS f32x4*)(fb1 + (SL) * 2048 + 128 + 32 * g4); \
                _Pragma("unroll") for (int e = 0; e < 4; ++e) { p0[4 * g4 + e] = fqp - fa[e]; p1[4 * g4 + e] = fqp - fb[e]; } } \
        } else { p0 = f32x16{}; p1 = f32x16{}; } \
        __builtin_amdgcn_sched_barrier(0); \
        AP3_MM(ka, 0, p0); ka = AP3_KRD(3, SL); __builtin_amdgcn_sched_barrier(0); \
        AP3_MM(kb, 0, p1); kb = AP3_KRD(4, SL); __builtin_amdgcn_sched_barrier(0); \
        AP3_MM(kc, 1, p0); kc = AP3_KRD(5, SL); __builtin_amdgcn_sched_barrier(0); \
        AP3_MM(ka, 1, p1); ka = AP3_KRD(6, SL); __builtin_amdgcn_sched_barrier(0); \
        AP3_MM(kb, 2, p0); kb = AP3_KRD(7, SL); __builtin_amdgcn_sched_barrier(0); \
        AP3_MM(kc, 2, p1); __builtin_amdgcn_sched_barrier(0); \
        AP3_MM(ka, 3, p0); __builtin_amdgcn_sched_barrier(0); \
        AP3_MM(kb, 3, p1); \
        asm volatile("" : "+v"(p0), "+v"(p1)); \
    } while (0)
#define AP3_QKS(SL) do { bf16x8 kf[8]; \
        _Pragma("unroll") for (int d0 = 0; d0 < 4; ++d0) { kf[2 * d0] = *(const LAS bf16x8*)(kb4[d0] + (SL) * 8192); kf[2 * d0 + 1] = *(const LAS bf16x8*)(kb4[d0] + (SL) * 8192 + 4096); } \
        if (MODE == 0) { const float sft = fqp - m_hat; \
            _Pragma("unroll") for (int g4 = 0; g4 < 4; ++g4) { const f32x4 fa = *(const LAS f32x4*)(fb1 + (SL) * 2048 + 32 * g4), fb = *(const LAS f32x4*)(fb1 + (SL) * 2048 + 128 + 32 * g4); \
                _Pragma("unroll") for (int e = 0; e < 4; ++e) { p0[4 * g4 + e] = sft - fa[e]; p1[4 * g4 + e] = sft - fb[e]; } } \
            _Pragma("unroll") for (int d0 = 0; d0 < 4; ++d0) { p0 = __builtin_amdgcn_mfma_f32_32x32x16_bf16(kf[2 * d0], qr[d0], p0, 0, 0, 0); p1 = __builtin_amdgcn_mfma_f32_32x32x16_bf16(kf[2 * d0 + 1], qr[d0], p1, 0, 0, 0); } \
        } else { \
            if constexpr (SREF) { p0 = __builtin_amdgcn_mfma_f32_32x32x16_bf16(kf[0], qr[0], f32x16{}, 0, 0, 0); p1 = __builtin_amdgcn_mfma_f32_32x32x16_bf16(kf[1], qr[0], f32x16{}, 0, 0, 0); } \
            else { p0 = __builtin_amdgcn_mfma_f32_32x32x16_bf16(kf[0], qr[0], negm, 0, 0, 0); p1 = __builtin_amdgcn_mfma_f32_32x32x16_bf16(kf[1], qr[0], negm, 0, 0, 0); } \
            _Pragma("unroll") for (int d0 = 1; d0 < 4; ++d0) { p0 = __builtin_amdgcn_mfma_f32_32x32x16_bf16(kf[2 * d0], qr[d0], p0, 0, 0, 0); p1 = __builtin_amdgcn_mfma_f32_32x32x16_bf16(kf[2 * d0 + 1], qr[d0], p1, 0, 0, 0); } } \
        if constexpr (SREF) asm volatile("" : "+v"(p0), "+v"(p1)); else asm volatile("s_nop 15\n\ts_nop 7" : "+v"(p0), "+v"(p1));     \
    } while (0)
#define AP3_QK(SL) do { if constexpr (SREF) AP3_QKF(SL); else AP3_QKS(SL); } while (0)
#define AP3_DECIDE(WITH_TAB) do { \
        if (MODE == 0) { \
            if (t * 64 + 63 > q0 + wid * 32) { const int ln_ = lane_id_opaque(), kv0 = t * 64 + 4 * (ln_ >> 5), qrow_ = q0 + wid * 32 + (ln_ & 31);     \
                _Pragma("unroll") for (int r = 0; r < 16; ++r) { const int kv = kv0 + (r & 3) + 8 * (r >> 2); if (kv > qrow_) p0[r] = -1e30f; if (kv + 32 > qrow_) p1[r] = -1e30f; } } \
        } else if (WITH_TAB) { \
            if (near) { const int ln_ = lane_id_opaque(), kv0 = t * 64 + 4 * (ln_ >> 5), qrow_ = q0 + wid * 32 + (ln_ & 31); const LAS float* tab_ = (const LAS float*)(F.lds + AT_TAB) + hb * 192; \
                _Pragma("unroll") for (int g4 = 0; g4 < 4; ++g4) { \
                    _Pragma("unroll") for (int e = 0; e < 4; ++e) { const int r = 4 * g4 + e; const int rel = kv0 + e + 8 * g4 - qrow_; int i0 = rel + 128, i1 = rel + 160; i0 = i0 < 0 ? 0 : i0; i1 = i1 < 0 ? 0 : i1; \
                        p0[r] += tab_[i0]; p1[r] += tab_[i1]; } \
                    __builtin_amdgcn_sched_barrier(0); } } } \
        if constexpr (!SREF) { \
        float ma = max3f_(p0[0], p0[1], p1[0]), mb = max3f_(p0[2], p0[3], p1[1]); ma = max3f_(ma, p1[2], p1[3]); \
        _Pragma("unroll") for (int r = 4; r < 16; r += 4) { ma = max3f_(ma, p0[r], p0[r + 1]); mb = max3f_(mb, p0[r + 2], p0[r + 3]); ma = max3f_(ma, p1[r], p1[r + 1]); mb = max3f_(mb, p1[r + 2], p1[r + 3]); } \
        float rm = max2f_(ma, mb); \
        { auto rr = __builtin_amdgcn_permlane32_swap(__float_as_uint(rm), __float_as_uint(rm), false, false); rm = max2f_(__uint_as_float(rr[0]), __uint_as_float(rr[1])); } \
        resc = (tz == t0) || __any(rm > THR); \
        if (resc) { const float dl = tz == t0 ? rm : fmaxf(rm, 0.f); m_hat += dl; \
            _Pragma("unroll") for (int r = 0; r < 16; ++r) { p0[r] -= dl; p1[r] -= dl; } \
            if (MODE == 1) { const float nm_ = -m_hat; _Pragma("unroll") for (int r = 0; r < 16; ++r) negm[r] = nm_; } \
            al = tz == t0 ? 1.0f : __builtin_amdgcn_exp2f(-dl); l_run *= al; } } } while (0)
#define AP3_STEP(tt, SL) do { const int t = (tt); if (t > NT) break; int tz = t; asm volatile("" : "+s"(tz)); \
        if (t < NT) AP_BATCH(t, SL); \
        const bool doPV = tz > t0 && t - 1 <= tmaxw, doQK = t < NT && t <= tmaxw; \
        bool resc = false; float al = 1.0f, rs = 0.f; \
        const bool near = MODE == 1 && (t * 64 + 63 + 91 > q0 + wid * 32); \
        if (doQK) AP3_QK(SL); else { p0 = f32x16{}; p1 = f32x16{}; }     \
        __builtin_amdgcn_sched_barrier(0); \
        if (doQK) AP3_DECIDE(true); \
        __builtin_amdgcn_sched_barrier(0); \
        if (doPV) { s16x4 vfa[2 * NDB]; AP3_VFL(vfa, 0, ((SL) + 2) % 3);     \
            AP3_GROUP(0, vfa, vfa, p0, 0, p0, 0, false, true, ((SL) + 2) % 3); \
            AP3_GROUP(1, vfa, vfa, p0, 8, p0, 0, true, true, ((SL) + 2) % 3); \
            AP3_GROUP(2, vfa, vfa, p1, 0, p0, 8, true, true, ((SL) + 2) % 3); \
            AP3_GROUP(3, vfa, vfa, p1, 8, p1, 0, true, false, ((SL) + 2) % 3); \
            _Pragma("unroll") for (int e = 0; e < 8; ++e) rs += p1[8 + e]; \
            _Pragma("unroll") for (int e = 0; e < 4; ++e) pwv[3][e] = cvtpk_(p1[8 + 2 * e], p1[8 + 2 * e + 1]); \
        } else if (doQK) { AP3_OCT(p0, 0, 0); AP3_OCT(p0, 8, 1); AP3_OCT(p1, 0, 2); AP3_OCT(p1, 8, 3); } \
        if (doQK) l_run += rs; \
          \
        if (resc && tz > t0) { \
            if (hi == 0) wsf[r32] = al; \
            asm volatile("s_waitcnt lgkmcnt(0)" ::: "memory"); \
            _Pragma("unroll") for (int g4 = 0; g4 < 4; ++g4) { const f32x4 a4 = *(const LAS f32x4*)(wsf + 8 * g4 + 4 * hi); \
                _Pragma("unroll") for (int d = 0; d < NDB; ++d) \
                    _Pragma("unroll") for (int e = 0; e < 4; ++e) o[d][4 * g4 + e] *= a4[e]; } } \
        if (t == NT) break; \
        if (pv == 6) { if (t + 2 < NT) asm volatile("s_waitcnt vmcnt(3) lgkmcnt(0)" ::: "memory"); else asm volatile("s_waitcnt vmcnt(0) lgkmcnt(0)" ::: "memory"); } \
        else { if (t + 2 < NT) asm volatile("s_waitcnt vmcnt(3) lgkmcnt(0)\n\ts_barrier" ::: "memory"); else asm volatile("s_waitcnt vmcnt(0) lgkmcnt(0)\n\ts_barrier" ::: "memory"); } \
    } while (0)
#define AP3_FSTEP(tt, SL) do { const int t = (tt); \
        AP_ISSUE_K(t + 2, ((SL) + 2) % 3); AP_ISSUE_V(t + 1, ((SL) + 1) % 3); \
        float rs = 0.f; \
        AP3_QKF(SL); \
        __builtin_amdgcn_sched_barrier(0); \
        { s16x4 vfa[2 * NDB]; AP3_VFL(vfa, 0, ((SL) + 2) % 3); \
          AP3_GROUP(0, vfa, vfa, p0, 0, p0, 0, false, true, ((SL) + 2) % 3); \
          AP3_GROUP(1, vfa, vfa, p0, 8, p0, 0, true, true, ((SL) + 2) % 3); \
          AP3_GROUP(2, vfa, vfa, p1, 0, p0, 8, true, true, ((SL) + 2) % 3); \
          AP3_GROUP(3, vfa, vfa, p1, 8, p1, 0, true, false, ((SL) + 2) % 3); \
          _Pragma("unroll") for (int e = 0; e < 8; ++e) rs += p1[8 + e]; \
          _Pragma("unroll") for (int e = 0; e < 4; ++e) pwv[3][e] = cvtpk_(p1[8 + 2 * e], p1[8 + 2 * e + 1]); } \
        l_run += rs; \
        asm volatile("s_waitcnt vmcnt(3) lgkmcnt(0)\n\ts_barrier" ::: "memory"); \
    } while (0)
    if (wid >= 4) __builtin_amdgcn_s_setprio(1);
    int t3 = t0;
    if constexpr (SREF && pv == 0) {
        AP3_STEP(t3, 0); AP3_STEP(t3 + 1, 1); AP3_STEP(t3 + 2, 2); t3 += 3;
        const int tfe = (q0 >> 6) - (MODE == 0 ? 1 : 3);
        for (; t3 + 2 <= tfe; t3 += 3) { AP3_FSTEP(t3, 0); AP3_FSTEP(t3 + 1, 1); AP3_FSTEP(t3 + 2, 2); }
    }
    for (; t3 <= NT; t3 += 3) { AP3_STEP(t3, 0); AP3_STEP(t3 + 1, 1); AP3_STEP(t3 + 2, 2); }
    if (wid >= 4) __builtin_amdgcn_s_setprio(0);
    asm volatile("s_waitcnt lgkmcnt(0)\n\ts_barrier" ::: "memory");
    l_run += __shfl_xor(l_run, 32);
    if (hi == 0) wsf[r32] = 1.0f / l_run;
    asm volatile("s_waitcnt lgkmcnt(0)" ::: "memory");
#pragma unroll
    for (int g4 = 0; g4 < 4; ++g4) { const f32x4 a4 = *(const LAS f32x4*)(wsf + 8 * g4 + 4 * hi);
#pragma unroll
        for (int d = 0; d < NDB; ++d)
#pragma unroll
            for (int e = 0; e < 4; ++e) o[d][4 * g4 + e] *= a4[e]; }
#undef AP_ISSUE_K
#undef AP_ISSUE_V
#undef AP_BATCH
#undef AP3_VFL
#undef AP3_VFL1
#undef AP3_FRAG
#undef AP3_GAP
#undef AP3_GROUP
#undef AP3_OCT
#undef AP3_STEP
#undef AP3_FSTEP
#undef AP3_QK
#undef AP3_QKF
#undef AP3_QKS
#undef AP3_KRD
#undef AP3_MM
#undef AP3_DECIDE
}

template <int NDB> __device__ __forceinline__ void store_o(const f32x16 (&o)[NDB], LAS unsigned char* stgb  , bf16_t* dst  , int ld, int lane) {
    const int r32 = lane & 31, hi = lane >> 5;
    constexpr int DVC = 32 * NDB;
    LAS bf16_t* stg = (LAS bf16_t*)stgb;
#pragma unroll
    for (int d = 0; d < NDB; ++d)
#pragma unroll
        for (int r = 0; r < 16; ++r) { const int row = (r & 3) + 8 * (r >> 2) + 4 * hi; stg[row * DVC + 32 * d + r32] = (bf16_t)f2bf(o[d][r]); }
    asm volatile("s_waitcnt lgkmcnt(0)" ::: "memory");
    constexpr int CPR = DVC / 8;
#pragma unroll
    for (int i = 0; i < (32 * CPR) / 64; ++i) { const int c = i * 64 + lane, row = c / CPR, ch = c % CPR;
        const u32x4 v = *(const LAS u32x4*)(stg + row * DVC + ch * 8); *(u32x4*)(dst + (size_t)row * ld + ch * 8) = v; }
    asm volatile("s_waitcnt lgkmcnt(0)" ::: "memory");
}

__device__ __forceinline__ float lambda_full(Frame& F) {
    const int l = lane_id_opaque() & 63;
    const float a = wave_sum(F.in[I_LQ1][l] * F.in[I_LK1][l]), b = wave_sum(F.in[I_LQ2][l] * F.in[I_LK2][l]);
    return __expf(a) - __expf(b) + 0.2f;
}

template <int pv = 0> __device__ __forceinline__ void attn_prompt_fox(Frame& F, int h, int qb) {
    const bf16_t* Q = (const bf16_t*)(F.ws + WS_QB) + h * 64; const bf16_t* K = (const bf16_t*)(F.ws + WS_KB) + h * 64; const bf16_t* V = (const bf16_t*)(F.ws + WS_VB) + h * 64;
    f32x16 o[2];
    const float* Fh = (const float*)(F.ws + WS_FP) + (size_t)h * SEQ;
    int t0 = 0; bool fast;
    { const unsigned* nw = (const unsigned*)(F.ws + WS_CTL) + 256;
      const float qn2 = __uint_as_float(nw[h * 2]) + __uint_as_float(nw[h * 2 + 1]), kn2 = __uint_as_float(nw[16 + h * 2]) + __uint_as_float(nw[16 + h * 2 + 1]);
      const float B = sqrtf(qn2 * kn2) * 1.02f + 0.5f;
      const float thresh = -40.0f - 2.0f * B;
      fast = __builtin_amdgcn_readfirstlane(B <= 60.0f ? 1 : 0) != 0;
      volatile LAS int* cnt = (volatile LAS int*)(F.lds + AT_MISC + 32);
      __syncthreads();
      if (F.tid < 256) { const int t = F.tid; const bool sk = t < 4 * qb && (Fh[qb * 256] - Fh[64 * t + 63]) <= thresh;
          const int c = __popcll(__ballot(sk)); if (F.lane == 0) cnt[F.wave] = c; }
      __syncthreads();
      t0 = cnt[0] + cnt[1] + cnt[2] + cnt[3]; t0 -= t0 % 3; }
    if (fast) attn_pass3<0, 64, pv, true>(F, Q, K, V, qb * 256, 4 * qb + 4, Fh, 0, o, t0); else attn_pass3<0, 64, pv, false>(F, Q, K, V, qb * 256, 4 * qb + 4, Fh, 0, o, t0);
    if (pv != 0 && o[0][0] != 1234.5678f) { __syncthreads(); return; }
    bf16_t* AB = (bf16_t*)(F.ws + WS_AB);
    store_o<2>(o, F.lds + F.wave * 8192, AB + (size_t)(qb * 256 + F.wave * 32) * DM + 512 + h * 64, DM, F.lane);
    __syncthreads();
}
template <int pv = 0> __device__ __forceinline__ void attn_prompt_diff_half(Frame& F, int h, int half, int qb) {
    const bf16_t* Q = (const bf16_t*)(F.ws + WS_QA) + h * 128 + 64 * half; const bf16_t* K = (const bf16_t*)(F.ws + WS_KA) + h * 128 + 64 * half; const bf16_t* V = (const bf16_t*)(F.ws + WS_VA) + h * 128;
    f32x16 o[4];
    bool fast;
    { const unsigned* nw = (const unsigned*)(F.ws + WS_CTL) + 288; const int hh = h * 2 + half;
      const float qn2 = __uint_as_float(nw[hh * 2]) + __uint_as_float(nw[hh * 2 + 1]), kn2 = __uint_as_float(nw[16 + hh * 2]) + __uint_as_float(nw[16 + hh * 2 + 1]);
      float bm = 0.f; for (int b = 0; b < 32; ++b) bm = fmaxf(bm, fabsf(F.in[I_RELB][b * 4 + h] - F.in[I_RELB][15 * 4 + h]));
      const float B = sqrtf(qn2 * kn2) * 1.02f + 0.5f + bm * LOG2E;
      fast = __builtin_amdgcn_readfirstlane(B <= 60.0f ? 1 : 0) != 0; }
    if (fast) attn_pass3<1, 128, pv, true>(F, Q, K, V, qb * 256, 4 * qb + 4, nullptr, h, o); else attn_pass3<1, 128, pv, false>(F, Q, K, V, qb * 256, 4 * qb + 4, nullptr, h, o);
    if (pv != 0 && o[0][0] != 1234.5678f) { __syncthreads(); return; }
    bf16_t* OD = (bf16_t*)(F.ws + (half ? WS_OD2 : WS_OD1));
    store_o<4>(o, F.lds + F.wave * 8192, OD + (size_t)(qb * 256 + F.wave * 32) * 512 + h * 128, 512, F.lane);
    __syncthreads();
}
constexpr int PF_STR = 66, PD_STR = 130;
__device__ __forceinline__ void p_combine(Frame& F) {
    const float lam = lambda_full(F);
    const bf16_t* O1 = (const bf16_t*)(F.ws + WS_OD1); const bf16_t* O2 = (const bf16_t*)(F.ws + WS_OD2); bf16_t* AB = (bf16_t*)(F.ws + WS_AB);
    const int gw = F.bid * 8 + F.wave, NGW = F.G * 8;
    const int c0 = 8 * F.lane;
    float sg[8];
#pragma unroll
    for (int i = 0; i < 8; ++i) sg[i] = F.in[I_SUBG][(c0 & 127) + i] * 0.8f;
    for (int m0 = gw; m0 < SEQ; m0 += 4 * NGW) {
        u32x4 a[4], b[4];
#pragma unroll
        for (int r = 0; r < 4; ++r) { const int m = m0 + r * NGW; if (m < SEQ) { a[r] = *(const u32x4*)(O1 + (size_t)m * 512 + c0); b[r] = *(const u32x4*)(O2 + (size_t)m * 512 + c0); } else { a[r] = (u32x4){0u, 0u, 0u, 0u}; b[r] = a[r]; } }
#pragma unroll
        for (int r = 0; r < 4; ++r) { const int m = m0 + r * NGW;
            float v[8];
            v[0] = bflo(a[r].x) - lam * bflo(b[r].x); v[1] = bfhi(a[r].x) - lam * bfhi(b[r].x); v[2] = bflo(a[r].y) - lam * bflo(b[r].y); v[3] = bfhi(a[r].y) - lam * bfhi(b[r].y);
            v[4] = bflo(a[r].z) - lam * bflo(b[r].z); v[5] = bfhi(a[r].z) - lam * bfhi(b[r].z); v[6] = bflo(a[r].w) - lam * bflo(b[r].w); v[7] = bfhi(a[r].w) - lam * bfhi(b[r].w);
            float ss = 0.f;
#pragma unroll
            for (int i = 0; i < 8; ++i) ss += v[i] * v[i];
#pragma unroll
            for (int ofs = 1; ofs < 16; ofs <<= 1) ss += __shfl_xor(ss, ofs);
            const float rn = 1.0f / sqrtf(ss * (1.0f / 128.0f) + LN_EPS);
            u32x4 w; w.x = pk2(v[0] * rn * sg[0], v[1] * rn * sg[1]); w.y = pk2(v[2] * rn * sg[2], v[3] * rn * sg[3]); w.z = pk2(v[4] * rn * sg[4], v[5] * rn * sg[5]); w.w = pk2(v[6] * rn * sg[6], v[7] * rn * sg[7]);
            if (m < SEQ) *(u32x4*)(AB + (size_t)m * DM + c0) = w; }
    }
    for (int it = F.bid; it < NSMP; it += F.G) {
        const int b = it >> 4, q = it & 15; const size_t row = (size_t)SEQ + it;
        if (F.wave == 0) {
            const int h = F.lane >> 3, cc = (F.lane & 7) * 8; const float* P = (const float*)(F.ws + WS_PF);
            float M = -1e30f;
#pragma unroll
            for (int s = 0; s < 8; ++s) M = fmaxf(M, P[((size_t)((b * 8 + s) * 8 + h) * 16 + q) * PF_STR + 64]);
            float acc[8], L = 0.f;
#pragma unroll
            for (int i = 0; i < 8; ++i) acc[i] = 0.f;
#pragma unroll
            for (int s = 0; s < 8; ++s) { const float* pr = P + ((size_t)((b * 8 + s) * 8 + h) * 16 + q) * PF_STR; const float wgt = __builtin_amdgcn_exp2f(pr[64] - M); L += wgt * pr[65];
#pragma unroll
                for (int i = 0; i < 8; ++i) acc[i] += wgt * pr[cc + i]; }
            const float inv = 1.0f / L;
            u32x4 w; w.x = pk2(acc[0] * inv, acc[1] * inv); w.y = pk2(acc[2] * inv, acc[3] * inv); w.z = pk2(acc[4] * inv, acc[5] * inv); w.w = pk2(acc[6] * inv, acc[7] * inv);
            *(u32x4*)(AB + row * DM + 512 + c0) = w; }
        if (F.wave == 1) {
            const int h = F.lane >> 4, cc = (F.lane & 15) * 8; const float* P = (const float*)(F.ws + WS_PD);
            float v[8];
#pragma unroll
            for (int i = 0; i < 8; ++i) v[i] = 0.f;
#pragma unroll
            for (int half = 0; half < 2; ++half) {
                float M = -1e30f;
#pragma unroll
                for (int s = 0; s < 8; ++s) M = fmaxf(M, P[((size_t)((b * 8 + s) * 8 + 2 * h + half) * 16 + q) * PD_STR + 128]);
                float acc[8], L = 0.f;
#pragma unroll
                for (int i = 0; i < 8; ++i) acc[i] = 0.f;
#pragma unroll
                for (int s = 0; s < 8; ++s) { const float* pr = P + ((size_t)((b * 8 + s) * 8 + 2 * h + half) * 16 + q) * PD_STR; const float wgt = __builtin_amdgcn_exp2f(pr[128] - M); L += wgt * pr[129];
#pragma unroll
                    for (int i = 0; i < 8; ++i) acc[i] += wgt * pr[cc + i]; }
                const float sc = (half ? -lam : 1.0f) / L;
#pragma unroll
                for (int i = 0; i < 8; ++i) v[i] += acc[i] * sc; }
            float ss = 0.f;
#pragma unroll
            for (int i = 0; i < 8; ++i) ss += v[i] * v[i];
#pragma unroll
            for (int ofs = 1; ofs < 16; ofs <<= 1) ss += __shfl_xor(ss, ofs);
            const float rn = 1.0f / sqrtf(ss * (1.0f / 128.0f) + LN_EPS);
            u32x4 w; w.x = pk2(v[0] * rn * sg[0], v[1] * rn * sg[1]); w.y = pk2(v[2] * rn * sg[2], v[3] * rn * sg[3]); w.z = pk2(v[4] * rn * sg[4], v[5] * rn * sg[5]); w.w = pk2(v[6] * rn * sg[6], v[7] * rn * sg[7]);
            *(u32x4*)(AB + row * DM + c0) = w; }
    }
}

constexpr int SM_K = 0, SM_V = 32768, SM_F = 81920, SM_WS = 83968;
template <int KIND  > __device__ __forceinline__ void sample_unit(Frame& F, int b, int s) {
    constexpr int DV = KIND == 0 ? 64 : 128, NDB = DV / 32, VSTR = KIND == 0 ? 192 : 320, VSUB = 16 * VSTR;
    const int lane = lane_id_opaque(), r32 = lane & 31, hi = lane >> 5, w = F.wave, tid = w * 64 + lane;
    const LAS char* lds = (const LAS char*)F.lds;
    LAS float* wsf = (LAS float*)(F.lds + SM_WS) + w * 64;
    const int hb = KIND == 0 ? w : (w >> 1);
    const LAS float* tab = (const LAS float*)(F.lds + AT_TAB) + hb * 192;
    const int q = r32 & 15, qpos = PAST + q;
    const size_t qrow = (size_t)SEQ + b * DEC_T + q;
    const bf16_t* Qp = (const bf16_t*)(F.ws + (KIND == 0 ? WS_QB : WS_QA)) + qrow * 512 + w * 64;
    bf16x8 qr[4];
#pragma unroll
    for (int d0 = 0; d0 < 4; ++d0) qr[d0] = *(const bf16x8*)(Qp + d0 * 16 + hi * 8);
    const float* Fs = (const float*)(F.ws + WS_FS) + (size_t)(b * 8 + w) * SKV;
    const float fq = KIND == 0 ? Fs[qpos] : 0.f;
    const float* Kc = F.in[KIND == 0 ? I_CFK : I_CDK] + (size_t)b * PAST * 512; const float* Vc = F.in[KIND == 0 ? I_CFV : I_CDV] + (size_t)b * PAST * 512;
    const float* Kn = F.out + (KIND == 0 ? O_FKS : O_DKS) + (size_t)b * DEC_T * 512; const float* Vn = F.out + (KIND == 0 ? O_FVS : O_DVS) + (size_t)b * DEC_T * 512;
    const int kr = tid >> 5, c16 = (tid & 31) * 16;
    const int ksub = c16 >> 6, kch = (c16 >> 3) & 7;
    const int kdst = SM_K + ksub * 4096 + kr * 128;
    const int vdst = KIND == 0 ? SM_V + ksub * VSUB + kr * VSTR + kch * 16 : SM_V + (c16 >> 7) * VSUB + kr * VSTR + ((c16 >> 3) & 15) * 16;
    f32x16 o[NDB];
#pragma unroll
    for (int d = 0; d < NDB; ++d) o[d] = f32x16{};
    float m_run = -1e30f, l_run = 0.f;
    f32x4 gkA[4], gvA[4], gkB[4], gvB[4]; float gfA = 0.f, gfB = 0.f;
    const int nt = s == 0 ? 17 : 16;
    auto gload = [&](f32x4 (&gk)[4], f32x4 (&gv)[4], float& gf, int t) {
        const float* ks; const float* vs;
        if (t < 128) { ks = Kc + (size_t)(16 * t + kr) * 512 + c16; vs = Vc + (size_t)(16 * t + kr) * 512 + c16; }
        else { ks = Kn + (size_t)kr * 512 + c16; vs = Vn + (size_t)kr * 512 + c16; }
#pragma unroll
        for (int j = 0; j < 4; ++j) { gk[j] = *(const f32x4*)(ks + 4 * j); gv[j] = *(const f32x4*)(vs + 4 * j); }
        if (KIND == 0 && tid < 128) gf = ((const float*)(F.ws + WS_FS))[(size_t)(b * 8 + (tid >> 4)) * SKV + 16 * t + (tid & 15)];
    };
    auto lwrite = [&](const f32x4 (&gk)[4], const f32x4 (&gv)[4], float gf) {
#pragma unroll
        for (int j = 0; j < 2; ++j) { u32x4 wk, wv;
            wk.x = pk2(gk[2 * j][0], gk[2 * j][1]); wk.y = pk2(gk[2 * j][2], gk[2 * j][3]); wk.z = pk2(gk[2 * j + 1][0], gk[2 * j + 1][1]); wk.w = pk2(gk[2 * j + 1][2], gk[2 * j + 1][3]);
            wv.x = pk2(gv[2 * j][0], gv[2 * j][1]); wv.y = pk2(gv[2 * j][2], gv[2 * j][3]); wv.z = pk2(gv[2 * j + 1][0], gv[2 * j + 1][1]); wv.w = pk2(gv[2 * j + 1][2], gv[2 * j + 1][3]);
            *(LAS u32x4*)(F.lds + kdst + (((kch + j) ^ (kr & 7)) << 4)) = wk;
            *(LAS u32x4*)(F.lds + vdst + j * 16) = wv; }
        if (KIND == 0 && tid < 128) ((LAS float*)(F.lds + SM_F))[tid] = gf;
    };
    gload(gkA, gvA, gfA, s); gload(gkB, gvB, gfB, s + 8);
    __syncthreads();
    { const int sub = tid >> 6, rr = 16 + ((tid >> 2) & 15), cq = (tid & 3) * 32;
      *(LAS u32x4*)(F.lds + SM_K + sub * 4096 + rr * 128 + cq) = (u32x4){0u, 0u, 0u, 0u}; *(LAS u32x4*)(F.lds + SM_K + sub * 4096 + rr * 128 + cq + 16) = (u32x4){0u, 0u, 0u, 0u}; }
    const int vb = SM_V + (KIND == 0 ? w : (w >> 1)) * VSUB + (4 * hi + ((lane & 15) >> 2)) * VSTR + (((lane >> 4) & 1) * 16 + (lane & 3) * 4) * 2;
    auto compute = [&](int t) {
        f32x16 p0 = f32x16{};
#pragma unroll
        for (int d0 = 0; d0 < 4; ++d0) { const bf16x8 kf = *(const LAS bf16x8*)(lds + SM_K + w * 4096 + r32 * 128 + (((2 * d0 + hi) ^ (r32 & 7)) << 4));
            p0 = __builtin_amdgcn_mfma_f32_32x32x16_bf16(kf, qr[d0], p0, 0, 0, 0); }
        const int kv0 = 16 * t + 4 * hi;
        float x[8];
        if (KIND == 0) {
#pragma unroll
            for (int g4 = 0; g4 < 2; ++g4) { const f32x4 fa = *(const LAS f32x4*)(lds + SM_F + (w * 16 + 4 * hi + 8 * g4) * 4);
#pragma unroll
                for (int e = 0; e < 4; ++e) x[4 * g4 + e] = p0[4 * g4 + e] + (fq - fa[e]); }
            if (t == 128) {
#pragma unroll
                for (int r = 0; r < 8; ++r) { const int kv = kv0 + (r & 3) + 8 * (r >> 2); if (kv > qpos) x[r] = -1e30f; } }
        } else {
            if (t < 120) {
#pragma unroll
                for (int r = 0; r < 8; ++r) x[r] = p0[r];
            } else {
#pragma unroll
                for (int r = 0; r < 8; ++r) { const int kv = kv0 + (r & 3) + 8 * (r >> 2); int i0 = kv - qpos + 128; i0 = i0 < 0 ? 0 : i0; x[r] = p0[r] + tab[i0]; } }
        }
        float rm = x[0];
#pragma unroll
        for (int r = 1; r < 8; ++r) rm = fmaxf(rm, x[r]);
        rm = fmaxf(rm, __shfl_xor(rm, 32));
        const float m_new = fmaxf(m_run, rm);
        if (__any(m_new > m_run)) { const float al = __builtin_amdgcn_exp2f(m_run - m_new); l_run *= al; m_run = m_new;
            if (hi == 0) wsf[r32] = al;
            asm volatile("s_waitcnt lgkmcnt(0)" ::: "memory");
#pragma unroll
            for (int g4 = 0; g4 < 2; ++g4) { const f32x4 a4 = *(const LAS f32x4*)(wsf + 8 * g4 + 4 * hi);
#pragma unroll
                for (int d = 0; d < NDB; ++d)
#pragma unroll
                    for (int e = 0; e < 4; ++e) o[d][4 * g4 + e] *= a4[e]; } }
        float rs = 0.f;
#pragma unroll
        for (int r = 0; r < 8; ++r) { x[r] = __builtin_amdgcn_exp2f(x[r] - m_run); rs += x[r]; }
        l_run += rs;
        u32x4 w0; w0.x = pg8::cvt_pk_bf16(x[0], x[1]); w0.y = pg8::cvt_pk_bf16(x[2], x[3]); w0.z = pg8::cvt_pk_bf16(x[4], x[5]); w0.w = pg8::cvt_pk_bf16(x[6], x[7]);
        const bf16x8 pa = __builtin_bit_cast(bf16x8, w0);
#pragma unroll
        for (int d = 0; d < NDB; ++d) { const LAS char* vp = lds + vb + d * 64;
            const s16x4 lo = vtr(vp), hi4 = vtr(vp + 8 * VSTR);
            const bf16x8 vf = (bf16x8){lo[0], lo[1], lo[2], lo[3], hi4[0], hi4[1], hi4[2], hi4[3]};
            o[d] = __builtin_amdgcn_mfma_f32_32x32x16_bf16(pa, vf, o[d], 0, 0, 0); }
    };
    for (int i = 0; i < nt; i += 2) {
        const int t = s + 8 * i;
        lwrite(gkA, gvA, gfA); __syncthreads();
        if (i + 2 < nt) gload(gkA, gvA, gfA, t + 16);
        compute(t);
        __syncthreads();
        if (i + 1 >= nt) break;
        lwrite(gkB, gvB, gfB); __syncthreads();
        if (i + 3 < nt) gload(gkB, gvB, gfB, t + 24);
        compute(t + 8);
        __syncthreads();
    }
    l_run += __shfl_xor(l_run, 32);
    float* P = (float*)(F.ws + (KIND == 0 ? WS_PF : WS_PD)) + ((size_t)((b * 8 + s) * 8 + w) * 16) * (DV + 2);
    { float* P0 = P + (size_t)(4 * hi) * (DV + 2) + r32; float* P1 = P0 + 8 * (DV + 2);
#pragma unroll
      for (int d = 0; d < NDB; ++d)
#pragma unroll
          for (int r = 0; r < 4; ++r) { P0[r * (DV + 2) + 32 * d] = o[d][r]; P1[r * (DV + 2) + 32 * d] = o[d][4 + r]; } }
    if (lane < 16) { P[(size_t)lane * (DV + 2) + DV] = m_run; P[(size_t)lane * (DV + 2) + DV + 1] = l_run; }
}

template <int pv = 0> __device__ __forceinline__ void p3_attention(Frame& F, int mask) {
    LAS float* tab = (LAS float*)(F.lds + AT_TAB);
    for (int i = F.tid; i < 4 * 192; i += 512) { const int h = i / 192, rel = (i % 192) - 128; tab[i] = (F.in[I_RELB][t5_bucket(rel) * 4 + h] - F.in[I_RELB][15 * 4 + h]) * LOG2E; }
    __syncthreads();
    const int x = F.bid & 7, p = (F.bid >> 3) & 31;
    const int spos = F.G == 256 ? (x + p) % 5 : 4;
    for (int j = 0; j < 5; ++j) {
        F.lane = lane_id_opaque(); F.tid = F.wave * 64 + F.lane;
        if (j == spos) {
            if (mask & 4) {
                for (int u = F.bid; u < 256; u += F.G) {
                    F.lane = lane_id_opaque(); F.tid = F.wave * 64 + F.lane;
                    if ((u >> 3) & 1) sample_unit<1>(F, u >> 4, u & 7); else sample_unit<0>(F, u >> 4, u & 7);
                }
            }
        } else if (F.bid < 256) {
            const int i = j - (j > spos ? 1 : 0);
            const int qb = (i & 1) ? p : 63 - p;
            if (i < 2) { if (mask & 1) attn_prompt_diff_half<pv>(F, x >> 1, x & 1, qb); }
            else { if (mask & 2) attn_prompt_fox<pv>(F, x, qb); }
        }
    }
}

__device__ __forceinline__ void slab_publish(Frame& F, int word, int nun) {
    int n = 0; for (int L = F.bid; L < nun; L += F.G) ++n;
    asm volatile("s_waitcnt vmcnt(0)" ::: "memory");
    __syncthreads();
    if (F.tid == 0 && n > 0) { __builtin_amdgcn_fence(__ATOMIC_RELEASE, "agent"); asm volatile("s_waitcnt vmcnt(0)" ::: "memory");
        __hip_atomic_fetch_add((unsigned*)(F.ws + WS_CTL) + word, (unsigned)n, __ATOMIC_RELAXED, __HIP_MEMORY_SCOPE_AGENT); }
}
__device__ __forceinline__ void slab_wait(Frame& F, int word, int nun) {
    if (F.tid == 0) { unsigned* w = (unsigned*)(F.ws + WS_CTL) + word; unsigned sp = 0;
        while (__hip_atomic_load(w, __ATOMIC_RELAXED, __HIP_MEMORY_SCOPE_AGENT) < (unsigned)nun && ++sp < (1u << 22)) __builtin_amdgcn_s_sleep(2);
        __builtin_amdgcn_fence(__ATOMIC_ACQUIRE, "agent"); asm volatile("s_waitcnt vmcnt(0)" ::: "memory"); }
    __syncthreads();
}

#define XB_TMO      128
#define XB_XCNT(j)  (256  + 64 * (j))
#define XB_XSUB(j)  (1280 + 64 * (j))
#define XB_XGEN(j)  (2304 + 64 * (j))
#define XB_TOP      3328
#define XB_TOPGEN   3392
#define XCD_BAR_WORDS 3456
#define XB_SPIN_CAP (1u << 20)
__device__ __forceinline__ unsigned xb_ld(unsigned* p)              { return __hip_atomic_load(p, __ATOMIC_RELAXED, __HIP_MEMORY_SCOPE_AGENT); }
__device__ __forceinline__ unsigned xb_add(unsigned* p, unsigned v) { return __hip_atomic_fetch_add(p, v, __ATOMIC_RELAXED, __HIP_MEMORY_SCOPE_AGENT); }
__device__ __forceinline__ unsigned xb_xcc_id() { return (unsigned)__builtin_amdgcn_s_getreg((3 << 11) | 20) & 0xFu; }
#define XB_SPIN(cond, bar) do { unsigned _sp = 0; while (cond) { __builtin_amdgcn_s_sleep(1); \
    if ((++_sp & 255u) == 0u) { if (xb_ld(&(bar)[XB_TMO])) break; if (_sp > XB_SPIN_CAP) { atomicAdd(&(bar)[XB_TMO], 1u); break; } } } } while (0)
struct XcdBarrier { unsigned* bar; unsigned x; volatile LAS unsigned* st; };
__device__ __forceinline__ XcdBarrier xcd_barrier_post(unsigned* bar, volatile LAS unsigned* st) {
    XcdBarrier b; b.bar = bar; b.x = xb_xcc_id(); b.st = st;
    if (threadIdx.x == 0) (void)xb_add(&bar[XB_XCNT(b.x)], 1u);
    return b;
}
__device__ __forceinline__ void xcd_barrier_complete(unsigned* bar, unsigned x, unsigned& nloc, unsigned& nx) {
    const unsigned G = gridDim.x * gridDim.y * gridDim.z;
    unsigned sum, cnt, mine, sp = 0u;
    for (;;) {
        sum = 0u; cnt = 0u; mine = 0u;
#pragma unroll
        for (unsigned j = 0; j < 16; ++j) { const unsigned c = xb_ld(&bar[XB_XCNT(j)]); sum += c; cnt += (c > 0u) ? 1u : 0u; mine = (j == x) ? c : mine; }
        if (sum == G) break;
        __builtin_amdgcn_s_sleep(1);
        if ((++sp & 255u) == 0u) { if (xb_ld(&bar[XB_TMO])) break; if (sp > XB_SPIN_CAP) { atomicAdd(&bar[XB_TMO], 1u); break; } }
    }
    nloc = mine > 0u ? mine : 1u; nx = cnt > 0u ? cnt : 1u;
}
__device__ __forceinline__ void xcd_barrier(const XcdBarrier& b) {
    asm volatile("s_waitcnt vmcnt(0)" ::: "memory");
    __syncthreads();
    if (threadIdx.x == 0) {
        unsigned* bar = b.bar;
        __builtin_amdgcn_s_waitcnt(0);
        unsigned nloc = b.st[0], nx = b.st[1];
        if (nloc == 0u) { xcd_barrier_complete(bar, b.x, nloc, nx); b.st[0] = nloc; b.st[1] = nx; }
        const unsigned old = xb_add(&bar[XB_XSUB(b.x)], 1u);
        const unsigned gen = old / nloc;
        if (old + 1u == (gen + 1u) * nloc) {
            __builtin_amdgcn_fence(__ATOMIC_RELEASE, "agent");
            asm volatile("s_waitcnt vmcnt(0)" ::: "memory");
            const unsigned og = xb_add(&bar[XB_TOP], 1u);
            const unsigned tg = og / nx;
            if (og + 1u == (tg + 1u) * nx) xb_add(&bar[XB_TOPGEN], 1u);
            else XB_SPIN(xb_ld(&bar[XB_TOPGEN]) == tg, bar);
            __builtin_amdgcn_fence(__ATOMIC_ACQUIRE, "agent");
            xb_add(&bar[XB_XGEN(b.x)], 1u);
            asm volatile("s_waitcnt vmcnt(0)" ::: "memory");
        } else {
            XB_SPIN(xb_ld(&bar[XB_XGEN(b.x)]) == gen, bar);
            __builtin_amdgcn_fence(__ATOMIC_ACQUIRE, "agent");
            asm volatile("s_waitcnt vmcnt(0)" ::: "memory");
        }
    }
    __syncthreads();
}

__global__ void __launch_bounds__(512, 2) mega_fwd(Args args) {
    extern __shared__ __attribute__((aligned(16))) unsigned char lds_raw[];
    Frame F;
    F.lds = (LAS unsigned char*)lds_raw; F.ldsg = lds_raw;
    F.tid = threadIdx.x; F.lane = F.tid & 63; F.wave = __builtin_amdgcn_readfirstlane(F.tid >> 6);
    F.G = gridDim.x; F.bid = blockIdx.x;
    F.in = args.in; F.out = args.out; F.ws = args.ws;
    const int lo = args.ph_lo, hi = args.ph_hi;
    cg::grid_group grid = cg::this_grid();
    const bool fused = (hi - lo) > 1;
    volatile LAS unsigned* bst = (volatile LAS unsigned*)(F.lds + AT_MISC + 16);
    if (F.tid == 0) { bst[0] = 0u; bst[1] = 0u; }
    __syncthreads();
    XcdBarrier xbar; xbar.bar = (unsigned*)(F.ws + WS_CTL) + 1024; xbar.x = 0; xbar.st = bst;
    if (fused) xbar = xcd_barrier_post((unsigned*)(F.ws + WS_CTL) + 1024, bst);
#define IN(k) (lo <= (k) && (k) < hi)
#define PB() do { F.lane = lane_id_opaque(); F.tid = F.wave * 64 + F.lane; } while (0)
#define SEAM(k) do { if (IN(k) && IN((k) + 1)) { xcd_barrier(xbar); } } while (0)
    const float* mod = (const float*)(F.ws + WS_MOD);
    if (IN(0)) { PB(); p0_prologue(F); }
    if (IN(0) && IN(1)) __syncthreads(); else SEAM(0);
    if (IN(1)) { PB(); p1_rows(F, IN(0)); } SEAM(1);
    if (IN(2)) { PB();
        p2_cumsum(F);
        __syncthreads();
        pg8::Gemm g{(const bf16_t*)(F.ws + WS_XN), (const bf16_t*)(F.ws + WS_WIN), 1024, 1024, 1024, 1 << 30, 0, 0};
        pg8::StaticOrder S; S.init(MT / 256, NZ / 256, F.G, F.bid, 0);
        EpiZ E{F.out, F.ws};
        pg8::gemm_phase<EpiZ, pg8::StaticOrder>(F.lds, g, S, E, F.wave);
#if PROBE_DUP == 2
        pg8::gemm_phase<EpiZ, pg8::StaticOrder>(F.lds, g, S, E, F.wave);
#endif
        { const int nun = (MT / 256) * (NZ / 256), nlong = nun - (nun / F.G) * F.G;
          if (nlong > 0 && nlong < F.G) { if (F.bid >= nlong) { PB(); weight_copies(F, F.bid - nlong, F.G - nlong, WC_IN, WC_ALL); } }
          else { PB(); weight_copies(F, F.bid, F.G, WC_IN, WC_ALL); } }
    } SEAM(2);
    if (IN(3)) { PB(); p3_attention(F, 7);
#if PROBE_DUP == 3
        p3_attention<PROBE_PV>(F, PROBE_MASK);
#endif
    } SEAM(3);
    if (IN(10)) { PB(); p_combine(F);
#if PROBE_DUP == 10
        p_combine(F);
#endif
    } if (IN(10) && IN(4)) xcd_barrier(xbar);
    if (IN(4)) { PB();
        pg8::Gemm g{(const bf16_t*)(F.ws + WS_AB), (const bf16_t*)(F.ws + WS_WAB), 1024, 512, 512, 4, 512, 0};
        pg8::StaticOrder S; S.init(MT / 256, 8, F.G, F.bid, 0);
        EpiGate E{(bf16_t*)(F.ws + WS_G), (bf16_t*)(F.ws + WS_G)};
#if PROBE_DUP == 4
        { EpiGate E2{(bf16_t*)(F.ws + WS_G), (bf16_t*)(F.ws + WS_QA)}; pg8::gemm_phase<EpiGate, pg8::StaticOrder>(F.lds, g, S, E2, F.wave); }
#endif
        pg8::gemm_phase<EpiGate, pg8::StaticOrder>(F.lds, g, S, E, F.wave);
    } SEAM(4);
    if (IN(5)) { PB();
        { pg8::Gemm g2{(const bf16_t*)(F.ws + WS_G), (const bf16_t*)(F.ws + WS_WO2), 2048, 2048, 256, 1 << 30, 0, 256};
          pg8::SplitOrder S2; S2.init(4, 8, F.G, F.bid, SEQ / 256); EpiSlab E2{(float*)(F.ws + WS_SLAB)};
          pg8::gemm_phase<EpiSlab, pg8::SplitOrder>(F.lds, g2, S2, E2, F.wave); slab_publish(F, 322, 32); }
        pg8::Gemm g{(const bf16_t*)(F.ws + WS_G), (const bf16_t*)(F.ws + WS_WO2), 2048, 2048, 2048, 1 << 30, 0, 0};
        pg8::StaticOrder S; S.init(SEQ / 256, 4, F.G, F.bid, 0);
        EpiResLn<false> E{(const void*)F.in[I_XP], mod + 2048, F.in[I_LN1G], F.in[I_LN1B], mod, (bf16_t*)(F.ws + WS_X1B), (bf16_t*)(F.ws + WS_XN), nullptr,
                          PanelStats{(unsigned*)(F.ws + WS_XB1), (unsigned*)(F.ws + WS_CTL) + CTL_LN1, LN_EPS}, F.lds};
        pg8::gemm_phase<EpiResLn<false>, pg8::StaticOrder>(F.lds, g, S, E, F.wave);
        PB(); slab_wait(F, 322, 32); ln_rows<false>(F, F.in[I_LN1G], F.in[I_LN1B], 8, 2048);
    } if (IN(5) && IN(7)) xcd_barrier(xbar);

    if (IN(7)) { PB();
        pg8::Gemm g{(const bf16_t*)(F.ws + WS_XN), (const bf16_t*)(F.ws + WS_WFI), 1024, 1024, 1024, 1 << 30, 0, 0};
        pg8::StaticOrder S; S.init(MT / 256, NFF2 / 256, F.G, F.bid, 0);
        EpiFfn E{(bf16_t*)(F.ws + WS_ACT)};
        pg8::gemm_phase<EpiFfn, pg8::StaticOrder>(F.lds, g, S, E, F.wave);
#if PROBE_DUP == 7
        pg8::gemm_phase<EpiFfn, pg8::StaticOrder>(F.lds, g, S, E, F.wave);
#endif
    } SEAM(7);
    if (IN(8)) { PB();
        { pg8::Gemm g2{(const bf16_t*)(F.ws + WS_ACT), (const bf16_t*)(F.ws + WS_WFO), DFF, DFF, 256, 1 << 30, 0, 256};
          pg8::SplitOrder S2; S2.init(4, 11, F.G, F.bid, SEQ / 256); EpiSlab E2{(float*)(F.ws + WS_SLAB)};
          pg8::gemm_phase<EpiSlab, pg8::SplitOrder>(F.lds, g2, S2, E2, F.wave); slab_publish(F, 323, 44); }
        pg8::Gemm g{(const bf16_t*)(F.ws + WS_ACT), (const bf16_t*)(F.ws + WS_WFO), DFF, DFF, DFF, 1 << 30, 0, 0};
        pg8::StaticOrder S; S.init(SEQ / 256, 4, F.G, F.bid, 0);
        EpiResLn<true> E{(const void*)(F.ws + WS_X1B), mod + 5120, F.in[I_LN2G], F.in[I_LN2B], mod, nullptr, nullptr, F.out,
                         PanelStats{(unsigned*)(F.ws + WS_XB2), (unsigned*)(F.ws + WS_CTL) + CTL_LN2, LN_EPS}, F.lds};
        pg8::gemm_phase<EpiResLn<true>, pg8::StaticOrder>(F.lds, g, S, E, F.wave);
        PB(); slab_wait(F, 323, 44); ln_rows<true>(F, F.in[I_LN2G], F.in[I_LN2B], 11, 5120);
    }
#undef IN
#undef SEAM
}

extern "C" void kernel_launch(void* const* d_in, const int* in_sizes, int n_in, void* d_out, int out_size, void* d_ws, size_t ws_size, hipStream_t stream) {
    static int grid = 0;
    if (grid == 0) {
        if (n_in != 28 || (size_t)out_size != O_END || ws_size < WS_END) { fprintf(stderr, "kernel_launch: unexpected shapes (n_in %d out %d ws %zu)\n", n_in, out_size, ws_size); grid = -1; return; }
        int dev = 0, cus = 0, per_cu = 0;
        hipGetDevice(&dev); hipDeviceGetAttribute(&cus, hipDeviceAttributeMultiprocessorCount, dev);
        hipFuncSetAttribute((const void*)mega_fwd, hipFuncAttributeMaxDynamicSharedMemorySize, LDS_BYTES);
        hipOccupancyMaxActiveBlocksPerMultiprocessor(&per_cu, (const void*)mega_fwd, 512, LDS_BYTES);
        if (per_cu < 1) { fprintf(stderr, "kernel_launch: occupancy query says %d blocks per CU\n", per_cu); per_cu = 1; }
        (void)hipGetLastError();
        grid = cus;
    }
    if (grid < 0) return;
    hipMemsetAsync((char*)d_ws + WS_CTL, 0, CTL_BYTES, stream);
    Args a{};
    for (int i = 0; i < 28; ++i) a.in[i] = (const float*)d_in[i];
    a.out = (float*)d_out; a.ws = (unsigned char*)d_ws;
#if MK_N_LAUNCHES == 1
    a.ph_lo = 0; a.ph_hi = NPH;
    void* kargs[] = {&a};
    hipError_t e = hipLaunchCooperativeKernel((const void*)mega_fwd, dim3(grid), dim3(512), kargs, LDS_BYTES, stream);
    if (e != hipSuccess) fprintf(stderr, "cooperative launch failed: %s\n", hipGetErrorString(e));
#else
    { const int seq[NPH] = {0, 1, 2, 3, 10, 4, 5, 6, 7, 8, 9}; for (int i = 0; i < NPH; ++i) { a.ph_lo = seq[i]; a.ph_hi = seq[i] + 1; hipLaunchKernelGGL(mega_fwd, dim3(grid), dim3(512), LDS_BYTES, stream, a); } }
#endif
}
```

```cpp
#include <hip/hip_runtime.h>
#include <hip/hip_cooperative_groups.h>
#include <cstdint>
#include <cstdio>
namespace cg = cooperative_groups;

#ifndef PROBE_DUP
#define PROBE_DUP -1
#endif
#ifndef PROBE_PV
#define PROBE_PV 0
#endif
#ifndef PROBE_MASK
#define PROBE_MASK 7
#endif
#ifndef MK_N_LAUNCHES
#define MK_N_LAUNCHES 1
#endif

#define LAS __attribute__((address_space(3)))
typedef unsigned short bf16_t;
typedef short bf16x8 __attribute__((ext_vector_type(8)));
typedef short s16x4 __attribute__((ext_vector_type(4)));
typedef float f32x4 __attribute__((ext_vector_type(4)));
typedef float f32x2 __attribute__((ext_vector_type(2)));
typedef float f32x16 __attribute__((ext_vector_type(16)));
typedef unsigned u32x4 __attribute__((ext_vector_type(4)));
typedef unsigned u32x2 __attribute__((ext_vector_type(2)));

constexpr int DM = 1024, SEQ = 16384, DEC_B = 16, DEC_T = 16, NSMP = DEC_B * DEC_T, MT = SEQ + NSMP, PAST = 2048, SKV = PAST + DEC_T;
constexpr int NZ = 5120, DFF = 2816, NFF2 = 2 * DFF, WIN_COLS = 5128;
constexpr float LOG2E = 1.4426950408889634f, C2 = 0.125f * LOG2E, ALPHA = 1.189207115002721f, LN_EPS = 1e-5f;
constexpr int NPH = 11;

constexpr size_t O_Y = 0, O_DKP = (size_t)MT * DM, O_DVP = O_DKP + (size_t)SEQ * 512, O_FKP = O_DVP + (size_t)SEQ * 512, O_FVP = O_FKP + (size_t)SEQ * 512,
                 O_FLP = O_FVP + (size_t)SEQ * 512, O_DKS = O_FLP + (size_t)SEQ * 8, O_DVS = O_DKS + (size_t)NSMP * 512, O_FKS = O_DVS + (size_t)NSMP * 512,
                 O_FVS = O_FKS + (size_t)NSMP * 512, O_FLS = O_FVS + (size_t)NSMP * 512, O_END = O_FLS + (size_t)NSMP * 8;

constexpr size_t MiB = 1u << 20;
constexpr size_t WS_CTL = 0, CTL_BYTES = 64 * 1024;
constexpr size_t WS_MOD = 1 * MiB;
constexpr size_t WS_FP = 2 * MiB;
constexpr size_t WS_FS = 3 * MiB;
constexpr size_t WS_WIN = 8 * MiB;
constexpr size_t WS_WAB = 18 * MiB;
constexpr size_t WS_WO2 = 20 * MiB;
constexpr size_t WS_WFI = 24 * MiB;
constexpr size_t WS_WFO = 35 * MiB;
constexpr size_t WS_XN = 48 * MiB;
constexpr size_t WS_QA = 84 * MiB, WS_KA = 101 * MiB, WS_VA = 118 * MiB, WS_QB = 135 * MiB, WS_KB = 152 * MiB, WS_VB = 169 * MiB;
constexpr size_t WS_ACT = 84 * MiB;
constexpr size_t WS_G = 188 * MiB;
constexpr size_t WS_AB = 254 * MiB;
constexpr size_t WS_OD1 = WS_XN, WS_OD2 = 288 * MiB;
constexpr size_t WS_PF = 304 * MiB, WS_PD = 309 * MiB;
constexpr size_t WS_TB = WS_AB;
constexpr size_t WS_X1B = WS_AB;
constexpr size_t WS_XB1 = 5 * MiB, WS_XB2 = 6 * MiB;
constexpr int CTL_LN1 = 8192, CTL_LN2 = 12288;
constexpr int LN_LDS = 135168;
constexpr size_t WS_SLAB = 288 * MiB;
constexpr size_t WS_END = 320 * MiB;

constexpr int LDS_BYTES = 147456;

struct Args { const float* in[28]; float* out; unsigned char* ws; int ph_lo, ph_hi; };

__device__ __forceinline__ int lane_id_opaque() { int l = (int)__builtin_amdgcn_mbcnt_hi(~0u, __builtin_amdgcn_mbcnt_lo(~0u, 0u)); asm volatile("" : "+v"(l)); return l; }
__device__ __forceinline__ unsigned f2bf(float f) { unsigned u = __builtin_bit_cast(unsigned, f); return (u + 0x7fffu + ((u >> 16) & 1u)) >> 16; }
__device__ __forceinline__ unsigned pk2(float lo, float hi) { return f2bf(lo) | (f2bf(hi) << 16); }
__device__ __forceinline__ float bf2f(unsigned short b) { return __builtin_bit_cast(float, (unsigned)b << 16); }
__device__ __forceinline__ float bflo(unsigned w) { return __builtin_bit_cast(float, w << 16); }
__device__ __forceinline__ float bfhi(unsigned w) { return __builtin_bit_cast(float, w & 0xffff0000u); }
__device__ __forceinline__ float wave_sum(float v) {
#pragma unroll
    for (int o = 1; o < 64; o <<= 1) v += __shfl_xor(v, o);
    return v;
}
typedef __bf16 bf16x2e_t_ __attribute__((ext_vector_type(2)));
__device__ __forceinline__ unsigned cvtpk_v(float lo, float hi) { f32x2 v = {lo, hi}; bf16x2e_t_ b = __builtin_convertvector(v, bf16x2e_t_); return __builtin_bit_cast(unsigned, b); }
__device__ __forceinline__ float sigmoidf_(float x) { return __builtin_amdgcn_rcpf(1.0f + __expf(-x)); }
__device__ __forceinline__ float siluf_(float x) { return x * __builtin_amdgcn_rcpf(1.0f + __expf(-x)); }

namespace pg8 {
constexpr int BM = 256, BK = 64, HALF = 128, HTB = HALF * BK * 2, STAGE_BYTES = 8 * HTB, NXCD = 8, WGM = 8;
__host__ __device__ __forceinline__ int lds_byte(int r, int c) { const int st = (r >> 4) * 2 + (c >> 5), rr = r & 15, cc = c & 31, ob = rr * 64 + cc * 2; return st * 1024 + (ob ^ (((ob >> 9) & 1) << 5)); }
__host__ __device__ __forceinline__ void stage_rc(int b, int& R, int& C) { const int st = b / 1024, sb = b % 1024, swz = sb ^ (((sb >> 9) & 1) << 5); R = (st >> 1) * 16 + swz / 64; C = (st & 1) * 32 + (swz % 64) / 2; }
__host__ __device__ __forceinline__ int perm32(int rho) { const int n = rho >> 4, i = rho & 15; return 8 * (i >> 2) + 4 * n + (i & 3); }

struct Unit { int pm, pn, ks; };
struct Gemm { const bf16_t* A; const bf16_t* Bt; int lda, ldb, K, a_split_pn, a_split_off, kpart; };

struct StaticOrder {
    int nM, nN, nwg, G, c, pm0;
    __device__ void init(int nM_, int nN_, int G_, int c_, int pm0_) { nM = nM_; nN = nN_; nwg = nM * nN; G = G_; c = c_; pm0 = pm0_; }
    __device__ bool next(int i, Unit& u) const {
        const long L = (long)i * G + c; if (L >= nwg) return false;
        int wgid = (int)L; { const int q = nwg / NXCD, r = nwg % NXCD, xcd = wgid % NXCD, off = wgid / NXCD; wgid = (xcd < r ? xcd * (q + 1) : r * (q + 1) + (xcd - r) * q) + off; }
        const int nig = WGM * nN, gid = wgid / nig, fm = gid * WGM, gsz = (nM - fm) < WGM ? (nM - fm) : WGM;
        u.pm = pm0 + fm + ((wgid % nig) % gsz); u.pn = (wgid % nig) / gsz; u.ks = 0; return true;
    }
};

struct SplitOrder {
    int nN, nun, G, c, pm;
    __device__ void init(int nN_, int KS_, int G_, int c_, int pm_) { nN = nN_; nun = nN_ * KS_; G = G_; c = c_; pm = pm_; }
    __device__ bool next(int i, Unit& u) const { const long L = (long)i * G + c; if (L >= nun) return false; u.pm = pm; u.pn = (int)L % nN; u.ks = (int)L / nN; return true; }
};

__device__ __forceinline__ unsigned cvt_pk_bf16(float lo, float hi) { unsigned r; asm volatile("v_cvt_pk_bf16_f32 %0, %1, %2" : "=v"(r) : "v"(lo), "v"(hi)); return r; }

template <class Epi, class Sched, bool ALIGN_EPI = true, bool SP2 = true>
__device__ __forceinline__ void gemm_phase(LAS unsigned char* lds, const Gemm g, const Sched& S, const Epi& E, int wid  ) {
    const int lane = lane_id_opaque(), tid = wid * 64 + lane, wr = wid >> 2, wc = wid & 3; int fr = lane & 15, fq = lane >> 4;
    const int K = g.K, nt = K / BK;
    unsigned voffA[2], voffB[2];
#pragma unroll
    for (int i = 0; i < 2; ++i) { int R, C; stage_rc(tid * 16 + i * 8192, R, C); const int Rb = Epi::PERM ? ((R & ~31) + perm32(R & 31)) : R;
        voffA[i] = (unsigned)(R * g.lda + C) * 2u; voffB[i] = (unsigned)(Rb * g.ldb + C) * 2u; }
    const size_t kstep = (size_t)(BK * 2);
    const size_t hstepA = (size_t)HALF * g.lda * 2, hstepB = (size_t)HALF * g.ldb * 2;
    const size_t tstepA = 2 * hstepA, tstepB = 2 * hstepB;
    const unsigned ldsw = (unsigned)wid * 1024u;
    const int aoff = lds_byte(wr * 64 + fr, fq * 8), boff = lds_byte(wc * 32 + fr, fq * 8);
#define PG8_SA(b, h) (((b) * 2 + (h)) * HTB)
#define PG8_SB(b, h) ((4 + (b) * 2 + (h)) * HTB)
#define PG8_STAGE(bufoff, gbase, voff) do { _Pragma("unroll") for (int _i = 0; _i < 2; ++_i) \
        __builtin_amdgcn_global_load_lds((const unsigned*)((const char*)(gbase) + (voff)[_i]), (LAS unsigned*)(lds + (bufoff) + ldsw + _i * 8192), 16, 0, 0); } while (0)
#define PG8_LDA(dst, b, h) do { _Pragma("unroll") for (int m = 0; m < 4; ++m) _Pragma("unroll") for (int k = 0; k < 2; ++k) dst[m][k] = *(const LAS bf16x8*)(lds + PG8_SA(b, h) + aoff + m * 2048 + k * 1024); } while (0)
#define PG8_LDB(dst, b, h) do { _Pragma("unroll") for (int n = 0; n < 2; ++n) _Pragma("unroll") for (int k = 0; k < 2; ++k) dst[n][k] = *(const LAS bf16x8*)(lds + PG8_SB(b, h) + boff + n * 2048 + k * 1024); } while (0)
#define PG8_MMA(ai, bj, At, Bt) do { __builtin_amdgcn_s_setprio(1); _Pragma("unroll") for (int m = 0; m < 4; ++m) _Pragma("unroll") for (int n = 0; n < 2; ++n) _Pragma("unroll") for (int k = 0; k < 2; ++k) \
        acc[ai][bj][m][n] = __builtin_amdgcn_mfma_f32_16x16x32_bf16(Bt[n][k], At[m][k], acc[ai][bj][m][n], 0, 0, 0); __builtin_amdgcn_s_setprio(0); } while (0)
#define PG8_WAIT_V(n) asm volatile("s_waitcnt vmcnt(" #n ")" ::: "memory")
#define PG8_WAIT_L(n) asm volatile("s_waitcnt lgkmcnt(" #n ")" ::: "memory")
#define PG8_BAR __builtin_amdgcn_s_barrier()
#define PG8_SCHED __builtin_amdgcn_sched_barrier(0)
#define PG8_ABASE(u) ((const char*)g.A + (size_t)(u).pm * tstepA + ((u).pn >= g.a_split_pn ? (size_t)g.a_split_off * 2 : (size_t)0) + (size_t)(u).ks * g.kpart * 2)
#define PG8_BBASE(u) ((const char*)g.Bt + (size_t)(u).pn * tstepB + (size_t)(u).ks * g.kpart * 2)
    Unit cur, nxt; int ui = 0;
    if (!S.next(0, cur)) return;
    f32x4 acc[2][2][4][2];
#pragma unroll
    for (int a = 0; a < 2; ++a)
#pragma unroll
        for (int b = 0; b < 2; ++b)
#pragma unroll
            for (int m = 0; m < 4; ++m)
#pragma unroll
                for (int n = 0; n < 2; ++n) acc[a][b][m][n] = (f32x4){0.f, 0.f, 0.f, 0.f};
    bf16x8 At[4][2], B0[2][2], B1[2][2];
    const char* cA = PG8_ABASE(cur); const char* cB = PG8_BBASE(cur);
    if constexpr (SP2) {
        PG8_STAGE(PG8_SB(0, 0), cB, voffB); PG8_STAGE(PG8_SB(0, 1), cB + hstepB, voffB); PG8_STAGE(PG8_SA(0, 0), cA, voffA); PG8_STAGE(PG8_SA(0, 1), cA + hstepA, voffA);
        if (wr == 1) PG8_BAR;
        PG8_WAIT_V(2); PG8_BAR;
        PG8_STAGE(PG8_SB(1, 0), cB + kstep, voffB); PG8_STAGE(PG8_SA(1, 0), cA + kstep, voffA); PG8_STAGE(PG8_SB(1, 1), cB + hstepB + kstep, voffB);
        PG8_WAIT_V(6); PG8_BAR;
    } else {
        PG8_STAGE(PG8_SB(0, 0), cB, voffB); PG8_STAGE(PG8_SA(0, 0), cA, voffA); PG8_STAGE(PG8_SB(0, 1), cB + hstepB, voffB); PG8_STAGE(PG8_SA(0, 1), cA + hstepA, voffA);
        if (wr == 1) PG8_BAR;
        PG8_WAIT_V(4); PG8_BAR;
        PG8_STAGE(PG8_SB(1, 0), cB + kstep, voffB); PG8_STAGE(PG8_SA(1, 0), cA + kstep, voffA); PG8_STAGE(PG8_SB(1, 1), cB + hstepB + kstep, voffB);
        PG8_WAIT_V(6); PG8_BAR;
    }
    for (;;) {
        const bool has_next = S.next(ui + 1, nxt);
        const char* nA = has_next ? PG8_ABASE(nxt) : cA; const char* nB = has_next ? PG8_BBASE(nxt) : cB;
        for (int t = 0; t < nt; t += 2) {
            const bool last = (t == nt - 2);
            const char* a1 = cA + (size_t)(t + 1) * kstep;
            const char* a2 = last ? nA : cA + (size_t)(t + 2) * kstep; const char* b2 = last ? nB : cB + (size_t)(t + 2) * kstep;
            const char* a3 = a2 + kstep; const char* b3 = b2 + kstep;
            if constexpr (SP2) {
            PG8_LDB(B0, 0, 0); PG8_LDB(B1, 0, 1); PG8_SCHED; PG8_LDA(At, 0, 0); PG8_STAGE(PG8_SA(1, 1), a1 + hstepA, voffA);
            PG8_WAIT_V(8); PG8_WAIT_L(0); PG8_BAR; PG8_MMA(0, 0, At, B0); PG8_MMA(0, 1, At, B1); PG8_BAR; PG8_SCHED;
            PG8_LDA(At, 0, 1); PG8_STAGE(PG8_SB(0, 0), b2, voffB); PG8_STAGE(PG8_SB(0, 1), b2 + hstepB, voffB); PG8_STAGE(PG8_SA(0, 0), a2, voffA);
            PG8_WAIT_V(8); PG8_WAIT_L(0); PG8_BAR; PG8_MMA(1, 0, At, B0); PG8_MMA(1, 1, At, B1); PG8_BAR; PG8_SCHED;
            PG8_LDB(B0, 1, 0); PG8_LDB(B1, 1, 1); PG8_SCHED; PG8_LDA(At, 1, 0); PG8_STAGE(PG8_SA(0, 1), a2 + hstepA, voffA);
            PG8_WAIT_V(8); PG8_WAIT_L(0); PG8_BAR; PG8_MMA(0, 0, At, B0); PG8_MMA(0, 1, At, B1); PG8_BAR; PG8_SCHED;
            PG8_LDA(At, 1, 1); PG8_STAGE(PG8_SB(1, 0), b3, voffB); PG8_STAGE(PG8_SB(1, 1), b3 + hstepB, voffB); PG8_STAGE(PG8_SA(1, 0), a3, voffA);
            PG8_WAIT_V(8); PG8_WAIT_L(0); PG8_BAR; PG8_MMA(1, 0, At, B0); PG8_MMA(1, 1, At, B1); PG8_BAR; PG8_SCHED;
            } else {
            PG8_LDB(B0, 0, 0); PG8_SCHED; PG8_LDA(At, 0, 0); PG8_STAGE(PG8_SA(1, 1), a1 + hstepA, voffA);
            PG8_WAIT_L(8); PG8_BAR; PG8_WAIT_L(0); PG8_MMA(0, 0, At, B0); PG8_BAR; PG8_SCHED;
            PG8_LDB(B1, 0, 1); PG8_STAGE(PG8_SB(0, 0), b2, voffB);
            PG8_BAR; PG8_WAIT_L(0); PG8_MMA(0, 1, At, B1); PG8_BAR;
            PG8_LDA(At, 0, 1); PG8_STAGE(PG8_SA(0, 0), a2, voffA);
            PG8_BAR; PG8_WAIT_L(0); PG8_MMA(1, 0, At, B0); PG8_BAR; PG8_SCHED;
            PG8_STAGE(PG8_SB(0, 1), b2 + hstepB, voffB);
            PG8_WAIT_V(6); PG8_BAR; PG8_MMA(1, 1, At, B1); PG8_BAR;
            PG8_LDB(B0, 1, 0); PG8_SCHED; PG8_LDA(At, 1, 0); PG8_STAGE(PG8_SA(0, 1), a2 + hstepA, voffA);
            PG8_WAIT_L(8); PG8_BAR; PG8_WAIT_L(0); PG8_MMA(0, 0, At, B0); PG8_BAR; PG8_SCHED;
            PG8_LDB(B1, 1, 1); PG8_STAGE(PG8_SB(1, 0), b3, voffB);
            PG8_BAR; PG8_WAIT_L(0); PG8_MMA(0, 1, At, B1); PG8_BAR;
            PG8_LDA(At, 1, 1); PG8_STAGE(PG8_SA(1, 0), a3, voffA);
            PG8_BAR; PG8_WAIT_L(0); PG8_MMA(1, 0, At, B0); PG8_BAR; PG8_SCHED;
            PG8_STAGE(PG8_SB(1, 1), b3 + hstepB, voffB);
            PG8_WAIT_V(6); PG8_BAR; PG8_MMA(1, 1, At, B1); PG8_BAR;
            }
        }
        if constexpr (ALIGN_EPI) { if (wr == 0) PG8_BAR; }
        { const int le_ = lane_id_opaque(); E(acc, cur, wr, wc, le_ & 15, le_ >> 4); }
        if (!has_next) break;
#pragma unroll
        for (int a = 0; a < 2; ++a)
#pragma unroll
            for (int b = 0; b < 2; ++b)
#pragma unroll
                for (int m = 0; m < 4; ++m)
#pragma unroll
                    for (int n = 0; n < 2; ++n) acc[a][b][m][n] = (f32x4){0.f, 0.f, 0.f, 0.f};
        cur = nxt; cA = nA; cB = nB; ++ui;
        if constexpr (ALIGN_EPI) { if (wr == 1) PG8_BAR; }
    }
    PG8_WAIT_V(0);
    if constexpr (!ALIGN_EPI) { if (wr == 0) PG8_BAR; }
    PG8_BAR;
#undef PG8_SA
#undef PG8_SB
#undef PG8_STAGE
#undef PG8_LDA
#undef PG8_LDB
#undef PG8_MMA
#undef PG8_WAIT_V
#undef PG8_WAIT_L
#undef PG8_BAR
#undef PG8_SCHED
#undef PG8_ABASE
#undef PG8_BBASE
}
}

struct EpiZ {
    static constexpr bool PERM = true;
    float* out; unsigned char* ws;
    __device__ __forceinline__ void operator()(const f32x4 (&acc)[2][2][4][2], const pg8::Unit& u, int wr, int wc, int fr, int fq) const {
        asm volatile("" : "+v"(fr), "+v"(fq));
        const int seg = u.pn >> 1;
        const bool smp = u.pm >= SEQ / 256;
        const int row0 = u.pm * 256 + wr * 64 + fr;
        const int cl0 = wc * 32 + 8 * fq;
        if (seg < 6) {
            bf16_t* B = (bf16_t*)(ws + WS_QA + (size_t)seg * (WS_KA - WS_QA));
            const bool isq = (seg == 0 || seg == 3);
            const float sc = isq ? C2 : 1.0f;
            const int kk = seg - 1 - (seg > 3 ? 1 : 0);
            float* ob = isq ? nullptr : (smp ? out + O_DKS + (size_t)kk * NSMP * 512 - (size_t)SEQ * 512 : out + O_DKP + (size_t)kk * SEQ * 512);
            const int cs = (u.pn & 1) * 256 + cl0;
            if (seg == 0 || seg == 1 || seg == 3 || seg == 4) {
                float mx0 = 0.f, mx1 = 0.f;
#pragma unroll
                for (int ai = 0; ai < 2; ++ai)
#pragma unroll
                    for (int m = 0; m < 4; ++m) {
#pragma unroll
                        for (int bj = 0; bj < 2; ++bj) { const f32x4 v0 = acc[ai][bj][m][0] * sc, v1 = acc[ai][bj][m][1] * sc;
                            float ss = (v0[0] * v0[0] + v0[1] * v0[1]) + (v0[2] * v0[2] + v0[3] * v0[3]) + (v1[0] * v1[0] + v1[1] * v1[1]) + (v1[2] * v1[2] + v1[3] * v1[3]);
                            ss += __shfl_xor(ss, 16); ss += __shfl_xor(ss, 32);
                            if (bj == 0) mx0 = fmaxf(mx0, ss); else mx1 = fmaxf(mx1, ss); } }
#pragma unroll
                for (int ofs = 1; ofs < 16; ofs <<= 1) { mx0 = fmaxf(mx0, __shfl_xor(mx0, ofs)); mx1 = fmaxf(mx1, __shfl_xor(mx1, ofs)); }
                if ((fr | fq) == 0) { unsigned* nw = (unsigned*)(ws + WS_CTL) + (seg < 3 ? 288 : 256) + ((seg == 4 || seg == 1) ? 16 : 0);
                    const int h0 = (u.pn & 1) * 4 + (wc >> 1), hf = wc & 1;
                    atomicMax(nw + (h0 * 2 + hf), __float_as_uint(mx0)); atomicMax(nw + ((h0 + 2) * 2 + hf), __float_as_uint(mx1)); }
            }
#pragma unroll
            for (int ai = 0; ai < 2; ++ai)
#pragma unroll
                for (int m = 0; m < 4; ++m) { const size_t r = (size_t)(row0 + ai * 128 + m * 16);
#pragma unroll
                    for (int bj = 0; bj < 2; ++bj) { const f32x4 v0 = acc[ai][bj][m][0], v1 = acc[ai][bj][m][1]; const int c = cs + bj * 128;
                        if (ob) { if (smp) { *(f32x4*)(ob + r * 512 + c) = v0; *(f32x4*)(ob + r * 512 + c + 4) = v1; }
                                  else { __builtin_nontemporal_store(v0, (f32x4*)(ob + r * 512 + c)); __builtin_nontemporal_store(v1, (f32x4*)(ob + r * 512 + c + 4)); } }
                        u32x4 w; w.x = pg8::cvt_pk_bf16(v0[0] * sc, v0[1] * sc); w.y = pg8::cvt_pk_bf16(v0[2] * sc, v0[3] * sc); w.z = pg8::cvt_pk_bf16(v1[0] * sc, v1[1] * sc); w.w = pg8::cvt_pk_bf16(v1[2] * sc, v1[3] * sc);
                        *(u32x4*)(B + r * 512 + c) = w; } }
        } else {
            bf16_t* G = (bf16_t*)(ws + WS_G);
            const int cs = (u.pn - 12) * 256 + cl0;
#pragma unroll
            for (int ai = 0; ai < 2; ++ai)
#pragma unroll
                for (int m = 0; m < 4; ++m) { const size_t r = (size_t)(row0 + ai * 128 + m * 16);
#pragma unroll
                    for (int bj = 0; bj < 2; ++bj) { const f32x4 v0 = acc[ai][bj][m][0], v1 = acc[ai][bj][m][1]; const int c = cs + bj * 128;
                        u32x4 w; w.x = cvtpk_v(sigmoidf_(v0[0]), sigmoidf_(v0[1])); w.y = cvtpk_v(sigmoidf_(v0[2]), sigmoidf_(v0[3]));
                        w.z = cvtpk_v(sigmoidf_(v1[0]), sigmoidf_(v1[1])); w.w = cvtpk_v(sigmoidf_(v1[2]), sigmoidf_(v1[3]));
                        *(u32x4*)(G + r * 2048 + c) = w; } }
        }
    }
};
struct EpiGate {
    static constexpr bool PERM = true;
    bf16_t* G; bf16_t* GO;
    __device__ __forceinline__ void operator()(const f32x4 (&acc)[2][2][4][2], const pg8::Unit& u, int wr, int wc, int fr, int fq) const {
        asm volatile("" : "+v"(fr), "+v"(fq));
        const int row0 = u.pm * 256 + wr * 64 + fr, c0 = u.pn * 256 + wc * 32 + 8 * fq;
#pragma unroll
        for (int ai = 0; ai < 2; ++ai)
#pragma unroll
            for (int m = 0; m < 4; ++m) { const size_t ro = (size_t)(row0 + ai * 128 + m * 16) * 2048 + c0; const bf16_t* rp = G + ro; bf16_t* wp = GO + ro;
#pragma unroll
                for (int bj = 0; bj < 2; ++bj) { const f32x4 v0 = acc[ai][bj][m][0], v1 = acc[ai][bj][m][1]; const u32x4 gw = *(const u32x4*)(rp + bj * 128);
                    u32x4 w; w.x = pg8::cvt_pk_bf16(v0[0] * bflo(gw.x), v0[1] * bfhi(gw.x)); w.y = pg8::cvt_pk_bf16(v0[2] * bflo(gw.y), v0[3] * bfhi(gw.y));
                    w.z = pg8::cvt_pk_bf16(v1[0] * bflo(gw.z), v1[1] * bfhi(gw.z)); w.w = pg8::cvt_pk_bf16(v1[2] * bflo(gw.w), v1[3] * bfhi(gw.w));
                    *(u32x4*)(wp + bj * 128) = w; } }
    }
};
template <bool BASE_BF16> struct EpiRes {
    static constexpr bool PERM = true;
    const void* base; bf16_t* T; const float* gate;
    __device__ __forceinline__ void operator()(const f32x4 (&acc)[2][2][4][2], const pg8::Unit& u, int wr, int wc, int fr, int fq) const {
        asm volatile("" : "+v"(fr), "+v"(fq));
        const int row0 = u.pm * 256 + wr * 64 + fr, c0 = u.pn * 256 + wc * 32 + 8 * fq;
#pragma unroll
        for (int ai = 0; ai < 2; ++ai)
#pragma unroll
            for (int m = 0; m < 4; ++m) { const size_t ro = (size_t)(row0 + ai * 128 + m * 16) * DM;
#pragma unroll
                for (int bj = 0; bj < 2; ++bj) { const int c = c0 + bj * 128; f32x4 b0, b1;
                    if (BASE_BF16) { const u32x4 bw = *(const u32x4*)((const bf16_t*)base + ro + c); b0 = (f32x4){bflo(bw.x), bfhi(bw.x), bflo(bw.y), bfhi(bw.y)}; b1 = (f32x4){bflo(bw.z), bfhi(bw.z), bflo(bw.w), bfhi(bw.w)}; }
                    else { b0 = *(const f32x4*)((const float*)base + ro + c); b1 = *(const f32x4*)((const float*)base + ro + c + 4); }
                    const f32x4 g0 = *(const f32x4*)(gate + c), g1 = *(const f32x4*)(gate + c + 4);
                    const f32x4 v0 = b0 * ALPHA + g0 * acc[ai][bj][m][0], v1 = b1 * ALPHA + g1 * acc[ai][bj][m][1];
                    u32x4 w; w.x = pg8::cvt_pk_bf16(v0[0], v0[1]); w.y = pg8::cvt_pk_bf16(v0[2], v0[3]); w.z = pg8::cvt_pk_bf16(v1[0], v1[1]); w.w = pg8::cvt_pk_bf16(v1[2], v1[3]);
                    *(u32x4*)(T + ro + c) = w; } }
    }
};
struct PanelStats {
    unsigned* xbuf; unsigned* cnt; float eps;
    __device__ __forceinline__ void run(const f32x4 (&v)[2][2][4][2], const pg8::Unit& u, int wr, int wc, int fr, int fq, LAS unsigned char* lds, int wid, int lane) const {
        LAS f32x2* P = (LAS f32x2*)(lds + LN_LDS);
        LAS f32x2* S = (LAS f32x2*)(lds + LN_LDS + 8192);
#pragma unroll
        for (int ai = 0; ai < 2; ++ai)
#pragma unroll
            for (int m = 0; m < 4; ++m) {
                float s = 0.f;
#pragma unroll
                for (int bj = 0; bj < 2; ++bj)
#pragma unroll
                    for (int n = 0; n < 2; ++n) { const f32x4 x = v[ai][bj][m][n]; s += (x[0] + x[1]) + (x[2] + x[3]); }
                s += __shfl_xor(s, 16); s += __shfl_xor(s, 32);
                const float mw = s * (1.0f / 64.0f); float q = 0.f;
#pragma unroll
                for (int bj = 0; bj < 2; ++bj)
#pragma unroll
                    for (int n = 0; n < 2; ++n) { const f32x4 d = v[ai][bj][m][n] - mw; q += (d[0] * d[0] + d[1] * d[1]) + (d[2] * d[2] + d[3] * d[3]); }
                q += __shfl_xor(q, 16); q += __shfl_xor(q, 32);
                if (fq == 0) P[(ai * 128 + wr * 64 + m * 16 + fr) * 4 + wc] = (f32x2){mw, q};
                __builtin_amdgcn_sched_barrier(0);
            }
        asm volatile("s_waitcnt lgkmcnt(0)" ::: "memory"); __builtin_amdgcn_s_barrier(); asm volatile("" ::: "memory");
        const int row = wid * 32 + (lane & 31);
        if (lane < 32) {
            const f32x2 a = P[row * 4 + 0], b = P[row * 4 + 1], c = P[row * 4 + 2], d = P[row * 4 + 3];
            const float mt = (a.x + b.x + c.x + d.x) * 0.25f;
            const float da = a.x - mt, db = b.x - mt, dc = c.x - mt, dd = d.x - mt;
            const float m2 = (a.y + b.y) + (c.y + d.y) + 64.0f * ((da * da + db * db) + (dc * dc + dd * dd));
            unsigned long long* slot = (unsigned long long*)xbuf + ((size_t)(u.pm * 256 + row) * 4 + u.pn);
            __hip_atomic_store(slot, ((unsigned long long)__float_as_uint(m2) << 32) | __float_as_uint(mt), __ATOMIC_RELAXED, __HIP_MEMORY_SCOPE_AGENT);
        }
        asm volatile("s_waitcnt vmcnt(0)" ::: "memory");
        if (lane == 0) __hip_atomic_fetch_add(cnt + 64 * u.pm, 1u, __ATOMIC_RELAXED, __HIP_MEMORY_SCOPE_AGENT);
        if (wid == 0) {
            unsigned sp = 0;
            while ((unsigned)__builtin_amdgcn_readfirstlane(__hip_atomic_load(cnt + 64 * u.pm, __ATOMIC_RELAXED, __HIP_MEMORY_SCOPE_AGENT)) < 32u && ++sp < (1u << 21)) __builtin_amdgcn_s_sleep(2);
            __builtin_amdgcn_fence(__ATOMIC_ACQUIRE, "agent");
        }
        asm volatile("s_waitcnt vmcnt(0) lgkmcnt(0)" ::: "memory"); __builtin_amdgcn_s_barrier(); asm volatile("" ::: "memory");
        if (lane < 32) {
            const unsigned long long* slot = (const unsigned long long*)xbuf + (size_t)(u.pm * 256 + row) * 4; float mt[4], m2[4]; float ms = 0.f;
#pragma unroll
            for (int t = 0; t < 4; ++t) { const unsigned long long w = __hip_atomic_load(slot + t, __ATOMIC_RELAXED, __HIP_MEMORY_SCOPE_AGENT); mt[t] = __uint_as_float((unsigned)w); m2[t] = __uint_as_float((unsigned)(w >> 32)); ms += mt[t]; }
            const float mean = ms * 0.25f; float q = 0.f;
#pragma unroll
            for (int t = 0; t < 4; ++t) { const float dm = mt[t] - mean; q += m2[t] + 256.0f * dm * dm; }
            S[row] = (f32x2){mean, 1.0f / sqrtf(q * (1.0f / 1024.0f) + eps)};
        }
        asm volatile("s_waitcnt lgkmcnt(0)" ::: "memory"); __builtin_amdgcn_s_barrier(); asm volatile("" ::: "memory");
    }
};
template <bool FINAL> struct EpiResLn {
    static constexpr bool PERM = true;
    const void* base; const float* gate; const float* lg; const float* lb; const float* mod; bf16_t* X1B; bf16_t* XN; float* out; PanelStats st; LAS unsigned char* lds;
    __device__ __forceinline__ void operator()(f32x4 (&acc)[2][2][4][2], const pg8::Unit& u, int wr, int wc, int fr, int fq) const {
        asm volatile("" : "+v"(fr), "+v"(fq));
        const int row0 = u.pm * 256 + wr * 64 + fr, c0 = u.pn * 256 + wc * 32 + 8 * fq;
#pragma unroll
        for (int ai = 0; ai < 2; ++ai)
#pragma unroll
            for (int m = 0; m < 4; ++m) { int rr_ = row0 + ai * 128 + m * 16; asm volatile("" : "+v"(rr_)); const size_t ro = (size_t)rr_ * DM;
#pragma unroll
                for (int bj = 0; bj < 2; ++bj) { int c = c0 + bj * 128; asm volatile("" : "+v"(c)); f32x4 b0, b1;
                    if (FINAL) { const u32x4 bw = *(const u32x4*)((const bf16_t*)base + ro + c); b0 = (f32x4){bflo(bw.x), bfhi(bw.x), bflo(bw.y), bfhi(bw.y)}; b1 = (f32x4){bflo(bw.z), bfhi(bw.z), bflo(bw.w), bfhi(bw.w)}; }
                    else { b0 = *(const f32x4*)((const float*)base + ro + c); b1 = *(const f32x4*)((const float*)base + ro + c + 4); }
                    const f32x4 g0 = *(const f32x4*)(gate + c), g1 = *(const f32x4*)(gate + c + 4);
                    acc[ai][bj][m][0] = b0 * ALPHA + g0 * acc[ai][bj][m][0]; acc[ai][bj][m][1] = b1 * ALPHA + g1 * acc[ai][bj][m][1];
                    asm volatile("" : "+v"(acc[ai][bj][m][0]), "+v"(acc[ai][bj][m][1])); }
                __builtin_amdgcn_sched_barrier(0); }
        st.run(acc, u, wr, wc, fr, fq, lds, wr * 4 + wc, fq * 16 + fr);
        const LAS f32x2* S = (const LAS f32x2*)(lds + LN_LDS + 8192);
#pragma unroll
        for (int ai = 0; ai < 2; ++ai)
#pragma unroll
            for (int m = 0; m < 4; ++m) { int r = ai * 128 + wr * 64 + m * 16 + fr; asm volatile("" : "+v"(r)); const f32x2 sr = S[r]; const size_t ro = (size_t)(u.pm * 256 + r) * DM;
#pragma unroll
                for (int bj = 0; bj < 2; ++bj) { int c = c0 + bj * 128; asm volatile("" : "+v"(c));
                    const f32x4 y0 = (acc[ai][bj][m][0] - sr.x) * sr.y * *(const f32x4*)(lg + c) + *(const f32x4*)(lb + c);
                    const f32x4 y1 = (acc[ai][bj][m][1] - sr.x) * sr.y * *(const f32x4*)(lg + c + 4) + *(const f32x4*)(lb + c + 4);
                    if (FINAL) { __builtin_nontemporal_store(y0, (f32x4*)(out + ro + c)); __builtin_nontemporal_store(y1, (f32x4*)(out + ro + c + 4)); }
                    else { u32x4 w; w.x = pg8::cvt_pk_bf16(y0[0], y0[1]); w.y = pg8::cvt_pk_bf16(y0[2], y0[3]); w.z = pg8::cvt_pk_bf16(y1[0], y1[1]); w.w = pg8::cvt_pk_bf16(y1[2], y1[3]);
                        *(u32x4*)(X1B + ro + c) = w;
                        const f32x4 h0 = y0 * (*(const f32x4*)(mod + 4096 + c) + 1.0f) + *(const f32x4*)(mod + 3072 + c), h1 = y1 * (*(const f32x4*)(mod + 4096 + c + 4) + 1.0f) + *(const f32x4*)(mod + 3072 + c + 4);
                        u32x4 w2; w2.x = pg8::cvt_pk_bf16(h0[0], h0[1]); w2.y = pg8::cvt_pk_bf16(h0[2], h0[3]); w2.z = pg8::cvt_pk_bf16(h1[0], h1[1]); w2.w = pg8::cvt_pk_bf16(h1[2], h1[3]);
                        *(u32x4*)(XN + ro + c) = w2; } }
                __builtin_amdgcn_sched_barrier(0); }
    }
};
struct EpiSlab {
    static constexpr bool PERM = true;
    float* slab;
    __device__ __forceinline__ void operator()(const f32x4 (&acc)[2][2][4][2], const pg8::Unit& u, int wr, int wc, int fr, int fq) const {
        asm volatile("" : "+v"(fr), "+v"(fq));
        const int row0 = wr * 64 + fr, c0 = u.pn * 256 + wc * 32 + 8 * fq; float* sb = slab + (size_t)u.ks * NSMP * DM;
#pragma unroll
        for (int ai = 0; ai < 2; ++ai)
#pragma unroll
            for (int m = 0; m < 4; ++m) { float* op = sb + (size_t)(row0 + ai * 128 + m * 16) * DM + c0;
#pragma unroll
                for (int bj = 0; bj < 2; ++bj) { *(f32x4*)(op + bj * 128) = acc[ai][bj][m][0]; *(f32x4*)(op + bj * 128 + 4) = acc[ai][bj][m][1]; } }
    }
};
struct EpiFfn {
    static constexpr bool PERM = true;
    bf16_t* ACT;
    __device__ __forceinline__ void operator()(const f32x4 (&acc)[2][2][4][2], const pg8::Unit& u, int wr, int wc, int fr, int fq) const {
        asm volatile("" : "+v"(fr), "+v"(fq));
        const int row0 = u.pm * 256 + wr * 64 + fr, c0 = u.pn * 128 + wc * 32 + 8 * fq;
#pragma unroll
        for (int ai = 0; ai < 2; ++ai)
#pragma unroll
            for (int m = 0; m < 4; ++m) { const f32x4 g0 = acc[ai][0][m][0], g1 = acc[ai][0][m][1], u0 = acc[ai][1][m][0], u1 = acc[ai][1][m][1];
                u32x4 w; w.x = pg8::cvt_pk_bf16(siluf_(g0[0]) * u0[0], siluf_(g0[1]) * u0[1]); w.y = pg8::cvt_pk_bf16(siluf_(g0[2]) * u0[2], siluf_(g0[3]) * u0[3]);
                w.z = pg8::cvt_pk_bf16(siluf_(g1[0]) * u1[0], siluf_(g1[1]) * u1[1]); w.w = pg8::cvt_pk_bf16(siluf_(g1[2]) * u1[2], siluf_(g1[3]) * u1[3]);
                *(u32x4*)(ACT + (size_t)(row0 + ai * 128 + m * 16) * DFF + c0) = w; }
    }
};

struct Frame {
    LAS unsigned char* lds; unsigned char* ldsg;
    int tid, lane, wave, G, bid;
    const float* const* in; float* out; unsigned char* ws;
};
enum { I_XP = 0, I_XS, I_CDK, I_CDV, I_CFK, I_CFV, I_CFL, I_CP, I_CS, I_WADA, I_BADA, I_WIN, I_BF, I_LQ1, I_LK1, I_LQ2, I_LK2, I_SUBG, I_RELB, I_WA, I_WB, I_WO, I_LN1G, I_LN1B, I_LN2G, I_LN2B, I_WFI, I_WFO };

__device__ __forceinline__ void tr_item(const float* W, int ldw, int src_n0, int k0, bf16_t* WT, int ldt, int dst_row0, int dst_k0, int dup_off, LAS float* scr, int lane) {
#pragma unroll 8
    for (int i = 0; i < 32; ++i) { const int kk = 2 * i + (lane >> 5); scr[kk * 33 + (lane & 31)] = W[(size_t)(k0 + kk) * ldw + src_n0 + (lane & 31)]; }
    asm volatile("s_waitcnt lgkmcnt(0)" ::: "memory");
    const int c = lane & 7;
#pragma unroll
    for (int j = 0; j < 4; ++j) { const int n = (lane >> 3) + 8 * j; const LAS float* s = scr + (8 * c) * 33 + n;
        u32x4 o; o.x = pk2(s[0 * 33], s[1 * 33]); o.y = pk2(s[2 * 33], s[3 * 33]); o.z = pk2(s[4 * 33], s[5 * 33]); o.w = pk2(s[6 * 33], s[7 * 33]);
        bf16_t* d = WT + (size_t)(dst_row0 + n) * ldt + dst_k0 + 8 * c;
        *(u32x4*)d = o; if (dup_off) *(u32x4*)(d + dup_off) = o; }
    asm volatile("s_waitcnt lgkmcnt(0)" ::: "memory");
}
__device__ __forceinline__ void weight_copies(Frame& F, int c, int n, int it0, int it1) {
    LAS float* scr = (LAS float*)(F.lds + F.wave * 16384);
    const int gw = c * 8 + F.wave, NGW = n * 8;
    constexpr int I_IN = 16 * (NZ / 32), I_A = 8 * 32, I_B = 8 * 32, I_O = 16 * 32, I_FI = 16 * (NFF2 / 32), I_FO = (DFF / 64) * 32;
    for (int it = it0 + gw; it < it1; it += NGW) {
        int r = it;
        if (r < I_IN) { const int nb = NZ / 32, kb = r / nb, n0 = 32 * (r % nb); tr_item(F.in[I_WIN], WIN_COLS, n0 < 3072 ? n0 : n0 + 8, 64 * kb, (bf16_t*)(F.ws + WS_WIN), 1024, n0, 64 * kb, 0, scr, F.lane); continue; } r -= I_IN;
        if (r < I_A) { const int kb = r / 32, n0 = 32 * (r % 32); tr_item(F.in[I_WA], 1024, n0, 64 * kb, (bf16_t*)(F.ws + WS_WAB), 512, n0, 64 * kb, 0, scr, F.lane); continue; } r -= I_A;
        if (r < I_B) { const int kb = r / 32, n0 = 32 * (r % 32); tr_item(F.in[I_WB], 1024, n0, 64 * kb, (bf16_t*)(F.ws + WS_WAB), 512, 1024 + n0, 64 * kb, 0, scr, F.lane); continue; } r -= I_B;
        if (r < I_O) { const int kb = r / 32, n0 = 32 * (r % 32); tr_item(F.in[I_WO], 1024, n0, 64 * kb, (bf16_t*)(F.ws + WS_WO2), 2048, n0, 64 * kb, 1024, scr, F.lane); continue; } r -= I_O;
        if (r < I_FI) { const int nb = NFF2 / 32, kb = r / nb, n0 = 32 * (r % nb), t = n0 >> 8, j = n0 & 255; const int src = j < 128 ? 128 * t + j : DFF + 128 * t + (j - 128);
            tr_item(F.in[I_WFI], NFF2, src, 64 * kb, (bf16_t*)(F.ws + WS_WFI), 1024, n0, 64 * kb, 0, scr, F.lane); continue; } r -= I_FI;
        { const int kb = r / 32, n0 = 32 * (r % 32); tr_item(F.in[I_WFO], 1024, n0, 64 * kb, (bf16_t*)(F.ws + WS_WFO), DFF, n0, 64 * kb, 0, scr, F.lane); }
    }
}
constexpr int WC_IN = 16 * (NZ / 32), WC_ALL = WC_IN + 8 * 32 + 8 * 32 + 16 * 32 + 16 * (NFF2 / 32) + (DFF / 64) * 32;
__device__ __forceinline__ void p0_prologue(Frame& F) {
    if (F.bid < 96) {
        LAS float* sc = (LAS float*)F.lds;
        LAS float* part = sc + 17 * 1024;
        { float cv[34];
#pragma unroll
          for (int j = 0; j < 34; ++j) { const int i = F.tid + 512 * j, r = i >> 10, k = i & 1023; cv[j] = r == 0 ? F.in[I_CP][k] : F.in[I_CS][(r - 1) * 1024 + k]; }
#pragma unroll
          for (int j = 0; j < 34; ++j) sc[F.tid + 512 * j] = siluf_(cv[j]); }
        __syncthreads();
        const int n = F.bid * 64 + F.lane; const float* wa = F.in[I_WADA] + n;
        float acc[17];
#pragma unroll
        for (int r = 0; r < 17; ++r) acc[r] = 0.f;
#pragma unroll 8
        for (int k = F.wave * 128; k < F.wave * 128 + 128; k += 4) {
            const float w0 = wa[(size_t)k * 6144], w1 = wa[(size_t)(k + 1) * 6144], w2 = wa[(size_t)(k + 2) * 6144], w3 = wa[(size_t)(k + 3) * 6144];
#pragma unroll
            for (int r = 0; r < 17; ++r) { const f32x4 s = *(const LAS f32x4*)(sc + r * 1024 + k); acc[r] += s[0] * w0 + s[1] * w1 + s[2] * w2 + s[3] * w3; }
        }
#pragma unroll
        for (int r = 0; r < 17; ++r) part[(F.wave * 17 + r) * 64 + F.lane] = acc[r];
        __syncthreads();
        float* mod = (float*)(F.ws + WS_MOD);
        for (int i = F.tid; i < 17 * 64; i += 512) { const int r = i >> 6, l = i & 63; float s = 0.f;
#pragma unroll
            for (int w = 0; w < 8; ++w) s += part[(w * 17 + r) * 64 + l];
            mod[r * 6144 + F.bid * 64 + l] = s + F.in[I_BADA][F.bid * 64 + l]; }
        asm volatile("s_waitcnt vmcnt(0)" ::: "memory");
        __syncthreads();
        if (F.tid == 0) { __builtin_amdgcn_fence(__ATOMIC_RELEASE, "agent"); asm volatile("s_waitcnt vmcnt(0)" ::: "memory");
            __hip_atomic_fetch_add((unsigned*)(F.ws + WS_CTL) + 320, 1u, __ATOMIC_RELAXED, __HIP_MEMORY_SCOPE_AGENT); }
    }
    if (F.G >= 192) { if (F.bid >= 96) weight_copies(F, F.bid - 96, F.G - 96, 0, 16 * (NZ / 32)); }
    else weight_copies(F, F.bid, F.G, 0, 16 * (NZ / 32));
}

__device__ __forceinline__ void p1_rows(Frame& F, bool wait_mod) {
    LAS float* wf = (LAS float*)F.lds;
    for (int i = F.tid; i < 1024 * 8; i += 512) wf[i] = F.in[I_WIN][(size_t)(i >> 3) * WIN_COLS + 3072 + (i & 7)];
    __syncthreads();
    const float* mod = (const float*)(F.ws + WS_MOD);
    bf16_t* XN = (bf16_t*)(F.ws + WS_XN);
    const int gw = F.bid * 8 + F.wave, NGW = F.G * 8;
    if (wait_mod) {
        if (F.tid == 0) { unsigned* w = (unsigned*)(F.ws + WS_CTL) + 320; unsigned sp = 0;
            while (__hip_atomic_load(w, __ATOMIC_RELAXED, __HIP_MEMORY_SCOPE_AGENT) < 96u && ++sp < (1u << 22)) __builtin_amdgcn_s_sleep(2);
            __builtin_amdgcn_fence(__ATOMIC_ACQUIRE, "agent"); asm volatile("s_waitcnt vmcnt(0)" ::: "memory"); }
        __syncthreads(); }
    int m = gw;
    for (; m + NGW < SEQ; m += 2 * NGW) {
        const float* xr0 = F.in[I_XP] + (size_t)m * DM; const float* xr1 = xr0 + (size_t)NGW * DM;
        float a8[2][8];
#pragma unroll
        for (int j = 0; j < 8; ++j) { a8[0][j] = 0.f; a8[1][j] = 0.f; }
#pragma unroll
        for (int j = 0; j < 4; ++j) { const int k = 4 * F.lane + 256 * j;
            const f32x4 x0 = *(const f32x4*)(xr0 + k), x1 = *(const f32x4*)(xr1 + k), s1 = *(const f32x4*)(mod + 1024 + k), t1 = *(const f32x4*)(mod + k);
            const f32x4 h0 = x0 * (s1 + 1.0f) + t1, h1 = x1 * (s1 + 1.0f) + t1;
            u32x2 w; w.x = pk2(h0[0], h0[1]); w.y = pk2(h0[2], h0[3]); *(u32x2*)(XN + (size_t)m * DM + k) = w;
            w.x = pk2(h1[0], h1[1]); w.y = pk2(h1[2], h1[3]); *(u32x2*)(XN + (size_t)(m + NGW) * DM + k) = w;
#pragma unroll
            for (int e = 0; e < 4; ++e) { const f32x4 wa = *(const LAS f32x4*)(wf + (k + e) * 8), wb = *(const LAS f32x4*)(wf + (k + e) * 8 + 4);
#pragma unroll
                for (int c = 0; c < 4; ++c) { a8[0][c] += h0[e] * wa[c]; a8[0][4 + c] += h0[e] * wb[c]; a8[1][c] += h1[e] * wa[c]; a8[1][4 + c] += h1[e] * wb[c]; } } }
        float mine = 0.f;
#pragma unroll
        for (int j = 0; j < 8; ++j) { const float s0 = wave_sum(a8[0][j]), s1 = wave_sum(a8[1][j]); if (F.lane == j) mine = s0; if (F.lane == 8 + j) mine = s1; }
        if (F.lane < 16) { const int rr = F.lane >> 3, c = F.lane & 7; const float v = mine + F.in[I_BF][c]; const float lf = fminf(v, 0.f) - log1pf(__expf(-fabsf(v)));
            F.out[O_FLP + (size_t)(m + rr * NGW) * 8 + c] = lf; }
    }
    for (; m < MT; m += NGW) {
        const bool smp = m >= SEQ; const int rb = smp ? 1 + ((m - SEQ) >> 4) : 0;
        const float* xr = smp ? F.in[I_XS] + (size_t)(m - SEQ) * DM : F.in[I_XP] + (size_t)m * DM;
        const float* sh = mod + (size_t)rb * 6144, *scl = sh + 1024;
        float a8[8];
#pragma unroll
        for (int j = 0; j < 8; ++j) a8[j] = 0.f;
#pragma unroll
        for (int j = 0; j < 4; ++j) { const int k = 4 * F.lane + 256 * j;
            const f32x4 x = *(const f32x4*)(xr + k), s1 = *(const f32x4*)(scl + k), t1 = *(const f32x4*)(sh + k);
            const f32x4 h = x * (s1 + 1.0f) + t1;
            u32x2 w; w.x = pk2(h[0], h[1]); w.y = pk2(h[2], h[3]); *(u32x2*)(XN + (size_t)m * DM + k) = w;
#pragma unroll
            for (int e = 0; e < 4; ++e) { const f32x4 wa = *(const LAS f32x4*)(wf + (k + e) * 8), wb = *(const LAS f32x4*)(wf + (k + e) * 8 + 4);
                a8[0] += h[e] * wa[0]; a8[1] += h[e] * wa[1]; a8[2] += h[e] * wa[2]; a8[3] += h[e] * wa[3];
                a8[4] += h[e] * wb[0]; a8[5] += h[e] * wb[1]; a8[6] += h[e] * wb[2]; a8[7] += h[e] * wb[3]; } }
        float mine = 0.f;
#pragma unroll
        for (int j = 0; j < 8; ++j) { const float s = wave_sum(a8[j]); if (F.lane == j) mine = s; }
        if (F.lane < 8) { const float v = mine + F.in[I_BF][F.lane]; const float lf = fminf(v, 0.f) - log1pf(__expf(-fabsf(v)));
            float* o = smp ? F.out + O_FLS + (size_t)(m - SEQ) * 8 : F.out + O_FLP + (size_t)m * 8; o[F.lane] = lf; }
    }
}

__device__ __forceinline__ float block_excl_scan(Frame& F, float tot, LAS float* sm) {
    float inc = tot;
#pragma unroll
    for (int o = 1; o < 64; o <<= 1) { const float t = __shfl_up(inc, o); if (F.lane >= o) inc += t; }
    if (F.lane == 63) sm[F.wave] = inc;
    __syncthreads();
    float base = 0.f;
    for (int w = 0; w < F.wave; ++w) base += sm[w];
    __syncthreads();
    return base + inc - tot;
}
__device__ __forceinline__ void p2_cumsum(Frame& F) {
    LAS float* sm = (LAS float*)F.lds;
    const int rb_ = F.G >= 160 ? F.bid - 20 : F.bid;
    if (rb_ < 0) return;
    if (rb_ < 8) {
        const int h = rb_; const float* lf = F.out + O_FLP; float* Fp = (float*)(F.ws + WS_FP) + (size_t)h * SEQ;
        float v[32]; float run = 0.f;
#pragma unroll
        for (int i = 0; i < 32; ++i) { run += lf[(size_t)(32 * F.tid + i) * 8 + h]; v[i] = run; }
        const float off = block_excl_scan(F, run, sm);
#pragma unroll
        for (int i = 0; i < 32; i += 4) *(f32x4*)(Fp + 32 * F.tid + i) = (f32x4){(off + v[i]) * LOG2E, (off + v[i + 1]) * LOG2E, (off + v[i + 2]) * LOG2E, (off + v[i + 3]) * LOG2E};
    } else if (rb_ < 8 + 128) {
        const int b = (rb_ - 8) >> 3, h = (rb_ - 8) & 7;
        const float* cl = F.in[I_CFL] + (size_t)b * PAST * 8; float* Fs = (float*)(F.ws + WS_FS) + (size_t)(b * 8 + h) * SKV;
        float v[4]; float run = 0.f;
#pragma unroll
        for (int i = 0; i < 4; ++i) { run += cl[(size_t)(4 * F.tid + i) * 8 + h]; v[i] = run; }
        const float off = block_excl_scan(F, run, sm);
        *(f32x4*)(Fs + 4 * F.tid) = (f32x4){(off + v[0]) * LOG2E, (off + v[1]) * LOG2E, (off + v[2]) * LOG2E, (off + v[3]) * LOG2E};
        if (F.tid == 511) { float r2 = off + run; const float* ls = F.out + O_FLS + (size_t)b * DEC_T * 8;
            for (int t = 0; t < DEC_T; ++t) { r2 += ls[t * 8 + h]; Fs[PAST + t] = r2 * LOG2E; } }
    }
}

template <bool FINAL> __device__ __forceinline__ void ln_rows(Frame& F, const float* g, const float* b, int KS, int gate_off) {
    const float* mod = (const float*)(F.ws + WS_MOD);
    const bf16_t* T = (const bf16_t*)(F.ws + WS_TB); bf16_t* X1B = (bf16_t*)(F.ws + WS_X1B); bf16_t* XN = (bf16_t*)(F.ws + WS_XN);
    const int gw = F.wave * F.G + F.bid, NGW = F.G * 8;
    for (int m = SEQ + gw; m < MT; m += NGW) {
        f32x4 v[4]; float s = 0.f;
        if (m < SEQ) {
#pragma unroll
            for (int j = 0; j < 2; ++j) { const u32x4 w = *(const u32x4*)(T + (size_t)m * DM + 8 * F.lane + 512 * j);
                v[2 * j] = (f32x4){bflo(w.x), bfhi(w.x), bflo(w.y), bfhi(w.y)}; v[2 * j + 1] = (f32x4){bflo(w.z), bfhi(w.z), bflo(w.w), bfhi(w.w)}; }
        } else {
            const float* sl = (const float*)(F.ws + WS_SLAB) + (size_t)(m - SEQ) * DM; const float* gp = mod + (size_t)(1 + ((m - SEQ) >> 4)) * 6144 + gate_off;
#pragma unroll
            for (int q = 0; q < 4; ++q) { const int k = 8 * F.lane + 512 * (q >> 1) + 4 * (q & 1); f32x4 a = (f32x4){0.f, 0.f, 0.f, 0.f};
                for (int ks = 0; ks < KS; ++ks) a += *(const f32x4*)(sl + (size_t)ks * NSMP * DM + k);
                f32x4 bs;
                if (FINAL) { const u32x2 w = *(const u32x2*)(X1B + (size_t)m * DM + k); bs = (f32x4){bflo(w.x), bfhi(w.x), bflo(w.y), bfhi(w.y)}; }
                else bs = *(const f32x4*)(F.in[I_XS] + (size_t)(m - SEQ) * DM + k);
                v[q] = bs * ALPHA + *(const f32x4*)(gp + k) * a; } }
#pragma unroll
        for (int q = 0; q < 4; ++q) s += (v[q][0] + v[q][1]) + (v[q][2] + v[q][3]);
        const float mean = wave_sum(s) * (1.f / DM); float s2 = 0.f;
#pragma unroll
        for (int q = 0; q < 4; ++q) { v[q] = v[q] - mean; s2 += (v[q][0] * v[q][0] + v[q][1] * v[q][1]) + (v[q][2] * v[q][2] + v[q][3] * v[q][3]); }
        const float rstd = 1.f / sqrtf(wave_sum(s2) * (1.f / DM) + LN_EPS);
        const int rb = m >= SEQ ? 1 + ((m - SEQ) >> 4) : 0;
#pragma unroll
        for (int q = 0; q < 4; ++q) { const int k = 8 * F.lane + 512 * (q >> 1) + 4 * (q & 1); const f32x4 gg = *(const f32x4*)(g + k), bb = *(const f32x4*)(b + k);
            const f32x4 y = v[q] * rstd * gg + bb;
            if (FINAL) *(f32x4*)(F.out + (size_t)m * DM + k) = y;
            else { u32x2 w; w.x = pk2(y[0], y[1]); w.y = pk2(y[2], y[3]); *(u32x2*)(X1B + (size_t)m * DM + k) = w;
                const f32x4 s2v = *(const f32x4*)(mod + (size_t)rb * 6144 + 4096 + k), t2v = *(const f32x4*)(mod + (size_t)rb * 6144 + 3072 + k);
                const f32x4 h = y * (s2v + 1.0f) + t2v; u32x2 w2; w2.x = pk2(h[0], h[1]); w2.y = pk2(h[2], h[3]); *(u32x2*)(XN + (size_t)m * DM + k) = w2; } }
    }
}

__device__ __forceinline__ int t5_bucket(int rel) {
    const int n = rel < 0 ? -rel : rel; int b;
    if (n < 8) b = n; else if (n < 12) b = 8; else if (n < 16) b = 9; else if (n < 23) b = 10; else if (n < 32) b = 11; else if (n < 46) b = 12; else if (n < 64) b = 13; else if (n < 91) b = 14; else b = 15;
    return b + (rel > 0 ? 16 : 0);
}
constexpr int AT_KB = 8192, AT_VB = 20480, AT_BUF = AT_KB + AT_VB;
constexpr int AT_WS = 2 * AT_BUF, AT_OST = AT_WS + 2048, AT_KEEP = 98304, AT_TAB = 131072, AT_MISC = AT_TAB + 4 * 192 * 4, AT_END = AT_MISC + 64;
__device__ __forceinline__ s16x4 vtr(const LAS char* p) { typedef short v4i16_t __attribute__((ext_vector_type(4))); return __builtin_bit_cast(s16x4, __builtin_amdgcn_ds_read_tr16_b64_v4i16((LAS v4i16_t*)p)); }

typedef __bf16 bf16x2_t_ __attribute__((ext_vector_type(2)));
__device__ __forceinline__ unsigned cvtpk_(float lo, float hi) { f32x2 v = {lo, hi}; bf16x2_t_ b = __builtin_convertvector(v, bf16x2_t_); return __builtin_bit_cast(unsigned, b); }
__device__ __forceinline__ void glds16_asm(const void* gsrc, unsigned lds_dst) { unsigned keep;
    asm volatile("s_mov_b32 %0, m0\n\ts_mov_b32 m0, %2\n\ts_nop 0\n\tglobal_load_lds_dwordx4 %1, off\n\ts_mov_b32 m0, %0" : "=&s"(keep) : "v"(gsrc), "s"(lds_dst) : "memory"); }
template <int OFF> __device__ __forceinline__ void glds16_asm_off(const void* gsrc, unsigned lds_dst) { unsigned keep;
    asm volatile("s_mov_b32 %0, m0\n\ts_mov_b32 m0, %2\n\ts_nop 0\n\tglobal_load_lds_dwordx4 %1, off offset:%3\n\ts_mov_b32 m0, %0" : "=&s"(keep) : "v"(gsrc), "s"(lds_dst), "i"(OFF) : "memory"); }
template <int OFF> __device__ __forceinline__ void glds16_s(const void* sbase, unsigned voff, unsigned lds_dst) { unsigned keep;
    asm volatile("s_mov_b32 %0, m0\n\ts_mov_b32 m0, %3\n\ts_nop 0\n\tglobal_load_lds_dwordx4 %1, %2 offset:%4\n\ts_mov_b32 m0, %0" : "=&s"(keep) : "v"(voff), "s"(sbase), "s"(lds_dst), "i"(OFF) : "memory"); }
__device__ __forceinline__ void glds4_s(const void* sbase, unsigned voff, unsigned lds_dst) { unsigned keep;
    asm volatile("s_mov_b32 %0, m0\n\ts_mov_b32 m0, %3\n\ts_nop 0\n\tglobal_load_lds_dword %1, %2\n\ts_mov_b32 m0, %0" : "=&s"(keep) : "v"(voff), "s"(sbase), "s"(lds_dst) : "memory"); }
__device__ __forceinline__ const void* uniform_ptr(const void* p) { const unsigned long long v = (unsigned long long)p;
    const unsigned lo = (unsigned)__builtin_amdgcn_readfirstlane((int)(unsigned)v), hi = (unsigned)__builtin_amdgcn_readfirstlane((int)(unsigned)(v >> 32)); return (const void*)(((unsigned long long)hi << 32) | lo); }
__device__ __forceinline__ void glds4_asm(const void* gsrc, unsigned lds_dst) { unsigned keep;
    asm volatile("s_mov_b32 %0, m0\n\ts_mov_b32 m0, %2\n\ts_nop 0\n\tglobal_load_lds_dword %1, off\n\ts_mov_b32 m0, %0" : "=&s"(keep) : "v"(gsrc), "s"(lds_dst) : "memory"); }
constexpr int R_V = 0, R_K = 49152, R_F = 73728, R_WS = 79872;
__device__ __forceinline__ float max3f_(float a, float b, float c) { float r; asm("v_max3_f32 %0, %1, %2, %3" : "=v"(r) : "v"(a), "v"(b), "v"(c)); return r; }
__device__ __forceinline__ float max2f_(float a, float b) { float r; asm("v_max_f32_e32 %0, %1, %2" : "=v"(r) : "v"(a), "v"(b)); return r; }
#define AP3_PIN(x) asm volatile("" : "+v"(x))
template <int MODE, int DV, int pv = 0, bool SREF = false>
__device__ __forceinline__ void attn_pass3(Frame& F, const bf16_t* Q, const bf16_t* K, const bf16_t* V, int q0, int NT, const float* Fh, int hb, f32x16 (&o)[DV / 32], int t0 = 0) {
    constexpr int NDB = DV / 32, VS = DV * 128, EPG = 8 / NDB;
    constexpr float THR = 8.0f;
    const int lane = F.lane, r32 = lane & 31, hi = lane >> 5, wid = F.wave;
    const LAS char* lds = (const LAS char*)F.lds;
    LAS float* wsf = (LAS float*)(F.lds + R_WS) + wid * 64;
    const LAS float* tab = (const LAS float*)(F.lds + AT_TAB) + hb * 192;
    const int qrow = q0 + wid * 32 + r32;
    const int tmaxw = (q0 >> 6) + (wid >> 1);
    const char* Ku = (const char*)uniform_ptr(K); const char* Vu = (const char*)uniform_ptr(V); const char* Fu = (const char*)uniform_ptr(MODE == 0 ? (const void*)Fh : (const void*)K);
    const unsigned kvo = (unsigned)(((8 * wid + (lane >> 3)) * 512 + (((lane & 7) ^ (lane >> 3)) << 3)) * 2);
    const unsigned vvo = (unsigned)(((16 * (wid & 3) + (lane >> 2)) * 512 + 32 * (wid >> 2) + 8 * (lane & 3)) * 2);
    const unsigned fvo = (unsigned)(lane * 4);
    const unsigned lds0 = (unsigned)(size_t)F.lds;
    const unsigned dk = (unsigned)__builtin_amdgcn_readfirstlane((int)(lds0 + R_K + wid * 1024)), dv = (unsigned)__builtin_amdgcn_readfirstlane((int)(lds0 + R_V + wid * 1024)),
                   df = (unsigned)__builtin_amdgcn_readfirstlane((int)(lds0 + R_F + wid * 256));
#define AP_ISSUE_K(t, SL) do { glds16_s<0>(Ku + (size_t)(t) * 65536, kvo, dk + (SL) * 8192); if (MODE == 0) glds4_s(Fu + (size_t)(t) * 256, fvo, df + (SL) * 2048); } while (0)
#define AP_ISSUE_V(t, SL) do { glds16_s<0>(Vu + (size_t)(t) * 65536, vvo, dv + (SL) * VS); if (DV == 128) glds16_s<0>(Vu + (size_t)(t) * 65536 + 128, vvo, dv + (SL) * VS + 8192); } while (0)
#define AP_BATCH(t, SL) do { if (pv != 1) { if ((t) + 2 < NT) AP_ISSUE_K((t) + 2, ((SL) + 2) % 3); if ((t) + 1 < NT) AP_ISSUE_V((t) + 1, ((SL) + 1) % 3); } } while (0)
    AP_ISSUE_K(t0, 0); AP_ISSUE_K(t0 + 1, 1); AP_ISSUE_V(t0, 0);
    bf16x8 qr[4];
#pragma unroll
    for (int d0 = 0; d0 < 4; ++d0) qr[d0] = *(const bf16x8*)(Q + (size_t)qrow * 512 + d0 * 16 + hi * 8);
    float fqp = MODE == 0 ? Fh[qrow] : 0.f;
#pragma unroll
    for (int d = 0; d < NDB; ++d) o[d] = f32x16{};
    float m_hat = 0.f, l_run = 0.f;
    f32x16 p0, p1, negm; u32x4 pwv[4];
#pragma unroll
    for (int r = 0; r < 16; ++r) negm[r] = 0.f;
#pragma unroll
    for (int i = 0; i < 4; ++i) pwv[i] = (u32x4){0u, 0u, 0u, 0u};
    const LAS char* kb4[4];
#pragma unroll
    for (int d0 = 0; d0 < 4; ++d0) kb4[d0] = lds + R_K + r32 * 128 + (((2 * d0 + hi) ^ (r32 & 7)) << 4);
    const LAS char* vb1 = lds + R_V + (4 * hi + ((lane & 15) >> 2)) * 64 + (((lane >> 4) & 1) * 16 + (lane & 3) * 4) * 2;
    const LAS char* fb1 = lds + R_F + wid * 256 + 16 * hi;
    asm volatile("s_waitcnt vmcnt(0)" ::: "memory");
    asm volatile("" : "+v"(qr[0]), "+v"(qr[1]), "+v"(qr[2]), "+v"(qr[3]), "+v"(fqp));
    asm volatile("s_waitcnt lgkmcnt(0)\n\ts_barrier" ::: "memory");
#define AP3_VFL(buf, ks, SLV) do { _Pragma("unroll") for (int d = 0; d < NDB; ++d) { buf[2 * d] = vtr(vb1 + (SLV) * VS + d * 4096 + (ks) * 1024); buf[2 * d + 1] = vtr(vb1 + (SLV) * VS + d * 4096 + (ks) * 1024 + 512); } } while (0)
#define AP3_VFL1(buf, d, ks, SLV) do { buf[2 * (d)] = vtr(vb1 + (SLV) * VS + (d) * 4096 + (ks) * 1024); buf[2 * (d) + 1] = vtr(vb1 + (SLV) * VS + (d) * 4096 + (ks) * 1024 + 512); } while (0)
#define AP3_FRAG(buf, d) ((bf16x8){buf[2 * (d)][0], buf[2 * (d)][1], buf[2 * (d)][2], buf[2 * (d)][3], buf[2 * (d) + 1][0], buf[2 * (d) + 1][1], buf[2 * (d) + 1][2], buf[2 * (d) + 1][3]})
#define AP3_GAP(ks, d, VCUR, VNXT, PC, BC, PP, BP, HASPREV, HASNEXT, SLV) do { \
        o[d] = __builtin_amdgcn_mfma_f32_32x32x16_bf16(__builtin_bit_cast(bf16x8, pwv[ks]), AP3_FRAG(VCUR, d), o[d], 0, 0, 0); \
        if (HASNEXT) AP3_VFL1(VNXT, d, (ks) + 1, SLV); \
        _Pragma("unroll") for (int e = 0; e < EPG; ++e) { PC[(BC) + EPG * (d) + e] = __builtin_amdgcn_exp2f(PC[(BC) + EPG * (d) + e]); } \
        if (HASPREV) { _Pragma("unroll") for (int e = 0; e < EPG; ++e) rs += PP[(BP) + EPG * (d) + e]; \
            _Pragma("unroll") for (int e = 0; e < EPG / 2; ++e) pwv[(ks) - 1][(EPG / 2) * (d) + e] = cvtpk_(PP[(BP) + EPG * (d) + 2 * e], PP[(BP) + EPG * (d) + 2 * e + 1]); AP3_PIN(rs); } \
        AP3_PIN(PC); \
        __builtin_amdgcn_sched_barrier(0); } while (0)
#define AP3_GROUP(ks, VCUR, VNXT, PC, BC, PP, BP, HASPREV, HASNEXT, SLV) do { _Pragma("unroll") for (int d = 0; d < NDB; ++d) AP3_GAP(ks, d, VCUR, VNXT, PC, BC, PP, BP, HASPREV, HASNEXT, SLV); } while (0)
#define AP3_OCT(PC, BC, KS) do { _Pragma("unroll") for (int e = 0; e < 8; ++e) { PC[(BC) + e] = __builtin_amdgcn_exp2f(PC[(BC) + e]); rs += PC[(BC) + e]; } \
        _Pragma("unroll") for (int e = 0; e < 4; ++e) pwv[KS][e] = cvtpk_(PC[(BC) + 2 * e], PC[(BC) + 2 * e + 1]); } while (0)
#define AP3_KRD(i, SL) (*(const LAS bf16x8*)(kb4[(i) >> 1] + (SL) * 8192 + ((i) & 1) * 4096))
#define AP3_MM(KF, d0, P) P = __builtin_amdgcn_mfma_f32_32x32x16_bf16(KF, qr[d0], P, 0, 0, 0)
#define AP3_QKF(SL) do { bf16x8 ka = AP3_KRD(0, SL), kb = AP3_KRD(1, SL), kc = AP3_KRD(2, SL); \
        if (MODE == 0) { \
            _Pragma("unroll") for (int g4 = 0; g4 < 4; ++g4) { const f32x4 fa = *(const LAS f32x4*)(fb1 + (SL) * 2048 + 32 * g4), fb = *(const LAS f32x4*)(fb1 + (SL) * 2048 + 128 + 32 * g4); \
                _Pragma("unroll") for (int e = 0; e < 4; ++e) { p0[4 * g4 + e] = fqp - fa[e]; p1[4 * g4 + e] = fqp - fb[e]; } } \
        } else { p0 = f32x16{}; p1 = f32x16{}; } \
        __builtin_amdgcn_sched_barrier(0); \
        AP3_MM(ka, 0, p0); ka = AP3_KRD(3, SL); __builtin_amdgcn_sched_barrier(0); \
        AP3_MM(kb, 0, p1); kb = AP3_KRD(4, SL); __builtin_amdgcn_sched_barrier(0); \
        AP3_MM(kc, 1, p0); kc = AP3_KRD(5, SL); __builtin_amdgcn_sched_barrier(0); \
        AP3_MM(ka, 1, p1); ka = AP3_KRD(6, SL); __builtin_amdgcn_sched_barrier(0); \
        AP3_MM(kb, 2, p0); kb = AP3_KRD(7, SL); __builtin_amdgcn_sched_barrier(0); \
        AP3_MM(kc, 2, p1); __builtin_amdgcn_sched_barrier(0); \
        AP3_MM(ka, 3, p0); __builtin_amdgcn_sched_barrier(0); \
        AP3_MM(kb, 3, p1); \
        asm volatile("" : "+v"(p0), "+v"(p1)); \
    } while (0)
#define AP3_QKS(SL) do { bf16x8 kf[8]; \
        _Pragma("unroll") for (int d0 = 0; d0 < 4; ++d0) { kf[2 * d0] = *(const LAS bf16x8*)(kb4[d0] + (SL) * 8192); kf[2 * d0 + 1] = *(const LAS bf16x8*)(kb4[d0] + (SL) * 8192 + 4096); } \
        if (MODE == 0) { const float sft = fqp - m_hat; \
            _Pragma("unroll") for (int g4 = 0; g4 < 4; ++g4) { const f32x4 fa = *(const LAS f32x4*)(fb1 + (SL) * 2048 + 32 * g4), fb = *(const LAS f32x4*)(fb1 + (SL) * 2048 + 128 + 32 * g4); \
                _Pragma("unroll") for (int e = 0; e < 4; ++e) { p0[4 * g4 + e] = sft - fa[e]; p1[4 * g4 + e] = sft - fb[e]; } } \
            _Pragma("unroll") for (int d0 = 0; d0 < 4; ++d0) { p0 = __builtin_amdgcn_mfma_f32_32x32x16_bf16(kf[2 * d0], qr[d0], p0, 0, 0, 0); p1 = __builtin_amdgcn_mfma_f32_32x32x16_bf16(kf[2 * d0 + 1], qr[d0], p1, 0, 0, 0); } \
        } else { \
            if constexpr (SREF) { p0 = __builtin_amdgcn_mfma_f32_32x32x16_bf16(kf[0], qr[0], f32x16{}, 0, 0, 0); p1 = __builtin_amdgcn_mfma_f32_32x32x16_bf16(kf[1], qr[0], f32x16{}, 0, 0, 0); } \
            else { p0 = __builtin_amdgcn_mfma_f32_32x32x16_bf16(kf[0], qr[0], negm, 0, 0, 0); p1 = __builtin_amdgcn_mfma_f32_32x32x16_bf16(kf[1], qr[0], negm, 0, 0, 0); } \
            _Pragma("unroll") for (int d0 = 1; d0 < 4; ++d0) { p0 = __builtin_amdgcn_mfma_f32_32x32x16_bf16(kf[2 * d0], qr[d0], p0, 0, 0, 0); p1 = __builtin_amdgcn_mfma_f32_32x32x16_bf16(kf[2 * d0 + 1], qr[d0], p1, 0, 0, 0); } } \
        if constexpr (SREF) asm volatile("" : "+v"(p0), "+v"(p1)); else asm volatile("s_nop 15\n\ts_nop 7" : "+v"(p0), "+v"(p1));     \
    } while (0)
#define AP3_QK(SL) do { if constexpr (SREF) AP3_QKF(SL); else AP3_QKS(SL); } while (0)
#define AP3_DECIDE(WITH_TAB) do { \
        if (MODE == 0) { \
            if (t * 64 + 63 > q0 + wid * 32) { const int ln_ = lane_id_opaque(), kv0 = t * 64 + 4 * (ln_ >> 5), qrow_ = q0 + wid * 32 + (ln_ & 31);     \
                _Pragma("unroll") for (int r = 0; r < 16; ++r) { const int kv = kv0 + (r & 3) + 8 * (r >> 2); if (kv > qrow_) p0[r] = -1e30f; if (kv + 32 > qrow_) p1[r] = -1e30f; } } \
        } else if (WITH_TAB) { \
            if (near) { const int ln_ = lane_id_opaque(), kv0 = t * 64 + 4 * (ln_ >> 5), qrow_ = q0 + wid * 32 + (ln_ & 31); const LAS float* tab_ = (const LAS float*)(F.lds + AT_TAB) + hb * 192; \
                _Pragma("unroll") for (int g4 = 0; g4 < 4; ++g4) { \
                    _Pragma("unroll") for (int e = 0; e < 4; ++e) { const int r = 4 * g4 + e; const int rel = kv0 + e + 8 * g4 - qrow_; int i0 = rel + 128, i1 = rel + 160; i0 = i0 < 0 ? 0 : i0; i1 = i1 < 0 ? 0 : i1; \
                        p0[r] += tab_[i0]; p1[r] += tab_[i1]; } \
                    __builtin_amdgcn_sched_barrier(0); } } } \
        if constexpr (!SREF) { \
        float ma = max3f_(p0[0], p0[1], p1[0]), mb = max3f_(p0[2], p0[3], p1[1]); ma = max3f_(ma, p1[2], p1[3]); \
        _Pragma("unroll") for (int r = 4; r < 16; r += 4) { ma = max3f_(ma, p0[r], p0[r + 1]); mb = max3f_(mb, p0[r + 2], p0[r + 3]); ma = max3f_(ma, p1[r], p1[r + 1]); mb = max3f_(mb, p1[r + 2], p1[r + 3]); } \
        float rm = max2f_(ma, mb); \
        { auto rr = __builtin_amdgcn_permlane32_swap(__float_as_uint(rm), __float_as_uint(rm), false, false); rm = max2f_(__uint_as_float(rr[0]), __uint_as_float(rr[1])); } \
        resc = (tz == t0) || __any(rm > THR); \
        if (resc) { const float dl = tz == t0 ? rm : fmaxf(rm, 0.f); m_hat += dl; \
            _Pragma("unroll") for (int r = 0; r < 16; ++r) { p0[r] -= dl; p1[r] -= dl; } \
            if (MODE == 1) { const float nm_ = -m_hat; _Pragma("unroll") for (int r = 0; r < 16; ++r) negm[r] = nm_; } \
            al = tz == t0 ? 1.0f : __builtin_amdgcn_exp2f(-dl); l_run *= al; } } } while (0)
#define AP3_STEP(tt, SL) do { const int t = (tt); if (t > NT) break; int tz = t; asm volatile("" : "+s"(tz)); \
        if (t < NT) AP_BATCH(t, SL); \
        const bool doPV = tz > t0 && t - 1 <= tmaxw, doQK = t < NT && t <= tmaxw; \
        bool resc = false; float al = 1.0f, rs = 0.f; \
        const bool near = MODE == 1 && (t * 64 + 63 + 91 > q0 + wid * 32); \
        if (doQK) AP3_QK(SL); else { p0 = f32x16{}; p1 = f32x16{}; }     \
        __builtin_amdgcn_sched_barrier(0); \
        if (doQK) AP3_DECIDE(true); \
        __builtin_amdgcn_sched_barrier(0); \
        if (doPV) { s16x4 vfa[2 * NDB]; AP3_VFL(vfa, 0, ((SL) + 2) % 3);     \
            AP3_GROUP(0, vfa, vfa, p0, 0, p0, 0, false, true, ((SL) + 2) % 3); \
            AP3_GROUP(1, vfa, vfa, p0, 8, p0, 0, true, true, ((SL) + 2) % 3); \
            AP3_GROUP(2, vfa, vfa, p1, 0, p0, 8, true, true, ((SL) + 2) % 3); \
            AP3_GROUP(3, vfa, vfa, p1, 8, p1, 0, true, false, ((SL) + 2) % 3); \
            _Pragma("unroll") for (int e = 0; e < 8; ++e) rs += p1[8 + e]; \
            _Pragma("unroll") for (int e = 0; e < 4; ++e) pwv[3][e] = cvtpk_(p1[8 + 2 * e], p1[8 + 2 * e + 1]); \
        } else if (doQK) { AP3_OCT(p0, 0, 0); AP3_OCT(p0, 8, 1); AP3_OCT(p1, 0, 2); AP3_OCT(p1, 8, 3); } \
        if (doQK) l_run += rs; \
          \
        if (resc && tz > t0) { \
            if (hi == 0) wsf[r32] = al; \
            asm volatile("s_waitcnt lgkmcnt(0)" ::: "memory"); \
            _Pragma("unroll") for (int g4 = 0; g4 < 4; ++g4) { const f32x4 a4 = *(const LAS f32x4*)(wsf + 8 * g4 + 4 * hi); \
                _Pragma("unroll") for (int d = 0; d < NDB; ++d) \
                    _Pragma("unroll") for (int e = 0; e < 4; ++e) o[d][4 * g4 + e] *= a4[e]; } } \
        if (t == NT) break; \
        if (pv == 6) { if (t + 2 < NT) asm volatile("s_waitcnt vmcnt(3) lgkmcnt(0)" ::: "memory"); else asm volatile("s_waitcnt vmcnt(0) lgkmcnt(0)" ::: "memory"); } \
        else { if (t + 2 < NT) asm volatile("s_waitcnt vmcnt(3) lgkmcnt(0)\n\ts_barrier" ::: "memory"); else asm volatile("s_waitcnt vmcnt(0) lgkmcnt(0)\n\ts_barrier" ::: "memory"); } \
    } while (0)
#define AP3_FSTEP(tt, SL) do { const int t = (tt); \
        AP_ISSUE_K(t + 2, ((SL) + 2) % 3); AP_ISSUE_V(t + 1, ((SL) + 1) % 3); \
        float rs = 0.f; \
        AP3_QKF(SL); \
        __builtin_amdgcn_sched_barrier(0); \
        { s16x4 vfa[2 * NDB]; AP3_VFL(vfa, 0, ((SL) + 2) % 3); \
          AP3_GROUP(0, vfa, vfa, p0, 0, p0, 0, false, true, ((SL) + 2) % 3); \
          AP3_GROUP(1, vfa, vfa, p0, 8, p0, 0, true, true, ((SL) + 2) % 3); \
          AP3_GROUP(2, vfa, vfa, p1, 0, p0, 8, true, true, ((SL) + 2) % 3); \
          AP3_GROUP(3, vfa, vfa, p1, 8, p1, 0, true, false, ((SL) + 2) % 3); \
          _Pragma("unroll") for (int e = 0; e < 8; ++e) rs += p1[8 + e]; \
          _Pragma("unroll") for (int e = 0; e < 4; ++e) pwv[3][e] = cvtpk_(p1[8 + 2 * e], p1[8 + 2 * e + 1]); } \
        l_run += rs; \
        asm volatile("s_waitcnt vmcnt(3) lgkmcnt(0)\n\ts_barrier" ::: "memory"); \
    } while (0)
    if (wid >= 4) __builtin_amdgcn_s_setprio(1);
    int t3 = t0;
    if constexpr (SREF && pv == 0) {
        AP3_STEP(t3, 0); AP3_STEP(t3 + 1, 1); AP3_STEP(t3 + 2, 2); t3 += 3;
        const int tfe = (q0 >> 6) - (MODE == 0 ? 1 : 3);
        for (; t3 + 2 <= tfe; t3 += 3) { AP3_FSTEP(t3, 0); AP3_FSTEP(t3 + 1, 1); AP3_FSTEP(t3 + 2, 2); }
    }
    for (; t3 <= NT; t3 += 3) { AP3_STEP(t3, 0); AP3_STEP(t3 + 1, 1); AP3_STEP(t3 + 2, 2); }
    if (wid >= 4) __builtin_amdgcn_s_setprio(0);
    asm volatile("s_waitcnt lgkmcnt(0)\n\ts_barrier" ::: "memory");
    l_run += __shfl_xor(l_run, 32);
    if (hi == 0) wsf[r32] = 1.0f / l_run;
    asm volatile("s_waitcnt lgkmcnt(0)" ::: "memory");
#pragma unroll
    for (int g4 = 0; g4 < 4; ++g4) { const f32x4 a4 = *(const LAS f32x4*)(wsf + 8 * g4 + 4 * hi);
#pragma unroll
        for (int d = 0; d < NDB; ++d)
#pragma unroll
            for (int e = 0; e < 4; ++e) o[d][4 * g4 + e] *= a4[e]; }
#undef AP_ISSUE_K
#undef AP_ISSUE_V
#undef AP_BATCH
#undef AP3_VFL
#undef AP3_VFL1
#undef AP3_FRAG
#undef AP3_GAP
#undef AP3_GROUP
#undef AP3_OCT
#undef AP3_STEP
#undef AP3_FSTEP
#undef AP3_QK
#undef AP3_QKF
#undef AP3_QKS
#undef AP3_KRD
#undef AP3_MM
#undef AP3_DECIDE
}

template <int NDB> __device__ __forceinline__ void store_o(const f32x16 (&o)[NDB], LAS unsigned char* stgb  , bf16_t* dst  , int ld, int lane) {
    const int r32 = lane & 31, hi = lane >> 5;
    constexpr int DVC = 32 * NDB;
    LAS bf16_t* stg = (LAS bf16_t*)stgb;
#pragma unroll
    for (int d = 0; d < NDB; ++d)
#pragma unroll
        for (int r = 0; r < 16; ++r) { const int row = (r & 3) + 8 * (r >> 2) + 4 * hi; stg[row * DVC + 32 * d + r32] = (bf16_t)f2bf(o[d][r]); }
    asm volatile("s_waitcnt lgkmcnt(0)" ::: "memory");
    constexpr int CPR = DVC / 8;
#pragma unroll
    for (int i = 0; i < (32 * CPR) / 64; ++i) { const int c = i * 64 + lane, row = c / CPR, ch = c % CPR;
        const u32x4 v = *(const LAS u32x4*)(stg + row * DVC + ch * 8); *(u32x4*)(dst + (size_t)row * ld + ch * 8) = v; }
    asm volatile("s_waitcnt lgkmcnt(0)" ::: "memory");
}

__device__ __forceinline__ float lambda_full(Frame& F) {
    const int l = lane_id_opaque() & 63;
    const float a = wave_sum(F.in[I_LQ1][l] * F.in[I_LK1][l]), b = wave_sum(F.in[I_LQ2][l] * F.in[I_LK2][l]);
    return __expf(a) - __expf(b) + 0.2f;
}

template <int pv = 0> __device__ __forceinline__ void attn_prompt_fox(Frame& F, int h, int qb) {
    const bf16_t* Q = (const bf16_t*)(F.ws + WS_QB) + h * 64; const bf16_t* K = (const bf16_t*)(F.ws + WS_KB) + h * 64; const bf16_t* V = (const bf16_t*)(F.ws + WS_VB) + h * 64;
    f32x16 o[2];
    const float* Fh = (const float*)(F.ws + WS_FP) + (size_t)h * SEQ;
    int t0 = 0; bool fast;
    { const unsigned* nw = (const unsigned*)(F.ws + WS_CTL) + 256;
      const float qn2 = __uint_as_float(nw[h * 2]) + __uint_as_float(nw[h * 2 + 1]), kn2 = __uint_as_float(nw[16 + h * 2]) + __uint_as_float(nw[16 + h * 2 + 1]);
      const float B = sqrtf(qn2 * kn2) * 1.02f + 0.5f;
      const float thresh = -40.0f - 2.0f * B;
      fast = __builtin_amdgcn_readfirstlane(B <= 60.0f ? 1 : 0) != 0;
      volatile LAS int* cnt = (volatile LAS int*)(F.lds + AT_MISC + 32);
      __syncthreads();
      if (F.tid < 256) { const int t = F.tid; const bool sk = t < 4 * qb && (Fh[qb * 256] - Fh[64 * t + 63]) <= thresh;
          const int c = __popcll(__ballot(sk)); if (F.lane == 0) cnt[F.wave] = c; }
      __syncthreads();
      t0 = cnt[0] + cnt[1] + cnt[2] + cnt[3]; t0 -= t0 % 3; }
    if (fast) attn_pass3<0, 64, pv, true>(F, Q, K, V, qb * 256, 4 * qb + 4, Fh, 0, o, t0); else attn_pass3<0, 64, pv, false>(F, Q, K, V, qb * 256, 4 * qb + 4, Fh, 0, o, t0);
    if (pv != 0 && o[0][0] != 1234.5678f) { __syncthreads(); return; }
    bf16_t* AB = (bf16_t*)(F.ws + WS_AB);
    store_o<2>(o, F.lds + F.wave * 8192, AB + (size_t)(qb * 256 + F.wave * 32) * DM + 512 + h * 64, DM, F.lane);
    __syncthreads();
}
template <int pv = 0> __device__ __forceinline__ void attn_prompt_diff_half(Frame& F, int h, int half, int qb) {
    const bf16_t* Q = (const bf16_t*)(F.ws + WS_QA) + h * 128 + 64 * half; const bf16_t* K = (const bf16_t*)(F.ws + WS_KA) + h * 128 + 64 * half; const bf16_t* V = (const bf16_t*)(F.ws + WS_VA) + h * 128;
    f32x16 o[4];
    bool fast;
    { const unsigned* nw = (const unsigned*)(F.ws + WS_CTL) + 288; const int hh = h * 2 + half;
      const float qn2 = __uint_as_float(nw[hh * 2]) + __uint_as_float(nw[hh * 2 + 1]), kn2 = __uint_as_float(nw[16 + hh * 2]) + __uint_as_float(nw[16 + hh * 2 + 1]);
      float bm = 0.f; for (int b = 0; b < 32; ++b) bm = fmaxf(bm, fabsf(F.in[I_RELB][b * 4 + h] - F.in[I_RELB][15 * 4 + h]));
      const float B = sqrtf(qn2 * kn2) * 1.02f + 0.5f + bm * LOG2E;
      fast = __builtin_amdgcn_readfirstlane(B <= 60.0f ? 1 : 0) != 0; }
    if (fast) attn_pass3<1, 128, pv, true>(F, Q, K, V, qb * 256, 4 * qb + 4, nullptr, h, o); else attn_pass3<1, 128, pv, false>(F, Q, K, V, qb * 256, 4 * qb + 4, nullptr, h, o);
    if (pv != 0 && o[0][0] != 1234.5678f) { __syncthreads(); return; }
    bf16_t* OD = (bf16_t*)(F.ws + (half ? WS_OD2 : WS_OD1));
    store_o<4>(o, F.lds + F.wave * 8192, OD + (size_t)(qb * 256 + F.wave * 32) * 512 + h * 128, 512, F.lane);
    __syncthreads();
}
constexpr int PF_STR = 66, PD_STR = 130;
__device__ __forceinline__ void p_combine(Frame& F) {
    const float lam = lambda_full(F);
    const bf16_t* O1 = (const bf16_t*)(F.ws + WS_OD1); const bf16_t* O2 = (const bf16_t*)(F.ws + WS_OD2); bf16_t* AB = (bf16_t*)(F.ws + WS_AB);
    const int gw = F.bid * 8 + F.wave, NGW = F.G * 8;
    const int c0 = 8 * F.lane;
    float sg[8];
#pragma unroll
    for (int i = 0; i < 8; ++i) sg[i] = F.in[I_SUBG][(c0 & 127) + i] * 0.8f;
    for (int m0 = gw; m0 < SEQ; m0 += 4 * NGW) {
        u32x4 a[4], b[4];
#pragma unroll
        for (int r = 0; r < 4; ++r) { const int m = m0 + r * NGW; if (m < SEQ) { a[r] = *(const u32x4*)(O1 + (size_t)m * 512 + c0); b[r] = *(const u32x4*)(O2 + (size_t)m * 512 + c0); } else { a[r] = (u32x4){0u, 0u, 0u, 0u}; b[r] = a[r]; } }
#pragma unroll
        for (int r = 0; r < 4; ++r) { const int m = m0 + r * NGW;
            float v[8];
            v[0] = bflo(a[r].x) - lam * bflo(b[r].x); v[1] = bfhi(a[r].x) - lam * bfhi(b[r].x); v[2] = bflo(a[r].y) - lam * bflo(b[r].y); v[3] = bfhi(a[r].y) - lam * bfhi(b[r].y);
            v[4] = bflo(a[r].z) - lam * bflo(b[r].z); v[5] = bfhi(a[r].z) - lam * bfhi(b[r].z); v[6] = bflo(a[r].w) - lam * bflo(b[r].w); v[7] = bfhi(a[r].w) - lam * bfhi(b[r].w);
            float ss = 0.f;
#pragma unroll
            for (int i = 0; i < 8; ++i) ss += v[i] * v[i];
#pragma unroll
            for (int ofs = 1; ofs < 16; ofs <<= 1) ss += __shfl_xor(ss, ofs);
            const float rn = 1.0f / sqrtf(ss * (1.0f / 128.0f) + LN_EPS);
            u32x4 w; w.x = pk2(v[0] * rn * sg[0], v[1] * rn * sg[1]); w.y = pk2(v[2] * rn * sg[2], v[3] * rn * sg[3]); w.z = pk2(v[4] * rn * sg[4], v[5] * rn * sg[5]); w.w = pk2(v[6] * rn * sg[6], v[7] * rn * sg[7]);
            if (m < SEQ) *(u32x4*)(AB + (size_t)m * DM + c0) = w; }
    }
    for (int it = F.bid; it < NSMP; it += F.G) {
        const int b = it >> 4, q = it & 15; const size_t row = (size_t)SEQ + it;
        if (F.wave == 0) {
            const int h = F.lane >> 3, cc = (F.lane & 7) * 8; const float* P = (const float*)(F.ws + WS_PF);
            float M = -1e30f;
#pragma unroll
            for (int s = 0; s < 8; ++s) M = fmaxf(M, P[((size_t)((b * 8 + s) * 8 + h) * 16 + q) * PF_STR + 64]);
            float acc[8], L = 0.f;
#pragma unroll
            for (int i = 0; i < 8; ++i) acc[i] = 0.f;
#pragma unroll
            for (int s = 0; s < 8; ++s) { const float* pr = P + ((size_t)((b * 8 + s) * 8 + h) * 16 + q) * PF_STR; const float wgt = __builtin_amdgcn_exp2f(pr[64] - M); L += wgt * pr[65];
#pragma unroll
                for (int i = 0; i < 8; ++i) acc[i] += wgt * pr[cc + i]; }
            const float inv = 1.0f / L;
            u32x4 w; w.x = pk2(acc[0] * inv, acc[1] * inv); w.y = pk2(acc[2] * inv, acc[3] * inv); w.z = pk2(acc[4] * inv, acc[5] * inv); w.w = pk2(acc[6] * inv, acc[7] * inv);
            *(u32x4*)(AB + row * DM + 512 + c0) = w; }
        if (F.wave == 1) {
            const int h = F.lane >> 4, cc = (F.lane & 15) * 8; const float* P = (const float*)(F.ws + WS_PD);
            float v[8];
#pragma unroll
            for (int i = 0; i < 8; ++i) v[i] = 0.f;
#pragma unroll
            for (int half = 0; half < 2; ++half) {
                float M = -1e30f;
#pragma unroll
                for (int s = 0; s < 8; ++s) M = fmaxf(M, P[((size_t)((b * 8 + s) * 8 + 2 * h + half) * 16 + q) * PD_STR + 128]);
                float acc[8], L = 0.f;
#pragma unroll
                for (int i = 0; i < 8; ++i) acc[i] = 0.f;
#pragma unroll
                for (int s = 0; s < 8; ++s) { const float* pr = P + ((size_t)((b * 8 + s) * 8 + 2 * h + half) * 16 + q) * PD_STR; const float wgt = __builtin_amdgcn_exp2f(pr[128] - M); L += wgt * pr[129];
#pragma unroll
                    for (int i = 0; i < 8; ++i) acc[i] += wgt * pr[cc + i]; }
                const float sc = (half ? -lam : 1.0f) / L;
#pragma unroll
                for (int i = 0; i < 8; ++i) v[i] += acc[i] * sc; }
            float ss = 0.f;
#pragma unroll
            for (int i = 0; i < 8; ++i) ss += v[i] * v[i];
#pragma unroll
            for (int ofs = 1; ofs < 16; ofs <<= 1) ss += __shfl_xor(ss, ofs);
            const float rn = 1.0f / sqrtf(ss * (1.0f / 128.0f) + LN_EPS);
            u32x4 w; w.x = pk2(v[0] * rn * sg[0], v[1] * rn * sg[1]); w.y = pk2(v[2] * rn * sg[2], v[3] * rn * sg[3]); w.z = pk2(v[4] * rn * sg[4], v[5] * rn * sg[5]); w.w = pk2(v[6] * rn * sg[6], v[7] * rn * sg[7]);
            *(u32x4*)(AB + row * DM + c0) = w; }
    }
}

constexpr int SM_K = 0, SM_V = 32768, SM_F = 81920, SM_WS = 83968;
template <int KIND  > __device__ __forceinline__ void sample_unit(Frame& F, int b, int s) {
    constexpr int DV = KIND == 0 ? 64 : 128, NDB = DV / 32, VSTR = KIND == 0 ? 192 : 320, VSUB = 16 * VSTR;
    const int lane = lane_id_opaque(), r32 = lane & 31, hi = lane >> 5, w = F.wave, tid = w * 64 + lane;
    const LAS char* lds = (const LAS char*)F.lds;
    LAS float* wsf = (LAS float*)(F.lds + SM_WS) + w * 64;
    const int hb = KIND == 0 ? w : (w >> 1);
    const LAS float* tab = (const LAS float*)(F.lds + AT_TAB) + hb * 192;
    const int q = r32 & 15, qpos = PAST + q;
    const size_t qrow = (size_t)SEQ + b * DEC_T + q;
    const bf16_t* Qp = (const bf16_t*)(F.ws + (KIND == 0 ? WS_QB : WS_QA)) + qrow * 512 + w * 64;
    bf16x8 qr[4];
#pragma unroll
    for (int d0 = 0; d0 < 4; ++d0) qr[d0] = *(const bf16x8*)(Qp + d0 * 16 + hi * 8);
    const float* Fs = (const float*)(F.ws + WS_FS) + (size_t)(b * 8 + w) * SKV;
    const float fq = KIND == 0 ? Fs[qpos] : 0.f;
    const float* Kc = F.in[KIND == 0 ? I_CFK : I_CDK] + (size_t)b * PAST * 512; const float* Vc = F.in[KIND == 0 ? I_CFV : I_CDV] + (size_t)b * PAST * 512;
    const float* Kn = F.out + (KIND == 0 ? O_FKS : O_DKS) + (size_t)b * DEC_T * 512; const float* Vn = F.out + (KIND == 0 ? O_FVS : O_DVS) + (size_t)b * DEC_T * 512;
    const int kr = tid >> 5, c16 = (tid & 31) * 16;
    const int ksub = c16 >> 6, kch = (c16 >> 3) & 7;
    const int kdst = SM_K + ksub * 4096 + kr * 128;
    const int vdst = KIND == 0 ? SM_V + ksub * VSUB + kr * VSTR + kch * 16 : SM_V + (c16 >> 7) * VSUB + kr * VSTR + ((c16 >> 3) & 15) * 16;
    f32x16 o[NDB];
#pragma unroll
    for (int d = 0; d < NDB; ++d) o[d] = f32x16{};
    float m_run = -1e30f, l_run = 0.f;
    f32x4 gkA[4], gvA[4], gkB[4], gvB[4]; float gfA = 0.f, gfB = 0.f;
    const int nt = s == 0 ? 17 : 16;
    auto gload = [&](f32x4 (&gk)[4], f32x4 (&gv)[4], float& gf, int t) {
        const float* ks; const float* vs;
        if (t < 128) { ks = Kc + (size_t)(16 * t + kr) * 512 + c16; vs = Vc + (size_t)(16 * t + kr) * 512 + c16; }
        else { ks = Kn + (size_t)kr * 512 + c16; vs = Vn + (size_t)kr * 512 + c16; }
#pragma unroll
        for (int j = 0; j < 4; ++j) { gk[j] = *(const f32x4*)(ks + 4 * j); gv[j] = *(const f32x4*)(vs + 4 * j); }
        if (KIND == 0 && tid < 128) gf = ((const float*)(F.ws + WS_FS))[(size_t)(b * 8 + (tid >> 4)) * SKV + 16 * t + (tid & 15)];
    };
    auto lwrite = [&](const f32x4 (&gk)[4], const f32x4 (&gv)[4], float gf) {
#pragma unroll
        for (int j = 0; j < 2; ++j) { u32x4 wk, wv;
            wk.x = pk2(gk[2 * j][0], gk[2 * j][1]); wk.y = pk2(gk[2 * j][2], gk[2 * j][3]); wk.z = pk2(gk[2 * j + 1][0], gk[2 * j + 1][1]); wk.w = pk2(gk[2 * j + 1][2], gk[2 * j + 1][3]);
            wv.x = pk2(gv[2 * j][0], gv[2 * j][1]); wv.y = pk2(gv[2 * j][2], gv[2 * j][3]); wv.z = pk2(gv[2 * j + 1][0], gv[2 * j + 1][1]); wv.w = pk2(gv[2 * j + 1][2], gv[2 * j + 1][3]);
            *(LAS u32x4*)(F.lds + kdst + (((kch + j) ^ (kr & 7)) << 4)) = wk;
            *(LAS u32x4*)(F.lds + vdst + j * 16) = wv; }
        if (KIND == 0 && tid < 128) ((LAS float*)(F.lds + SM_F))[tid] = gf;
    };
    gload(gkA, gvA, gfA, s); gload(gkB, gvB, gfB, s + 8);
    __syncthreads();
    { const int sub = tid >> 6, rr = 16 + ((tid >> 2) & 15), cq = (tid & 3) * 32;
      *(LAS u32x4*)(F.lds + SM_K + sub * 4096 + rr * 128 + cq) = (u32x4){0u, 0u, 0u, 0u}; *(LAS u32x4*)(F.lds + SM_K + sub * 4096 + rr * 128 + cq + 16) = (u32x4){0u, 0u, 0u, 0u}; }
    const int vb = SM_V + (KIND == 0 ? w : (w >> 1)) * VSUB + (4 * hi + ((lane & 15) >> 2)) * VSTR + (((lane >> 4) & 1) * 16 + (lane & 3) * 4) * 2;
    auto compute = [&](int t) {
        f32x16 p0 = f32x16{};
#pragma unroll
        for (int d0 = 0; d0 < 4; ++d0) { const bf16x8 kf = *(const LAS bf16x8*)(lds + SM_K + w * 4096 + r32 * 128 + (((2 * d0 + hi) ^ (r32 & 7)) << 4));
            p0 = __builtin_amdgcn_mfma_f32_32x32x16_bf16(kf, qr[d0], p0, 0, 0, 0); }
        const int kv0 = 16 * t + 4 * hi;
        float x[8];
        if (KIND == 0) {
#pragma unroll
            for (int g4 = 0; g4 < 2; ++g4) { const f32x4 fa = *(const LAS f32x4*)(lds + SM_F + (w * 16 + 4 * hi + 8 * g4) * 4);
#pragma unroll
                for (int e = 0; e < 4; ++e) x[4 * g4 + e] = p0[4 * g4 + e] + (fq - fa[e]); }
            if (t == 128) {
#pragma unroll
                for (int r = 0; r < 8; ++r) { const int kv = kv0 + (r & 3) + 8 * (r >> 2); if (kv > qpos) x[r] = -1e30f; } }
        } else {
            if (t < 120) {
#pragma unroll
                for (int r = 0; r < 8; ++r) x[r] = p0[r];
            } else {
#pragma unroll
                for (int r = 0; r < 8; ++r) { const int kv = kv0 + (r & 3) + 8 * (r >> 2); int i0 = kv - qpos + 128; i0 = i0 < 0 ? 0 : i0; x[r] = p0[r] + tab[i0]; } }
        }
        float rm = x[0];
#pragma unroll
        for (int r = 1; r < 8; ++r) rm = fmaxf(rm, x[r]);
        rm = fmaxf(rm, __shfl_xor(rm, 32));
        const float m_new = fmaxf(m_run, rm);
        if (__any(m_new > m_run)) { const float al = __builtin_amdgcn_exp2f(m_run - m_new); l_run *= al; m_run = m_new;
            if (hi == 0) wsf[r32] = al;
            asm volatile("s_waitcnt lgkmcnt(0)" ::: "memory");
#pragma unroll
            for (int g4 = 0; g4 < 2; ++g4) { const f32x4 a4 = *(const LAS f32x4*)(wsf + 8 * g4 + 4 * hi);
#pragma unroll
                for (int d = 0; d < NDB; ++d)
#pragma unroll
                    for (int e = 0; e < 4; ++e) o[d][4 * g4 + e] *= a4[e]; } }
        float rs = 0.f;
#pragma unroll
        for (int r = 0; r < 8; ++r) { x[r] = __builtin_amdgcn_exp2f(x[r] - m_run); rs += x[r]; }
        l_run += rs;
        u32x4 w0; w0.x = cvtpk_v(x[0], x[1]); w0.y = cvtpk_v(x[2], x[3]); w0.z = cvtpk_v(x[4], x[5]); w0.w = cvtpk_v(x[6], x[7]);
        const bf16x8 pa = __builtin_bit_cast(bf16x8, w0);
#pragma unroll
        for (int d = 0; d < NDB; ++d) { const LAS char* vp = lds + vb + d * 64;
            const s16x4 lo = vtr(vp), hi4 = vtr(vp + 8 * VSTR);
            const bf16x8 vf = (bf16x8){lo[0], lo[1], lo[2], lo[3], hi4[0], hi4[1], hi4[2], hi4[3]};
            o[d] = __builtin_amdgcn_mfma_f32_32x32x16_bf16(pa, vf, o[d], 0, 0, 0); }
    };
    for (int i = 0; i < nt; i += 2) {
        const int t = s + 8 * i;
        lwrite(gkA, gvA, gfA); __syncthreads();
        if (i + 2 < nt) gload(gkA, gvA, gfA, t + 16);
        compute(t);
        __syncthreads();
        if (i + 1 >= nt) break;
        lwrite(gkB, gvB, gfB); __syncthreads();
        if (i + 3 < nt) gload(gkB, gvB, gfB, t + 24);
        compute(t + 8);
        __syncthreads();
    }
    l_run += __shfl_xor(l_run, 32);
    float* P = (float*)(F.ws + (KIND == 0 ? WS_PF : WS_PD)) + ((size_t)((b * 8 + s) * 8 + w) * 16) * (DV + 2);
    { float* P0 = P + (size_t)(4 * hi) * (DV + 2) + r32; float* P1 = P0 + 8 * (DV + 2);
#pragma unroll
      for (int d = 0; d < NDB; ++d)
#pragma unroll
          for (int r = 0; r < 4; ++r) { P0[r * (DV + 2) + 32 * d] = o[d][r]; P1[r * (DV + 2) + 32 * d] = o[d][4 + r]; } }
    if (lane < 16) { P[(size_t)lane * (DV + 2) + DV] = m_run; P[(size_t)lane * (DV + 2) + DV + 1] = l_run; }
}

template <int pv = 0> __device__ __forceinline__ void p3_attention(Frame& F, int mask) {
    LAS float* tab = (LAS float*)(F.lds + AT_TAB);
    for (int i = F.tid; i < 4 * 192; i += 512) { const int h = i / 192, rel = (i % 192) - 128; tab[i] = (F.in[I_RELB][t5_bucket(rel) * 4 + h] - F.in[I_RELB][15 * 4 + h]) * LOG2E; }
    __syncthreads();
    const int x = F.bid & 7, p = (F.bid >> 3) & 31;
    const int spos = F.G == 256 ? (x + p) % 5 : 4;
    for (int j = 0; j < 5; ++j) {
        F.lane = lane_id_opaque(); F.tid = F.wave * 64 + F.lane;
        if (j == spos) {
            if (mask & 4) {
                for (int u = F.bid; u < 256; u += F.G) {
                    F.lane = lane_id_opaque(); F.tid = F.wave * 64 + F.lane;
                    if ((u >> 3) & 1) sample_unit<1>(F, u >> 4, u & 7); else sample_unit<0>(F, u >> 4, u & 7);
                }
            }
        } else if (F.bid < 256) {
            const int i = j - (j > spos ? 1 : 0);
            const int qb = (i & 1) ? p : 63 - p;
            if (i < 2) { if (mask & 1) attn_prompt_diff_half<pv>(F, x >> 1, x & 1, qb); }
            else { if (mask & 2) attn_prompt_fox<pv>(F, x, qb); }
        }
    }
}

__device__ __forceinline__ void slab_publish(Frame& F, int word, int nun) {
    int n = 0; for (int L = F.bid; L < nun; L += F.G) ++n;
    asm volatile("s_waitcnt vmcnt(0)" ::: "memory");
    __syncthreads();
    if (F.tid == 0 && n > 0) { __builtin_amdgcn_fence(__ATOMIC_RELEASE, "agent"); asm volatile("s_waitcnt vmcnt(0)" ::: "memory");
        __hip_atomic_fetch_add((unsigned*)(F.ws + WS_CTL) + word, (unsigned)n, __ATOMIC_RELAXED, __HIP_MEMORY_SCOPE_AGENT); }
}
__device__ __forceinline__ void slab_wait(Frame& F, int word, int nun) {
    if (F.tid == 0) { unsigned* w = (unsigned*)(F.ws + WS_CTL) + word; unsigned sp = 0;
        while (__hip_atomic_load(w, __ATOMIC_RELAXED, __HIP_MEMORY_SCOPE_AGENT) < (unsigned)nun && ++sp < (1u << 22)) __builtin_amdgcn_s_sleep(2);
        __builtin_amdgcn_fence(__ATOMIC_ACQUIRE, "agent"); asm volatile("s_waitcnt vmcnt(0)" ::: "memory"); }
    __syncthreads();
}

#define XB_TMO      128
#define XB_XCNT(j)  (256  + 64 * (j))
#define XB_XSUB(j)  (1280 + 64 * (j))
#define XB_XGEN(j)  (2304 + 64 * (j))
#define XB_TOP      3328
#define XB_TOPGEN   3392
#define XCD_BAR_WORDS 3456
#define XB_SPIN_CAP (1u << 20)
__device__ __forceinline__ unsigned xb_ld(unsigned* p)              { return __hip_atomic_load(p, __ATOMIC_RELAXED, __HIP_MEMORY_SCOPE_AGENT); }
__device__ __forceinline__ unsigned xb_add(unsigned* p, unsigned v) { return __hip_atomic_fetch_add(p, v, __ATOMIC_RELAXED, __HIP_MEMORY_SCOPE_AGENT); }
__device__ __forceinline__ unsigned xb_xcc_id() { return (unsigned)__builtin_amdgcn_s_getreg((3 << 11) | 20) & 0xFu; }
#define XB_SPIN(cond, bar) do { unsigned _sp = 0; while (cond) { __builtin_amdgcn_s_sleep(1); \
    if ((++_sp & 255u) == 0u) { if (xb_ld(&(bar)[XB_TMO])) break; if (_sp > XB_SPIN_CAP) { atomicAdd(&(bar)[XB_TMO], 1u); break; } } } } while (0)
struct XcdBarrier { unsigned* bar; unsigned x; volatile LAS unsigned* st; };
__device__ __forceinline__ XcdBarrier xcd_barrier_post(unsigned* bar, volatile LAS unsigned* st) {
    XcdBarrier b; b.bar = bar; b.x = xb_xcc_id(); b.st = st;
    if (threadIdx.x == 0) (void)xb_add(&bar[XB_XCNT(b.x)], 1u);
    return b;
}
__device__ __forceinline__ void xcd_barrier_complete(unsigned* bar, unsigned x, unsigned& nloc, unsigned& nx) {
    const unsigned G = gridDim.x * gridDim.y * gridDim.z;
    unsigned sum, cnt, mine, sp = 0u;
    for (;;) {
        sum = 0u; cnt = 0u; mine = 0u;
#pragma unroll
        for (unsigned j = 0; j < 16; ++j) { const unsigned c = xb_ld(&bar[XB_XCNT(j)]); sum += c; cnt += (c > 0u) ? 1u : 0u; mine = (j == x) ? c : mine; }
        if (sum == G) break;
        __builtin_amdgcn_s_sleep(1);
        if ((++sp & 255u) == 0u) { if (xb_ld(&bar[XB_TMO])) break; if (sp > XB_SPIN_CAP) { atomicAdd(&bar[XB_TMO], 1u); break; } }
    }
    nloc = mine > 0u ? mine : 1u; nx = cnt > 0u ? cnt : 1u;
}
__device__ __forceinline__ void xcd_barrier(const XcdBarrier& b) {
    asm volatile("s_waitcnt vmcnt(0)" ::: "memory");
    __syncthreads();
    if (threadIdx.x == 0) {
        unsigned* bar = b.bar;
        __builtin_amdgcn_s_waitcnt(0);
        unsigned nloc = b.st[0], nx = b.st[1];
        if (nloc == 0u) { xcd_barrier_complete(bar, b.x, nloc, nx); b.st[0] = nloc; b.st[1] = nx; }
        const unsigned old = xb_add(&bar[XB_XSUB(b.x)], 1u);
        const unsigned gen = old / nloc;
        if (old + 1u == (gen + 1u) * nloc) {
            __builtin_amdgcn_fence(__ATOMIC_RELEASE, "agent");
            asm volatile("s_waitcnt vmcnt(0)" ::: "memory");
            const unsigned og = xb_add(&bar[XB_TOP], 1u);
            const unsigned tg = og / nx;
            if (og + 1u == (tg + 1u) * nx) xb_add(&bar[XB_TOPGEN], 1u);
            else XB_SPIN(xb_ld(&bar[XB_TOPGEN]) == tg, bar);
            __builtin_amdgcn_fence(__ATOMIC_ACQUIRE, "agent");
            xb_add(&bar[XB_XGEN(b.x)], 1u);
            asm volatile("s_waitcnt vmcnt(0)" ::: "memory");
        } else {
            XB_SPIN(xb_ld(&bar[XB_XGEN(b.x)]) == gen, bar);
            __builtin_amdgcn_fence(__ATOMIC_ACQUIRE, "agent");
            asm volatile("s_waitcnt vmcnt(0)" ::: "memory");
        }
    }
    __syncthreads();
}

__global__ void __launch_bounds__(512, 2) mega_fwd(Args args) {
    extern __shared__ __attribute__((aligned(16))) unsigned char lds_raw[];
    Frame F;
    F.lds = (LAS unsigned char*)lds_raw; F.ldsg = lds_raw;
    F.tid = threadIdx.x; F.lane = F.tid & 63; F.wave = __builtin_amdgcn_readfirstlane(F.tid >> 6);
    F.G = gridDim.x; F.bid = blockIdx.x;
    F.in = args.in; F.out = args.out; F.ws = args.ws;
    const int lo = args.ph_lo, hi = args.ph_hi;
    cg::grid_group grid = cg::this_grid();
    const bool fused = (hi - lo) > 1;
    volatile LAS unsigned* bst = (volatile LAS unsigned*)(F.lds + AT_MISC + 16);
    if (F.tid == 0) { bst[0] = 0u; bst[1] = 0u; }
    __syncthreads();
    XcdBarrier xbar; xbar.bar = (unsigned*)(F.ws + WS_CTL) + 1024; xbar.x = 0; xbar.st = bst;
    if (fused) xbar = xcd_barrier_post((unsigned*)(F.ws + WS_CTL) + 1024, bst);
#define IN(k) (lo <= (k) && (k) < hi)
#define PB() do { F.lane = lane_id_opaque(); F.tid = F.wave * 64 + F.lane; } while (0)
#define SEAM(k) do { if (IN(k) && IN((k) + 1)) { xcd_barrier(xbar); } } while (0)
    const float* mod = (const float*)(F.ws + WS_MOD);
    if (IN(0)) { PB(); p0_prologue(F); }
    if (IN(0) && IN(1)) __syncthreads(); else SEAM(0);
    if (IN(1)) { PB(); p1_rows(F, IN(0)); } SEAM(1);
    if (IN(2)) { PB();
        p2_cumsum(F);
        __syncthreads();
        pg8::Gemm g{(const bf16_t*)(F.ws + WS_XN), (const bf16_t*)(F.ws + WS_WIN), 1024, 1024, 1024, 1 << 30, 0, 0};
        pg8::StaticOrder S; S.init(MT / 256, NZ / 256, F.G, F.bid, 0);
        EpiZ E{F.out, F.ws};
        pg8::gemm_phase<EpiZ, pg8::StaticOrder>(F.lds, g, S, E, F.wave);
#if PROBE_DUP == 2
        pg8::gemm_phase<EpiZ, pg8::StaticOrder>(F.lds, g, S, E, F.wave);
#endif
        { const int nun = (MT / 256) * (NZ / 256), nlong = nun - (nun / F.G) * F.G;
          if (nlong > 0 && nlong < F.G) { if (F.bid >= nlong) { PB(); weight_copies(F, F.bid - nlong, F.G - nlong, WC_IN, WC_ALL); } }
          else { PB(); weight_copies(F, F.bid, F.G, WC_IN, WC_ALL); } }
    } SEAM(2);
    if (IN(3)) { PB(); p3_attention(F, 7);
#if PROBE_DUP == 3
        p3_attention<PROBE_PV>(F, PROBE_MASK);
#endif
    } SEAM(3);
    if (IN(10)) { PB(); p_combine(F);
#if PROBE_DUP == 10
        p_combine(F);
#endif
    } if (IN(10) && IN(4)) xcd_barrier(xbar);
    if (IN(4)) { PB();
        pg8::Gemm g{(const bf16_t*)(F.ws + WS_AB), (const bf16_t*)(F.ws + WS_WAB), 1024, 512, 512, 4, 512, 0};
        pg8::StaticOrder S; S.init(MT / 256, 8, F.G, F.bid, 0);
        EpiGate E{(bf16_t*)(F.ws + WS_G), (bf16_t*)(F.ws + WS_G)};
#if PROBE_DUP == 4
        { EpiGate E2{(bf16_t*)(F.ws + WS_G), (bf16_t*)(F.ws + WS_QA)}; pg8::gemm_phase<EpiGate, pg8::StaticOrder>(F.lds, g, S, E2, F.wave); }
#endif
        pg8::gemm_phase<EpiGate, pg8::StaticOrder>(F.lds, g, S, E, F.wave);
    } SEAM(4);
    if (IN(5)) { PB();
        { pg8::Gemm g2{(const bf16_t*)(F.ws + WS_G), (const bf16_t*)(F.ws + WS_WO2), 2048, 2048, 256, 1 << 30, 0, 256};
          pg8::SplitOrder S2; S2.init(4, 8, F.G, F.bid, SEQ / 256); EpiSlab E2{(float*)(F.ws + WS_SLAB)};
          pg8::gemm_phase<EpiSlab, pg8::SplitOrder>(F.lds, g2, S2, E2, F.wave); slab_publish(F, 322, 32); }
        pg8::Gemm g{(const bf16_t*)(F.ws + WS_G), (const bf16_t*)(F.ws + WS_WO2), 2048, 2048, 2048, 1 << 30, 0, 0};
        pg8::StaticOrder S; S.init(SEQ / 256, 4, F.G, F.bid, 0);
        EpiResLn<false> E{(const void*)F.in[I_XP], mod + 2048, F.in[I_LN1G], F.in[I_LN1B], mod, (bf16_t*)(F.ws + WS_X1B), (bf16_t*)(F.ws + WS_XN), nullptr,
                          PanelStats{(unsigned*)(F.ws + WS_XB1), (unsigned*)(F.ws + WS_CTL) + CTL_LN1, LN_EPS}, F.lds};
        pg8::gemm_phase<EpiResLn<false>, pg8::StaticOrder>(F.lds, g, S, E, F.wave);
        PB(); slab_wait(F, 322, 32); ln_rows<false>(F, F.in[I_LN1G], F.in[I_LN1B], 8, 2048);
    } if (IN(5) && IN(7)) xcd_barrier(xbar);

    if (IN(7)) { PB();
        pg8::Gemm g{(const bf16_t*)(F.ws + WS_XN), (const bf16_t*)(F.ws + WS_WFI), 1024, 1024, 1024, 1 << 30, 0, 0};
        pg8::StaticOrder S; S.init(MT / 256, NFF2 / 256, F.G, F.bid, 0);
        EpiFfn E{(bf16_t*)(F.ws + WS_ACT)};
        pg8::gemm_phase<EpiFfn, pg8::StaticOrder>(F.lds, g, S, E, F.wave);
#if PROBE_DUP == 7
        pg8::gemm_phase<EpiFfn, pg8::StaticOrder>(F.lds, g, S, E, F.wave);
#endif
    } SEAM(7);
    if (IN(8)) { PB();
        { pg8::Gemm g2{(const bf16_t*)(F.ws + WS_ACT), (const bf16_t*)(F.ws + WS_WFO), DFF, DFF, 256, 1 << 30, 0, 256};
          pg8::SplitOrder S2; S2.init(4, 11, F.G, F.bid, SEQ / 256); EpiSlab E2{(float*)(F.ws + WS_SLAB)};
          pg8::gemm_phase<EpiSlab, pg8::SplitOrder>(F.lds, g2, S2, E2, F.wave); slab_publish(F, 323, 44); }
        pg8::Gemm g{(const bf16_t*)(F.ws + WS_ACT), (const bf16_t*)(F.ws + WS_WFO), DFF, DFF, DFF, 1 << 30, 0, 0};
        pg8::StaticOrder S; S.init(SEQ / 256, 4, F.G, F.bid, 0);
        EpiResLn<true> E{(const void*)(F.ws + WS_X1B), mod + 5120, F.in[I_LN2G], F.in[I_LN2B], mod, nullptr, nullptr, F.out,
                         PanelStats{(unsigned*)(F.ws + WS_XB2), (unsigned*)(F.ws + WS_CTL) + CTL_LN2, LN_EPS}, F.lds};
        pg8::gemm_phase<EpiResLn<true>, pg8::StaticOrder>(F.lds, g, S, E, F.wave);
        PB(); slab_wait(F, 323, 44); ln_rows<true>(F, F.in[I_LN2G], F.in[I_LN2B], 11, 5120);
    }
#undef IN
#undef SEAM
}

extern "C" void kernel_launch(void* const* d_in, const int* in_sizes, int n_in, void* d_out, int out_size, void* d_ws, size_t ws_size, hipStream_t stream) {
    static int grid = 0;
    if (grid == 0) {
        if (n_in != 28 || (size_t)out_size != O_END || ws_size < WS_END) { fprintf(stderr, "kernel_launch: unexpected shapes (n_in %d out %d ws %zu)\n", n_in, out_size, ws_size); grid = -1; return; }
        int dev = 0, cus = 0, per_cu = 0;
        hipGetDevice(&dev); hipDeviceGetAttribute(&cus, hipDeviceAttributeMultiprocessorCount, dev);
        hipFuncSetAttribute((const void*)mega_fwd, hipFuncAttributeMaxDynamicSharedMemorySize, LDS_BYTES);
        hipOccupancyMaxActiveBlocksPerMultiprocessor(&per_cu, (const void*)mega_fwd, 512, LDS_BYTES);
        if (per_cu < 1) { fprintf(stderr, "kernel_launch: occupancy query says %d blocks per CU\n", per_cu); per_cu = 1; }
        (void)hipGetLastError();
        grid = cus;
    }
    if (grid < 0) return;
    hipMemsetAsync((char*)d_ws + WS_CTL, 0, CTL_BYTES, stream);
    Args a{};
    for (int i = 0; i < 28; ++i) a.in[i] = (const float*)d_in[i];
    a.out = (float*)d_out; a.ws = (unsigned char*)d_ws;
#if MK_N_LAUNCHES == 1
    a.ph_lo = 0; a.ph_hi = NPH;
    void* kargs[] = {&a};
    hipError_t e = hipLaunchCooperativeKernel((const void*)mega_fwd, dim3(grid), dim3(512), kargs, LDS_BYTES, stream);
    if (e != hipSuccess) fprintf(stderr, "cooperative launch failed: %s\n", hipGetErrorString(e));
#else
    { const int seq[NPH] = {0, 1, 2, 3, 10, 4, 5, 6, 7, 8, 9}; for (int i = 0; i < NPH; ++i) { a.ph_lo = seq[i]; a.ph_hi = seq[i] + 1; hipLaunchKernelGGL(mega_fwd, dim3(grid), dim3(512), LDS_BYTES, stream, a); } }
#endif
}
```

```cpp
#include <hip/hip_runtime.h>
#include <hip/hip_cooperative_groups.h>
#include <cstdint>
#include <cstdio>
namespace cg = cooperative_groups;

#ifndef PROBE_DUP
#define PROBE_DUP -1
#endif
#ifndef PROBE_PV
#define PROBE_PV 0
#endif
#ifndef PROBE_MASK
#define PROBE_MASK 7
#endif
#ifndef MK_N_LAUNCHES
#define MK_N_LAUNCHES 1
#endif

#define LAS __attribute__((address_space(3)))
typedef unsigned short bf16_t;
typedef short bf16x8 __attribute__((ext_vector_type(8)));
typedef short s16x4 __attribute__((ext_vector_type(4)));
typedef float f32x4 __attribute__((ext_vector_type(4)));
typedef float f32x2 __attribute__((ext_vector_type(2)));
typedef float f32x16 __attribute__((ext_vector_type(16)));
typedef unsigned u32x4 __attribute__((ext_vector_type(4)));
typedef unsigned u32x2 __attribute__((ext_vector_type(2)));

constexpr int DM = 1024, SEQ = 16384, DEC_B = 16, DEC_T = 16, NSMP = DEC_B * DEC_T, MT = SEQ + NSMP, PAST = 2048, SKV = PAST + DEC_T;
constexpr int NZ = 5120, DFF = 2816, NFF2 = 2 * DFF, WIN_COLS = 5128;
constexpr float LOG2E = 1.4426950408889634f, C2 = 0.125f * LOG2E, ALPHA = 1.189207115002721f, LN_EPS = 1e-5f;
constexpr int NPH = 11;

constexpr size_t O_Y = 0, O_DKP = (size_t)MT * DM, O_DVP = O_DKP + (size_t)SEQ * 512, O_FKP = O_DVP + (size_t)SEQ * 512, O_FVP = O_FKP + (size_t)SEQ * 512,
                 O_FLP = O_FVP + (size_t)SEQ * 512, O_DKS = O_FLP + (size_t)SEQ * 8, O_DVS = O_DKS + (size_t)NSMP * 512, O_FKS = O_DVS + (size_t)NSMP * 512,
                 O_FVS = O_FKS + (size_t)NSMP * 512, O_FLS = O_FVS + (size_t)NSMP * 512, O_END = O_FLS + (size_t)NSMP * 8;

constexpr size_t MiB = 1u << 20;
constexpr size_t WS_CTL = 0, CTL_BYTES = 64 * 1024;
constexpr size_t WS_MOD = 1 * MiB;
constexpr size_t WS_FP = 2 * MiB;
constexpr size_t WS_FS = 3 * MiB;
constexpr size_t WS_WIN = 8 * MiB;
constexpr size_t WS_WAB = 18 * MiB;
constexpr size_t WS_WO2 = 20 * MiB;
constexpr size_t WS_WFI = 24 * MiB;
constexpr size_t WS_WFO = 35 * MiB;
constexpr size_t WS_XN = 48 * MiB;
constexpr size_t WS_QA = 84 * MiB, WS_KA = 101 * MiB, WS_VA = 118 * MiB, WS_QB = 135 * MiB, WS_KB = 152 * MiB, WS_VB = 169 * MiB;
constexpr size_t WS_ACT = 84 * MiB;
constexpr size_t WS_G = 188 * MiB;
constexpr size_t WS_AB = 254 * MiB;
constexpr size_t WS_OD1 = WS_XN, WS_OD2 = 288 * MiB;
constexpr size_t WS_PF = 304 * MiB, WS_PD = 309 * MiB;
constexpr size_t WS_TB = WS_AB;
constexpr size_t WS_X1B = WS_AB;
constexpr size_t WS_XB1 = 5 * MiB, WS_XB2 = 6 * MiB;
constexpr int CTL_LN1 = 8192, CTL_LN2 = 12288;
constexpr int LN_LDS = 135168;
constexpr size_t WS_SLAB = 288 * MiB;
constexpr size_t WS_END = 320 * MiB;

constexpr int LDS_BYTES = 147456;

struct Args { const float* in[28]; float* out; unsigned char* ws; int ph_lo, ph_hi; };

__device__ __forceinline__ int lane_id_opaque() { int l = (int)__builtin_amdgcn_mbcnt_hi(~0u, __builtin_amdgcn_mbcnt_lo(~0u, 0u)); asm volatile("" : "+v"(l)); return l; }
__device__ __forceinline__ unsigned f2bf(float f) { unsigned u = __builtin_bit_cast(unsigned, f); return (u + 0x7fffu + ((u >> 16) & 1u)) >> 16; }
typedef __bf16 bf16x2e_t_ __attribute__((ext_vector_type(2)));
__device__ __forceinline__ unsigned cvtpk_v(float lo, float hi) { f32x2 v = {lo, hi}; bf16x2e_t_ b = __builtin_convertvector(v, bf16x2e_t_); return __builtin_bit_cast(unsigned, b); }
__device__ __forceinline__ unsigned pk2(float lo, float hi) { return cvtpk_v(lo, hi); }
__device__ __forceinline__ float bf2f(unsigned short b) { return __builtin_bit_cast(float, (unsigned)b << 16); }
__device__ __forceinline__ float bflo(unsigned w) { return __builtin_bit_cast(float, w << 16); }
__device__ __forceinline__ float bfhi(unsigned w) { return __builtin_bit_cast(float, w & 0xffff0000u); }
__device__ __forceinline__ float wave_sum(float v) {
#pragma unroll
    for (int o = 1; o < 64; o <<= 1) v += __shfl_xor(v, o);
    return v;
}
__device__ __forceinline__ float sigmoidf_(float x) { return __builtin_amdgcn_rcpf(1.0f + __expf(-x)); }
__device__ __forceinline__ float siluf_(float x) { return x * __builtin_amdgcn_rcpf(1.0f + __expf(-x)); }

namespace pg8 {
constexpr int BM = 256, BK = 64, HALF = 128, HTB = HALF * BK * 2, STAGE_BYTES = 8 * HTB, NXCD = 8, WGM = 8;
__host__ __device__ __forceinline__ int lds_byte(int r, int c) { const int st = (r >> 4) * 2 + (c >> 5), rr = r & 15, cc = c & 31, ob = rr * 64 + cc * 2; return st * 1024 + (ob ^ (((ob >> 9) & 1) << 5)); }
__host__ __device__ __forceinline__ void stage_rc(int b, int& R, int& C) { const int st = b / 1024, sb = b % 1024, swz = sb ^ (((sb >> 9) & 1) << 5); R = (st >> 1) * 16 + swz / 64; C = (st & 1) * 32 + (swz % 64) / 2; }
__host__ __device__ __forceinline__ int perm32(int rho) { const int n = rho >> 4, i = rho & 15; return 8 * (i >> 2) + 4 * n + (i & 3); }

struct Unit { int pm, pn, ks; };
struct Gemm { const bf16_t* A; const bf16_t* Bt; int lda, ldb, K, a_split_pn, a_split_off, kpart; };

struct StaticOrder {
    int nM, nN, nwg, G, c, pm0;
    __device__ void init(int nM_, int nN_, int G_, int c_, int pm0_) { nM = nM_; nN = nN_; nwg = nM * nN; G = G_; c = c_; pm0 = pm0_; }
    __device__ bool next(int i, Unit& u) const {
        const long L = (long)i * G + c; if (L >= nwg) return false;
        int wgid = (int)L; { const int q = nwg / NXCD, r = nwg % NXCD, xcd = wgid % NXCD, off = wgid / NXCD; wgid = (xcd < r ? xcd * (q + 1) : r * (q + 1) + (xcd - r) * q) + off; }
        const int nig = WGM * nN, gid = wgid / nig, fm = gid * WGM, gsz = (nM - fm) < WGM ? (nM - fm) : WGM;
        u.pm = pm0 + fm + ((wgid % nig) % gsz); u.pn = (wgid % nig) / gsz; u.ks = 0; return true;
    }
};

struct SplitOrder {
    int nN, nun, G, c, pm;
    __device__ void init(int nN_, int KS_, int G_, int c_, int pm_) { nN = nN_; nun = nN_ * KS_; G = G_; c = c_; pm = pm_; }
    __device__ bool next(int i, Unit& u) const { const long L = (long)i * G + c; if (L >= nun) return false; u.pm = pm; u.pn = (int)L % nN; u.ks = (int)L / nN; return true; }
};

__device__ __forceinline__ unsigned cvt_pk_bf16(float lo, float hi) { unsigned r; asm volatile("v_cvt_pk_bf16_f32 %0, %1, %2" : "=v"(r) : "v"(lo), "v"(hi)); return r; }

template <class Epi, class Sched, bool ALIGN_EPI = true, bool SP2 = true>
__device__ __forceinline__ void gemm_phase(LAS unsigned char* lds, const Gemm g, const Sched& S, const Epi& E, int wid  ) {
    const int lane = lane_id_opaque(), tid = wid * 64 + lane, wr = wid >> 2, wc = wid & 3; int fr = lane & 15, fq = lane >> 4;
    const int K = g.K, nt = K / BK;
    unsigned voffA[2], voffB[2];
#pragma unroll
    for (int i = 0; i < 2; ++i) { int R, C; stage_rc(tid * 16 + i * 8192, R, C); const int Rb = Epi::PERM ? ((R & ~31) + perm32(R & 31)) : R;
        voffA[i] = (unsigned)(R * g.lda + C) * 2u; voffB[i] = (unsigned)(Rb * g.ldb + C) * 2u; }
    const size_t kstep = (size_t)(BK * 2);
    const size_t hstepA = (size_t)HALF * g.lda * 2, hstepB = (size_t)HALF * g.ldb * 2;
    const size_t tstepA = 2 * hstepA, tstepB = 2 * hstepB;
    const unsigned ldsw = (unsigned)wid * 1024u;
    const int aoff = lds_byte(wr * 64 + fr, fq * 8), boff = lds_byte(wc * 32 + fr, fq * 8);
#define PG8_SA(b, h) (((b) * 2 + (h)) * HTB)
#define PG8_SB(b, h) ((4 + (b) * 2 + (h)) * HTB)
#define PG8_STAGE(bufoff, gbase, voff) do { _Pragma("unroll") for (int _i = 0; _i < 2; ++_i) \
        __builtin_amdgcn_global_load_lds((const unsigned*)((const char*)(gbase) + (voff)[_i]), (LAS unsigned*)(lds + (bufoff) + ldsw + _i * 8192), 16, 0, 0); } while (0)
#define PG8_LDA(dst, b, h) do { _Pragma("unroll") for (int m = 0; m < 4; ++m) _Pragma("unroll") for (int k = 0; k < 2; ++k) dst[m][k] = *(const LAS bf16x8*)(lds + PG8_SA(b, h) + aoff + m * 2048 + k * 1024); } while (0)
#define PG8_LDB(dst, b, h) do { _Pragma("unroll") for (int n = 0; n < 2; ++n) _Pragma("unroll") for (int k = 0; k < 2; ++k) dst[n][k] = *(const LAS bf16x8*)(lds + PG8_SB(b, h) + boff + n * 2048 + k * 1024); } while (0)
#define PG8_MMA(ai, bj, At, Bt) do { __builtin_amdgcn_s_setprio(1); _Pragma("unroll") for (int m = 0; m < 4; ++m) _Pragma("unroll") for (int n = 0; n < 2; ++n) _Pragma("unroll") for (int k = 0; k < 2; ++k) \
        acc[ai][bj][m][n] = __builtin_amdgcn_mfma_f32_16x16x32_bf16(Bt[n][k], At[m][k], acc[ai][bj][m][n], 0, 0, 0); __builtin_amdgcn_s_setprio(0); } while (0)
#define PG8_WAIT_V(n) asm volatile("s_waitcnt vmcnt(" #n ")" ::: "memory")
#define PG8_WAIT_L(n) asm volatile("s_waitcnt lgkmcnt(" #n ")" ::: "memory")
#define PG8_BAR __builtin_amdgcn_s_barrier()
#define PG8_SCHED __builtin_amdgcn_sched_barrier(0)
#define PG8_ABASE(u) ((const char*)g.A + (size_t)(u).pm * tstepA + ((u).pn >= g.a_split_pn ? (size_t)g.a_split_off * 2 : (size_t)0) + (size_t)(u).ks * g.kpart * 2)
#define PG8_BBASE(u) ((const char*)g.Bt + (size_t)(u).pn * tstepB + (size_t)(u).ks * g.kpart * 2)
    Unit cur, nxt; int ui = 0;
    if (!S.next(0, cur)) return;
    f32x4 acc[2][2][4][2];
#pragma unroll
    for (int a = 0; a < 2; ++a)
#pragma unroll
        for (int b = 0; b < 2; ++b)
#pragma unroll
            for (int m = 0; m < 4; ++m)
#pragma unroll
                for (int n = 0; n < 2; ++n) acc[a][b][m][n] = (f32x4){0.f, 0.f, 0.f, 0.f};
    bf16x8 At[4][2], B0[2][2], B1[2][2];
    const char* cA = PG8_ABASE(cur); const char* cB = PG8_BBASE(cur);
    if constexpr (SP2) {
        PG8_STAGE(PG8_SB(0, 0), cB, voffB); PG8_STAGE(PG8_SB(0, 1), cB + hstepB, voffB); PG8_STAGE(PG8_SA(0, 0), cA, voffA); PG8_STAGE(PG8_SA(0, 1), cA + hstepA, voffA);
        if (wr == 1) PG8_BAR;
        PG8_WAIT_V(2); PG8_BAR;
        PG8_STAGE(PG8_SB(1, 0), cB + kstep, voffB); PG8_STAGE(PG8_SA(1, 0), cA + kstep, voffA); PG8_STAGE(PG8_SB(1, 1), cB + hstepB + kstep, voffB);
        PG8_WAIT_V(6); PG8_BAR;
    } else {
        PG8_STAGE(PG8_SB(0, 0), cB, voffB); PG8_STAGE(PG8_SA(0, 0), cA, voffA); PG8_STAGE(PG8_SB(0, 1), cB + hstepB, voffB); PG8_STAGE(PG8_SA(0, 1), cA + hstepA, voffA);
        if (wr == 1) PG8_BAR;
        PG8_WAIT_V(4); PG8_BAR;
        PG8_STAGE(PG8_SB(1, 0), cB + kstep, voffB); PG8_STAGE(PG8_SA(1, 0), cA + kstep, voffA); PG8_STAGE(PG8_SB(1, 1), cB + hstepB + kstep, voffB);
        PG8_WAIT_V(6); PG8_BAR;
    }
    for (;;) {
        const bool has_next = S.next(ui + 1, nxt);
        const char* nA = has_next ? PG8_ABASE(nxt) : cA; const char* nB = has_next ? PG8_BBASE(nxt) : cB;
        for (int t = 0; t < nt; t += 2) {
            const bool last = (t == nt - 2);
            const char* a1 = cA + (size_t)(t + 1) * kstep;
            const char* a2 = last ? nA : cA + (size_t)(t + 2) * kstep; const char* b2 = last ? nB : cB + (size_t)(t + 2) * kstep;
            const char* a3 = a2 + kstep; const char* b3 = b2 + kstep;
            if constexpr (SP2) {
            PG8_LDB(B0, 0, 0); PG8_LDB(B1, 0, 1); PG8_SCHED; PG8_LDA(At, 0, 0); PG8_STAGE(PG8_SA(1, 1), a1 + hstepA, voffA);
            PG8_WAIT_V(8); PG8_WAIT_L(0); PG8_BAR; PG8_MMA(0, 0, At, B0); PG8_MMA(0, 1, At, B1); PG8_BAR; PG8_SCHED;
            PG8_LDA(At, 0, 1); PG8_STAGE(PG8_SB(0, 0), b2, voffB); PG8_STAGE(PG8_SB(0, 1), b2 + hstepB, voffB); PG8_STAGE(PG8_SA(0, 0), a2, voffA);
            PG8_WAIT_V(8); PG8_WAIT_L(0); PG8_BAR; PG8_MMA(1, 0, At, B0); PG8_MMA(1, 1, At, B1); PG8_BAR; PG8_SCHED;
            PG8_LDB(B0, 1, 0); PG8_LDB(B1, 1, 1); PG8_SCHED; PG8_LDA(At, 1, 0); PG8_STAGE(PG8_SA(0, 1), a2 + hstepA, voffA);
            PG8_WAIT_V(8); PG8_WAIT_L(0); PG8_BAR; PG8_MMA(0, 0, At, B0); PG8_MMA(0, 1, At, B1); PG8_BAR; PG8_SCHED;
            PG8_LDA(At, 1, 1); PG8_STAGE(PG8_SB(1, 0), b3, voffB); PG8_STAGE(PG8_SB(1, 1), b3 + hstepB, voffB); PG8_STAGE(PG8_SA(1, 0), a3, voffA);
            PG8_WAIT_V(8); PG8_WAIT_L(0); PG8_BAR; PG8_MMA(1, 0, At, B0); PG8_MMA(1, 1, At, B1); PG8_BAR; PG8_SCHED;
            } else {
            PG8_LDB(B0, 0, 0); PG8_SCHED; PG8_LDA(At, 0, 0); PG8_STAGE(PG8_SA(1, 1), a1 + hstepA, voffA);
            PG8_WAIT_L(8); PG8_BAR; PG8_WAIT_L(0); PG8_MMA(0, 0, At, B0); PG8_BAR; PG8_SCHED;
            PG8_LDB(B1, 0, 1); PG8_STAGE(PG8_SB(0, 0), b2, voffB);
            PG8_BAR; PG8_WAIT_L(0); PG8_MMA(0, 1, At, B1); PG8_BAR;
            PG8_LDA(At, 0, 1); PG8_STAGE(PG8_SA(0, 0), a2, voffA);
            PG8_BAR; PG8_WAIT_L(0); PG8_MMA(1, 0, At, B0); PG8_BAR; PG8_SCHED;
            PG8_STAGE(PG8_SB(0, 1), b2 + hstepB, voffB);
            PG8_WAIT_V(6); PG8_BAR; PG8_MMA(1, 1, At, B1); PG8_BAR;
            PG8_LDB(B0, 1, 0); PG8_SCHED; PG8_LDA(At, 1, 0); PG8_STAGE(PG8_SA(0, 1), a2 + hstepA, voffA);
            PG8_WAIT_L(8); PG8_BAR; PG8_WAIT_L(0); PG8_MMA(0, 0, At, B0); PG8_BAR; PG8_SCHED;
            PG8_LDB(B1, 1, 1); PG8_STAGE(PG8_SB(1, 0), b3, voffB);
            PG8_BAR; PG8_WAIT_L(0); PG8_MMA(0, 1, At, B1); PG8_BAR;
            PG8_LDA(At, 1, 1); PG8_STAGE(PG8_SA(1, 0), a3, voffA);
            PG8_BAR; PG8_WAIT_L(0); PG8_MMA(1, 0, At, B0); PG8_BAR; PG8_SCHED;
            PG8_STAGE(PG8_SB(1, 1), b3 + hstepB, voffB);
            PG8_WAIT_V(6); PG8_BAR; PG8_MMA(1, 1, At, B1); PG8_BAR;
            }
        }
        if constexpr (ALIGN_EPI) { if (wr == 0) PG8_BAR; }
        { const int le_ = lane_id_opaque(); E(acc, cur, wr, wc, le_ & 15, le_ >> 4); }
        if (!has_next) break;
#pragma unroll
        for (int a = 0; a < 2; ++a)
#pragma unroll
            for (int b = 0; b < 2; ++b)
#pragma unroll
                for (int m = 0; m < 4; ++m)
#pragma unroll
                    for (int n = 0; n < 2; ++n) acc[a][b][m][n] = (f32x4){0.f, 0.f, 0.f, 0.f};
        cur = nxt; cA = nA; cB = nB; ++ui;
        if constexpr (ALIGN_EPI) { if (wr == 1) PG8_BAR; }
    }
    PG8_WAIT_V(0);
    if constexpr (!ALIGN_EPI) { if (wr == 0) PG8_BAR; }
    PG8_BAR;
#undef PG8_SA
#undef PG8_SB
#undef PG8_STAGE
#undef PG8_LDA
#undef PG8_LDB
#undef PG8_MMA
#undef PG8_WAIT_V
#undef PG8_WAIT_L
#undef PG8_BAR
#undef PG8_SCHED
#undef PG8_ABASE
#undef PG8_BBASE
}
}

struct EpiZ {
    static constexpr bool PERM = true;
    float* out; unsigned char* ws;
    __device__ __forceinline__ void operator()(const f32x4 (&acc)[2][2][4][2], const pg8::Unit& u, int wr, int wc, int fr, int fq) const {
        asm volatile("" : "+v"(fr), "+v"(fq));
        const int seg = u.pn >> 1;
        const bool smp = u.pm >= SEQ / 256;
        const int row0 = u.pm * 256 + wr * 64 + fr;
        const int cl0 = wc * 32 + 8 * fq;
        if (seg < 6) {
            bf16_t* B = (bf16_t*)(ws + WS_QA + (size_t)seg * (WS_KA - WS_QA));
            const bool isq = (seg == 0 || seg == 3);
            const float sc = isq ? C2 : 1.0f;
            const int kk = seg - 1 - (seg > 3 ? 1 : 0);
            float* ob = isq ? nullptr : (smp ? out + O_DKS + (size_t)kk * NSMP * 512 - (size_t)SEQ * 512 : out + O_DKP + (size_t)kk * SEQ * 512);
            const int cs = (u.pn & 1) * 256 + cl0;
            if (seg == 0 || seg == 1 || seg == 3 || seg == 4) {
                float mx0 = 0.f, mx1 = 0.f;
#pragma unroll
                for (int ai = 0; ai < 2; ++ai)
#pragma unroll
                    for (int m = 0; m < 4; ++m) {
#pragma unroll
                        for (int bj = 0; bj < 2; ++bj) { const f32x4 v0 = acc[ai][bj][m][0] * sc, v1 = acc[ai][bj][m][1] * sc;
                            float ss = (v0[0] * v0[0] + v0[1] * v0[1]) + (v0[2] * v0[2] + v0[3] * v0[3]) + (v1[0] * v1[0] + v1[1] * v1[1]) + (v1[2] * v1[2] + v1[3] * v1[3]);
                            ss += __shfl_xor(ss, 16); ss += __shfl_xor(ss, 32);
                            if (bj == 0) mx0 = fmaxf(mx0, ss); else mx1 = fmaxf(mx1, ss); } }
#pragma unroll
                for (int ofs = 1; ofs < 16; ofs <<= 1) { mx0 = fmaxf(mx0, __shfl_xor(mx0, ofs)); mx1 = fmaxf(mx1, __shfl_xor(mx1, ofs)); }
                if ((fr | fq) == 0) { unsigned* nw = (unsigned*)(ws + WS_CTL) + (seg < 3 ? 288 : 256) + ((seg == 4 || seg == 1) ? 16 : 0);
                    const int h0 = (u.pn & 1) * 4 + (wc >> 1), hf = wc & 1;
                    atomicMax(nw + (h0 * 2 + hf), __float_as_uint(mx0)); atomicMax(nw + ((h0 + 2) * 2 + hf), __float_as_uint(mx1)); }
            }
#pragma unroll
            for (int ai = 0; ai < 2; ++ai)
#pragma unroll
                for (int m = 0; m < 4; ++m) { const size_t r = (size_t)(row0 + ai * 128 + m * 16);
#pragma unroll
                    for (int bj = 0; bj < 2; ++bj) { const f32x4 v0 = acc[ai][bj][m][0], v1 = acc[ai][bj][m][1]; const int c = cs + bj * 128;
                        if (ob) { if (smp) { *(f32x4*)(ob + r * 512 + c) = v0; *(f32x4*)(ob + r * 512 + c + 4) = v1; }
                                  else { __builtin_nontemporal_store(v0, (f32x4*)(ob + r * 512 + c)); __builtin_nontemporal_store(v1, (f32x4*)(ob + r * 512 + c + 4)); } }
                        u32x4 w; w.x = pg8::cvt_pk_bf16(v0[0] * sc, v0[1] * sc); w.y = pg8::cvt_pk_bf16(v0[2] * sc, v0[3] * sc); w.z = pg8::cvt_pk_bf16(v1[0] * sc, v1[1] * sc); w.w = pg8::cvt_pk_bf16(v1[2] * sc, v1[3] * sc);
                        *(u32x4*)(B + r * 512 + c) = w; } }
        } else {
            bf16_t* G = (bf16_t*)(ws + WS_G);
            const int cs = (u.pn - 12) * 256 + cl0;
#pragma unroll
            for (int ai = 0; ai < 2; ++ai)
#pragma unroll
                for (int m = 0; m < 4; ++m) { const size_t r = (size_t)(row0 + ai * 128 + m * 16);
#pragma unroll
                    for (int bj = 0; bj < 2; ++bj) { const f32x4 v0 = acc[ai][bj][m][0], v1 = acc[ai][bj][m][1]; const int c = cs + bj * 128;
                        u32x4 w; w.x = cvtpk_v(sigmoidf_(v0[0]), sigmoidf_(v0[1])); w.y = cvtpk_v(sigmoidf_(v0[2]), sigmoidf_(v0[3]));
                        w.z = cvtpk_v(sigmoidf_(v1[0]), sigmoidf_(v1[1])); w.w = cvtpk_v(sigmoidf_(v1[2]), sigmoidf_(v1[3]));
                        *(u32x4*)(G + r * 2048 + c) = w; } }
        }
    }
};
struct EpiGate {
    static constexpr bool PERM = true;
    bf16_t* G; bf16_t* GO;
    __device__ __forceinline__ void operator()(const f32x4 (&acc)[2][2][4][2], const pg8::Unit& u, int wr, int wc, int fr, int fq) const {
        asm volatile("" : "+v"(fr), "+v"(fq));
        const int row0 = u.pm * 256 + wr * 64 + fr, c0 = u.pn * 256 + wc * 32 + 8 * fq;
#pragma unroll
        for (int ai = 0; ai < 2; ++ai)
#pragma unroll
            for (int m = 0; m < 4; ++m) { const size_t ro = (size_t)(row0 + ai * 128 + m * 16) * 2048 + c0; const bf16_t* rp = G + ro; bf16_t* wp = GO + ro;
#pragma unroll
                for (int bj = 0; bj < 2; ++bj) { const f32x4 v0 = acc[ai][bj][m][0], v1 = acc[ai][bj][m][1]; const u32x4 gw = *(const u32x4*)(rp + bj * 128);
                    u32x4 w; w.x = pg8::cvt_pk_bf16(v0[0] * bflo(gw.x), v0[1] * bfhi(gw.x)); w.y = pg8::cvt_pk_bf16(v0[2] * bflo(gw.y), v0[3] * bfhi(gw.y));
                    w.z = pg8::cvt_pk_bf16(v1[0] * bflo(gw.z), v1[1] * bfhi(gw.z)); w.w = pg8::cvt_pk_bf16(v1[2] * bflo(gw.w), v1[3] * bfhi(gw.w));
                    *(u32x4*)(wp + bj * 128) = w; } }
    }
};
template <bool BASE_BF16> struct EpiRes {
    static constexpr bool PERM = true;
    const void* base; bf16_t* T; const float* gate;
    __device__ __forceinline__ void operator()(const f32x4 (&acc)[2][2][4][2], const pg8::Unit& u, int wr, int wc, int fr, int fq) const {
        asm volatile("" : "+v"(fr), "+v"(fq));
        const int row0 = u.pm * 256 + wr * 64 + fr, c0 = u.pn * 256 + wc * 32 + 8 * fq;
#pragma unroll
        for (int ai = 0; ai < 2; ++ai)
#pragma unroll
            for (int m = 0; m < 4; ++m) { const size_t ro = (size_t)(row0 + ai * 128 + m * 16) * DM;
#pragma unroll
                for (int bj = 0; bj < 2; ++bj) { const int c = c0 + bj * 128; f32x4 b0, b1;
                    if (BASE_BF16) { const u32x4 bw = *(const u32x4*)((const bf16_t*)base + ro + c); b0 = (f32x4){bflo(bw.x), bfhi(bw.x), bflo(bw.y), bfhi(bw.y)}; b1 = (f32x4){bflo(bw.z), bfhi(bw.z), bflo(bw.w), bfhi(bw.w)}; }
                    else { b0 = *(const f32x4*)((const float*)base + ro + c); b1 = *(const f32x4*)((const float*)base + ro + c + 4); }
                    const f32x4 g0 = *(const f32x4*)(gate + c), g1 = *(const f32x4*)(gate + c + 4);
                    const f32x4 v0 = b0 * ALPHA + g0 * acc[ai][bj][m][0], v1 = b1 * ALPHA + g1 * acc[ai][bj][m][1];
                    u32x4 w; w.x = pg8::cvt_pk_bf16(v0[0], v0[1]); w.y = pg8::cvt_pk_bf16(v0[2], v0[3]); w.z = pg8::cvt_pk_bf16(v1[0], v1[1]); w.w = pg8::cvt_pk_bf16(v1[2], v1[3]);
                    *(u32x4*)(T + ro + c) = w; } }
    }
};
struct PanelStats {
    unsigned* xbuf; unsigned* cnt; float eps;
    __device__ __forceinline__ void run(const f32x4 (&v)[2][2][4][2], const pg8::Unit& u, int wr, int wc, int fr, int fq, LAS unsigned char* lds, int wid, int lane) const {
        LAS f32x2* P = (LAS f32x2*)(lds + LN_LDS);
        LAS f32x2* S = (LAS f32x2*)(lds + LN_LDS + 8192);
#pragma unroll
        for (int ai = 0; ai < 2; ++ai)
#pragma unroll
            for (int m = 0; m < 4; ++m) {
                float s = 0.f;
#pragma unroll
                for (int bj = 0; bj < 2; ++bj)
#pragma unroll
                    for (int n = 0; n < 2; ++n) { const f32x4 x = v[ai][bj][m][n]; s += (x[0] + x[1]) + (x[2] + x[3]); }
                s += __shfl_xor(s, 16); s += __shfl_xor(s, 32);
                const float mw = s * (1.0f / 64.0f); float q = 0.f;
#pragma unroll
                for (int bj = 0; bj < 2; ++bj)
#pragma unroll
                    for (int n = 0; n < 2; ++n) { const f32x4 d = v[ai][bj][m][n] - mw; q += (d[0] * d[0] + d[1] * d[1]) + (d[2] * d[2] + d[3] * d[3]); }
                q += __shfl_xor(q, 16); q += __shfl_xor(q, 32);
                if (fq == 0) P[(ai * 128 + wr * 64 + m * 16 + fr) * 4 + wc] = (f32x2){mw, q};
                __builtin_amdgcn_sched_barrier(0);
            }
        asm volatile("s_waitcnt lgkmcnt(0)" ::: "memory"); __builtin_amdgcn_s_barrier(); asm volatile("" ::: "memory");
        const int row = wid * 32 + (lane & 31);
        if (lane < 32) {
            const f32x2 a = P[row * 4 + 0], b = P[row * 4 + 1], c = P[row * 4 + 2], d = P[row * 4 + 3];
            const float mt = (a.x + b.x + c.x + d.x) * 0.25f;
            const float da = a.x - mt, db = b.x - mt, dc = c.x - mt, dd = d.x - mt;
            const float m2 = (a.y + b.y) + (c.y + d.y) + 64.0f * ((da * da + db * db) + (dc * dc + dd * dd));
            unsigned long long* slot = (unsigned long long*)xbuf + ((size_t)(u.pm * 256 + row) * 4 + u.pn);
            __hip_atomic_store(slot, ((unsigned long long)__float_as_uint(m2) << 32) | __float_as_uint(mt), __ATOMIC_RELAXED, __HIP_MEMORY_SCOPE_AGENT);
        }
        asm volatile("s_waitcnt vmcnt(0)" ::: "memory");
        if (lane == 0) __hip_atomic_fetch_add(cnt + 64 * u.pm, 1u, __ATOMIC_RELAXED, __HIP_MEMORY_SCOPE_AGENT);
        if (wid == 0) {
            unsigned sp = 0;
            while ((unsigned)__builtin_amdgcn_readfirstlane(__hip_atomic_load(cnt + 64 * u.pm, __ATOMIC_RELAXED, __HIP_MEMORY_SCOPE_AGENT)) < 32u && ++sp < (1u << 21)) __builtin_amdgcn_s_sleep(2);
            __builtin_amdgcn_fence(__ATOMIC_ACQUIRE, "agent");
        }
        asm volatile("s_waitcnt vmcnt(0) lgkmcnt(0)" ::: "memory"); __builtin_amdgcn_s_barrier(); asm volatile("" ::: "memory");
        if (lane < 32) {
            const unsigned long long* slot = (const unsigned long long*)xbuf + (size_t)(u.pm * 256 + row) * 4; float mt[4], m2[4]; float ms = 0.f;
#pragma unroll
            for (int t = 0; t < 4; ++t) { const unsigned long long w = __hip_atomic_load(slot + t, __ATOMIC_RELAXED, __HIP_MEMORY_SCOPE_AGENT); mt[t] = __uint_as_float((unsigned)w); m2[t] = __uint_as_float((unsigned)(w >> 32)); ms += mt[t]; }
            const float mean = ms * 0.25f; float q = 0.f;
#pragma unroll
            for (int t = 0; t < 4; ++t) { const float dm = mt[t] - mean; q += m2[t] + 256.0f * dm * dm; }
            S[row] = (f32x2){mean, 1.0f / sqrtf(q * (1.0f / 1024.0f) + eps)};
        }
        asm volatile("s_waitcnt lgkmcnt(0)" ::: "memory"); __builtin_amdgcn_s_barrier(); asm volatile("" ::: "memory");
    }
};
template <bool FINAL> struct EpiResLn {
    static constexpr bool PERM = true;
    const void* base; const float* gate; const float* lg; const float* lb; const float* mod; bf16_t* X1B; bf16_t* XN; float* out; PanelStats st; LAS unsigned char* lds;
    __device__ __forceinline__ void operator()(f32x4 (&acc)[2][2][4][2], const pg8::Unit& u, int wr, int wc, int fr, int fq) const {
        asm volatile("" : "+v"(fr), "+v"(fq));
        const int row0 = u.pm * 256 + wr * 64 + fr, c0 = u.pn * 256 + wc * 32 + 8 * fq;
#pragma unroll
        for (int ai = 0; ai < 2; ++ai)
#pragma unroll
            for (int m = 0; m < 4; ++m) { int rr_ = row0 + ai * 128 + m * 16; asm volatile("" : "+v"(rr_)); const size_t ro = (size_t)rr_ * DM;
#pragma unroll
                for (int bj = 0; bj < 2; ++bj) { int c = c0 + bj * 128; asm volatile("" : "+v"(c)); f32x4 b0, b1;
                    if (FINAL) { const u32x4 bw = *(const u32x4*)((const bf16_t*)base + ro + c); b0 = (f32x4){bflo(bw.x), bfhi(bw.x), bflo(bw.y), bfhi(bw.y)}; b1 = (f32x4){bflo(bw.z), bfhi(bw.z), bflo(bw.w), bfhi(bw.w)}; }
                    else { b0 = *(const f32x4*)((const float*)base + ro + c); b1 = *(const f32x4*)((const float*)base + ro + c + 4); }
                    const f32x4 g0 = *(const f32x4*)(gate + c), g1 = *(const f32x4*)(gate + c + 4);
                    acc[ai][bj][m][0] = b0 * ALPHA + g0 * acc[ai][bj][m][0]; acc[ai][bj][m][1] = b1 * ALPHA + g1 * acc[ai][bj][m][1];
                    asm volatile("" : "+v"(acc[ai][bj][m][0]), "+v"(acc[ai][bj][m][1])); }
                __builtin_amdgcn_sched_barrier(0); }
        st.run(acc, u, wr, wc, fr, fq, lds, wr * 4 + wc, fq * 16 + fr);
        const LAS f32x2* S = (const LAS f32x2*)(lds + LN_LDS + 8192);
#pragma unroll
        for (int ai = 0; ai < 2; ++ai)
#pragma unroll
            for (int m = 0; m < 4; ++m) { int r = ai * 128 + wr * 64 + m * 16 + fr; asm volatile("" : "+v"(r)); const f32x2 sr = S[r]; const size_t ro = (size_t)(u.pm * 256 + r) * DM;
#pragma unroll
                for (int bj = 0; bj < 2; ++bj) { int c = c0 + bj * 128; asm volatile("" : "+v"(c));
                    const f32x4 y0 = (acc[ai][bj][m][0] - sr.x) * sr.y * *(const f32x4*)(lg + c) + *(const f32x4*)(lb + c);
                    const f32x4 y1 = (acc[ai][bj][m][1] - sr.x) * sr.y * *(const f32x4*)(lg + c + 4) + *(const f32x4*)(lb + c + 4);
                    if (FINAL) { __builtin_nontemporal_store(y0, (f32x4*)(out + ro + c)); __builtin_nontemporal_store(y1, (f32x4*)(out + ro + c + 4)); }
                    else { u32x4 w; w.x = pg8::cvt_pk_bf16(y0[0], y0[1]); w.y = pg8::cvt_pk_bf16(y0[2], y0[3]); w.z = pg8::cvt_pk_bf16(y1[0], y1[1]); w.w = pg8::cvt_pk_bf16(y1[2], y1[3]);
                        *(u32x4*)(X1B + ro + c) = w;
                        const f32x4 h0 = y0 * (*(const f32x4*)(mod + 4096 + c) + 1.0f) + *(const f32x4*)(mod + 3072 + c), h1 = y1 * (*(const f32x4*)(mod + 4096 + c + 4) + 1.0f) + *(const f32x4*)(mod + 3072 + c + 4);
                        u32x4 w2; w2.x = pg8::cvt_pk_bf16(h0[0], h0[1]); w2.y = pg8::cvt_pk_bf16(h0[2], h0[3]); w2.z = pg8::cvt_pk_bf16(h1[0], h1[1]); w2.w = pg8::cvt_pk_bf16(h1[2], h1[3]);
                        *(u32x4*)(XN + ro + c) = w2; } }
                __builtin_amdgcn_sched_barrier(0); }
    }
};
struct EpiSlab {
    static constexpr bool PERM = true;
    float* slab;
    __device__ __forceinline__ void operator()(const f32x4 (&acc)[2][2][4][2], const pg8::Unit& u, int wr, int wc, int fr, int fq) const {
        asm volatile("" : "+v"(fr), "+v"(fq));
        const int row0 = wr * 64 + fr, c0 = u.pn * 256 + wc * 32 + 8 * fq; float* sb = slab + (size_t)u.ks * NSMP * DM;
#pragma unroll
        for (int ai = 0; ai < 2; ++ai)
#pragma unroll
            for (int m = 0; m < 4; ++m) { float* op = sb + (size_t)(row0 + ai * 128 + m * 16) * DM + c0;
#pragma unroll
                for (int bj = 0; bj < 2; ++bj) { *(f32x4*)(op + bj * 128) = acc[ai][bj][m][0]; *(f32x4*)(op + bj * 128 + 4) = acc[ai][bj][m][1]; } }
    }
};
struct EpiFfn {
    static constexpr bool PERM = true;
    bf16_t* ACT;
    __device__ __forceinline__ void operator()(const f32x4 (&acc)[2][2][4][2], const pg8::Unit& u, int wr, int wc, int fr, int fq) const {
        asm volatile("" : "+v"(fr), "+v"(fq));
        const int row0 = u.pm * 256 + wr * 64 + fr, c0 = u.pn * 128 + wc * 32 + 8 * fq;
#pragma unroll
        for (int ai = 0; ai < 2; ++ai)
#pragma unroll
            for (int m = 0; m < 4; ++m) { const f32x4 g0 = acc[ai][0][m][0], g1 = acc[ai][0][m][1], u0 = acc[ai][1][m][0], u1 = acc[ai][1][m][1];
                u32x4 w; w.x = pg8::cvt_pk_bf16(siluf_(g0[0]) * u0[0], siluf_(g0[1]) * u0[1]); w.y = pg8::cvt_pk_bf16(siluf_(g0[2]) * u0[2], siluf_(g0[3]) * u0[3]);
                w.z = pg8::cvt_pk_bf16(siluf_(g1[0]) * u1[0], siluf_(g1[1]) * u1[1]); w.w = pg8::cvt_pk_bf16(siluf_(g1[2]) * u1[2], siluf_(g1[3]) * u1[3]);
                *(u32x4*)(ACT + (size_t)(row0 + ai * 128 + m * 16) * DFF + c0) = w; }
    }
};

struct Frame {
    LAS unsigned char* lds; unsigned char* ldsg;
    int tid, lane, wave, G, bid;
    const float* const* in; float* out; unsigned char* ws;
};
enum { I_XP = 0, I_XS, I_CDK, I_CDV, I_CFK, I_CFV, I_CFL, I_CP, I_CS, I_WADA, I_BADA, I_WIN, I_BF, I_LQ1, I_LK1, I_LQ2, I_LK2, I_SUBG, I_RELB, I_WA, I_WB, I_WO, I_LN1G, I_LN1B, I_LN2G, I_LN2B, I_WFI, I_WFO };

__device__ __forceinline__ void tr_item(const float* W, int ldw, int src_n0, int k0, bf16_t* WT, int ldt, int dst_row0, int dst_k0, int dup_off, LAS float* scr, int lane) {
#pragma unroll 8
    for (int i = 0; i < 32; ++i) { const int kk = 2 * i + (lane >> 5); scr[kk * 33 + (lane & 31)] = W[(size_t)(k0 + kk) * ldw + src_n0 + (lane & 31)]; }
    asm volatile("s_waitcnt lgkmcnt(0)" ::: "memory");
    const int c = lane & 7;
#pragma unroll
    for (int j = 0; j < 4; ++j) { const int n = (lane >> 3) + 8 * j; const LAS float* s = scr + (8 * c) * 33 + n;
        u32x4 o; o.x = pk2(s[0 * 33], s[1 * 33]); o.y = pk2(s[2 * 33], s[3 * 33]); o.z = pk2(s[4 * 33], s[5 * 33]); o.w = pk2(s[6 * 33], s[7 * 33]);
        bf16_t* d = WT + (size_t)(dst_row0 + n) * ldt + dst_k0 + 8 * c;
        *(u32x4*)d = o; if (dup_off) *(u32x4*)(d + dup_off) = o; }
    asm volatile("s_waitcnt lgkmcnt(0)" ::: "memory");
}
__device__ __forceinline__ void weight_copies(Frame& F, int c, int n, int it0, int it1) {
    LAS float* scr = (LAS float*)(F.lds + F.wave * 16384);
    const int gw = c * 8 + F.wave, NGW = n * 8;
    constexpr int I_IN = 16 * (NZ / 32), I_A = 8 * 32, I_B = 8 * 32, I_O = 16 * 32, I_FI = 16 * (NFF2 / 32), I_FO = (DFF / 64) * 32;
    for (int it = it0 + gw; it < it1; it += NGW) {
        int r = it;
        if (r < I_IN) { const int nb = NZ / 32, kb = r / nb, n0 = 32 * (r % nb); tr_item(F.in[I_WIN], WIN_COLS, n0 < 3072 ? n0 : n0 + 8, 64 * kb, (bf16_t*)(F.ws + WS_WIN), 1024, n0, 64 * kb, 0, scr, F.lane); continue; } r -= I_IN;
        if (r < I_A) { const int kb = r / 32, n0 = 32 * (r % 32); tr_item(F.in[I_WA], 1024, n0, 64 * kb, (bf16_t*)(F.ws + WS_WAB), 512, n0, 64 * kb, 0, scr, F.lane); continue; } r -= I_A;
        if (r < I_B) { const int kb = r / 32, n0 = 32 * (r % 32); tr_item(F.in[I_WB], 1024, n0, 64 * kb, (bf16_t*)(F.ws + WS_WAB), 512, 1024 + n0, 64 * kb, 0, scr, F.lane); continue; } r -= I_B;
        if (r < I_O) { const int kb = r / 32, n0 = 32 * (r % 32); tr_item(F.in[I_WO], 1024, n0, 64 * kb, (bf16_t*)(F.ws + WS_WO2), 2048, n0, 64 * kb, 1024, scr, F.lane); continue; } r -= I_O;
        if (r < I_FI) { const int nb = NFF2 / 32, kb = r / nb, n0 = 32 * (r % nb), t = n0 >> 8, j = n0 & 255; const int src = j < 128 ? 128 * t + j : DFF + 128 * t + (j - 128);
            tr_item(F.in[I_WFI], NFF2, src, 64 * kb, (bf16_t*)(F.ws + WS_WFI), 1024, n0, 64 * kb, 0, scr, F.lane); continue; } r -= I_FI;
        { const int kb = r / 32, n0 = 32 * (r % 32); tr_item(F.in[I_WFO], 1024, n0, 64 * kb, (bf16_t*)(F.ws + WS_WFO), DFF, n0, 64 * kb, 0, scr, F.lane); }
    }
}
constexpr int WC_IN = 16 * (NZ / 32), WC_ALL = WC_IN + 8 * 32 + 8 * 32 + 16 * 32 + 16 * (NFF2 / 32) + (DFF / 64) * 32;
__device__ __forceinline__ void p0_prologue(Frame& F) {
    if (F.bid < 96) {
        LAS float* sc = (LAS float*)F.lds;
        LAS float* part = sc + 17 * 1024;
        { float cv[34];
#pragma unroll
          for (int j = 0; j < 34; ++j) { const int i = F.tid + 512 * j, r = i >> 10, k = i & 1023; cv[j] = r == 0 ? F.in[I_CP][k] : F.in[I_CS][(r - 1) * 1024 + k]; }
#pragma unroll
          for (int j = 0; j < 34; ++j) sc[F.tid + 512 * j] = siluf_(cv[j]); }
        __syncthreads();
        const int n = F.bid * 64 + F.lane; const float* wa = F.in[I_WADA] + n;
        float acc[17];
#pragma unroll
        for (int r = 0; r < 17; ++r) acc[r] = 0.f;
#pragma unroll 8
        for (int k = F.wave * 128; k < F.wave * 128 + 128; k += 4) {
            const float w0 = wa[(size_t)k * 6144], w1 = wa[(size_t)(k + 1) * 6144], w2 = wa[(size_t)(k + 2) * 6144], w3 = wa[(size_t)(k + 3) * 6144];
#pragma unroll
            for (int r = 0; r < 17; ++r) { const f32x4 s = *(const LAS f32x4*)(sc + r * 1024 + k); acc[r] += s[0] * w0 + s[1] * w1 + s[2] * w2 + s[3] * w3; }
        }
#pragma unroll
        for (int r = 0; r < 17; ++r) part[(F.wave * 17 + r) * 64 + F.lane] = acc[r];
        __syncthreads();
        float* mod = (float*)(F.ws + WS_MOD);
        for (int i = F.tid; i < 17 * 64; i += 512) { const int r = i >> 6, l = i & 63; float s = 0.f;
#pragma unroll
            for (int w = 0; w < 8; ++w) s += part[(w * 17 + r) * 64 + l];
            mod[r * 6144 + F.bid * 64 + l] = s + F.in[I_BADA][F.bid * 64 + l]; }
        asm volatile("s_waitcnt vmcnt(0)" ::: "memory");
        __syncthreads();
        if (F.tid == 0) { __builtin_amdgcn_fence(__ATOMIC_RELEASE, "agent"); asm volatile("s_waitcnt vmcnt(0)" ::: "memory");
            __hip_atomic_fetch_add((unsigned*)(F.ws + WS_CTL) + 320, 1u, __ATOMIC_RELAXED, __HIP_MEMORY_SCOPE_AGENT); }
    }
    if (F.G >= 192) { if (F.bid >= 96) weight_copies(F, F.bid - 96, F.G - 96, 0, 16 * (NZ / 32)); }
    else weight_copies(F, F.bid, F.G, 0, 16 * (NZ / 32));
}

__device__ __forceinline__ void p1_rows(Frame& F, bool wait_mod) {
    LAS float* wf = (LAS float*)F.lds;
    for (int i = F.tid; i < 1024 * 8; i += 512) wf[i] = F.in[I_WIN][(size_t)(i >> 3) * WIN_COLS + 3072 + (i & 7)];
    __syncthreads();
    const float* mod = (const float*)(F.ws + WS_MOD);
    bf16_t* XN = (bf16_t*)(F.ws + WS_XN);
    const int gw = F.bid * 8 + F.wave, NGW = F.G * 8;
    if (wait_mod) {
        if (F.tid == 0) { unsigned* w = (unsigned*)(F.ws + WS_CTL) + 320; unsigned sp = 0;
            while (__hip_atomic_load(w, __ATOMIC_RELAXED, __HIP_MEMORY_SCOPE_AGENT) < 96u && ++sp < (1u << 22)) __builtin_amdgcn_s_sleep(2);
            __builtin_amdgcn_fence(__ATOMIC_ACQUIRE, "agent"); asm volatile("s_waitcnt vmcnt(0)" ::: "memory"); }
        __syncthreads(); }
    int m = gw;
    for (; m + NGW < SEQ; m += 2 * NGW) {
        const float* xr0 = F.in[I_XP] + (size_t)m * DM; const float* xr1 = xr0 + (size_t)NGW * DM;
        float a8[2][8];
#pragma unroll
        for (int j = 0; j < 8; ++j) { a8[0][j] = 0.f; a8[1][j] = 0.f; }
#pragma unroll
        for (int j = 0; j < 4; ++j) { const int k = 4 * F.lane + 256 * j;
            const f32x4 x0 = *(const f32x4*)(xr0 + k), x1 = *(const f32x4*)(xr1 + k), s1 = *(const f32x4*)(mod + 1024 + k), t1 = *(const f32x4*)(mod + k);
            const f32x4 h0 = x0 * (s1 + 1.0f) + t1, h1 = x1 * (s1 + 1.0f) + t1;
            u32x2 w; w.x = pk2(h0[0], h0[1]); w.y = pk2(h0[2], h0[3]); *(u32x2*)(XN + (size_t)m * DM + k) = w;
            w.x = pk2(h1[0], h1[1]); w.y = pk2(h1[2], h1[3]); *(u32x2*)(XN + (size_t)(m + NGW) * DM + k) = w;
#pragma unroll
            for (int e = 0; e < 4; ++e) { const f32x4 wa = *(const LAS f32x4*)(wf + (k + e) * 8), wb = *(const LAS f32x4*)(wf + (k + e) * 8 + 4);
#pragma unroll
                for (int c = 0; c < 4; ++c) { a8[0][c] += h0[e] * wa[c]; a8[0][4 + c] += h0[e] * wb[c]; a8[1][c] += h1[e] * wa[c]; a8[1][4 + c] += h1[e] * wb[c]; } } }
        float mine = 0.f;
#pragma unroll
        for (int j = 0; j < 8; ++j) { const float s0 = wave_sum(a8[0][j]), s1 = wave_sum(a8[1][j]); if (F.lane == j) mine = s0; if (F.lane == 8 + j) mine = s1; }
        if (F.lane < 16) { const int rr = F.lane >> 3, c = F.lane & 7; const float v = mine + F.in[I_BF][c]; const float lf = fminf(v, 0.f) - log1pf(__expf(-fabsf(v)));
            F.out[O_FLP + (size_t)(m + rr * NGW) * 8 + c] = lf; }
    }
    for (; m < MT; m += NGW) {
        const bool smp = m >= SEQ; const int rb = smp ? 1 + ((m - SEQ) >> 4) : 0;
        const float* xr = smp ? F.in[I_XS] + (size_t)(m - SEQ) * DM : F.in[I_XP] + (size_t)m * DM;
        const float* sh = mod + (size_t)rb * 6144, *scl = sh + 1024;
        float a8[8];
#pragma unroll
        for (int j = 0; j < 8; ++j) a8[j] = 0.f;
#pragma unroll
        for (int j = 0; j < 4; ++j) { const int k = 4 * F.lane + 256 * j;
            const f32x4 x = *(const f32x4*)(xr + k), s1 = *(const f32x4*)(scl + k), t1 = *(const f32x4*)(sh + k);
            const f32x4 h = x * (s1 + 1.0f) + t1;
            u32x2 w; w.x = pk2(h[0], h[1]); w.y = pk2(h[2], h[3]); *(u32x2*)(XN + (size_t)m * DM + k) = w;
#pragma unroll
            for (int e = 0; e < 4; ++e) { const f32x4 wa = *(const LAS f32x4*)(wf + (k + e) * 8), wb = *(const LAS f32x4*)(wf + (k + e) * 8 + 4);
                a8[0] += h[e] * wa[0]; a8[1] += h[e] * wa[1]; a8[2] += h[e] * wa[2]; a8[3] += h[e] * wa[3];
                a8[4] += h[e] * wb[0]; a8[5] += h[e] * wb[1]; a8[6] += h[e] * wb[2]; a8[7] += h[e] * wb[3]; } }
        float mine = 0.f;
#pragma unroll
        for (int j = 0; j < 8; ++j) { const float s = wave_sum(a8[j]); if (F.lane == j) mine = s; }
        if (F.lane < 8) { const float v = mine + F.in[I_BF][F.lane]; const float lf = fminf(v, 0.f) - log1pf(__expf(-fabsf(v)));
            float* o = smp ? F.out + O_FLS + (size_t)(m - SEQ) * 8 : F.out + O_FLP + (size_t)m * 8; o[F.lane] = lf; }
    }
}

__device__ __forceinline__ float block_excl_scan(Frame& F, float tot, LAS float* sm) {
    float inc = tot;
#pragma unroll
    for (int o = 1; o < 64; o <<= 1) { const float t = __shfl_up(inc, o); if (F.lane >= o) inc += t; }
    if (F.lane == 63) sm[F.wave] = inc;
    __syncthreads();
    float base = 0.f;
    for (int w = 0; w < F.wave; ++w) base += sm[w];
    __syncthreads();
    return base + inc - tot;
}
__device__ __forceinline__ void p2_cumsum(Frame& F) {
    LAS float* sm = (LAS float*)F.lds;
    const int rb_ = F.G >= 160 ? F.bid - 20 : F.bid;
    if (rb_ < 0) return;
    if (rb_ < 8) {
        const int h = rb_; const float* lf = F.out + O_FLP; float* Fp = (float*)(F.ws + WS_FP) + (size_t)h * SEQ;
        float v[32]; float run = 0.f;
#pragma unroll
        for (int i = 0; i < 32; ++i) { run += lf[(size_t)(32 * F.tid + i) * 8 + h]; v[i] = run; }
        const float off = block_excl_scan(F, run, sm);
#pragma unroll
        for (int i = 0; i < 32; i += 4) *(f32x4*)(Fp + 32 * F.tid + i) = (f32x4){(off + v[i]) * LOG2E, (off + v[i + 1]) * LOG2E, (off + v[i + 2]) * LOG2E, (off + v[i + 3]) * LOG2E};
    } else if (rb_ < 8 + 128) {
        const int b = (rb_ - 8) >> 3, h = (rb_ - 8) & 7;
        const float* cl = F.in[I_CFL] + (size_t)b * PAST * 8; float* Fs = (float*)(F.ws + WS_FS) + (size_t)(b * 8 + h) * SKV;
        float v[4]; float run = 0.f;
#pragma unroll
        for (int i = 0; i < 4; ++i) { run += cl[(size_t)(4 * F.tid + i) * 8 + h]; v[i] = run; }
        const float off = block_excl_scan(F, run, sm);
        *(f32x4*)(Fs + 4 * F.tid) = (f32x4){(off + v[0]) * LOG2E, (off + v[1]) * LOG2E, (off + v[2]) * LOG2E, (off + v[3]) * LOG2E};
        if (F.tid == 511) { float r2 = off + run; const float* ls = F.out + O_FLS + (size_t)b * DEC_T * 8;
            for (int t = 0; t < DEC_T; ++t) { r2 += ls[t * 8 + h]; Fs[PAST + t] = r2 * LOG2E; } }
    }
}

template <bool FINAL> __device__ __forceinline__ void ln_rows(Frame& F, const float* g, const float* b, int KS, int gate_off) {
    const float* mod = (const float*)(F.ws + WS_MOD);
    const bf16_t* T = (const bf16_t*)(F.ws + WS_TB); bf16_t* X1B = (bf16_t*)(F.ws + WS_X1B); bf16_t* XN = (bf16_t*)(F.ws + WS_XN);
    const int gw = F.wave * F.G + F.bid, NGW = F.G * 8;
    for (int m = SEQ + gw; m < MT; m += NGW) {
        f32x4 v[4]; float s = 0.f;
        if (m < SEQ) {
#pragma unroll
            for (int j = 0; j < 2; ++j) { const u32x4 w = *(const u32x4*)(T + (size_t)m * DM + 8 * F.lane + 512 * j);
                v[2 * j] = (f32x4){bflo(w.x), bfhi(w.x), bflo(w.y), bfhi(w.y)}; v[2 * j + 1] = (f32x4){bflo(w.z), bfhi(w.z), bflo(w.w), bfhi(w.w)}; }
        } else {
            const float* sl = (const float*)(F.ws + WS_SLAB) + (size_t)(m - SEQ) * DM; const float* gp = mod + (size_t)(1 + ((m - SEQ) >> 4)) * 6144 + gate_off;
#pragma unroll
            for (int q = 0; q < 4; ++q) { const int k = 8 * F.lane + 512 * (q >> 1) + 4 * (q & 1); f32x4 a = (f32x4){0.f, 0.f, 0.f, 0.f};
                for (int ks = 0; ks < KS; ++ks) a += *(const f32x4*)(sl + (size_t)ks * NSMP * DM + k);
                f32x4 bs;
                if (FINAL) { const u32x2 w = *(const u32x2*)(X1B + (size_t)m * DM + k); bs = (f32x4){bflo(w.x), bfhi(w.x), bflo(w.y), bfhi(w.y)}; }
                else bs = *(const f32x4*)(F.in[I_XS] + (size_t)(m - SEQ) * DM + k);
                v[q] = bs * ALPHA + *(const f32x4*)(gp + k) * a; } }
#pragma unroll
        for (int q = 0; q < 4; ++q) s += (v[q][0] + v[q][1]) + (v[q][2] + v[q][3]);
        const float mean = wave_sum(s) * (1.f / DM); float s2 = 0.f;
#pragma unroll
        for (int q = 0; q < 4; ++q) { v[q] = v[q] - mean; s2 += (v[q][0] * v[q][0] + v[q][1] * v[q][1]) + (v[q][2] * v[q][2] + v[q][3] * v[q][3]); }
        const float rstd = 1.f / sqrtf(wave_sum(s2) * (1.f / DM) + LN_EPS);
        const int rb = m >= SEQ ? 1 + ((m - SEQ) >> 4) : 0;
#pragma unroll
        for (int q = 0; q < 4; ++q) { const int k = 8 * F.lane + 512 * (q >> 1) + 4 * (q & 1); const f32x4 gg = *(const f32x4*)(g + k), bb = *(const f32x4*)(b + k);
            const f32x4 y = v[q] * rstd * gg + bb;
            if (FINAL) *(f32x4*)(F.out + (size_t)m * DM + k) = y;
            else { u32x2 w; w.x = pk2(y[0], y[1]); w.y = pk2(y[2], y[3]); *(u32x2*)(X1B + (size_t)m * DM + k) = w;
                const f32x4 s2v = *(const f32x4*)(mod + (size_t)rb * 6144 + 4096 + k), t2v = *(const f32x4*)(mod + (size_t)rb * 6144 + 3072 + k);
                const f32x4 h = y * (s2v + 1.0f) + t2v; u32x2 w2; w2.x = pk2(h[0], h[1]); w2.y = pk2(h[2], h[3]); *(u32x2*)(XN + (size_t)m * DM + k) = w2; } }
    }
}

__device__ __forceinline__ int t5_bucket(int rel) {
    const int n = rel < 0 ? -rel : rel; int b;
    if (n < 8) b = n; else if (n < 12) b = 8; else if (n < 16) b = 9; else if (n < 23) b = 10; else if (n < 32) b = 11; else if (n < 46) b = 12; else if (n < 64) b = 13; else if (n < 91) b = 14; else b = 15;
    return b + (rel > 0 ? 16 : 0);
}
constexpr int AT_KB = 8192, AT_VB = 20480, AT_BUF = AT_KB + AT_VB;
constexpr int AT_WS = 2 * AT_BUF, AT_OST = AT_WS + 2048, AT_KEEP = 98304, AT_TAB = 131072, AT_MISC = AT_TAB + 4 * 192 * 4, AT_END = AT_MISC + 64;
__device__ __forceinline__ s16x4 vtr(const LAS char* p) { typedef short v4i16_t __attribute__((ext_vector_type(4))); return __builtin_bit_cast(s16x4, __builtin_amdgcn_ds_read_tr16_b64_v4i16((LAS v4i16_t*)p)); }

typedef __bf16 bf16x2_t_ __attribute__((ext_vector_type(2)));
__device__ __forceinline__ unsigned cvtpk_(float lo, float hi) { f32x2 v = {lo, hi}; bf16x2_t_ b = __builtin_convertvector(v, bf16x2_t_); return __builtin_bit_cast(unsigned, b); }
__device__ __forceinline__ void glds16_asm(const void* gsrc, unsigned lds_dst) { unsigned keep;
    asm volatile("s_mov_b32 %0, m0\n\ts_mov_b32 m0, %2\n\ts_nop 0\n\tglobal_load_lds_dwordx4 %1, off\n\ts_mov_b32 m0, %0" : "=&s"(keep) : "v"(gsrc), "s"(lds_dst) : "memory"); }
template <int OFF> __device__ __forceinline__ void glds16_asm_off(const void* gsrc, unsigned lds_dst) { unsigned keep;
    asm volatile("s_mov_b32 %0, m0\n\ts_mov_b32 m0, %2\n\ts_nop 0\n\tglobal_load_lds_dwordx4 %1, off offset:%3\n\ts_mov_b32 m0, %0" : "=&s"(keep) : "v"(gsrc), "s"(lds_dst), "i"(OFF) : "memory"); }
template <int OFF> __device__ __forceinline__ void glds16_s(const void* sbase, unsigned voff, unsigned lds_dst) { unsigned keep;
    asm volatile("s_mov_b32 %0, m0\n\ts_mov_b32 m0, %3\n\ts_nop 0\n\tglobal_load_lds_dwordx4 %1, %2 offset:%4\n\ts_mov_b32 m0, %0" : "=&s"(keep) : "v"(voff), "s"(sbase), "s"(lds_dst), "i"(OFF) : "memory"); }
__device__ __forceinline__ void glds4_s(const void* sbase, unsigned voff, unsigned lds_dst) { unsigned keep;
    asm volatile("s_mov_b32 %0, m0\n\ts_mov_b32 m0, %3\n\ts_nop 0\n\tglobal_load_lds_dword %1, %2\n\ts_mov_b32 m0, %0" : "=&s"(keep) : "v"(voff), "s"(sbase), "s"(lds_dst) : "memory"); }
__device__ __forceinline__ const void* uniform_ptr(const void* p) { const unsigned long long v = (unsigned long long)p;
    const unsigned lo = (unsigned)__builtin_amdgcn_readfirstlane((int)(unsigned)v), hi = (unsigned)__builtin_amdgcn_readfirstlane((int)(unsigned)(v >> 32)); return (const void*)(((unsigned long long)hi << 32) | lo); }
__device__ __forceinline__ void glds4_asm(const void* gsrc, unsigned lds_dst) { unsigned keep;
    asm volatile("s_mov_b32 %0, m0\n\ts_mov_b32 m0, %2\n\ts_nop 0\n\tglobal_load_lds_dword %1, off\n\ts_mov_b32 m0, %0" : "=&s"(keep) : "v"(gsrc), "s"(lds_dst) : "memory"); }
constexpr int R_V = 0, R_K = 49152, R_F = 73728, R_WS = 79872;
__device__ __forceinline__ float max3f_(float a, float b, float c) { float r; asm("v_max3_f32 %0, %1, %2, %3" : "=v"(r) : "v"(a), "v"(b), "v"(c)); return r; }
__device__ __forceinline__ float max2f_(float a, float b) { float r; asm("v_max_f32_e32 %0, %1, %2" : "=v"(r) : "v"(a), "v"(b)); return r; }
#define AP3_PIN(x) asm volatile("" : "+v"(x))
template <int MODE, int DV, int pv = 0, bool SREF = false>
__device__ __forceinline__ void attn_pass3(Frame& F, const bf16_t* Q, const bf16_t* K, const bf16_t* V, int q0, int NT, const float* Fh, int hb, f32x16 (&o)[DV / 32], int t0 = 0) {
    constexpr int NDB = DV / 32, VS = DV * 128, EPG = 8 / NDB;
    constexpr float THR = 8.0f;
    const int lane = F.lane, r32 = lane & 31, hi = lane >> 5, wid = F.wave;
    const LAS char* lds = (const LAS char*)F.lds;
    LAS float* wsf = (LAS float*)(F.lds + R_WS) + wid * 64;
    const LAS float* tab = (const LAS float*)(F.lds + AT_TAB) + hb * 192;
    const int qrow = q0 + wid * 32 + r32;
    const int tmaxw = (q0 >> 6) + (wid >> 1);
    const char* Ku = (const char*)uniform_ptr(K); const char* Vu = (const char*)uniform_ptr(V); const char* Fu = (const char*)uniform_ptr(MODE == 0 ? (const void*)Fh : (const void*)K);
    const unsigned kvo = (unsigned)(((8 * wid + (lane >> 3)) * 512 + (((lane & 7) ^ (lane >> 3)) << 3)) * 2);
    const unsigned vvo = (unsigned)(((16 * (wid & 3) + (lane >> 2)) * 512 + 32 * (wid >> 2) + 8 * (lane & 3)) * 2);
    const unsigned fvo = (unsigned)(lane * 4);
    const unsigned lds0 = (unsigned)(size_t)F.lds;
    const unsigned dk = (unsigned)__builtin_amdgcn_readfirstlane((int)(lds0 + R_K + wid * 1024)), dv = (unsigned)__builtin_amdgcn_readfirstlane((int)(lds0 + R_V + wid * 1024)),
                   df = (unsigned)__builtin_amdgcn_readfirstlane((int)(lds0 + R_F + wid * 256));
#define AP_ISSUE_K(t, SL) do { glds16_s<0>(Ku + (size_t)(t) * 65536, kvo, dk + (SL) * 8192); if (MODE == 0) glds4_s(Fu + (size_t)(t) * 256, fvo, df + (SL) * 2048); } while (0)
#define AP_ISSUE_V(t, SL) do { glds16_s<0>(Vu + (size_t)(t) * 65536, vvo, dv + (SL) * VS); if (DV == 128) glds16_s<0>(Vu + (size_t)(t) * 65536 + 128, vvo, dv + (SL) * VS + 8192); } while (0)
#define AP_BATCH(t, SL) do { if (pv != 1) { if ((t) + 2 < NT) AP_ISSUE_K((t) + 2, ((SL) + 2) % 3); if ((t) + 1 < NT) AP_ISSUE_V((t) + 1, ((SL) + 1) % 3); } } while (0)
    AP_ISSUE_K(t0, 0); AP_ISSUE_K(t0 + 1, 1); AP_ISSUE_V(t0, 0);
    bf16x8 qr[4];
#pragma unroll
    for (int d0 = 0; d0 < 4; ++d0) qr[d0] = *(const bf16x8*)(Q + (size_t)qrow * 512 + d0 * 16 + hi * 8);
    float fqp = MODE == 0 ? Fh[qrow] : 0.f;
#pragma unroll
    for (int d = 0; d < NDB; ++d) o[d] = f32x16{};
    float m_hat = 0.f, l_run = 0.f;
    f32x16 p0, p1, negm; u32x4 pwv[4];
#pragma unroll
    for (int r = 0; r < 16; ++r) negm[r] = 0.f;
#pragma unroll
    for (int i = 0; i < 4; ++i) pwv[i] = (u32x4){0u, 0u, 0u, 0u};
    const LAS char* kb4[4];
#pragma unroll
    for (int d0 = 0; d0 < 4; ++d0) kb4[d0] = lds + R_K + r32 * 128 + (((2 * d0 + hi) ^ (r32 & 7)) << 4);
    const LAS char* vb1 = lds + R_V + (4 * hi + ((lane & 15) >> 2)) * 64 + (((lane >> 4) & 1) * 16 + (lane & 3) * 4) * 2;
    const LAS char* fb1 = lds + R_F + wid * 256 + 16 * hi;
    asm volatile("s_waitcnt vmcnt(0)" ::: "memory");
    asm volatile("" : "+v"(qr[0]), "+v"(qr[1]), "+v"(qr[2]), "+v"(qr[3]), "+v"(fqp));
    asm volatile("s_waitcnt lgkmcnt(0)\n\ts_barrier" ::: "memory");
#define AP3_VFL(buf, ks, SLV) do { _Pragma("unroll") for (int d = 0; d < NDB; ++d) { buf[2 * d] = vtr(vb1 + (SLV) * VS + d * 4096 + (ks) * 1024); buf[2 * d + 1] = vtr(vb1 + (SLV) * VS + d * 4096 + (ks) * 1024 + 512); } } while (0)
#define AP3_VFL1(buf, d, ks, SLV) do { buf[2 * (d)] = vtr(vb1 + (SLV) * VS + (d) * 4096 + (ks) * 1024); buf[2 * (d) + 1] = vtr(vb1 + (SLV) * VS + (d) * 4096 + (ks) * 1024 + 512); } while (0)
#define AP3_FRAG(buf, d) ((bf16x8){buf[2 * (d)][0], buf[2 * (d)][1], buf[2 * (d)][2], buf[2 * (d)][3], buf[2 * (d) + 1][0], buf[2 * (d) + 1][1], buf[2 * (d) + 1][2], buf[2 * (d) + 1][3]})
#define AP3_GAP(ks, d, VCUR, VNXT, PC, BC, PP, BP, HASPREV, HASNEXT, SLV) do { \
        o[d] = __builtin_amdgcn_mfma_f32_32x32x16_bf16(__builtin_bit_cast(bf16x8, pwv[ks]), AP3_FRAG(VCUR, d), o[d], 0, 0, 0); \
        if (HASNEXT) AP3_VFL1(VNXT, d, (ks) + 1, SLV); \
        _Pragma("unroll") for (int e = 0; e < EPG; ++e) { PC[(BC) + EPG * (d) + e] = __builtin_amdgcn_exp2f(PC[(BC) + EPG * (d) + e]); } \
        if (HASPREV) { _Pragma("unroll") for (int e = 0; e < EPG; ++e) rs += PP[(BP) + EPG * (d) + e]; \
            _Pragma("unroll") for (int e = 0; e < EPG / 2; ++e) pwv[(ks) - 1][(EPG / 2) * (d) + e] = cvtpk_(PP[(BP) + EPG * (d) + 2 * e], PP[(BP) + EPG * (d) + 2 * e + 1]); AP3_PIN(rs); } \
        AP3_PIN(PC); \
        __builtin_amdgcn_sched_barrier(0); } while (0)
#define AP3_GROUP(ks, VCUR, VNXT, PC, BC, PP, BP, HASPREV, HASNEXT, SLV) do { _Pragma("unroll") for (int d = 0; d < NDB; ++d) AP3_GAP(ks, d, VCUR, VNXT, PC, BC, PP, BP, HASPREV, HASNEXT, SLV); } while (0)
#define AP3_OCT(PC, BC, KS) do { _Pragma("unroll") for (int e = 0; e < 8; ++e) { PC[(BC) + e] = __builtin_amdgcn_exp2f(PC[(BC) + e]); rs += PC[(BC) + e]; } \
        _Pragma("unroll") for (int e = 0; e < 4; ++e) pwv[KS][e] = cvtpk_(PC[(BC) + 2 * e], PC[(BC) + 2 * e + 1]); } while (0)
#define AP3_KRD(i, SL) (*(const LAS bf16x8*)(kb4[(i) >> 1] + (SL) * 8192 + ((i) & 1) * 4096))
#define AP3_MM(KF, d0, P) P = __builtin_amdgcn_mfma_f32_32x32x16_bf16(KF, qr[d0], P, 0, 0, 0)
#define AP3_QKF(SL) do { bf16x8 ka = AP3_KRD(0, SL), kb = AP3_KRD(1, SL), kc = AP3_KRD(2, SL); \
        if (MODE == 0) { \
            _Pragma("unroll") for (int g4 = 0; g4 < 4; ++g4) { const f32x4 fa = *(const LAS f32x4*)(fb1 + (SL) * 2048 + 32 * g4), fb = *(const LAS f32x4*)(fb1 + (SL) * 2048 + 128 + 32 * g4); \
                _Pragma("unroll") for (int e = 0; e < 4; ++e) { p0[4 * g4 + e] = fqp - fa[e]; p1[4 * g4 + e] = fqp - fb[e]; } } \
        } else { p0 = f32x16{}; p1 = f32x16{}; } \
        __builtin_amdgcn_sched_barrier(0); \
        AP3_MM(ka, 0, p0); ka = AP3_KRD(3, SL); __builtin_amdgcn_sched_barrier(0); \
        AP3_MM(kb, 0, p1); kb = AP3_KRD(4, SL); __builtin_amdgcn_sched_barrier(0); \
        AP3_MM(kc, 1, p0); kc = AP3_KRD(5, SL); __builtin_amdgcn_sched_barrier(0); \
        AP3_MM(ka, 1, p1); ka = AP3_KRD(6, SL); __builtin_amdgcn_sched_barrier(0); \
        AP3_MM(kb, 2, p0); kb = AP3_KRD(7, SL); __builtin_amdgcn_sched_barrier(0); \
        AP3_MM(kc, 2, p1); __builtin_amdgcn_sched_barrier(0); \
        AP3_MM(ka, 3, p0); __builtin_amdgcn_sched_barrier(0); \
        AP3_MM(kb, 3, p1); \
        asm volatile("" : "+v"(p0), "+v"(p1)); \
    } while (0)
#define AP3_QKS(SL) do { bf16x8 kf[8]; \
        _Pragma("unroll") for (int d0 = 0; d0 < 4; ++d0) { kf[2 * d0] = *(const LAS bf16x8*)(kb4[d0] + (SL) * 8192); kf[2 * d0 + 1] = *(const LAS bf16x8*)(kb4[d0] + (SL) * 8192 + 4096); } \
        if (MODE == 0) { const float sft = fqp - m_hat; \
            _Pragma("unroll") for (int g4 = 0; g4 < 4; ++g4) { const f32x4 fa = *(const LAS f32x4*)(fb1 + (SL) * 2048 + 32 * g4), fb = *(const LAS f32x4*)(fb1 + (SL) * 2048 + 128 + 32 * g4); \
                _Pragma("unroll") for (int e = 0; e < 4; ++e) { p0[4 * g4 + e] = sft - fa[e]; p1[4 * g4 + e] = sft - fb[e]; } } \
            _Pragma("unroll") for (int d0 = 0; d0 < 4; ++d0) { p0 = __builtin_amdgcn_mfma_f32_32x32x16_bf16(kf[2 * d0], qr[d0], p0, 0, 0, 0); p1 = __builtin_amdgcn_mfma_f32_32x32x16_bf16(kf[2 * d0 + 1], qr[d0], p1, 0, 0, 0); } \
        } else { \
            if constexpr (SREF) { p0 = __builtin_amdgcn_mfma_f32_32x32x16_bf16(kf[0], qr[0], f32x16{}, 0, 0, 0); p1 = __builtin_amdgcn_mfma_f32_32x32x16_bf16(kf[1], qr[0], f32x16{}, 0, 0, 0); } \
            else { p0 = __builtin_amdgcn_mfma_f32_32x32x16_bf16(kf[0], qr[0], negm, 0, 0, 0); p1 = __builtin_amdgcn_mfma_f32_32x32x16_bf16(kf[1], qr[0], negm, 0, 0, 0); } \
            _Pragma("unroll") for (int d0 = 1; d0 < 4; ++d0) { p0 = __builtin_amdgcn_mfma_f32_32x32x16_bf16(kf[2 * d0], qr[d0], p0, 0, 0, 0); p1 = __builtin_amdgcn_mfma_f32_32x32x16_bf16(kf[2 * d0 + 1], qr[d0], p1, 0, 0, 0); } } \
        if constexpr (SREF) asm volatile("" : "+v"(p0), "+v"(p1)); else asm volatile("s_nop 15\n\ts_nop 7" : "+v"(p0), "+v"(p1));     \
    } while (0)
#define AP3_QK(SL) do { if constexpr (SREF) AP3_QKF(SL); else AP3_QKS(SL); } while (0)
#define AP3_DECIDE(WITH_TAB) do { \
        if (MODE == 0) { \
            if (t * 64 + 63 > q0 + wid * 32) { const int ln_ = lane_id_opaque(), kv0 = t * 64 + 4 * (ln_ >> 5), qrow_ = q0 + wid * 32 + (ln_ & 31);     \
                _Pragma("unroll") for (int r = 0; r < 16; ++r) { const int kv = kv0 + (r & 3) + 8 * (r >> 2); if (kv > qrow_) p0[r] = -1e30f; if (kv + 32 > qrow_) p1[r] = -1e30f; } } \
        } else if (WITH_TAB) { \
            if (near) { const int ln_ = lane_id_opaque(), kv0 = t * 64 + 4 * (ln_ >> 5), qrow_ = q0 + wid * 32 + (ln_ & 31); const LAS float* tab_ = (const LAS float*)(F.lds + AT_TAB) + hb * 192; \
                _Pragma("unroll") for (int g4 = 0; g4 < 4; ++g4) { \
                    _Pragma("unroll") for (int e = 0; e < 4; ++e) { const int r = 4 * g4 + e; const int rel = kv0 + e + 8 * g4 - qrow_; int i0 = rel + 128, i1 = rel + 160; i0 = i0 < 0 ? 0 : i0; i1 = i1 < 0 ? 0 : i1; \
                        p0[r] += tab_[i0]; p1[r] += tab_[i1]; } \
                    __builtin_amdgcn_sched_barrier(0); } } } \
        if constexpr (!SREF) { \
        float ma = max3f_(p0[0], p0[1], p1[0]), mb = max3f_(p0[2], p0[3], p1[1]); ma = max3f_(ma, p1[2], p1[3]); \
        _Pragma("unroll") for (int r = 4; r < 16; r += 4) { ma = max3f_(ma, p0[r], p0[r + 1]); mb = max3f_(mb, p0[r + 2], p0[r + 3]); ma = max3f_(ma, p1[r], p1[r + 1]); mb = max3f_(mb, p1[r + 2], p1[r + 3]); } \
        float rm = max2f_(ma, mb); \
        { auto rr = __builtin_amdgcn_permlane32_swap(__float_as_uint(rm), __float_as_uint(rm), false, false); rm = max2f_(__uint_as_float(rr[0]), __uint_as_float(rr[1])); } \
        resc = (tz == t0) || __any(rm > THR); \
        if (resc) { const float dl = tz == t0 ? rm : fmaxf(rm, 0.f); m_hat += dl; \
            _Pragma("unroll") for (int r = 0; r < 16; ++r) { p0[r] -= dl; p1[r] -= dl; } \
            if (MODE == 1) { const float nm_ = -m_hat; _Pragma("unroll") for (int r = 0; r < 16; ++r) negm[r] = nm_; } \
            al = tz == t0 ? 1.0f : __builtin_amdgcn_exp2f(-dl); l_run *= al; } } } while (0)
#define AP3_STEP(tt, SL) do { const int t = (tt); if (t > NT) break; int tz = t; asm volatile("" : "+s"(tz)); \
        if (t < NT) AP_BATCH(t, SL); \
        const bool doPV = tz > t0 && t - 1 <= tmaxw, doQK = t < NT && t <= tmaxw; \
        bool resc = false; float al = 1.0f, rs = 0.f; \
        const bool near = MODE == 1 && (t * 64 + 63 + 91 > q0 + wid * 32); \
        if (doQK) AP3_QK(SL); else { p0 = f32x16{}; p1 = f32x16{}; }     \
        __builtin_amdgcn_sched_barrier(0); \
        if (doQK) AP3_DECIDE(true); \
        __builtin_amdgcn_sched_barrier(0); \
        if (doPV) { s16x4 vfa[2 * NDB]; AP3_VFL(vfa, 0, ((SL) + 2) % 3);     \
            AP3_GROUP(0, vfa, vfa, p0, 0, p0, 0, false, true, ((SL) + 2) % 3); \
            AP3_GROUP(1, vfa, vfa, p0, 8, p0, 0, true, true, ((SL) + 2) % 3); \
            AP3_GROUP(2, vfa, vfa, p1, 0, p0, 8, true, true, ((SL) + 2) % 3); \
            AP3_GROUP(3, vfa, vfa, p1, 8, p1, 0, true, false, ((SL) + 2) % 3); \
            _Pragma("unroll") for (int e = 0; e < 8; ++e) rs += p1[8 + e]; \
            _Pragma("unroll") for (int e = 0; e < 4; ++e) pwv[3][e] = cvtpk_(p1[8 + 2 * e], p1[8 + 2 * e + 1]); \
        } else if (doQK) { AP3_OCT(p0, 0, 0); AP3_OCT(p0, 8, 1); AP3_OCT(p1, 0, 2); AP3_OCT(p1, 8, 3); } \
        if (doQK) l_run += rs; \
          \
        if (resc && tz > t0) { \
            if (hi == 0) wsf[r32] = al; \
            asm volatile("s_waitcnt lgkmcnt(0)" ::: "memory"); \
            _Pragma("unroll") for (int g4 = 0; g4 < 4; ++g4) { const f32x4 a4 = *(const LAS f32x4*)(wsf + 8 * g4 + 4 * hi); \
                _Pragma("unroll") for (int d = 0; d < NDB; ++d) \
                    _Pragma("unroll") for (int e = 0; e < 4; ++e) o[d][4 * g4 + e] *= a4[e]; } } \
        if (t == NT) break; \
        if (pv == 6) { if (t + 2 < NT) asm volatile("s_waitcnt vmcnt(3) lgkmcnt(0)" ::: "memory"); else asm volatile("s_waitcnt vmcnt(0) lgkmcnt(0)" ::: "memory"); } \
        else { if (t + 2 < NT) asm volatile("s_waitcnt vmcnt(3) lgkmcnt(0)\n\ts_barrier" ::: "memory"); else asm volatile("s_waitcnt vmcnt(0) lgkmcnt(0)\n\ts_barrier" ::: "memory"); } \
    } while (0)
#define AP3_FSTEP(tt, SL) do { const int t = (tt); \
        AP_ISSUE_K(t + 2, ((SL) + 2) % 3); AP_ISSUE_V(t + 1, ((SL) + 1) % 3); \
        float rs = 0.f; \
        AP3_QKF(SL); \
        __builtin_amdgcn_sched_barrier(0); \
        { s16x4 vfa[2 * NDB]; AP3_VFL(vfa, 0, ((SL) + 2) % 3); \
          AP3_GROUP(0, vfa, vfa, p0, 0, p0, 0, false, true, ((SL) + 2) % 3); \
          AP3_GROUP(1, vfa, vfa, p0, 8, p0, 0, true, true, ((SL) + 2) % 3); \
          AP3_GROUP(2, vfa, vfa, p1, 0, p0, 8, true, true, ((SL) + 2) % 3); \
          AP3_GROUP(3, vfa, vfa, p1, 8, p1, 0, true, false, ((SL) + 2) % 3); \
          _Pragma("unroll") for (int e = 0; e < 8; ++e) rs += p1[8 + e]; \
          _Pragma("unroll") for (int e = 0; e < 4; ++e) pwv[3][e] = cvtpk_(p1[8 + 2 * e], p1[8 + 2 * e + 1]); } \
        l_run += rs; \
        asm volatile("s_waitcnt vmcnt(3) lgkmcnt(0)\n\ts_barrier" ::: "memory"); \
    } while (0)
    if (wid >= 4) __builtin_amdgcn_s_setprio(1);
    int t3 = t0;
    if constexpr (SREF && pv == 0) {
        AP3_STEP(t3, 0); AP3_STEP(t3 + 1, 1); AP3_STEP(t3 + 2, 2); t3 += 3;
        const int tfe = (q0 >> 6) - (MODE == 0 ? 1 : 3);
        for (; t3 + 2 <= tfe; t3 += 3) { AP3_FSTEP(t3, 0); AP3_FSTEP(t3 + 1, 1); AP3_FSTEP(t3 + 2, 2); }
    }
    for (; t3 <= NT; t3 += 3) { AP3_STEP(t3, 0); AP3_STEP(t3 + 1, 1); AP3_STEP(t3 + 2, 2); }
    if (wid >= 4) __builtin_amdgcn_s_setprio(0);
    asm volatile("s_waitcnt lgkmcnt(0)\n\ts_barrier" ::: "memory");
    l_run += __shfl_xor(l_run, 32);
    if (hi == 0) wsf[r32] = 1.0f / l_run;
    asm volatile("s_waitcnt lgkmcnt(0)" ::: "memory");
#pragma unroll
    for (int g4 = 0; g4 < 4; ++g4) { const f32x4 a4 = *(const LAS f32x4*)(wsf + 8 * g4 + 4 * hi);
#pragma unroll
        for (int d = 0; d < NDB; ++d)
#pragma unroll
            for (int e = 0; e < 4; ++e) o[d][4 * g4 + e] *= a4[e]; }
#undef AP_ISSUE_K
#undef AP_ISSUE_V
#undef AP_BATCH
#undef AP3_VFL
#undef AP3_VFL1
#undef AP3_FRAG
#undef AP3_GAP
#undef AP3_GROUP
#undef AP3_OCT
#undef AP3_STEP
#undef AP3_FSTEP
#undef AP3_QK
#undef AP3_QKF
#undef AP3_QKS
#undef AP3_KRD
#undef AP3_MM
#undef AP3_DECIDE
}

template <int NDB> __device__ __forceinline__ void store_o(const f32x16 (&o)[NDB], LAS unsigned char* stgb  , bf16_t* dst  , int ld, int lane) {
    const int r32 = lane & 31, hi = lane >> 5;
    constexpr int DVC = 32 * NDB;
    LAS bf16_t* stg = (LAS bf16_t*)stgb;
#pragma unroll
    for (int d = 0; d < NDB; ++d)
#pragma unroll
        for (int r = 0; r < 16; ++r) { const int row = (r & 3) + 8 * (r >> 2) + 4 * hi; stg[row * DVC + 32 * d + r32] = (bf16_t)f2bf(o[d][r]); }
    asm volatile("s_waitcnt lgkmcnt(0)" ::: "memory");
    constexpr int CPR = DVC / 8;
#pragma unroll
    for (int i = 0; i < (32 * CPR) / 64; ++i) { const int c = i * 64 + lane, row = c / CPR, ch = c % CPR;
        const u32x4 v = *(const LAS u32x4*)(stg + row * DVC + ch * 8); *(u32x4*)(dst + (size_t)row * ld + ch * 8) = v; }
    asm volatile("s_waitcnt lgkmcnt(0)" ::: "memory");
}

__device__ __forceinline__ float lambda_full(Frame& F) {
    const int l = lane_id_opaque() & 63;
    const float a = wave_sum(F.in[I_LQ1][l] * F.in[I_LK1][l]), b = wave_sum(F.in[I_LQ2][l] * F.in[I_LK2][l]);
    return __expf(a) - __expf(b) + 0.2f;
}

template <int pv = 0> __device__ __forceinline__ void attn_prompt_fox(Frame& F, int h, int qb) {
    const bf16_t* Q = (const bf16_t*)(F.ws + WS_QB) + h * 64; const bf16_t* K = (const bf16_t*)(F.ws + WS_KB) + h * 64; const bf16_t* V = (const bf16_t*)(F.ws + WS_VB) + h * 64;
    f32x16 o[2];
    const float* Fh = (const float*)(F.ws + WS_FP) + (size_t)h * SEQ;
    int t0 = 0; bool fast;
    { const unsigned* nw = (const unsigned*)(F.ws + WS_CTL) + 256;
      const float qn2 = __uint_as_float(nw[h * 2]) + __uint_as_float(nw[h * 2 + 1]), kn2 = __uint_as_float(nw[16 + h * 2]) + __uint_as_float(nw[16 + h * 2 + 1]);
      const float B = sqrtf(qn2 * kn2) * 1.02f + 0.5f;
      const float thresh = -40.0f - 2.0f * B;
      fast = __builtin_amdgcn_readfirstlane(B <= 60.0f ? 1 : 0) != 0;
      volatile LAS int* cnt = (volatile LAS int*)(F.lds + AT_MISC + 32);
      __syncthreads();
      if (F.tid < 256) { const int t = F.tid; const bool sk = t < 4 * qb && (Fh[qb * 256] - Fh[64 * t + 63]) <= thresh;
          const int c = __popcll(__ballot(sk)); if (F.lane == 0) cnt[F.wave] = c; }
      __syncthreads();
      t0 = cnt[0] + cnt[1] + cnt[2] + cnt[3]; t0 -= t0 % 3; }
    if (fast) attn_pass3<0, 64, pv, true>(F, Q, K, V, qb * 256, 4 * qb + 4, Fh, 0, o, t0); else attn_pass3<0, 64, pv, false>(F, Q, K, V, qb * 256, 4 * qb + 4, Fh, 0, o, t0);
    if (pv != 0 && o[0][0] != 1234.5678f) { __syncthreads(); return; }
    bf16_t* AB = (bf16_t*)(F.ws + WS_AB);
    store_o<2>(o, F.lds + F.wave * 8192, AB + (size_t)(qb * 256 + F.wave * 32) * DM + 512 + h * 64, DM, F.lane);
    __syncthreads();
}
template <int pv = 0> __device__ __forceinline__ void attn_prompt_diff_half(Frame& F, int h, int half, int qb) {
    const bf16_t* Q = (const bf16_t*)(F.ws + WS_QA) + h * 128 + 64 * half; const bf16_t* K = (const bf16_t*)(F.ws + WS_KA) + h * 128 + 64 * half; const bf16_t* V = (const bf16_t*)(F.ws + WS_VA) + h * 128;
    f32x16 o[4];
    bool fast;
    { const unsigned* nw = (const unsigned*)(F.ws + WS_CTL) + 288; const int hh = h * 2 + half;
      const float qn2 = __uint_as_float(nw[hh * 2]) + __uint_as_float(nw[hh * 2 + 1]), kn2 = __uint_as_float(nw[16 + hh * 2]) + __uint_as_float(nw[16 + hh * 2 + 1]);
      float bm = 0.f; for (int b = 0; b < 32; ++b) bm = fmaxf(bm, fabsf(F.in[I_RELB][b * 4 + h] - F.in[I_RELB][15 * 4 + h]));
      const float B = sqrtf(qn2 * kn2) * 1.02f + 0.5f + bm * LOG2E;
      fast = __builtin_amdgcn_readfirstlane(B <= 60.0f ? 1 : 0) != 0; }
    if (fast) attn_pass3<1, 128, pv, true>(F, Q, K, V, qb * 256, 4 * qb + 4, nullptr, h, o); else attn_pass3<1, 128, pv, false>(F, Q, K, V, qb * 256, 4 * qb + 4, nullptr, h, o);
    if (pv != 0 && o[0][0] != 1234.5678f) { __syncthreads(); return; }
    bf16_t* OD = (bf16_t*)(F.ws + (half ? WS_OD2 : WS_OD1));
    store_o<4>(o, F.lds + F.wave * 8192, OD + (size_t)(qb * 256 + F.wave * 32) * 512 + h * 128, 512, F.lane);
    __syncthreads();
}
constexpr int PF_STR = 66, PD_STR = 130;
__device__ __forceinline__ void p_combine(Frame& F) {
    const float lam = lambda_full(F);
    const bf16_t* O1 = (const bf16_t*)(F.ws + WS_OD1); const bf16_t* O2 = (const bf16_t*)(F.ws + WS_OD2); bf16_t* AB = (bf16_t*)(F.ws + WS_AB);
    const int gw = F.bid * 8 + F.wave, NGW = F.G * 8;
    const int c0 = 8 * F.lane;
    float sg[8];
#pragma unroll
    for (int i = 0; i < 8; ++i) sg[i] = F.in[I_SUBG][(c0 & 127) + i] * 0.8f;
    for (int m0 = gw; m0 < SEQ; m0 += 4 * NGW) {
        u32x4 a[4], b[4];
#pragma unroll
        for (int r = 0; r < 4; ++r) { const int m = m0 + r * NGW; if (m < SEQ) { a[r] = *(const u32x4*)(O1 + (size_t)m * 512 + c0); b[r] = *(const u32x4*)(O2 + (size_t)m * 512 + c0); } else { a[r] = (u32x4){0u, 0u, 0u, 0u}; b[r] = a[r]; } }
#pragma unroll
        for (int r = 0; r < 4; ++r) { const int m = m0 + r * NGW;
            float v[8];
            v[0] = bflo(a[r].x) - lam * bflo(b[r].x); v[1] = bfhi(a[r].x) - lam * bfhi(b[r].x); v[2] = bflo(a[r].y) - lam * bflo(b[r].y); v[3] = bfhi(a[r].y) - lam * bfhi(b[r].y);
            v[4] = bflo(a[r].z) - lam * bflo(b[r].z); v[5] = bfhi(a[r].z) - lam * bfhi(b[r].z); v[6] = bflo(a[r].w) - lam * bflo(b[r].w); v[7] = bfhi(a[r].w) - lam * bfhi(b[r].w);
            float ss = 0.f;
#pragma unroll
            for (int i = 0; i < 8; ++i) ss += v[i] * v[i];
#pragma unroll
            for (int ofs = 1; ofs < 16; ofs <<= 1) ss += __shfl_xor(ss, ofs);
            const float rn = 1.0f / sqrtf(ss * (1.0f / 128.0f) + LN_EPS);
            u32x4 w; w.x = pk2(v[0] * rn * sg[0], v[1] * rn * sg[1]); w.y = pk2(v[2] * rn * sg[2], v[3] * rn * sg[3]); w.z = pk2(v[4] * rn * sg[4], v[5] * rn * sg[5]); w.w = pk2(v[6] * rn * sg[6], v[7] * rn * sg[7]);
            if (m < SEQ) *(u32x4*)(AB + (size_t)m * DM + c0) = w; }
    }
    for (int it = F.bid; it < NSMP; it += F.G) {
        const int b = it >> 4, q = it & 15; const size_t row = (size_t)SEQ + it;
        if (F.wave == 0) {
            const int h = F.lane >> 3, cc = (F.lane & 7) * 8; const float* P = (const float*)(F.ws + WS_PF);
            float M = -1e30f;
#pragma unroll
            for (int s = 0; s < 8; ++s) M = fmaxf(M, P[((size_t)((b * 8 + s) * 8 + h) * 16 + q) * PF_STR + 64]);
            float acc[8], L = 0.f;
#pragma unroll
            for (int i = 0; i < 8; ++i) acc[i] = 0.f;
#pragma unroll
            for (int s = 0; s < 8; ++s) { const float* pr = P + ((size_t)((b * 8 + s) * 8 + h) * 16 + q) * PF_STR; const float wgt = __builtin_amdgcn_exp2f(pr[64] - M); L += wgt * pr[65];
#pragma unroll
                for (int i = 0; i < 8; ++i) acc[i] += wgt * pr[cc + i]; }
            const float inv = 1.0f / L;
            u32x4 w; w.x = pk2(acc[0] * inv, acc[1] * inv); w.y = pk2(acc[2] * inv, acc[3] * inv); w.z = pk2(acc[4] * inv, acc[5] * inv); w.w = pk2(acc[6] * inv, acc[7] * inv);
            *(u32x4*)(AB + row * DM + 512 + c0) = w; }
        if (F.wave == 1) {
            const int h = F.lane >> 4, cc = (F.lane & 15) * 8; const float* P = (const float*)(F.ws + WS_PD);
            float v[8];
#pragma unroll
            for (int i = 0; i < 8; ++i) v[i] = 0.f;
#pragma unroll
            for (int half = 0; half < 2; ++half) {
                float M = -1e30f;
#pragma unroll
                for (int s = 0; s < 8; ++s) M = fmaxf(M, P[((size_t)((b * 8 + s) * 8 + 2 * h + half) * 16 + q) * PD_STR + 128]);
                float acc[8], L = 0.f;
#pragma unroll
                for (int i = 0; i < 8; ++i) acc[i] = 0.f;
#pragma unroll
                for (int s = 0; s < 8; ++s) { const float* pr = P + ((size_t)((b * 8 + s) * 8 + 2 * h + half) * 16 + q) * PD_STR; const float wgt = __builtin_amdgcn_exp2f(pr[128] - M); L += wgt * pr[129];
#pragma unroll
                    for (int i = 0; i < 8; ++i) acc[i] += wgt * pr[cc + i]; }
                const float sc = (half ? -lam : 1.0f) / L;
#pragma unroll
                for (int i = 0; i < 8; ++i) v[i] += acc[i] * sc; }
            float ss = 0.f;
#pragma unroll
            for (int i = 0; i < 8; ++i) ss += v[i] * v[i];
#pragma unroll
            for (int ofs = 1; ofs < 16; ofs <<= 1) ss += __shfl_xor(ss, ofs);
            const float rn = 1.0f / sqrtf(ss * (1.0f / 128.0f) + LN_EPS);
            u32x4 w; w.x = pk2(v[0] * rn * sg[0], v[1] * rn * sg[1]); w.y = pk2(v[2] * rn * sg[2], v[3] * rn * sg[3]); w.z = pk2(v[4] * rn * sg[4], v[5] * rn * sg[5]); w.w = pk2(v[6] * rn * sg[6], v[7] * rn * sg[7]);
            *(u32x4*)(AB + row * DM + c0) = w; }
    }
}

constexpr int SM_K = 0, SM_V = 32768, SM_F = 81920, SM_WS = 83968;
template <int KIND  > __device__ __forceinline__ void sample_unit(Frame& F, int b, int s) {
    constexpr int DV = KIND == 0 ? 64 : 128, NDB = DV / 32, VSTR = KIND == 0 ? 192 : 320, VSUB = 16 * VSTR;
    const int lane = lane_id_opaque(), r32 = lane & 31, hi = lane >> 5, w = F.wave, tid = w * 64 + lane;
    const LAS char* lds = (const LAS char*)F.lds;
    LAS float* wsf = (LAS float*)(F.lds + SM_WS) + w * 64;
    const int hb = KIND == 0 ? w : (w >> 1);
    const LAS float* tab = (const LAS float*)(F.lds + AT_TAB) + hb * 192;
    const int q = r32 & 15, qpos = PAST + q;
    const size_t qrow = (size_t)SEQ + b * DEC_T + q;
    const bf16_t* Qp = (const bf16_t*)(F.ws + (KIND == 0 ? WS_QB : WS_QA)) + qrow * 512 + w * 64;
    bf16x8 qr[4];
#pragma unroll
    for (int d0 = 0; d0 < 4; ++d0) qr[d0] = *(const bf16x8*)(Qp + d0 * 16 + hi * 8);
    const float* Fs = (const float*)(F.ws + WS_FS) + (size_t)(b * 8 + w) * SKV;
    const float fq = KIND == 0 ? Fs[qpos] : 0.f;
    const float* Kc = F.in[KIND == 0 ? I_CFK : I_CDK] + (size_t)b * PAST * 512; const float* Vc = F.in[KIND == 0 ? I_CFV : I_CDV] + (size_t)b * PAST * 512;
    const float* Kn = F.out + (KIND == 0 ? O_FKS : O_DKS) + (size_t)b * DEC_T * 512; const float* Vn = F.out + (KIND == 0 ? O_FVS : O_DVS) + (size_t)b * DEC_T * 512;
    const int kr = tid >> 5, c16 = (tid & 31) * 16;
    const int ksub = c16 >> 6, kch = (c16 >> 3) & 7;
    const int kdst = SM_K + ksub * 4096 + kr * 128;
    const int vdst = KIND == 0 ? SM_V + ksub * VSUB + kr * VSTR + kch * 16 : SM_V + (c16 >> 7) * VSUB + kr * VSTR + ((c16 >> 3) & 15) * 16;
    f32x16 o[NDB];
#pragma unroll
    for (int d = 0; d < NDB; ++d) o[d] = f32x16{};
    float m_run = -1e30f, l_run = 0.f;
    f32x4 gkA[4], gvA[4], gkB[4], gvB[4], gkC[4], gvC[4]; float gfA = 0.f, gfB = 0.f, gfC = 0.f;
    const int nt = s == 0 ? 17 : 16;
    auto gload = [&](f32x4 (&gk)[4], f32x4 (&gv)[4], float& gf, int t) {
        const float* ks; const float* vs;
        if (t < 128) { ks = Kc + (size_t)(16 * t + kr) * 512 + c16; vs = Vc + (size_t)(16 * t + kr) * 512 + c16; }
        else { ks = Kn + (size_t)kr * 512 + c16; vs = Vn + (size_t)kr * 512 + c16; }
#pragma unroll
        for (int j = 0; j < 4; ++j) { gk[j] = *(const f32x4*)(ks + 4 * j); gv[j] = *(const f32x4*)(vs + 4 * j); }
        if (KIND == 0 && tid < 128) gf = ((const float*)(F.ws + WS_FS))[(size_t)(b * 8 + (tid >> 4)) * SKV + 16 * t + (tid & 15)];
    };
    auto lwrite = [&](const f32x4 (&gk)[4], const f32x4 (&gv)[4], float gf) {
#pragma unroll
        for (int j = 0; j < 2; ++j) { u32x4 wk, wv;
            wk.x = pk2(gk[2 * j][0], gk[2 * j][1]); wk.y = pk2(gk[2 * j][2], gk[2 * j][3]); wk.z = pk2(gk[2 * j + 1][0], gk[2 * j + 1][1]); wk.w = pk2(gk[2 * j + 1][2], gk[2 * j + 1][3]);
            wv.x = pk2(gv[2 * j][0], gv[2 * j][1]); wv.y = pk2(gv[2 * j][2], gv[2 * j][3]); wv.z = pk2(gv[2 * j + 1][0], gv[2 * j + 1][1]); wv.w = pk2(gv[2 * j + 1][2], gv[2 * j + 1][3]);
            *(LAS u32x4*)(F.lds + kdst + (((kch + j) ^ (kr & 7)) << 4)) = wk;
            *(LAS u32x4*)(F.lds + vdst + j * 16) = wv; }
        if (KIND == 0 && tid < 128) ((LAS float*)(F.lds + SM_F))[tid] = gf;
    };
    gload(gkA, gvA, gfA, s); gload(gkB, gvB, gfB, s + 8); gload(gkC, gvC, gfC, s + 16);
    __syncthreads();
    { const int sub = tid >> 6, rr = 16 + ((tid >> 2) & 15), cq = (tid & 3) * 32;
      *(LAS u32x4*)(F.lds + SM_K + sub * 4096 + rr * 128 + cq) = (u32x4){0u, 0u, 0u, 0u}; *(LAS u32x4*)(F.lds + SM_K + sub * 4096 + rr * 128 + cq + 16) = (u32x4){0u, 0u, 0u, 0u}; }
    const int vb = SM_V + (KIND == 0 ? w : (w >> 1)) * VSUB + (4 * hi + ((lane & 15) >> 2)) * VSTR + (((lane >> 4) & 1) * 16 + (lane & 3) * 4) * 2;
    auto compute = [&](int t) {
        f32x16 p0 = f32x16{};
#pragma unroll
        for (int d0 = 0; d0 < 4; ++d0) { const bf16x8 kf = *(const LAS bf16x8*)(lds + SM_K + w * 4096 + r32 * 128 + (((2 * d0 + hi) ^ (r32 & 7)) << 4));
            p0 = __builtin_amdgcn_mfma_f32_32x32x16_bf16(kf, qr[d0], p0, 0, 0, 0); }
        const int kv0 = 16 * t + 4 * hi;
        float x[8];
        if (KIND == 0) {
#pragma unroll
            for (int g4 = 0; g4 < 2; ++g4) { const f32x4 fa = *(const LAS f32x4*)(lds + SM_F + (w * 16 + 4 * hi + 8 * g4) * 4);
#pragma unroll
                for (int e = 0; e < 4; ++e) x[4 * g4 + e] = p0[4 * g4 + e] + (fq - fa[e]); }
            if (t == 128) {
#pragma unroll
                for (int r = 0; r < 8; ++r) { const int kv = kv0 + (r & 3) + 8 * (r >> 2); if (kv > qpos) x[r] = -1e30f; } }
        } else {
            if (t < 120) {
#pragma unroll
                for (int r = 0; r < 8; ++r) x[r] = p0[r];
            } else {
#pragma unroll
                for (int r = 0; r < 8; ++r) { const int kv = kv0 + (r & 3) + 8 * (r >> 2); int i0 = kv - qpos + 128; i0 = i0 < 0 ? 0 : i0; x[r] = p0[r] + tab[i0]; } }
        }
        float rm = x[0];
#pragma unroll
        for (int r = 1; r < 8; ++r) rm = fmaxf(rm, x[r]);
        rm = fmaxf(rm, __shfl_xor(rm, 32));
        const float m_new = fmaxf(m_run, rm);
        if (__any(m_new > m_run)) { const float al = __builtin_amdgcn_exp2f(m_run - m_new); l_run *= al; m_run = m_new;
            if (hi == 0) wsf[r32] = al;
            asm volatile("s_waitcnt lgkmcnt(0)" ::: "memory");
#pragma unroll
            for (int g4 = 0; g4 < 2; ++g4) { const f32x4 a4 = *(const LAS f32x4*)(wsf + 8 * g4 + 4 * hi);
#pragma unroll
                for (int d = 0; d < NDB; ++d)
#pragma unroll
                    for (int e = 0; e < 4; ++e) o[d][4 * g4 + e] *= a4[e]; } }
        float rs = 0.f;
#pragma unroll
        for (int r = 0; r < 8; ++r) { x[r] = __builtin_amdgcn_exp2f(x[r] - m_run); rs += x[r]; }
        l_run += rs;
        u32x4 w0; w0.x = cvtpk_v(x[0], x[1]); w0.y = cvtpk_v(x[2], x[3]); w0.z = cvtpk_v(x[4], x[5]); w0.w = cvtpk_v(x[6], x[7]);
        const bf16x8 pa = __builtin_bit_cast(bf16x8, w0);
#pragma unroll
        for (int d = 0; d < NDB; ++d) { const LAS char* vp = lds + vb + d * 64;
            const s16x4 lo = vtr(vp), hi4 = vtr(vp + 8 * VSTR);
            const bf16x8 vf = (bf16x8){lo[0], lo[1], lo[2], lo[3], hi4[0], hi4[1], hi4[2], hi4[3]};
            o[d] = __builtin_amdgcn_mfma_f32_32x32x16_bf16(pa, vf, o[d], 0, 0, 0); }
    };
    for (int i = 0; i < nt; i += 3) {
        const int t = s + 8 * i;
        lwrite(gkA, gvA, gfA); __syncthreads();
        if (i + 3 < nt) gload(gkA, gvA, gfA, t + 24);
        compute(t);
        __syncthreads();
        if (i + 1 >= nt) break;
        lwrite(gkB, gvB, gfB); __syncthreads();
        if (i + 4 < nt) gload(gkB, gvB, gfB, t + 32);
        compute(t + 8);
        __syncthreads();
        if (i + 2 >= nt) break;
        lwrite(gkC, gvC, gfC); __syncthreads();
        if (i + 5 < nt) gload(gkC, gvC, gfC, t + 40);
        compute(t + 16);
        __syncthreads();
    }
    l_run += __shfl_xor(l_run, 32);
    float* P = (float*)(F.ws + (KIND == 0 ? WS_PF : WS_PD)) + ((size_t)((b * 8 + s) * 8 + w) * 16) * (DV + 2);
    { float* P0 = P + (size_t)(4 * hi) * (DV + 2) + r32; float* P1 = P0 + 8 * (DV + 2);
#pragma unroll
      for (int d = 0; d < NDB; ++d)
#pragma unroll
          for (int r = 0; r < 4; ++r) { P0[r * (DV + 2) + 32 * d] = o[d][r]; P1[r * (DV + 2) + 32 * d] = o[d][4 + r]; } }
    if (lane < 16) { P[(size_t)lane * (DV + 2) + DV] = m_run; P[(size_t)lane * (DV + 2) + DV + 1] = l_run; }
}

template <int pv = 0> __device__ __forceinline__ void p3_attention(Frame& F, int mask) {
    LAS float* tab = (LAS float*)(F.lds + AT_TAB);
    for (int i = F.tid; i < 4 * 192; i += 512) { const int h = i / 192, rel = (i % 192) - 128; tab[i] = (F.in[I_RELB][t5_bucket(rel) * 4 + h] - F.in[I_RELB][15 * 4 + h]) * LOG2E; }
    __syncthreads();
    const int x = F.bid & 7, p = (F.bid >> 3) & 31;
    const int spos = F.G == 256 ? (x + p) % 5 : 4;
    for (int j = 0; j < 5; ++j) {
        F.lane = lane_id_opaque(); F.tid = F.wave * 64 + F.lane;
        if (j == spos) {
            if (mask & 4) {
                for (int u = F.bid; u < 256; u += F.G) {
                    F.lane = lane_id_opaque(); F.tid = F.wave * 64 + F.lane;
                    if ((u >> 3) & 1) sample_unit<1>(F, u >> 4, u & 7); else sample_unit<0>(F, u >> 4, u & 7);
                }
            }
        } else if (F.bid < 256) {
            const int i = j - (j > spos ? 1 : 0);
            const int qb = (i & 1) ? p : 63 - p;
            if (i < 2) { if (mask & 1) attn_prompt_diff_half<pv>(F, x >> 1, x & 1, qb); }
            else { if (mask & 2) attn_prompt_fox<pv>(F, x, qb); }
        }
    }
}

__device__ __forceinline__ void slab_publish(Frame& F, int word, int nun) {
    int n = 0; for (int L = F.bid; L < nun; L += F.G) ++n;
    asm volatile("s_waitcnt vmcnt(0)" ::: "memory");
    __syncthreads();
    if (F.tid == 0 && n > 0) { __builtin_amdgcn_fence(__ATOMIC_RELEASE, "agent"); asm volatile("s_waitcnt vmcnt(0)" ::: "memory");
        __hip_atomic_fetch_add((unsigned*)(F.ws + WS_CTL) + word, (unsigned)n, __ATOMIC_RELAXED, __HIP_MEMORY_SCOPE_AGENT); }
}
__device__ __forceinline__ void slab_wait(Frame& F, int word, int nun) {
    if (F.tid == 0) { unsigned* w = (unsigned*)(F.ws + WS_CTL) + word; unsigned sp = 0;
        while (__hip_atomic_load(w, __ATOMIC_RELAXED, __HIP_MEMORY_SCOPE_AGENT) < (unsigned)nun && ++sp < (1u << 22)) __builtin_amdgcn_s_sleep(2);
        __builtin_amdgcn_fence(__ATOMIC_ACQUIRE, "agent"); asm volatile("s_waitcnt vmcnt(0)" ::: "memory"); }
    __syncthreads();
}

#define XB_TMO      128
#define XB_XCNT(j)  (256  + 64 * (j))
#define XB_XSUB(j)  (1280 + 64 * (j))
#define XB_XGEN(j)  (2304 + 64 * (j))
#define XB_TOP      3328
#define XB_TOPGEN   3392
#define XCD_BAR_WORDS 3456
#define XB_SPIN_CAP (1u << 20)
__device__ __forceinline__ unsigned xb_ld(unsigned* p)              { return __hip_atomic_load(p, __ATOMIC_RELAXED, __HIP_MEMORY_SCOPE_AGENT); }
__device__ __forceinline__ unsigned xb_add(unsigned* p, unsigned v) { return __hip_atomic_fetch_add(p, v, __ATOMIC_RELAXED, __HIP_MEMORY_SCOPE_AGENT); }
__device__ __forceinline__ unsigned xb_xcc_id() { return (unsigned)__builtin_amdgcn_s_getreg((3 << 11) | 20) & 0xFu; }
#define XB_SPIN(cond, bar) do { unsigned _sp = 0; while (cond) { __builtin_amdgcn_s_sleep(1); \
    if ((++_sp & 255u) == 0u) { if (xb_ld(&(bar)[XB_TMO])) break; if (_sp > XB_SPIN_CAP) { atomicAdd(&(bar)[XB_TMO], 1u); break; } } } } while (0)
struct XcdBarrier { unsigned* bar; unsigned x; volatile LAS unsigned* st; };
__device__ __forceinline__ XcdBarrier xcd_barrier_post(unsigned* bar, volatile LAS unsigned* st) {
    XcdBarrier b; b.bar = bar; b.x = xb_xcc_id(); b.st = st;
    if (threadIdx.x == 0) (void)xb_add(&bar[XB_XCNT(b.x)], 1u);
    return b;
}
__device__ __forceinline__ void xcd_barrier_complete(unsigned* bar, unsigned x, unsigned& nloc, unsigned& nx) {
    const unsigned G = gridDim.x * gridDim.y * gridDim.z;
    unsigned sum, cnt, mine, sp = 0u;
    for (;;) {
        sum = 0u; cnt = 0u; mine = 0u;
#pragma unroll
        for (unsigned j = 0; j < 16; ++j) { const unsigned c = xb_ld(&bar[XB_XCNT(j)]); sum += c; cnt += (c > 0u) ? 1u : 0u; mine = (j == x) ? c : mine; }
        if (sum == G) break;
        __builtin_amdgcn_s_sleep(1);
        if ((++sp & 255u) == 0u) { if (xb_ld(&bar[XB_TMO])) break; if (sp > XB_SPIN_CAP) { atomicAdd(&bar[XB_TMO], 1u); break; } }
    }
    nloc = mine > 0u ? mine : 1u; nx = cnt > 0u ? cnt : 1u;
}
__device__ __forceinline__ void xcd_barrier(const XcdBarrier& b) {
    asm volatile("s_waitcnt vmcnt(0)" ::: "memory");
    __syncthreads();
    if (threadIdx.x == 0) {
        unsigned* bar = b.bar;
        __builtin_amdgcn_s_waitcnt(0);
        unsigned nloc = b.st[0], nx = b.st[1];
        if (nloc == 0u) { xcd_barrier_complete(bar, b.x, nloc, nx); b.st[0] = nloc; b.st[1] = nx; }
        const unsigned old = xb_add(&bar[XB_XSUB(b.x)], 1u);
        const unsigned gen = old / nloc;
        if (old + 1u == (gen + 1u) * nloc) {
            __builtin_amdgcn_fence(__ATOMIC_RELEASE, "agent");
            asm volatile("s_waitcnt vmcnt(0)" ::: "memory");
            const unsigned og = xb_add(&bar[XB_TOP], 1u);
            const unsigned tg = og / nx;
            if (og + 1u == (tg + 1u) * nx) xb_add(&bar[XB_TOPGEN], 1u);
            else XB_SPIN(xb_ld(&bar[XB_TOPGEN]) == tg, bar);
            __builtin_amdgcn_fence(__ATOMIC_ACQUIRE, "agent");
            xb_add(&bar[XB_XGEN(b.x)], 1u);
            asm volatile("s_waitcnt vmcnt(0)" ::: "memory");
        } else {
            XB_SPIN(xb_ld(&bar[XB_XGEN(b.x)]) == gen, bar);
            __builtin_amdgcn_fence(__ATOMIC_ACQUIRE, "agent");
            asm volatile("s_waitcnt vmcnt(0)" ::: "memory");
        }
    }
    __syncthreads();
}

__global__ void __launch_bounds__(512, 2) mega_fwd(Args args) {
    extern __shared__ __attribute__((aligned(16))) unsigned char lds_raw[];
    Frame F;
    F.lds = (LAS unsigned char*)lds_raw; F.ldsg = lds_raw;
    F.tid = threadIdx.x; F.lane = F.tid & 63; F.wave = __builtin_amdgcn_readfirstlane(F.tid >> 6);
    F.G = gridDim.x; F.bid = blockIdx.x;
    F.in = args.in; F.out = args.out; F.ws = args.ws;
    const int lo = args.ph_lo, hi = args.ph_hi;
    cg::grid_group grid = cg::this_grid();
    const bool fused = (hi - lo) > 1;
    volatile LAS unsigned* bst = (volatile LAS unsigned*)(F.lds + AT_MISC + 16);
    if (F.tid == 0) { bst[0] = 0u; bst[1] = 0u; }
    __syncthreads();
    XcdBarrier xbar; xbar.bar = (unsigned*)(F.ws + WS_CTL) + 1024; xbar.x = 0; xbar.st = bst;
    if (fused) xbar = xcd_barrier_post((unsigned*)(F.ws + WS_CTL) + 1024, bst);
#define IN(k) (lo <= (k) && (k) < hi)
#define PB() do { F.lane = lane_id_opaque(); F.tid = F.wave * 64 + F.lane; } while (0)
#define SEAM(k) do { if (IN(k) && IN((k) + 1)) { xcd_barrier(xbar); } } while (0)
    const float* mod = (const float*)(F.ws + WS_MOD);
    if (IN(0)) { PB(); p0_prologue(F); }
    if (IN(0) && IN(1)) __syncthreads(); else SEAM(0);
    if (IN(1)) { PB(); p1_rows(F, IN(0)); } SEAM(1);
    if (IN(2)) { PB();
        p2_cumsum(F);
        __syncthreads();
        pg8::Gemm g{(const bf16_t*)(F.ws + WS_XN), (const bf16_t*)(F.ws + WS_WIN), 1024, 1024, 1024, 1 << 30, 0, 0};
        pg8::StaticOrder S; S.init(MT / 256, NZ / 256, F.G, F.bid, 0);
        EpiZ E{F.out, F.ws};
        pg8::gemm_phase<EpiZ, pg8::StaticOrder>(F.lds, g, S, E, F.wave);
#if PROBE_DUP == 2
        pg8::gemm_phase<EpiZ, pg8::StaticOrder>(F.lds, g, S, E, F.wave);
#endif
        { const int nun = (MT / 256) * (NZ / 256), nlong = nun - (nun / F.G) * F.G;
          if (nlong > 0 && nlong < F.G) { if (F.bid >= nlong) { PB(); weight_copies(F, F.bid - nlong, F.G - nlong, WC_IN, WC_ALL); } }
          else { PB(); weight_copies(F, F.bid, F.G, WC_IN, WC_ALL); } }
    } SEAM(2);
    if (IN(3)) { PB(); p3_attention(F, 7);
#if PROBE_DUP == 3
        p3_attention<PROBE_PV>(F, PROBE_MASK);
#endif
    } SEAM(3);
    if (IN(10)) { PB(); p_combine(F);
#if PROBE_DUP == 10
        p_combine(F);
#endif
    } if (IN(10) && IN(4)) xcd_barrier(xbar);
    if (IN(4)) { PB();
        pg8::Gemm g{(const bf16_t*)(F.ws + WS_AB), (const bf16_t*)(F.ws + WS_WAB), 1024, 512, 512, 4, 512, 0};
        pg8::StaticOrder S; S.init(MT / 256, 8, F.G, F.bid, 0);
        EpiGate E{(bf16_t*)(F.ws + WS_G), (bf16_t*)(F.ws + WS_G)};
#if PROBE_DUP == 4
        { EpiGate E2{(bf16_t*)(F.ws + WS_G), (bf16_t*)(F.ws + WS_QA)}; pg8::gemm_phase<EpiGate, pg8::StaticOrder>(F.lds, g, S, E2, F.wave); }
#endif
        pg8::gemm_phase<EpiGate, pg8::StaticOrder>(F.lds, g, S, E, F.wave);
    } SEAM(4);
    if (IN(5)) { PB();
        { pg8::Gemm g2{(const bf16_t*)(F.ws + WS_G), (const bf16_t*)(F.ws + WS_WO2), 2048, 2048, 256, 1 << 30, 0, 256};
          pg8::SplitOrder S2; S2.init(4, 8, F.G, F.bid, SEQ / 256); EpiSlab E2{(float*)(F.ws + WS_SLAB)};
          pg8::gemm_phase<EpiSlab, pg8::SplitOrder>(F.lds, g2, S2, E2, F.wave); slab_publish(F, 322, 32); }
        pg8::Gemm g{(const bf16_t*)(F.ws + WS_G), (const bf16_t*)(F.ws + WS_WO2), 2048, 2048, 2048, 1 << 30, 0, 0};
        pg8::StaticOrder S; S.init(SEQ / 256, 4, F.G, F.bid, 0);
        EpiResLn<false> E{(const void*)F.in[I_XP], mod + 2048, F.in[I_LN1G], F.in[I_LN1B], mod, (bf16_t*)(F.ws + WS_X1B), (bf16_t*)(F.ws + WS_XN), nullptr,
                          PanelStats{(unsigned*)(F.ws + WS_XB1), (unsigned*)(F.ws + WS_CTL) + CTL_LN1, LN_EPS}, F.lds};
        pg8::gemm_phase<EpiResLn<false>, pg8::StaticOrder>(F.lds, g, S, E, F.wave);
        PB(); slab_wait(F, 322, 32); ln_rows<false>(F, F.in[I_LN1G], F.in[I_LN1B], 8, 2048);
    } if (IN(5) && IN(7)) xcd_barrier(xbar);

    if (IN(7)) { PB();
        pg8::Gemm g{(const bf16_t*)(F.ws + WS_XN), (const bf16_t*)(F.ws + WS_WFI), 1024, 1024, 1024, 1 << 30, 0, 0};
        pg8::StaticOrder S; S.init(MT / 256, NFF2 / 256, F.G, F.bid, 0);
        EpiFfn E{(bf16_t*)(F.ws + WS_ACT)};
        pg8::gemm_phase<EpiFfn, pg8::StaticOrder>(F.lds, g, S, E, F.wave);
#if PROBE_DUP == 7
        pg8::gemm_phase<EpiFfn, pg8::StaticOrder>(F.lds, g, S, E, F.wave);
#endif
    } SEAM(7);
    if (IN(8)) { PB();
        { pg8::Gemm g2{(const bf16_t*)(F.ws + WS_ACT), (const bf16_t*)(F.ws + WS_WFO), DFF, DFF, 256, 1 << 30, 0, 256};
          pg8::SplitOrder S2; S2.init(4, 11, F.G, F.bid, SEQ / 256); EpiSlab E2{(float*)(F.ws + WS_SLAB)};
          pg8::gemm_phase<EpiSlab, pg8::SplitOrder>(F.lds, g2, S2, E2, F.wave); slab_publish(F, 323, 44); }
        pg8::Gemm g{(const bf16_t*)(F.ws + WS_ACT), (const bf16_t*)(F.ws + WS_WFO), DFF, DFF, DFF, 1 << 30, 0, 0};
        pg8::StaticOrder S; S.init(SEQ / 256, 4, F.G, F.bid, 0);
        EpiResLn<true> E{(const void*)(F.ws + WS_X1B), mod + 5120, F.in[I_LN2G], F.in[I_LN2B], mod, nullptr, nullptr, F.out,
                         PanelStats{(unsigned*)(F.ws + WS_XB2), (unsigned*)(F.ws + WS_CTL) + CTL_LN2, LN_EPS}, F.lds};
        pg8::gemm_phase<EpiResLn<true>, pg8::StaticOrder>(F.lds, g, S, E, F.wave);
        PB(); slab_wait(F, 323, 44); ln_rows<true>(F, F.in[I_LN2G], F.in[I_LN2B], 11, 5120);
    }
#undef IN
#undef SEAM
}

extern "C" void kernel_launch(void* const* d_in, const int* in_sizes, int n_in, void* d_out, int out_size, void* d_ws, size_t ws_size, hipStream_t stream) {
    static int grid = 0;
    if (grid == 0) {
        if (n_in != 28 || (size_t)out_size != O_END || ws_size < WS_END) { fprintf(stderr, "kernel_launch: unexpected shapes (n_in %d out %d ws %zu)\n", n_in, out_size, ws_size); grid = -1; return; }
        int dev = 0, cus = 0, per_cu = 0;
        hipGetDevice(&dev); hipDeviceGetAttribute(&cus, hipDeviceAttributeMultiprocessorCount, dev);
        hipFuncSetAttribute((const void*)mega_fwd, hipFuncAttributeMaxDynamicSharedMemorySize, LDS_BYTES);
        hipOccupancyMaxActiveBlocksPerMultiprocessor(&per_cu, (const void*)mega_fwd, 512, LDS_BYTES);
        if (per_cu < 1) { fprintf(stderr, "kernel_launch: occupancy query says %d blocks per CU\n", per_cu); per_cu = 1; }
        (void)hipGetLastError();
        grid = cus;
    }
    if (grid < 0) return;
    hipMemsetAsync((char*)d_ws + WS_CTL, 0, CTL_BYTES, stream);
    Args a{};
    for (int i = 0; i < 28; ++i) a.in[i] = (const float*)d_in[i];
    a.out = (float*)d_out; a.ws = (unsigned char*)d_ws;
#if MK_N_LAUNCHES == 1
    a.ph_lo = 0; a.ph_hi = NPH;
    void* kargs[] = {&a};
    hipError_t e = hipLaunchCooperativeKernel((const void*)mega_fwd, dim3(grid), dim3(512), kargs, LDS_BYTES, stream);
    if (e != hipSuccess) fprintf(stderr, "cooperative launch failed: %s\n", hipGetErrorString(e));
#else
    { const int seq[NPH] = {0, 1, 2, 3, 10, 4, 5, 6, 7, 8, 9}; for (int i = 0; i < NPH; ++i) { a.ph_lo = seq[i]; a.ph_hi = seq[i] + 1; hipLaunchKernelGGL(mega_fwd, dim3(grid), dim3(512), LDS_BYTES, stream, a); } }
#endif
}
```

```cpp
#include <hip/hip_runtime.h>
#include <hip/hip_cooperative_groups.h>
#include <cstdint>
#include <cstdio>
namespace cg = cooperative_groups;

#ifndef PROBE_DUP
#define PROBE_DUP -1
#endif
#ifndef PROBE_PV
#define PROBE_PV 0
#endif
#ifndef PROBE_MASK
#define PROBE_MASK 7
#endif
#ifndef MK_N_LAUNCHES
#define MK_N_LAUNCHES 1
#endif

#define LAS __attribute__((address_space(3)))
typedef unsigned short bf16_t;
typedef short bf16x8 __attribute__((ext_vector_type(8)));
typedef short s16x4 __attribute__((ext_vector_type(4)));
typedef float f32x4 __attribute__((ext_vector_type(4)));
typedef float f32x2 __attribute__((ext_vector_type(2)));
typedef float f32x16 __attribute__((ext_vector_type(16)));
typedef unsigned u32x4 __attribute__((ext_vector_type(4)));
typedef unsigned u32x2 __attribute__((ext_vector_type(2)));

constexpr int DM = 1024, SEQ = 16384, DEC_B = 16, DEC_T = 16, NSMP = DEC_B * DEC_T, MT = SEQ + NSMP, PAST = 2048, SKV = PAST + DEC_T;
constexpr int NZ = 5120, DFF = 2816, NFF2 = 2 * DFF, WIN_COLS = 5128;
constexpr float LOG2E = 1.4426950408889634f, C2 = 0.125f * LOG2E, ALPHA = 1.189207115002721f, LN_EPS = 1e-5f;
constexpr int NPH = 11;

constexpr size_t O_Y = 0, O_DKP = (size_t)MT * DM, O_DVP = O_DKP + (size_t)SEQ * 512, O_FKP = O_DVP + (size_t)SEQ * 512, O_FVP = O_FKP + (size_t)SEQ * 512,
                 O_FLP = O_FVP + (size_t)SEQ * 512, O_DKS = O_FLP + (size_t)SEQ * 8, O_DVS = O_DKS + (size_t)NSMP * 512, O_FKS = O_DVS + (size_t)NSMP * 512,
                 O_FVS = O_FKS + (size_t)NSMP * 512, O_FLS = O_FVS + (size_t)NSMP * 512, O_END = O_FLS + (size_t)NSMP * 8;

constexpr size_t MiB = 1u << 20;
constexpr size_t WS_CTL = 0, CTL_BYTES = 64 * 1024;
constexpr size_t WS_MOD = 1 * MiB;
constexpr size_t WS_FP = 2 * MiB;
constexpr size_t WS_FS = 3 * MiB;
constexpr size_t WS_WIN = 8 * MiB;
constexpr size_t WS_WAB = 18 * MiB;
constexpr size_t WS_WO2 = 20 * MiB;
constexpr size_t WS_WFI = 24 * MiB;
constexpr size_t WS_WFO = 35 * MiB;
constexpr size_t WS_XN = 48 * MiB;
constexpr size_t WS_QA = 84 * MiB, WS_KA = 101 * MiB, WS_VA = 118 * MiB, WS_QB = 135 * MiB, WS_KB = 152 * MiB, WS_VB = 169 * MiB;
constexpr size_t WS_ACT = 84 * MiB;
constexpr size_t WS_G = 188 * MiB;
constexpr size_t WS_AB = 254 * MiB;
constexpr size_t WS_OD1 = WS_XN, WS_OD2 = 288 * MiB;
constexpr size_t WS_PF = 304 * MiB, WS_PD = 309 * MiB;
constexpr size_t WS_TB = WS_AB;
constexpr size_t WS_X1B = WS_AB;
constexpr size_t WS_XB1 = 5 * MiB, WS_XB2 = 6 * MiB;
constexpr int CTL_LN1 = 8192, CTL_LN2 = 12288;
constexpr int LN_LDS = 135168;
constexpr size_t WS_SLAB = 288 * MiB;
constexpr size_t WS_END = 320 * MiB;

constexpr int LDS_BYTES = 147456;

struct Args { const float* in[28]; float* out; unsigned char* ws; int ph_lo, ph_hi; };

__device__ __forceinline__ int lane_id_opaque() { int l = (int)__builtin_amdgcn_mbcnt_hi(~0u, __builtin_amdgcn_mbcnt_lo(~0u, 0u)); asm volatile("" : "+v"(l)); return l; }
__device__ __forceinline__ unsigned f2bf(float f) { unsigned u = __builtin_bit_cast(unsigned, f); return (u + 0x7fffu + ((u >> 16) & 1u)) >> 16; }
typedef __bf16 bf16x2e_t_ __attribute__((ext_vector_type(2)));
__device__ __forceinline__ unsigned cvtpk_v(float lo, float hi) { f32x2 v = {lo, hi}; bf16x2e_t_ b = __builtin_convertvector(v, bf16x2e_t_); return __builtin_bit_cast(unsigned, b); }
__device__ __forceinline__ unsigned pk2(float lo, float hi) { return cvtpk_v(lo, hi); }
__device__ __forceinline__ float bf2f(unsigned short b) { return __builtin_bit_cast(float, (unsigned)b << 16); }
__device__ __forceinline__ float bflo(unsigned w) { return __builtin_bit_cast(float, w << 16); }
__device__ __forceinline__ float bfhi(unsigned w) { return __builtin_bit_cast(float, w & 0xffff0000u); }
__device__ __forceinline__ float wave_sum(float v) {
#pragma unroll
    for (int o = 1; o < 64; o <<= 1) v += __shfl_xor(v, o);
    return v;
}
__device__ __forceinline__ float sigmoidf_(float x) { return __builtin_amdgcn_rcpf(1.0f + __expf(-x)); }
__device__ __forceinline__ float siluf_(float x) { return x * __builtin_amdgcn_rcpf(1.0f + __expf(-x)); }

namespace pg8 {
constexpr int BM = 256, BK = 64, HALF = 128, HTB = HALF * BK * 2, STAGE_BYTES = 8 * HTB, NXCD = 8, WGM = 8;
__host__ __device__ __forceinline__ int lds_byte(int r, int c) { const int st = (r >> 4) * 2 + (c >> 5), rr = r & 15, cc = c & 31, ob = rr * 64 + cc * 2; return st * 1024 + (ob ^ (((ob >> 9) & 1) << 5)); }
__host__ __device__ __forceinline__ void stage_rc(int b, int& R, int& C) { const int st = b / 1024, sb = b % 1024, swz = sb ^ (((sb >> 9) & 1) << 5); R = (st >> 1) * 16 + swz / 64; C = (st & 1) * 32 + (swz % 64) / 2; }
__host__ __device__ __forceinline__ int perm32(int rho) { const int n = rho >> 4, i = rho & 15; return 8 * (i >> 2) + 4 * n + (i & 3); }

struct Unit { int pm, pn, ks; };
struct Gemm { const bf16_t* A; const bf16_t* Bt; int lda, ldb, K, a_split_pn, a_split_off, kpart; };

struct StaticOrder {
    int nM, nN, nwg, G, c, pm0;
    __device__ void init(int nM_, int nN_, int G_, int c_, int pm0_) { nM = nM_; nN = nN_; nwg = nM * nN; G = G_; c = c_; pm0 = pm0_; }
    __device__ bool next(int i, Unit& u) const {
        const long L = (long)i * G + c; if (L >= nwg) return false;
        int wgid = (int)L; { const int q = nwg / NXCD, r = nwg % NXCD, xcd = wgid % NXCD, off = wgid / NXCD; wgid = (xcd < r ? xcd * (q + 1) : r * (q + 1) + (xcd - r) * q) + off; }
        const int nig = WGM * nN, gid = wgid / nig, fm = gid * WGM, gsz = (nM - fm) < WGM ? (nM - fm) : WGM;
        u.pm = pm0 + fm + ((wgid % nig) % gsz); u.pn = (wgid % nig) / gsz; u.ks = 0; return true;
    }
};

struct SplitOrder {
    int nN, nun, G, c, pm;
    __device__ void init(int nN_, int KS_, int G_, int c_, int pm_) { nN = nN_; nun = nN_ * KS_; G = G_; c = c_; pm = pm_; }
    __device__ bool next(int i, Unit& u) const { const long L = (long)i * G + c; if (L >= nun) return false; u.pm = pm; u.pn = (int)L % nN; u.ks = (int)L / nN; return true; }
};

__device__ __forceinline__ unsigned cvt_pk_bf16(float lo, float hi) { unsigned r; asm volatile("v_cvt_pk_bf16_f32 %0, %1, %2" : "=v"(r) : "v"(lo), "v"(hi)); return r; }

template <class Epi, class Sched, bool ALIGN_EPI = true, bool SP2 = true>
__device__ __forceinline__ void gemm_phase(LAS unsigned char* lds, const Gemm g, const Sched& S, const Epi& E, int wid  ) {
    const int lane = lane_id_opaque(), tid = wid * 64 + lane, wr = wid >> 2, wc = wid & 3; int fr = lane & 15, fq = lane >> 4;
    const int K = g.K, nt = K / BK;
    unsigned voffA[2], voffB[2];
#pragma unroll
    for (int i = 0; i < 2; ++i) { int R, C; stage_rc(tid * 16 + i * 8192, R, C); const int Rb = Epi::PERM ? ((R & ~31) + perm32(R & 31)) : R;
        voffA[i] = (unsigned)(R * g.lda + C) * 2u; voffB[i] = (unsigned)(Rb * g.ldb + C) * 2u; }
    const size_t kstep = (size_t)(BK * 2);
    const size_t hstepA = (size_t)HALF * g.lda * 2, hstepB = (size_t)HALF * g.ldb * 2;
    const size_t tstepA = 2 * hstepA, tstepB = 2 * hstepB;
    const unsigned ldsw = (unsigned)wid * 1024u;
    const int aoff = lds_byte(wr * 64 + fr, fq * 8), boff = lds_byte(wc * 32 + fr, fq * 8);
#define PG8_SA(b, h) (((b) * 2 + (h)) * HTB)
#define PG8_SB(b, h) ((4 + (b) * 2 + (h)) * HTB)
#define PG8_STAGE(bufoff, gbase, voff) do { _Pragma("unroll") for (int _i = 0; _i < 2; ++_i) \
        __builtin_amdgcn_global_load_lds((const unsigned*)((const char*)(gbase) + (voff)[_i]), (LAS unsigned*)(lds + (bufoff) + ldsw + _i * 8192), 16, 0, 0); } while (0)
#define PG8_LDA(dst, b, h) do { _Pragma("unroll") for (int m = 0; m < 4; ++m) _Pragma("unroll") for (int k = 0; k < 2; ++k) dst[m][k] = *(const LAS bf16x8*)(lds + PG8_SA(b, h) + aoff + m * 2048 + k * 1024); } while (0)
#define PG8_LDB(dst, b, h) do { _Pragma("unroll") for (int n = 0; n < 2; ++n) _Pragma("unroll") for (int k = 0; k < 2; ++k) dst[n][k] = *(const LAS bf16x8*)(lds + PG8_SB(b, h) + boff + n * 2048 + k * 1024); } while (0)
#define PG8_MMA(ai, bj, At, Bt) do { __builtin_amdgcn_s_setprio(1); _Pragma("unroll") for (int m = 0; m < 4; ++m) _Pragma("unroll") for (int n = 0; n < 2; ++n) _Pragma("unroll") for (int k = 0; k < 2; ++k) \
        acc[ai][bj][m][n] = __builtin_amdgcn_mfma_f32_16x16x32_bf16(Bt[n][k], At[m][k], acc[ai][bj][m][n], 0, 0, 0); __builtin_amdgcn_s_setprio(0); } while (0)
#define PG8_WAIT_V(n) asm volatile("s_waitcnt vmcnt(" #n ")" ::: "memory")
#define PG8_WAIT_L(n) asm volatile("s_waitcnt lgkmcnt(" #n ")" ::: "memory")
#define PG8_BAR __builtin_amdgcn_s_barrier()
#define PG8_SCHED __builtin_amdgcn_sched_barrier(0)
#define PG8_ABASE(u) ((const char*)g.A + (size_t)(u).pm * tstepA + ((u).pn >= g.a_split_pn ? (size_t)g.a_split_off * 2 : (size_t)0) + (size_t)(u).ks * g.kpart * 2)
#define PG8_BBASE(u) ((const char*)g.Bt + (size_t)(u).pn * tstepB + (size_t)(u).ks * g.kpart * 2)
    Unit cur, nxt; int ui = 0;
    if (!S.next(0, cur)) return;
    f32x4 acc[2][2][4][2];
#pragma unroll
    for (int a = 0; a < 2; ++a)
#pragma unroll
        for (int b = 0; b < 2; ++b)
#pragma unroll
            for (int m = 0; m < 4; ++m)
#pragma unroll
                for (int n = 0; n < 2; ++n) acc[a][b][m][n] = (f32x4){0.f, 0.f, 0.f, 0.f};
    bf16x8 At[4][2], B0[2][2], B1[2][2];
    const char* cA = PG8_ABASE(cur); const char* cB = PG8_BBASE(cur);
    if constexpr (SP2) {
        PG8_STAGE(PG8_SB(0, 0), cB, voffB); PG8_STAGE(PG8_SB(0, 1), cB + hstepB, voffB); PG8_STAGE(PG8_SA(0, 0), cA, voffA); PG8_STAGE(PG8_SA(0, 1), cA + hstepA, voffA);
        if (wr == 1) PG8_BAR;
        PG8_WAIT_V(2); PG8_BAR;
        PG8_STAGE(PG8_SB(1, 0), cB + kstep, voffB); PG8_STAGE(PG8_SA(1, 0), cA + kstep, voffA); PG8_STAGE(PG8_SB(1, 1), cB + hstepB + kstep, voffB);
        PG8_WAIT_V(6); PG8_BAR;
    } else {
        PG8_STAGE(PG8_SB(0, 0), cB, voffB); PG8_STAGE(PG8_SA(0, 0), cA, voffA); PG8_STAGE(PG8_SB(0, 1), cB + hstepB, voffB); PG8_STAGE(PG8_SA(0, 1), cA + hstepA, voffA);
        if (wr == 1) PG8_BAR;
        PG8_WAIT_V(4); PG8_BAR;
        PG8_STAGE(PG8_SB(1, 0), cB + kstep, voffB); PG8_STAGE(PG8_SA(1, 0), cA + kstep, voffA); PG8_STAGE(PG8_SB(1, 1), cB + hstepB + kstep, voffB);
        PG8_WAIT_V(6); PG8_BAR;
    }
    for (;;) {
        const bool has_next = S.next(ui + 1, nxt);
        const char* nA = has_next ? PG8_ABASE(nxt) : cA; const char* nB = has_next ? PG8_BBASE(nxt) : cB;
        for (int t = 0; t < nt; t += 2) {
            const bool last = (t == nt - 2);
            const char* a1 = cA + (size_t)(t + 1) * kstep;
            const char* a2 = last ? nA : cA + (size_t)(t + 2) * kstep; const char* b2 = last ? nB : cB + (size_t)(t + 2) * kstep;
            const char* a3 = a2 + kstep; const char* b3 = b2 + kstep;
            if constexpr (SP2) {
            PG8_LDB(B0, 0, 0); PG8_LDB(B1, 0, 1); PG8_SCHED; PG8_LDA(At, 0, 0); PG8_STAGE(PG8_SA(1, 1), a1 + hstepA, voffA);
            PG8_WAIT_V(8); PG8_WAIT_L(0); PG8_BAR; PG8_MMA(0, 0, At, B0); PG8_MMA(0, 1, At, B1); PG8_BAR; PG8_SCHED;
            PG8_LDA(At, 0, 1); PG8_STAGE(PG8_SB(0, 0), b2, voffB); PG8_STAGE(PG8_SB(0, 1), b2 + hstepB, voffB); PG8_STAGE(PG8_SA(0, 0), a2, voffA);
            PG8_WAIT_V(8); PG8_WAIT_L(0); PG8_BAR; PG8_MMA(1, 0, At, B0); PG8_MMA(1, 1, At, B1); PG8_BAR; PG8_SCHED;
            PG8_LDB(B0, 1, 0); PG8_LDB(B1, 1, 1); PG8_SCHED; PG8_LDA(At, 1, 0); PG8_STAGE(PG8_SA(0, 1), a2 + hstepA, voffA);
            PG8_WAIT_V(8); PG8_WAIT_L(0); PG8_BAR; PG8_MMA(0, 0, At, B0); PG8_MMA(0, 1, At, B1); PG8_BAR; PG8_SCHED;
            PG8_LDA(At, 1, 1); PG8_STAGE(PG8_SB(1, 0), b3, voffB); PG8_STAGE(PG8_SB(1, 1), b3 + hstepB, voffB); PG8_STAGE(PG8_SA(1, 0), a3, voffA);
            PG8_WAIT_V(8); PG8_WAIT_L(0); PG8_BAR; PG8_MMA(1, 0, At, B0); PG8_MMA(1, 1, At, B1); PG8_BAR; PG8_SCHED;
            } else {
            PG8_LDB(B0, 0, 0); PG8_SCHED; PG8_LDA(At, 0, 0); PG8_STAGE(PG8_SA(1, 1), a1 + hstepA, voffA);
            PG8_WAIT_L(8); PG8_BAR; PG8_WAIT_L(0); PG8_MMA(0, 0, At, B0); PG8_BAR; PG8_SCHED;
            PG8_LDB(B1, 0, 1); PG8_STAGE(PG8_SB(0, 0), b2, voffB);
            PG8_BAR; PG8_WAIT_L(0); PG8_MMA(0, 1, At, B1); PG8_BAR;
            PG8_LDA(At, 0, 1); PG8_STAGE(PG8_SA(0, 0), a2, voffA);
            PG8_BAR; PG8_WAIT_L(0); PG8_MMA(1, 0, At, B0); PG8_BAR; PG8_SCHED;
            PG8_STAGE(PG8_SB(0, 1), b2 + hstepB, voffB);
            PG8_WAIT_V(6); PG8_BAR; PG8_MMA(1, 1, At, B1); PG8_BAR;
            PG8_LDB(B0, 1, 0); PG8_SCHED; PG8_LDA(At, 1, 0); PG8_STAGE(PG8_SA(0, 1), a2 + hstepA, voffA);
            PG8_WAIT_L(8); PG8_BAR; PG8_WAIT_L(0); PG8_MMA(0, 0, At, B0); PG8_BAR; PG8_SCHED;
            PG8_LDB(B1, 1, 1); PG8_STAGE(PG8_SB(1, 0), b3, voffB);
            PG8_BAR; PG8_WAIT_L(0); PG8_MMA(0, 1, At, B1); PG8_BAR;
            PG8_LDA(At, 1, 1); PG8_STAGE(PG8_SA(1, 0), a3, voffA);
            PG8_BAR; PG8_WAIT_L(0); PG8_MMA(1, 0, At, B0); PG8_BAR; PG8_SCHED;
            PG8_STAGE(PG8_SB(1, 1), b3 + hstepB, voffB);
            PG8_WAIT_V(6); PG8_BAR; PG8_MMA(1, 1, At, B1); PG8_BAR;
            }
        }
        if constexpr (ALIGN_EPI) { if (wr == 0) PG8_BAR; }
        { const int le_ = lane_id_opaque(); E(acc, cur, wr, wc, le_ & 15, le_ >> 4); }
        if (!has_next) break;
#pragma unroll
        for (int a = 0; a < 2; ++a)
#pragma unroll
            for (int b = 0; b < 2; ++b)
#pragma unroll
                for (int m = 0; m < 4; ++m)
#pragma unroll
                    for (int n = 0; n < 2; ++n) acc[a][b][m][n] = (f32x4){0.f, 0.f, 0.f, 0.f};
        cur = nxt; cA = nA; cB = nB; ++ui;
        if constexpr (ALIGN_EPI) { if (wr == 1) PG8_BAR; }
    }
    PG8_WAIT_V(0);
    if constexpr (!ALIGN_EPI) { if (wr == 0) PG8_BAR; }
    PG8_BAR;
#undef PG8_SA
#undef PG8_SB
#undef PG8_STAGE
#undef PG8_LDA
#undef PG8_LDB
#undef PG8_MMA
#undef PG8_WAIT_V
#undef PG8_WAIT_L
#undef PG8_BAR
#undef PG8_SCHED
#undef PG8_ABASE
#undef PG8_BBASE
}
}

struct EpiZ {
    static constexpr bool PERM = true;
    float* out; unsigned char* ws;
    __device__ __forceinline__ void operator()(const f32x4 (&acc)[2][2][4][2], const pg8::Unit& u, int wr, int wc, int fr, int fq) const {
        asm volatile("" : "+v"(fr), "+v"(fq));
        const int seg = u.pn >> 1;
        const bool smp = u.pm >= SEQ / 256;
        const int row0 = u.pm * 256 + wr * 64 + fr;
        const int cl0 = wc * 32 + 8 * fq;
        if (seg < 6) {
            bf16_t* B = (bf16_t*)(ws + WS_QA + (size_t)seg * (WS_KA - WS_QA));
            const bool isq = (seg == 0 || seg == 3);
            const float sc = isq ? C2 : 1.0f;
            const int kk = seg - 1 - (seg > 3 ? 1 : 0);
            float* ob = isq ? nullptr : (smp ? out + O_DKS + (size_t)kk * NSMP * 512 - (size_t)SEQ * 512 : out + O_DKP + (size_t)kk * SEQ * 512);
            const int cs = (u.pn & 1) * 256 + cl0;
            if (seg == 0 || seg == 1 || seg == 3 || seg == 4) {
                float mx0 = 0.f, mx1 = 0.f;
#pragma unroll
                for (int ai = 0; ai < 2; ++ai)
#pragma unroll
                    for (int m = 0; m < 4; ++m) {
#pragma unroll
                        for (int bj = 0; bj < 2; ++bj) { const f32x4 v0 = acc[ai][bj][m][0] * sc, v1 = acc[ai][bj][m][1] * sc;
                            float ss = (v0[0] * v0[0] + v0[1] * v0[1]) + (v0[2] * v0[2] + v0[3] * v0[3]) + (v1[0] * v1[0] + v1[1] * v1[1]) + (v1[2] * v1[2] + v1[3] * v1[3]);
                            ss += __shfl_xor(ss, 16); ss += __shfl_xor(ss, 32);
                            if (bj == 0) mx0 = fmaxf(mx0, ss); else mx1 = fmaxf(mx1, ss); } }
#pragma unroll
                for (int ofs = 1; ofs < 16; ofs <<= 1) { mx0 = fmaxf(mx0, __shfl_xor(mx0, ofs)); mx1 = fmaxf(mx1, __shfl_xor(mx1, ofs)); }
                if ((fr | fq) == 0) { unsigned* nw = (unsigned*)(ws + WS_CTL) + (seg < 3 ? 288 : 256) + ((seg == 4 || seg == 1) ? 16 : 0);
                    const int h0 = (u.pn & 1) * 4 + (wc >> 1), hf = wc & 1;
                    atomicMax(nw + (h0 * 2 + hf), __float_as_uint(mx0)); atomicMax(nw + ((h0 + 2) * 2 + hf), __float_as_uint(mx1)); }
            }
#pragma unroll
            for (int ai = 0; ai < 2; ++ai)
#pragma unroll
                for (int m = 0; m < 4; ++m) { const size_t r = (size_t)(row0 + ai * 128 + m * 16);
#pragma unroll
                    for (int bj = 0; bj < 2; ++bj) { const f32x4 v0 = acc[ai][bj][m][0], v1 = acc[ai][bj][m][1]; const int c = cs + bj * 128;
                        if (ob) { if (smp) { *(f32x4*)(ob + r * 512 + c) = v0; *(f32x4*)(ob + r * 512 + c + 4) = v1; }
                                  else { __builtin_nontemporal_store(v0, (f32x4*)(ob + r * 512 + c)); __builtin_nontemporal_store(v1, (f32x4*)(ob + r * 512 + c + 4)); } }
                        u32x4 w; w.x = pg8::cvt_pk_bf16(v0[0] * sc, v0[1] * sc); w.y = pg8::cvt_pk_bf16(v0[2] * sc, v0[3] * sc); w.z = pg8::cvt_pk_bf16(v1[0] * sc, v1[1] * sc); w.w = pg8::cvt_pk_bf16(v1[2] * sc, v1[3] * sc);
                        *(u32x4*)(B + r * 512 + c) = w; } }
        } else {
            bf16_t* G = (bf16_t*)(ws + WS_G);
            const int cs = (u.pn - 12) * 256 + cl0;
#pragma unroll
            for (int ai = 0; ai < 2; ++ai)
#pragma unroll
                for (int m = 0; m < 4; ++m) { const size_t r = (size_t)(row0 + ai * 128 + m * 16);
#pragma unroll
                    for (int bj = 0; bj < 2; ++bj) { const f32x4 v0 = acc[ai][bj][m][0], v1 = acc[ai][bj][m][1]; const int c = cs + bj * 128;
                        u32x4 w; w.x = cvtpk_v(sigmoidf_(v0[0]), sigmoidf_(v0[1])); w.y = cvtpk_v(sigmoidf_(v0[2]), sigmoidf_(v0[3]));
                        w.z = cvtpk_v(sigmoidf_(v1[0]), sigmoidf_(v1[1])); w.w = cvtpk_v(sigmoidf_(v1[2]), sigmoidf_(v1[3]));
                        *(u32x4*)(G + r * 2048 + c) = w; } }
        }
    }
};
struct EpiGate {
    static constexpr bool PERM = true;
    bf16_t* G; bf16_t* GO;
    __device__ __forceinline__ void operator()(const f32x4 (&acc)[2][2][4][2], const pg8::Unit& u, int wr, int wc, int fr, int fq) const {
        asm volatile("" : "+v"(fr), "+v"(fq));
        const int row0 = u.pm * 256 + wr * 64 + fr, c0 = u.pn * 256 + wc * 32 + 8 * fq;
#pragma unroll
        for (int ai = 0; ai < 2; ++ai)
#pragma unroll
            for (int m = 0; m < 4; ++m) { const size_t ro = (size_t)(row0 + ai * 128 + m * 16) * 2048 + c0; const bf16_t* rp = G + ro; bf16_t* wp = GO + ro;
#pragma unroll
                for (int bj = 0; bj < 2; ++bj) { const f32x4 v0 = acc[ai][bj][m][0], v1 = acc[ai][bj][m][1]; const u32x4 gw = *(const u32x4*)(rp + bj * 128);
                    u32x4 w; w.x = pg8::cvt_pk_bf16(v0[0] * bflo(gw.x), v0[1] * bfhi(gw.x)); w.y = pg8::cvt_pk_bf16(v0[2] * bflo(gw.y), v0[3] * bfhi(gw.y));
                    w.z = pg8::cvt_pk_bf16(v1[0] * bflo(gw.z), v1[1] * bfhi(gw.z)); w.w = pg8::cvt_pk_bf16(v1[2] * bflo(gw.w), v1[3] * bfhi(gw.w));
                    *(u32x4*)(wp + bj * 128) = w; } }
    }
};
template <bool BASE_BF16> struct EpiRes {
    static constexpr bool PERM = true;
    const void* base; bf16_t* T; const float* gate;
    __device__ __forceinline__ void operator()(const f32x4 (&acc)[2][2][4][2], const pg8::Unit& u, int wr, int wc, int fr, int fq) const {
        asm volatile("" : "+v"(fr), "+v"(fq));
        const int row0 = u.pm * 256 + wr * 64 + fr, c0 = u.pn * 256 + wc * 32 + 8 * fq;
#pragma unroll
        for (int ai = 0; ai < 2; ++ai)
#pragma unroll
            for (int m = 0; m < 4; ++m) { const size_t ro = (size_t)(row0 + ai * 128 + m * 16) * DM;
#pragma unroll
                for (int bj = 0; bj < 2; ++bj) { const int c = c0 + bj * 128; f32x4 b0, b1;
                    if (BASE_BF16) { const u32x4 bw = *(const u32x4*)((const bf16_t*)base + ro + c); b0 = (f32x4){bflo(bw.x), bfhi(bw.x), bflo(bw.y), bfhi(bw.y)}; b1 = (f32x4){bflo(bw.z), bfhi(bw.z), bflo(bw.w), bfhi(bw.w)}; }
                    else { b0 = *(const f32x4*)((const float*)base + ro + c); b1 = *(const f32x4*)((const float*)base + ro + c + 4); }
                    const f32x4 g0 = *(const f32x4*)(gate + c), g1 = *(const f32x4*)(gate + c + 4);
                    const f32x4 v0 = b0 * ALPHA + g0 * acc[ai][bj][m][0], v1 = b1 * ALPHA + g1 * acc[ai][bj][m][1];
                    u32x4 w; w.x = pg8::cvt_pk_bf16(v0[0], v0[1]); w.y = pg8::cvt_pk_bf16(v0[2], v0[3]); w.z = pg8::cvt_pk_bf16(v1[0], v1[1]); w.w = pg8::cvt_pk_bf16(v1[2], v1[3]);
                    *(u32x4*)(T + ro + c) = w; } }
    }
};
struct PanelStats {
    unsigned* xbuf; unsigned* cnt; float eps;
    __device__ __forceinline__ void run(const f32x4 (&v)[2][2][4][2], const pg8::Unit& u, int wr, int wc, int fr, int fq, LAS unsigned char* lds, int wid, int lane) const {
        LAS f32x2* P = (LAS f32x2*)(lds + LN_LDS);
        LAS f32x2* S = (LAS f32x2*)(lds + LN_LDS + 8192);
#pragma unroll
        for (int ai = 0; ai < 2; ++ai)
#pragma unroll
            for (int m = 0; m < 4; ++m) {
                float s = 0.f;
#pragma unroll
                for (int bj = 0; bj < 2; ++bj)
#pragma unroll
                    for (int n = 0; n < 2; ++n) { const f32x4 x = v[ai][bj][m][n]; s += (x[0] + x[1]) + (x[2] + x[3]); }
                s += __shfl_xor(s, 16); s += __shfl_xor(s, 32);
                const float mw = s * (1.0f / 64.0f); float q = 0.f;
#pragma unroll
                for (int bj = 0; bj < 2; ++bj)
#pragma unroll
                    for (int n = 0; n < 2; ++n) { const f32x4 d = v[ai][bj][m][n] - mw; q += (d[0] * d[0] + d[1] * d[1]) + (d[2] * d[2] + d[3] * d[3]); }
                q += __shfl_xor(q, 16); q += __shfl_xor(q, 32);
                if (fq == 0) P[(ai * 128 + wr * 64 + m * 16 + fr) * 4 + wc] = (f32x2){mw, q};
                __builtin_amdgcn_sched_barrier(0);
            }
        asm volatile("s_waitcnt lgkmcnt(0)" ::: "memory"); __builtin_amdgcn_s_barrier(); asm volatile("" ::: "memory");
        const int row = wid * 32 + (lane & 31);
        if (lane < 32) {
            const f32x2 a = P[row * 4 + 0], b = P[row * 4 + 1], c = P[row * 4 + 2], d = P[row * 4 + 3];
            const float mt = (a.x + b.x + c.x + d.x) * 0.25f;
            const float da = a.x - mt, db = b.x - mt, dc = c.x - mt, dd = d.x - mt;
            const float m2 = (a.y + b.y) + (c.y + d.y) + 64.0f * ((da * da + db * db) + (dc * dc + dd * dd));
            unsigned long long* slot = (unsigned long long*)xbuf + ((size_t)(u.pm * 256 + row) * 4 + u.pn);
            __hip_atomic_store(slot, ((unsigned long long)__float_as_uint(m2) << 32) | __float_as_uint(mt), __ATOMIC_RELAXED, __HIP_MEMORY_SCOPE_AGENT);
        }
        asm volatile("s_waitcnt vmcnt(0)" ::: "memory");
        if (lane == 0) __hip_atomic_fetch_add(cnt + 64 * u.pm, 1u, __ATOMIC_RELAXED, __HIP_MEMORY_SCOPE_AGENT);
        if (wid == 0) {
            unsigned sp = 0;
            while ((unsigned)__builtin_amdgcn_readfirstlane(__hip_atomic_load(cnt + 64 * u.pm, __ATOMIC_RELAXED, __HIP_MEMORY_SCOPE_AGENT)) < 32u && ++sp < (1u << 21)) __builtin_amdgcn_s_sleep(2);
            __builtin_amdgcn_fence(__ATOMIC_ACQUIRE, "agent");
        }
        asm volatile("s_waitcnt vmcnt(0) lgkmcnt(0)" ::: "memory"); __builtin_amdgcn_s_barrier(); asm volatile("" ::: "memory");
        if (lane < 32) {
            const unsigned long long* slot = (const unsigned long long*)xbuf + (size_t)(u.pm * 256 + row) * 4; float mt[4], m2[4]; float ms = 0.f;
#pragma unroll
            for (int t = 0; t < 4; ++t) { const unsigned long long w = __hip_atomic_load(slot + t, __ATOMIC_RELAXED, __HIP_MEMORY_SCOPE_AGENT); mt[t] = __uint_as_float((unsigned)w); m2[t] = __uint_as_float((unsigned)(w >> 32)); ms += mt[t]; }
            const float mean = ms * 0.25f; float q = 0.f;
#pragma unroll
            for (int t = 0; t < 4; ++t) { const float dm = mt[t] - mean; q += m2[t] + 256.0f * dm * dm; }
            S[row] = (f32x2){mean, 1.0f / sqrtf(q * (1.0f / 1024.0f) + eps)};
        }
        asm volatile("s_waitcnt lgkmcnt(0)" ::: "memory"); __builtin_amdgcn_s_barrier(); asm volatile("" ::: "memory");
    }
};
template <bool FINAL> struct EpiResLn {
    static constexpr bool PERM = true;
    const void* base; const float* gate; const float* lg; const float* lb; const float* mod; bf16_t* X1B; bf16_t* XN; float* out; PanelStats st; LAS unsigned char* lds;
    __device__ __forceinline__ void operator()(f32x4 (&acc)[2][2][4][2], const pg8::Unit& u, int wr, int wc, int fr, int fq) const {
        asm volatile("" : "+v"(fr), "+v"(fq));
        const int row0 = u.pm * 256 + wr * 64 + fr, c0 = u.pn * 256 + wc * 32 + 8 * fq;
        f32x4 gv[2][2];
#pragma unroll
        for (int bj = 0; bj < 2; ++bj) { int c = c0 + bj * 128; asm volatile("" : "+v"(c)); gv[bj][0] = *(const f32x4*)(gate + c); gv[bj][1] = *(const f32x4*)(gate + c + 4); }
        constexpr int LD_D = 4;
        f32x4 bf_[LD_D][2][2]; u32x4 bw_[LD_D][2];
#define ERL_LOAD(g) do { int rr_ = row0 + ((g) >> 2) * 128 + ((g) & 3) * 16; asm volatile("" : "+v"(rr_)); const size_t ro = (size_t)rr_ * DM; \
        _Pragma("unroll") for (int bj = 0; bj < 2; ++bj) { const int c = c0 + bj * 128; \
            if (FINAL) bw_[(g) % LD_D][bj] = *(const u32x4*)((const bf16_t*)base + ro + c); \
            else { bf_[(g) % LD_D][bj][0] = *(const f32x4*)((const float*)base + ro + c); bf_[(g) % LD_D][bj][1] = *(const f32x4*)((const float*)base + ro + c + 4); } } } while (0)
#pragma unroll
        for (int g = 0; g < LD_D; ++g) ERL_LOAD(g);
#pragma unroll
        for (int g = 0; g < 8; ++g) { const int ai = g >> 2, m = g & 3;
#pragma unroll
            for (int bj = 0; bj < 2; ++bj) { f32x4 b0, b1;
                if (FINAL) { const u32x4 bw = bw_[g % LD_D][bj]; b0 = (f32x4){bflo(bw.x), bfhi(bw.x), bflo(bw.y), bfhi(bw.y)}; b1 = (f32x4){bflo(bw.z), bfhi(bw.z), bflo(bw.w), bfhi(bw.w)}; }
                else { b0 = bf_[g % LD_D][bj][0]; b1 = bf_[g % LD_D][bj][1]; }
                acc[ai][bj][m][0] = b0 * ALPHA + gv[bj][0] * acc[ai][bj][m][0]; acc[ai][bj][m][1] = b1 * ALPHA + gv[bj][1] * acc[ai][bj][m][1];
                asm volatile("" : "+v"(acc[ai][bj][m][0]), "+v"(acc[ai][bj][m][1])); }
            if (g + LD_D < 8) ERL_LOAD(g + LD_D);
            __builtin_amdgcn_sched_barrier(0); }
#undef ERL_LOAD
        st.run(acc, u, wr, wc, fr, fq, lds, wr * 4 + wc, fq * 16 + fr);
        const LAS f32x2* S = (const LAS f32x2*)(lds + LN_LDS + 8192);
        f32x4 cg[2][2], cb[2][2], cs[2][2], ct[2][2];
#pragma unroll
        for (int bj = 0; bj < 2; ++bj) { int c = c0 + bj * 128; asm volatile("" : "+v"(c));
            cg[bj][0] = *(const f32x4*)(lg + c); cg[bj][1] = *(const f32x4*)(lg + c + 4); cb[bj][0] = *(const f32x4*)(lb + c); cb[bj][1] = *(const f32x4*)(lb + c + 4);
            if (!FINAL) { cs[bj][0] = *(const f32x4*)(mod + 4096 + c) + 1.0f; cs[bj][1] = *(const f32x4*)(mod + 4096 + c + 4) + 1.0f; ct[bj][0] = *(const f32x4*)(mod + 3072 + c); ct[bj][1] = *(const f32x4*)(mod + 3072 + c + 4); } }
#pragma unroll
        for (int ai = 0; ai < 2; ++ai)
#pragma unroll
            for (int m = 0; m < 4; ++m) { int r = ai * 128 + wr * 64 + m * 16 + fr; asm volatile("" : "+v"(r)); const f32x2 sr = S[r]; const size_t ro = (size_t)(u.pm * 256 + r) * DM;
#pragma unroll
                for (int bj = 0; bj < 2; ++bj) { const int c = c0 + bj * 128;
                    const f32x4 y0 = (acc[ai][bj][m][0] - sr.x) * sr.y * cg[bj][0] + cb[bj][0];
                    const f32x4 y1 = (acc[ai][bj][m][1] - sr.x) * sr.y * cg[bj][1] + cb[bj][1];
                    if (FINAL) { __builtin_nontemporal_store(y0, (f32x4*)(out + ro + c)); __builtin_nontemporal_store(y1, (f32x4*)(out + ro + c + 4)); }
                    else { u32x4 w; w.x = pg8::cvt_pk_bf16(y0[0], y0[1]); w.y = pg8::cvt_pk_bf16(y0[2], y0[3]); w.z = pg8::cvt_pk_bf16(y1[0], y1[1]); w.w = pg8::cvt_pk_bf16(y1[2], y1[3]);
                        *(u32x4*)(X1B + ro + c) = w;
                        const f32x4 h0 = y0 * cs[bj][0] + ct[bj][0], h1 = y1 * cs[bj][1] + ct[bj][1];
                        u32x4 w2; w2.x = pg8::cvt_pk_bf16(h0[0], h0[1]); w2.y = pg8::cvt_pk_bf16(h0[2], h0[3]); w2.z = pg8::cvt_pk_bf16(h1[0], h1[1]); w2.w = pg8::cvt_pk_bf16(h1[2], h1[3]);
                        *(u32x4*)(XN + ro + c) = w2; } }
                __builtin_amdgcn_sched_barrier(0); }
    }
};
struct EpiSlab {
    static constexpr bool PERM = true;
    float* slab;
    __device__ __forceinline__ void operator()(const f32x4 (&acc)[2][2][4][2], const pg8::Unit& u, int wr, int wc, int fr, int fq) const {
        asm volatile("" : "+v"(fr), "+v"(fq));
        const int row0 = wr * 64 + fr, c0 = u.pn * 256 + wc * 32 + 8 * fq; float* sb = slab + (size_t)u.ks * NSMP * DM;
#pragma unroll
        for (int ai = 0; ai < 2; ++ai)
#pragma unroll
            for (int m = 0; m < 4; ++m) { float* op = sb + (size_t)(row0 + ai * 128 + m * 16) * DM + c0;
#pragma unroll
                for (int bj = 0; bj < 2; ++bj) { *(f32x4*)(op + bj * 128) = acc[ai][bj][m][0]; *(f32x4*)(op + bj * 128 + 4) = acc[ai][bj][m][1]; } }
    }
};
struct EpiFfn {
    static constexpr bool PERM = true;
    bf16_t* ACT;
    __device__ __forceinline__ void operator()(const f32x4 (&acc)[2][2][4][2], const pg8::Unit& u, int wr, int wc, int fr, int fq) const {
        asm volatile("" : "+v"(fr), "+v"(fq));
        const int row0 = u.pm * 256 + wr * 64 + fr, c0 = u.pn * 128 + wc * 32 + 8 * fq;
#pragma unroll
        for (int ai = 0; ai < 2; ++ai)
#pragma unroll
            for (int m = 0; m < 4; ++m) { const f32x4 g0 = acc[ai][0][m][0], g1 = acc[ai][0][m][1], u0 = acc[ai][1][m][0], u1 = acc[ai][1][m][1];
                u32x4 w; w.x = pg8::cvt_pk_bf16(siluf_(g0[0]) * u0[0], siluf_(g0[1]) * u0[1]); w.y = pg8::cvt_pk_bf16(siluf_(g0[2]) * u0[2], siluf_(g0[3]) * u0[3]);
                w.z = pg8::cvt_pk_bf16(siluf_(g1[0]) * u1[0], siluf_(g1[1]) * u1[1]); w.w = pg8::cvt_pk_bf16(siluf_(g1[2]) * u1[2], siluf_(g1[3]) * u1[3]);
                *(u32x4*)(ACT + (size_t)(row0 + ai * 128 + m * 16) * DFF + c0) = w; }
    }
};

struct Frame {
    LAS unsigned char* lds; unsigned char* ldsg;
    int tid, lane, wave, G, bid;
    const float* const* in; float* out; unsigned char* ws;
};
enum { I_XP = 0, I_XS, I_CDK, I_CDV, I_CFK, I_CFV, I_CFL, I_CP, I_CS, I_WADA, I_BADA, I_WIN, I_BF, I_LQ1, I_LK1, I_LQ2, I_LK2, I_SUBG, I_RELB, I_WA, I_WB, I_WO, I_LN1G, I_LN1B, I_LN2G, I_LN2B, I_WFI, I_WFO };

__device__ __forceinline__ void tr_item(const float* W, int ldw, int src_n0, int k0, bf16_t* WT, int ldt, int dst_row0, int dst_k0, int dup_off, LAS float* scr, int lane) {
#pragma unroll 8
    for (int i = 0; i < 32; ++i) { const int kk = 2 * i + (lane >> 5); scr[kk * 33 + (lane & 31)] = W[(size_t)(k0 + kk) * ldw + src_n0 + (lane & 31)]; }
    asm volatile("s_waitcnt lgkmcnt(0)" ::: "memory");
    const int c = lane & 7;
#pragma unroll
    for (int j = 0; j < 4; ++j) { const int n = (lane >> 3) + 8 * j; const LAS float* s = scr + (8 * c) * 33 + n;
        u32x4 o; o.x = pk2(s[0 * 33], s[1 * 33]); o.y = pk2(s[2 * 33], s[3 * 33]); o.z = pk2(s[4 * 33], s[5 * 33]); o.w = pk2(s[6 * 33], s[7 * 33]);
        bf16_t* d = WT + (size_t)(dst_row0 + n) * ldt + dst_k0 + 8 * c;
        *(u32x4*)d = o; if (dup_off) *(u32x4*)(d + dup_off) = o; }
    asm volatile("s_waitcnt lgkmcnt(0)" ::: "memory");
}
__device__ __forceinline__ void weight_copies(Frame& F, int c, int n, int it0, int it1) {
    LAS float* scr = (LAS float*)(F.lds + F.wave * 16384);
    const int gw = c * 8 + F.wave, NGW = n * 8;
    constexpr int I_IN = 16 * (NZ / 32), I_A = 8 * 32, I_B = 8 * 32, I_O = 16 * 32, I_FI = 16 * (NFF2 / 32), I_FO = (DFF / 64) * 32;
    for (int it = it0 + gw; it < it1; it += NGW) {
        int r = it;
        if (r < I_IN) { const int nb = NZ / 32, kb = r / nb, n0 = 32 * (r % nb); tr_item(F.in[I_WIN], WIN_COLS, n0 < 3072 ? n0 : n0 + 8, 64 * kb, (bf16_t*)(F.ws + WS_WIN), 1024, n0, 64 * kb, 0, scr, F.lane); continue; } r -= I_IN;
        if (r < I_A) { const int kb = r / 32, n0 = 32 * (r % 32); tr_item(F.in[I_WA], 1024, n0, 64 * kb, (bf16_t*)(F.ws + WS_WAB), 512, n0, 64 * kb, 0, scr, F.lane); continue; } r -= I_A;
        if (r < I_B) { const int kb = r / 32, n0 = 32 * (r % 32); tr_item(F.in[I_WB], 1024, n0, 64 * kb, (bf16_t*)(F.ws + WS_WAB), 512, 1024 + n0, 64 * kb, 0, scr, F.lane); continue; } r -= I_B;
        if (r < I_O) { const int kb = r / 32, n0 = 32 * (r % 32); tr_item(F.in[I_WO], 1024, n0, 64 * kb, (bf16_t*)(F.ws + WS_WO2), 2048, n0, 64 * kb, 1024, scr, F.lane); continue; } r -= I_O;
        if (r < I_FI) { const int nb = NFF2 / 32, kb = r / nb, n0 = 32 * (r % nb), t = n0 >> 8, j = n0 & 255; const int src = j < 128 ? 128 * t + j : DFF + 128 * t + (j - 128);
            tr_item(F.in[I_WFI], NFF2, src, 64 * kb, (bf16_t*)(F.ws + WS_WFI), 1024, n0, 64 * kb, 0, scr, F.lane); continue; } r -= I_FI;
        { const int kb = r / 32, n0 = 32 * (r % 32); tr_item(F.in[I_WFO], 1024, n0, 64 * kb, (bf16_t*)(F.ws + WS_WFO), DFF, n0, 64 * kb, 0, scr, F.lane); }
    }
}
constexpr int WC_IN = 16 * (NZ / 32), WC_ALL = WC_IN + 8 * 32 + 8 * 32 + 16 * 32 + 16 * (NFF2 / 32) + (DFF / 64) * 32;
__device__ __forceinline__ void p0_prologue(Frame& F) {
    if (F.bid < 96) {
        LAS float* sc = (LAS float*)F.lds;
        LAS float* part = sc + 17 * 1024;
        const int n = F.bid * 64 + F.lane; const float* wa = F.in[I_WADA] + n + (size_t)(F.wave * 128) * 6144;
        float w[32];
#pragma unroll
        for (int j = 0; j < 32; ++j) w[j] = wa[(size_t)j * 6144];
        { float cv[34];
#pragma unroll
          for (int j = 0; j < 34; ++j) { const int i = F.tid + 512 * j, r = i >> 10, k = i & 1023; cv[j] = r == 0 ? F.in[I_CP][k] : F.in[I_CS][(r - 1) * 1024 + k]; }
#pragma unroll
          for (int j = 0; j < 34; ++j) sc[F.tid + 512 * j] = siluf_(cv[j]); }
        __syncthreads();
        float acc[17];
#pragma unroll
        for (int r = 0; r < 17; ++r) acc[r] = 0.f;
#pragma unroll
        for (int kb = 0; kb < 128; kb += 32) {
            float wn[32];
            if (kb + 32 < 128) {
#pragma unroll
                for (int j = 0; j < 32; ++j) wn[j] = wa[(size_t)(kb + 32 + j) * 6144]; }
#pragma unroll
            for (int j = 0; j < 32; j += 4) { const int k = F.wave * 128 + kb + j;
#pragma unroll
                for (int r = 0; r < 17; ++r) { const f32x4 s = *(const LAS f32x4*)(sc + r * 1024 + k); acc[r] += s[0] * w[j] + s[1] * w[j + 1] + s[2] * w[j + 2] + s[3] * w[j + 3]; } }
            if (kb + 32 < 128) {
#pragma unroll
                for (int j = 0; j < 32; ++j) w[j] = wn[j]; }
        }
#pragma unroll
        for (int r = 0; r < 17; ++r) part[(F.wave * 17 + r) * 64 + F.lane] = acc[r];
        __syncthreads();
        float* mod = (float*)(F.ws + WS_MOD);
        for (int i = F.tid; i < 17 * 64; i += 512) { const int r = i >> 6, l = i & 63; float s = 0.f;
#pragma unroll
            for (int w = 0; w < 8; ++w) s += part[(w * 17 + r) * 64 + l];
            mod[r * 6144 + F.bid * 64 + l] = s + F.in[I_BADA][F.bid * 64 + l]; }
        asm volatile("s_waitcnt vmcnt(0)" ::: "memory");
        __syncthreads();
        if (F.tid == 0) { __builtin_amdgcn_fence(__ATOMIC_RELEASE, "agent"); asm volatile("s_waitcnt vmcnt(0)" ::: "memory");
            __hip_atomic_fetch_add((unsigned*)(F.ws + WS_CTL) + 320, 1u, __ATOMIC_RELAXED, __HIP_MEMORY_SCOPE_AGENT); }
    }
    if (F.G >= 192) { if (F.bid >= 96) weight_copies(F, F.bid - 96, F.G - 96, 0, 16 * (NZ / 32)); }
    else weight_copies(F, F.bid, F.G, 0, 16 * (NZ / 32));
}

__device__ __forceinline__ void p1_rows(Frame& F, bool wait_mod) {
    LAS float* wf = (LAS float*)F.lds;
    for (int i = F.tid; i < 1024 * 8; i += 512) wf[i] = F.in[I_WIN][(size_t)(i >> 3) * WIN_COLS + 3072 + (i & 7)];
    __syncthreads();
    const float* mod = (const float*)(F.ws + WS_MOD);
    bf16_t* XN = (bf16_t*)(F.ws + WS_XN);
    const int gw = F.bid * 8 + F.wave, NGW = F.G * 8;
    if (wait_mod) {
        if (F.tid == 0) { unsigned* w = (unsigned*)(F.ws + WS_CTL) + 320; unsigned sp = 0;
            while (__hip_atomic_load(w, __ATOMIC_RELAXED, __HIP_MEMORY_SCOPE_AGENT) < 96u && ++sp < (1u << 22)) __builtin_amdgcn_s_sleep(2);
            __builtin_amdgcn_fence(__ATOMIC_ACQUIRE, "agent"); asm volatile("s_waitcnt vmcnt(0)" ::: "memory"); }
        __syncthreads(); }
    int m = gw;
    for (; m + NGW < SEQ; m += 2 * NGW) {
        const float* xr0 = F.in[I_XP] + (size_t)m * DM; const float* xr1 = xr0 + (size_t)NGW * DM;
        float a8[2][8];
#pragma unroll
        for (int j = 0; j < 8; ++j) { a8[0][j] = 0.f; a8[1][j] = 0.f; }
#pragma unroll
        for (int j = 0; j < 4; ++j) { const int k = 4 * F.lane + 256 * j;
            const f32x4 x0 = *(const f32x4*)(xr0 + k), x1 = *(const f32x4*)(xr1 + k), s1 = *(const f32x4*)(mod + 1024 + k), t1 = *(const f32x4*)(mod + k);
            const f32x4 h0 = x0 * (s1 + 1.0f) + t1, h1 = x1 * (s1 + 1.0f) + t1;
            u32x2 w; w.x = pk2(h0[0], h0[1]); w.y = pk2(h0[2], h0[3]); *(u32x2*)(XN + (size_t)m * DM + k) = w;
            w.x = pk2(h1[0], h1[1]); w.y = pk2(h1[2], h1[3]); *(u32x2*)(XN + (size_t)(m + NGW) * DM + k) = w;
#pragma unroll
            for (int e = 0; e < 4; ++e) { const f32x4 wa = *(const LAS f32x4*)(wf + (k + e) * 8), wb = *(const LAS f32x4*)(wf + (k + e) * 8 + 4);
#pragma unroll
                for (int c = 0; c < 4; ++c) { a8[0][c] += h0[e] * wa[c]; a8[0][4 + c] += h0[e] * wb[c]; a8[1][c] += h1[e] * wa[c]; a8[1][4 + c] += h1[e] * wb[c]; } } }
        float mine = 0.f;
#pragma unroll
        for (int j = 0; j < 8; ++j) { const float s0 = wave_sum(a8[0][j]), s1 = wave_sum(a8[1][j]); if (F.lane == j) mine = s0; if (F.lane == 8 + j) mine = s1; }
        if (F.lane < 16) { const int rr = F.lane >> 3, c = F.lane & 7; const float v = mine + F.in[I_BF][c]; const float lf = fminf(v, 0.f) - log1pf(__expf(-fabsf(v)));
            F.out[O_FLP + (size_t)(m + rr * NGW) * 8 + c] = lf; }
    }
    for (; m < MT; m += NGW) {
        const bool smp = m >= SEQ; const int rb = smp ? 1 + ((m - SEQ) >> 4) : 0;
        const float* xr = smp ? F.in[I_XS] + (size_t)(m - SEQ) * DM : F.in[I_XP] + (size_t)m * DM;
        const float* sh = mod + (size_t)rb * 6144, *scl = sh + 1024;
        float a8[8];
#pragma unroll
        for (int j = 0; j < 8; ++j) a8[j] = 0.f;
#pragma unroll
        for (int j = 0; j < 4; ++j) { const int k = 4 * F.lane + 256 * j;
            const f32x4 x = *(const f32x4*)(xr + k), s1 = *(const f32x4*)(scl + k), t1 = *(const f32x4*)(sh + k);
            const f32x4 h = x * (s1 + 1.0f) + t1;
            u32x2 w; w.x = pk2(h[0], h[1]); w.y = pk2(h[2], h[3]); *(u32x2*)(XN + (size_t)m * DM + k) = w;
#pragma unroll
            for (int e = 0; e < 4; ++e) { const f32x4 wa = *(const LAS f32x4*)(wf + (k + e) * 8), wb = *(const LAS f32x4*)(wf + (k + e) * 8 + 4);
                a8[0] += h[e] * wa[0]; a8[1] += h[e] * wa[1]; a8[2] += h[e] * wa[2]; a8[3] += h[e] * wa[3];
                a8[4] += h[e] * wb[0]; a8[5] += h[e] * wb[1]; a8[6] += h[e] * wb[2]; a8[7] += h[e] * wb[3]; } }
        float mine = 0.f;
#pragma unroll
        for (int j = 0; j < 8; ++j) { const float s = wave_sum(a8[j]); if (F.lane == j) mine = s; }
        if (F.lane < 8) { const float v = mine + F.in[I_BF][F.lane]; const float lf = fminf(v, 0.f) - log1pf(__expf(-fabsf(v)));
            float* o = smp ? F.out + O_FLS + (size_t)(m - SEQ) * 8 : F.out + O_FLP + (size_t)m * 8; o[F.lane] = lf; }
    }
}

__device__ __forceinline__ float block_excl_scan(Frame& F, float tot, LAS float* sm) {
    float inc = tot;
#pragma unroll
    for (int o = 1; o < 64; o <<= 1) { const float t = __shfl_up(inc, o); if (F.lane >= o) inc += t; }
    if (F.lane == 63) sm[F.wave] = inc;
    __syncthreads();
    float base = 0.f;
    for (int w = 0; w < F.wave; ++w) base += sm[w];
    __syncthreads();
    return base + inc - tot;
}
__device__ __forceinline__ void p2_cumsum(Frame& F) {
    LAS float* sm = (LAS float*)F.lds;
    const int rb_ = F.G >= 160 ? F.bid - 20 : F.bid;
    if (rb_ < 0) return;
    if (rb_ < 8) {
        const int h = rb_; const float* lf = F.out + O_FLP; float* Fp = (float*)(F.ws + WS_FP) + (size_t)h * SEQ;
        float v[32]; float run = 0.f;
#pragma unroll
        for (int i = 0; i < 32; ++i) { run += lf[(size_t)(32 * F.tid + i) * 8 + h]; v[i] = run; }
        const float off = block_excl_scan(F, run, sm);
#pragma unroll
        for (int i = 0; i < 32; i += 4) *(f32x4*)(Fp + 32 * F.tid + i) = (f32x4){(off + v[i]) * LOG2E, (off + v[i + 1]) * LOG2E, (off + v[i + 2]) * LOG2E, (off + v[i + 3]) * LOG2E};
    } else if (rb_ < 8 + 128) {
        const int b = (rb_ - 8) >> 3, h = (rb_ - 8) & 7;
        const float* cl = F.in[I_CFL] + (size_t)b * PAST * 8; float* Fs = (float*)(F.ws + WS_FS) + (size_t)(b * 8 + h) * SKV;
        float v[4]; float run = 0.f;
#pragma unroll
        for (int i = 0; i < 4; ++i) { run += cl[(size_t)(4 * F.tid + i) * 8 + h]; v[i] = run; }
        const float off = block_excl_scan(F, run, sm);
        *(f32x4*)(Fs + 4 * F.tid) = (f32x4){(off + v[0]) * LOG2E, (off + v[1]) * LOG2E, (off + v[2]) * LOG2E, (off + v[3]) * LOG2E};
        if (F.tid == 511) { float r2 = off + run; const float* ls = F.out + O_FLS + (size_t)b * DEC_T * 8;
            for (int t = 0; t < DEC_T; ++t) { r2 += ls[t * 8 + h]; Fs[PAST + t] = r2 * LOG2E; } }
    }
}

template <bool FINAL> __device__ __forceinline__ void ln_rows(Frame& F, const float* g, const float* b, int KS, int gate_off) {
    const float* mod = (const float*)(F.ws + WS_MOD);
    const bf16_t* T = (const bf16_t*)(F.ws + WS_TB); bf16_t* X1B = (bf16_t*)(F.ws + WS_X1B); bf16_t* XN = (bf16_t*)(F.ws + WS_XN);
    const int gw = F.wave * F.G + F.bid, NGW = F.G * 8;
    for (int m = SEQ + gw; m < MT; m += NGW) {
        f32x4 v[4]; float s = 0.f;
        if (m < SEQ) {
#pragma unroll
            for (int j = 0; j < 2; ++j) { const u32x4 w = *(const u32x4*)(T + (size_t)m * DM + 8 * F.lane + 512 * j);
                v[2 * j] = (f32x4){bflo(w.x), bfhi(w.x), bflo(w.y), bfhi(w.y)}; v[2 * j + 1] = (f32x4){bflo(w.z), bfhi(w.z), bflo(w.w), bfhi(w.w)}; }
        } else {
            const float* sl = (const float*)(F.ws + WS_SLAB) + (size_t)(m - SEQ) * DM; const float* gp = mod + (size_t)(1 + ((m - SEQ) >> 4)) * 6144 + gate_off;
#pragma unroll
            for (int q = 0; q < 4; ++q) { const int k = 8 * F.lane + 512 * (q >> 1) + 4 * (q & 1); f32x4 a = (f32x4){0.f, 0.f, 0.f, 0.f};
                { constexpr int KSC = FINAL ? 11 : 8; f32x4 sv[KSC];
#pragma unroll
                  for (int ks = 0; ks < KSC; ++ks) sv[ks] = *(const f32x4*)(sl + (size_t)ks * NSMP * DM + k);
#pragma unroll
                  for (int ks = 0; ks < KSC; ++ks) a += sv[ks]; }
                f32x4 bs;
                if (FINAL) { const u32x2 w = *(const u32x2*)(X1B + (size_t)m * DM + k); bs = (f32x4){bflo(w.x), bfhi(w.x), bflo(w.y), bfhi(w.y)}; }
                else bs = *(const f32x4*)(F.in[I_XS] + (size_t)(m - SEQ) * DM + k);
                v[q] = bs * ALPHA + *(const f32x4*)(gp + k) * a; } }
#pragma unroll
        for (int q = 0; q < 4; ++q) s += (v[q][0] + v[q][1]) + (v[q][2] + v[q][3]);
        const float mean = wave_sum(s) * (1.f / DM); float s2 = 0.f;
#pragma unroll
        for (int q = 0; q < 4; ++q) { v[q] = v[q] - mean; s2 += (v[q][0] * v[q][0] + v[q][1] * v[q][1]) + (v[q][2] * v[q][2] + v[q][3] * v[q][3]); }
        const float rstd = 1.f / sqrtf(wave_sum(s2) * (1.f / DM) + LN_EPS);
        const int rb = m >= SEQ ? 1 + ((m - SEQ) >> 4) : 0;
#pragma unroll
        for (int q = 0; q < 4; ++q) { const int k = 8 * F.lane + 512 * (q >> 1) + 4 * (q & 1); const f32x4 gg = *(const f32x4*)(g + k), bb = *(const f32x4*)(b + k);
            const f32x4 y = v[q] * rstd * gg + bb;
            if (FINAL) *(f32x4*)(F.out + (size_t)m * DM + k) = y;
            else { u32x2 w; w.x = pk2(y[0], y[1]); w.y = pk2(y[2], y[3]); *(u32x2*)(X1B + (size_t)m * DM + k) = w;
                const f32x4 s2v = *(const f32x4*)(mod + (size_t)rb * 6144 + 4096 + k), t2v = *(const f32x4*)(mod + (size_t)rb * 6144 + 3072 + k);
                const f32x4 h = y * (s2v + 1.0f) + t2v; u32x2 w2; w2.x = pk2(h[0], h[1]); w2.y = pk2(h[2], h[3]); *(u32x2*)(XN + (size_t)m * DM + k) = w2; } }
    }
}

__device__ __forceinline__ int t5_bucket(int rel) {
    const int n = rel < 0 ? -rel : rel; int b;
    if (n < 8) b = n; else if (n < 12) b = 8; else if (n < 16) b = 9; else if (n < 23) b = 10; else if (n < 32) b = 11; else if (n < 46) b = 12; else if (n < 64) b = 13; else if (n < 91) b = 14; else b = 15;
    return b + (rel > 0 ? 16 : 0);
}
constexpr int AT_KB = 8192, AT_VB = 20480, AT_BUF = AT_KB + AT_VB;
constexpr int AT_WS = 2 * AT_BUF, AT_OST = AT_WS + 2048, AT_KEEP = 98304, AT_TAB = 131072, AT_MISC = AT_TAB + 4 * 192 * 4, AT_END = AT_MISC + 64;
__device__ __forceinline__ s16x4 vtr(const LAS char* p) { typedef short v4i16_t __attribute__((ext_vector_type(4))); return __builtin_bit_cast(s16x4, __builtin_amdgcn_ds_read_tr16_b64_v4i16((LAS v4i16_t*)p)); }

typedef __bf16 bf16x2_t_ __attribute__((ext_vector_type(2)));
__device__ __forceinline__ unsigned cvtpk_(float lo, float hi) { f32x2 v = {lo, hi}; bf16x2_t_ b = __builtin_convertvector(v, bf16x2_t_); return __builtin_bit_cast(unsigned, b); }
__device__ __forceinline__ void glds16_asm(const void* gsrc, unsigned lds_dst) { unsigned keep;
    asm volatile("s_mov_b32 %0, m0\n\ts_mov_b32 m0, %2\n\ts_nop 0\n\tglobal_load_lds_dwordx4 %1, off\n\ts_mov_b32 m0, %0" : "=&s"(keep) : "v"(gsrc), "s"(lds_dst) : "memory"); }
template <int OFF> __device__ __forceinline__ void glds16_asm_off(const void* gsrc, unsigned lds_dst) { unsigned keep;
    asm volatile("s_mov_b32 %0, m0\n\ts_mov_b32 m0, %2\n\ts_nop 0\n\tglobal_load_lds_dwordx4 %1, off offset:%3\n\ts_mov_b32 m0, %0" : "=&s"(keep) : "v"(gsrc), "s"(lds_dst), "i"(OFF) : "memory"); }
template <int OFF> __device__ __forceinline__ void glds16_s(const void* sbase, unsigned voff, unsigned lds_dst) { unsigned keep;
    asm volatile("s_mov_b32 %0, m0\n\ts_mov_b32 m0, %3\n\ts_nop 0\n\tglobal_load_lds_dwordx4 %1, %2 offset:%4\n\ts_mov_b32 m0, %0" : "=&s"(keep) : "v"(voff), "s"(sbase), "s"(lds_dst), "i"(OFF) : "memory"); }
__device__ __forceinline__ void glds4_s(const void* sbase, unsigned voff, unsigned lds_dst) { unsigned keep;
    asm volatile("s_mov_b32 %0, m0\n\ts_mov_b32 m0, %3\n\ts_nop 0\n\tglobal_load_lds_dword %1, %2\n\ts_mov_b32 m0, %0" : "=&s"(keep) : "v"(voff), "s"(sbase), "s"(lds_dst) : "memory"); }
__device__ __forceinline__ const void* uniform_ptr(const void* p) { const unsigned long long v = (unsigned long long)p;
    const unsigned lo = (unsigned)__builtin_amdgcn_readfirstlane((int)(unsigned)v), hi = (unsigned)__builtin_amdgcn_readfirstlane((int)(unsigned)(v >> 32)); return (const void*)(((unsigned long long)hi << 32) | lo); }
__device__ __forceinline__ void glds4_asm(const void* gsrc, unsigned lds_dst) { unsigned keep;
    asm volatile("s_mov_b32 %0, m0\n\ts_mov_b32 m0, %2\n\ts_nop 0\n\tglobal_load_lds_dword %1, off\n\ts_mov_b32 m0, %0" : "=&s"(keep) : "v"(gsrc), "s"(lds_dst) : "memory"); }
constexpr int R_V = 0, R_K = 49152, R_F = 73728, R_WS = 79872;
__device__ __forceinline__ float max3f_(float a, float b, float c) { float r; asm("v_max3_f32 %0, %1, %2, %3" : "=v"(r) : "v"(a), "v"(b), "v"(c)); return r; }
__device__ __forceinline__ float max2f_(float a, float b) { float r; asm("v_max_f32_e32 %0, %1, %2" : "=v"(r) : "v"(a), "v"(b)); return r; }
#define AP3_PIN(x) asm volatile("" : "+v"(x))
template <int MODE, int DV, int pv = 0, bool SREF = false>
__device__ __forceinline__ void attn_pass3(Frame& F, const bf16_t* Q, const bf16_t* K, const bf16_t* V, int q0, int NT, const float* Fh, int hb, f32x16 (&o)[DV / 32], int t0 = 0) {
    constexpr int NDB = DV / 32, VS = DV * 128, EPG = 8 / NDB;
    constexpr float THR = 8.0f;
    const int lane = F.lane, r32 = lane & 31, hi = lane >> 5, wid = F.wave;
    const LAS char* lds = (const LAS char*)F.lds;
    LAS float* wsf = (LAS float*)(F.lds + R_WS) + wid * 64;
    const LAS float* tab = (const LAS float*)(F.lds + AT_TAB) + hb * 192;
    const int qrow = q0 + wid * 32 + r32;
    const int tmaxw = (q0 >> 6) + (wid >> 1);
    const char* Ku = (const char*)uniform_ptr(K); const char* Vu = (const char*)uniform_ptr(V); const char* Fu = (const char*)uniform_ptr(MODE == 0 ? (const void*)Fh : (const void*)K);
    const unsigned kvo = (unsigned)(((8 * wid + (lane >> 3)) * 512 + (((lane & 7) ^ (lane >> 3)) << 3)) * 2);
    const unsigned vvo = (unsigned)(((16 * (wid & 3) + (lane >> 2)) * 512 + 32 * (wid >> 2) + 8 * (lane & 3)) * 2);
    const unsigned fvo = (unsigned)(lane * 4);
    const unsigned lds0 = (unsigned)(size_t)F.lds;
    const unsigned dk = (unsigned)__builtin_amdgcn_readfirstlane((int)(lds0 + R_K + wid * 1024)), dv = (unsigned)__builtin_amdgcn_readfirstlane((int)(lds0 + R_V + wid * 1024)),
                   df = (unsigned)__builtin_amdgcn_readfirstlane((int)(lds0 + R_F + wid * 256));
#define AP_ISSUE_K(t, SL) do { glds16_s<0>(Ku + (size_t)(t) * 65536, kvo, dk + (SL) * 8192); if (MODE == 0) glds4_s(Fu + (size_t)(t) * 256, fvo, df + (SL) * 2048); } while (0)
#define AP_ISSUE_V(t, SL) do { glds16_s<0>(Vu + (size_t)(t) * 65536, vvo, dv + (SL) * VS); if (DV == 128) glds16_s<0>(Vu + (size_t)(t) * 65536 + 128, vvo, dv + (SL) * VS + 8192); } while (0)
#define AP_BATCH(t, SL) do { if (pv != 1) { if ((t) + 2 < NT) AP_ISSUE_K((t) + 2, ((SL) + 2) % 3); if ((t) + 1 < NT) AP_ISSUE_V((t) + 1, ((SL) + 1) % 3); } } while (0)
    AP_ISSUE_K(t0, 0); AP_ISSUE_K(t0 + 1, 1); AP_ISSUE_V(t0, 0);
    bf16x8 qr[4];
#pragma unroll
    for (int d0 = 0; d0 < 4; ++d0) qr[d0] = *(const bf16x8*)(Q + (size_t)qrow * 512 + d0 * 16 + hi * 8);
    float fqp = MODE == 0 ? Fh[qrow] : 0.f;
#pragma unroll
    for (int d = 0; d < NDB; ++d) o[d] = f32x16{};
    float m_hat = 0.f, l_run = 0.f;
    f32x16 p0, p1, negm; u32x4 pwv[4];
#pragma unroll
    for (int r = 0; r < 16; ++r) negm[r] = 0.f;
#pragma unroll
    for (int i = 0; i < 4; ++i) pwv[i] = (u32x4){0u, 0u, 0u, 0u};
    const LAS char* kb4[4];
#pragma unroll
    for (int d0 = 0; d0 < 4; ++d0) kb4[d0] = lds + R_K + r32 * 128 + (((2 * d0 + hi) ^ (r32 & 7)) << 4);
    const LAS char* vb1 = lds + R_V + (4 * hi + ((lane & 15) >> 2)) * 64 + (((lane >> 4) & 1) * 16 + (lane & 3) * 4) * 2;
    const LAS char* fb1 = lds + R_F + wid * 256 + 16 * hi;
    asm volatile("s_waitcnt vmcnt(0)" ::: "memory");
    asm volatile("" : "+v"(qr[0]), "+v"(qr[1]), "+v"(qr[2]), "+v"(qr[3]), "+v"(fqp));
    asm volatile("s_waitcnt lgkmcnt(0)\n\ts_barrier" ::: "memory");
#define AP3_VFL(buf, ks, SLV) do { _Pragma("unroll") for (int d = 0; d < NDB; ++d) { buf[2 * d] = vtr(vb1 + (SLV) * VS + d * 4096 + (ks) * 1024); buf[2 * d + 1] = vtr(vb1 + (SLV) * VS + d * 4096 + (ks) * 1024 + 512); } } while (0)
#define AP3_VFL1(buf, d, ks, SLV) do { buf[2 * (d)] = vtr(vb1 + (SLV) * VS + (d) * 4096 + (ks) * 1024); buf[2 * (d) + 1] = vtr(vb1 + (SLV) * VS + (d) * 4096 + (ks) * 1024 + 512); } while (0)
#define AP3_FRAG(buf, d) ((bf16x8){buf[2 * (d)][0], buf[2 * (d)][1], buf[2 * (d)][2], buf[2 * (d)][3], buf[2 * (d) + 1][0], buf[2 * (d) + 1][1], buf[2 * (d) + 1][2], buf[2 * (d) + 1][3]})
#define AP3_GAP(ks, d, VCUR, VNXT, PC, BC, PP, BP, HASPREV, HASNEXT, SLV) do { \
        o[d] = __builtin_amdgcn_mfma_f32_32x32x16_bf16(__builtin_bit_cast(bf16x8, pwv[ks]), AP3_FRAG(VCUR, d), o[d], 0, 0, 0); \
        if (HASNEXT) AP3_VFL1(VNXT, d, (ks) + 1, SLV); \
        _Pragma("unroll") for (int e = 0; e < EPG; ++e) { PC[(BC) + EPG * (d) + e] = __builtin_amdgcn_exp2f(PC[(BC) + EPG * (d) + e]); } \
        if (HASPREV) { _Pragma("unroll") for (int e = 0; e < EPG; ++e) rs += PP[(BP) + EPG * (d) + e]; \
            _Pragma("unroll") for (int e = 0; e < EPG / 2; ++e) pwv[(ks) - 1][(EPG / 2) * (d) + e] = cvtpk_(PP[(BP) + EPG * (d) + 2 * e], PP[(BP) + EPG * (d) + 2 * e + 1]); AP3_PIN(rs); } \
        AP3_PIN(PC); \
        __builtin_amdgcn_sched_barrier(0); } while (0)
#define AP3_GROUP(ks, VCUR, VNXT, PC, BC, PP, BP, HASPREV, HASNEXT, SLV) do { _Pragma("unroll") for (int d = 0; d < NDB; ++d) AP3_GAP(ks, d, VCUR, VNXT, PC, BC, PP, BP, HASPREV, HASNEXT, SLV); } while (0)
#define AP3_OCT(PC, BC, KS) do { _Pragma("unroll") for (int e = 0; e < 8; ++e) { PC[(BC) + e] = __builtin_amdgcn_exp2f(PC[(BC) + e]); rs += PC[(BC) + e]; } \
        _Pragma("unroll") for (int e = 0; e < 4; ++e) pwv[KS][e] = cvtpk_(PC[(BC) + 2 * e], PC[(BC) + 2 * e + 1]); } while (0)
#define AP3_KRD(i, SL) (*(const LAS bf16x8*)(kb4[(i) >> 1] + (SL) * 8192 + ((i) & 1) * 4096))
#define AP3_MM(KF, d0, P) P = __builtin_amdgcn_mfma_f32_32x32x16_bf16(KF, qr[d0], P, 0, 0, 0)
#define AP3_QKF(SL) do { bf16x8 ka = AP3_KRD(0, SL), kb = AP3_KRD(1, SL), kc = AP3_KRD(2, SL); \
        if (MODE == 0) { \
            _Pragma("unroll") for (int g4 = 0; g4 < 4; ++g4) { const f32x4 fa = *(const LAS f32x4*)(fb1 + (SL) * 2048 + 32 * g4), fb = *(const LAS f32x4*)(fb1 + (SL) * 2048 + 128 + 32 * g4); \
                _Pragma("unroll") for (int e = 0; e < 4; ++e) { p0[4 * g4 + e] = fqp - fa[e]; p1[4 * g4 + e] = fqp - fb[e]; } } \
        } else { p0 = f32x16{}; p1 = f32x16{}; } \
        __builtin_amdgcn_sched_barrier(0); \
        AP3_MM(ka, 0, p0); ka = AP3_KRD(3, SL); __builtin_amdgcn_sched_barrier(0); \
        AP3_MM(kb, 0, p1); kb = AP3_KRD(4, SL); __builtin_amdgcn_sched_barrier(0); \
        AP3_MM(kc, 1, p0); kc = AP3_KRD(5, SL); __builtin_amdgcn_sched_barrier(0); \
        AP3_MM(ka, 1, p1); ka = AP3_KRD(6, SL); __builtin_amdgcn_sched_barrier(0); \
        AP3_MM(kb, 2, p0); kb = AP3_KRD(7, SL); __builtin_amdgcn_sched_barrier(0); \
        AP3_MM(kc, 2, p1); __builtin_amdgcn_sched_barrier(0); \
        AP3_MM(ka, 3, p0); __builtin_amdgcn_sched_barrier(0); \
        AP3_MM(kb, 3, p1); \
        asm volatile("" : "+v"(p0), "+v"(p1)); \
    } while (0)
#define AP3_QKS(SL) do { bf16x8 kf[8]; \
        _Pragma("unroll") for (int d0 = 0; d0 < 4; ++d0) { kf[2 * d0] = *(const LAS bf16x8*)(kb4[d0] + (SL) * 8192); kf[2 * d0 + 1] = *(const LAS bf16x8*)(kb4[d0] + (SL) * 8192 + 4096); } \
        if (MODE == 0) { const float sft = fqp - m_hat; \
            _Pragma("unroll") for (int g4 = 0; g4 < 4; ++g4) { const f32x4 fa = *(const LAS f32x4*)(fb1 + (SL) * 2048 + 32 * g4), fb = *(const LAS f32x4*)(fb1 + (SL) * 2048 + 128 + 32 * g4); \
                _Pragma("unroll") for (int e = 0; e < 4; ++e) { p0[4 * g4 + e] = sft - fa[e]; p1[4 * g4 + e] = sft - fb[e]; } } \
            _Pragma("unroll") for (int d0 = 0; d0 < 4; ++d0) { p0 = __builtin_amdgcn_mfma_f32_32x32x16_bf16(kf[2 * d0], qr[d0], p0, 0, 0, 0); p1 = __builtin_amdgcn_mfma_f32_32x32x16_bf16(kf[2 * d0 + 1], qr[d0], p1, 0, 0, 0); } \
        } else { \
            if constexpr (SREF) { p0 = __builtin_amdgcn_mfma_f32_32x32x16_bf16(kf[0], qr[0], f32x16{}, 0, 0, 0); p1 = __builtin_amdgcn_mfma_f32_32x32x16_bf16(kf[1], qr[0], f32x16{}, 0, 0, 0); } \
            else { p0 = __builtin_amdgcn_mfma_f32_32x32x16_bf16(kf[0], qr[0], negm, 0, 0, 0); p1 = __builtin_amdgcn_mfma_f32_32x32x16_bf16(kf[1], qr[0], negm, 0, 0, 0); } \
            _Pragma("unroll") for (int d0 = 1; d0 < 4; ++d0) { p0 = __builtin_amdgcn_mfma_f32_32x32x16_bf16(kf[2 * d0], qr[d0], p0, 0, 0, 0); p1 = __builtin_amdgcn_mfma_f32_32x32x16_bf16(kf[2 * d0 + 1], qr[d0], p1, 0, 0, 0); } } \
        if constexpr (SREF) asm volatile("" : "+v"(p0), "+v"(p1)); else asm volatile("s_nop 15\n\ts_nop 7" : "+v"(p0), "+v"(p1));     \
    } while (0)
#define AP3_QK(SL) do { if constexpr (SREF) AP3_QKF(SL); else AP3_QKS(SL); } while (0)
#define AP3_DECIDE(WITH_TAB) do { \
        if (MODE == 0) { \
            if (t * 64 + 63 > q0 + wid * 32) { const int ln_ = lane_id_opaque(), kv0 = t * 64 + 4 * (ln_ >> 5), qrow_ = q0 + wid * 32 + (ln_ & 31);     \
                _Pragma("unroll") for (int r = 0; r < 16; ++r) { const int kv = kv0 + (r & 3) + 8 * (r >> 2); if (kv > qrow_) p0[r] = -1e30f; if (kv + 32 > qrow_) p1[r] = -1e30f; } } \
        } else if (WITH_TAB) { \
            if (near) { const int ln_ = lane_id_opaque(), kv0 = t * 64 + 4 * (ln_ >> 5), qrow_ = q0 + wid * 32 + (ln_ & 31); const LAS float* tab_ = (const LAS float*)(F.lds + AT_TAB) + hb * 192; \
                _Pragma("unroll") for (int g4 = 0; g4 < 4; ++g4) { \
                    _Pragma("unroll") for (int e = 0; e < 4; ++e) { const int r = 4 * g4 + e; const int rel = kv0 + e + 8 * g4 - qrow_; int i0 = rel + 128, i1 = rel + 160; i0 = i0 < 0 ? 0 : i0; i1 = i1 < 0 ? 0 : i1; \
                        p0[r] += tab_[i0]; p1[r] += tab_[i1]; } \
                    __builtin_amdgcn_sched_barrier(0); } } } \
        if constexpr (!SREF) { \
        float ma = max3f_(p0[0], p0[1], p1[0]), mb = max3f_(p0[2], p0[3], p1[1]); ma = max3f_(ma, p1[2], p1[3]); \
        _Pragma("unroll") for (int r = 4; r < 16; r += 4) { ma = max3f_(ma, p0[r], p0[r + 1]); mb = max3f_(mb, p0[r + 2], p0[r + 3]); ma = max3f_(ma, p1[r], p1[r + 1]); mb = max3f_(mb, p1[r + 2], p1[r + 3]); } \
        float rm = max2f_(ma, mb); \
        { auto rr = __builtin_amdgcn_permlane32_swap(__float_as_uint(rm), __float_as_uint(rm), false, false); rm = max2f_(__uint_as_float(rr[0]), __uint_as_float(rr[1])); } \
        resc = (tz == t0) || __any(rm > THR); \
        if (resc) { const float dl = tz == t0 ? rm : fmaxf(rm, 0.f); m_hat += dl; \
            _Pragma("unroll") for (int r = 0; r < 16; ++r) { p0[r] -= dl; p1[r] -= dl; } \
            if (MODE == 1) { const float nm_ = -m_hat; _Pragma("unroll") for (int r = 0; r < 16; ++r) negm[r] = nm_; } \
            al = tz == t0 ? 1.0f : __builtin_amdgcn_exp2f(-dl); l_run *= al; } } } while (0)
#define AP3_STEP(tt, SL) do { const int t = (tt); if (t > NT) break; int tz = t; asm volatile("" : "+s"(tz)); \
        if (t < NT) AP_BATCH(t, SL); \
        const bool doPV = tz > t0 && t - 1 <= tmaxw, doQK = t < NT && t <= tmaxw; \
        bool resc = false; float al = 1.0f, rs = 0.f; \
        const bool near = MODE == 1 && (t * 64 + 63 + 91 > q0 + wid * 32); \
        if (doQK) AP3_QK(SL); else { p0 = f32x16{}; p1 = f32x16{}; }     \
        __builtin_amdgcn_sched_barrier(0); \
        if (doQK) AP3_DECIDE(true); \
        __builtin_amdgcn_sched_barrier(0); \
        if (doPV) { s16x4 vfa[2 * NDB]; AP3_VFL(vfa, 0, ((SL) + 2) % 3);     \
            AP3_GROUP(0, vfa, vfa, p0, 0, p0, 0, false, true, ((SL) + 2) % 3); \
            AP3_GROUP(1, vfa, vfa, p0, 8, p0, 0, true, true, ((SL) + 2) % 3); \
            AP3_GROUP(2, vfa, vfa, p1, 0, p0, 8, true, true, ((SL) + 2) % 3); \
            AP3_GROUP(3, vfa, vfa, p1, 8, p1, 0, true, false, ((SL) + 2) % 3); \
            _Pragma("unroll") for (int e = 0; e < 8; ++e) rs += p1[8 + e]; \
            _Pragma("unroll") for (int e = 0; e < 4; ++e) pwv[3][e] = cvtpk_(p1[8 + 2 * e], p1[8 + 2 * e + 1]); \
        } else if (doQK) { AP3_OCT(p0, 0, 0); AP3_OCT(p0, 8, 1); AP3_OCT(p1, 0, 2); AP3_OCT(p1, 8, 3); } \
        if (doQK) l_run += rs; \
          \
        if (resc && tz > t0) { \
            if (hi == 0) wsf[r32] = al; \
            asm volatile("s_waitcnt lgkmcnt(0)" ::: "memory"); \
            _Pragma("unroll") for (int g4 = 0; g4 < 4; ++g4) { const f32x4 a4 = *(const LAS f32x4*)(wsf + 8 * g4 + 4 * hi); \
                _Pragma("unroll") for (int d = 0; d < NDB; ++d) \
                    _Pragma("unroll") for (int e = 0; e < 4; ++e) o[d][4 * g4 + e] *= a4[e]; } } \
        if (t == NT) break; \
        if (pv == 6) { if (t + 2 < NT) asm volatile("s_waitcnt vmcnt(3) lgkmcnt(0)" ::: "memory"); else asm volatile("s_waitcnt vmcnt(0) lgkmcnt(0)" ::: "memory"); } \
        else { if (t + 2 < NT) asm volatile("s_waitcnt vmcnt(3) lgkmcnt(0)\n\ts_barrier" ::: "memory"); else asm volatile("s_waitcnt vmcnt(0) lgkmcnt(0)\n\ts_barrier" ::: "memory"); } \
    } while (0)
#define AP3_FSTEP(tt, SL) do { const int t = (tt); \
        AP_ISSUE_K(t + 2, ((SL) + 2) % 3); AP_ISSUE_V(t + 1, ((SL) + 1) % 3); \
        float rs = 0.f; \
        AP3_QKF(SL); \
        __builtin_amdgcn_sched_barrier(0); \
        { s16x4 vfa[2 * NDB]; AP3_VFL(vfa, 0, ((SL) + 2) % 3); \
          AP3_GROUP(0, vfa, vfa, p0, 0, p0, 0, false, true, ((SL) + 2) % 3); \
          AP3_GROUP(1, vfa, vfa, p0, 8, p0, 0, true, true, ((SL) + 2) % 3); \
          AP3_GROUP(2, vfa, vfa, p1, 0, p0, 8, true, true, ((SL) + 2) % 3); \
          AP3_GROUP(3, vfa, vfa, p1, 8, p1, 0, true, false, ((SL) + 2) % 3); \
          _Pragma("unroll") for (int e = 0; e < 8; ++e) rs += p1[8 + e]; \
          _Pragma("unroll") for (int e = 0; e < 4; ++e) pwv[3][e] = cvtpk_(p1[8 + 2 * e], p1[8 + 2 * e + 1]); } \
        l_run += rs; \
        asm volatile("s_waitcnt vmcnt(3) lgkmcnt(0)\n\ts_barrier" ::: "memory"); \
    } while (0)
    if (wid >= 4) __builtin_amdgcn_s_setprio(1);
    int t3 = t0;
    if constexpr (SREF && pv == 0) {
        AP3_STEP(t3, 0); AP3_STEP(t3 + 1, 1); AP3_STEP(t3 + 2, 2); t3 += 3;
        const int tfe = (q0 >> 6) - (MODE == 0 ? 1 : 3);
        for (; t3 + 2 <= tfe; t3 += 3) { AP3_FSTEP(t3, 0); AP3_FSTEP(t3 + 1, 1); AP3_FSTEP(t3 + 2, 2); }
    }
    for (; t3 <= NT; t3 += 3) { AP3_STEP(t3, 0); AP3_STEP(t3 + 1, 1); AP3_STEP(t3 + 2, 2); }
    if (wid >= 4) __builtin_amdgcn_s_setprio(0);
    asm volatile("s_waitcnt lgkmcnt(0)\n\ts_barrier" ::: "memory");
    l_run += __shfl_xor(l_run, 32);
    if (hi == 0) wsf[r32] = 1.0f / l_run;
    asm volatile("s_waitcnt lgkmcnt(0)" ::: "memory");
#pragma unroll
    for (int g4 = 0; g4 < 4; ++g4) { const f32x4 a4 = *(const LAS f32x4*)(wsf + 8 * g4 + 4 * hi);
#pragma unroll
        for (int d = 0; d < NDB; ++d)
#pragma unroll
            for (int e = 0; e < 4; ++e) o[d][4 * g4 + e] *= a4[e]; }
#undef AP_ISSUE_K
#undef AP_ISSUE_V
#undef AP_BATCH
#undef AP3_VFL
#undef AP3_VFL1
#undef AP3_FRAG
#undef AP3_GAP
#undef AP3_GROUP
#undef AP3_OCT
#undef AP3_STEP
#undef AP3_FSTEP
#undef AP3_QK
#undef AP3_QKF
#undef AP3_QKS
#undef AP3_KRD
#undef AP3_MM
#undef AP3_DECIDE
}

template <int NDB> __device__ __forceinline__ void store_o(const f32x16 (&o)[NDB], LAS unsigned char* stgb  , bf16_t* dst  , int ld, int lane) {
    const int r32 = lane & 31, hi = lane >> 5;
    constexpr int DVC = 32 * NDB;
    LAS bf16_t* stg = (LAS bf16_t*)stgb;
#pragma unroll
    for (int d = 0; d < NDB; ++d)
#pragma unroll
        for (int r = 0; r < 16; ++r) { const int row = (r & 3) + 8 * (r >> 2) + 4 * hi; stg[row * DVC + 32 * d + r32] = (bf16_t)f2bf(o[d][r]); }
    asm volatile("s_waitcnt lgkmcnt(0)" ::: "memory");
    constexpr int CPR = DVC / 8;
#pragma unroll
    for (int i = 0; i < (32 * CPR) / 64; ++i) { const int c = i * 64 + lane, row = c / CPR, ch = c % CPR;
        const u32x4 v = *(const LAS u32x4*)(stg + row * DVC + ch * 8); *(u32x4*)(dst + (size_t)row * ld + ch * 8) = v; }
    asm volatile("s_waitcnt lgkmcnt(0)" ::: "memory");
}

__device__ __forceinline__ float lambda_full(Frame& F) {
    const int l = lane_id_opaque() & 63;
    const float a = wave_sum(F.in[I_LQ1][l] * F.in[I_LK1][l]), b = wave_sum(F.in[I_LQ2][l] * F.in[I_LK2][l]);
    return __expf(a) - __expf(b) + 0.2f;
}

template <int pv = 0> __device__ __forceinline__ void attn_prompt_fox(Frame& F, int h, int qb) {
    const bf16_t* Q = (const bf16_t*)(F.ws + WS_QB) + h * 64; const bf16_t* K = (const bf16_t*)(F.ws + WS_KB) + h * 64; const bf16_t* V = (const bf16_t*)(F.ws + WS_VB) + h * 64;
    f32x16 o[2];
    const float* Fh = (const float*)(F.ws + WS_FP) + (size_t)h * SEQ;
    int t0 = 0; bool fast;
    { const unsigned* nw = (const unsigned*)(F.ws + WS_CTL) + 256;
      const float qn2 = __uint_as_float(nw[h * 2]) + __uint_as_float(nw[h * 2 + 1]), kn2 = __uint_as_float(nw[16 + h * 2]) + __uint_as_float(nw[16 + h * 2 + 1]);
      const float B = sqrtf(qn2 * kn2) * 1.02f + 0.5f;
      const float thresh = -40.0f - 2.0f * B;
      fast = __builtin_amdgcn_readfirstlane(B <= 60.0f ? 1 : 0) != 0;
      volatile LAS int* cnt = (volatile LAS int*)(F.lds + AT_MISC + 32);
      __syncthreads();
      if (F.tid < 256) { const int t = F.tid; const bool sk = t < 4 * qb && (Fh[qb * 256] - Fh[64 * t + 63]) <= thresh;
          const int c = __popcll(__ballot(sk)); if (F.lane == 0) cnt[F.wave] = c; }
      __syncthreads();
      t0 = cnt[0] + cnt[1] + cnt[2] + cnt[3]; t0 -= t0 % 3; }
    if (fast) attn_pass3<0, 64, pv, true>(F, Q, K, V, qb * 256, 4 * qb + 4, Fh, 0, o, t0); else attn_pass3<0, 64, pv, false>(F, Q, K, V, qb * 256, 4 * qb + 4, Fh, 0, o, t0);
    if (pv != 0 && o[0][0] != 1234.5678f) { __syncthreads(); return; }
    bf16_t* AB = (bf16_t*)(F.ws + WS_AB);
    store_o<2>(o, F.lds + F.wave * 8192, AB + (size_t)(qb * 256 + F.wave * 32) * DM + 512 + h * 64, DM, F.lane);
    __syncthreads();
}
template <int pv = 0> __device__ __forceinline__ void attn_prompt_diff_half(Frame& F, int h, int half, int qb) {
    const bf16_t* Q = (const bf16_t*)(F.ws + WS_QA) + h * 128 + 64 * half; const bf16_t* K = (const bf16_t*)(F.ws + WS_KA) + h * 128 + 64 * half; const bf16_t* V = (const bf16_t*)(F.ws + WS_VA) + h * 128;
    f32x16 o[4];
    bool fast;
    { const unsigned* nw = (const unsigned*)(F.ws + WS_CTL) + 288; const int hh = h * 2 + half;
      const float qn2 = __uint_as_float(nw[hh * 2]) + __uint_as_float(nw[hh * 2 + 1]), kn2 = __uint_as_float(nw[16 + hh * 2]) + __uint_as_float(nw[16 + hh * 2 + 1]);
      float bm = 0.f; for (int b = 0; b < 32; ++b) bm = fmaxf(bm, fabsf(F.in[I_RELB][b * 4 + h] - F.in[I_RELB][15 * 4 + h]));
      const float B = sqrtf(qn2 * kn2) * 1.02f + 0.5f + bm * LOG2E;
      fast = __builtin_amdgcn_readfirstlane(B <= 60.0f ? 1 : 0) != 0; }
    if (fast) attn_pass3<1, 128, pv, true>(F, Q, K, V, qb * 256, 4 * qb + 4, nullptr, h, o); else attn_pass3<1, 128, pv, false>(F, Q, K, V, qb * 256, 4 * qb + 4, nullptr, h, o);
    if (pv != 0 && o[0][0] != 1234.5678f) { __syncthreads(); return; }
    bf16_t* OD = (bf16_t*)(F.ws + (half ? WS_OD2 : WS_OD1));
    store_o<4>(o, F.lds + F.wave * 8192, OD + (size_t)(qb * 256 + F.wave * 32) * 512 + h * 128, 512, F.lane);
    __syncthreads();
}
constexpr int PF_STR = 66, PD_STR = 130;
__device__ __forceinline__ void p_combine(Frame& F) {
    const float lam = lambda_full(F);
    const bf16_t* O1 = (const bf16_t*)(F.ws + WS_OD1); const bf16_t* O2 = (const bf16_t*)(F.ws + WS_OD2); bf16_t* AB = (bf16_t*)(F.ws + WS_AB);
    const int gw = F.bid * 8 + F.wave, NGW = F.G * 8;
    const int c0 = 8 * F.lane;
    float sg[8];
#pragma unroll
    for (int i = 0; i < 8; ++i) sg[i] = F.in[I_SUBG][(c0 & 127) + i] * 0.8f;
    for (int m0 = gw; m0 < SEQ; m0 += 4 * NGW) {
        u32x4 a[4], b[4];
#pragma unroll
        for (int r = 0; r < 4; ++r) { const int m = m0 + r * NGW; if (m < SEQ) { a[r] = *(const u32x4*)(O1 + (size_t)m * 512 + c0); b[r] = *(const u32x4*)(O2 + (size_t)m * 512 + c0); } else { a[r] = (u32x4){0u, 0u, 0u, 0u}; b[r] = a[r]; } }
#pragma unroll
        for (int r = 0; r < 4; ++r) { const int m = m0 + r * NGW;
            float v[8];
            v[0] = bflo(a[r].x) - lam * bflo(b[r].x); v[1] = bfhi(a[r].x) - lam * bfhi(b[r].x); v[2] = bflo(a[r].y) - lam * bflo(b[r].y); v[3] = bfhi(a[r].y) - lam * bfhi(b[r].y);
            v[4] = bflo(a[r].z) - lam * bflo(b[r].z); v[5] = bfhi(a[r].z) - lam * bfhi(b[r].z); v[6] = bflo(a[r].w) - lam * bflo(b[r].w); v[7] = bfhi(a[r].w) - lam * bfhi(b[r].w);
            float ss = 0.f;
#pragma unroll
            for (int i = 0; i < 8; ++i) ss += v[i] * v[i];
#pragma unroll
            for (int ofs = 1; ofs < 16; ofs <<= 1) ss += __shfl_xor(ss, ofs);
            const float rn = 1.0f / sqrtf(ss * (1.0f / 128.0f) + LN_EPS);
            u32x4 w; w.x = pk2(v[0] * rn * sg[0], v[1] * rn * sg[1]); w.y = pk2(v[2] * rn * sg[2], v[3] * rn * sg[3]); w.z = pk2(v[4] * rn * sg[4], v[5] * rn * sg[5]); w.w = pk2(v[6] * rn * sg[6], v[7] * rn * sg[7]);
            if (m < SEQ) *(u32x4*)(AB + (size_t)m * DM + c0) = w; }
    }
    for (int it = F.bid; it < NSMP; it += F.G) {
        const int b = it >> 4, q = it & 15; const size_t row = (size_t)SEQ + it;
        if (F.wave == 0) {
            const int h = F.lane >> 3, cc = (F.lane & 7) * 8; const float* P = (const float*)(F.ws + WS_PF);
            float M = -1e30f;
#pragma unroll
            for (int s = 0; s < 8; ++s) M = fmaxf(M, P[((size_t)((b * 8 + s) * 8 + h) * 16 + q) * PF_STR + 64]);
            float acc[8], L = 0.f;
#pragma unroll
            for (int i = 0; i < 8; ++i) acc[i] = 0.f;
#pragma unroll
            for (int s = 0; s < 8; ++s) { const float* pr = P + ((size_t)((b * 8 + s) * 8 + h) * 16 + q) * PF_STR; const float wgt = __builtin_amdgcn_exp2f(pr[64] - M); L += wgt * pr[65];
#pragma unroll
                for (int i = 0; i < 8; ++i) acc[i] += wgt * pr[cc + i]; }
            const float inv = 1.0f / L;
            u32x4 w; w.x = pk2(acc[0] * inv, acc[1] * inv); w.y = pk2(acc[2] * inv, acc[3] * inv); w.z = pk2(acc[4] * inv, acc[5] * inv); w.w = pk2(acc[6] * inv, acc[7] * inv);
            *(u32x4*)(AB + row * DM + 512 + c0) = w; }
        if (F.wave == 1) {
            const int h = F.lane >> 4, cc = (F.lane & 15) * 8; const float* P = (const float*)(F.ws + WS_PD);
            float v[8];
#pragma unroll
            for (int i = 0; i < 8; ++i) v[i] = 0.f;
#pragma unroll
            for (int half = 0; half < 2; ++half) {
                float M = -1e30f;
#pragma unroll
                for (int s = 0; s < 8; ++s) M = fmaxf(M, P[((size_t)((b * 8 + s) * 8 + 2 * h + half) * 16 + q) * PD_STR + 128]);
                float acc[8], L = 0.f;
#pragma unroll
                for (int i = 0; i < 8; ++i) acc[i] = 0.f;
#pragma unroll
                for (int s = 0; s < 8; ++s) { const float* pr = P + ((size_t)((b * 8 + s) * 8 + 2 * h + half) * 16 + q) * PD_STR; const float wgt = __builtin_amdgcn_exp2f(pr[128] - M); L += wgt * pr[129];
#pragma unroll
                    for (int i = 0; i < 8; ++i) acc[i] += wgt * pr[cc + i]; }
                const float sc = (half ? -lam : 1.0f) / L;
#pragma unroll
                for (int i = 0; i < 8; ++i) v[i] += acc[i] * sc; }
            float ss = 0.f;
#pragma unroll
            for (int i = 0; i < 8; ++i) ss += v[i] * v[i];
#pragma unroll
            for (int ofs = 1; ofs < 16; ofs <<= 1) ss += __shfl_xor(ss, ofs);
            const float rn = 1.0f / sqrtf(ss * (1.0f / 128.0f) + LN_EPS);
            u32x4 w; w.x = pk2(v[0] * rn * sg[0], v[1] * rn * sg[1]); w.y = pk2(v[2] * rn * sg[2], v[3] * rn * sg[3]); w.z = pk2(v[4] * rn * sg[4], v[5] * rn * sg[5]); w.w = pk2(v[6] * rn * sg[6], v[7] * rn * sg[7]);
            *(u32x4*)(AB + row * DM + c0) = w; }
    }
}

constexpr int SM_K = 0, SM_V = 32768, SM_F = 81920, SM_WS = 83968;
template <int KIND  > __device__ __forceinline__ void sample_unit(Frame& F, int b, int s) {
    constexpr int DV = KIND == 0 ? 64 : 128, NDB = DV / 32, VSTR = KIND == 0 ? 192 : 320, VSUB = 16 * VSTR;
    const int lane = lane_id_opaque(), r32 = lane & 31, hi = lane >> 5, w = F.wave, tid = w * 64 + lane;
    const LAS char* lds = (const LAS char*)F.lds;
    LAS float* wsf = (LAS float*)(F.lds + SM_WS) + w * 64;
    const int hb = KIND == 0 ? w : (w >> 1);
    const LAS float* tab = (const LAS float*)(F.lds + AT_TAB) + hb * 192;
    const int q = r32 & 15, qpos = PAST + q;
    const size_t qrow = (size_t)SEQ + b * DEC_T + q;
    const bf16_t* Qp = (const bf16_t*)(F.ws + (KIND == 0 ? WS_QB : WS_QA)) + qrow * 512 + w * 64;
    bf16x8 qr[4];
#pragma unroll
    for (int d0 = 0; d0 < 4; ++d0) qr[d0] = *(const bf16x8*)(Qp + d0 * 16 + hi * 8);
    const float* Fs = (const float*)(F.ws + WS_FS) + (size_t)(b * 8 + w) * SKV;
    const float fq = KIND == 0 ? Fs[qpos] : 0.f;
    const float* Kc = F.in[KIND == 0 ? I_CFK : I_CDK] + (size_t)b * PAST * 512; const float* Vc = F.in[KIND == 0 ? I_CFV : I_CDV] + (size_t)b * PAST * 512;
    const float* Kn = F.out + (KIND == 0 ? O_FKS : O_DKS) + (size_t)b * DEC_T * 512; const float* Vn = F.out + (KIND == 0 ? O_FVS : O_DVS) + (size_t)b * DEC_T * 512;
    const int kr = tid >> 5, c16 = (tid & 31) * 16;
    const int ksub = c16 >> 6, kch = (c16 >> 3) & 7;
    const int kdst = SM_K + ksub * 4096 + kr * 128;
    const int vdst = KIND == 0 ? SM_V + ksub * VSUB + kr * VSTR + kch * 16 : SM_V + (c16 >> 7) * VSUB + kr * VSTR + ((c16 >> 3) & 15) * 16;
    f32x16 o[NDB];
#pragma unroll
    for (int d = 0; d < NDB; ++d) o[d] = f32x16{};
    float m_run = -1e30f, l_run = 0.f;
    f32x4 gkA[4], gvA[4], gkB[4], gvB[4], gkC[4], gvC[4]; float gfA = 0.f, gfB = 0.f, gfC = 0.f;
    const int nt = s == 0 ? 17 : 16;
    auto gload = [&](f32x4 (&gk)[4], f32x4 (&gv)[4], float& gf, int t) {
        const float* ks; const float* vs;
        if (t < 128) { ks = Kc + (size_t)(16 * t + kr) * 512 + c16; vs = Vc + (size_t)(16 * t + kr) * 512 + c16; }
        else { ks = Kn + (size_t)kr * 512 + c16; vs = Vn + (size_t)kr * 512 + c16; }
#pragma unroll
        for (int j = 0; j < 4; ++j) { gk[j] = *(const f32x4*)(ks + 4 * j); gv[j] = *(const f32x4*)(vs + 4 * j); }
        if (KIND == 0 && tid < 128) gf = ((const float*)(F.ws + WS_FS))[(size_t)(b * 8 + (tid >> 4)) * SKV + 16 * t + (tid & 15)];
    };
    auto lwrite = [&](const f32x4 (&gk)[4], const f32x4 (&gv)[4], float gf) {
#pragma unroll
        for (int j = 0; j < 2; ++j) { u32x4 wk, wv;
            wk.x = pk2(gk[2 * j][0], gk[2 * j][1]); wk.y = pk2(gk[2 * j][2], gk[2 * j][3]); wk.z = pk2(gk[2 * j + 1][0], gk[2 * j + 1][1]); wk.w = pk2(gk[2 * j + 1][2], gk[2 * j + 1][3]);
            wv.x = pk2(gv[2 * j][0], gv[2 * j][1]); wv.y = pk2(gv[2 * j][2], gv[2 * j][3]); wv.z = pk2(gv[2 * j + 1][0], gv[2 * j + 1][1]); wv.w = pk2(gv[2 * j + 1][2], gv[2 * j + 1][3]);
            *(LAS u32x4*)(F.lds + kdst + (((kch + j) ^ (kr & 7)) << 4)) = wk;
            *(LAS u32x4*)(F.lds + vdst + j * 16) = wv; }
        if (KIND == 0 && tid < 128) ((LAS float*)(F.lds + SM_F))[tid] = gf;
    };
    gload(gkA, gvA, gfA, s); gload(gkB, gvB, gfB, s + 8); gload(gkC, gvC, gfC, s + 16);
    __syncthreads();
    { const int sub = tid >> 6, rr = 16 + ((tid >> 2) & 15), cq = (tid & 3) * 32;
      *(LAS u32x4*)(F.lds + SM_K + sub * 4096 + rr * 128 + cq) = (u32x4){0u, 0u, 0u, 0u}; *(LAS u32x4*)(F.lds + SM_K + sub * 4096 + rr * 128 + cq + 16) = (u32x4){0u, 0u, 0u, 0u}; }
    const int vb = SM_V + (KIND == 0 ? w : (w >> 1)) * VSUB + (4 * hi + ((lane & 15) >> 2)) * VSTR + (((lane >> 4) & 1) * 16 + (lane & 3) * 4) * 2;
    auto compute = [&](int t) {
        f32x16 p0 = f32x16{};
#pragma unroll
        for (int d0 = 0; d0 < 4; ++d0) { const bf16x8 kf = *(const LAS bf16x8*)(lds + SM_K + w * 4096 + r32 * 128 + (((2 * d0 + hi) ^ (r32 & 7)) << 4));
            p0 = __builtin_amdgcn_mfma_f32_32x32x16_bf16(kf, qr[d0], p0, 0, 0, 0); }
        const int kv0 = 16 * t + 4 * hi;
        float x[8];
        if (KIND == 0) {
#pragma unroll
            for (int g4 = 0; g4 < 2; ++g4) { const f32x4 fa = *(const LAS f32x4*)(lds + SM_F + (w * 16 + 4 * hi + 8 * g4) * 4);
#pragma unroll
                for (int e = 0; e < 4; ++e) x[4 * g4 + e] = p0[4 * g4 + e] + (fq - fa[e]); }
            if (t == 128) {
#pragma unroll
                for (int r = 0; r < 8; ++r) { const int kv = kv0 + (r & 3) + 8 * (r >> 2); if (kv > qpos) x[r] = -1e30f; } }
        } else {
            if (t < 120) {
#pragma unroll
                for (int r = 0; r < 8; ++r) x[r] = p0[r];
            } else {
#pragma unroll
                for (int r = 0; r < 8; ++r) { const int kv = kv0 + (r & 3) + 8 * (r >> 2); int i0 = kv - qpos + 128; i0 = i0 < 0 ? 0 : i0; x[r] = p0[r] + tab[i0]; } }
        }
        float rm = x[0];
#pragma unroll
        for (int r = 1; r < 8; ++r) rm = fmaxf(rm, x[r]);
        rm = fmaxf(rm, __shfl_xor(rm, 32));
        const float m_new = fmaxf(m_run, rm);
        if (__any(m_new > m_run)) { const float al = __builtin_amdgcn_exp2f(m_run - m_new); l_run *= al; m_run = m_new;
            if (hi == 0) wsf[r32] = al;
            asm volatile("s_waitcnt lgkmcnt(0)" ::: "memory");
#pragma unroll
            for (int g4 = 0; g4 < 2; ++g4) { const f32x4 a4 = *(const LAS f32x4*)(wsf + 8 * g4 + 4 * hi);
#pragma unroll
                for (int d = 0; d < NDB; ++d)
#pragma unroll
                    for (int e = 0; e < 4; ++e) o[d][4 * g4 + e] *= a4[e]; } }
        float rs = 0.f;
#pragma unroll
        for (int r = 0; r < 8; ++r) { x[r] = __builtin_amdgcn_exp2f(x[r] - m_run); rs += x[r]; }
        l_run += rs;
        u32x4 w0; w0.x = cvtpk_v(x[0], x[1]); w0.y = cvtpk_v(x[2], x[3]); w0.z = cvtpk_v(x[4], x[5]); w0.w = cvtpk_v(x[6], x[7]);
        const bf16x8 pa = __builtin_bit_cast(bf16x8, w0);
#pragma unroll
        for (int d = 0; d < NDB; ++d) { const LAS char* vp = lds + vb + d * 64;
            const s16x4 lo = vtr(vp), hi4 = vtr(vp + 8 * VSTR);
            const bf16x8 vf = (bf16x8){lo[0], lo[1], lo[2], lo[3], hi4[0], hi4[1], hi4[2], hi4[3]};
            o[d] = __builtin_amdgcn_mfma_f32_32x32x16_bf16(pa, vf, o[d], 0, 0, 0); }
    };
    for (int i = 0; i < nt; i += 3) {
        const int t = s + 8 * i;
        lwrite(gkA, gvA, gfA); __syncthreads();
        if (i + 3 < nt) gload(gkA, gvA, gfA, t + 24);
        compute(t);
        __syncthreads();
        if (i + 1 >= nt) break;
        lwrite(gkB, gvB, gfB); __syncthreads();
        if (i + 4 < nt) gload(gkB, gvB, gfB, t + 32);
        compute(t + 8);
        __syncthreads();
        if (i + 2 >= nt) break;
        lwrite(gkC, gvC, gfC); __syncthreads();
        if (i + 5 < nt) gload(gkC, gvC, gfC, t + 40);
        compute(t + 16);
        __syncthreads();
    }
    l_run += __shfl_xor(l_run, 32);
    float* P = (float*)(F.ws + (KIND == 0 ? WS_PF : WS_PD)) + ((size_t)((b * 8 + s) * 8 + w) * 16) * (DV + 2);
    { float* P0 = P + (size_t)(4 * hi) * (DV + 2) + r32; float* P1 = P0 + 8 * (DV + 2);
#pragma unroll
      for (int d = 0; d < NDB; ++d)
#pragma unroll
          for (int r = 0; r < 4; ++r) { P0[r * (DV + 2) + 32 * d] = o[d][r]; P1[r * (DV + 2) + 32 * d] = o[d][4 + r]; } }
    if (lane < 16) { P[(size_t)lane * (DV + 2) + DV] = m_run; P[(size_t)lane * (DV + 2) + DV + 1] = l_run; }
}

template <int pv = 0> __device__ __forceinline__ void p3_attention(Frame& F, int mask) {
    LAS float* tab = (LAS float*)(F.lds + AT_TAB);
    for (int i = F.tid; i < 4 * 192; i += 512) { const int h = i / 192, rel = (i % 192) - 128; tab[i] = (F.in[I_RELB][t5_bucket(rel) * 4 + h] - F.in[I_RELB][15 * 4 + h]) * LOG2E; }
    __syncthreads();
    const int x = F.bid & 7, p = (F.bid >> 3) & 31;
    const int spos = F.G == 256 ? (x + p) % 5 : 4;
    for (int j = 0; j < 5; ++j) {
        F.lane = lane_id_opaque(); F.tid = F.wave * 64 + F.lane;
        if (j == spos) {
            if (mask & 4) {
                for (int u = F.bid; u < 256; u += F.G) {
                    F.lane = lane_id_opaque(); F.tid = F.wave * 64 + F.lane;
                    if ((u >> 3) & 1) sample_unit<1>(F, u >> 4, u & 7); else sample_unit<0>(F, u >> 4, u & 7);
                }
            }
        } else if (F.bid < 256) {
            const int i = j - (j > spos ? 1 : 0);
            const int qb = (i & 1) ? p : 63 - p;
            if (i < 2) { if (mask & 1) attn_prompt_diff_half<pv>(F, x >> 1, x & 1, qb); }
            else { if (mask & 2) attn_prompt_fox<pv>(F, x, qb); }
        }
    }
}

__device__ __forceinline__ void slab_publish(Frame& F, int word, int nun) {
    int n = 0; for (int L = F.bid; L < nun; L += F.G) ++n;
    asm volatile("s_waitcnt vmcnt(0)" ::: "memory");
    __syncthreads();
    if (F.tid == 0 && n > 0) { __builtin_amdgcn_fence(__ATOMIC_RELEASE, "agent"); asm volatile("s_waitcnt vmcnt(0)" ::: "memory");
        __hip_atomic_fetch_add((unsigned*)(F.ws + WS_CTL) + word, (unsigned)n, __ATOMIC_RELAXED, __HIP_MEMORY_SCOPE_AGENT); }
}
__device__ __forceinline__ void slab_wait(Frame& F, int word, int nun) {
    if (F.tid == 0) { unsigned* w = (unsigned*)(F.ws + WS_CTL) + word; unsigned sp = 0;
        while (__hip_atomic_load(w, __ATOMIC_RELAXED, __HIP_MEMORY_SCOPE_AGENT) < (unsigned)nun && ++sp < (1u << 22)) __builtin_amdgcn_s_sleep(2);
        __builtin_amdgcn_fence(__ATOMIC_ACQUIRE, "agent"); asm volatile("s_waitcnt vmcnt(0)" ::: "memory"); }
    __syncthreads();
}

#define XB_TMO      128
#define XB_XCNT(j)  (256  + 64 * (j))
#define XB_XSUB(j)  (1280 + 64 * (j))
#define XB_XGEN(j)  (2304 + 64 * (j))
#define XB_TOP      3328
#define XB_TOPGEN   3392
#define XCD_BAR_WORDS 3456
#define XB_SPIN_CAP (1u << 20)
__device__ __forceinline__ unsigned xb_ld(unsigned* p)              { return __hip_atomic_load(p, __ATOMIC_RELAXED, __HIP_MEMORY_SCOPE_AGENT); }
__device__ __forceinline__ unsigned xb_add(unsigned* p, unsigned v) { return __hip_atomic_fetch_add(p, v, __ATOMIC_RELAXED, __HIP_MEMORY_SCOPE_AGENT); }
__device__ __forceinline__ unsigned xb_xcc_id() { return (unsigned)__builtin_amdgcn_s_getreg((3 << 11) | 20) & 0xFu; }
#define XB_SPIN(cond, bar) do { unsigned _sp = 0; while (cond) { __builtin_amdgcn_s_sleep(1); \
    if ((++_sp & 255u) == 0u) { if (xb_ld(&(bar)[XB_TMO])) break; if (_sp > XB_SPIN_CAP) { atomicAdd(&(bar)[XB_TMO], 1u); break; } } } } while (0)
struct XcdBarrier { unsigned* bar; unsigned x; volatile LAS unsigned* st; };
__device__ __forceinline__ XcdBarrier xcd_barrier_post(unsigned* bar, volatile LAS unsigned* st) {
    XcdBarrier b; b.bar = bar; b.x = xb_xcc_id(); b.st = st;
    if (threadIdx.x == 0) (void)xb_add(&bar[XB_XCNT(b.x)], 1u);
    return b;
}
__device__ __forceinline__ void xcd_barrier_complete(unsigned* bar, unsigned x, unsigned& nloc, unsigned& nx) {
    const unsigned G = gridDim.x * gridDim.y * gridDim.z;
    unsigned sum, cnt, mine, sp = 0u;
    for (;;) {
        sum = 0u; cnt = 0u; mine = 0u;
#pragma unroll
        for (unsigned j = 0; j < 16; ++j) { const unsigned c = xb_ld(&bar[XB_XCNT(j)]); sum += c; cnt += (c > 0u) ? 1u : 0u; mine = (j == x) ? c : mine; }
        if (sum == G) break;
        __builtin_amdgcn_s_sleep(1);
        if ((++sp & 255u) == 0u) { if (xb_ld(&bar[XB_TMO])) break; if (sp > XB_SPIN_CAP) { atomicAdd(&bar[XB_TMO], 1u); break; } }
    }
    nloc = mine > 0u ? mine : 1u; nx = cnt > 0u ? cnt : 1u;
}
__device__ __forceinline__ void xcd_barrier(const XcdBarrier& b) {
    asm volatile("s_waitcnt vmcnt(0)" ::: "memory");
    __syncthreads();
    if (threadIdx.x == 0) {
        unsigned* bar = b.bar;
        __builtin_amdgcn_s_waitcnt(0);
        unsigned nloc = b.st[0], nx = b.st[1];
        if (nloc == 0u) { xcd_barrier_complete(bar, b.x, nloc, nx); b.st[0] = nloc; b.st[1] = nx; }
        const unsigned old = xb_add(&bar[XB_XSUB(b.x)], 1u);
        const unsigned gen = old / nloc;
        if (old + 1u == (gen + 1u) * nloc) {
            __builtin_amdgcn_fence(__ATOMIC_RELEASE, "agent");
            asm volatile("s_waitcnt vmcnt(0)" ::: "memory");
            const unsigned og = xb_add(&bar[XB_TOP], 1u);
            const unsigned tg = og / nx;
            if (og + 1u == (tg + 1u) * nx) xb_add(&bar[XB_TOPGEN], 1u);
            else XB_SPIN(xb_ld(&bar[XB_TOPGEN]) == tg, bar);
            __builtin_amdgcn_fence(__ATOMIC_ACQUIRE, "agent");
            xb_add(&bar[XB_XGEN(b.x)], 1u);
            asm volatile("s_waitcnt vmcnt(0)" ::: "memory");
        } else {
            XB_SPIN(xb_ld(&bar[XB_XGEN(b.x)]) == gen, bar);
            __builtin_amdgcn_fence(__ATOMIC_ACQUIRE, "agent");
            asm volatile("s_waitcnt vmcnt(0)" ::: "memory");
        }
    }
    __syncthreads();
}

__global__ void __launch_bounds__(512, 2) mega_fwd(Args args) {
    extern __shared__ __attribute__((aligned(16))) unsigned char lds_raw[];
    Frame F;
    F.lds = (LAS unsigned char*)lds_raw; F.ldsg = lds_raw;
    F.tid = threadIdx.x; F.lane = F.tid & 63; F.wave = __builtin_amdgcn_readfirstlane(F.tid >> 6);
    F.G = gridDim.x; F.bid = blockIdx.x;
    F.in = args.in; F.out = args.out; F.ws = args.ws;
    const int lo = args.ph_lo, hi = args.ph_hi;
    cg::grid_group grid = cg::this_grid();
    const bool fused = (hi - lo) > 1;
    volatile LAS unsigned* bst = (volatile LAS unsigned*)(F.lds + AT_MISC + 16);
    if (F.tid == 0) { bst[0] = 0u; bst[1] = 0u; }
    __syncthreads();
    XcdBarrier xbar; xbar.bar = (unsigned*)(F.ws + WS_CTL) + 1024; xbar.x = 0; xbar.st = bst;
    if (fused) xbar = xcd_barrier_post((unsigned*)(F.ws + WS_CTL) + 1024, bst);
#define IN(k) (lo <= (k) && (k) < hi)
#define PB() do { F.lane = lane_id_opaque(); F.tid = F.wave * 64 + F.lane; } while (0)
#define SEAM(k) do { if (IN(k) && IN((k) + 1)) { xcd_barrier(xbar); } } while (0)
    const float* mod = (const float*)(F.ws + WS_MOD);
    if (IN(0)) { PB(); p0_prologue(F); }
    if (IN(0) && IN(1)) __syncthreads(); else SEAM(0);
    if (IN(1)) { PB(); p1_rows(F, IN(0)); } SEAM(1);
    if (IN(2)) { PB();
        p2_cumsum(F);
        __syncthreads();
        pg8::Gemm g{(const bf16_t*)(F.ws + WS_XN), (const bf16_t*)(F.ws + WS_WIN), 1024, 1024, 1024, 1 << 30, 0, 0};
        pg8::StaticOrder S; S.init(MT / 256, NZ / 256, F.G, F.bid, 0);
        EpiZ E{F.out, F.ws};
        pg8::gemm_phase<EpiZ, pg8::StaticOrder>(F.lds, g, S, E, F.wave);
#if PROBE_DUP == 2
        pg8::gemm_phase<EpiZ, pg8::StaticOrder>(F.lds, g, S, E, F.wave);
#endif
        { const int nun = (MT / 256) * (NZ / 256), nlong = nun - (nun / F.G) * F.G;
          if (nlong > 0 && nlong < F.G) { if (F.bid >= nlong) { PB(); weight_copies(F, F.bid - nlong, F.G - nlong, WC_IN, WC_ALL); } }
          else { PB(); weight_copies(F, F.bid, F.G, WC_IN, WC_ALL); } }
    } SEAM(2);
    if (IN(3)) { PB(); p3_attention(F, 7);
#if PROBE_DUP == 3
        p3_attention<PROBE_PV>(F, PROBE_MASK);
#endif
    } SEAM(3);
    if (IN(10)) { PB(); p_combine(F);
#if PROBE_DUP == 10
        p_combine(F);
#endif
    } if (IN(10) && IN(4)) xcd_barrier(xbar);
    if (IN(4)) { PB();
        pg8::Gemm g{(const bf16_t*)(F.ws + WS_AB), (const bf16_t*)(F.ws + WS_WAB), 1024, 512, 512, 4, 512, 0};
        pg8::StaticOrder S; S.init(MT / 256, 8, F.G, F.bid, 0);
        EpiGate E{(bf16_t*)(F.ws + WS_G), (bf16_t*)(F.ws + WS_G)};
#if PROBE_DUP == 4
        { EpiGate E2{(bf16_t*)(F.ws + WS_G), (bf16_t*)(F.ws + WS_QA)}; pg8::gemm_phase<EpiGate, pg8::StaticOrder>(F.lds, g, S, E2, F.wave); }
#endif
        pg8::gemm_phase<EpiGate, pg8::StaticOrder>(F.lds, g, S, E, F.wave);
    } SEAM(4);
    if (IN(5)) { PB();
        { pg8::Gemm g2{(const bf16_t*)(F.ws + WS_G), (const bf16_t*)(F.ws + WS_WO2), 2048, 2048, 256, 1 << 30, 0, 256};
          pg8::SplitOrder S2; S2.init(4, 8, F.G, F.bid, SEQ / 256); EpiSlab E2{(float*)(F.ws + WS_SLAB)};
          pg8::gemm_phase<EpiSlab, pg8::SplitOrder>(F.lds, g2, S2, E2, F.wave); PB(); slab_publish(F, 322, 32); }
        pg8::Gemm g{(const bf16_t*)(F.ws + WS_G), (const bf16_t*)(F.ws + WS_WO2), 2048, 2048, 2048, 1 << 30, 0, 0};
        pg8::StaticOrder S; S.init(SEQ / 256, 4, F.G, F.bid, 0);
        EpiResLn<false> E{(const void*)F.in[I_XP], mod + 2048, F.in[I_LN1G], F.in[I_LN1B], mod, (bf16_t*)(F.ws + WS_X1B), (bf16_t*)(F.ws + WS_XN), nullptr,
                          PanelStats{(unsigned*)(F.ws + WS_XB1), (unsigned*)(F.ws + WS_CTL) + CTL_LN1, LN_EPS}, F.lds};
        pg8::gemm_phase<EpiResLn<false>, pg8::StaticOrder>(F.lds, g, S, E, F.wave);
        PB(); slab_wait(F, 322, 32); ln_rows<false>(F, F.in[I_LN1G], F.in[I_LN1B], 8, 2048);
    } if (IN(5) && IN(7)) xcd_barrier(xbar);

    if (IN(7)) { PB();
        pg8::Gemm g{(const bf16_t*)(F.ws + WS_XN), (const bf16_t*)(F.ws + WS_WFI), 1024, 1024, 1024, 1 << 30, 0, 0};
        pg8::StaticOrder S; S.init(MT / 256, NFF2 / 256, F.G, F.bid, 0);
        EpiFfn E{(bf16_t*)(F.ws + WS_ACT)};
        pg8::gemm_phase<EpiFfn, pg8::StaticOrder>(F.lds, g, S, E, F.wave);
#if PROBE_DUP == 7
        pg8::gemm_phase<EpiFfn, pg8::StaticOrder>(F.lds, g, S, E, F.wave);
#endif
    } SEAM(7);
    if (IN(8)) { PB();
        { pg8::Gemm g2{(const bf16_t*)(F.ws + WS_ACT), (const bf16_t*)(F.ws + WS_WFO), DFF, DFF, 256, 1 << 30, 0, 256};
          pg8::SplitOrder S2; S2.init(4, 11, F.G, F.bid, SEQ / 256); EpiSlab E2{(float*)(F.ws + WS_SLAB)};
          pg8::gemm_phase<EpiSlab, pg8::SplitOrder>(F.lds, g2, S2, E2, F.wave); PB(); slab_publish(F, 323, 44); }
        pg8::Gemm g{(const bf16_t*)(F.ws + WS_ACT), (const bf16_t*)(F.ws + WS_WFO), DFF, DFF, DFF, 1 << 30, 0, 0};
        pg8::StaticOrder S; S.init(SEQ / 256, 4, F.G, F.bid, 0);
        EpiResLn<true> E{(const void*)(F.ws + WS_X1B), mod + 5120, F.in[I_LN2G], F.in[I_LN2B], mod, nullptr, nullptr, F.out,
                         PanelStats{(unsigned*)(F.ws + WS_XB2), (unsigned*)(F.ws + WS_CTL) + CTL_LN2, LN_EPS}, F.lds};
        pg8::gemm_phase<EpiResLn<true>, pg8::StaticOrder>(F.lds, g, S, E, F.wave);
        PB(); slab_wait(F, 323, 44); ln_rows<true>(F, F.in[I_LN2G], F.in[I_LN2B], 11, 5120);
    }
#undef IN
#undef SEAM
}

extern "C" void kernel_launch(void* const* d_in, const int* in_sizes, int n_in, void* d_out, int out_size, void* d_ws, size_t ws_size, hipStream_t stream) {
    static int grid = 0;
    if (grid == 0) {
        if (n_in != 28 || (size_t)out_size != O_END || ws_size < WS_END) { fprintf(stderr, "kernel_launch: unexpected shapes (n_in %d out %d ws %zu)\n", n_in, out_size, ws_size); grid = -1; return; }
        int dev = 0, cus = 0, per_cu = 0;
        hipGetDevice(&dev); hipDeviceGetAttribute(&cus, hipDeviceAttributeMultiprocessorCount, dev);
        hipFuncSetAttribute((const void*)mega_fwd, hipFuncAttributeMaxDynamicSharedMemorySize, LDS_BYTES);
        hipOccupancyMaxActiveBlocksPerMultiprocessor(&per_cu, (const void*)mega_fwd, 512, LDS_BYTES);
        if (per_cu < 1) { fprintf(stderr, "kernel_launch: occupancy query says %d blocks per CU\n", per_cu); per_cu = 1; }
        (void)hipGetLastError();
        grid = cus;
    }
    if (grid < 0) return;
    hipMemsetAsync((char*)d_ws + WS_CTL, 0, CTL_BYTES, stream);
    Args a{};
    for (int i = 0; i < 28; ++i) a.in[i] = (const float*)d_in[i];
    a.out = (float*)d_out; a.ws = (unsigned char*)d_ws;
#if MK_N_LAUNCHES == 1
    a.ph_lo = 0; a.ph_hi = NPH;
    void* kargs[] = {&a};
    hipError_t e = hipLaunchCooperativeKernel((const void*)mega_fwd, dim3(grid), dim3(512), kargs, LDS_BYTES, stream);
    if (e != hipSuccess) fprintf(stderr, "cooperative launch failed: %s\n", hipGetErrorString(e));
#else
    { const int seq[NPH] = {0, 1, 2, 3, 10, 4, 5, 6, 7, 8, 9}; for (int i = 0; i < NPH; ++i) { a.ph_lo = seq[i]; a.ph_hi = seq[i] + 1; hipLaunchKernelGGL(mega_fwd, dim3(grid), dim3(512), LDS_BYTES, stream, a); } }
#endif
}
```

```cpp
#include <hip/hip_runtime.h>
#include <hip/hip_cooperative_groups.h>
#include <cstdint>
#include <cstdio>
namespace cg = cooperative_groups;

#ifndef PROBE_DUP
#define PROBE_DUP -1
#endif
#ifndef PROBE_PV
#define PROBE_PV 0
#endif
#ifndef PROBE_MASK
#define PROBE_MASK 7
#endif
#ifndef MK_N_LAUNCHES
#define MK_N_LAUNCHES 1
#endif

#define LAS __attribute__((address_space(3)))
typedef unsigned short bf16_t;
typedef short bf16x8 __attribute__((ext_vector_type(8)));
typedef short s16x4 __attribute__((ext_vector_type(4)));
typedef float f32x4 __attribute__((ext_vector_type(4)));
typedef float f32x2 __attribute__((ext_vector_type(2)));
typedef float f32x16 __attribute__((ext_vector_type(16)));
typedef unsigned u32x4 __attribute__((ext_vector_type(4)));
typedef unsigned u32x2 __attribute__((ext_vector_type(2)));

constexpr int DM = 1024, SEQ = 16384, DEC_B = 16, DEC_T = 16, NSMP = DEC_B * DEC_T, MT = SEQ + NSMP, PAST = 2048, SKV = PAST + DEC_T;
constexpr int NZ = 5120, DFF = 2816, NFF2 = 2 * DFF, WIN_COLS = 5128;
constexpr float LOG2E = 1.4426950408889634f, C2 = 0.125f * LOG2E, ALPHA = 1.189207115002721f, LN_EPS = 1e-5f;
constexpr int NPH = 11;

constexpr size_t O_Y = 0, O_DKP = (size_t)MT * DM, O_DVP = O_DKP + (size_t)SEQ * 512, O_FKP = O_DVP + (size_t)SEQ * 512, O_FVP = O_FKP + (size_t)SEQ * 512,
                 O_FLP = O_FVP + (size_t)SEQ * 512, O_DKS = O_FLP + (size_t)SEQ * 8, O_DVS = O_DKS + (size_t)NSMP * 512, O_FKS = O_DVS + (size_t)NSMP * 512,
                 O_FVS = O_FKS + (size_t)NSMP * 512, O_FLS = O_FVS + (size_t)NSMP * 512, O_END = O_FLS + (size_t)NSMP * 8;

constexpr size_t MiB = 1u << 20;
constexpr size_t WS_CTL = 0, CTL_BYTES = 64 * 1024;
constexpr size_t WS_MOD = 1 * MiB;
constexpr size_t WS_FP = 2 * MiB;
constexpr size_t WS_FS = 3 * MiB;
constexpr size_t WS_WIN = 8 * MiB;
constexpr size_t WS_WAB = 18 * MiB;
constexpr size_t WS_WO2 = 20 * MiB;
constexpr size_t WS_WFI = 24 * MiB;
constexpr size_t WS_WFO = 35 * MiB;
constexpr size_t WS_XN = 48 * MiB;
constexpr size_t WS_QA = 84 * MiB, WS_KA = 101 * MiB, WS_VA = 118 * MiB, WS_QB = 135 * MiB, WS_KB = 152 * MiB, WS_VB = 169 * MiB;
constexpr size_t WS_ACT = 84 * MiB;
constexpr size_t WS_G = 188 * MiB;
constexpr size_t WS_AB = 254 * MiB;
constexpr size_t WS_OD1 = WS_XN, WS_OD2 = 288 * MiB;
constexpr size_t WS_PF = 304 * MiB, WS_PD = 309 * MiB;
constexpr size_t WS_TB = WS_AB;
constexpr size_t WS_X1B = WS_AB;
constexpr size_t WS_XB1 = 5 * MiB, WS_XB2 = 6 * MiB;
constexpr int CTL_LN1 = 8192, CTL_LN2 = 12288;
constexpr int LN_LDS = 135168;
constexpr size_t WS_SLAB = 288 * MiB;
constexpr size_t WS_END = 320 * MiB;

constexpr int LDS_BYTES = 147456;

struct Args { const float* in[28]; float* out; unsigned char* ws; int ph_lo, ph_hi; };

__device__ __forceinline__ int lane_id_opaque() { int l = (int)__builtin_amdgcn_mbcnt_hi(~0u, __builtin_amdgcn_mbcnt_lo(~0u, 0u)); asm volatile("" : "+v"(l)); return l; }
__device__ __forceinline__ unsigned f2bf(float f) { unsigned u = __builtin_bit_cast(unsigned, f); return (u + 0x7fffu + ((u >> 16) & 1u)) >> 16; }
typedef __bf16 bf16x2e_t_ __attribute__((ext_vector_type(2)));
__device__ __forceinline__ unsigned cvtpk_v(float lo, float hi) { f32x2 v = {lo, hi}; bf16x2e_t_ b = __builtin_convertvector(v, bf16x2e_t_); return __builtin_bit_cast(unsigned, b); }
__device__ __forceinline__ unsigned pk2(float lo, float hi) { return cvtpk_v(lo, hi); }
__device__ __forceinline__ float bf2f(unsigned short b) { return __builtin_bit_cast(float, (unsigned)b << 16); }
__device__ __forceinline__ float bflo(unsigned w) { return __builtin_bit_cast(float, w << 16); }
__device__ __forceinline__ float bfhi(unsigned w) { return __builtin_bit_cast(float, w & 0xffff0000u); }
__device__ __forceinline__ float wave_sum(float v) {
#pragma unroll
    for (int o = 1; o < 64; o <<= 1) v += __shfl_xor(v, o);
    return v;
}
__device__ __forceinline__ float sigmoidf_(float x) { return __builtin_amdgcn_rcpf(1.0f + __expf(-x)); }
__device__ __forceinline__ float siluf_(float x) { return x * __builtin_amdgcn_rcpf(1.0f + __expf(-x)); }

namespace pg8 {
constexpr int BM = 256, BK = 64, HALF = 128, HTB = HALF * BK * 2, STAGE_BYTES = 8 * HTB, NXCD = 8, WGM = 8;
__host__ __device__ __forceinline__ int lds_byte(int r, int c) { const int st = (r >> 4) * 2 + (c >> 5), rr = r & 15, cc = c & 31, ob = rr * 64 + cc * 2; return st * 1024 + (ob ^ (((ob >> 9) & 1) << 5)); }
__host__ __device__ __forceinline__ void stage_rc(int b, int& R, int& C) { const int st = b / 1024, sb = b % 1024, swz = sb ^ (((sb >> 9) & 1) << 5); R = (st >> 1) * 16 + swz / 64; C = (st & 1) * 32 + (swz % 64) / 2; }
__host__ __device__ __forceinline__ int perm32(int rho) { const int n = rho >> 4, i = rho & 15; return 8 * (i >> 2) + 4 * n + (i & 3); }

struct Unit { int pm, pn, ks; };
struct Gemm { const bf16_t* A; const bf16_t* Bt; int lda, ldb, K, a_split_pn, a_split_off, kpart; };

struct StaticOrder {
    int nM, nN, nwg, G, c, pm0;
    __device__ void init(int nM_, int nN_, int G_, int c_, int pm0_) { nM = nM_; nN = nN_; nwg = nM * nN; G = G_; c = c_; pm0 = pm0_; }
    __device__ bool next(int i, Unit& u) const {
        const long L = (long)i * G + c; if (L >= nwg) return false;
        int wgid = (int)L; { const int q = nwg / NXCD, r = nwg % NXCD, xcd = wgid % NXCD, off = wgid / NXCD; wgid = (xcd < r ? xcd * (q + 1) : r * (q + 1) + (xcd - r) * q) + off; }
        const int nig = WGM * nN, gid = wgid / nig, fm = gid * WGM, gsz = (nM - fm) < WGM ? (nM - fm) : WGM;
        u.pm = pm0 + fm + ((wgid % nig) % gsz); u.pn = (wgid % nig) / gsz; u.ks = 0; return true;
    }
};

struct SplitOrder {
    int nN, nun, G, c, pm;
    __device__ void init(int nN_, int KS_, int G_, int c_, int pm_) { nN = nN_; nun = nN_ * KS_; G = G_; c = c_; pm = pm_; }
    __device__ bool next(int i, Unit& u) const { const long L = (long)i * G + c; if (L >= nun) return false; u.pm = pm; u.pn = (int)L % nN; u.ks = (int)L / nN; return true; }
};

__device__ __forceinline__ unsigned cvt_pk_bf16(float lo, float hi) { unsigned r; asm volatile("v_cvt_pk_bf16_f32 %0, %1, %2" : "=v"(r) : "v"(lo), "v"(hi)); return r; }

template <class Epi, class Sched, bool ALIGN_EPI = true, bool SP2 = true>
__device__ __forceinline__ void gemm_phase(LAS unsigned char* lds, const Gemm g, const Sched& S, const Epi& E, int wid  ) {
    const int lane = lane_id_opaque(), tid = wid * 64 + lane, wr = wid >> 2, wc = wid & 3; int fr = lane & 15, fq = lane >> 4;
    const int K = g.K, nt = K / BK;
    unsigned voffA[2], voffB[2];
#pragma unroll
    for (int i = 0; i < 2; ++i) { int R, C; stage_rc(tid * 16 + i * 8192, R, C); const int Rb = Epi::PERM ? ((R & ~31) + perm32(R & 31)) : R;
        voffA[i] = (unsigned)(R * g.lda + C) * 2u; voffB[i] = (unsigned)(Rb * g.ldb + C) * 2u; }
    const size_t kstep = (size_t)(BK * 2);
    const size_t hstepA = (size_t)HALF * g.lda * 2, hstepB = (size_t)HALF * g.ldb * 2;
    const size_t tstepA = 2 * hstepA, tstepB = 2 * hstepB;
    const unsigned ldsw = (unsigned)wid * 1024u;
    const int aoff = lds_byte(wr * 64 + fr, fq * 8), boff = lds_byte(wc * 32 + fr, fq * 8);
#define PG8_SA(b, h) (((b) * 2 + (h)) * HTB)
#define PG8_SB(b, h) ((4 + (b) * 2 + (h)) * HTB)
#define PG8_STAGE(bufoff, gbase, voff) do { _Pragma("unroll") for (int _i = 0; _i < 2; ++_i) \
        __builtin_amdgcn_global_load_lds((const unsigned*)((const char*)(gbase) + (voff)[_i]), (LAS unsigned*)(lds + (bufoff) + ldsw + _i * 8192), 16, 0, 0); } while (0)
#define PG8_LDA(dst, b, h) do { _Pragma("unroll") for (int m = 0; m < 4; ++m) _Pragma("unroll") for (int k = 0; k < 2; ++k) dst[m][k] = *(const LAS bf16x8*)(lds + PG8_SA(b, h) + aoff + m * 2048 + k * 1024); } while (0)
#define PG8_LDB(dst, b, h) do { _Pragma("unroll") for (int n = 0; n < 2; ++n) _Pragma("unroll") for (int k = 0; k < 2; ++k) dst[n][k] = *(const LAS bf16x8*)(lds + PG8_SB(b, h) + boff + n * 2048 + k * 1024); } while (0)
#define PG8_MMA(ai, bj, At, Bt) do { __builtin_amdgcn_s_setprio(1); _Pragma("unroll") for (int m = 0; m < 4; ++m) _Pragma("unroll") for (int n = 0; n < 2; ++n) _Pragma("unroll") for (int k = 0; k < 2; ++k) \
        acc[ai][bj][m][n] = __builtin_amdgcn_mfma_f32_16x16x32_bf16(Bt[n][k], At[m][k], acc[ai][bj][m][n], 0, 0, 0); __builtin_amdgcn_s_setprio(0); } while (0)
#define PG8_WAIT_V(n) asm volatile("s_waitcnt vmcnt(" #n ")" ::: "memory")
#define PG8_WAIT_L(n) asm volatile("s_waitcnt lgkmcnt(" #n ")" ::: "memory")
#define PG8_BAR __builtin_amdgcn_s_barrier()
#define PG8_SCHED __builtin_amdgcn_sched_barrier(0)
#define PG8_ABASE(u) ((const char*)g.A + (size_t)(u).pm * tstepA + ((u).pn >= g.a_split_pn ? (size_t)g.a_split_off * 2 : (size_t)0) + (size_t)(u).ks * g.kpart * 2)
#define PG8_BBASE(u) ((const char*)g.Bt + (size_t)(u).pn * tstepB + (size_t)(u).ks * g.kpart * 2)
    Unit cur, nxt; int ui = 0;
    if (!S.next(0, cur)) return;
    f32x4 acc[2][2][4][2];
#pragma unroll
    for (int a = 0; a < 2; ++a)
#pragma unroll
        for (int b = 0; b < 2; ++b)
#pragma unroll
            for (int m = 0; m < 4; ++m)
#pragma unroll
                for (int n = 0; n < 2; ++n) acc[a][b][m][n] = (f32x4){0.f, 0.f, 0.f, 0.f};
    bf16x8 At[4][2], B0[2][2], B1[2][2];
    const char* cA = PG8_ABASE(cur); const char* cB = PG8_BBASE(cur);
    if constexpr (SP2) {
        PG8_STAGE(PG8_SB(0, 0), cB, voffB); PG8_STAGE(PG8_SB(0, 1), cB + hstepB, voffB); PG8_STAGE(PG8_SA(0, 0), cA, voffA); PG8_STAGE(PG8_SA(0, 1), cA + hstepA, voffA);
        if (wr == 1) PG8_BAR;
        PG8_WAIT_V(2); PG8_BAR;
        PG8_STAGE(PG8_SB(1, 0), cB + kstep, voffB); PG8_STAGE(PG8_SA(1, 0), cA + kstep, voffA); PG8_STAGE(PG8_SB(1, 1), cB + hstepB + kstep, voffB);
        PG8_WAIT_V(6); PG8_BAR;
    } else {
        PG8_STAGE(PG8_SB(0, 0), cB, voffB); PG8_STAGE(PG8_SA(0, 0), cA, voffA); PG8_STAGE(PG8_SB(0, 1), cB + hstepB, voffB); PG8_STAGE(PG8_SA(0, 1), cA + hstepA, voffA);
        if (wr == 1) PG8_BAR;
        PG8_WAIT_V(4); PG8_BAR;
        PG8_STAGE(PG8_SB(1, 0), cB + kstep, voffB); PG8_STAGE(PG8_SA(1, 0), cA + kstep, voffA); PG8_STAGE(PG8_SB(1, 1), cB + hstepB + kstep, voffB);
        PG8_WAIT_V(6); PG8_BAR;
    }
    for (;;) {
        const bool has_next = S.next(ui + 1, nxt);
        const char* nA = has_next ? PG8_ABASE(nxt) : cA; const char* nB = has_next ? PG8_BBASE(nxt) : cB;
        for (int t = 0; t < nt; t += 2) {
            const bool last = (t == nt - 2);
            const char* a1 = cA + (size_t)(t + 1) * kstep;
            const char* a2 = last ? nA : cA + (size_t)(t + 2) * kstep; const char* b2 = last ? nB : cB + (size_t)(t + 2) * kstep;
            const char* a3 = a2 + kstep; const char* b3 = b2 + kstep;
            if constexpr (SP2) {
            PG8_LDB(B0, 0, 0); PG8_LDB(B1, 0, 1); PG8_SCHED; PG8_LDA(At, 0, 0); PG8_STAGE(PG8_SA(1, 1), a1 + hstepA, voffA);
            PG8_WAIT_V(8); PG8_WAIT_L(0); PG8_BAR; PG8_MMA(0, 0, At, B0); PG8_MMA(0, 1, At, B1); PG8_BAR; PG8_SCHED;
            PG8_LDA(At, 0, 1); PG8_STAGE(PG8_SB(0, 0), b2, voffB); PG8_STAGE(PG8_SB(0, 1), b2 + hstepB, voffB); PG8_STAGE(PG8_SA(0, 0), a2, voffA);
            PG8_WAIT_V(8); PG8_WAIT_L(0); PG8_BAR; PG8_MMA(1, 0, At, B0); PG8_MMA(1, 1, At, B1); PG8_BAR; PG8_SCHED;
            PG8_LDB(B0, 1, 0); PG8_LDB(B1, 1, 1); PG8_SCHED; PG8_LDA(At, 1, 0); PG8_STAGE(PG8_SA(0, 1), a2 + hstepA, voffA);
            PG8_WAIT_V(8); PG8_WAIT_L(0); PG8_BAR; PG8_MMA(0, 0, At, B0); PG8_MMA(0, 1, At, B1); PG8_BAR; PG8_SCHED;
            PG8_LDA(At, 1, 1); PG8_STAGE(PG8_SB(1, 0), b3, voffB); PG8_STAGE(PG8_SB(1, 1), b3 + hstepB, voffB); PG8_STAGE(PG8_SA(1, 0), a3, voffA);
            PG8_WAIT_V(8); PG8_WAIT_L(0); PG8_BAR; PG8_MMA(1, 0, At, B0); PG8_MMA(1, 1, At, B1); PG8_BAR; PG8_SCHED;
            } else {
            PG8_LDB(B0, 0, 0); PG8_SCHED; PG8_LDA(At, 0, 0); PG8_STAGE(PG8_SA(1, 1), a1 + hstepA, voffA);
            PG8_WAIT_L(8); PG8_BAR; PG8_WAIT_L(0); PG8_MMA(0, 0, At, B0); PG8_BAR; PG8_SCHED;
            PG8_LDB(B1, 0, 1); PG8_STAGE(PG8_SB(0, 0), b2, voffB);
            PG8_BAR; PG8_WAIT_L(0); PG8_MMA(0, 1, At, B1); PG8_BAR;
            PG8_LDA(At, 0, 1); PG8_STAGE(PG8_SA(0, 0), a2, voffA);
            PG8_BAR; PG8_WAIT_L(0); PG8_MMA(1, 0, At, B0); PG8_BAR; PG8_SCHED;
            PG8_STAGE(PG8_SB(0, 1), b2 + hstepB, voffB);
            PG8_WAIT_V(6); PG8_BAR; PG8_MMA(1, 1, At, B1); PG8_BAR;
            PG8_LDB(B0, 1, 0); PG8_SCHED; PG8_LDA(At, 1, 0); PG8_STAGE(PG8_SA(0, 1), a2 + hstepA, voffA);
            PG8_WAIT_L(8); PG8_BAR; PG8_WAIT_L(0); PG8_MMA(0, 0, At, B0); PG8_BAR; PG8_SCHED;
            PG8_LDB(B1, 1, 1); PG8_STAGE(PG8_SB(1, 0), b3, voffB);
            PG8_BAR; PG8_WAIT_L(0); PG8_MMA(0, 1, At, B1); PG8_BAR;
            PG8_LDA(At, 1, 1); PG8_STAGE(PG8_SA(1, 0), a3, voffA);
            PG8_BAR; PG8_WAIT_L(0); PG8_MMA(1, 0, At, B0); PG8_BAR; PG8_SCHED;
            PG8_STAGE(PG8_SB(1, 1), b3 + hstepB, voffB);
            PG8_WAIT_V(6); PG8_BAR; PG8_MMA(1, 1, At, B1); PG8_BAR;
            }
        }
        if constexpr (ALIGN_EPI) { if (wr == 0) PG8_BAR; }
        { const int le_ = lane_id_opaque(); E(acc, cur, wr, wc, le_ & 15, le_ >> 4); }
        if (!has_next) break;
#pragma unroll
        for (int a = 0; a < 2; ++a)
#pragma unroll
            for (int b = 0; b < 2; ++b)
#pragma unroll
                for (int m = 0; m < 4; ++m)
#pragma unroll
                    for (int n = 0; n < 2; ++n) acc[a][b][m][n] = (f32x4){0.f, 0.f, 0.f, 0.f};
        cur = nxt; cA = nA; cB = nB; ++ui;
        if constexpr (ALIGN_EPI) { if (wr == 1) PG8_BAR; }
    }
    PG8_WAIT_V(0);
    if constexpr (!ALIGN_EPI) { if (wr == 0) PG8_BAR; }
    PG8_BAR;
#undef PG8_SA
#undef PG8_SB
#undef PG8_STAGE
#undef PG8_LDA
#undef PG8_LDB
#undef PG8_MMA
#undef PG8_WAIT_V
#undef PG8_WAIT_L
#undef PG8_BAR
#undef PG8_SCHED
#undef PG8_ABASE
#undef PG8_BBASE
}
}

struct EpiZ {
    static constexpr bool PERM = true;
    float* out; unsigned char* ws;
    __device__ __forceinline__ void operator()(const f32x4 (&acc)[2][2][4][2], const pg8::Unit& u, int wr, int wc, int fr, int fq) const {
        asm volatile("" : "+v"(fr), "+v"(fq));
        const int seg = u.pn >> 1;
        const bool smp = u.pm >= SEQ / 256;
        const int row0 = u.pm * 256 + wr * 64 + fr;
        const int cl0 = wc * 32 + 8 * fq;
        if (seg < 6) {
            bf16_t* B = (bf16_t*)(ws + WS_QA + (size_t)seg * (WS_KA - WS_QA));
            const bool isq = (seg == 0 || seg == 3);
            const float sc = isq ? C2 : 1.0f;
            const int kk = seg - 1 - (seg > 3 ? 1 : 0);
            float* ob = isq ? nullptr : (smp ? out + O_DKS + (size_t)kk * NSMP * 512 - (size_t)SEQ * 512 : out + O_DKP + (size_t)kk * SEQ * 512);
            const int cs = (u.pn & 1) * 256 + cl0;
            if (seg == 0 || seg == 1 || seg == 3 || seg == 4) {
                float mx0 = 0.f, mx1 = 0.f;
#pragma unroll
                for (int ai = 0; ai < 2; ++ai)
#pragma unroll
                    for (int m = 0; m < 4; ++m) {
#pragma unroll
                        for (int bj = 0; bj < 2; ++bj) { const f32x4 v0 = acc[ai][bj][m][0] * sc, v1 = acc[ai][bj][m][1] * sc;
                            float ss = (v0[0] * v0[0] + v0[1] * v0[1]) + (v0[2] * v0[2] + v0[3] * v0[3]) + (v1[0] * v1[0] + v1[1] * v1[1]) + (v1[2] * v1[2] + v1[3] * v1[3]);
                            ss += __shfl_xor(ss, 16); ss += __shfl_xor(ss, 32);
                            if (bj == 0) mx0 = fmaxf(mx0, ss); else mx1 = fmaxf(mx1, ss); } }
#pragma unroll
                for (int ofs = 1; ofs < 16; ofs <<= 1) { mx0 = fmaxf(mx0, __shfl_xor(mx0, ofs)); mx1 = fmaxf(mx1, __shfl_xor(mx1, ofs)); }
                if ((fr | fq) == 0) { unsigned* nw = (unsigned*)(ws + WS_CTL) + (seg < 3 ? 288 : 256) + ((seg == 4 || seg == 1) ? 16 : 0);
                    const int h0 = (u.pn & 1) * 4 + (wc >> 1), hf = wc & 1;
                    atomicMax(nw + (h0 * 2 + hf), __float_as_uint(mx0)); atomicMax(nw + ((h0 + 2) * 2 + hf), __float_as_uint(mx1)); }
            }
#pragma unroll
            for (int ai = 0; ai < 2; ++ai)
#pragma unroll
                for (int m = 0; m < 4; ++m) { const size_t r = (size_t)(row0 + ai * 128 + m * 16);
#pragma unroll
                    for (int bj = 0; bj < 2; ++bj) { const f32x4 v0 = acc[ai][bj][m][0], v1 = acc[ai][bj][m][1]; const int c = cs + bj * 128;
                        if (ob) { if (smp) { *(f32x4*)(ob + r * 512 + c) = v0; *(f32x4*)(ob + r * 512 + c + 4) = v1; }
                                  else { __builtin_nontemporal_store(v0, (f32x4*)(ob + r * 512 + c)); __builtin_nontemporal_store(v1, (f32x4*)(ob + r * 512 + c + 4)); } }
                        u32x4 w; w.x = pg8::cvt_pk_bf16(v0[0] * sc, v0[1] * sc); w.y = pg8::cvt_pk_bf16(v0[2] * sc, v0[3] * sc); w.z = pg8::cvt_pk_bf16(v1[0] * sc, v1[1] * sc); w.w = pg8::cvt_pk_bf16(v1[2] * sc, v1[3] * sc);
                        *(u32x4*)(B + r * 512 + c) = w; } }
        } else {
            bf16_t* G = (bf16_t*)(ws + WS_G);
            const int cs = (u.pn - 12) * 256 + cl0;
#pragma unroll
            for (int ai = 0; ai < 2; ++ai)
#pragma unroll
                for (int m = 0; m < 4; ++m) { const size_t r = (size_t)(row0 + ai * 128 + m * 16);
#pragma unroll
                    for (int bj = 0; bj < 2; ++bj) { const f32x4 v0 = acc[ai][bj][m][0], v1 = acc[ai][bj][m][1]; const int c = cs + bj * 128;
                        u32x4 w; w.x = cvtpk_v(sigmoidf_(v0[0]), sigmoidf_(v0[1])); w.y = cvtpk_v(sigmoidf_(v0[2]), sigmoidf_(v0[3]));
                        w.z = cvtpk_v(sigmoidf_(v1[0]), sigmoidf_(v1[1])); w.w = cvtpk_v(sigmoidf_(v1[2]), sigmoidf_(v1[3]));
                        *(u32x4*)(G + r * 2048 + c) = w; } }
        }
    }
};
struct EpiGate {
    static constexpr bool PERM = true;
    bf16_t* G; bf16_t* GO;
    __device__ __forceinline__ void operator()(const f32x4 (&acc)[2][2][4][2], const pg8::Unit& u, int wr, int wc, int fr, int fq) const {
        asm volatile("" : "+v"(fr), "+v"(fq));
        const int row0 = u.pm * 256 + wr * 64 + fr, c0 = u.pn * 256 + wc * 32 + 8 * fq;
        u32x4 gq[2][4][2];
#pragma unroll
        for (int ai = 0; ai < 2; ++ai)
#pragma unroll
            for (int m = 0; m < 4; ++m)
#pragma unroll
                for (int bj = 0; bj < 2; ++bj) gq[ai][m][bj] = *(const u32x4*)(G + (size_t)(row0 + ai * 128 + m * 16) * 2048 + c0 + bj * 128);
#pragma unroll
        for (int ai = 0; ai < 2; ++ai)
#pragma unroll
            for (int m = 0; m < 4; ++m) { const size_t ro = (size_t)(row0 + ai * 128 + m * 16) * 2048 + c0; bf16_t* wp = GO + ro;
#pragma unroll
                for (int bj = 0; bj < 2; ++bj) { const f32x4 v0 = acc[ai][bj][m][0], v1 = acc[ai][bj][m][1]; const u32x4 gw = gq[ai][m][bj];
                    u32x4 w; w.x = pg8::cvt_pk_bf16(v0[0] * bflo(gw.x), v0[1] * bfhi(gw.x)); w.y = pg8::cvt_pk_bf16(v0[2] * bflo(gw.y), v0[3] * bfhi(gw.y));
                    w.z = pg8::cvt_pk_bf16(v1[0] * bflo(gw.z), v1[1] * bfhi(gw.z)); w.w = pg8::cvt_pk_bf16(v1[2] * bflo(gw.w), v1[3] * bfhi(gw.w));
                    *(u32x4*)(wp + bj * 128) = w; } }
    }
};
template <bool BASE_BF16> struct EpiRes {
    static constexpr bool PERM = true;
    const void* base; bf16_t* T; const float* gate;
    __device__ __forceinline__ void operator()(const f32x4 (&acc)[2][2][4][2], const pg8::Unit& u, int wr, int wc, int fr, int fq) const {
        asm volatile("" : "+v"(fr), "+v"(fq));
        const int row0 = u.pm * 256 + wr * 64 + fr, c0 = u.pn * 256 + wc * 32 + 8 * fq;
#pragma unroll
        for (int ai = 0; ai < 2; ++ai)
#pragma unroll
            for (int m = 0; m < 4; ++m) { const size_t ro = (size_t)(row0 + ai * 128 + m * 16) * DM;
#pragma unroll
                for (int bj = 0; bj < 2; ++bj) { const int c = c0 + bj * 128; f32x4 b0, b1;
                    if (BASE_BF16) { const u32x4 bw = *(const u32x4*)((const bf16_t*)base + ro + c); b0 = (f32x4){bflo(bw.x), bfhi(bw.x), bflo(bw.y), bfhi(bw.y)}; b1 = (f32x4){bflo(bw.z), bfhi(bw.z), bflo(bw.w), bfhi(bw.w)}; }
                    else { b0 = *(const f32x4*)((const float*)base + ro + c); b1 = *(const f32x4*)((const float*)base + ro + c + 4); }
                    const f32x4 g0 = *(const f32x4*)(gate + c), g1 = *(const f32x4*)(gate + c + 4);
                    const f32x4 v0 = b0 * ALPHA + g0 * acc[ai][bj][m][0], v1 = b1 * ALPHA + g1 * acc[ai][bj][m][1];
                    u32x4 w; w.x = pg8::cvt_pk_bf16(v0[0], v0[1]); w.y = pg8::cvt_pk_bf16(v0[2], v0[3]); w.z = pg8::cvt_pk_bf16(v1[0], v1[1]); w.w = pg8::cvt_pk_bf16(v1[2], v1[3]);
                    *(u32x4*)(T + ro + c) = w; } }
    }
};
struct PanelStats {
    unsigned* xbuf; unsigned* cnt; float eps;
    __device__ __forceinline__ void run(const f32x4 (&v)[2][2][4][2], const pg8::Unit& u, int wr, int wc, int fr, int fq, LAS unsigned char* lds, int wid, int lane) const {
        LAS f32x2* P = (LAS f32x2*)(lds + LN_LDS);
        LAS f32x2* S = (LAS f32x2*)(lds + LN_LDS + 8192);
#pragma unroll
        for (int ai = 0; ai < 2; ++ai)
#pragma unroll
            for (int m = 0; m < 4; ++m) {
                float s = 0.f;
#pragma unroll
                for (int bj = 0; bj < 2; ++bj)
#pragma unroll
                    for (int n = 0; n < 2; ++n) { const f32x4 x = v[ai][bj][m][n]; s += (x[0] + x[1]) + (x[2] + x[3]); }
                s += __shfl_xor(s, 16); s += __shfl_xor(s, 32);
                const float mw = s * (1.0f / 64.0f); float q = 0.f;
#pragma unroll
                for (int bj = 0; bj < 2; ++bj)
#pragma unroll
                    for (int n = 0; n < 2; ++n) { const f32x4 d = v[ai][bj][m][n] - mw; q += (d[0] * d[0] + d[1] * d[1]) + (d[2] * d[2] + d[3] * d[3]); }
                q += __shfl_xor(q, 16); q += __shfl_xor(q, 32);
                if (fq == 0) P[(ai * 128 + wr * 64 + m * 16 + fr) * 4 + wc] = (f32x2){mw, q};
                __builtin_amdgcn_sched_barrier(0);
            }
        asm volatile("s_waitcnt lgkmcnt(0)" ::: "memory"); __builtin_amdgcn_s_barrier(); asm volatile("" ::: "memory");
        const int row = wid * 32 + (lane & 31);
        if (lane < 32) {
            const f32x2 a = P[row * 4 + 0], b = P[row * 4 + 1], c = P[row * 4 + 2], d = P[row * 4 + 3];
            const float mt = (a.x + b.x + c.x + d.x) * 0.25f;
            const float da = a.x - mt, db = b.x - mt, dc = c.x - mt, dd = d.x - mt;
            const float m2 = (a.y + b.y) + (c.y + d.y) + 64.0f * ((da * da + db * db) + (dc * dc + dd * dd));
            unsigned long long* slot = (unsigned long long*)xbuf + ((size_t)(u.pm * 256 + row) * 4 + u.pn);
            __hip_atomic_store(slot, ((unsigned long long)__float_as_uint(m2) << 32) | __float_as_uint(mt), __ATOMIC_RELAXED, __HIP_MEMORY_SCOPE_AGENT);
        }
        asm volatile("s_waitcnt vmcnt(0)" ::: "memory");
        if (lane == 0) __hip_atomic_fetch_add(cnt + 64 * u.pm, 1u, __ATOMIC_RELAXED, __HIP_MEMORY_SCOPE_AGENT);
        if (wid == 0) {
            unsigned sp = 0;
            while ((unsigned)__builtin_amdgcn_readfirstlane(__hip_atomic_load(cnt + 64 * u.pm, __ATOMIC_RELAXED, __HIP_MEMORY_SCOPE_AGENT)) < 32u && ++sp < (1u << 21)) __builtin_amdgcn_s_sleep(2);
            __builtin_amdgcn_fence(__ATOMIC_ACQUIRE, "agent");
        }
        asm volatile("s_waitcnt vmcnt(0) lgkmcnt(0)" ::: "memory"); __builtin_amdgcn_s_barrier(); asm volatile("" ::: "memory");
        if (lane < 32) {
            const unsigned long long* slot = (const unsigned long long*)xbuf + (size_t)(u.pm * 256 + row) * 4; float mt[4], m2[4]; float ms = 0.f;
#pragma unroll
            for (int t = 0; t < 4; ++t) { const unsigned long long w = __hip_atomic_load(slot + t, __ATOMIC_RELAXED, __HIP_MEMORY_SCOPE_AGENT); mt[t] = __uint_as_float((unsigned)w); m2[t] = __uint_as_float((unsigned)(w >> 32)); ms += mt[t]; }
            const float mean = ms * 0.25f; float q = 0.f;
#pragma unroll
            for (int t = 0; t < 4; ++t) { const float dm = mt[t] - mean; q += m2[t] + 256.0f * dm * dm; }
            S[row] = (f32x2){mean, 1.0f / sqrtf(q * (1.0f / 1024.0f) + eps)};
        }
        asm volatile("s_waitcnt lgkmcnt(0)" ::: "memory"); __builtin_amdgcn_s_barrier(); asm volatile("" ::: "memory");
    }
};
template <bool FINAL> struct EpiResLn {
    static constexpr bool PERM = true;
    const void* base; const float* gate; const float* lg; const float* lb; const float* mod; bf16_t* X1B; bf16_t* XN; float* out; PanelStats st; LAS unsigned char* lds;
    __device__ __forceinline__ void operator()(f32x4 (&acc)[2][2][4][2], const pg8::Unit& u, int wr, int wc, int fr, int fq) const {
        asm volatile("" : "+v"(fr), "+v"(fq));
        const int row0 = u.pm * 256 + wr * 64 + fr, c0 = u.pn * 256 + wc * 32 + 8 * fq;
        f32x4 gv[2][2];
#pragma unroll
        for (int bj = 0; bj < 2; ++bj) { int c = c0 + bj * 128; asm volatile("" : "+v"(c)); gv[bj][0] = *(const f32x4*)(gate + c); gv[bj][1] = *(const f32x4*)(gate + c + 4); }
        constexpr int LD_D = 4;
        f32x4 bf_[LD_D][2][2]; u32x4 bw_[LD_D][2];
#define ERL_LOAD(g) do { int rr_ = row0 + ((g) >> 2) * 128 + ((g) & 3) * 16; asm volatile("" : "+v"(rr_)); const size_t ro = (size_t)rr_ * DM; \
        _Pragma("unroll") for (int bj = 0; bj < 2; ++bj) { const int c = c0 + bj * 128; \
            if (FINAL) bw_[(g) % LD_D][bj] = *(const u32x4*)((const bf16_t*)base + ro + c); \
            else { bf_[(g) % LD_D][bj][0] = *(const f32x4*)((const float*)base + ro + c); bf_[(g) % LD_D][bj][1] = *(const f32x4*)((const float*)base + ro + c + 4); } } } while (0)
#pragma unroll
        for (int g = 0; g < LD_D; ++g) ERL_LOAD(g);
#pragma unroll
        for (int g = 0; g < 8; ++g) { const int ai = g >> 2, m = g & 3;
#pragma unroll
            for (int bj = 0; bj < 2; ++bj) { f32x4 b0, b1;
                if (FINAL) { const u32x4 bw = bw_[g % LD_D][bj]; b0 = (f32x4){bflo(bw.x), bfhi(bw.x), bflo(bw.y), bfhi(bw.y)}; b1 = (f32x4){bflo(bw.z), bfhi(bw.z), bflo(bw.w), bfhi(bw.w)}; }
                else { b0 = bf_[g % LD_D][bj][0]; b1 = bf_[g % LD_D][bj][1]; }
                acc[ai][bj][m][0] = b0 * ALPHA + gv[bj][0] * acc[ai][bj][m][0]; acc[ai][bj][m][1] = b1 * ALPHA + gv[bj][1] * acc[ai][bj][m][1];
                asm volatile("" : "+v"(acc[ai][bj][m][0]), "+v"(acc[ai][bj][m][1])); }
            if (g + LD_D < 8) ERL_LOAD(g + LD_D);
            __builtin_amdgcn_sched_barrier(0); }
#undef ERL_LOAD
        st.run(acc, u, wr, wc, fr, fq, lds, wr * 4 + wc, fq * 16 + fr);
        const LAS f32x2* S = (const LAS f32x2*)(lds + LN_LDS + 8192);
        f32x4 cg[2][2], cb[2][2], cs[2][2], ct[2][2];
#pragma unroll
        for (int bj = 0; bj < 2; ++bj) { int c = c0 + bj * 128; asm volatile("" : "+v"(c));
            cg[bj][0] = *(const f32x4*)(lg + c); cg[bj][1] = *(const f32x4*)(lg + c + 4); cb[bj][0] = *(const f32x4*)(lb + c); cb[bj][1] = *(const f32x4*)(lb + c + 4);
            if (!FINAL) { cs[bj][0] = *(const f32x4*)(mod + 4096 + c) + 1.0f; cs[bj][1] = *(const f32x4*)(mod + 4096 + c + 4) + 1.0f; ct[bj][0] = *(const f32x4*)(mod + 3072 + c); ct[bj][1] = *(const f32x4*)(mod + 3072 + c + 4); } }
#pragma unroll
        for (int ai = 0; ai < 2; ++ai)
#pragma unroll
            for (int m = 0; m < 4; ++m) { int r = ai * 128 + wr * 64 + m * 16 + fr; asm volatile("" : "+v"(r)); const f32x2 sr = S[r]; const size_t ro = (size_t)(u.pm * 256 + r) * DM;
#pragma unroll
                for (int bj = 0; bj < 2; ++bj) { const int c = c0 + bj * 128;
                    const f32x4 y0 = (acc[ai][bj][m][0] - sr.x) * sr.y * cg[bj][0] + cb[bj][0];
                    const f32x4 y1 = (acc[ai][bj][m][1] - sr.x) * sr.y * cg[bj][1] + cb[bj][1];
                    if (FINAL) { __builtin_nontemporal_store(y0, (f32x4*)(out + ro + c)); __builtin_nontemporal_store(y1, (f32x4*)(out + ro + c + 4)); }
                    else { u32x4 w; w.x = pg8::cvt_pk_bf16(y0[0], y0[1]); w.y = pg8::cvt_pk_bf16(y0[2], y0[3]); w.z = pg8::cvt_pk_bf16(y1[0], y1[1]); w.w = pg8::cvt_pk_bf16(y1[2], y1[3]);
                        *(u32x4*)(X1B + ro + c) = w;
                        const f32x4 h0 = y0 * cs[bj][0] + ct[bj][0], h1 = y1 * cs[bj][1] + ct[bj][1];
                        u32x4 w2; w2.x = pg8::cvt_pk_bf16(h0[0], h0[1]); w2.y = pg8::cvt_pk_bf16(h0[2], h0[3]); w2.z = pg8::cvt_pk_bf16(h1[0], h1[1]); w2.w = pg8::cvt_pk_bf16(h1[2], h1[3]);
                        *(u32x4*)(XN + ro + c) = w2; } }
                __builtin_amdgcn_sched_barrier(0); }
    }
};
struct EpiSlab {
    static constexpr bool PERM = true;
    float* slab;
    __device__ __forceinline__ void operator()(const f32x4 (&acc)[2][2][4][2], const pg8::Unit& u, int wr, int wc, int fr, int fq) const {
        asm volatile("" : "+v"(fr), "+v"(fq));
        const int row0 = wr * 64 + fr, c0 = u.pn * 256 + wc * 32 + 8 * fq; float* sb = slab + (size_t)u.ks * NSMP * DM;
#pragma unroll
        for (int ai = 0; ai < 2; ++ai)
#pragma unroll
            for (int m = 0; m < 4; ++m) { float* op = sb + (size_t)(row0 + ai * 128 + m * 16) * DM + c0;
#pragma unroll
                for (int bj = 0; bj < 2; ++bj) { *(f32x4*)(op + bj * 128) = acc[ai][bj][m][0]; *(f32x4*)(op + bj * 128 + 4) = acc[ai][bj][m][1]; } }
    }
};
struct EpiFfn {
    static constexpr bool PERM = true;
    bf16_t* ACT;
    __device__ __forceinline__ void operator()(const f32x4 (&acc)[2][2][4][2], const pg8::Unit& u, int wr, int wc, int fr, int fq) const {
        asm volatile("" : "+v"(fr), "+v"(fq));
        const int row0 = u.pm * 256 + wr * 64 + fr, c0 = u.pn * 128 + wc * 32 + 8 * fq;
#pragma unroll
        for (int ai = 0; ai < 2; ++ai)
#pragma unroll
            for (int m = 0; m < 4; ++m) { const f32x4 g0 = acc[ai][0][m][0], g1 = acc[ai][0][m][1], u0 = acc[ai][1][m][0], u1 = acc[ai][1][m][1];
                u32x4 w; w.x = pg8::cvt_pk_bf16(siluf_(g0[0]) * u0[0], siluf_(g0[1]) * u0[1]); w.y = pg8::cvt_pk_bf16(siluf_(g0[2]) * u0[2], siluf_(g0[3]) * u0[3]);
                w.z = pg8::cvt_pk_bf16(siluf_(g1[0]) * u1[0], siluf_(g1[1]) * u1[1]); w.w = pg8::cvt_pk_bf16(siluf_(g1[2]) * u1[2], siluf_(g1[3]) * u1[3]);
                *(u32x4*)(ACT + (size_t)(row0 + ai * 128 + m * 16) * DFF + c0) = w; }
    }
};

struct Frame {
    LAS unsigned char* lds; unsigned char* ldsg;
    int tid, lane, wave, G, bid;
    const float* const* in; float* out; unsigned char* ws;
};
enum { I_XP = 0, I_XS, I_CDK, I_CDV, I_CFK, I_CFV, I_CFL, I_CP, I_CS, I_WADA, I_BADA, I_WIN, I_BF, I_LQ1, I_LK1, I_LQ2, I_LK2, I_SUBG, I_RELB, I_WA, I_WB, I_WO, I_LN1G, I_LN1B, I_LN2G, I_LN2B, I_WFI, I_WFO };

__device__ __forceinline__ void tr_item(const float* W, int ldw, int src_n0, int k0, bf16_t* WT, int ldt, int dst_row0, int dst_k0, int dup_off, LAS float* scr, int lane) {
#pragma unroll 8
    for (int i = 0; i < 32; ++i) { const int kk = 2 * i + (lane >> 5); scr[kk * 33 + (lane & 31)] = W[(size_t)(k0 + kk) * ldw + src_n0 + (lane & 31)]; }
    asm volatile("s_waitcnt lgkmcnt(0)" ::: "memory");
    const int c = lane & 7;
#pragma unroll
    for (int j = 0; j < 4; ++j) { const int n = (lane >> 3) + 8 * j; const LAS float* s = scr + (8 * c) * 33 + n;
        u32x4 o; o.x = pk2(s[0 * 33], s[1 * 33]); o.y = pk2(s[2 * 33], s[3 * 33]); o.z = pk2(s[4 * 33], s[5 * 33]); o.w = pk2(s[6 * 33], s[7 * 33]);
        bf16_t* d = WT + (size_t)(dst_row0 + n) * ldt + dst_k0 + 8 * c;
        *(u32x4*)d = o; if (dup_off) *(u32x4*)(d + dup_off) = o; }
    asm volatile("s_waitcnt lgkmcnt(0)" ::: "memory");
}
__device__ __forceinline__ void weight_copies(Frame& F, int c, int n, int it0, int it1) {
    LAS float* scr = (LAS float*)(F.lds + F.wave * 16384);
    const int gw = c * 8 + F.wave, NGW = n * 8;
    constexpr int I_IN = 16 * (NZ / 32), I_A = 8 * 32, I_B = 8 * 32, I_O = 16 * 32, I_FI = 16 * (NFF2 / 32), I_FO = (DFF / 64) * 32;
    for (int it = it0 + gw; it < it1; it += NGW) {
        int r = it;
        if (r < I_IN) { const int nb = NZ / 32, kb = r / nb, n0 = 32 * (r % nb); tr_item(F.in[I_WIN], WIN_COLS, n0 < 3072 ? n0 : n0 + 8, 64 * kb, (bf16_t*)(F.ws + WS_WIN), 1024, n0, 64 * kb, 0, scr, F.lane); continue; } r -= I_IN;
        if (r < I_A) { const int kb = r / 32, n0 = 32 * (r % 32); tr_item(F.in[I_WA], 1024, n0, 64 * kb, (bf16_t*)(F.ws + WS_WAB), 512, n0, 64 * kb, 0, scr, F.lane); continue; } r -= I_A;
        if (r < I_B) { const int kb = r / 32, n0 = 32 * (r % 32); tr_item(F.in[I_WB], 1024, n0, 64 * kb, (bf16_t*)(F.ws + WS_WAB), 512, 1024 + n0, 64 * kb, 0, scr, F.lane); continue; } r -= I_B;
        if (r < I_O) { const int kb = r / 32, n0 = 32 * (r % 32); tr_item(F.in[I_WO], 1024, n0, 64 * kb, (bf16_t*)(F.ws + WS_WO2), 2048, n0, 64 * kb, 1024, scr, F.lane); continue; } r -= I_O;
        if (r < I_FI) { const int nb = NFF2 / 32, kb = r / nb, n0 = 32 * (r % nb), t = n0 >> 8, j = n0 & 255; const int src = j < 128 ? 128 * t + j : DFF + 128 * t + (j - 128);
            tr_item(F.in[I_WFI], NFF2, src, 64 * kb, (bf16_t*)(F.ws + WS_WFI), 1024, n0, 64 * kb, 0, scr, F.lane); continue; } r -= I_FI;
        { const int kb = r / 32, n0 = 32 * (r % 32); tr_item(F.in[I_WFO], 1024, n0, 64 * kb, (bf16_t*)(F.ws + WS_WFO), DFF, n0, 64 * kb, 0, scr, F.lane); }
    }
}
constexpr int WC_IN = 16 * (NZ / 32), WC_ALL = WC_IN + 8 * 32 + 8 * 32 + 16 * 32 + 16 * (NFF2 / 32) + (DFF / 64) * 32;
__device__ __forceinline__ void p0_prologue(Frame& F) {
    if (F.bid < 96) {
        LAS float* sc = (LAS float*)F.lds;
        LAS float* part = sc + 17 * 1024;
        const int n = F.bid * 64 + F.lane; const float* wa = F.in[I_WADA] + n + (size_t)(F.wave * 128) * 6144;
        float w[32];
#pragma unroll
        for (int j = 0; j < 32; ++j) w[j] = wa[(size_t)j * 6144];
        { float cv[34];
#pragma unroll
          for (int j = 0; j < 34; ++j) { const int i = F.tid + 512 * j, r = i >> 10, k = i & 1023; cv[j] = r == 0 ? F.in[I_CP][k] : F.in[I_CS][(r - 1) * 1024 + k]; }
#pragma unroll
          for (int j = 0; j < 34; ++j) sc[F.tid + 512 * j] = siluf_(cv[j]); }
        __syncthreads();
        float acc[17];
#pragma unroll
        for (int r = 0; r < 17; ++r) acc[r] = 0.f;
#pragma unroll
        for (int kb = 0; kb < 128; kb += 32) {
            float wn[32];
            if (kb + 32 < 128) {
#pragma unroll
                for (int j = 0; j < 32; ++j) wn[j] = wa[(size_t)(kb + 32 + j) * 6144]; }
#pragma unroll
            for (int j = 0; j < 32; j += 4) { const int k = F.wave * 128 + kb + j;
#pragma unroll
                for (int r = 0; r < 17; ++r) { const f32x4 s = *(const LAS f32x4*)(sc + r * 1024 + k); acc[r] += s[0] * w[j] + s[1] * w[j + 1] + s[2] * w[j + 2] + s[3] * w[j + 3]; } }
            if (kb + 32 < 128) {
#pragma unroll
                for (int j = 0; j < 32; ++j) w[j] = wn[j]; }
        }
#pragma unroll
        for (int r = 0; r < 17; ++r) part[(F.wave * 17 + r) * 64 + F.lane] = acc[r];
        __syncthreads();
        float* mod = (float*)(F.ws + WS_MOD);
        for (int i = F.tid; i < 17 * 64; i += 512) { const int r = i >> 6, l = i & 63; float s = 0.f;
#pragma unroll
            for (int w = 0; w < 8; ++w) s += part[(w * 17 + r) * 64 + l];
            mod[r * 6144 + F.bid * 64 + l] = s + F.in[I_BADA][F.bid * 64 + l]; }
        asm volatile("s_waitcnt vmcnt(0)" ::: "memory");
        __syncthreads();
        if (F.tid == 0) { __builtin_amdgcn_fence(__ATOMIC_RELEASE, "agent"); asm volatile("s_waitcnt vmcnt(0)" ::: "memory");
            __hip_atomic_fetch_add((unsigned*)(F.ws + WS_CTL) + 320, 1u, __ATOMIC_RELAXED, __HIP_MEMORY_SCOPE_AGENT); }
    }
    if (F.G >= 192) { if (F.bid >= 96) weight_copies(F, F.bid - 96, F.G - 96, 0, 16 * (NZ / 32)); }
    else weight_copies(F, F.bid, F.G, 0, 16 * (NZ / 32));
}

__device__ __forceinline__ void p1_rows(Frame& F, bool wait_mod) {
    LAS float* wf = (LAS float*)F.lds;
    for (int i = F.tid; i < 1024 * 8; i += 512) wf[i] = F.in[I_WIN][(size_t)(i >> 3) * WIN_COLS + 3072 + (i & 7)];
    __syncthreads();
    const float* mod = (const float*)(F.ws + WS_MOD);
    bf16_t* XN = (bf16_t*)(F.ws + WS_XN);
    const int gw = F.bid * 8 + F.wave, NGW = F.G * 8;
    if (wait_mod) {
        if (F.tid == 0) { unsigned* w = (unsigned*)(F.ws + WS_CTL) + 320; unsigned sp = 0;
            while (__hip_atomic_load(w, __ATOMIC_RELAXED, __HIP_MEMORY_SCOPE_AGENT) < 96u && ++sp < (1u << 22)) __builtin_amdgcn_s_sleep(2);
            __builtin_amdgcn_fence(__ATOMIC_ACQUIRE, "agent"); asm volatile("s_waitcnt vmcnt(0)" ::: "memory"); }
        __syncthreads(); }
    int m = gw;
    for (; m + NGW < SEQ; m += 2 * NGW) {
        const float* xr0 = F.in[I_XP] + (size_t)m * DM; const float* xr1 = xr0 + (size_t)NGW * DM;
        float a8[2][8];
#pragma unroll
        for (int j = 0; j < 8; ++j) { a8[0][j] = 0.f; a8[1][j] = 0.f; }
#pragma unroll
        for (int j = 0; j < 4; ++j) { const int k = 4 * F.lane + 256 * j;
            const f32x4 x0 = *(const f32x4*)(xr0 + k), x1 = *(const f32x4*)(xr1 + k), s1 = *(const f32x4*)(mod + 1024 + k), t1 = *(const f32x4*)(mod + k);
            const f32x4 h0 = x0 * (s1 + 1.0f) + t1, h1 = x1 * (s1 + 1.0f) + t1;
            u32x2 w; w.x = pk2(h0[0], h0[1]); w.y = pk2(h0[2], h0[3]); *(u32x2*)(XN + (size_t)m * DM + k) = w;
            w.x = pk2(h1[0], h1[1]); w.y = pk2(h1[2], h1[3]); *(u32x2*)(XN + (size_t)(m + NGW) * DM + k) = w;
#pragma unroll
            for (int e = 0; e < 4; ++e) { const f32x4 wa = *(const LAS f32x4*)(wf + (k + e) * 8), wb = *(const LAS f32x4*)(wf + (k + e) * 8 + 4);
#pragma unroll
                for (int c = 0; c < 4; ++c) { a8[0][c] += h0[e] * wa[c]; a8[0][4 + c] += h0[e] * wb[c]; a8[1][c] += h1[e] * wa[c]; a8[1][4 + c] += h1[e] * wb[c]; } } }
        float mine = 0.f;
#pragma unroll
        for (int j = 0; j < 8; ++j) { const float s0 = wave_sum(a8[0][j]), s1 = wave_sum(a8[1][j]); if (F.lane == j) mine = s0; if (F.lane == 8 + j) mine = s1; }
        if (F.lane < 16) { const int rr = F.lane >> 3, c = F.lane & 7; const float v = mine + F.in[I_BF][c]; const float lf = fminf(v, 0.f) - log1pf(__expf(-fabsf(v)));
            F.out[O_FLP + (size_t)(m + rr * NGW) * 8 + c] = lf; }
    }
    for (; m < MT; m += NGW) {
        const bool smp = m >= SEQ; const int rb = smp ? 1 + ((m - SEQ) >> 4) : 0;
        const float* xr = smp ? F.in[I_XS] + (size_t)(m - SEQ) * DM : F.in[I_XP] + (size_t)m * DM;
        const float* sh = mod + (size_t)rb * 6144, *scl = sh + 1024;
        float a8[8];
#pragma unroll
        for (int j = 0; j < 8; ++j) a8[j] = 0.f;
#pragma unroll
        for (int j = 0; j < 4; ++j) { const int k = 4 * F.lane + 256 * j;
            const f32x4 x = *(const f32x4*)(xr + k), s1 = *(const f32x4*)(scl + k), t1 = *(const f32x4*)(sh + k);
            const f32x4 h = x * (s1 + 1.0f) + t1;
            u32x2 w; w.x = pk2(h[0], h[1]); w.y = pk2(h[2], h[3]); *(u32x2*)(XN + (size_t)m * DM + k) = w;
#pragma unroll
            for (int e = 0; e < 4; ++e) { const f32x4 wa = *(const LAS f32x4*)(wf + (k + e) * 8), wb = *(const LAS f32x4*)(wf + (k + e) * 8 + 4);
                a8[0] += h[e] * wa[0]; a8[1] += h[e] * wa[1]; a8[2] += h[e] * wa[2]; a8[3] += h[e] * wa[3];
                a8[4] += h[e] * wb[0]; a8[5] += h[e] * wb[1]; a8[6] += h[e] * wb[2]; a8[7] += h[e] * wb[3]; } }
        float mine = 0.f;
#pragma unroll
        for (int j = 0; j < 8; ++j) { const float s = wave_sum(a8[j]); if (F.lane == j) mine = s; }
        if (F.lane < 8) { const float v = mine + F.in[I_BF][F.lane]; const float lf = fminf(v, 0.f) - log1pf(__expf(-fabsf(v)));
            float* o = smp ? F.out + O_FLS + (size_t)(m - SEQ) * 8 : F.out + O_FLP + (size_t)m * 8; o[F.lane] = lf; }
    }
}

__device__ __forceinline__ float block_excl_scan(Frame& F, float tot, LAS float* sm) {
    float inc = tot;
#pragma unroll
    for (int o = 1; o < 64; o <<= 1) { const float t = __shfl_up(inc, o); if (F.lane >= o) inc += t; }
    if (F.lane == 63) sm[F.wave] = inc;
    __syncthreads();
    float base = 0.f;
    for (int w = 0; w < F.wave; ++w) base += sm[w];
    __syncthreads();
    return base + inc - tot;
}
__device__ __forceinline__ void p2_cumsum(Frame& F) {
    LAS float* sm = (LAS float*)F.lds;
    const int rb_ = F.G >= 160 ? F.bid - 20 : F.bid;
    if (rb_ < 0) return;
    if (rb_ < 8) {
        const int h = rb_; const float* lf = F.out + O_FLP; float* Fp = (float*)(F.ws + WS_FP) + (size_t)h * SEQ;
        float v[32]; float run = 0.f;
#pragma unroll
        for (int i = 0; i < 32; ++i) { run += lf[(size_t)(32 * F.tid + i) * 8 + h]; v[i] = run; }
        const float off = block_excl_scan(F, run, sm);
#pragma unroll
        for (int i = 0; i < 32; i += 4) *(f32x4*)(Fp + 32 * F.tid + i) = (f32x4){(off + v[i]) * LOG2E, (off + v[i + 1]) * LOG2E, (off + v[i + 2]) * LOG2E, (off + v[i + 3]) * LOG2E};
    } else if (rb_ < 8 + 128) {
        const int b = (rb_ - 8) >> 3, h = (rb_ - 8) & 7;
        const float* cl = F.in[I_CFL] + (size_t)b * PAST * 8; float* Fs = (float*)(F.ws + WS_FS) + (size_t)(b * 8 + h) * SKV;
        float v[4]; float run = 0.f;
#pragma unroll
        for (int i = 0; i < 4; ++i) { run += cl[(size_t)(4 * F.tid + i) * 8 + h]; v[i] = run; }
        const float off = block_excl_scan(F, run, sm);
        *(f32x4*)(Fs + 4 * F.tid) = (f32x4){(off + v[0]) * LOG2E, (off + v[1]) * LOG2E, (off + v[2]) * LOG2E, (off + v[3]) * LOG2E};
        if (F.tid == 511) { float r2 = off + run; const float* ls = F.out + O_FLS + (size_t)b * DEC_T * 8;
            for (int t = 0; t < DEC_T; ++t) { r2 += ls[t * 8 + h]; Fs[PAST + t] = r2 * LOG2E; } }
    }
}

template <bool FINAL> __device__ __forceinline__ void ln_rows(Frame& F, const float* g, const float* b, int KS, int gate_off) {
    const float* mod = (const float*)(F.ws + WS_MOD);
    const bf16_t* T = (const bf16_t*)(F.ws + WS_TB); bf16_t* X1B = (bf16_t*)(F.ws + WS_X1B); bf16_t* XN = (bf16_t*)(F.ws + WS_XN);
    const int gw = F.wave * F.G + F.bid, NGW = F.G * 8;
    for (int m = SEQ + gw; m < MT; m += NGW) {
        f32x4 v[4]; float s = 0.f;
        if (m < SEQ) {
#pragma unroll
            for (int j = 0; j < 2; ++j) { const u32x4 w = *(const u32x4*)(T + (size_t)m * DM + 8 * F.lane + 512 * j);
                v[2 * j] = (f32x4){bflo(w.x), bfhi(w.x), bflo(w.y), bfhi(w.y)}; v[2 * j + 1] = (f32x4){bflo(w.z), bfhi(w.z), bflo(w.w), bfhi(w.w)}; }
        } else {
            const float* sl = (const float*)(F.ws + WS_SLAB) + (size_t)(m - SEQ) * DM; const float* gp = mod + (size_t)(1 + ((m - SEQ) >> 4)) * 6144 + gate_off;
#pragma unroll
            for (int q = 0; q < 4; ++q) { const int k = 8 * F.lane + 512 * (q >> 1) + 4 * (q & 1); f32x4 a = (f32x4){0.f, 0.f, 0.f, 0.f};
                { constexpr int KSC = FINAL ? 11 : 8; f32x4 sv[KSC];
#pragma unroll
                  for (int ks = 0; ks < KSC; ++ks) sv[ks] = *(const f32x4*)(sl + (size_t)ks * NSMP * DM + k);
#pragma unroll
                  for (int ks = 0; ks < KSC; ++ks) a += sv[ks]; }
                f32x4 bs;
                if (FINAL) { const u32x2 w = *(const u32x2*)(X1B + (size_t)m * DM + k); bs = (f32x4){bflo(w.x), bfhi(w.x), bflo(w.y), bfhi(w.y)}; }
                else bs = *(const f32x4*)(F.in[I_XS] + (size_t)(m - SEQ) * DM + k);
                v[q] = bs * ALPHA + *(const f32x4*)(gp + k) * a; } }
#pragma unroll
        for (int q = 0; q < 4; ++q) s += (v[q][0] + v[q][1]) + (v[q][2] + v[q][3]);
        const float mean = wave_sum(s) * (1.f / DM); float s2 = 0.f;
#pragma unroll
        for (int q = 0; q < 4; ++q) { v[q] = v[q] - mean; s2 += (v[q][0] * v[q][0] + v[q][1] * v[q][1]) + (v[q][2] * v[q][2] + v[q][3] * v[q][3]); }
        const float rstd = 1.f / sqrtf(wave_sum(s2) * (1.f / DM) + LN_EPS);
        const int rb = m >= SEQ ? 1 + ((m - SEQ) >> 4) : 0;
#pragma unroll
        for (int q = 0; q < 4; ++q) { const int k = 8 * F.lane + 512 * (q >> 1) + 4 * (q & 1); const f32x4 gg = *(const f32x4*)(g + k), bb = *(const f32x4*)(b + k);
            const f32x4 y = v[q] * rstd * gg + bb;
            if (FINAL) *(f32x4*)(F.out + (size_t)m * DM + k) = y;
            else { u32x2 w; w.x = pk2(y[0], y[1]); w.y = pk2(y[2], y[3]); *(u32x2*)(X1B + (size_t)m * DM + k) = w;
                const f32x4 s2v = *(const f32x4*)(mod + (size_t)rb * 6144 + 4096 + k), t2v = *(const f32x4*)(mod + (size_t)rb * 6144 + 3072 + k);
                const f32x4 h = y * (s2v + 1.0f) + t2v; u32x2 w2; w2.x = pk2(h[0], h[1]); w2.y = pk2(h[2], h[3]); *(u32x2*)(XN + (size_t)m * DM + k) = w2; } }
    }
}

__device__ __forceinline__ int t5_bucket(int rel) {
    const int n = rel < 0 ? -rel : rel; int b;
    if (n < 8) b = n; else if (n < 12) b = 8; else if (n < 16) b = 9; else if (n < 23) b = 10; else if (n < 32) b = 11; else if (n < 46) b = 12; else if (n < 64) b = 13; else if (n < 91) b = 14; else b = 15;
    return b + (rel > 0 ? 16 : 0);
}
constexpr int AT_KB = 8192, AT_VB = 20480, AT_BUF = AT_KB + AT_VB;
constexpr int AT_WS = 2 * AT_BUF, AT_OST = AT_WS + 2048, AT_KEEP = 98304, AT_TAB = 131072, AT_MISC = AT_TAB + 4 * 192 * 4, AT_END = AT_MISC + 64;
__device__ __forceinline__ s16x4 vtr(const LAS char* p) { typedef short v4i16_t __attribute__((ext_vector_type(4))); return __builtin_bit_cast(s16x4, __builtin_amdgcn_ds_read_tr16_b64_v4i16((LAS v4i16_t*)p)); }

typedef __bf16 bf16x2_t_ __attribute__((ext_vector_type(2)));
__device__ __forceinline__ unsigned cvtpk_(float lo, float hi) { f32x2 v = {lo, hi}; bf16x2_t_ b = __builtin_convertvector(v, bf16x2_t_); return __builtin_bit_cast(unsigned, b); }
__device__ __forceinline__ void glds16_asm(const void* gsrc, unsigned lds_dst) { unsigned keep;
    asm volatile("s_mov_b32 %0, m0\n\ts_mov_b32 m0, %2\n\ts_nop 0\n\tglobal_load_lds_dwordx4 %1, off\n\ts_mov_b32 m0, %0" : "=&s"(keep) : "v"(gsrc), "s"(lds_dst) : "memory"); }
template <int OFF> __device__ __forceinline__ void glds16_asm_off(const void* gsrc, unsigned lds_dst) { unsigned keep;
    asm volatile("s_mov_b32 %0, m0\n\ts_mov_b32 m0, %2\n\ts_nop 0\n\tglobal_load_lds_dwordx4 %1, off offset:%3\n\ts_mov_b32 m0, %0" : "=&s"(keep) : "v"(gsrc), "s"(lds_dst), "i"(OFF) : "memory"); }
template <int OFF> __device__ __forceinline__ void glds16_s(const void* sbase, unsigned voff, unsigned lds_dst) { unsigned keep;
    asm volatile("s_mov_b32 %0, m0\n\ts_mov_b32 m0, %3\n\ts_nop 0\n\tglobal_load_lds_dwordx4 %1, %2 offset:%4\n\ts_mov_b32 m0, %0" : "=&s"(keep) : "v"(voff), "s"(sbase), "s"(lds_dst), "i"(OFF) : "memory"); }
__device__ __forceinline__ void glds4_s(const void* sbase, unsigned voff, unsigned lds_dst) { unsigned keep;
    asm volatile("s_mov_b32 %0, m0\n\ts_mov_b32 m0, %3\n\ts_nop 0\n\tglobal_load_lds_dword %1, %2\n\ts_mov_b32 m0, %0" : "=&s"(keep) : "v"(voff), "s"(sbase), "s"(lds_dst) : "memory"); }
__device__ __forceinline__ const void* uniform_ptr(const void* p) { const unsigned long long v = (unsigned long long)p;
    const unsigned lo = (unsigned)__builtin_amdgcn_readfirstlane((int)(unsigned)v), hi = (unsigned)__builtin_amdgcn_readfirstlane((int)(unsigned)(v >> 32)); return (const void*)(((unsigned long long)hi << 32) | lo); }
__device__ __forceinline__ void glds4_asm(const void* gsrc, unsigned lds_dst) { unsigned keep;
    asm volatile("s_mov_b32 %0, m0\n\ts_mov_b32 m0, %2\n\ts_nop 0\n\tglobal_load_lds_dword %1, off\n\ts_mov_b32 m0, %0" : "=&s"(keep) : "v"(gsrc), "s"(lds_dst) : "memory"); }
constexpr int R_V = 0, R_K = 49152, R_F = 73728, R_WS = 79872;
__device__ __forceinline__ float max3f_(float a, float b, float c) { float r; asm("v_max3_f32 %0, %1, %2, %3" : "=v"(r) : "v"(a), "v"(b), "v"(c)); return r; }
__device__ __forceinline__ float max2f_(float a, float b) { float r; asm("v_max_f32_e32 %0, %1, %2" : "=v"(r) : "v"(a), "v"(b)); return r; }
#define AP3_PIN(x) asm volatile("" : "+v"(x))
template <int MODE, int DV, int pv = 0, bool SREF = false>
__device__ __forceinline__ void attn_pass3(Frame& F, const bf16_t* Q, const bf16_t* K, const bf16_t* V, int q0, int NT, const float* Fh, int hb, f32x16 (&o)[DV / 32], int t0 = 0) {
    constexpr int NDB = DV / 32, VS = DV * 128, EPG = 8 / NDB;
    constexpr float THR = 8.0f;
    const int lane = F.lane, r32 = lane & 31, hi = lane >> 5, wid = F.wave;
    const LAS char* lds = (const LAS char*)F.lds;
    LAS float* wsf = (LAS float*)(F.lds + R_WS) + wid * 64;
    const LAS float* tab = (const LAS float*)(F.lds + AT_TAB) + hb * 192;
    const int qrow = q0 + wid * 32 + r32;
    const int tmaxw = (q0 >> 6) + (wid >> 1);
    const char* Ku = (const char*)uniform_ptr(K); const char* Vu = (const char*)uniform_ptr(V); const char* Fu = (const char*)uniform_ptr(MODE == 0 ? (const void*)Fh : (const void*)K);
    const unsigned kvo = (unsigned)(((8 * wid + (lane >> 3)) * 512 + (((lane & 7) ^ (lane >> 3)) << 3)) * 2);
    const unsigned vvo = (unsigned)(((16 * (wid & 3) + (lane >> 2)) * 512 + 32 * (wid >> 2) + 8 * (lane & 3)) * 2);
    const unsigned fvo = (unsigned)(lane * 4);
    const unsigned lds0 = (unsigned)(size_t)F.lds;
    const unsigned dk = (unsigned)__builtin_amdgcn_readfirstlane((int)(lds0 + R_K + wid * 1024)), dv = (unsigned)__builtin_amdgcn_readfirstlane((int)(lds0 + R_V + wid * 1024)),
                   df = (unsigned)__builtin_amdgcn_readfirstlane((int)(lds0 + R_F + wid * 256));
#define AP_ISSUE_K(t, SL) do { glds16_s<0>(Ku + (size_t)(t) * 65536, kvo, dk + (SL) * 8192); if (MODE == 0) glds4_s(Fu + (size_t)(t) * 256, fvo, df + (SL) * 2048); } while (0)
#define AP_ISSUE_V(t, SL) do { glds16_s<0>(Vu + (size_t)(t) * 65536, vvo, dv + (SL) * VS); if (DV == 128) glds16_s<0>(Vu + (size_t)(t) * 65536 + 128, vvo, dv + (SL) * VS + 8192); } while (0)
#define AP_BATCH(t, SL) do { if (pv != 1) { if ((t) + 2 < NT) AP_ISSUE_K((t) + 2, ((SL) + 2) % 3); if ((t) + 1 < NT) AP_ISSUE_V((t) + 1, ((SL) + 1) % 3); } } while (0)
    AP_ISSUE_K(t0, 0); AP_ISSUE_K(t0 + 1, 1); AP_ISSUE_V(t0, 0);
    bf16x8 qr[4];
#pragma unroll
    for (int d0 = 0; d0 < 4; ++d0) qr[d0] = *(const bf16x8*)(Q + (size_t)qrow * 512 + d0 * 16 + hi * 8);
    float fqp = MODE == 0 ? Fh[qrow] : 0.f;
#pragma unroll
    for (int d = 0; d < NDB; ++d) o[d] = f32x16{};
    float m_hat = 0.f, l_run = 0.f;
    f32x16 p0, p1, negm; u32x4 pwv[4];
#pragma unroll
    for (int r = 0; r < 16; ++r) negm[r] = 0.f;
#pragma unroll
    for (int i = 0; i < 4; ++i) pwv[i] = (u32x4){0u, 0u, 0u, 0u};
    const LAS char* kb4[4];
#pragma unroll
    for (int d0 = 0; d0 < 4; ++d0) kb4[d0] = lds + R_K + r32 * 128 + (((2 * d0 + hi) ^ (r32 & 7)) << 4);
    const LAS char* vb1 = lds + R_V + (4 * hi + ((lane & 15) >> 2)) * 64 + (((lane >> 4) & 1) * 16 + (lane & 3) * 4) * 2;
    const LAS char* fb1 = lds + R_F + wid * 256 + 16 * hi;
    asm volatile("s_waitcnt vmcnt(0)" ::: "memory");
    asm volatile("" : "+v"(qr[0]), "+v"(qr[1]), "+v"(qr[2]), "+v"(qr[3]), "+v"(fqp));
    asm volatile("s_waitcnt lgkmcnt(0)\n\ts_barrier" ::: "memory");
#define AP3_VFL(buf, ks, SLV) do { _Pragma("unroll") for (int d = 0; d < NDB; ++d) { buf[2 * d] = vtr(vb1 + (SLV) * VS + d * 4096 + (ks) * 1024); buf[2 * d + 1] = vtr(vb1 + (SLV) * VS + d * 4096 + (ks) * 1024 + 512); } } while (0)
#define AP3_VFL1(buf, d, ks, SLV) do { buf[2 * (d)] = vtr(vb1 + (SLV) * VS + (d) * 4096 + (ks) * 1024); buf[2 * (d) + 1] = vtr(vb1 + (SLV) * VS + (d) * 4096 + (ks) * 1024 + 512); } while (0)
#define AP3_FRAG(buf, d) ((bf16x8){buf[2 * (d)][0], buf[2 * (d)][1], buf[2 * (d)][2], buf[2 * (d)][3], buf[2 * (d) + 1][0], buf[2 * (d) + 1][1], buf[2 * (d) + 1][2], buf[2 * (d) + 1][3]})
#define AP3_GAP(ks, d, VCUR, VNXT, PC, BC, PP, BP, HASPREV, HASNEXT, SLV) do { \
        o[d] = __builtin_amdgcn_mfma_f32_32x32x16_bf16(__builtin_bit_cast(bf16x8, pwv[ks]), AP3_FRAG(VCUR, d), o[d], 0, 0, 0); \
        if (HASNEXT) AP3_VFL1(VNXT, d, (ks) + 1, SLV); \
        _Pragma("unroll") for (int e = 0; e < EPG; ++e) { PC[(BC) + EPG * (d) + e] = __builtin_amdgcn_exp2f(PC[(BC) + EPG * (d) + e]); } \
        if (HASPREV) { _Pragma("unroll") for (int e = 0; e < EPG; ++e) rs += PP[(BP) + EPG * (d) + e]; \
            _Pragma("unroll") for (int e = 0; e < EPG / 2; ++e) pwv[(ks) - 1][(EPG / 2) * (d) + e] = cvtpk_(PP[(BP) + EPG * (d) + 2 * e], PP[(BP) + EPG * (d) + 2 * e + 1]); AP3_PIN(rs); } \
        AP3_PIN(PC); \
        __builtin_amdgcn_sched_barrier(0); } while (0)
#define AP3_GROUP(ks, VCUR, VNXT, PC, BC, PP, BP, HASPREV, HASNEXT, SLV) do { _Pragma("unroll") for (int d = 0; d < NDB; ++d) AP3_GAP(ks, d, VCUR, VNXT, PC, BC, PP, BP, HASPREV, HASNEXT, SLV); } while (0)
#define AP3_OCT(PC, BC, KS) do { _Pragma("unroll") for (int e = 0; e < 8; ++e) { PC[(BC) + e] = __builtin_amdgcn_exp2f(PC[(BC) + e]); rs += PC[(BC) + e]; } \
        _Pragma("unroll") for (int e = 0; e < 4; ++e) pwv[KS][e] = cvtpk_(PC[(BC) + 2 * e], PC[(BC) + 2 * e + 1]); } while (0)
#define AP3_KRD(i, SL) (*(const LAS bf16x8*)(kb4[(i) >> 1] + (SL) * 8192 + ((i) & 1) * 4096))
#define AP3_MM(KF, d0, P) P = __builtin_amdgcn_mfma_f32_32x32x16_bf16(KF, qr[d0], P, 0, 0, 0)
#define AP3_QKF(SL) do { bf16x8 ka = AP3_KRD(0, SL), kb = AP3_KRD(1, SL), kc = AP3_KRD(2, SL); \
        if (MODE == 0) { \
            _Pragma("unroll") for (int g4 = 0; g4 < 4; ++g4) { const f32x4 fa = *(const LAS f32x4*)(fb1 + (SL) * 2048 + 32 * g4), fb = *(const LAS f32x4*)(fb1 + (SL) * 2048 + 128 + 32 * g4); \
                _Pragma("unroll") for (int e = 0; e < 4; ++e) { p0[4 * g4 + e] = fqp - fa[e]; p1[4 * g4 + e] = fqp - fb[e]; } } \
        } else { p0 = f32x16{}; p1 = f32x16{}; } \
        __builtin_amdgcn_sched_barrier(0); \
        AP3_MM(ka, 0, p0); ka = AP3_KRD(3, SL); __builtin_amdgcn_sched_barrier(0); \
        AP3_MM(kb, 0, p1); kb = AP3_KRD(4, SL); __builtin_amdgcn_sched_barrier(0); \
        AP3_MM(kc, 1, p0); kc = AP3_KRD(5, SL); __builtin_amdgcn_sched_barrier(0); \
        AP3_MM(ka, 1, p1); ka = AP3_KRD(6, SL); __builtin_amdgcn_sched_barrier(0); \
        AP3_MM(kb, 2, p0); kb = AP3_KRD(7, SL); __builtin_amdgcn_sched_barrier(0); \
        AP3_MM(kc, 2, p1); __builtin_amdgcn_sched_barrier(0); \
        AP3_MM(ka, 3, p0); __builtin_amdgcn_sched_barrier(0); \
        AP3_MM(kb, 3, p1); \
        asm volatile("" : "+v"(p0), "+v"(p1)); \
    } while (0)
#define AP3_QKS(SL) do { bf16x8 kf[8]; \
        _Pragma("unroll") for (int d0 = 0; d0 < 4; ++d0) { kf[2 * d0] = *(const LAS bf16x8*)(kb4[d0] + (SL) * 8192); kf[2 * d0 + 1] = *(const LAS bf16x8*)(kb4[d0] + (SL) * 8192 + 4096); } \
        if (MODE == 0) { const float sft = fqp - m_hat; \
            _Pragma("unroll") for (int g4 = 0; g4 < 4; ++g4) { const f32x4 fa = *(const LAS f32x4*)(fb1 + (SL) * 2048 + 32 * g4), fb = *(const LAS f32x4*)(fb1 + (SL) * 2048 + 128 + 32 * g4); \
                _Pragma("unroll") for (int e = 0; e < 4; ++e) { p0[4 * g4 + e] = sft - fa[e]; p1[4 * g4 + e] = sft - fb[e]; } } \
            _Pragma("unroll") for (int d0 = 0; d0 < 4; ++d0) { p0 = __builtin_amdgcn_mfma_f32_32x32x16_bf16(kf[2 * d0], qr[d0], p0, 0, 0, 0); p1 = __builtin_amdgcn_mfma_f32_32x32x16_bf16(kf[2 * d0 + 1], qr[d0], p1, 0, 0, 0); } \
        } else { \
            if constexpr (SREF) { p0 = __builtin_amdgcn_mfma_f32_32x32x16_bf16(kf[0], qr[0], f32x16{}, 0, 0, 0); p1 = __builtin_amdgcn_mfma_f32_32x32x16_bf16(kf[1], qr[0], f32x16{}, 0, 0, 0); } \
            else { p0 = __builtin_amdgcn_mfma_f32_32x32x16_bf16(kf[0], qr[0], negm, 0, 0, 0); p1 = __builtin_amdgcn_mfma_f32_32x32x16_bf16(kf[1], qr[0], negm, 0, 0, 0); } \
            _Pragma("unroll") for (int d0 = 1; d0 < 4; ++d0) { p0 = __builtin_amdgcn_mfma_f32_32x32x16_bf16(kf[2 * d0], qr[d0], p0, 0, 0, 0); p1 = __builtin_amdgcn_mfma_f32_32x32x16_bf16(kf[2 * d0 + 1], qr[d0], p1, 0, 0, 0); } } \
        if constexpr (SREF) asm volatile("" : "+v"(p0), "+v"(p1)); else asm volatile("s_nop 15\n\ts_nop 7" : "+v"(p0), "+v"(p1));     \
    } while (0)
#define AP3_QK(SL) do { if constexpr (SREF) AP3_QKF(SL); else AP3_QKS(SL); } while (0)
#define AP3_DECIDE(WITH_TAB) do { \
        if (MODE == 0) { \
            if (t * 64 + 63 > q0 + wid * 32) { const int ln_ = lane_id_opaque(), kv0 = t * 64 + 4 * (ln_ >> 5), qrow_ = q0 + wid * 32 + (ln_ & 31);     \
                _Pragma("unroll") for (int r = 0; r < 16; ++r) { const int kv = kv0 + (r & 3) + 8 * (r >> 2); if (kv > qrow_) p0[r] = -1e30f; if (kv + 32 > qrow_) p1[r] = -1e30f; } } \
        } else if (WITH_TAB) { \
            if (near) { const int ln_ = lane_id_opaque(), kv0 = t * 64 + 4 * (ln_ >> 5), qrow_ = q0 + wid * 32 + (ln_ & 31); const LAS float* tab_ = (const LAS float*)(F.lds + AT_TAB) + hb * 192; \
                _Pragma("unroll") for (int g4 = 0; g4 < 4; ++g4) { \
                    _Pragma("unroll") for (int e = 0; e < 4; ++e) { const int r = 4 * g4 + e; const int rel = kv0 + e + 8 * g4 - qrow_; int i0 = rel + 128, i1 = rel + 160; i0 = i0 < 0 ? 0 : i0; i1 = i1 < 0 ? 0 : i1; \
                        p0[r] += tab_[i0]; p1[r] += tab_[i1]; } \
                    __builtin_amdgcn_sched_barrier(0); } } } \
        if constexpr (!SREF) { \
        float ma = max3f_(p0[0], p0[1], p1[0]), mb = max3f_(p0[2], p0[3], p1[1]); ma = max3f_(ma, p1[2], p1[3]); \
        _Pragma("unroll") for (int r = 4; r < 16; r += 4) { ma = max3f_(ma, p0[r], p0[r + 1]); mb = max3f_(mb, p0[r + 2], p0[r + 3]); ma = max3f_(ma, p1[r], p1[r + 1]); mb = max3f_(mb, p1[r + 2], p1[r + 3]); } \
        float rm = max2f_(ma, mb); \
        { auto rr = __builtin_amdgcn_permlane32_swap(__float_as_uint(rm), __float_as_uint(rm), false, false); rm = max2f_(__uint_as_float(rr[0]), __uint_as_float(rr[1])); } \
        resc = (tz == t0) || __any(rm > THR); \
        if (resc) { const float dl = tz == t0 ? rm : fmaxf(rm, 0.f); m_hat += dl; \
            _Pragma("unroll") for (int r = 0; r < 16; ++r) { p0[r] -= dl; p1[r] -= dl; } \
            if (MODE == 1) { const float nm_ = -m_hat; _Pragma("unroll") for (int r = 0; r < 16; ++r) negm[r] = nm_; } \
            al = tz == t0 ? 1.0f : __builtin_amdgcn_exp2f(-dl); l_run *= al; } } } while (0)
#define AP3_STEP(tt, SL) do { const int t = (tt); if (t > NT) break; int tz = t; asm volatile("" : "+s"(tz)); \
        if (t < NT) AP_BATCH(t, SL); \
        const bool doPV = tz > t0 && t - 1 <= tmaxw, doQK = t < NT && t <= tmaxw; \
        bool resc = false; float al = 1.0f, rs = 0.f; \
        const bool near = MODE == 1 && (t * 64 + 63 + 91 > q0 + wid * 32); \
        if (doQK) AP3_QK(SL); else { p0 = f32x16{}; p1 = f32x16{}; }     \
        __builtin_amdgcn_sched_barrier(0); \
        if (doQK) AP3_DECIDE(true); \
        __builtin_amdgcn_sched_barrier(0); \
        if (doPV) { s16x4 vfa[2 * NDB]; AP3_VFL(vfa, 0, ((SL) + 2) % 3);     \
            AP3_GROUP(0, vfa, vfa, p0, 0, p0, 0, false, true, ((SL) + 2) % 3); \
            AP3_GROUP(1, vfa, vfa, p0, 8, p0, 0, true, true, ((SL) + 2) % 3); \
            AP3_GROUP(2, vfa, vfa, p1, 0, p0, 8, true, true, ((SL) + 2) % 3); \
            AP3_GROUP(3, vfa, vfa, p1, 8, p1, 0, true, false, ((SL) + 2) % 3); \
            _Pragma("unroll") for (int e = 0; e < 8; ++e) rs += p1[8 + e]; \
            _Pragma("unroll") for (int e = 0; e < 4; ++e) pwv[3][e] = cvtpk_(p1[8 + 2 * e], p1[8 + 2 * e + 1]); \
        } else if (doQK) { AP3_OCT(p0, 0, 0); AP3_OCT(p0, 8, 1); AP3_OCT(p1, 0, 2); AP3_OCT(p1, 8, 3); } \
        if (doQK) l_run += rs; \
          \
        if (resc && tz > t0) { \
            if (hi == 0) wsf[r32] = al; \
            asm volatile("s_waitcnt lgkmcnt(0)" ::: "memory"); \
            _Pragma("unroll") for (int g4 = 0; g4 < 4; ++g4) { const f32x4 a4 = *(const LAS f32x4*)(wsf + 8 * g4 + 4 * hi); \
                _Pragma("unroll") for (int d = 0; d < NDB; ++d) \
                    _Pragma("unroll") for (int e = 0; e < 4; ++e) o[d][4 * g4 + e] *= a4[e]; } } \
        if (t == NT) break; \
        if (pv == 6) { if (t + 2 < NT) asm volatile("s_waitcnt vmcnt(3) lgkmcnt(0)" ::: "memory"); else asm volatile("s_waitcnt vmcnt(0) lgkmcnt(0)" ::: "memory"); } \
        else { if (t + 2 < NT) asm volatile("s_waitcnt vmcnt(3) lgkmcnt(0)\n\ts_barrier" ::: "memory"); else asm volatile("s_waitcnt vmcnt(0) lgkmcnt(0)\n\ts_barrier" ::: "memory"); } \
    } while (0)
#define AP3_FSTEP(tt, SL) do { const int t = (tt); \
        AP_ISSUE_K(t + 2, ((SL) + 2) % 3); AP_ISSUE_V(t + 1, ((SL) + 1) % 3); \
        float rs = 0.f; \
        AP3_QKF(SL); \
        __builtin_amdgcn_sched_barrier(0); \
        { s16x4 vfa[2 * NDB]; AP3_VFL(vfa, 0, ((SL) + 2) % 3); \
          AP3_GROUP(0, vfa, vfa, p0, 0, p0, 0, false, true, ((SL) + 2) % 3); \
          AP3_GROUP(1, vfa, vfa, p0, 8, p0, 0, true, true, ((SL) + 2) % 3); \
          AP3_GROUP(2, vfa, vfa, p1, 0, p0, 8, true, true, ((SL) + 2) % 3); \
          AP3_GROUP(3, vfa, vfa, p1, 8, p1, 0, true, false, ((SL) + 2) % 3); \
          _Pragma("unroll") for (int e = 0; e < 8; ++e) rs += p1[8 + e]; \
          _Pragma("unroll") for (int e = 0; e < 4; ++e) pwv[3][e] = cvtpk_(p1[8 + 2 * e], p1[8 + 2 * e + 1]); } \
        l_run += rs; \
        asm volatile("s_waitcnt vmcnt(3) lgkmcnt(0)\n\ts_barrier" ::: "memory"); \
    } while (0)
    if (wid >= 4) __builtin_amdgcn_s_setprio(1);
    int t3 = t0;
    if constexpr (SREF && pv == 0) {
        AP3_STEP(t3, 0); AP3_STEP(t3 + 1, 1); AP3_STEP(t3 + 2, 2); t3 += 3;
        const int tfe = (q0 >> 6) - (MODE == 0 ? 1 : 3);
        for (; t3 + 2 <= tfe; t3 += 3) { AP3_FSTEP(t3, 0); AP3_FSTEP(t3 + 1, 1); AP3_FSTEP(t3 + 2, 2); }
    }
    for (; t3 <= NT; t3 += 3) { AP3_STEP(t3, 0); AP3_STEP(t3 + 1, 1); AP3_STEP(t3 + 2, 2); }
    if (wid >= 4) __builtin_amdgcn_s_setprio(0);
    asm volatile("s_waitcnt lgkmcnt(0)\n\ts_barrier" ::: "memory");
    l_run += __shfl_xor(l_run, 32);
    if (hi == 0) wsf[r32] = 1.0f / l_run;
    asm volatile("s_waitcnt lgkmcnt(0)" ::: "memory");
#pragma unroll
    for (int g4 = 0; g4 < 4; ++g4) { const f32x4 a4 = *(const LAS f32x4*)(wsf + 8 * g4 + 4 * hi);
#pragma unroll
        for (int d = 0; d < NDB; ++d)
#pragma unroll
            for (int e = 0; e < 4; ++e) o[d][4 * g4 + e] *= a4[e]; }
#undef AP_ISSUE_K
#undef AP_ISSUE_V
#undef AP_BATCH
#undef AP3_VFL
#undef AP3_VFL1
#undef AP3_FRAG
#undef AP3_GAP
#undef AP3_GROUP
#undef AP3_OCT
#undef AP3_STEP
#undef AP3_FSTEP
#undef AP3_QK
#undef AP3_QKF
#undef AP3_QKS
#undef AP3_KRD
#undef AP3_MM
#undef AP3_DECIDE
}

template <int NDB> __device__ __forceinline__ void store_o(const f32x16 (&o)[NDB], LAS unsigned char* stgb  , bf16_t* dst  , int ld, int lane) {
    const int r32 = lane & 31, hi = lane >> 5;
    constexpr int DVC = 32 * NDB;
    LAS bf16_t* stg = (LAS bf16_t*)stgb;
#pragma unroll
    for (int d = 0; d < NDB; ++d)
#pragma unroll
        for (int r = 0; r < 16; ++r) { const int row = (r & 3) + 8 * (r >> 2) + 4 * hi; stg[row * DVC + 32 * d + r32] = (bf16_t)f2bf(o[d][r]); }
    asm volatile("s_waitcnt lgkmcnt(0)" ::: "memory");
    constexpr int CPR = DVC / 8;
#pragma unroll
    for (int i = 0; i < (32 * CPR) / 64; ++i) { const int c = i * 64 + lane, row = c / CPR, ch = c % CPR;
        const u32x4 v = *(const LAS u32x4*)(stg + row * DVC + ch * 8); *(u32x4*)(dst + (size_t)row * ld + ch * 8) = v; }
    asm volatile("s_waitcnt lgkmcnt(0)" ::: "memory");
}

__device__ __forceinline__ float lambda_full(Frame& F) {
    const int l = lane_id_opaque() & 63;
    const float a = wave_sum(F.in[I_LQ1][l] * F.in[I_LK1][l]), b = wave_sum(F.in[I_LQ2][l] * F.in[I_LK2][l]);
    return __expf(a) - __expf(b) + 0.2f;
}

template <int pv = 0> __device__ __forceinline__ void attn_prompt_fox(Frame& F, int h, int qb) {
    const bf16_t* Q = (const bf16_t*)(F.ws + WS_QB) + h * 64; const bf16_t* K = (const bf16_t*)(F.ws + WS_KB) + h * 64; const bf16_t* V = (const bf16_t*)(F.ws + WS_VB) + h * 64;
    f32x16 o[2];
    const float* Fh = (const float*)(F.ws + WS_FP) + (size_t)h * SEQ;
    int t0 = 0; bool fast;
    { const unsigned* nw = (const unsigned*)(F.ws + WS_CTL) + 256;
      const float qn2 = __uint_as_float(nw[h * 2]) + __uint_as_float(nw[h * 2 + 1]), kn2 = __uint_as_float(nw[16 + h * 2]) + __uint_as_float(nw[16 + h * 2 + 1]);
      const float B = sqrtf(qn2 * kn2) * 1.02f + 0.5f;
      const float thresh = -40.0f - 2.0f * B;
      fast = __builtin_amdgcn_readfirstlane(B <= 60.0f ? 1 : 0) != 0;
      volatile LAS int* cnt = (volatile LAS int*)(F.lds + AT_MISC + 32);
      __syncthreads();
      if (F.tid < 256) { const int t = F.tid; const bool sk = t < 4 * qb && (Fh[qb * 256] - Fh[64 * t + 63]) <= thresh;
          const int c = __popcll(__ballot(sk)); if (F.lane == 0) cnt[F.wave] = c; }
      __syncthreads();
      t0 = cnt[0] + cnt[1] + cnt[2] + cnt[3]; t0 -= t0 % 3; }
    if (fast) attn_pass3<0, 64, pv, true>(F, Q, K, V, qb * 256, 4 * qb + 4, Fh, 0, o, t0); else attn_pass3<0, 64, pv, false>(F, Q, K, V, qb * 256, 4 * qb + 4, Fh, 0, o, t0);
    if (pv != 0 && o[0][0] != 1234.5678f) { __syncthreads(); return; }
    bf16_t* AB = (bf16_t*)(F.ws + WS_AB);
    store_o<2>(o, F.lds + F.wave * 8192, AB + (size_t)(qb * 256 + F.wave * 32) * DM + 512 + h * 64, DM, F.lane);
    __syncthreads();
}
template <int pv = 0> __device__ __forceinline__ void attn_prompt_diff_half(Frame& F, int h, int half, int qb) {
    const bf16_t* Q = (const bf16_t*)(F.ws + WS_QA) + h * 128 + 64 * half; const bf16_t* K = (const bf16_t*)(F.ws + WS_KA) + h * 128 + 64 * half; const bf16_t* V = (const bf16_t*)(F.ws + WS_VA) + h * 128;
    f32x16 o[4];
    bool fast;
    { const unsigned* nw = (const unsigned*)(F.ws + WS_CTL) + 288; const int hh = h * 2 + half;
      const float qn2 = __uint_as_float(nw[hh * 2]) + __uint_as_float(nw[hh * 2 + 1]), kn2 = __uint_as_float(nw[16 + hh * 2]) + __uint_as_float(nw[16 + hh * 2 + 1]);
      float bm = 0.f; for (int b = 0; b < 32; ++b) bm = fmaxf(bm, fabsf(F.in[I_RELB][b * 4 + h] - F.in[I_RELB][15 * 4 + h]));
      const float B = sqrtf(qn2 * kn2) * 1.02f + 0.5f + bm * LOG2E;
      fast = __builtin_amdgcn_readfirstlane(B <= 60.0f ? 1 : 0) != 0; }
    if (fast) attn_pass3<1, 128, pv, true>(F, Q, K, V, qb * 256, 4 * qb + 4, nullptr, h, o); else attn_pass3<1, 128, pv, false>(F, Q, K, V, qb * 256, 4 * qb + 4, nullptr, h, o);
    if (pv != 0 && o[0][0] != 1234.5678f) { __syncthreads(); return; }
    bf16_t* OD = (bf16_t*)(F.ws + (half ? WS_OD2 : WS_OD1));
    store_o<4>(o, F.lds + F.wave * 8192, OD + (size_t)(qb * 256 + F.wave * 32) * 512 + h * 128, 512, F.lane);
    __syncthreads();
}
constexpr int PF_STR = 66, PD_STR = 130;
__device__ __forceinline__ void p_combine(Frame& F) {
    const float lam = lambda_full(F);
    const bf16_t* O1 = (const bf16_t*)(F.ws + WS_OD1); const bf16_t* O2 = (const bf16_t*)(F.ws + WS_OD2); bf16_t* AB = (bf16_t*)(F.ws + WS_AB);
    const int gw = F.bid * 8 + F.wave, NGW = F.G * 8;
    const int c0 = 8 * F.lane;
    float sg[8];
#pragma unroll
    for (int i = 0; i < 8; ++i) sg[i] = F.in[I_SUBG][(c0 & 127) + i] * 0.8f;
    for (int m0 = gw; m0 < SEQ; m0 += 4 * NGW) {
        u32x4 a[4], b[4];
#pragma unroll
        for (int r = 0; r < 4; ++r) { const int m = m0 + r * NGW; if (m < SEQ) { a[r] = *(const u32x4*)(O1 + (size_t)m * 512 + c0); b[r] = *(const u32x4*)(O2 + (size_t)m * 512 + c0); } else { a[r] = (u32x4){0u, 0u, 0u, 0u}; b[r] = a[r]; } }
#pragma unroll
        for (int r = 0; r < 4; ++r) { const int m = m0 + r * NGW;
            float v[8];
            v[0] = bflo(a[r].x) - lam * bflo(b[r].x); v[1] = bfhi(a[r].x) - lam * bfhi(b[r].x); v[2] = bflo(a[r].y) - lam * bflo(b[r].y); v[3] = bfhi(a[r].y) - lam * bfhi(b[r].y);
            v[4] = bflo(a[r].z) - lam * bflo(b[r].z); v[5] = bfhi(a[r].z) - lam * bfhi(b[r].z); v[6] = bflo(a[r].w) - lam * bflo(b[r].w); v[7] = bfhi(a[r].w) - lam * bfhi(b[r].w);
            float ss = 0.f;
#pragma unroll
            for (int i = 0; i < 8; ++i) ss += v[i] * v[i];
#pragma unroll
            for (int ofs = 1; ofs < 16; ofs <<= 1) ss += __shfl_xor(ss, ofs);
            const float rn = 1.0f / sqrtf(ss * (1.0f / 128.0f) + LN_EPS);
            u32x4 w; w.x = pk2(v[0] * rn * sg[0], v[1] * rn * sg[1]); w.y = pk2(v[2] * rn * sg[2], v[3] * rn * sg[3]); w.z = pk2(v[4] * rn * sg[4], v[5] * rn * sg[5]); w.w = pk2(v[6] * rn * sg[6], v[7] * rn * sg[7]);
            if (m < SEQ) *(u32x4*)(AB + (size_t)m * DM + c0) = w; }
    }
    for (int it = F.bid; it < NSMP; it += F.G) {
        const int b = it >> 4, q = it & 15; const size_t row = (size_t)SEQ + it;
        if (F.wave == 0) {
            const int h = F.lane >> 3, cc = (F.lane & 7) * 8; const float* P = (const float*)(F.ws + WS_PF);
            float M = -1e30f;
#pragma unroll
            for (int s = 0; s < 8; ++s) M = fmaxf(M, P[((size_t)((b * 8 + s) * 8 + h) * 16 + q) * PF_STR + 64]);
            float acc[8], L = 0.f;
#pragma unroll
            for (int i = 0; i < 8; ++i) acc[i] = 0.f;
#pragma unroll
            for (int s = 0; s < 8; ++s) { const float* pr = P + ((size_t)((b * 8 + s) * 8 + h) * 16 + q) * PF_STR; const float wgt = __builtin_amdgcn_exp2f(pr[64] - M); L += wgt * pr[65];
#pragma unroll
                for (int i = 0; i < 8; ++i) acc[i] += wgt * pr[cc + i]; }
            const float inv = 1.0f / L;
            u32x4 w; w.x = pk2(acc[0] * inv, acc[1] * inv); w.y = pk2(acc[2] * inv, acc[3] * inv); w.z = pk2(acc[4] * inv, acc[5] * inv); w.w = pk2(acc[6] * inv, acc[7] * inv);
            *(u32x4*)(AB + row * DM + 512 + c0) = w; }
        if (F.wave == 1) {
            const int h = F.lane >> 4, cc = (F.lane & 15) * 8; const float* P = (const float*)(F.ws + WS_PD);
            float v[8];
#pragma unroll
            for (int i = 0; i < 8; ++i) v[i] = 0.f;
#pragma unroll
            for (int half = 0; half < 2; ++half) {
                float M = -1e30f;
#pragma unroll
                for (int s = 0; s < 8; ++s) M = fmaxf(M, P[((size_t)((b * 8 + s) * 8 + 2 * h + half) * 16 + q) * PD_STR + 128]);
                float acc[8], L = 0.f;
#pragma unroll
                for (int i = 0; i < 8; ++i) acc[i] = 0.f;
#pragma unroll
                for (int s = 0; s < 8; ++s) { const float* pr = P + ((size_t)((b * 8 + s) * 8 + 2 * h + half) * 16 + q) * PD_STR; const float wgt = __builtin_amdgcn_exp2f(pr[128] - M); L += wgt * pr[129];
#pragma unroll
                    for (int i = 0; i < 8; ++i) acc[i] += wgt * pr[cc + i]; }
                const float sc = (half ? -lam : 1.0f) / L;
#pragma unroll
                for (int i = 0; i < 8; ++i) v[i] += acc[i] * sc; }
            float ss = 0.f;
#pragma unroll
            for (int i = 0; i < 8; ++i) ss += v[i] * v[i];
#pragma unroll
            for (int ofs = 1; ofs < 16; ofs <<= 1) ss += __shfl_xor(ss, ofs);
            const float rn = 1.0f / sqrtf(ss * (1.0f / 128.0f) + LN_EPS);
            u32x4 w; w.x = pk2(v[0] * rn * sg[0], v[1] * rn * sg[1]); w.y = pk2(v[2] * rn * sg[2], v[3] * rn * sg[3]); w.z = pk2(v[4] * rn * sg[4], v[5] * rn * sg[5]); w.w = pk2(v[6] * rn * sg[6], v[7] * rn * sg[7]);
            *(u32x4*)(AB + row * DM + c0) = w; }
    }
}

constexpr int SM_K = 0, SM_V = 32768, SM_F = 81920, SM_WS = 83968;
template <int KIND  > __device__ __forceinline__ void sample_unit(Frame& F, int b, int s) {
    constexpr int DV = KIND == 0 ? 64 : 128, NDB = DV / 32, VSTR = KIND == 0 ? 192 : 320, VSUB = 16 * VSTR;
    const int lane = lane_id_opaque(), r32 = lane & 31, hi = lane >> 5, w = F.wave, tid = w * 64 + lane;
    const LAS char* lds = (const LAS char*)F.lds;
    LAS float* wsf = (LAS float*)(F.lds + SM_WS) + w * 64;
    const int hb = KIND == 0 ? w : (w >> 1);
    const LAS float* tab = (const LAS float*)(F.lds + AT_TAB) + hb * 192;
    const int q = r32 & 15, qpos = PAST + q;
    const size_t qrow = (size_t)SEQ + b * DEC_T + q;
    const bf16_t* Qp = (const bf16_t*)(F.ws + (KIND == 0 ? WS_QB : WS_QA)) + qrow * 512 + w * 64;
    bf16x8 qr[4];
#pragma unroll
    for (int d0 = 0; d0 < 4; ++d0) qr[d0] = *(const bf16x8*)(Qp + d0 * 16 + hi * 8);
    const float* Fs = (const float*)(F.ws + WS_FS) + (size_t)(b * 8 + w) * SKV;
    const float fq = KIND == 0 ? Fs[qpos] : 0.f;
    const float* Kc = F.in[KIND == 0 ? I_CFK : I_CDK] + (size_t)b * PAST * 512; const float* Vc = F.in[KIND == 0 ? I_CFV : I_CDV] + (size_t)b * PAST * 512;
    const float* Kn = F.out + (KIND == 0 ? O_FKS : O_DKS) + (size_t)b * DEC_T * 512; const float* Vn = F.out + (KIND == 0 ? O_FVS : O_DVS) + (size_t)b * DEC_T * 512;
    const int kr = tid >> 5, c16 = (tid & 31) * 16;
    const int ksub = c16 >> 6, kch = (c16 >> 3) & 7;
    const int kdst = SM_K + ksub * 4096 + kr * 128;
    const int vdst = KIND == 0 ? SM_V + ksub * VSUB + kr * VSTR + kch * 16 : SM_V + (c16 >> 7) * VSUB + kr * VSTR + ((c16 >> 3) & 15) * 16;
    f32x16 o[NDB];
#pragma unroll
    for (int d = 0; d < NDB; ++d) o[d] = f32x16{};
    float m_run = -1e30f, l_run = 0.f;
    f32x4 gkA[4], gvA[4], gkB[4], gvB[4], gkC[4], gvC[4]; float gfA = 0.f, gfB = 0.f, gfC = 0.f;
    const int nt = s == 0 ? 17 : 16;
    auto gload = [&](f32x4 (&gk)[4], f32x4 (&gv)[4], float& gf, int t) {
        const float* ks; const float* vs;
        if (t < 128) { ks = Kc + (size_t)(16 * t + kr) * 512 + c16; vs = Vc + (size_t)(16 * t + kr) * 512 + c16; }
        else { ks = Kn + (size_t)kr * 512 + c16; vs = Vn + (size_t)kr * 512 + c16; }
#pragma unroll
        for (int j = 0; j < 4; ++j) { gk[j] = *(const f32x4*)(ks + 4 * j); gv[j] = *(const f32x4*)(vs + 4 * j); }
        if (KIND == 0 && tid < 128) gf = ((const float*)(F.ws + WS_FS))[(size_t)(b * 8 + (tid >> 4)) * SKV + 16 * t + (tid & 15)];
    };
    auto lwrite = [&](const f32x4 (&gk)[4], const f32x4 (&gv)[4], float gf) {
#pragma unroll
        for (int j = 0; j < 2; ++j) { u32x4 wk, wv;
            wk.x = pk2(gk[2 * j][0], gk[2 * j][1]); wk.y = pk2(gk[2 * j][2], gk[2 * j][3]); wk.z = pk2(gk[2 * j + 1][0], gk[2 * j + 1][1]); wk.w = pk2(gk[2 * j + 1][2], gk[2 * j + 1][3]);
            wv.x = pk2(gv[2 * j][0], gv[2 * j][1]); wv.y = pk2(gv[2 * j][2], gv[2 * j][3]); wv.z = pk2(gv[2 * j + 1][0], gv[2 * j + 1][1]); wv.w = pk2(gv[2 * j + 1][2], gv[2 * j + 1][3]);
            *(LAS u32x4*)(F.lds + kdst + (((kch + j) ^ (kr & 7)) << 4)) = wk;
            *(LAS u32x4*)(F.lds + vdst + j * 16) = wv; }
        if (KIND == 0 && tid < 128) ((LAS float*)(F.lds + SM_F))[tid] = gf;
    };
    gload(gkA, gvA, gfA, s); gload(gkB, gvB, gfB, s + 8); gload(gkC, gvC, gfC, s + 16);
    __syncthreads();
    { const int sub = tid >> 6, rr = 16 + ((tid >> 2) & 15), cq = (tid & 3) * 32;
      *(LAS u32x4*)(F.lds + SM_K + sub * 4096 + rr * 128 + cq) = (u32x4){0u, 0u, 0u, 0u}; *(LAS u32x4*)(F.lds + SM_K + sub * 4096 + rr * 128 + cq + 16) = (u32x4){0u, 0u, 0u, 0u}; }
    const int vb = SM_V + (KIND == 0 ? w : (w >> 1)) * VSUB + (4 * hi + ((lane & 15) >> 2)) * VSTR + (((lane >> 4) & 1) * 16 + (lane & 3) * 4) * 2;
    auto compute = [&](int t) {
        f32x16 p0 = f32x16{};
#pragma unroll
        for (int d0 = 0; d0 < 4; ++d0) { const bf16x8 kf = *(const LAS bf16x8*)(lds + SM_K + w * 4096 + r32 * 128 + (((2 * d0 + hi) ^ (r32 & 7)) << 4));
            p0 = __builtin_amdgcn_mfma_f32_32x32x16_bf16(kf, qr[d0], p0, 0, 0, 0); }
        const int kv0 = 16 * t + 4 * hi;
        float x[8];
        if (KIND == 0) {
#pragma unroll
            for (int g4 = 0; g4 < 2; ++g4) { const f32x4 fa = *(const LAS f32x4*)(lds + SM_F + (w * 16 + 4 * hi + 8 * g4) * 4);
#pragma unroll
                for (int e = 0; e < 4; ++e) x[4 * g4 + e] = p0[4 * g4 + e] + (fq - fa[e]); }
            if (t == 128) {
#pragma unroll
                for (int r = 0; r < 8; ++r) { const int kv = kv0 + (r & 3) + 8 * (r >> 2); if (kv > qpos) x[r] = -1e30f; } }
        } else {
            if (t < 120) {
#pragma unroll
                for (int r = 0; r < 8; ++r) x[r] = p0[r];
            } else {
#pragma unroll
                for (int r = 0; r < 8; ++r) { const int kv = kv0 + (r & 3) + 8 * (r >> 2); int i0 = kv - qpos + 128; i0 = i0 < 0 ? 0 : i0; x[r] = p0[r] + tab[i0]; } }
        }
        float rm = x[0];
#pragma unroll
        for (int r = 1; r < 8; ++r) rm = fmaxf(rm, x[r]);
        rm = fmaxf(rm, __shfl_xor(rm, 32));
        const float m_new = fmaxf(m_run, rm);
        if (__any(m_new > m_run)) { const float al = __builtin_amdgcn_exp2f(m_run - m_new); l_run *= al; m_run = m_new;
            if (hi == 0) wsf[r32] = al;
            asm volatile("s_waitcnt lgkmcnt(0)" ::: "memory");
#pragma unroll
            for (int g4 = 0; g4 < 2; ++g4) { const f32x4 a4 = *(const LAS f32x4*)(wsf + 8 * g4 + 4 * hi);
#pragma unroll
                for (int d = 0; d < NDB; ++d)
#pragma unroll
                    for (int e = 0; e < 4; ++e) o[d][4 * g4 + e] *= a4[e]; } }
        float rs = 0.f;
#pragma unroll
        for (int r = 0; r < 8; ++r) { x[r] = __builtin_amdgcn_exp2f(x[r] - m_run); rs += x[r]; }
        l_run += rs;
        u32x4 w0; w0.x = cvtpk_v(x[0], x[1]); w0.y = cvtpk_v(x[2], x[3]); w0.z = cvtpk_v(x[4], x[5]); w0.w = cvtpk_v(x[6], x[7]);
        const bf16x8 pa = __builtin_bit_cast(bf16x8, w0);
#pragma unroll
        for (int d = 0; d < NDB; ++d) { const LAS char* vp = lds + vb + d * 64;
            const s16x4 lo = vtr(vp), hi4 = vtr(vp + 8 * VSTR);
            const bf16x8 vf = (bf16x8){lo[0], lo[1], lo[2], lo[3], hi4[0], hi4[1], hi4[2], hi4[3]};
            o[d] = __builtin_amdgcn_mfma_f32_32x32x16_bf16(pa, vf, o[d], 0, 0, 0); }
    };
    for (int i = 0; i < nt; i += 3) {
        const int t = s + 8 * i;
        lwrite(gkA, gvA, gfA); __syncthreads();
        if (i + 3 < nt) gload(gkA, gvA, gfA, t + 24);
        compute(t);
        __syncthreads();
        if (i + 1 >= nt) break;
        lwrite(gkB, gvB, gfB); __syncthreads();
        if (i + 4 < nt) gload(gkB, gvB, gfB, t + 32);
        compute(t + 8);
        __syncthreads();
        if (i + 2 >= nt) break;
        lwrite(gkC, gvC, gfC); __syncthreads();
        if (i + 5 < nt) gload(gkC, gvC, gfC, t + 40);
        compute(t + 16);
        __syncthreads();
    }
    l_run += __shfl_xor(l_run, 32);
    float* P = (float*)(F.ws + (KIND == 0 ? WS_PF : WS_PD)) + ((size_t)((b * 8 + s) * 8 + w) * 16) * (DV + 2);
    { float* P0 = P + (size_t)(4 * hi) * (DV + 2) + r32; float* P1 = P0 + 8 * (DV + 2);
#pragma unroll
      for (int d = 0; d < NDB; ++d)
#pragma unroll
          for (int r = 0; r < 4; ++r) { P0[r * (DV + 2) + 32 * d] = o[d][r]; P1[r * (DV + 2) + 32 * d] = o[d][4 + r]; } }
    if (lane < 16) { P[(size_t)lane * (DV + 2) + DV] = m_run; P[(size_t)lane * (DV + 2) + DV + 1] = l_run; }
}

template <int pv = 0> __device__ __forceinline__ void p3_attention(Frame& F, int mask) {
    LAS float* tab = (LAS float*)(F.lds + AT_TAB);
    for (int i = F.tid; i < 4 * 192; i += 512) { const int h = i / 192, rel = (i % 192) - 128; tab[i] = (F.in[I_RELB][t5_bucket(rel) * 4 + h] - F.in[I_RELB][15 * 4 + h]) * LOG2E; }
    __syncthreads();
    const int x = F.bid & 7, p = (F.bid >> 3) & 31;
    const int spos = F.G == 256 ? (x + p) % 5 : 4;
    for (int j = 0; j < 5; ++j) {
        F.lane = lane_id_opaque(); F.tid = F.wave * 64 + F.lane;
        if (j == spos) {
            if (mask & 4) {
                for (int u = F.bid; u < 256; u += F.G) {
                    F.lane = lane_id_opaque(); F.tid = F.wave * 64 + F.lane;
                    if ((u >> 3) & 1) sample_unit<1>(F, u >> 4, u & 7); else sample_unit<0>(F, u >> 4, u & 7);
                }
            }
        } else if (F.bid < 256) {
            const int i = j - (j > spos ? 1 : 0);
            const int qb = (i & 1) ? p : 63 - p;
            if (i < 2) { if (mask & 1) attn_prompt_diff_half<pv>(F, x >> 1, x & 1, qb); }
            else { if (mask & 2) attn_prompt_fox<pv>(F, x, qb); }
        }
    }
}

__device__ __forceinline__ void slab_publish(Frame& F, int word, int nun) {
    int n = 0; for (int L = F.bid; L < nun; L += F.G) ++n;
    asm volatile("s_waitcnt vmcnt(0)" ::: "memory");
    __syncthreads();
    if (F.tid == 0 && n > 0) { __builtin_amdgcn_fence(__ATOMIC_RELEASE, "agent"); asm volatile("s_waitcnt vmcnt(0)" ::: "memory");
        __hip_atomic_fetch_add((unsigned*)(F.ws + WS_CTL) + word, (unsigned)n, __ATOMIC_RELAXED, __HIP_MEMORY_SCOPE_AGENT); }
}
__device__ __forceinline__ void slab_wait(Frame& F, int word, int nun) {
    if (F.tid == 0) { unsigned* w = (unsigned*)(F.ws + WS_CTL) + word; unsigned sp = 0;
        while (__hip_atomic_load(w, __ATOMIC_RELAXED, __HIP_MEMORY_SCOPE_AGENT) < (unsigned)nun && ++sp < (1u << 22)) __builtin_amdgcn_s_sleep(2);
        __builtin_amdgcn_fence(__ATOMIC_ACQUIRE, "agent"); asm volatile("s_waitcnt vmcnt(0)" ::: "memory"); }
    __syncthreads();
}

#define XB_TMO      128
#define XB_XCNT(j)  (256  + 64 * (j))
#define XB_XSUB(j)  (1280 + 64 * (j))
#define XB_XGEN(j)  (2304 + 64 * (j))
#define XB_TOP      3328
#define XB_TOPGEN   3392
#define XCD_BAR_WORDS 3456
#define XB_SPIN_CAP (1u << 20)
__device__ __forceinline__ unsigned xb_ld(unsigned* p)              { return __hip_atomic_load(p, __ATOMIC_RELAXED, __HIP_MEMORY_SCOPE_AGENT); }
__device__ __forceinline__ unsigned xb_add(unsigned* p, unsigned v) { return __hip_atomic_fetch_add(p, v, __ATOMIC_RELAXED, __HIP_MEMORY_SCOPE_AGENT); }
__device__ __forceinline__ unsigned xb_xcc_id() { return (unsigned)__builtin_amdgcn_s_getreg((3 << 11) | 20) & 0xFu; }
#define XB_SPIN(cond, bar) do { unsigned _sp = 0; while (cond) { __builtin_amdgcn_s_sleep(1); \
    if ((++_sp & 255u) == 0u) { if (xb_ld(&(bar)[XB_TMO])) break; if (_sp > XB_SPIN_CAP) { atomicAdd(&(bar)[XB_TMO], 1u); break; } } } } while (0)
struct XcdBarrier { unsigned* bar; unsigned x; volatile LAS unsigned* st; };
__device__ __forceinline__ XcdBarrier xcd_barrier_post(unsigned* bar, volatile LAS unsigned* st) {
    XcdBarrier b; b.bar = bar; b.x = xb_xcc_id(); b.st = st;
    if (threadIdx.x == 0) (void)xb_add(&bar[XB_XCNT(b.x)], 1u);
    return b;
}
__device__ __forceinline__ void xcd_barrier_complete(unsigned* bar, unsigned x, unsigned& nloc, unsigned& nx) {
    const unsigned G = gridDim.x * gridDim.y * gridDim.z;
    unsigned sum, cnt, mine, sp = 0u;
    for (;;) {
        sum = 0u; cnt = 0u; mine = 0u;
#pragma unroll
        for (unsigned j = 0; j < 16; ++j) { const unsigned c = xb_ld(&bar[XB_XCNT(j)]); sum += c; cnt += (c > 0u) ? 1u : 0u; mine = (j == x) ? c : mine; }
        if (sum == G) break;
        __builtin_amdgcn_s_sleep(1);
        if ((++sp & 255u) == 0u) { if (xb_ld(&bar[XB_TMO])) break; if (sp > XB_SPIN_CAP) { atomicAdd(&bar[XB_TMO], 1u); break; } }
    }
    nloc = mine > 0u ? mine : 1u; nx = cnt > 0u ? cnt : 1u;
}
__device__ __forceinline__ void xcd_barrier(const XcdBarrier& b) {
    asm volatile("s_waitcnt vmcnt(0)" ::: "memory");
    __syncthreads();
    if (threadIdx.x == 0) {
        unsigned* bar = b.bar;
        __builtin_amdgcn_s_waitcnt(0);
        unsigned nloc = b.st[0], nx = b.st[1];
        if (nloc == 0u) { xcd_barrier_complete(bar, b.x, nloc, nx); b.st[0] = nloc; b.st[1] = nx; }
        const unsigned old = xb_add(&bar[XB_XSUB(b.x)], 1u);
        const unsigned gen = old / nloc;
        if (old + 1u == (gen + 1u) * nloc) {
            __builtin_amdgcn_fence(__ATOMIC_RELEASE, "agent");
            asm volatile("s_waitcnt vmcnt(0)" ::: "memory");
            const unsigned og = xb_add(&bar[XB_TOP], 1u);
            const unsigned tg = og / nx;
            if (og + 1u == (tg + 1u) * nx) xb_add(&bar[XB_TOPGEN], 1u);
            else XB_SPIN(xb_ld(&bar[XB_TOPGEN]) == tg, bar);
            __builtin_amdgcn_fence(__ATOMIC_ACQUIRE, "agent");
            xb_add(&bar[XB_XGEN(b.x)], 1u);
            asm volatile("s_waitcnt vmcnt(0)" ::: "memory");
        } else {
            XB_SPIN(xb_ld(&bar[XB_XGEN(b.x)]) == gen, bar);
            __builtin_amdgcn_fence(__ATOMIC_ACQUIRE, "agent");
            asm volatile("s_waitcnt vmcnt(0)" ::: "memory");
        }
    }
    __syncthreads();
}

__global__ void __launch_bounds__(512, 2) mega_fwd(Args args) {
    extern __shared__ __attribute__((aligned(16))) unsigned char lds_raw[];
    Frame F;
    F.lds = (LAS unsigned char*)lds_raw; F.ldsg = lds_raw;
    F.tid = threadIdx.x; F.lane = F.tid & 63; F.wave = __builtin_amdgcn_readfirstlane(F.tid >> 6);
    F.G = gridDim.x; F.bid = blockIdx.x;
    F.in = args.in; F.out = args.out; F.ws = args.ws;
    const int lo = args.ph_lo, hi = args.ph_hi;
    cg::grid_group grid = cg::this_grid();
    const bool fused = (hi - lo) > 1;
    volatile LAS unsigned* bst = (volatile LAS unsigned*)(F.lds + AT_MISC + 16);
    if (F.tid == 0) { bst[0] = 0u; bst[1] = 0u; }
    __syncthreads();
    XcdBarrier xbar; xbar.bar = (unsigned*)(F.ws + WS_CTL) + 1024; xbar.x = 0; xbar.st = bst;
    if (fused) xbar = xcd_barrier_post((unsigned*)(F.ws + WS_CTL) + 1024, bst);
#define IN(k) (lo <= (k) && (k) < hi)
#define PB() do { F.lane = lane_id_opaque(); F.tid = F.wave * 64 + F.lane; } while (0)
#define SEAM(k) do { if (IN(k) && IN((k) + 1)) { xcd_barrier(xbar); } } while (0)
    const float* mod = (const float*)(F.ws + WS_MOD);
    if (IN(0)) { PB(); p0_prologue(F); }
    if (IN(0) && IN(1)) __syncthreads(); else SEAM(0);
    if (IN(1)) { PB(); p1_rows(F, IN(0)); } SEAM(1);
    if (IN(2)) { PB();
        p2_cumsum(F);
        __syncthreads();
        pg8::Gemm g{(const bf16_t*)(F.ws + WS_XN), (const bf16_t*)(F.ws + WS_WIN), 1024, 1024, 1024, 1 << 30, 0, 0};
        pg8::StaticOrder S; S.init(MT / 256, NZ / 256, F.G, F.bid, 0);
        EpiZ E{F.out, F.ws};
        pg8::gemm_phase<EpiZ, pg8::StaticOrder>(F.lds, g, S, E, F.wave);
#if PROBE_DUP == 2
        pg8::gemm_phase<EpiZ, pg8::StaticOrder>(F.lds, g, S, E, F.wave);
#endif
        { const int nun = (MT / 256) * (NZ / 256), nlong = nun - (nun / F.G) * F.G;
          if (nlong > 0 && nlong < F.G) { if (F.bid >= nlong) { PB(); weight_copies(F, F.bid - nlong, F.G - nlong, WC_IN, WC_ALL); } }
          else { PB(); weight_copies(F, F.bid, F.G, WC_IN, WC_ALL); } }
    } SEAM(2);
    if (IN(3)) { PB(); p3_attention(F, 7);
#if PROBE_DUP == 3
        p3_attention<PROBE_PV>(F, PROBE_MASK);
#endif
    } SEAM(3);
    if (IN(10)) { PB(); p_combine(F);
#if PROBE_DUP == 10
        p_combine(F);
#endif
    } if (IN(10) && IN(4)) xcd_barrier(xbar);
    if (IN(4)) { PB();
        pg8::Gemm g{(const bf16_t*)(F.ws + WS_AB), (const bf16_t*)(F.ws + WS_WAB), 1024, 512, 512, 4, 512, 0};
        pg8::StaticOrder S; S.init(MT / 256, 8, F.G, F.bid, 0);
        EpiGate E{(bf16_t*)(F.ws + WS_G), (bf16_t*)(F.ws + WS_G)};
#if PROBE_DUP == 4
        { EpiGate E2{(bf16_t*)(F.ws + WS_G), (bf16_t*)(F.ws + WS_QA)}; pg8::gemm_phase<EpiGate, pg8::StaticOrder>(F.lds, g, S, E2, F.wave); }
#endif
        pg8::gemm_phase<EpiGate, pg8::StaticOrder>(F.lds, g, S, E, F.wave);
    } SEAM(4);
    if (IN(5)) { PB();
        { pg8::Gemm g2{(const bf16_t*)(F.ws + WS_G), (const bf16_t*)(F.ws + WS_WO2), 2048, 2048, 256, 1 << 30, 0, 256};
          pg8::SplitOrder S2; S2.init(4, 8, F.G, F.bid, SEQ / 256); EpiSlab E2{(float*)(F.ws + WS_SLAB)};
          pg8::gemm_phase<EpiSlab, pg8::SplitOrder>(F.lds, g2, S2, E2, F.wave); PB(); slab_publish(F, 322, 32); }
        pg8::Gemm g{(const bf16_t*)(F.ws + WS_G), (const bf16_t*)(F.ws + WS_WO2), 2048, 2048, 2048, 1 << 30, 0, 0};
        pg8::StaticOrder S; S.init(SEQ / 256, 4, F.G, F.bid, 0);
        EpiResLn<false> E{(const void*)F.in[I_XP], mod + 2048, F.in[I_LN1G], F.in[I_LN1B], mod, (bf16_t*)(F.ws + WS_X1B), (bf16_t*)(F.ws + WS_XN), nullptr,
                          PanelStats{(unsigned*)(F.ws + WS_XB1), (unsigned*)(F.ws + WS_CTL) + CTL_LN1, LN_EPS}, F.lds};
        pg8::gemm_phase<EpiResLn<false>, pg8::StaticOrder>(F.lds, g, S, E, F.wave);
        PB(); slab_wait(F, 322, 32); ln_rows<false>(F, F.in[I_LN1G], F.in[I_LN1B], 8, 2048);
    } if (IN(5) && IN(7)) xcd_barrier(xbar);

    if (IN(7)) { PB();
        pg8::Gemm g{(const bf16_t*)(F.ws + WS_XN), (const bf16_t*)(F.ws + WS_WFI), 1024, 1024, 1024, 1 << 30, 0, 0};
        pg8::StaticOrder S; S.init(MT / 256, NFF2 / 256, F.G, F.bid, 0);
        EpiFfn E{(bf16_t*)(F.ws + WS_ACT)};
        pg8::gemm_phase<EpiFfn, pg8::StaticOrder>(F.lds, g, S, E, F.wave);
#if PROBE_DUP == 7
        pg8::gemm_phase<EpiFfn, pg8::StaticOrder>(F.lds, g, S, E, F.wave);
#endif
    } SEAM(7);
    if (IN(8)) { PB();
        { pg8::Gemm g2{(const bf16_t*)(F.ws + WS_ACT), (const bf16_t*)(F.ws + WS_WFO), DFF, DFF, 256, 1 << 30, 0, 256};
          pg8::SplitOrder S2; S2.init(4, 11, F.G, F.bid, SEQ / 256); EpiSlab E2{(float*)(F.ws + WS_SLAB)};
          pg8::gemm_phase<EpiSlab, pg8::SplitOrder>(F.lds, g2, S2, E2, F.wave); PB(); slab_publish(F, 323, 44); }
        pg8::Gemm g{(const bf16_t*)(F.ws + WS_ACT), (const bf16_t*)(F.ws + WS_WFO), DFF, DFF, DFF, 1 << 30, 0, 0};
        pg8::StaticOrder S; S.init(SEQ / 256, 4, F.G, F.bid, 0);
        EpiResLn<true> E{(const void*)(F.ws + WS_X1B), mod + 5120, F.in[I_LN2G], F.in[I_LN2B], mod, nullptr, nullptr, F.out,
                         PanelStats{(unsigned*)(F.ws + WS_XB2), (unsigned*)(F.ws + WS_CTL) + CTL_LN2, LN_EPS}, F.lds};
        pg8::gemm_phase<EpiResLn<true>, pg8::StaticOrder>(F.lds, g, S, E, F.wave);
        PB(); slab_wait(F, 323, 44); ln_rows<true>(F, F.in[I_LN2G], F.in[I_LN2B], 11, 5120);
    }
#undef IN
#undef SEAM
}

extern "C" void kernel_launch(void* const* d_in, const int* in_sizes, int n_in, void* d_out, int out_size, void* d_ws, size_t ws_size, hipStream_t stream) {
    static int grid = 0;
    if (grid == 0) {
        if (n_in != 28 || (size_t)out_size != O_END || ws_size < WS_END) { fprintf(stderr, "kernel_launch: unexpected shapes (n_in %d out %d ws %zu)\n", n_in, out_size, ws_size); grid = -1; return; }
        int dev = 0, cus = 0, per_cu = 0;
        hipGetDevice(&dev); hipDeviceGetAttribute(&cus, hipDeviceAttributeMultiprocessorCount, dev);
        hipFuncSetAttribute((const void*)mega_fwd, hipFuncAttributeMaxDynamicSharedMemorySize, LDS_BYTES);
        hipOccupancyMaxActiveBlocksPerMultiprocessor(&per_cu, (const void*)mega_fwd, 512, LDS_BYTES);
        if (per_cu < 1) { fprintf(stderr, "kernel_launch: occupancy query says %d blocks per CU\n", per_cu); per_cu = 1; }
        (void)hipGetLastError();
        grid = cus;
    }
    if (grid < 0) return;
    hipMemsetAsync((char*)d_ws + WS_CTL, 0, CTL_BYTES, stream);
    Args a{};
    for (int i = 0; i < 28; ++i) a.in[i] = (const float*)d_in[i];
    a.out = (float*)d_out; a.ws = (unsigned char*)d_ws;
#if MK_N_LAUNCHES == 1
    a.ph_lo = 0; a.ph_hi = NPH;
    void* kargs[] = {&a};
    hipError_t e = hipLaunchCooperativeKernel((const void*)mega_fwd, dim3(grid), dim3(512), kargs, LDS_BYTES, stream);
    if (e != hipSuccess) fprintf(stderr, "cooperative launch failed: %s\n", hipGetErrorString(e));
#else
    { const int seq[NPH] = {0, 1, 2, 3, 10, 4, 5, 6, 7, 8, 9}; for (int i = 0; i < NPH; ++i) { a.ph_lo = seq[i]; a.ph_hi = seq[i] + 1; hipLaunchKernelGGL(mega_fwd, dim3(grid), dim3(512), LDS_BYTES, stream, a); } }
#endif
}
```

```cpp
#include <hip/hip_runtime.h>
#include <hip/hip_cooperative_groups.h>
#include <cstdint>
#include <cstdio>
namespace cg = cooperative_groups;

#ifndef PROBE_DUP
#define PROBE_DUP -1
#endif
#ifndef PROBE_PV
#define PROBE_PV 0
#endif
#ifndef PROBE_MASK
#define PROBE_MASK 7
#endif
#ifndef MK_N_LAUNCHES
#define MK_N_LAUNCHES 1
#endif

#define LAS __attribute__((address_space(3)))
typedef unsigned short bf16_t;
typedef short bf16x8 __attribute__((ext_vector_type(8)));
typedef short s16x4 __attribute__((ext_vector_type(4)));
typedef float f32x4 __attribute__((ext_vector_type(4)));
typedef float f32x2 __attribute__((ext_vector_type(2)));
typedef float f32x16 __attribute__((ext_vector_type(16)));
typedef unsigned u32x4 __attribute__((ext_vector_type(4)));
typedef unsigned u32x2 __attribute__((ext_vector_type(2)));

constexpr int DM = 1024, SEQ = 16384, DEC_B = 16, DEC_T = 16, NSMP = DEC_B * DEC_T, MT = SEQ + NSMP, PAST = 2048, SKV = PAST + DEC_T;
constexpr int NZ = 5120, DFF = 2816, NFF2 = 2 * DFF, WIN_COLS = 5128;
constexpr float LOG2E = 1.4426950408889634f, C2 = 0.125f * LOG2E, ALPHA = 1.189207115002721f, LN_EPS = 1e-5f;
constexpr int NPH = 11;

constexpr size_t O_Y = 0, O_DKP = (size_t)MT * DM, O_DVP = O_DKP + (size_t)SEQ * 512, O_FKP = O_DVP + (size_t)SEQ * 512, O_FVP = O_FKP + (size_t)SEQ * 512,
                 O_FLP = O_FVP + (size_t)SEQ * 512, O_DKS = O_FLP + (size_t)SEQ * 8, O_DVS = O_DKS + (size_t)NSMP * 512, O_FKS = O_DVS + (size_t)NSMP * 512,
                 O_FVS = O_FKS + (size_t)NSMP * 512, O_FLS = O_FVS + (size_t)NSMP * 512, O_END = O_FLS + (size_t)NSMP * 8;

constexpr size_t MiB = 1u << 20;
constexpr size_t WS_CTL = 0, CTL_BYTES = 64 * 1024;
constexpr size_t WS_MOD = 1 * MiB;
constexpr size_t WS_FP = 2 * MiB;
constexpr size_t WS_FS = 3 * MiB;
constexpr size_t WS_WIN = 8 * MiB;
constexpr size_t WS_WAB = 18 * MiB;
constexpr size_t WS_WO2 = 20 * MiB;
constexpr size_t WS_WFI = 24 * MiB;
constexpr size_t WS_WFO = 35 * MiB;
constexpr size_t WS_XN = 48 * MiB;
constexpr size_t WS_QA = 84 * MiB, WS_KA = 101 * MiB, WS_VA = 118 * MiB, WS_QB = 135 * MiB, WS_KB = 152 * MiB, WS_VB = 169 * MiB;
constexpr size_t WS_ACT = 84 * MiB;
constexpr size_t WS_G = 188 * MiB;
constexpr size_t WS_AB = 254 * MiB;
constexpr size_t WS_OD1 = WS_XN, WS_OD2 = 288 * MiB;
constexpr size_t WS_PF = 304 * MiB, WS_PD = 309 * MiB;
constexpr size_t WS_TB = WS_AB;
constexpr size_t WS_X1B = WS_AB;
constexpr size_t WS_XB1 = 5 * MiB, WS_XB2 = 6 * MiB;
constexpr int CTL_LN1 = 8192, CTL_LN2 = 12288;
constexpr int LN_LDS = 135168;
constexpr size_t WS_SLAB = 288 * MiB;
constexpr size_t WS_END = 320 * MiB;

constexpr int LDS_BYTES = 147456;

struct Args { const float* in[28]; float* out; unsigned char* ws; int ph_lo, ph_hi; };

__device__ __forceinline__ int lane_id_opaque() { int l = (int)__builtin_amdgcn_mbcnt_hi(~0u, __builtin_amdgcn_mbcnt_lo(~0u, 0u)); asm volatile("" : "+v"(l)); return l; }
__device__ __forceinline__ unsigned f2bf(float f) { unsigned u = __builtin_bit_cast(unsigned, f); return (u + 0x7fffu + ((u >> 16) & 1u)) >> 16; }
typedef __bf16 bf16x2e_t_ __attribute__((ext_vector_type(2)));
__device__ __forceinline__ unsigned cvtpk_v(float lo, float hi) { f32x2 v = {lo, hi}; bf16x2e_t_ b = __builtin_convertvector(v, bf16x2e_t_); return __builtin_bit_cast(unsigned, b); }
__device__ __forceinline__ unsigned pk2(float lo, float hi) { return cvtpk_v(lo, hi); }
__device__ __forceinline__ float bf2f(unsigned short b) { return __builtin_bit_cast(float, (unsigned)b << 16); }
__device__ __forceinline__ float bflo(unsigned w) { return __builtin_bit_cast(float, w << 16); }
__device__ __forceinline__ float bfhi(unsigned w) { return __builtin_bit_cast(float, w & 0xffff0000u); }
__device__ __forceinline__ float wave_sum(float v) {
#pragma unroll
    for (int o = 1; o < 64; o <<= 1) v += __shfl_xor(v, o);
    return v;
}
__device__ __forceinline__ float sigmoidf_(float x) { return __builtin_amdgcn_rcpf(1.0f + __expf(-x)); }
__device__ __forceinline__ float siluf_(float x) { return x * __builtin_amdgcn_rcpf(1.0f + __expf(-x)); }

namespace pg8 {
constexpr int BM = 256, BK = 64, HALF = 128, HTB = HALF * BK * 2, STAGE_BYTES = 8 * HTB, NXCD = 8, WGM = 8;
__host__ __device__ __forceinline__ int lds_byte(int r, int c) { const int st = (r >> 4) * 2 + (c >> 5), rr = r & 15, cc = c & 31, ob = rr * 64 + cc * 2; return st * 1024 + (ob ^ (((ob >> 9) & 1) << 5)); }
__host__ __device__ __forceinline__ void stage_rc(int b, int& R, int& C) { const int st = b / 1024, sb = b % 1024, swz = sb ^ (((sb >> 9) & 1) << 5); R = (st >> 1) * 16 + swz / 64; C = (st & 1) * 32 + (swz % 64) / 2; }
__host__ __device__ __forceinline__ int perm32(int rho) { const int n = rho >> 4, i = rho & 15; return 8 * (i >> 2) + 4 * n + (i & 3); }

struct Unit { int pm, pn, ks; };
struct Gemm { const bf16_t* A; const bf16_t* Bt; int lda, ldb, K, a_split_pn, a_split_off, kpart; };

struct StaticOrder {
    int nM, nN, nwg, G, c, pm0;
    __device__ void init(int nM_, int nN_, int G_, int c_, int pm0_) { nM = nM_; nN = nN_; nwg = nM * nN; G = G_; c = c_; pm0 = pm0_; }
    __device__ bool next(int i, Unit& u) const {
        const long L = (long)i * G + c; if (L >= nwg) return false;
        int wgid = (int)L; { const int q = nwg / NXCD, r = nwg % NXCD, xcd = wgid % NXCD, off = wgid / NXCD; wgid = (xcd < r ? xcd * (q + 1) : r * (q + 1) + (xcd - r) * q) + off; }
        const int nig = WGM * nN, gid = wgid / nig, fm = gid * WGM, gsz = (nM - fm) < WGM ? (nM - fm) : WGM;
        u.pm = pm0 + fm + ((wgid % nig) % gsz); u.pn = (wgid % nig) / gsz; u.ks = 0; return true;
    }
};

struct SplitOrder {
    int nN, nun, G, c, pm;
    __device__ void init(int nN_, int KS_, int G_, int c_, int pm_) { nN = nN_; nun = nN_ * KS_; G = G_; c = c_; pm = pm_; }
    __device__ bool next(int i, Unit& u) const { const long L = (long)i * G + c; if (L >= nun) return false; u.pm = pm; u.pn = (int)L % nN; u.ks = (int)L / nN; return true; }
};

__device__ __forceinline__ unsigned cvt_pk_bf16(float lo, float hi) { unsigned r; asm volatile("v_cvt_pk_bf16_f32 %0, %1, %2" : "=v"(r) : "v"(lo), "v"(hi)); return r; }

template <class Epi, class Sched, bool ALIGN_EPI = true, bool SP2 = true>
__device__ __forceinline__ void gemm_phase(LAS unsigned char* lds, const Gemm g, const Sched& S, const Epi& E, int wid  ) {
    const int lane = lane_id_opaque(), tid = wid * 64 + lane, wr = wid >> 2, wc = wid & 3; int fr = lane & 15, fq = lane >> 4;
    const int K = g.K, nt = K / BK;
    unsigned voffA[2], voffB[2];
#pragma unroll
    for (int i = 0; i < 2; ++i) { int R, C; stage_rc(tid * 16 + i * 8192, R, C); const int Rb = Epi::PERM ? ((R & ~31) + perm32(R & 31)) : R;
        voffA[i] = (unsigned)(R * g.lda + C) * 2u; voffB[i] = (unsigned)(Rb * g.ldb + C) * 2u; }
    const size_t kstep = (size_t)(BK * 2);
    const size_t hstepA = (size_t)HALF * g.lda * 2, hstepB = (size_t)HALF * g.ldb * 2;
    const size_t tstepA = 2 * hstepA, tstepB = 2 * hstepB;
    const unsigned ldsw = (unsigned)wid * 1024u;
    const int aoff = lds_byte(wr * 64 + fr, fq * 8), boff = lds_byte(wc * 32 + fr, fq * 8);
#define PG8_SA(b, h) (((b) * 2 + (h)) * HTB)
#define PG8_SB(b, h) ((4 + (b) * 2 + (h)) * HTB)
#define PG8_STAGE(bufoff, gbase, voff) do { _Pragma("unroll") for (int _i = 0; _i < 2; ++_i) \
        __builtin_amdgcn_global_load_lds((const unsigned*)((const char*)(gbase) + (voff)[_i]), (LAS unsigned*)(lds + (bufoff) + ldsw + _i * 8192), 16, 0, 0); } while (0)
#define PG8_LDA(dst, b, h) do { _Pragma("unroll") for (int m = 0; m < 4; ++m) _Pragma("unroll") for (int k = 0; k < 2; ++k) dst[m][k] = *(const LAS bf16x8*)(lds + PG8_SA(b, h) + aoff + m * 2048 + k * 1024); } while (0)
#define PG8_LDB(dst, b, h) do { _Pragma("unroll") for (int n = 0; n < 2; ++n) _Pragma("unroll") for (int k = 0; k < 2; ++k) dst[n][k] = *(const LAS bf16x8*)(lds + PG8_SB(b, h) + boff + n * 2048 + k * 1024); } while (0)
#define PG8_MMA(ai, bj, At, Bt) do { __builtin_amdgcn_s_setprio(1); _Pragma("unroll") for (int m = 0; m < 4; ++m) _Pragma("unroll") for (int n = 0; n < 2; ++n) _Pragma("unroll") for (int k = 0; k < 2; ++k) \
        acc[ai][bj][m][n] = __builtin_amdgcn_mfma_f32_16x16x32_bf16(Bt[n][k], At[m][k], acc[ai][bj][m][n], 0, 0, 0); __builtin_amdgcn_s_setprio(0); } while (0)
#define PG8_WAIT_V(n) asm volatile("s_waitcnt vmcnt(" #n ")" ::: "memory")
#define PG8_WAIT_L(n) asm volatile("s_waitcnt lgkmcnt(" #n ")" ::: "memory")
#define PG8_BAR __builtin_amdgcn_s_barrier()
#define PG8_SCHED __builtin_amdgcn_sched_barrier(0)
#define PG8_ABASE(u) ((const char*)g.A + (size_t)(u).pm * tstepA + ((u).pn >= g.a_split_pn ? (size_t)g.a_split_off * 2 : (size_t)0) + (size_t)(u).ks * g.kpart * 2)
#define PG8_BBASE(u) ((const char*)g.Bt + (size_t)(u).pn * tstepB + (size_t)(u).ks * g.kpart * 2)
    Unit cur, nxt; int ui = 0;
    if (!S.next(0, cur)) return;
    f32x4 acc[2][2][4][2];
#pragma unroll
    for (int a = 0; a < 2; ++a)
#pragma unroll
        for (int b = 0; b < 2; ++b)
#pragma unroll
            for (int m = 0; m < 4; ++m)
#pragma unroll
                for (int n = 0; n < 2; ++n) acc[a][b][m][n] = (f32x4){0.f, 0.f, 0.f, 0.f};
    bf16x8 At[4][2], B0[2][2], B1[2][2];
    const char* cA = PG8_ABASE(cur); const char* cB = PG8_BBASE(cur);
    if constexpr (SP2) {
        PG8_STAGE(PG8_SB(0, 0), cB, voffB); PG8_STAGE(PG8_SB(0, 1), cB + hstepB, voffB); PG8_STAGE(PG8_SA(0, 0), cA, voffA); PG8_STAGE(PG8_SA(0, 1), cA + hstepA, voffA);
        if (wr == 1) PG8_BAR;
        PG8_WAIT_V(2); PG8_BAR;
        PG8_STAGE(PG8_SB(1, 0), cB + kstep, voffB); PG8_STAGE(PG8_SA(1, 0), cA + kstep, voffA); PG8_STAGE(PG8_SB(1, 1), cB + hstepB + kstep, voffB);
        PG8_WAIT_V(6); PG8_BAR;
    } else {
        PG8_STAGE(PG8_SB(0, 0), cB, voffB); PG8_STAGE(PG8_SA(0, 0), cA, voffA); PG8_STAGE(PG8_SB(0, 1), cB + hstepB, voffB); PG8_STAGE(PG8_SA(0, 1), cA + hstepA, voffA);
        if (wr == 1) PG8_BAR;
        PG8_WAIT_V(4); PG8_BAR;
        PG8_STAGE(PG8_SB(1, 0), cB + kstep, voffB); PG8_STAGE(PG8_SA(1, 0), cA + kstep, voffA); PG8_STAGE(PG8_SB(1, 1), cB + hstepB + kstep, voffB);
        PG8_WAIT_V(6); PG8_BAR;
    }
    for (;;) {
        const bool has_next = S.next(ui + 1, nxt);
        const char* nA = has_next ? PG8_ABASE(nxt) : cA; const char* nB = has_next ? PG8_BBASE(nxt) : cB;
        for (int t = 0; t < nt; t += 2) {
            const bool last = (t == nt - 2);
            const char* a1 = cA + (size_t)(t + 1) * kstep;
            const char* a2 = last ? nA : cA + (size_t)(t + 2) * kstep; const char* b2 = last ? nB : cB + (size_t)(t + 2) * kstep;
            const char* a3 = a2 + kstep; const char* b3 = b2 + kstep;
            if constexpr (SP2) {
            PG8_LDB(B0, 0, 0); PG8_LDB(B1, 0, 1); PG8_SCHED; PG8_LDA(At, 0, 0); PG8_STAGE(PG8_SA(1, 1), a1 + hstepA, voffA);
            PG8_WAIT_V(8); PG8_WAIT_L(0); PG8_BAR; PG8_MMA(0, 0, At, B0); PG8_MMA(0, 1, At, B1); PG8_BAR; PG8_SCHED;
            PG8_LDA(At, 0, 1); PG8_STAGE(PG8_SB(0, 0), b2, voffB); PG8_STAGE(PG8_SB(0, 1), b2 + hstepB, voffB); PG8_STAGE(PG8_SA(0, 0), a2, voffA);
            PG8_WAIT_V(8); PG8_WAIT_L(0); PG8_BAR; PG8_MMA(1, 0, At, B0); PG8_MMA(1, 1, At, B1); PG8_BAR; PG8_SCHED;
            PG8_LDB(B0, 1, 0); PG8_LDB(B1, 1, 1); PG8_SCHED; PG8_LDA(At, 1, 0); PG8_STAGE(PG8_SA(0, 1), a2 + hstepA, voffA);
            PG8_WAIT_V(8); PG8_WAIT_L(0); PG8_BAR; PG8_MMA(0, 0, At, B0); PG8_MMA(0, 1, At, B1); PG8_BAR; PG8_SCHED;
            PG8_LDA(At, 1, 1); PG8_STAGE(PG8_SB(1, 0), b3, voffB); PG8_STAGE(PG8_SB(1, 1), b3 + hstepB, voffB); PG8_STAGE(PG8_SA(1, 0), a3, voffA);
            PG8_WAIT_V(8); PG8_WAIT_L(0); PG8_BAR; PG8_MMA(1, 0, At, B0); PG8_MMA(1, 1, At, B1); PG8_BAR; PG8_SCHED;
            } else {
            PG8_LDB(B0, 0, 0); PG8_SCHED; PG8_LDA(At, 0, 0); PG8_STAGE(PG8_SA(1, 1), a1 + hstepA, voffA);
            PG8_WAIT_L(8); PG8_BAR; PG8_WAIT_L(0); PG8_MMA(0, 0, At, B0); PG8_BAR; PG8_SCHED;
            PG8_LDB(B1, 0, 1); PG8_STAGE(PG8_SB(0, 0), b2, voffB);
            PG8_BAR; PG8_WAIT_L(0); PG8_MMA(0, 1, At, B1); PG8_BAR;
            PG8_LDA(At, 0, 1); PG8_STAGE(PG8_SA(0, 0), a2, voffA);
            PG8_BAR; PG8_WAIT_L(0); PG8_MMA(1, 0, At, B0); PG8_BAR; PG8_SCHED;
            PG8_STAGE(PG8_SB(0, 1), b2 + hstepB, voffB);
            PG8_WAIT_V(6); PG8_BAR; PG8_MMA(1, 1, At, B1); PG8_BAR;
            PG8_LDB(B0, 1, 0); PG8_SCHED; PG8_LDA(At, 1, 0); PG8_STAGE(PG8_SA(0, 1), a2 + hstepA, voffA);
            PG8_WAIT_L(8); PG8_BAR; PG8_WAIT_L(0); PG8_MMA(0, 0, At, B0); PG8_BAR; PG8_SCHED;
            PG8_LDB(B1, 1, 1); PG8_STAGE(PG8_SB(1, 0), b3, voffB);
            PG8_BAR; PG8_WAIT_L(0); PG8_MMA(0, 1, At, B1); PG8_BAR;
            PG8_LDA(At, 1, 1); PG8_STAGE(PG8_SA(1, 0), a3, voffA);
            PG8_BAR; PG8_WAIT_L(0); PG8_MMA(1, 0, At, B0); PG8_BAR; PG8_SCHED;
            PG8_STAGE(PG8_SB(1, 1), b3 + hstepB, voffB);
            PG8_WAIT_V(6); PG8_BAR; PG8_MMA(1, 1, At, B1); PG8_BAR;
            }
        }
        if constexpr (ALIGN_EPI) { if (wr == 0) PG8_BAR; }
        { const int le_ = lane_id_opaque(); E(acc, cur, wr, wc, le_ & 15, le_ >> 4); }
        if (!has_next) break;
#pragma unroll
        for (int a = 0; a < 2; ++a)
#pragma unroll
            for (int b = 0; b < 2; ++b)
#pragma unroll
                for (int m = 0; m < 4; ++m)
#pragma unroll
                    for (int n = 0; n < 2; ++n) acc[a][b][m][n] = (f32x4){0.f, 0.f, 0.f, 0.f};
        cur = nxt; cA = nA; cB = nB; ++ui;
        if constexpr (ALIGN_EPI) { if (wr == 1) PG8_BAR; }
    }
    PG8_WAIT_V(0);
    if constexpr (!ALIGN_EPI) { if (wr == 0) PG8_BAR; }
    PG8_BAR;
#undef PG8_SA
#undef PG8_SB
#undef PG8_STAGE
#undef PG8_LDA
#undef PG8_LDB
#undef PG8_MMA
#undef PG8_WAIT_V
#undef PG8_WAIT_L
#undef PG8_BAR
#undef PG8_SCHED
#undef PG8_ABASE
#undef PG8_BBASE
}
}

struct EpiZ {
    static constexpr bool PERM = true;
    float* out; unsigned char* ws;
    __device__ __forceinline__ void operator()(const f32x4 (&acc)[2][2][4][2], const pg8::Unit& u, int wr, int wc, int fr, int fq) const {
        asm volatile("" : "+v"(fr), "+v"(fq));
        const int seg = u.pn >> 1;
        const bool smp = u.pm >= SEQ / 256;
        const int row0 = u.pm * 256 + wr * 64 + fr;
        const int cl0 = wc * 32 + 8 * fq;
        if (seg < 6) {
            bf16_t* B = (bf16_t*)(ws + WS_QA + (size_t)seg * (WS_KA - WS_QA));
            const bool isq = (seg == 0 || seg == 3);
            const float sc = isq ? C2 : 1.0f;
            const int kk = seg - 1 - (seg > 3 ? 1 : 0);
            float* ob = isq ? nullptr : (smp ? out + O_DKS + (size_t)kk * NSMP * 512 - (size_t)SEQ * 512 : out + O_DKP + (size_t)kk * SEQ * 512);
            const int cs = (u.pn & 1) * 256 + cl0;
            if (seg == 0 || seg == 1 || seg == 3 || seg == 4) {
                float mx0 = 0.f, mx1 = 0.f;
#pragma unroll
                for (int ai = 0; ai < 2; ++ai)
#pragma unroll
                    for (int m = 0; m < 4; ++m) {
#pragma unroll
                        for (int bj = 0; bj < 2; ++bj) { const f32x4 v0 = acc[ai][bj][m][0] * sc, v1 = acc[ai][bj][m][1] * sc;
                            float ss = (v0[0] * v0[0] + v0[1] * v0[1]) + (v0[2] * v0[2] + v0[3] * v0[3]) + (v1[0] * v1[0] + v1[1] * v1[1]) + (v1[2] * v1[2] + v1[3] * v1[3]);
                            ss += __shfl_xor(ss, 16); ss += __shfl_xor(ss, 32);
                            if (bj == 0) mx0 = fmaxf(mx0, ss); else mx1 = fmaxf(mx1, ss); } }
#pragma unroll
                for (int ofs = 1; ofs < 16; ofs <<= 1) { mx0 = fmaxf(mx0, __shfl_xor(mx0, ofs)); mx1 = fmaxf(mx1, __shfl_xor(mx1, ofs)); }
                if ((fr | fq) == 0) { unsigned* nw = (unsigned*)(ws + WS_CTL) + (seg < 3 ? 288 : 256) + ((seg == 4 || seg == 1) ? 16 : 0);
                    const int h0 = (u.pn & 1) * 4 + (wc >> 1), hf = wc & 1;
                    atomicMax(nw + (h0 * 2 + hf), __float_as_uint(mx0)); atomicMax(nw + ((h0 + 2) * 2 + hf), __float_as_uint(mx1)); }
            }
#pragma unroll
            for (int ai = 0; ai < 2; ++ai)
#pragma unroll
                for (int m = 0; m < 4; ++m) { const size_t r = (size_t)(row0 + ai * 128 + m * 16);
#pragma unroll
                    for (int bj = 0; bj < 2; ++bj) { const f32x4 v0 = acc[ai][bj][m][0], v1 = acc[ai][bj][m][1]; const int c = cs + bj * 128;
                        if (ob) { if (smp) { *(f32x4*)(ob + r * 512 + c) = v0; *(f32x4*)(ob + r * 512 + c + 4) = v1; }
                                  else { __builtin_nontemporal_store(v0, (f32x4*)(ob + r * 512 + c)); __builtin_nontemporal_store(v1, (f32x4*)(ob + r * 512 + c + 4)); } }
                        u32x4 w; w.x = pg8::cvt_pk_bf16(v0[0] * sc, v0[1] * sc); w.y = pg8::cvt_pk_bf16(v0[2] * sc, v0[3] * sc); w.z = pg8::cvt_pk_bf16(v1[0] * sc, v1[1] * sc); w.w = pg8::cvt_pk_bf16(v1[2] * sc, v1[3] * sc);
                        *(u32x4*)(B + r * 512 + c) = w; } }
        } else {
            bf16_t* G = (bf16_t*)(ws + WS_G);
            const int cs = (u.pn - 12) * 256 + cl0;
#pragma unroll
            for (int ai = 0; ai < 2; ++ai)
#pragma unroll
                for (int m = 0; m < 4; ++m) { const size_t r = (size_t)(row0 + ai * 128 + m * 16);
#pragma unroll
                    for (int bj = 0; bj < 2; ++bj) { const f32x4 v0 = acc[ai][bj][m][0], v1 = acc[ai][bj][m][1]; const int c = cs + bj * 128;
                        u32x4 w; w.x = cvtpk_v(sigmoidf_(v0[0]), sigmoidf_(v0[1])); w.y = cvtpk_v(sigmoidf_(v0[2]), sigmoidf_(v0[3]));
                        w.z = cvtpk_v(sigmoidf_(v1[0]), sigmoidf_(v1[1])); w.w = cvtpk_v(sigmoidf_(v1[2]), sigmoidf_(v1[3]));
                        *(u32x4*)(G + r * 2048 + c) = w; } }
        }
    }
};
struct EpiGate {
    static constexpr bool PERM = true;
    bf16_t* G; bf16_t* GO;
    __device__ __forceinline__ void operator()(const f32x4 (&acc)[2][2][4][2], const pg8::Unit& u, int wr, int wc, int fr, int fq) const {
        asm volatile("" : "+v"(fr), "+v"(fq));
        const int row0 = u.pm * 256 + wr * 64 + fr, c0 = u.pn * 256 + wc * 32 + 8 * fq;
        u32x4 gq[2][4][2];
#pragma unroll
        for (int ai = 0; ai < 2; ++ai)
#pragma unroll
            for (int m = 0; m < 4; ++m)
#pragma unroll
                for (int bj = 0; bj < 2; ++bj) gq[ai][m][bj] = *(const u32x4*)(G + (size_t)(row0 + ai * 128 + m * 16) * 2048 + c0 + bj * 128);
#pragma unroll
        for (int ai = 0; ai < 2; ++ai)
#pragma unroll
            for (int m = 0; m < 4; ++m) { const size_t ro = (size_t)(row0 + ai * 128 + m * 16) * 2048 + c0; bf16_t* wp = GO + ro;
#pragma unroll
                for (int bj = 0; bj < 2; ++bj) { const f32x4 v0 = acc[ai][bj][m][0], v1 = acc[ai][bj][m][1]; const u32x4 gw = gq[ai][m][bj];
                    u32x4 w; w.x = pg8::cvt_pk_bf16(v0[0] * bflo(gw.x), v0[1] * bfhi(gw.x)); w.y = pg8::cvt_pk_bf16(v0[2] * bflo(gw.y), v0[3] * bfhi(gw.y));
                    w.z = pg8::cvt_pk_bf16(v1[0] * bflo(gw.z), v1[1] * bfhi(gw.z)); w.w = pg8::cvt_pk_bf16(v1[2] * bflo(gw.w), v1[3] * bfhi(gw.w));
                    *(u32x4*)(wp + bj * 128) = w; } }
    }
};
template <bool BASE_BF16> struct EpiRes {
    static constexpr bool PERM = true;
    const void* base; bf16_t* T; const float* gate;
    __device__ __forceinline__ void operator()(const f32x4 (&acc)[2][2][4][2], const pg8::Unit& u, int wr, int wc, int fr, int fq) const {
        asm volatile("" : "+v"(fr), "+v"(fq));
        const int row0 = u.pm * 256 + wr * 64 + fr, c0 = u.pn * 256 + wc * 32 + 8 * fq;
#pragma unroll
        for (int ai = 0; ai < 2; ++ai)
#pragma unroll
            for (int m = 0; m < 4; ++m) { const size_t ro = (size_t)(row0 + ai * 128 + m * 16) * DM;
#pragma unroll
                for (int bj = 0; bj < 2; ++bj) { const int c = c0 + bj * 128; f32x4 b0, b1;
                    if (BASE_BF16) { const u32x4 bw = *(const u32x4*)((const bf16_t*)base + ro + c); b0 = (f32x4){bflo(bw.x), bfhi(bw.x), bflo(bw.y), bfhi(bw.y)}; b1 = (f32x4){bflo(bw.z), bfhi(bw.z), bflo(bw.w), bfhi(bw.w)}; }
                    else { b0 = *(const f32x4*)((const float*)base + ro + c); b1 = *(const f32x4*)((const float*)base + ro + c + 4); }
                    const f32x4 g0 = *(const f32x4*)(gate + c), g1 = *(const f32x4*)(gate + c + 4);
                    const f32x4 v0 = b0 * ALPHA + g0 * acc[ai][bj][m][0], v1 = b1 * ALPHA + g1 * acc[ai][bj][m][1];
                    u32x4 w; w.x = pg8::cvt_pk_bf16(v0[0], v0[1]); w.y = pg8::cvt_pk_bf16(v0[2], v0[3]); w.z = pg8::cvt_pk_bf16(v1[0], v1[1]); w.w = pg8::cvt_pk_bf16(v1[2], v1[3]);
                    *(u32x4*)(T + ro + c) = w; } }
    }
};
struct PanelStats {
    unsigned* xbuf; unsigned* cnt; float eps;
    __device__ __forceinline__ void run(const f32x4 (&v)[2][2][4][2], const pg8::Unit& u, int wr, int wc, int fr, int fq, LAS unsigned char* lds, int wid, int lane) const {
        LAS f32x2* P = (LAS f32x2*)(lds + LN_LDS);
        LAS f32x2* S = (LAS f32x2*)(lds + LN_LDS + 8192);
#pragma unroll
        for (int ai = 0; ai < 2; ++ai)
#pragma unroll
            for (int m = 0; m < 4; ++m) {
                float s = 0.f;
#pragma unroll
                for (int bj = 0; bj < 2; ++bj)
#pragma unroll
                    for (int n = 0; n < 2; ++n) { const f32x4 x = v[ai][bj][m][n]; s += (x[0] + x[1]) + (x[2] + x[3]); }
                s += __shfl_xor(s, 16); s += __shfl_xor(s, 32);
                const float mw = s * (1.0f / 64.0f); float q = 0.f;
#pragma unroll
                for (int bj = 0; bj < 2; ++bj)
#pragma unroll
                    for (int n = 0; n < 2; ++n) { const f32x4 d = v[ai][bj][m][n] - mw; q += (d[0] * d[0] + d[1] * d[1]) + (d[2] * d[2] + d[3] * d[3]); }
                q += __shfl_xor(q, 16); q += __shfl_xor(q, 32);
                if (fq == 0) P[(ai * 128 + wr * 64 + m * 16 + fr) * 4 + wc] = (f32x2){mw, q};
                __builtin_amdgcn_sched_barrier(0);
            }
        asm volatile("s_waitcnt lgkmcnt(0)" ::: "memory"); __builtin_amdgcn_s_barrier(); asm volatile("" ::: "memory");
        const int row = wid * 32 + (lane & 31);
        if (lane < 32) {
            const f32x2 a = P[row * 4 + 0], b = P[row * 4 + 1], c = P[row * 4 + 2], d = P[row * 4 + 3];
            const float mt = (a.x + b.x + c.x + d.x) * 0.25f;
            const float da = a.x - mt, db = b.x - mt, dc = c.x - mt, dd = d.x - mt;
            const float m2 = (a.y + b.y) + (c.y + d.y) + 64.0f * ((da * da + db * db) + (dc * dc + dd * dd));
            unsigned long long* slot = (unsigned long long*)xbuf + ((size_t)(u.pm * 256 + row) * 4 + u.pn);
            __hip_atomic_store(slot, ((unsigned long long)__float_as_uint(m2) << 32) | __float_as_uint(mt), __ATOMIC_RELAXED, __HIP_MEMORY_SCOPE_AGENT);
        }
        asm volatile("s_waitcnt vmcnt(0)" ::: "memory");
        if (lane == 0) __hip_atomic_fetch_add(cnt + 64 * u.pm, 1u, __ATOMIC_RELAXED, __HIP_MEMORY_SCOPE_AGENT);
        if (wid == 0) {
            unsigned sp = 0;
            while ((unsigned)__builtin_amdgcn_readfirstlane(__hip_atomic_load(cnt + 64 * u.pm, __ATOMIC_RELAXED, __HIP_MEMORY_SCOPE_AGENT)) < 32u && ++sp < (1u << 21)) __builtin_amdgcn_s_sleep(2);
            __builtin_amdgcn_fence(__ATOMIC_ACQUIRE, "agent");
        }
        asm volatile("s_waitcnt vmcnt(0) lgkmcnt(0)" ::: "memory"); __builtin_amdgcn_s_barrier(); asm volatile("" ::: "memory");
        if (lane < 32) {
            const unsigned long long* slot = (const unsigned long long*)xbuf + (size_t)(u.pm * 256 + row) * 4; float mt[4], m2[4]; float ms = 0.f;
#pragma unroll
            for (int t = 0; t < 4; ++t) { const unsigned long long w = __hip_atomic_load(slot + t, __ATOMIC_RELAXED, __HIP_MEMORY_SCOPE_AGENT); mt[t] = __uint_as_float((unsigned)w); m2[t] = __uint_as_float((unsigned)(w >> 32)); ms += mt[t]; }
            const float mean = ms * 0.25f; float q = 0.f;
#pragma unroll
            for (int t = 0; t < 4; ++t) { const float dm = mt[t] - mean; q += m2[t] + 256.0f * dm * dm; }
            S[row] = (f32x2){mean, 1.0f / sqrtf(q * (1.0f / 1024.0f) + eps)};
        }
        asm volatile("s_waitcnt lgkmcnt(0)" ::: "memory"); __builtin_amdgcn_s_barrier(); asm volatile("" ::: "memory");
    }
};
template <bool FINAL> struct EpiResLn {
    static constexpr bool PERM = true;
    const void* base; const float* gate; const float* lg; const float* lb; const float* mod; bf16_t* X1B; bf16_t* XN; float* out; PanelStats st; LAS unsigned char* lds;
    __device__ __forceinline__ void operator()(f32x4 (&acc)[2][2][4][2], const pg8::Unit& u, int wr, int wc, int fr, int fq) const {
        asm volatile("" : "+v"(fr), "+v"(fq));
        const int row0 = u.pm * 256 + wr * 64 + fr, c0 = u.pn * 256 + wc * 32 + 8 * fq;
        f32x4 gv[2][2];
#pragma unroll
        for (int bj = 0; bj < 2; ++bj) { int c = c0 + bj * 128; asm volatile("" : "+v"(c)); gv[bj][0] = *(const f32x4*)(gate + c); gv[bj][1] = *(const f32x4*)(gate + c + 4); }
        constexpr int LD_D = 4;
        f32x4 bf_[LD_D][2][2]; u32x4 bw_[LD_D][2];
#define ERL_LOAD(g) do { int rr_ = row0 + ((g) >> 2) * 128 + ((g) & 3) * 16; asm volatile("" : "+v"(rr_)); const size_t ro = (size_t)rr_ * DM; \
        _Pragma("unroll") for (int bj = 0; bj < 2; ++bj) { const int c = c0 + bj * 128; \
            if (FINAL) bw_[(g) % LD_D][bj] = *(const u32x4*)((const bf16_t*)base + ro + c); \
            else { bf_[(g) % LD_D][bj][0] = *(const f32x4*)((const float*)base + ro + c); bf_[(g) % LD_D][bj][1] = *(const f32x4*)((const float*)base + ro + c + 4); } } } while (0)
#pragma unroll
        for (int g = 0; g < LD_D; ++g) ERL_LOAD(g);
#pragma unroll
        for (int g = 0; g < 8; ++g) { const int ai = g >> 2, m = g & 3;
#pragma unroll
            for (int bj = 0; bj < 2; ++bj) { f32x4 b0, b1;
                if (FINAL) { const u32x4 bw = bw_[g % LD_D][bj]; b0 = (f32x4){bflo(bw.x), bfhi(bw.x), bflo(bw.y), bfhi(bw.y)}; b1 = (f32x4){bflo(bw.z), bfhi(bw.z), bflo(bw.w), bfhi(bw.w)}; }
                else { b0 = bf_[g % LD_D][bj][0]; b1 = bf_[g % LD_D][bj][1]; }
                acc[ai][bj][m][0] = b0 * ALPHA + gv[bj][0] * acc[ai][bj][m][0]; acc[ai][bj][m][1] = b1 * ALPHA + gv[bj][1] * acc[ai][bj][m][1];
                asm volatile("" : "+v"(acc[ai][bj][m][0]), "+v"(acc[ai][bj][m][1])); }
            if (g + LD_D < 8) ERL_LOAD(g + LD_D);
            __builtin_amdgcn_sched_barrier(0); }
#undef ERL_LOAD
        st.run(acc, u, wr, wc, fr, fq, lds, wr * 4 + wc, fq * 16 + fr);
        const LAS f32x2* S = (const LAS f32x2*)(lds + LN_LDS + 8192);
        f32x4 cg[2][2], cb[2][2], cs[2][2], ct[2][2];
#pragma unroll
        for (int bj = 0; bj < 2; ++bj) { int c = c0 + bj * 128; asm volatile("" : "+v"(c));
            cg[bj][0] = *(const f32x4*)(lg + c); cg[bj][1] = *(const f32x4*)(lg + c + 4); cb[bj][0] = *(const f32x4*)(lb + c); cb[bj][1] = *(const f32x4*)(lb + c + 4);
            if (!FINAL) { cs[bj][0] = *(const f32x4*)(mod + 4096 + c) + 1.0f; cs[bj][1] = *(const f32x4*)(mod + 4096 + c + 4) + 1.0f; ct[bj][0] = *(const f32x4*)(mod + 3072 + c); ct[bj][1] = *(const f32x4*)(mod + 3072 + c + 4); } }
#pragma unroll
        for (int ai = 0; ai < 2; ++ai)
#pragma unroll
            for (int m = 0; m < 4; ++m) { int r = ai * 128 + wr * 64 + m * 16 + fr; asm volatile("" : "+v"(r)); const f32x2 sr = S[r]; const size_t ro = (size_t)(u.pm * 256 + r) * DM;
#pragma unroll
                for (int bj = 0; bj < 2; ++bj) { const int c = c0 + bj * 128;
                    const f32x4 y0 = (acc[ai][bj][m][0] - sr.x) * sr.y * cg[bj][0] + cb[bj][0];
                    const f32x4 y1 = (acc[ai][bj][m][1] - sr.x) * sr.y * cg[bj][1] + cb[bj][1];
                    if (FINAL) { __builtin_nontemporal_store(y0, (f32x4*)(out + ro + c)); __builtin_nontemporal_store(y1, (f32x4*)(out + ro + c + 4)); }
                    else { u32x4 w; w.x = pg8::cvt_pk_bf16(y0[0], y0[1]); w.y = pg8::cvt_pk_bf16(y0[2], y0[3]); w.z = pg8::cvt_pk_bf16(y1[0], y1[1]); w.w = pg8::cvt_pk_bf16(y1[2], y1[3]);
                        *(u32x4*)(X1B + ro + c) = w;
                        const f32x4 h0 = y0 * cs[bj][0] + ct[bj][0], h1 = y1 * cs[bj][1] + ct[bj][1];
                        u32x4 w2; w2.x = pg8::cvt_pk_bf16(h0[0], h0[1]); w2.y = pg8::cvt_pk_bf16(h0[2], h0[3]); w2.z = pg8::cvt_pk_bf16(h1[0], h1[1]); w2.w = pg8::cvt_pk_bf16(h1[2], h1[3]);
                        *(u32x4*)(XN + ro + c) = w2; } }
                __builtin_amdgcn_sched_barrier(0); }
    }
};
struct EpiSlab {
    static constexpr bool PERM = true;
    float* slab;
    __device__ __forceinline__ void operator()(const f32x4 (&acc)[2][2][4][2], const pg8::Unit& u, int wr, int wc, int fr, int fq) const {
        asm volatile("" : "+v"(fr), "+v"(fq));
        const int row0 = wr * 64 + fr, c0 = u.pn * 256 + wc * 32 + 8 * fq; float* sb = slab + (size_t)u.ks * NSMP * DM;
#pragma unroll
        for (int ai = 0; ai < 2; ++ai)
#pragma unroll
            for (int m = 0; m < 4; ++m) { float* op = sb + (size_t)(row0 + ai * 128 + m * 16) * DM + c0;
#pragma unroll
                for (int bj = 0; bj < 2; ++bj) { *(f32x4*)(op + bj * 128) = acc[ai][bj][m][0]; *(f32x4*)(op + bj * 128 + 4) = acc[ai][bj][m][1]; } }
    }
};
struct EpiFfn {
    static constexpr bool PERM = true;
    bf16_t* ACT;
    __device__ __forceinline__ void operator()(const f32x4 (&acc)[2][2][4][2], const pg8::Unit& u, int wr, int wc, int fr, int fq) const {
        asm volatile("" : "+v"(fr), "+v"(fq));
        const int row0 = u.pm * 256 + wr * 64 + fr, c0 = u.pn * 128 + wc * 32 + 8 * fq;
#pragma unroll
        for (int ai = 0; ai < 2; ++ai)
#pragma unroll
            for (int m = 0; m < 4; ++m) { const f32x4 g0 = acc[ai][0][m][0], g1 = acc[ai][0][m][1], u0 = acc[ai][1][m][0], u1 = acc[ai][1][m][1];
                u32x4 w; w.x = pg8::cvt_pk_bf16(siluf_(g0[0]) * u0[0], siluf_(g0[1]) * u0[1]); w.y = pg8::cvt_pk_bf16(siluf_(g0[2]) * u0[2], siluf_(g0[3]) * u0[3]);
                w.z = pg8::cvt_pk_bf16(siluf_(g1[0]) * u1[0], siluf_(g1[1]) * u1[1]); w.w = pg8::cvt_pk_bf16(siluf_(g1[2]) * u1[2], siluf_(g1[3]) * u1[3]);
                *(u32x4*)(ACT + (size_t)(row0 + ai * 128 + m * 16) * DFF + c0) = w; }
    }
};

struct Frame {
    LAS unsigned char* lds; unsigned char* ldsg;
    int tid, lane, wave, G, bid;
    const float* const* in; float* out; unsigned char* ws;
};
enum { I_XP = 0, I_XS, I_CDK, I_CDV, I_CFK, I_CFV, I_CFL, I_CP, I_CS, I_WADA, I_BADA, I_WIN, I_BF, I_LQ1, I_LK1, I_LQ2, I_LK2, I_SUBG, I_RELB, I_WA, I_WB, I_WO, I_LN1G, I_LN1B, I_LN2G, I_LN2B, I_WFI, I_WFO };

__device__ __forceinline__ void tr_item(const float* W, int ldw, int src_n0, int k0, bf16_t* WT, int ldt, int dst_row0, int dst_k0, int dup_off, LAS float* scr, int lane) {
#pragma unroll 8
    for (int i = 0; i < 32; ++i) { const int kk = 2 * i + (lane >> 5); scr[kk * 33 + (lane & 31)] = W[(size_t)(k0 + kk) * ldw + src_n0 + (lane & 31)]; }
    asm volatile("s_waitcnt lgkmcnt(0)" ::: "memory");
    const int c = lane & 7;
#pragma unroll
    for (int j = 0; j < 4; ++j) { const int n = (lane >> 3) + 8 * j; const LAS float* s = scr + (8 * c) * 33 + n;
        u32x4 o; o.x = pk2(s[0 * 33], s[1 * 33]); o.y = pk2(s[2 * 33], s[3 * 33]); o.z = pk2(s[4 * 33], s[5 * 33]); o.w = pk2(s[6 * 33], s[7 * 33]);
        bf16_t* d = WT + (size_t)(dst_row0 + n) * ldt + dst_k0 + 8 * c;
        *(u32x4*)d = o; if (dup_off) *(u32x4*)(d + dup_off) = o; }
    asm volatile("s_waitcnt lgkmcnt(0)" ::: "memory");
}
__device__ __forceinline__ void weight_copies(Frame& F, int c, int n, int it0, int it1) {
    LAS float* scr = (LAS float*)(F.lds + F.wave * 16384);
    const int gw = c * 8 + F.wave, NGW = n * 8;
    constexpr int I_IN = 16 * (NZ / 32), I_A = 8 * 32, I_B = 8 * 32, I_O = 16 * 32, I_FI = 16 * (NFF2 / 32), I_FO = (DFF / 64) * 32;
    for (int it = it0 + gw; it < it1; it += NGW) {
        int r = it;
        if (r < I_IN) { const int nb = NZ / 32, kb = r / nb, n0 = 32 * (r % nb); tr_item(F.in[I_WIN], WIN_COLS, n0 < 3072 ? n0 : n0 + 8, 64 * kb, (bf16_t*)(F.ws + WS_WIN), 1024, n0, 64 * kb, 0, scr, F.lane); continue; } r -= I_IN;
        if (r < I_A) { const int kb = r / 32, n0 = 32 * (r % 32); tr_item(F.in[I_WA], 1024, n0, 64 * kb, (bf16_t*)(F.ws + WS_WAB), 512, n0, 64 * kb, 0, scr, F.lane); continue; } r -= I_A;
        if (r < I_B) { const int kb = r / 32, n0 = 32 * (r % 32); tr_item(F.in[I_WB], 1024, n0, 64 * kb, (bf16_t*)(F.ws + WS_WAB), 512, 1024 + n0, 64 * kb, 0, scr, F.lane); continue; } r -= I_B;
        if (r < I_O) { const int kb = r / 32, n0 = 32 * (r % 32); tr_item(F.in[I_WO], 1024, n0, 64 * kb, (bf16_t*)(F.ws + WS_WO2), 2048, n0, 64 * kb, 1024, scr, F.lane); continue; } r -= I_O;
        if (r < I_FI) { const int nb = NFF2 / 32, kb = r / nb, n0 = 32 * (r % nb), t = n0 >> 8, j = n0 & 255; const int src = j < 128 ? 128 * t + j : DFF + 128 * t + (j - 128);
            tr_item(F.in[I_WFI], NFF2, src, 64 * kb, (bf16_t*)(F.ws + WS_WFI), 1024, n0, 64 * kb, 0, scr, F.lane); continue; } r -= I_FI;
        { const int kb = r / 32, n0 = 32 * (r % 32); tr_item(F.in[I_WFO], 1024, n0, 64 * kb, (bf16_t*)(F.ws + WS_WFO), DFF, n0, 64 * kb, 0, scr, F.lane); }
    }
}
constexpr int WC_IN = 16 * (NZ / 32), WC_ALL = WC_IN + 8 * 32 + 8 * 32 + 16 * 32 + 16 * (NFF2 / 32) + (DFF / 64) * 32;
__device__ __forceinline__ void p0_prologue(Frame& F) {
    if (F.bid < 96) {
        LAS float* sc = (LAS float*)F.lds;
        LAS float* part = sc + 17 * 1024;
        const int n = F.bid * 64 + F.lane; const float* wa = F.in[I_WADA] + n + (size_t)(F.wave * 128) * 6144;
        float w[32];
#pragma unroll
        for (int j = 0; j < 32; ++j) w[j] = wa[(size_t)j * 6144];
        { float cv[34];
#pragma unroll
          for (int j = 0; j < 34; ++j) { const int i = F.tid + 512 * j, r = i >> 10, k = i & 1023; cv[j] = r == 0 ? F.in[I_CP][k] : F.in[I_CS][(r - 1) * 1024 + k]; }
#pragma unroll
          for (int j = 0; j < 34; ++j) sc[F.tid + 512 * j] = siluf_(cv[j]); }
        __syncthreads();
        float acc[17];
#pragma unroll
        for (int r = 0; r < 17; ++r) acc[r] = 0.f;
#pragma unroll
        for (int kb = 0; kb < 128; kb += 32) {
            float wn[32];
            if (kb + 32 < 128) {
#pragma unroll
                for (int j = 0; j < 32; ++j) wn[j] = wa[(size_t)(kb + 32 + j) * 6144]; }
#pragma unroll
            for (int j = 0; j < 32; j += 4) { const int k = F.wave * 128 + kb + j;
#pragma unroll
                for (int r = 0; r < 17; ++r) { const f32x4 s = *(const LAS f32x4*)(sc + r * 1024 + k); acc[r] += s[0] * w[j] + s[1] * w[j + 1] + s[2] * w[j + 2] + s[3] * w[j + 3]; } }
            if (kb + 32 < 128) {
#pragma unroll
                for (int j = 0; j < 32; ++j) w[j] = wn[j]; }
        }
#pragma unroll
        for (int r = 0; r < 17; ++r) part[(F.wave * 17 + r) * 64 + F.lane] = acc[r];
        __syncthreads();
        float* mod = (float*)(F.ws + WS_MOD);
        for (int i = F.tid; i < 17 * 64; i += 512) { const int r = i >> 6, l = i & 63; float s = 0.f;
#pragma unroll
            for (int w = 0; w < 8; ++w) s += part[(w * 17 + r) * 64 + l];
            mod[r * 6144 + F.bid * 64 + l] = s + F.in[I_BADA][F.bid * 64 + l]; }
        asm volatile("s_waitcnt vmcnt(0)" ::: "memory");
        __syncthreads();
        if (F.tid == 0) { __builtin_amdgcn_fence(__ATOMIC_RELEASE, "agent"); asm volatile("s_waitcnt vmcnt(0)" ::: "memory");
            __hip_atomic_fetch_add((unsigned*)(F.ws + WS_CTL) + 320, 1u, __ATOMIC_RELAXED, __HIP_MEMORY_SCOPE_AGENT); }
    }
    if (F.G >= 192) { if (F.bid >= 96) weight_copies(F, F.bid - 96, F.G - 96, 0, 16 * (NZ / 32)); }
    else weight_copies(F, F.bid, F.G, 0, 16 * (NZ / 32));
}

__device__ __forceinline__ void p1_rows(Frame& F, bool wait_mod) {
    LAS float* wf = (LAS float*)F.lds;
    { float wv[16];
#pragma unroll
      for (int j = 0; j < 16; ++j) { const int i = F.tid + 512 * j; wv[j] = F.in[I_WIN][(size_t)(i >> 3) * WIN_COLS + 3072 + (i & 7)]; }
#pragma unroll
      for (int j = 0; j < 16; ++j) wf[F.tid + 512 * j] = wv[j]; }
    __syncthreads();
    const float* mod = (const float*)(F.ws + WS_MOD);
    bf16_t* XN = (bf16_t*)(F.ws + WS_XN);
    const int gw = F.bid * 8 + F.wave, NGW = F.G * 8;
    if (wait_mod) {
        if (F.tid == 0) { unsigned* w = (unsigned*)(F.ws + WS_CTL) + 320; unsigned sp = 0;
            while (__hip_atomic_load(w, __ATOMIC_RELAXED, __HIP_MEMORY_SCOPE_AGENT) < 96u && ++sp < (1u << 22)) __builtin_amdgcn_s_sleep(2);
            __builtin_amdgcn_fence(__ATOMIC_ACQUIRE, "agent"); asm volatile("s_waitcnt vmcnt(0)" ::: "memory"); }
        __syncthreads(); }
    int m = gw;
    for (; m + NGW < SEQ; m += 2 * NGW) {
        const float* xr0 = F.in[I_XP] + (size_t)m * DM; const float* xr1 = xr0 + (size_t)NGW * DM;
        float a8[2][8];
#pragma unroll
        for (int j = 0; j < 8; ++j) { a8[0][j] = 0.f; a8[1][j] = 0.f; }
#pragma unroll
        for (int j = 0; j < 4; ++j) { const int k = 4 * F.lane + 256 * j;
            const f32x4 x0 = *(const f32x4*)(xr0 + k), x1 = *(const f32x4*)(xr1 + k), s1 = *(const f32x4*)(mod + 1024 + k), t1 = *(const f32x4*)(mod + k);
            const f32x4 h0 = x0 * (s1 + 1.0f) + t1, h1 = x1 * (s1 + 1.0f) + t1;
            u32x2 w; w.x = pk2(h0[0], h0[1]); w.y = pk2(h0[2], h0[3]); *(u32x2*)(XN + (size_t)m * DM + k) = w;
            w.x = pk2(h1[0], h1[1]); w.y = pk2(h1[2], h1[3]); *(u32x2*)(XN + (size_t)(m + NGW) * DM + k) = w;
#pragma unroll
            for (int e = 0; e < 4; ++e) { const f32x4 wa = *(const LAS f32x4*)(wf + (k + e) * 8), wb = *(const LAS f32x4*)(wf + (k + e) * 8 + 4);
#pragma unroll
                for (int c = 0; c < 4; ++c) { a8[0][c] += h0[e] * wa[c]; a8[0][4 + c] += h0[e] * wb[c]; a8[1][c] += h1[e] * wa[c]; a8[1][4 + c] += h1[e] * wb[c]; } } }
        float mine = 0.f;
#pragma unroll
        for (int j = 0; j < 8; ++j) { const float s0 = wave_sum(a8[0][j]), s1 = wave_sum(a8[1][j]); if (F.lane == j) mine = s0; if (F.lane == 8 + j) mine = s1; }
        if (F.lane < 16) { const int rr = F.lane >> 3, c = F.lane & 7; const float v = mine + F.in[I_BF][c]; const float lf = fminf(v, 0.f) - log1pf(__expf(-fabsf(v)));
            F.out[O_FLP + (size_t)(m + rr * NGW) * 8 + c] = lf; }
    }
    for (; m < MT; m += NGW) {
        const bool smp = m >= SEQ; const int rb = smp ? 1 + ((m - SEQ) >> 4) : 0;
        const float* xr = smp ? F.in[I_XS] + (size_t)(m - SEQ) * DM : F.in[I_XP] + (size_t)m * DM;
        const float* sh = mod + (size_t)rb * 6144, *scl = sh + 1024;
        float a8[8];
#pragma unroll
        for (int j = 0; j < 8; ++j) a8[j] = 0.f;
#pragma unroll
        for (int j = 0; j < 4; ++j) { const int k = 4 * F.lane + 256 * j;
            const f32x4 x = *(const f32x4*)(xr + k), s1 = *(const f32x4*)(scl + k), t1 = *(const f32x4*)(sh + k);
            const f32x4 h = x * (s1 + 1.0f) + t1;
            u32x2 w; w.x = pk2(h[0], h[1]); w.y = pk2(h[2], h[3]); *(u32x2*)(XN + (size_t)m * DM + k) = w;
#pragma unroll
            for (int e = 0; e < 4; ++e) { const f32x4 wa = *(const LAS f32x4*)(wf + (k + e) * 8), wb = *(const LAS f32x4*)(wf + (k + e) * 8 + 4);
                a8[0] += h[e] * wa[0]; a8[1] += h[e] * wa[1]; a8[2] += h[e] * wa[2]; a8[3] += h[e] * wa[3];
                a8[4] += h[e] * wb[0]; a8[5] += h[e] * wb[1]; a8[6] += h[e] * wb[2]; a8[7] += h[e] * wb[3]; } }
        float mine = 0.f;
#pragma unroll
        for (int j = 0; j < 8; ++j) { const float s = wave_sum(a8[j]); if (F.lane == j) mine = s; }
        if (F.lane < 8) { const float v = mine + F.in[I_BF][F.lane]; const float lf = fminf(v, 0.f) - log1pf(__expf(-fabsf(v)));
            float* o = smp ? F.out + O_FLS + (size_t)(m - SEQ) * 8 : F.out + O_FLP + (size_t)m * 8; o[F.lane] = lf; }
    }
}

__device__ __forceinline__ float block_excl_scan(Frame& F, float tot, LAS float* sm) {
    float inc = tot;
#pragma unroll
    for (int o = 1; o < 64; o <<= 1) { const float t = __shfl_up(inc, o); if (F.lane >= o) inc += t; }
    if (F.lane == 63) sm[F.wave] = inc;
    __syncthreads();
    float base = 0.f;
    for (int w = 0; w < F.wave; ++w) base += sm[w];
    __syncthreads();
    return base + inc - tot;
}
__device__ __forceinline__ void p2_cumsum(Frame& F) {
    LAS float* sm = (LAS float*)F.lds;
    const int rb_ = F.G >= 160 ? F.bid - 20 : F.bid;
    if (rb_ < 0) return;
    if (rb_ < 8) {
        const int h = rb_; const float* lf = F.out + O_FLP; float* Fp = (float*)(F.ws + WS_FP) + (size_t)h * SEQ;
        float v[32]; float run = 0.f;
#pragma unroll
        for (int i = 0; i < 32; ++i) { run += lf[(size_t)(32 * F.tid + i) * 8 + h]; v[i] = run; }
        const float off = block_excl_scan(F, run, sm);
#pragma unroll
        for (int i = 0; i < 32; i += 4) *(f32x4*)(Fp + 32 * F.tid + i) = (f32x4){(off + v[i]) * LOG2E, (off + v[i + 1]) * LOG2E, (off + v[i + 2]) * LOG2E, (off + v[i + 3]) * LOG2E};
    } else if (rb_ < 8 + 128) {
        const int b = (rb_ - 8) >> 3, h = (rb_ - 8) & 7;
        const float* cl = F.in[I_CFL] + (size_t)b * PAST * 8; float* Fs = (float*)(F.ws + WS_FS) + (size_t)(b * 8 + h) * SKV;
        float v[4]; float run = 0.f;
#pragma unroll
        for (int i = 0; i < 4; ++i) { run += cl[(size_t)(4 * F.tid + i) * 8 + h]; v[i] = run; }
        const float off = block_excl_scan(F, run, sm);
        *(f32x4*)(Fs + 4 * F.tid) = (f32x4){(off + v[0]) * LOG2E, (off + v[1]) * LOG2E, (off + v[2]) * LOG2E, (off + v[3]) * LOG2E};
        if (F.tid == 511) { float r2 = off + run; const float* ls = F.out + O_FLS + (size_t)b * DEC_T * 8;
            for (int t = 0; t < DEC_T; ++t) { r2 += ls[t * 8 + h]; Fs[PAST + t] = r2 * LOG2E; } }
    }
}

template <bool FINAL> __device__ __forceinline__ void ln_rows(Frame& F, const float* g, const float* b, int KS, int gate_off) {
    const float* mod = (const float*)(F.ws + WS_MOD);
    const bf16_t* T = (const bf16_t*)(F.ws + WS_TB); bf16_t* X1B = (bf16_t*)(F.ws + WS_X1B); bf16_t* XN = (bf16_t*)(F.ws + WS_XN);
    const int gw = F.wave * F.G + F.bid, NGW = F.G * 8;
    for (int m = SEQ + gw; m < MT; m += NGW) {
        f32x4 v[4]; float s = 0.f;
        if (m < SEQ) {
#pragma unroll
            for (int j = 0; j < 2; ++j) { const u32x4 w = *(const u32x4*)(T + (size_t)m * DM + 8 * F.lane + 512 * j);
                v[2 * j] = (f32x4){bflo(w.x), bfhi(w.x), bflo(w.y), bfhi(w.y)}; v[2 * j + 1] = (f32x4){bflo(w.z), bfhi(w.z), bflo(w.w), bfhi(w.w)}; }
        } else {
            const float* sl = (const float*)(F.ws + WS_SLAB) + (size_t)(m - SEQ) * DM; const float* gp = mod + (size_t)(1 + ((m - SEQ) >> 4)) * 6144 + gate_off;
#pragma unroll
            for (int q = 0; q < 4; ++q) { const int k = 8 * F.lane + 512 * (q >> 1) + 4 * (q & 1); f32x4 a = (f32x4){0.f, 0.f, 0.f, 0.f};
                { constexpr int KSC = FINAL ? 11 : 8; f32x4 sv[KSC];
#pragma unroll
                  for (int ks = 0; ks < KSC; ++ks) sv[ks] = *(const f32x4*)(sl + (size_t)ks * NSMP * DM + k);
#pragma unroll
                  for (int ks = 0; ks < KSC; ++ks) a += sv[ks]; }
                f32x4 bs;
                if (FINAL) { const u32x2 w = *(const u32x2*)(X1B + (size_t)m * DM + k); bs = (f32x4){bflo(w.x), bfhi(w.x), bflo(w.y), bfhi(w.y)}; }
                else bs = *(const f32x4*)(F.in[I_XS] + (size_t)(m - SEQ) * DM + k);
                v[q] = bs * ALPHA + *(const f32x4*)(gp + k) * a; } }
#pragma unroll
        for (int q = 0; q < 4; ++q) s += (v[q][0] + v[q][1]) + (v[q][2] + v[q][3]);
        const float mean = wave_sum(s) * (1.f / DM); float s2 = 0.f;
#pragma unroll
        for (int q = 0; q < 4; ++q) { v[q] = v[q] - mean; s2 += (v[q][0] * v[q][0] + v[q][1] * v[q][1]) + (v[q][2] * v[q][2] + v[q][3] * v[q][3]); }
        const float rstd = 1.f / sqrtf(wave_sum(s2) * (1.f / DM) + LN_EPS);
        const int rb = m >= SEQ ? 1 + ((m - SEQ) >> 4) : 0;
#pragma unroll
        for (int q = 0; q < 4; ++q) { const int k = 8 * F.lane + 512 * (q >> 1) + 4 * (q & 1); const f32x4 gg = *(const f32x4*)(g + k), bb = *(const f32x4*)(b + k);
            const f32x4 y = v[q] * rstd * gg + bb;
            if (FINAL) *(f32x4*)(F.out + (size_t)m * DM + k) = y;
            else { u32x2 w; w.x = pk2(y[0], y[1]); w.y = pk2(y[2], y[3]); *(u32x2*)(X1B + (size_t)m * DM + k) = w;
                const f32x4 s2v = *(const f32x4*)(mod + (size_t)rb * 6144 + 4096 + k), t2v = *(const f32x4*)(mod + (size_t)rb * 6144 + 3072 + k);
                const f32x4 h = y * (s2v + 1.0f) + t2v; u32x2 w2; w2.x = pk2(h[0], h[1]); w2.y = pk2(h[2], h[3]); *(u32x2*)(XN + (size_t)m * DM + k) = w2; } }
    }
}

__device__ __forceinline__ int t5_bucket(int rel) {
    const int n = rel < 0 ? -rel : rel; int b;
    if (n < 8) b = n; else if (n < 12) b = 8; else if (n < 16) b = 9; else if (n < 23) b = 10; else if (n < 32) b = 11; else if (n < 46) b = 12; else if (n < 64) b = 13; else if (n < 91) b = 14; else b = 15;
    return b + (rel > 0 ? 16 : 0);
}
constexpr int AT_KB = 8192, AT_VB = 20480, AT_BUF = AT_KB + AT_VB;
constexpr int AT_WS = 2 * AT_BUF, AT_OST = AT_WS + 2048, AT_KEEP = 98304, AT_TAB = 131072, AT_MISC = AT_TAB + 4 * 192 * 4, AT_END = AT_MISC + 64;
__device__ __forceinline__ s16x4 vtr(const LAS char* p) { typedef short v4i16_t __attribute__((ext_vector_type(4))); return __builtin_bit_cast(s16x4, __builtin_amdgcn_ds_read_tr16_b64_v4i16((LAS v4i16_t*)p)); }

typedef __bf16 bf16x2_t_ __attribute__((ext_vector_type(2)));
__device__ __forceinline__ unsigned cvtpk_(float lo, float hi) { f32x2 v = {lo, hi}; bf16x2_t_ b = __builtin_convertvector(v, bf16x2_t_); return __builtin_bit_cast(unsigned, b); }
__device__ __forceinline__ void glds16_asm(const void* gsrc, unsigned lds_dst) { unsigned keep;
    asm volatile("s_mov_b32 %0, m0\n\ts_mov_b32 m0, %2\n\ts_nop 0\n\tglobal_load_lds_dwordx4 %1, off\n\ts_mov_b32 m0, %0" : "=&s"(keep) : "v"(gsrc), "s"(lds_dst) : "memory"); }
template <int OFF> __device__ __forceinline__ void glds16_asm_off(const void* gsrc, unsigned lds_dst) { unsigned keep;
    asm volatile("s_mov_b32 %0, m0\n\ts_mov_b32 m0, %2\n\ts_nop 0\n\tglobal_load_lds_dwordx4 %1, off offset:%3\n\ts_mov_b32 m0, %0" : "=&s"(keep) : "v"(gsrc), "s"(lds_dst), "i"(OFF) : "memory"); }
template <int OFF> __device__ __forceinline__ void glds16_s(const void* sbase, unsigned voff, unsigned lds_dst) { unsigned keep;
    asm volatile("s_mov_b32 %0, m0\n\ts_mov_b32 m0, %3\n\ts_nop 0\n\tglobal_load_lds_dwordx4 %1, %2 offset:%4\n\ts_mov_b32 m0, %0" : "=&s"(keep) : "v"(voff), "s"(sbase), "s"(lds_dst), "i"(OFF) : "memory"); }
__device__ __forceinline__ void glds4_s(const void* sbase, unsigned voff, unsigned lds_dst) { unsigned keep;
    asm volatile("s_mov_b32 %0, m0\n\ts_mov_b32 m0, %3\n\ts_nop 0\n\tglobal_load_lds_dword %1, %2\n\ts_mov_b32 m0, %0" : "=&s"(keep) : "v"(voff), "s"(sbase), "s"(lds_dst) : "memory"); }
__device__ __forceinline__ const void* uniform_ptr(const void* p) { const unsigned long long v = (unsigned long long)p;
    const unsigned lo = (unsigned)__builtin_amdgcn_readfirstlane((int)(unsigned)v), hi = (unsigned)__builtin_amdgcn_readfirstlane((int)(unsigned)(v >> 32)); return (const void*)(((unsigned long long)hi << 32) | lo); }
__device__ __forceinline__ void glds4_asm(const void* gsrc, unsigned lds_dst) { unsigned keep;
    asm volatile("s_mov_b32 %0, m0\n\ts_mov_b32 m0, %2\n\ts_nop 0\n\tglobal_load_lds_dword %1, off\n\ts_mov_b32 m0, %0" : "=&s"(keep) : "v"(gsrc), "s"(lds_dst) : "memory"); }
constexpr int R_V = 0, R_K = 49152, R_F = 73728, R_WS = 79872;
__device__ __forceinline__ float max3f_(float a, float b, float c) { float r; asm("v_max3_f32 %0, %1, %2, %3" : "=v"(r) : "v"(a), "v"(b), "v"(c)); return r; }
__device__ __forceinline__ float max2f_(float a, float b) { float r; asm("v_max_f32_e32 %0, %1, %2" : "=v"(r) : "v"(a), "v"(b)); return r; }
#define AP3_PIN(x) asm volatile("" : "+v"(x))
template <int MODE, int DV, int pv = 0, bool SREF = false>
__device__ __forceinline__ void attn_pass3(Frame& F, const bf16_t* Q, const bf16_t* K, const bf16_t* V, int q0, int NT, const float* Fh, int hb, f32x16 (&o)[DV / 32], int t0 = 0) {
    constexpr int NDB = DV / 32, VS = DV * 128, EPG = 8 / NDB;
    constexpr float THR = 8.0f;
    const int lane = F.lane, r32 = lane & 31, hi = lane >> 5, wid = F.wave;
    const LAS char* lds = (const LAS char*)F.lds;
    LAS float* wsf = (LAS float*)(F.lds + R_WS) + wid * 64;
    const LAS float* tab = (const LAS float*)(F.lds + AT_TAB) + hb * 192;
    const int qrow = q0 + wid * 32 + r32;
    const int tmaxw = (q0 >> 6) + (wid >> 1);
    const char* Ku = (const char*)uniform_ptr(K); const char* Vu = (const char*)uniform_ptr(V); const char* Fu = (const char*)uniform_ptr(MODE == 0 ? (const void*)Fh : (const void*)K);
    const unsigned kvo = (unsigned)(((8 * wid + (lane >> 3)) * 512 + (((lane & 7) ^ (lane >> 3)) << 3)) * 2);
    const unsigned vvo = (unsigned)(((16 * (wid & 3) + (lane >> 2)) * 512 + 32 * (wid >> 2) + 8 * (lane & 3)) * 2);
    const unsigned fvo = (unsigned)(lane * 4);
    const unsigned lds0 = (unsigned)(size_t)F.lds;
    const unsigned dk = (unsigned)__builtin_amdgcn_readfirstlane((int)(lds0 + R_K + wid * 1024)), dv = (unsigned)__builtin_amdgcn_readfirstlane((int)(lds0 + R_V + wid * 1024)),
                   df = (unsigned)__builtin_amdgcn_readfirstlane((int)(lds0 + R_F + wid * 256));
#define AP_ISSUE_K(t, SL) do { glds16_s<0>(Ku + (size_t)(t) * 65536, kvo, dk + (SL) * 8192); if (MODE == 0) glds4_s(Fu + (size_t)(t) * 256, fvo, df + (SL) * 2048); } while (0)
#define AP_ISSUE_V(t, SL) do { glds16_s<0>(Vu + (size_t)(t) * 65536, vvo, dv + (SL) * VS); if (DV == 128) glds16_s<0>(Vu + (size_t)(t) * 65536 + 128, vvo, dv + (SL) * VS + 8192); } while (0)
#define AP_BATCH(t, SL) do { if (pv != 1) { if ((t) + 2 < NT) AP_ISSUE_K((t) + 2, ((SL) + 2) % 3); if ((t) + 1 < NT) AP_ISSUE_V((t) + 1, ((SL) + 1) % 3); } } while (0)
    AP_ISSUE_K(t0, 0); AP_ISSUE_K(t0 + 1, 1); AP_ISSUE_V(t0, 0);
    bf16x8 qr[4];
#pragma unroll
    for (int d0 = 0; d0 < 4; ++d0) qr[d0] = *(const bf16x8*)(Q + (size_t)qrow * 512 + d0 * 16 + hi * 8);
    float fqp = MODE == 0 ? Fh[qrow] : 0.f;
#pragma unroll
    for (int d = 0; d < NDB; ++d) o[d] = f32x16{};
    float m_hat = 0.f, l_run = 0.f;
    f32x16 p0, p1, negm; u32x4 pwv[4];
#pragma unroll
    for (int r = 0; r < 16; ++r) negm[r] = 0.f;
#pragma unroll
    for (int i = 0; i < 4; ++i) pwv[i] = (u32x4){0u, 0u, 0u, 0u};
    const LAS char* kb4[4];
#pragma unroll
    for (int d0 = 0; d0 < 4; ++d0) kb4[d0] = lds + R_K + r32 * 128 + (((2 * d0 + hi) ^ (r32 & 7)) << 4);
    const LAS char* vb1 = lds + R_V + (4 * hi + ((lane & 15) >> 2)) * 64 + (((lane >> 4) & 1) * 16 + (lane & 3) * 4) * 2;
    const LAS char* fb1 = lds + R_F + wid * 256 + 16 * hi;
    asm volatile("s_waitcnt vmcnt(0)" ::: "memory");
    asm volatile("" : "+v"(qr[0]), "+v"(qr[1]), "+v"(qr[2]), "+v"(qr[3]), "+v"(fqp));
    asm volatile("s_waitcnt lgkmcnt(0)\n\ts_barrier" ::: "memory");
#define AP3_VFL(buf, ks, SLV) do { _Pragma("unroll") for (int d = 0; d < NDB; ++d) { buf[2 * d] = vtr(vb1 + (SLV) * VS + d * 4096 + (ks) * 1024); buf[2 * d + 1] = vtr(vb1 + (SLV) * VS + d * 4096 + (ks) * 1024 + 512); } } while (0)
#define AP3_VFL1(buf, d, ks, SLV) do { buf[2 * (d)] = vtr(vb1 + (SLV) * VS + (d) * 4096 + (ks) * 1024); buf[2 * (d) + 1] = vtr(vb1 + (SLV) * VS + (d) * 4096 + (ks) * 1024 + 512); } while (0)
#define AP3_FRAG(buf, d) ((bf16x8){buf[2 * (d)][0], buf[2 * (d)][1], buf[2 * (d)][2], buf[2 * (d)][3], buf[2 * (d) + 1][0], buf[2 * (d) + 1][1], buf[2 * (d) + 1][2], buf[2 * (d) + 1][3]})
#define AP3_GAP(ks, d, VCUR, VNXT, PC, BC, PP, BP, HASPREV, HASNEXT, SLV) do { \
        o[d] = __builtin_amdgcn_mfma_f32_32x32x16_bf16(__builtin_bit_cast(bf16x8, pwv[ks]), AP3_FRAG(VCUR, d), o[d], 0, 0, 0); \
        if (HASNEXT) AP3_VFL1(VNXT, d, (ks) + 1, SLV); \
        _Pragma("unroll") for (int e = 0; e < EPG; ++e) { PC[(BC) + EPG * (d) + e] = __builtin_amdgcn_exp2f(PC[(BC) + EPG * (d) + e]); } \
        if (HASPREV) { _Pragma("unroll") for (int e = 0; e < EPG; ++e) rs += PP[(BP) + EPG * (d) + e]; \
            _Pragma("unroll") for (int e = 0; e < EPG / 2; ++e) pwv[(ks) - 1][(EPG / 2) * (d) + e] = cvtpk_(PP[(BP) + EPG * (d) + 2 * e], PP[(BP) + EPG * (d) + 2 * e + 1]); AP3_PIN(rs); } \
        AP3_PIN(PC); \
        __builtin_amdgcn_sched_barrier(0); } while (0)
#define AP3_GROUP(ks, VCUR, VNXT, PC, BC, PP, BP, HASPREV, HASNEXT, SLV) do { _Pragma("unroll") for (int d = 0; d < NDB; ++d) AP3_GAP(ks, d, VCUR, VNXT, PC, BC, PP, BP, HASPREV, HASNEXT, SLV); } while (0)
#define AP3_OCT(PC, BC, KS) do { _Pragma("unroll") for (int e = 0; e < 8; ++e) { PC[(BC) + e] = __builtin_amdgcn_exp2f(PC[(BC) + e]); rs += PC[(BC) + e]; } \
        _Pragma("unroll") for (int e = 0; e < 4; ++e) pwv[KS][e] = cvtpk_(PC[(BC) + 2 * e], PC[(BC) + 2 * e + 1]); } while (0)
#define AP3_KRD(i, SL) (*(const LAS bf16x8*)(kb4[(i) >> 1] + (SL) * 8192 + ((i) & 1) * 4096))
#define AP3_MM(KF, d0, P) P = __builtin_amdgcn_mfma_f32_32x32x16_bf16(KF, qr[d0], P, 0, 0, 0)
#define AP3_QKF(SL) do { bf16x8 ka = AP3_KRD(0, SL), kb = AP3_KRD(1, SL), kc = AP3_KRD(2, SL); \
        if (MODE == 0) { \
            _Pragma("unroll") for (int g4 = 0; g4 < 4; ++g4) { const f32x4 fa = *(const LAS f32x4*)(fb1 + (SL) * 2048 + 32 * g4), fb = *(const LAS f32x4*)(fb1 + (SL) * 2048 + 128 + 32 * g4); \
                _Pragma("unroll") for (int e = 0; e < 4; ++e) { p0[4 * g4 + e] = fqp - fa[e]; p1[4 * g4 + e] = fqp - fb[e]; } } \
        } else { p0 = f32x16{}; p1 = f32x16{}; } \
        __builtin_amdgcn_sched_barrier(0); \
        AP3_MM(ka, 0, p0); ka = AP3_KRD(3, SL); __builtin_amdgcn_sched_barrier(0); \
        AP3_MM(kb, 0, p1); kb = AP3_KRD(4, SL); __builtin_amdgcn_sched_barrier(0); \
        AP3_MM(kc, 1, p0); kc = AP3_KRD(5, SL); __builtin_amdgcn_sched_barrier(0); \
        AP3_MM(ka, 1, p1); ka = AP3_KRD(6, SL); __builtin_amdgcn_sched_barrier(0); \
        AP3_MM(kb, 2, p0); kb = AP3_KRD(7, SL); __builtin_amdgcn_sched_barrier(0); \
        AP3_MM(kc, 2, p1); __builtin_amdgcn_sched_barrier(0); \
        AP3_MM(ka, 3, p0); __builtin_amdgcn_sched_barrier(0); \
        AP3_MM(kb, 3, p1); \
        asm volatile("" : "+v"(p0), "+v"(p1)); \
    } while (0)
#define AP3_QKS(SL) do { bf16x8 kf[8]; \
        _Pragma("unroll") for (int d0 = 0; d0 < 4; ++d0) { kf[2 * d0] = *(const LAS bf16x8*)(kb4[d0] + (SL) * 8192); kf[2 * d0 + 1] = *(const LAS bf16x8*)(kb4[d0] + (SL) * 8192 + 4096); } \
        if (MODE == 0) { const float sft = fqp - m_hat; \
            _Pragma("unroll") for (int g4 = 0; g4 < 4; ++g4) { const f32x4 fa = *(const LAS f32x4*)(fb1 + (SL) * 2048 + 32 * g4), fb = *(const LAS f32x4*)(fb1 + (SL) * 2048 + 128 + 32 * g4); \
                _Pragma("unroll") for (int e = 0; e < 4; ++e) { p0[4 * g4 + e] = sft - fa[e]; p1[4 * g4 + e] = sft - fb[e]; } } \
            _Pragma("unroll") for (int d0 = 0; d0 < 4; ++d0) { p0 = __builtin_amdgcn_mfma_f32_32x32x16_bf16(kf[2 * d0], qr[d0], p0, 0, 0, 0); p1 = __builtin_amdgcn_mfma_f32_32x32x16_bf16(kf[2 * d0 + 1], qr[d0], p1, 0, 0, 0); } \
        } else { \
            if constexpr (SREF) { p0 = __builtin_amdgcn_mfma_f32_32x32x16_bf16(kf[0], qr[0], f32x16{}, 0, 0, 0); p1 = __builtin_amdgcn_mfma_f32_32x32x16_bf16(kf[1], qr[0], f32x16{}, 0, 0, 0); } \
            else { p0 = __builtin_amdgcn_mfma_f32_32x32x16_bf16(kf[0], qr[0], negm, 0, 0, 0); p1 = __builtin_amdgcn_mfma_f32_32x32x16_bf16(kf[1], qr[0], negm, 0, 0, 0); } \
            _Pragma("unroll") for (int d0 = 1; d0 < 4; ++d0) { p0 = __builtin_amdgcn_mfma_f32_32x32x16_bf16(kf[2 * d0], qr[d0], p0, 0, 0, 0); p1 = __builtin_amdgcn_mfma_f32_32x32x16_bf16(kf[2 * d0 + 1], qr[d0], p1, 0, 0, 0); } } \
        if constexpr (SREF) asm volatile("" : "+v"(p0), "+v"(p1)); else asm volatile("s_nop 15\n\ts_nop 7" : "+v"(p0), "+v"(p1));     \
    } while (0)
#define AP3_QK(SL) do { if constexpr (SREF) AP3_QKF(SL); else AP3_QKS(SL); } while (0)
#define AP3_DECIDE(WITH_TAB) do { \
        if (MODE == 0) { \
            if (t * 64 + 63 > q0 + wid * 32) { const int ln_ = lane_id_opaque(), kv0 = t * 64 + 4 * (ln_ >> 5), qrow_ = q0 + wid * 32 + (ln_ & 31);     \
                _Pragma("unroll") for (int r = 0; r < 16; ++r) { const int kv = kv0 + (r & 3) + 8 * (r >> 2); if (kv > qrow_) p0[r] = -1e30f; if (kv + 32 > qrow_) p1[r] = -1e30f; } } \
        } else if (WITH_TAB) { \
            if (near) { const int ln_ = lane_id_opaque(), kv0 = t * 64 + 4 * (ln_ >> 5), qrow_ = q0 + wid * 32 + (ln_ & 31); const LAS float* tab_ = (const LAS float*)(F.lds + AT_TAB) + hb * 192; \
                _Pragma("unroll") for (int g4 = 0; g4 < 4; ++g4) { \
                    _Pragma("unroll") for (int e = 0; e < 4; ++e) { const int r = 4 * g4 + e; const int rel = kv0 + e + 8 * g4 - qrow_; int i0 = rel + 128, i1 = rel + 160; i0 = i0 < 0 ? 0 : i0; i1 = i1 < 0 ? 0 : i1; \
                        p0[r] += tab_[i0]; p1[r] += tab_[i1]; } \
                    __builtin_amdgcn_sched_barrier(0); } } } \
        if constexpr (!SREF) { \
        float ma = max3f_(p0[0], p0[1], p1[0]), mb = max3f_(p0[2], p0[3], p1[1]); ma = max3f_(ma, p1[2], p1[3]); \
        _Pragma("unroll") for (int r = 4; r < 16; r += 4) { ma = max3f_(ma, p0[r], p0[r + 1]); mb = max3f_(mb, p0[r + 2], p0[r + 3]); ma = max3f_(ma, p1[r], p1[r + 1]); mb = max3f_(mb, p1[r + 2], p1[r + 3]); } \
        float rm = max2f_(ma, mb); \
        { auto rr = __builtin_amdgcn_permlane32_swap(__float_as_uint(rm), __float_as_uint(rm), false, false); rm = max2f_(__uint_as_float(rr[0]), __uint_as_float(rr[1])); } \
        resc = (tz == t0) || __any(rm > THR); \
        if (resc) { const float dl = tz == t0 ? rm : fmaxf(rm, 0.f); m_hat += dl; \
            _Pragma("unroll") for (int r = 0; r < 16; ++r) { p0[r] -= dl; p1[r] -= dl; } \
            if (MODE == 1) { const float nm_ = -m_hat; _Pragma("unroll") for (int r = 0; r < 16; ++r) negm[r] = nm_; } \
            al = tz == t0 ? 1.0f : __builtin_amdgcn_exp2f(-dl); l_run *= al; } } } while (0)
#define AP3_STEP(tt, SL) do { const int t = (tt); if (t > NT) break; int tz = t; asm volatile("" : "+s"(tz)); \
        if (t < NT) AP_BATCH(t, SL); \
        const bool doPV = tz > t0 && t - 1 <= tmaxw, doQK = t < NT && t <= tmaxw; \
        bool resc = false; float al = 1.0f, rs = 0.f; \
        const bool near = MODE == 1 && (t * 64 + 63 + 91 > q0 + wid * 32); \
        if (doQK) AP3_QK(SL); else { p0 = f32x16{}; p1 = f32x16{}; }     \
        __builtin_amdgcn_sched_barrier(0); \
        if (doQK) AP3_DECIDE(true); \
        __builtin_amdgcn_sched_barrier(0); \
        if (doPV) { s16x4 vfa[2 * NDB]; AP3_VFL(vfa, 0, ((SL) + 2) % 3);     \
            AP3_GROUP(0, vfa, vfa, p0, 0, p0, 0, false, true, ((SL) + 2) % 3); \
            AP3_GROUP(1, vfa, vfa, p0, 8, p0, 0, true, true, ((SL) + 2) % 3); \
            AP3_GROUP(2, vfa, vfa, p1, 0, p0, 8, true, true, ((SL) + 2) % 3); \
            AP3_GROUP(3, vfa, vfa, p1, 8, p1, 0, true, false, ((SL) + 2) % 3); \
            _Pragma("unroll") for (int e = 0; e < 8; ++e) rs += p1[8 + e]; \
            _Pragma("unroll") for (int e = 0; e < 4; ++e) pwv[3][e] = cvtpk_(p1[8 + 2 * e], p1[8 + 2 * e + 1]); \
        } else if (doQK) { AP3_OCT(p0, 0, 0); AP3_OCT(p0, 8, 1); AP3_OCT(p1, 0, 2); AP3_OCT(p1, 8, 3); } \
        if (doQK) l_run += rs; \
          \
        if (resc && tz > t0) { \
            if (hi == 0) wsf[r32] = al; \
            asm volatile("s_waitcnt lgkmcnt(0)" ::: "memory"); \
            _Pragma("unroll") for (int g4 = 0; g4 < 4; ++g4) { const f32x4 a4 = *(const LAS f32x4*)(wsf + 8 * g4 + 4 * hi); \
                _Pragma("unroll") for (int d = 0; d < NDB; ++d) \
                    _Pragma("unroll") for (int e = 0; e < 4; ++e) o[d][4 * g4 + e] *= a4[e]; } } \
        if (t == NT) break; \
        if (pv == 6) { if (t + 2 < NT) asm volatile("s_waitcnt vmcnt(3) lgkmcnt(0)" ::: "memory"); else asm volatile("s_waitcnt vmcnt(0) lgkmcnt(0)" ::: "memory"); } \
        else { if (t + 2 < NT) asm volatile("s_waitcnt vmcnt(3) lgkmcnt(0)\n\ts_barrier" ::: "memory"); else asm volatile("s_waitcnt vmcnt(0) lgkmcnt(0)\n\ts_barrier" ::: "memory"); } \
    } while (0)
#define AP3_FSTEP(tt, SL) do { const int t = (tt); \
        AP_ISSUE_K(t + 2, ((SL) + 2) % 3); AP_ISSUE_V(t + 1, ((SL) + 1) % 3); \
        float rs = 0.f; \
        AP3_QKF(SL); \
        __builtin_amdgcn_sched_barrier(0); \
        { s16x4 vfa[2 * NDB]; AP3_VFL(vfa, 0, ((SL) + 2) % 3); \
          AP3_GROUP(0, vfa, vfa, p0, 0, p0, 0, false, true, ((SL) + 2) % 3); \
          AP3_GROUP(1, vfa, vfa, p0, 8, p0, 0, true, true, ((SL) + 2) % 3); \
          AP3_GROUP(2, vfa, vfa, p1, 0, p0, 8, true, true, ((SL) + 2) % 3); \
          AP3_GROUP(3, vfa, vfa, p1, 8, p1, 0, true, false, ((SL) + 2) % 3); \
          _Pragma("unroll") for (int e = 0; e < 8; ++e) rs += p1[8 + e]; \
          _Pragma("unroll") for (int e = 0; e < 4; ++e) pwv[3][e] = cvtpk_(p1[8 + 2 * e], p1[8 + 2 * e + 1]); } \
        l_run += rs; \
        asm volatile("s_waitcnt vmcnt(3) lgkmcnt(0)\n\ts_barrier" ::: "memory"); \
    } while (0)
    if (wid >= 4) __builtin_amdgcn_s_setprio(1);
    int t3 = t0;
    if constexpr (SREF && pv == 0) {
        AP3_STEP(t3, 0); AP3_STEP(t3 + 1, 1); AP3_STEP(t3 + 2, 2); t3 += 3;
        const int tfe = (q0 >> 6) - (MODE == 0 ? 1 : 3);
        for (; t3 + 2 <= tfe; t3 += 3) { AP3_FSTEP(t3, 0); AP3_FSTEP(t3 + 1, 1); AP3_FSTEP(t3 + 2, 2); }
    }
    for (; t3 <= NT; t3 += 3) { AP3_STEP(t3, 0); AP3_STEP(t3 + 1, 1); AP3_STEP(t3 + 2, 2); }
    if (wid >= 4) __builtin_amdgcn_s_setprio(0);
    asm volatile("s_waitcnt lgkmcnt(0)\n\ts_barrier" ::: "memory");
    l_run += __shfl_xor(l_run, 32);
    if (hi == 0) wsf[r32] = 1.0f / l_run;
    asm volatile("s_waitcnt lgkmcnt(0)" ::: "memory");
#pragma unroll
    for (int g4 = 0; g4 < 4; ++g4) { const f32x4 a4 = *(const LAS f32x4*)(wsf + 8 * g4 + 4 * hi);
#pragma unroll
        for (int d = 0; d < NDB; ++d)
#pragma unroll
            for (int e = 0; e < 4; ++e) o[d][4 * g4 + e] *= a4[e]; }
#undef AP_ISSUE_K
#undef AP_ISSUE_V
#undef AP_BATCH
#undef AP3_VFL
#undef AP3_VFL1
#undef AP3_FRAG
#undef AP3_GAP
#undef AP3_GROUP
#undef AP3_OCT
#undef AP3_STEP
#undef AP3_FSTEP
#undef AP3_QK
#undef AP3_QKF
#undef AP3_QKS
#undef AP3_KRD
#undef AP3_MM
#undef AP3_DECIDE
}

template <int NDB> __device__ __forceinline__ void store_o(const f32x16 (&o)[NDB], LAS unsigned char* stgb  , bf16_t* dst  , int ld, int lane) {
    const int r32 = lane & 31, hi = lane >> 5;
    constexpr int DVC = 32 * NDB;
    LAS bf16_t* stg = (LAS bf16_t*)stgb;
#pragma unroll
    for (int d = 0; d < NDB; ++d)
#pragma unroll
        for (int r = 0; r < 16; ++r) { const int row = (r & 3) + 8 * (r >> 2) + 4 * hi; stg[row * DVC + 32 * d + r32] = (bf16_t)f2bf(o[d][r]); }
    asm volatile("s_waitcnt lgkmcnt(0)" ::: "memory");
    constexpr int CPR = DVC / 8;
#pragma unroll
    for (int i = 0; i < (32 * CPR) / 64; ++i) { const int c = i * 64 + lane, row = c / CPR, ch = c % CPR;
        const u32x4 v = *(const LAS u32x4*)(stg + row * DVC + ch * 8); *(u32x4*)(dst + (size_t)row * ld + ch * 8) = v; }
    asm volatile("s_waitcnt lgkmcnt(0)" ::: "memory");
}

__device__ __forceinline__ float lambda_full(Frame& F) {
    const int l = lane_id_opaque() & 63;
    const float a = wave_sum(F.in[I_LQ1][l] * F.in[I_LK1][l]), b = wave_sum(F.in[I_LQ2][l] * F.in[I_LK2][l]);
    return __expf(a) - __expf(b) + 0.2f;
}

template <int pv = 0> __device__ __forceinline__ void attn_prompt_fox(Frame& F, int h, int qb) {
    const bf16_t* Q = (const bf16_t*)(F.ws + WS_QB) + h * 64; const bf16_t* K = (const bf16_t*)(F.ws + WS_KB) + h * 64; const bf16_t* V = (const bf16_t*)(F.ws + WS_VB) + h * 64;
    f32x16 o[2];
    const float* Fh = (const float*)(F.ws + WS_FP) + (size_t)h * SEQ;
    int t0 = 0; bool fast;
    { const unsigned* nw = (const unsigned*)(F.ws + WS_CTL) + 256;
      const float qn2 = __uint_as_float(nw[h * 2]) + __uint_as_float(nw[h * 2 + 1]), kn2 = __uint_as_float(nw[16 + h * 2]) + __uint_as_float(nw[16 + h * 2 + 1]);
      const float B = sqrtf(qn2 * kn2) * 1.02f + 0.5f;
      const float thresh = -40.0f - 2.0f * B;
      fast = __builtin_amdgcn_readfirstlane(B <= 60.0f ? 1 : 0) != 0;
      volatile LAS int* cnt = (volatile LAS int*)(F.lds + AT_MISC + 32);
      __syncthreads();
      if (F.tid < 256) { const int t = F.tid; const bool sk = t < 4 * qb && (Fh[qb * 256] - Fh[64 * t + 63]) <= thresh;
          const int c = __popcll(__ballot(sk)); if (F.lane == 0) cnt[F.wave] = c; }
      __syncthreads();
      t0 = cnt[0] + cnt[1] + cnt[2] + cnt[3]; t0 -= t0 % 3; }
    if (fast) attn_pass3<0, 64, pv, true>(F, Q, K, V, qb * 256, 4 * qb + 4, Fh, 0, o, t0); else attn_pass3<0, 64, pv, false>(F, Q, K, V, qb * 256, 4 * qb + 4, Fh, 0, o, t0);
    if (pv != 0 && o[0][0] != 1234.5678f) { __syncthreads(); return; }
    bf16_t* AB = (bf16_t*)(F.ws + WS_AB);
    store_o<2>(o, F.lds + F.wave * 8192, AB + (size_t)(qb * 256 + F.wave * 32) * DM + 512 + h * 64, DM, F.lane);
    __syncthreads();
}
template <int pv = 0> __device__ __forceinline__ void attn_prompt_diff_half(Frame& F, int h, int half, int qb) {
    const bf16_t* Q = (const bf16_t*)(F.ws + WS_QA) + h * 128 + 64 * half; const bf16_t* K = (const bf16_t*)(F.ws + WS_KA) + h * 128 + 64 * half; const bf16_t* V = (const bf16_t*)(F.ws + WS_VA) + h * 128;
    f32x16 o[4];
    bool fast;
    { const unsigned* nw = (const unsigned*)(F.ws + WS_CTL) + 288; const int hh = h * 2 + half;
      const float qn2 = __uint_as_float(nw[hh * 2]) + __uint_as_float(nw[hh * 2 + 1]), kn2 = __uint_as_float(nw[16 + hh * 2]) + __uint_as_float(nw[16 + hh * 2 + 1]);
      float bm = 0.f; for (int b = 0; b < 32; ++b) bm = fmaxf(bm, fabsf(F.in[I_RELB][b * 4 + h] - F.in[I_RELB][15 * 4 + h]));
      const float B = sqrtf(qn2 * kn2) * 1.02f + 0.5f + bm * LOG2E;
      fast = __builtin_amdgcn_readfirstlane(B <= 60.0f ? 1 : 0) != 0; }
    if (fast) attn_pass3<1, 128, pv, true>(F, Q, K, V, qb * 256, 4 * qb + 4, nullptr, h, o); else attn_pass3<1, 128, pv, false>(F, Q, K, V, qb * 256, 4 * qb + 4, nullptr, h, o);
    if (pv != 0 && o[0][0] != 1234.5678f) { __syncthreads(); return; }
    bf16_t* OD = (bf16_t*)(F.ws + (half ? WS_OD2 : WS_OD1));
    store_o<4>(o, F.lds + F.wave * 8192, OD + (size_t)(qb * 256 + F.wave * 32) * 512 + h * 128, 512, F.lane);
    __syncthreads();
}
constexpr int PF_STR = 66, PD_STR = 130;
__device__ __forceinline__ void p_combine(Frame& F) {
    const float lam = lambda_full(F);
    const bf16_t* O1 = (const bf16_t*)(F.ws + WS_OD1); const bf16_t* O2 = (const bf16_t*)(F.ws + WS_OD2); bf16_t* AB = (bf16_t*)(F.ws + WS_AB);
    const int gw = F.bid * 8 + F.wave, NGW = F.G * 8;
    const int c0 = 8 * F.lane;
    float sg[8];
#pragma unroll
    for (int i = 0; i < 8; ++i) sg[i] = F.in[I_SUBG][(c0 & 127) + i] * 0.8f;
    for (int m0 = gw; m0 < SEQ; m0 += 4 * NGW) {
        u32x4 a[4], b[4];
#pragma unroll
        for (int r = 0; r < 4; ++r) { const int m = m0 + r * NGW; if (m < SEQ) { a[r] = *(const u32x4*)(O1 + (size_t)m * 512 + c0); b[r] = *(const u32x4*)(O2 + (size_t)m * 512 + c0); } else { a[r] = (u32x4){0u, 0u, 0u, 0u}; b[r] = a[r]; } }
#pragma unroll
        for (int r = 0; r < 4; ++r) { const int m = m0 + r * NGW;
            float v[8];
            v[0] = bflo(a[r].x) - lam * bflo(b[r].x); v[1] = bfhi(a[r].x) - lam * bfhi(b[r].x); v[2] = bflo(a[r].y) - lam * bflo(b[r].y); v[3] = bfhi(a[r].y) - lam * bfhi(b[r].y);
            v[4] = bflo(a[r].z) - lam * bflo(b[r].z); v[5] = bfhi(a[r].z) - lam * bfhi(b[r].z); v[6] = bflo(a[r].w) - lam * bflo(b[r].w); v[7] = bfhi(a[r].w) - lam * bfhi(b[r].w);
            float ss = 0.f;
#pragma unroll
            for (int i = 0; i < 8; ++i) ss += v[i] * v[i];
#pragma unroll
            for (int ofs = 1; ofs < 16; ofs <<= 1) ss += __shfl_xor(ss, ofs);
            const float rn = 1.0f / sqrtf(ss * (1.0f / 128.0f) + LN_EPS);
            u32x4 w; w.x = pk2(v[0] * rn * sg[0], v[1] * rn * sg[1]); w.y = pk2(v[2] * rn * sg[2], v[3] * rn * sg[3]); w.z = pk2(v[4] * rn * sg[4], v[5] * rn * sg[5]); w.w = pk2(v[6] * rn * sg[6], v[7] * rn * sg[7]);
            if (m < SEQ) *(u32x4*)(AB + (size_t)m * DM + c0) = w; }
    }
    for (int it = F.bid; it < NSMP; it += F.G) {
        const int b = it >> 4, q = it & 15; const size_t row = (size_t)SEQ + it;
        if (F.wave == 0) {
            const int h = F.lane >> 3, cc = (F.lane & 7) * 8; const float* P = (const float*)(F.ws + WS_PF);
            float M = -1e30f;
#pragma unroll
            for (int s = 0; s < 8; ++s) M = fmaxf(M, P[((size_t)((b * 8 + s) * 8 + h) * 16 + q) * PF_STR + 64]);
            float acc[8], L = 0.f;
#pragma unroll
            for (int i = 0; i < 8; ++i) acc[i] = 0.f;
#pragma unroll
            for (int s = 0; s < 8; ++s) { const float* pr = P + ((size_t)((b * 8 + s) * 8 + h) * 16 + q) * PF_STR; const float wgt = __builtin_amdgcn_exp2f(pr[64] - M); L += wgt * pr[65];
#pragma unroll
                for (int i = 0; i < 8; ++i) acc[i] += wgt * pr[cc + i]; }
            const float inv = 1.0f / L;
            u32x4 w; w.x = pk2(acc[0] * inv, acc[1] * inv); w.y = pk2(acc[2] * inv, acc[3] * inv); w.z = pk2(acc[4] * inv, acc[5] * inv); w.w = pk2(acc[6] * inv, acc[7] * inv);
            *(u32x4*)(AB + row * DM + 512 + c0) = w; }
        if (F.wave == 1) {
            const int h = F.lane >> 4, cc = (F.lane & 15) * 8; const float* P = (const float*)(F.ws + WS_PD);
            float v[8];
#pragma unroll
            for (int i = 0; i < 8; ++i) v[i] = 0.f;
#pragma unroll
            for (int half = 0; half < 2; ++half) {
                float M = -1e30f;
#pragma unroll
                for (int s = 0; s < 8; ++s) M = fmaxf(M, P[((size_t)((b * 8 + s) * 8 + 2 * h + half) * 16 + q) * PD_STR + 128]);
                float acc[8], L = 0.f;
#pragma unroll
                for (int i = 0; i < 8; ++i) acc[i] = 0.f;
#pragma unroll
                for (int s = 0; s < 8; ++s) { const float* pr = P + ((size_t)((b * 8 + s) * 8 + 2 * h + half) * 16 + q) * PD_STR; const float wgt = __builtin_amdgcn_exp2f(pr[128] - M); L += wgt * pr[129];
#pragma unroll
                    for (int i = 0; i < 8; ++i) acc[i] += wgt * pr[cc + i]; }
                const float sc = (half ? -lam : 1.0f) / L;
#pragma unroll
                for (int i = 0; i < 8; ++i) v[i] += acc[i] * sc; }
            float ss = 0.f;
#pragma unroll
            for (int i = 0; i < 8; ++i) ss += v[i] * v[i];
#pragma unroll
            for (int ofs = 1; ofs < 16; ofs <<= 1) ss += __shfl_xor(ss, ofs);
            const float rn = 1.0f / sqrtf(ss * (1.0f / 128.0f) + LN_EPS);
            u32x4 w; w.x = pk2(v[0] * rn * sg[0], v[1] * rn * sg[1]); w.y = pk2(v[2] * rn * sg[2], v[3] * rn * sg[3]); w.z = pk2(v[4] * rn * sg[4], v[5] * rn * sg[5]); w.w = pk2(v[6] * rn * sg[6], v[7] * rn * sg[7]);
            *(u32x4*)(AB + row * DM + c0) = w; }
    }
}

constexpr int SM_K = 0, SM_V = 32768, SM_F = 81920, SM_WS = 83968;
template <int KIND  > __device__ __forceinline__ void sample_unit(Frame& F, int b, int s) {
    constexpr int DV = KIND == 0 ? 64 : 128, NDB = DV / 32, VSTR = KIND == 0 ? 192 : 320, VSUB = 16 * VSTR;
    const int lane = lane_id_opaque(), r32 = lane & 31, hi = lane >> 5, w = F.wave, tid = w * 64 + lane;
    const LAS char* lds = (const LAS char*)F.lds;
    LAS float* wsf = (LAS float*)(F.lds + SM_WS) + w * 64;
    const int hb = KIND == 0 ? w : (w >> 1);
    const LAS float* tab = (const LAS float*)(F.lds + AT_TAB) + hb * 192;
    const int q = r32 & 15, qpos = PAST + q;
    const size_t qrow = (size_t)SEQ + b * DEC_T + q;
    const bf16_t* Qp = (const bf16_t*)(F.ws + (KIND == 0 ? WS_QB : WS_QA)) + qrow * 512 + w * 64;
    bf16x8 qr[4];
#pragma unroll
    for (int d0 = 0; d0 < 4; ++d0) qr[d0] = *(const bf16x8*)(Qp + d0 * 16 + hi * 8);
    const float* Fs = (const float*)(F.ws + WS_FS) + (size_t)(b * 8 + w) * SKV;
    const float fq = KIND == 0 ? Fs[qpos] : 0.f;
    const float* Kc = F.in[KIND == 0 ? I_CFK : I_CDK] + (size_t)b * PAST * 512; const float* Vc = F.in[KIND == 0 ? I_CFV : I_CDV] + (size_t)b * PAST * 512;
    const float* Kn = F.out + (KIND == 0 ? O_FKS : O_DKS) + (size_t)b * DEC_T * 512; const float* Vn = F.out + (KIND == 0 ? O_FVS : O_DVS) + (size_t)b * DEC_T * 512;
    const int kr = tid >> 5, c16 = (tid & 31) * 16;
    const int ksub = c16 >> 6, kch = (c16 >> 3) & 7;
    const int kdst = SM_K + ksub * 4096 + kr * 128;
    const int vdst = KIND == 0 ? SM_V + ksub * VSUB + kr * VSTR + kch * 16 : SM_V + (c16 >> 7) * VSUB + kr * VSTR + ((c16 >> 3) & 15) * 16;
    f32x16 o[NDB];
#pragma unroll
    for (int d = 0; d < NDB; ++d) o[d] = f32x16{};
    float m_run = -1e30f, l_run = 0.f;
    f32x4 gkA[4], gvA[4], gkB[4], gvB[4], gkC[4], gvC[4]; float gfA = 0.f, gfB = 0.f, gfC = 0.f;
    const int nt = s == 0 ? 17 : 16;
    auto gload = [&](f32x4 (&gk)[4], f32x4 (&gv)[4], float& gf, int t) {
        const float* ks; const float* vs;
        if (t < 128) { ks = Kc + (size_t)(16 * t + kr) * 512 + c16; vs = Vc + (size_t)(16 * t + kr) * 512 + c16; }
        else { ks = Kn + (size_t)kr * 512 + c16; vs = Vn + (size_t)kr * 512 + c16; }
#pragma unroll
        for (int j = 0; j < 4; ++j) { gk[j] = *(const f32x4*)(ks + 4 * j); gv[j] = *(const f32x4*)(vs + 4 * j); }
        if (KIND == 0 && tid < 128) gf = ((const float*)(F.ws + WS_FS))[(size_t)(b * 8 + (tid >> 4)) * SKV + 16 * t + (tid & 15)];
    };
    auto lwrite = [&](const f32x4 (&gk)[4], const f32x4 (&gv)[4], float gf) {
#pragma unroll
        for (int j = 0; j < 2; ++j) { u32x4 wk, wv;
            wk.x = pk2(gk[2 * j][0], gk[2 * j][1]); wk.y = pk2(gk[2 * j][2], gk[2 * j][3]); wk.z = pk2(gk[2 * j + 1][0], gk[2 * j + 1][1]); wk.w = pk2(gk[2 * j + 1][2], gk[2 * j + 1][3]);
            wv.x = pk2(gv[2 * j][0], gv[2 * j][1]); wv.y = pk2(gv[2 * j][2], gv[2 * j][3]); wv.z = pk2(gv[2 * j + 1][0], gv[2 * j + 1][1]); wv.w = pk2(gv[2 * j + 1][2], gv[2 * j + 1][3]);
            *(LAS u32x4*)(F.lds + kdst + (((kch + j) ^ (kr & 7)) << 4)) = wk;
            *(LAS u32x4*)(F.lds + vdst + j * 16) = wv; }
        if (KIND == 0 && tid < 128) ((LAS float*)(F.lds + SM_F))[tid] = gf;
    };
    gload(gkA, gvA, gfA, s); gload(gkB, gvB, gfB, s + 8); gload(gkC, gvC, gfC, s + 16);
    __syncthreads();
    { const int sub = tid >> 6, rr = 16 + ((tid >> 2) & 15), cq = (tid & 3) * 32;
      *(LAS u32x4*)(F.lds + SM_K + sub * 4096 + rr * 128 + cq) = (u32x4){0u, 0u, 0u, 0u}; *(LAS u32x4*)(F.lds + SM_K + sub * 4096 + rr * 128 + cq + 16) = (u32x4){0u, 0u, 0u, 0u}; }
    const int vb = SM_V + (KIND == 0 ? w : (w >> 1)) * VSUB + (4 * hi + ((lane & 15) >> 2)) * VSTR + (((lane >> 4) & 1) * 16 + (lane & 3) * 4) * 2;
    auto compute = [&](int t) {
        f32x16 p0 = f32x16{};
#pragma unroll
        for (int d0 = 0; d0 < 4; ++d0) { const bf16x8 kf = *(const LAS bf16x8*)(lds + SM_K + w * 4096 + r32 * 128 + (((2 * d0 + hi) ^ (r32 & 7)) << 4));
            p0 = __builtin_amdgcn_mfma_f32_32x32x16_bf16(kf, qr[d0], p0, 0, 0, 0); }
        const int kv0 = 16 * t + 4 * hi;
        float x[8];
        if (KIND == 0) {
#pragma unroll
            for (int g4 = 0; g4 < 2; ++g4) { const f32x4 fa = *(const LAS f32x4*)(lds + SM_F + (w * 16 + 4 * hi + 8 * g4) * 4);
#pragma unroll
                for (int e = 0; e < 4; ++e) x[4 * g4 + e] = p0[4 * g4 + e] + (fq - fa[e]); }
            if (t == 128) {
#pragma unroll
                for (int r = 0; r < 8; ++r) { const int kv = kv0 + (r & 3) + 8 * (r >> 2); if (kv > qpos) x[r] = -1e30f; } }
        } else {
            if (t < 120) {
#pragma unroll
                for (int r = 0; r < 8; ++r) x[r] = p0[r];
            } else {
#pragma unroll
                for (int r = 0; r < 8; ++r) { const int kv = kv0 + (r & 3) + 8 * (r >> 2); int i0 = kv - qpos + 128; i0 = i0 < 0 ? 0 : i0; x[r] = p0[r] + tab[i0]; } }
        }
        float rm = x[0];
#pragma unroll
        for (int r = 1; r < 8; ++r) rm = fmaxf(rm, x[r]);
        rm = fmaxf(rm, __shfl_xor(rm, 32));
        const float m_new = fmaxf(m_run, rm);
        if (__any(m_new > m_run)) { const float al = __builtin_amdgcn_exp2f(m_run - m_new); l_run *= al; m_run = m_new;
            if (hi == 0) wsf[r32] = al;
            asm volatile("s_waitcnt lgkmcnt(0)" ::: "memory");
#pragma unroll
            for (int g4 = 0; g4 < 2; ++g4) { const f32x4 a4 = *(const LAS f32x4*)(wsf + 8 * g4 + 4 * hi);
#pragma unroll
                for (int d = 0; d < NDB; ++d)
#pragma unroll
                    for (int e = 0; e < 4; ++e) o[d][4 * g4 + e] *= a4[e]; } }
        float rs = 0.f;
#pragma unroll
        for (int r = 0; r < 8; ++r) { x[r] = __builtin_amdgcn_exp2f(x[r] - m_run); rs += x[r]; }
        l_run += rs;
        u32x4 w0; w0.x = cvtpk_v(x[0], x[1]); w0.y = cvtpk_v(x[2], x[3]); w0.z = cvtpk_v(x[4], x[5]); w0.w = cvtpk_v(x[6], x[7]);
        const bf16x8 pa = __builtin_bit_cast(bf16x8, w0);
#pragma unroll
        for (int d = 0; d < NDB; ++d) { const LAS char* vp = lds + vb + d * 64;
            const s16x4 lo = vtr(vp), hi4 = vtr(vp + 8 * VSTR);
            const bf16x8 vf = (bf16x8){lo[0], lo[1], lo[2], lo[3], hi4[0], hi4[1], hi4[2], hi4[3]};
            o[d] = __builtin_amdgcn_mfma_f32_32x32x16_bf16(pa, vf, o[d], 0, 0, 0); }
    };
    for (int i = 0; i < nt; i += 3) {
        const int t = s + 8 * i;
        lwrite(gkA, gvA, gfA); __syncthreads();
        if (i + 3 < nt) gload(gkA, gvA, gfA, t + 24);
        compute(t);
        __syncthreads();
        if (i + 1 >= nt) break;
        lwrite(gkB, gvB, gfB); __syncthreads();
        if (i + 4 < nt) gload(gkB, gvB, gfB, t + 32);
        compute(t + 8);
        __syncthreads();
        if (i + 2 >= nt) break;
        lwrite(gkC, gvC, gfC); __syncthreads();
        if (i + 5 < nt) gload(gkC, gvC, gfC, t + 40);
        compute(t + 16);
        __syncthreads();
    }
    l_run += __shfl_xor(l_run, 32);
    float* P = (float*)(F.ws + (KIND == 0 ? WS_PF : WS_PD)) + ((size_t)((b * 8 + s) * 8 + w) * 16) * (DV + 2);
    { float* P0 = P + (size_t)(4 * hi) * (DV + 2) + r32; float* P1 = P0 + 8 * (DV + 2);
#pragma unroll
      for (int d = 0; d < NDB; ++d)
#pragma unroll
          for (int r = 0; r < 4; ++r) { P0[r * (DV + 2) + 32 * d] = o[d][r]; P1[r * (DV + 2) + 32 * d] = o[d][4 + r]; } }
    if (lane < 16) { P[(size_t)lane * (DV + 2) + DV] = m_run; P[(size_t)lane * (DV + 2) + DV + 1] = l_run; }
}

template <int pv = 0> __device__ __forceinline__ void p3_attention(Frame& F, int mask) {
    LAS float* tab = (LAS float*)(F.lds + AT_TAB);
    for (int i = F.tid; i < 4 * 192; i += 512) { const int h = i / 192, rel = (i % 192) - 128; tab[i] = (F.in[I_RELB][t5_bucket(rel) * 4 + h] - F.in[I_RELB][15 * 4 + h]) * LOG2E; }
    __syncthreads();
    const int x = F.bid & 7, p = (F.bid >> 3) & 31;
    const int spos = F.G == 256 ? (x + p) % 5 : 4;
    for (int j = 0; j < 5; ++j) {
        F.lane = lane_id_opaque(); F.tid = F.wave * 64 + F.lane;
        if (j == spos) {
            if (mask & 4) {
                for (int u = F.bid; u < 256; u += F.G) {
                    F.lane = lane_id_opaque(); F.tid = F.wave * 64 + F.lane;
                    if ((u >> 3) & 1) sample_unit<1>(F, u >> 4, u & 7); else sample_unit<0>(F, u >> 4, u & 7);
                }
            }
        } else if (F.bid < 256) {
            const int i = j - (j > spos ? 1 : 0);
            const int qb = (i & 1) ? p : 63 - p;
            if (i < 2) { if (mask & 1) attn_prompt_diff_half<pv>(F, x >> 1, x & 1, qb); }
            else { if (mask & 2) attn_prompt_fox<pv>(F, x, qb); }
        }
    }
}

__device__ __forceinline__ void slab_publish(Frame& F, int word, int nun) {
    int n = 0; for (int L = F.bid; L < nun; L += F.G) ++n;
    asm volatile("s_waitcnt vmcnt(0)" ::: "memory");
    __syncthreads();
    if (F.tid == 0 && n > 0) { __builtin_amdgcn_fence(__ATOMIC_RELEASE, "agent"); asm volatile("s_waitcnt vmcnt(0)" ::: "memory");
        __hip_atomic_fetch_add((unsigned*)(F.ws + WS_CTL) + word, (unsigned)n, __ATOMIC_RELAXED, __HIP_MEMORY_SCOPE_AGENT); }
}
__device__ __forceinline__ void slab_wait(Frame& F, int word, int nun) {
    if (F.tid == 0) { unsigned* w = (unsigned*)(F.ws + WS_CTL) + word; unsigned sp = 0;
        while (__hip_atomic_load(w, __ATOMIC_RELAXED, __HIP_MEMORY_SCOPE_AGENT) < (unsigned)nun && ++sp < (1u << 22)) __builtin_amdgcn_s_sleep(2);
        __builtin_amdgcn_fence(__ATOMIC_ACQUIRE, "agent"); asm volatile("s_waitcnt vmcnt(0)" ::: "memory"); }
    __syncthreads();
}

#define XB_TMO      128
#define XB_XCNT(j)  (256  + 64 * (j))
#define XB_XSUB(j)  (1280 + 64 * (j))
#define XB_XGEN(j)  (2304 + 64 * (j))
#define XB_TOP      3328
#define XB_TOPGEN   3392
#define XCD_BAR_WORDS 3456
#define XB_SPIN_CAP (1u << 20)
__device__ __forceinline__ unsigned xb_ld(unsigned* p)              { return __hip_atomic_load(p, __ATOMIC_RELAXED, __HIP_MEMORY_SCOPE_AGENT); }
__device__ __forceinline__ unsigned xb_add(unsigned* p, unsigned v) { return __hip_atomic_fetch_add(p, v, __ATOMIC_RELAXED, __HIP_MEMORY_SCOPE_AGENT); }
__device__ __forceinline__ unsigned xb_xcc_id() { return (unsigned)__builtin_amdgcn_s_getreg((3 << 11) | 20) & 0xFu; }
#define XB_SPIN(cond, bar) do { unsigned _sp = 0; while (cond) { __builtin_amdgcn_s_sleep(1); \
    if ((++_sp & 255u) == 0u) { if (xb_ld(&(bar)[XB_TMO])) break; if (_sp > XB_SPIN_CAP) { atomicAdd(&(bar)[XB_TMO], 1u); break; } } } } while (0)
struct XcdBarrier { unsigned* bar; unsigned x; volatile LAS unsigned* st; };
__device__ __forceinline__ XcdBarrier xcd_barrier_post(unsigned* bar, volatile LAS unsigned* st) {
    XcdBarrier b; b.bar = bar; b.x = xb_xcc_id(); b.st = st;
    if (threadIdx.x == 0) (void)xb_add(&bar[XB_XCNT(b.x)], 1u);
    return b;
}
__device__ __forceinline__ void xcd_barrier_complete(unsigned* bar, unsigned x, unsigned& nloc, unsigned& nx) {
    const unsigned G = gridDim.x * gridDim.y * gridDim.z;
    unsigned sum, cnt, mine, sp = 0u;
    for (;;) {
        sum = 0u; cnt = 0u; mine = 0u;
#pragma unroll
        for (unsigned j = 0; j < 16; ++j) { const unsigned c = xb_ld(&bar[XB_XCNT(j)]); sum += c; cnt += (c > 0u) ? 1u : 0u; mine = (j == x) ? c : mine; }
        if (sum == G) break;
        __builtin_amdgcn_s_sleep(1);
        if ((++sp & 255u) == 0u) { if (xb_ld(&bar[XB_TMO])) break; if (sp > XB_SPIN_CAP) { atomicAdd(&bar[XB_TMO], 1u); break; } }
    }
    nloc = mine > 0u ? mine : 1u; nx = cnt > 0u ? cnt : 1u;
}
__device__ __forceinline__ void xcd_barrier(const XcdBarrier& b) {
    asm volatile("s_waitcnt vmcnt(0)" ::: "memory");
    __syncthreads();
    if (threadIdx.x == 0) {
        unsigned* bar = b.bar;
        __builtin_amdgcn_s_waitcnt(0);
        unsigned nloc = b.st[0], nx = b.st[1];
        if (nloc == 0u) { xcd_barrier_complete(bar, b.x, nloc, nx); b.st[0] = nloc; b.st[1] = nx; }
        const unsigned old = xb_add(&bar[XB_XSUB(b.x)], 1u);
        const unsigned gen = old / nloc;
        if (old + 1u == (gen + 1u) * nloc) {
            __builtin_amdgcn_fence(__ATOMIC_RELEASE, "agent");
            asm volatile("s_waitcnt vmcnt(0)" ::: "memory");
            const unsigned og = xb_add(&bar[XB_TOP], 1u);
            const unsigned tg = og / nx;
            if (og + 1u == (tg + 1u) * nx) xb_add(&bar[XB_TOPGEN], 1u);
            else XB_SPIN(xb_ld(&bar[XB_TOPGEN]) == tg, bar);
            __builtin_amdgcn_fence(__ATOMIC_ACQUIRE, "agent");
            xb_add(&bar[XB_XGEN(b.x)], 1u);
            asm volatile("s_waitcnt vmcnt(0)" ::: "memory");
        } else {
            XB_SPIN(xb_ld(&bar[XB_XGEN(b.x)]) == gen, bar);
            __builtin_amdgcn_fence(__ATOMIC_ACQUIRE, "agent");
            asm volatile("s_waitcnt vmcnt(0)" ::: "memory");
        }
    }
    __syncthreads();
}

__global__ void __launch_bounds__(512, 2) mega_fwd(Args args) {
    extern __shared__ __attribute__((aligned(16))) unsigned char lds_raw[];
    Frame F;
    F.lds = (LAS unsigned char*)lds_raw; F.ldsg = lds_raw;
    F.tid = threadIdx.x; F.lane = F.tid & 63; F.wave = __builtin_amdgcn_readfirstlane(F.tid >> 6);
    F.G = gridDim.x; F.bid = blockIdx.x;
    F.in = args.in; F.out = args.out; F.ws = args.ws;
    const int lo = args.ph_lo, hi = args.ph_hi;
    cg::grid_group grid = cg::this_grid();
    const bool fused = (hi - lo) > 1;
    volatile LAS unsigned* bst = (volatile LAS unsigned*)(F.lds + AT_MISC + 16);
    if (F.tid == 0) { bst[0] = 0u; bst[1] = 0u; }
    __syncthreads();
    XcdBarrier xbar; xbar.bar = (unsigned*)(F.ws + WS_CTL) + 1024; xbar.x = 0; xbar.st = bst;
    if (fused) xbar = xcd_barrier_post((unsigned*)(F.ws + WS_CTL) + 1024, bst);
#define IN(k) (lo <= (k) && (k) < hi)
#define PB() do { F.lane = lane_id_opaque(); F.tid = F.wave * 64 + F.lane; } while (0)
#define SEAM(k) do { if (IN(k) && IN((k) + 1)) { xcd_barrier(xbar); } } while (0)
    const float* mod = (const float*)(F.ws + WS_MOD);
    if (IN(0)) { PB(); p0_prologue(F); }
    if (IN(0) && IN(1)) __syncthreads(); else SEAM(0);
    if (IN(1)) { PB(); p1_rows(F, IN(0)); } SEAM(1);
    if (IN(2)) { PB();
        p2_cumsum(F);
        __syncthreads();
        pg8::Gemm g{(const bf16_t*)(F.ws + WS_XN), (const bf16_t*)(F.ws + WS_WIN), 1024, 1024, 1024, 1 << 30, 0, 0};
        pg8::StaticOrder S; S.init(MT / 256, NZ / 256, F.G, F.bid, 0);
        EpiZ E{F.out, F.ws};
        pg8::gemm_phase<EpiZ, pg8::StaticOrder>(F.lds, g, S, E, F.wave);
#if PROBE_DUP == 2
        pg8::gemm_phase<EpiZ, pg8::StaticOrder>(F.lds, g, S, E, F.wave);
#endif
        { const int nun = (MT / 256) * (NZ / 256), nlong = nun - (nun / F.G) * F.G;
          if (nlong > 0 && nlong < F.G) { if (F.bid >= nlong) { PB(); weight_copies(F, F.bid - nlong, F.G - nlong, WC_IN, WC_ALL); } }
          else { PB(); weight_copies(F, F.bid, F.G, WC_IN, WC_ALL); } }
    } SEAM(2);
    if (IN(3)) { PB(); p3_attention(F, 7);
#if PROBE_DUP == 3
        p3_attention<PROBE_PV>(F, PROBE_MASK);
#endif
    } SEAM(3);
    if (IN(10)) { PB(); p_combine(F);
#if PROBE_DUP == 10
        p_combine(F);
#endif
    } if (IN(10) && IN(4)) xcd_barrier(xbar);
    if (IN(4)) { PB();
        pg8::Gemm g{(const bf16_t*)(F.ws + WS_AB), (const bf16_t*)(F.ws + WS_WAB), 1024, 512, 512, 4, 512, 0};
        pg8::StaticOrder S; S.init(MT / 256, 8, F.G, F.bid, 0);
        EpiGate E{(bf16_t*)(F.ws + WS_G), (bf16_t*)(F.ws + WS_G)};
#if PROBE_DUP == 4
        { EpiGate E2{(bf16_t*)(F.ws + WS_G), (bf16_t*)(F.ws + WS_QA)}; pg8::gemm_phase<EpiGate, pg8::StaticOrder>(F.lds, g, S, E2, F.wave); }
#endif
        pg8::gemm_phase<EpiGate, pg8::StaticOrder>(F.lds, g, S, E, F.wave);
    } SEAM(4);
    if (IN(5)) { PB();
        { pg8::Gemm g2{(const bf16_t*)(F.ws + WS_G), (const bf16_t*)(F.ws + WS_WO2), 2048, 2048, 256, 1 << 30, 0, 256};
          pg8::SplitOrder S2; S2.init(4, 8, F.G, F.bid, SEQ / 256); EpiSlab E2{(float*)(F.ws + WS_SLAB)};
          pg8::gemm_phase<EpiSlab, pg8::SplitOrder>(F.lds, g2, S2, E2, F.wave); PB(); slab_publish(F, 322, 32); }
        pg8::Gemm g{(const bf16_t*)(F.ws + WS_G), (const bf16_t*)(F.ws + WS_WO2), 2048, 2048, 2048, 1 << 30, 0, 0};
        pg8::StaticOrder S; S.init(SEQ / 256, 4, F.G, F.bid, 0);
        EpiResLn<false> E{(const void*)F.in[I_XP], mod + 2048, F.in[I_LN1G], F.in[I_LN1B], mod, (bf16_t*)(F.ws + WS_X1B), (bf16_t*)(F.ws + WS_XN), nullptr,
                          PanelStats{(unsigned*)(F.ws + WS_XB1), (unsigned*)(F.ws + WS_CTL) + CTL_LN1, LN_EPS}, F.lds};
        pg8::gemm_phase<EpiResLn<false>, pg8::StaticOrder>(F.lds, g, S, E, F.wave);
        PB(); slab_wait(F, 322, 32); ln_rows<false>(F, F.in[I_LN1G], F.in[I_LN1B], 8, 2048);
    } if (IN(5) && IN(7)) xcd_barrier(xbar);

    if (IN(7)) { PB();
        pg8::Gemm g{(const bf16_t*)(F.ws + WS_XN), (const bf16_t*)(F.ws + WS_WFI), 1024, 1024, 1024, 1 << 30, 0, 0};
        pg8::StaticOrder S; S.init(MT / 256, NFF2 / 256, F.G, F.bid, 0);
        EpiFfn E{(bf16_t*)(F.ws + WS_ACT)};
        pg8::gemm_phase<EpiFfn, pg8::StaticOrder>(F.lds, g, S, E, F.wave);
#if PROBE_DUP == 7
        pg8::gemm_phase<EpiFfn, pg8::StaticOrder>(F.lds, g, S, E, F.wave);
#endif
    } SEAM(7);
    if (IN(8)) { PB();
        { pg8::Gemm g2{(const bf16_t*)(F.ws + WS_ACT), (const bf16_t*)(F.ws + WS_WFO), DFF, DFF, 256, 1 << 30, 0, 256};
          pg8::SplitOrder S2; S2.init(4, 11, F.G, F.bid, SEQ / 256); EpiSlab E2{(float*)(F.ws + WS_SLAB)};
          pg8::gemm_phase<EpiSlab, pg8::SplitOrder>(F.lds, g2, S2, E2, F.wave); PB(); slab_publish(F, 323, 44); }
        pg8::Gemm g{(const bf16_t*)(F.ws + WS_ACT), (const bf16_t*)(F.ws + WS_WFO), DFF, DFF, DFF, 1 << 30, 0, 0};
        pg8::StaticOrder S; S.init(SEQ / 256, 4, F.G, F.bid, 0);
        EpiResLn<true> E{(const void*)(F.ws + WS_X1B), mod + 5120, F.in[I_LN2G], F.in[I_LN2B], mod, nullptr, nullptr, F.out,
                         PanelStats{(unsigned*)(F.ws + WS_XB2), (unsigned*)(F.ws + WS_CTL) + CTL_LN2, LN_EPS}, F.lds};
        pg8::gemm_phase<EpiResLn<true>, pg8::StaticOrder>(F.lds, g, S, E, F.wave);
        PB(); slab_wait(F, 323, 44); ln_rows<true>(F, F.in[I_LN2G], F.in[I_LN2B], 11, 5120);
    }
#undef IN
#undef SEAM
}

extern "C" void kernel_launch(void* const* d_in, const int* in_sizes, int n_in, void* d_out, int out_size, void* d_ws, size_t ws_size, hipStream_t stream) {
    static int grid = 0;
    if (grid == 0) {
        if (n_in != 28 || (size_t)out_size != O_END || ws_size < WS_END) { fprintf(stderr, "kernel_launch: unexpected shapes (n_in %d out %d ws %zu)\n", n_in, out_size, ws_size); grid = -1; return; }
        int dev = 0, cus = 0, per_cu = 0;
        hipGetDevice(&dev); hipDeviceGetAttribute(&cus, hipDeviceAttributeMultiprocessorCount, dev);
        hipFuncSetAttribute((const void*)mega_fwd, hipFuncAttributeMaxDynamicSharedMemorySize, LDS_BYTES);
        hipOccupancyMaxActiveBlocksPerMultiprocessor(&per_cu, (const void*)mega_fwd, 512, LDS_BYTES);
        if (per_cu < 1) { fprintf(stderr, "kernel_launch: occupancy query says %d blocks per CU\n", per_cu); per_cu = 1; }
        (void)hipGetLastError();
        grid = cus;
    }
    if (grid < 0) return;
    hipMemsetAsync((char*)d_ws + WS_CTL, 0, CTL_BYTES, stream);
    Args a{};
    for (int i = 0; i < 28; ++i) a.in[i] = (const float*)d_in[i];
    a.out = (float*)d_out; a.ws = (unsigned char*)d_ws;
#if MK_N_LAUNCHES == 1
    a.ph_lo = 0; a.ph_hi = NPH;
    void* kargs[] = {&a};
    hipError_t e = hipLaunchCooperativeKernel((const void*)mega_fwd, dim3(grid), dim3(512), kargs, LDS_BYTES, stream);
    if (e != hipSuccess) fprintf(stderr, "cooperative launch failed: %s\n", hipGetErrorString(e));
#else
    { const int seq[NPH] = {0, 1, 2, 3, 10, 4, 5, 6, 7, 8, 9}; for (int i = 0; i < NPH; ++i) { a.ph_lo = seq[i]; a.ph_hi = seq[i] + 1; hipLaunchKernelGGL(mega_fwd, dim3(grid), dim3(512), LDS_BYTES, stream, a); } }
#endif
}
```
